# Optimizing an MI355X kernel written in HIP

```python
import math
import jax, jax.numpy as jnp
from jax import lax
import numpy as np

D_MODEL = 2048
BATCH = 2
SEQ = 4096
DEPTH = 2

N_MIXERS = 2
MEM_LEN = 256
CHUNK = 128
A_HEAD_DIM = 128
A_WIDTH = D_MODEL
A_HEADS = A_WIDTH // A_HEAD_DIM
B_GROUP = 16
B_STATE = 64
B_WIDTH = D_MODEL
B_GROUPS = B_WIDTH // B_GROUP
DT_MIN = 1e-3
DT_MAX = 1e-1
LAM_RE_MAX = -1e-4
X_HEADS = 4
X_HEAD_DIM = D_MODEL // X_HEADS
D_FF = 4 * D_MODEL
EPS = 1e-6

kernel_name = "hybrid_gmlp_s5_memory_trunk"

F32 = jnp.float32


def rms_norm(x, g):
    xf = x.astype(F32)
    y = xf * lax.rsqrt(jnp.mean(xf * xf, axis=-1, keepdims=True) + EPS)
    return (y * g.astype(F32)).astype(x.dtype)


def layer_norm(x, g, b):
    xf = x.astype(F32)
    mu = jnp.mean(xf, axis=-1, keepdims=True)
    var = jnp.mean(jnp.square(xf - mu), axis=-1, keepdims=True)
    y = (xf - mu) * lax.rsqrt(var + EPS)
    return (y * g.astype(F32) + b.astype(F32)).astype(x.dtype)


def chunked_gmlp(h, w_in, b_in, ln_g, ln_b, w_s, b_s, w_out):
    bsz, seq, _ = h.shape
    z = jax.nn.gelu(h @ w_in + b_in, approximate=False)
    u, v = jnp.split(z, 2, axis=-1)
    v = layer_norm(v, ln_g, ln_b)
    v = v.reshape(bsz, seq // CHUNK, CHUNK, A_HEADS, A_HEAD_DIM)
    causal = jnp.tril(jnp.ones((CHUNK, CHUNK), dtype=bool))
    w = jnp.where(causal[None], w_s, jnp.zeros((), w_s.dtype))
    s = jnp.einsum('hts,bnshd->bnthd', w, v) + jnp.swapaxes(b_s, 0, 1)[None, None, :, :, None]
    s = s.reshape(bsz, seq, A_WIDTH)
    return (u * s) @ w_out


def s5_glu(h, w_in, lam_re, lam_im, log_dt, bm_re, bm_im, cm_re, cm_im, d_skip, w_out, b_out):
    bsz, seq, _ = h.shape
    u = (h @ w_in).astype(F32).reshape(bsz, seq, B_GROUPS, B_GROUP)
    lam = lax.complex(jnp.minimum(lam_re.astype(F32), LAM_RE_MAX), lam_im.astype(F32))
    dt = jnp.exp(log_dt.astype(F32))[:, None]
    lam_bar = jnp.exp(lam * dt)
    bmat = lax.complex(bm_re.astype(F32), bm_im.astype(F32))
    b_bar = ((lam_bar - 1.0) / lam)[..., None] * bmat
    bu = jnp.einsum('gpc,bsgc->sbgp', b_bar, u.astype(jnp.complex64))
    a = jnp.broadcast_to(lam_bar[None, None], (seq, 1, B_GROUPS, B_STATE))

    def combine(left, right):
        a_l, b_l = left
        a_r, b_r = right
        return a_r * a_l, a_r * b_l + b_r

    _, states = lax.associative_scan(combine, (a, bu), axis=0)
    cmat = lax.complex(cm_re.astype(F32), cm_im.astype(F32))
    y = jnp.einsum('gcp,sbgp->bsgc', cmat, states).real + d_skip.astype(F32) * u
    y = jax.nn.gelu(y.reshape(bsz, seq, B_WIDTH), approximate=False).astype(h.dtype)
    val, gate = jnp.split(y @ w_out + b_out, 2, axis=-1)
    return val * jax.nn.sigmoid(gate)


def memory_attention(h, mem_n, w_q, w_kv, w_o):
    bsz, seq, _ = h.shape
    m = mem_n.shape[1]
    q = (h @ w_q).reshape(bsz, seq, X_HEADS, X_HEAD_DIM)
    k, v = jnp.split(mem_n @ w_kv, 2, axis=-1)
    k = k.reshape(bsz, m, X_HEADS, X_HEAD_DIM)
    v = v.reshape(bsz, m, X_HEADS, X_HEAD_DIM)
    scores = jnp.einsum('bshd,bmhd->bhsm', q, k).astype(F32) * (X_HEAD_DIM ** -0.5)
    p = jax.nn.softmax(scores, axis=-1).astype(v.dtype)
    o = jnp.einsum('bhsm,bmhd->bshd', p, v).reshape(bsz, seq, X_HEADS * X_HEAD_DIM)
    return o @ w_o


def squared_relu_mlp(h, w_up, w_down):
    return jnp.square(jax.nn.relu(h @ w_up)) @ w_down


def setup_inputs(seed: int = 0) -> dict:
    key = jax.random.key(seed)
    ks = iter(jax.random.split(key, 64))

    def nrm(shape, scale):
        return scale * jax.random.normal(next(ks), shape, F32)

    n_a = len(range(0, DEPTH, N_MIXERS))
    n_b = len(range(1, DEPTH, N_MIXERS))
    x = nrm((BATCH, SEQ, D_MODEL), 1.0)
    mem = nrm((BATCH, MEM_LEN, D_MODEL), 1.0)
    g_mix = 1.0 + nrm((DEPTH, D_MODEL), 0.02)
    g_xattn = 1.0 + nrm((DEPTH, D_MODEL), 0.02)
    g_mem = 1.0 + nrm((DEPTH, D_MODEL), 0.02)
    g_ff = 1.0 + nrm((DEPTH, D_MODEL), 0.02)
    g_final = 1.0 + nrm((D_MODEL,), 0.02)
    a_w_in = nrm((n_a, D_MODEL, 2 * A_WIDTH), D_MODEL ** -0.5)
    a_b_in = nrm((n_a, 2 * A_WIDTH), 0.02)
    a_ln_g = 1.0 + nrm((n_a, A_WIDTH), 0.02)
    a_ln_b = nrm((n_a, A_WIDTH), 0.02)
    a_w_s = nrm((n_a, A_HEADS, CHUNK, CHUNK), 0.5 * CHUNK ** -0.5)
    a_b_s = 1.0 + nrm((n_a, A_HEADS, CHUNK), 0.1)
    a_w_out = nrm((n_a, A_WIDTH, D_MODEL), A_WIDTH ** -0.5)
    b_w_in = nrm((n_b, D_MODEL, B_WIDTH), D_MODEL ** -0.5)
    n_idx = jnp.arange(B_STATE, dtype=F32)
    b_lam_re = -0.5 + nrm((n_b, B_GROUPS, B_STATE), 0.01)
    b_lam_im = math.pi * n_idx + nrm((n_b, B_GROUPS, B_STATE), 0.01)
    b_log_dt = jax.random.uniform(next(ks), (n_b, B_GROUPS), F32, math.log(DT_MIN), math.log(DT_MAX))
    b_bm_re = nrm((n_b, B_GROUPS, B_STATE, B_GROUP), (2 * B_GROUP) ** -0.5)
    b_bm_im = nrm((n_b, B_GROUPS, B_STATE, B_GROUP), (2 * B_GROUP) ** -0.5)
    b_cm_re = nrm((n_b, B_GROUPS, B_GROUP, B_STATE), B_STATE ** -0.5)
    b_cm_im = nrm((n_b, B_GROUPS, B_GROUP, B_STATE), B_STATE ** -0.5)
    b_d = nrm((n_b, B_GROUPS, B_GROUP), 1.0)
    b_w_out = nrm((n_b, B_WIDTH, 2 * D_MODEL), B_WIDTH ** -0.5)
    b_b_out = nrm((n_b, 2 * D_MODEL), 0.02)
    x_w_q = nrm((DEPTH, D_MODEL, D_MODEL), D_MODEL ** -0.5)
    x_w_kv = nrm((DEPTH, D_MODEL, 2 * D_MODEL), D_MODEL ** -0.5)
    x_w_o = nrm((DEPTH, D_MODEL, D_MODEL), D_MODEL ** -0.5)
    f_w_up = nrm((DEPTH, D_MODEL, D_FF), D_MODEL ** -0.5)
    f_w_down = nrm((DEPTH, D_FF, D_MODEL), D_FF ** -0.5)
    return {
        'x': x, 'mem': mem,
        'g_mix': g_mix, 'g_xattn': g_xattn, 'g_mem': g_mem, 'g_ff': g_ff, 'g_final': g_final,
        'a_w_in': a_w_in, 'a_b_in': a_b_in, 'a_ln_g': a_ln_g, 'a_ln_b': a_ln_b,
        'a_w_s': a_w_s, 'a_b_s': a_b_s, 'a_w_out': a_w_out,
        'b_w_in': b_w_in, 'b_lam_re': b_lam_re, 'b_lam_im': b_lam_im, 'b_log_dt': b_log_dt,
        'b_bm_re': b_bm_re, 'b_bm_im': b_bm_im, 'b_cm_re': b_cm_re, 'b_cm_im': b_cm_im,
        'b_d': b_d, 'b_w_out': b_w_out, 'b_b_out': b_b_out,
        'x_w_q': x_w_q, 'x_w_kv': x_w_kv, 'x_w_o': x_w_o,
        'f_w_up': f_w_up, 'f_w_down': f_w_down,
    }


def reference(x, mem, g_mix, g_xattn, g_mem, g_ff, g_final,
              a_w_in, a_b_in, a_ln_g, a_ln_b, a_w_s, a_b_s, a_w_out,
              b_w_in, b_lam_re, b_lam_im, b_log_dt, b_bm_re, b_bm_im, b_cm_re, b_cm_im,
              b_d, b_w_out, b_b_out,
              x_w_q, x_w_kv, x_w_o, f_w_up, f_w_down):
    for i in range(DEPTH):
        j = i // N_MIXERS
        h = rms_norm(x, g_mix[i])
        if i % N_MIXERS == 0:
            x = x + chunked_gmlp(h, a_w_in[j], a_b_in[j], a_ln_g[j], a_ln_b[j],
                                 a_w_s[j], a_b_s[j], a_w_out[j])
        else:
            x = x + s5_glu(h, b_w_in[j], b_lam_re[j], b_lam_im[j], b_log_dt[j],
                           b_bm_re[j], b_bm_im[j], b_cm_re[j], b_cm_im[j],
                           b_d[j], b_w_out[j], b_b_out[j])
        x = x + memory_attention(rms_norm(x, g_xattn[i]), rms_norm(mem, g_mem[i]),
                                 x_w_q[i], x_w_kv[i], x_w_o[i])
        x = x + squared_relu_mlp(rms_norm(x, g_ff[i]), f_w_up[i], f_w_down[i])
    return rms_norm(x, g_final)
```

```cpp
#include <hip/hip_runtime.h>
#include <hip/hip_cooperative_groups.h>
#include <cstdio>
#include <cstdint>
namespace cg = cooperative_groups;
#define MK_N_LAUNCHES 1
namespace pg8 {
#define PG8_LAS __attribute__((address_space(3)))
typedef unsigned short bf16_t;
typedef short bf16x8 __attribute__((ext_vector_type(8)));
typedef float f32x4 __attribute__((ext_vector_type(4)));
typedef unsigned u32x4 __attribute__((ext_vector_type(4)));
constexpr int BM = 256, BK = 64, HALF = 128, HTB = HALF * BK * 2  , STAGE_BYTES = 8 * HTB, NXCD = 8, WGM = 8;

__host__ __device__ __forceinline__ int lds_byte(int r, int c) { const int st = (r >> 4) * 2 + (c >> 5), rr = r & 15, cc = c & 31, ob = rr * 64 + cc * 2; return st * 1024 + (ob ^ (((ob >> 9) & 1) << 5)); }
__host__ __device__ __forceinline__ void stage_rc(int b, int& R, int& C) { const int st = b / 1024, sb = b % 1024, swz = sb ^ (((sb >> 9) & 1) << 5); R = (st >> 1) * 16 + swz / 64; C = (st & 1) * 32 + (swz % 64) / 2; }
__host__ __device__ __forceinline__ int perm32(int rho) { const int n = rho >> 4, i = rho & 15; return 8 * (i >> 2) + 4 * n + (i & 3); }

struct Unit { int pm, pn; };
struct Gemm { const bf16_t* A; const bf16_t* Bt; int M, N, K; };

struct StaticOrder {
    int nM, nN, nwg, G, c;
    __host__ __device__ void init(int M, int N, int G_, int c_) { nM = M / BM; nN = N / BM; nwg = nM * nN; G = G_; c = c_; }
    __host__ __device__ bool next(int i, Unit& u) const {
        const long L = (long)i * G + c; if (L >= nwg) return false;
        int wgid = (int)L; { const int q = nwg / NXCD, r = nwg % NXCD, xcd = wgid % NXCD, off = wgid / NXCD; wgid = (xcd < r ? xcd * (q + 1) : r * (q + 1) + (xcd - r) * q) + off; }
        const int nig = WGM * nN, gid = wgid / nig, fm = gid * WGM, gsz = (nM - fm) < WGM ? (nM - fm) : WGM;
        u.pm = fm + ((wgid % nig) % gsz); u.pn = (wgid % nig) / gsz; return true;
    }
    __device__ __forceinline__ void a_ready(const Unit&) const {}
    __device__ __forceinline__ void done(const Unit&) const {}
};

__device__ __forceinline__ unsigned cvt_pk_bf16(float lo, float hi) { unsigned r; asm volatile("v_cvt_pk_bf16_f32 %0, %1, %2" : "=v"(r) : "v"(lo), "v"(hi)); return r; }
typedef float f32x2 __attribute__((ext_vector_type(2)));
__device__ __forceinline__ f32x2 gelu_pk(f32x2 v) {
    const f32x2 av = __builtin_elementwise_abs(v), d = av * 0.2316418882f + 1.0f;
    f32x2 t; t.x = __builtin_amdgcn_rcpf(d.x); t.y = __builtin_amdgcn_rcpf(d.y);
    f32x2 q = t * 0.5307027145f + (-0.7265760135f); q = q * t + 0.7107068705f; q = q * t + (-0.142248368f); q = q * t + 0.127414796f; q = q * t;
    const f32x2 s = (v * v) * (-0.72134752044f);
    f32x2 e; e.x = __builtin_amdgcn_exp2f(s.x); e.y = __builtin_amdgcn_exp2f(s.y);
    const f32x2 m = v * (q * e), r = v - m;
    f32x2 o; o.x = v.x < 0.f ? m.x : r.x; o.y = v.y < 0.f ? m.y : r.y; return o;
}
typedef unsigned u32x2 __attribute__((ext_vector_type(2)));
constexpr int SSQ_STRIDE = 64;
__device__ __forceinline__ float row_rstd(const float* ssq, int np, int row, int fq) {
    const float* p = ssq + (size_t)row * SSQ_STRIDE + fq * (np >> 2);
    f32x4 a = *(const f32x4*)p, b = *(const f32x4*)(p + 4);
    float s = (a[0] + a[1]) + (a[2] + a[3]) + (b[0] + b[1]) + (b[2] + b[3]);
    if (np == 64) { f32x4 c = *(const f32x4*)(p + 8), d = *(const f32x4*)(p + 12); s += (c[0] + c[1]) + (c[2] + c[3]) + (d[0] + d[1]) + (d[2] + d[3]); }
    s += __shfl_xor(s, 16); s += __shfl_xor(s, 32);
    return __builtin_amdgcn_rsqf(s * (1.0f / 2048.0f) + 1e-6f);
}
template <int ACT, bool STATS> struct EpiAct {
    static constexpr bool PERM = true, AFTER_DRAIN = false;
    bf16_t* O; int ldc; const float* bias; const float* ssq; int np; float oscale; float* vst; int stat_pn0;
    __device__ __forceinline__ void operator()(const f32x4 (&acc)[2][2][4][2], const Unit& u, int wr, int wc, int fr, int fq) const {
        const int row0 = u.pm * BM + wr * 64 + fr, col0 = u.pn * BM + wc * 32 + 8 * fq;
        f32x4 bv[2][2];
#pragma unroll
        for (int bj = 0; bj < 2; ++bj)
#pragma unroll
            for (int n = 0; n < 2; ++n) bv[bj][n] = bias ? *(const f32x4*)(bias + col0 + bj * HALF + 4 * n) : (f32x4){0.f, 0.f, 0.f, 0.f};
        float rsv[2][4];
#pragma unroll
        for (int ai = 0; ai < 2; ++ai) {
#pragma unroll
            for (int m = 0; m < 4; ++m) rsv[ai][m] = row_rstd(ssq, np, row0 + ai * HALF + m * 16, fq);
            asm volatile("" ::: "memory"); }
#pragma unroll
        for (int ai = 0; ai < 2; ++ai)
#pragma unroll
            for (int m = 0; m < 4; ++m) { const int row = row0 + ai * HALF + m * 16; const float rs = rsv[ai][m];
                bf16_t* rowp = O + (size_t)row * ldc + col0; float s1 = 0.f, s2 = 0.f;
#pragma unroll
                for (int bj = 0; bj < 2; ++bj) { f32x4 v0 = acc[ai][bj][m][0] * rs + bv[bj][0], v1 = acc[ai][bj][m][1] * rs + bv[bj][1];
                    if (ACT == 1) { f32x2 a = gelu_pk((f32x2){v0[0], v0[1]}), b = gelu_pk((f32x2){v0[2], v0[3]}), c = gelu_pk((f32x2){v1[0], v1[1]}), d = gelu_pk((f32x2){v1[2], v1[3]});
                        v0 = (f32x4){a.x, a.y, b.x, b.y}; v1 = (f32x4){c.x, c.y, d.x, d.y}; }
                    if (ACT == 2) {
#pragma unroll
                        for (int j = 0; j < 4; ++j) { const float a = fmaxf(v0[j], 0.f), b = fmaxf(v1[j], 0.f); v0[j] = a * a; v1[j] = b * b; } }
                    v0 = v0 * oscale; v1 = v1 * oscale;
                    if (STATS) { s1 += (v0[0] + v0[1]) + (v0[2] + v0[3]) + (v1[0] + v1[1]) + (v1[2] + v1[3]);
                        s2 += (v0[0] * v0[0] + v0[1] * v0[1]) + (v0[2] * v0[2] + v0[3] * v0[3]) + (v1[0] * v1[0] + v1[1] * v1[1]) + (v1[2] * v1[2] + v1[3] * v1[3]); }
                    u32x4 w; w.x = cvt_pk_bf16(v0[0], v0[1]); w.y = cvt_pk_bf16(v0[2], v0[3]); w.z = cvt_pk_bf16(v1[0], v1[1]); w.w = cvt_pk_bf16(v1[2], v1[3]);
                    *(u32x4*)(rowp + bj * HALF) = w; }
                if (STATS) { s1 += __shfl_xor(s1, 16); s1 += __shfl_xor(s1, 32); s2 += __shfl_xor(s2, 16); s2 += __shfl_xor(s2, 32);
                    if (u.pn >= stat_pn0 && fq == 0) *(f32x2*)(vst + (size_t)row * SSQ_STRIDE + ((u.pn - stat_pn0) * 4 + wc) * 2) = (f32x2){s1, s2}; }
            }
    }
};
struct EpiRes {
    static constexpr bool PERM = false, AFTER_DRAIN = false;
    const float* base; float* out; bf16_t* xb; float* ssq;
    __device__ __forceinline__ void operator()(const f32x4 (&acc)[2][2][4][2], const Unit& u, int wr, int wc, int fr, int fq) const {
        const int row0 = u.pm * BM + wr * 64 + fr, col0 = u.pn * BM + wc * 32 + 4 * fq;
#pragma unroll
        for (int ai = 0; ai < 2; ++ai)
#pragma unroll
            for (int m = 0; m < 4; ++m) { const int row = row0 + ai * HALF + m * 16; const size_t off = (size_t)row * 2048 + col0; float ss = 0.f;
#pragma unroll
                for (int bj = 0; bj < 2; ++bj)
#pragma unroll
                    for (int n = 0; n < 2; ++n) { const f32x4 o = *(const f32x4*)(base + off + bj * HALF + n * 16) + acc[ai][bj][m][n];
                        *(f32x4*)(out + off + bj * HALF + n * 16) = o; ss += (o[0] * o[0] + o[1] * o[1]) + (o[2] * o[2] + o[3] * o[3]);
                        u32x2 w; w.x = cvt_pk_bf16(o[0], o[1]); w.y = cvt_pk_bf16(o[2], o[3]); *(u32x2*)(xb + off + bj * HALF + n * 16) = w; }
                ss += __shfl_xor(ss, 16); ss += __shfl_xor(ss, 32);
                if (fq == 0) ssq[(size_t)row * SSQ_STRIDE + u.pn * 4 + wc] = ss;
                asm volatile("" ::: "memory"); }
    }
};
struct EpiGlu {
    static constexpr bool PERM = false, AFTER_DRAIN = false;
    const float* base; float* out; bf16_t* xb; float* ssq; const float* bias;
    __device__ __forceinline__ void operator()(const f32x4 (&acc)[2][2][4][2], const Unit& u, int wr, int wc, int fr, int fq) const {
        const int row0 = u.pm * BM + wr * 64 + fr, col0 = u.pn * 128 + wc * 16 + 4 * fq;
        f32x4 bval[2], bgate[2];
#pragma unroll
        for (int bj = 0; bj < 2; ++bj) { bval[bj] = *(const f32x4*)(bias + col0 + bj * 64); bgate[bj] = *(const f32x4*)(bias + 2048 + col0 + bj * 64); }
#pragma unroll
        for (int ai = 0; ai < 2; ++ai)
#pragma unroll
            for (int m = 0; m < 4; ++m) { const int row = row0 + ai * HALF + m * 16; const size_t off = (size_t)row * 2048 + col0; float ss = 0.f;
#pragma unroll
                for (int bj = 0; bj < 2; ++bj) { const f32x4 val = acc[ai][bj][m][0] + bval[bj], gate = acc[ai][bj][m][1] + bgate[bj]; f32x4 o = *(const f32x4*)(base + off + bj * 64);
#pragma unroll
                    for (int j = 0; j < 4; ++j) { const float sg = __builtin_amdgcn_rcpf(1.0f + __builtin_amdgcn_exp2f(-1.4426950408889634f * gate[j])); o[j] += val[j] * sg; }
                    *(f32x4*)(out + off + bj * 64) = o; ss += (o[0] * o[0] + o[1] * o[1]) + (o[2] * o[2] + o[3] * o[3]);
                    u32x2 w; w.x = cvt_pk_bf16(o[0], o[1]); w.y = cvt_pk_bf16(o[2], o[3]); *(u32x2*)(xb + off + bj * 64) = w; }
                ss += __shfl_xor(ss, 16); ss += __shfl_xor(ss, 32);
                if (fq == 0) ssq[(size_t)row * SSQ_STRIDE + u.pn * 4 + wc] = ss;
                asm volatile("" ::: "memory"); }
    }
};
__host__ __device__ __forceinline__ int vt_pos(int key) { const int s = key >> 5, w = key & 31; return 32 * s + 8 * ((w & 15) >> 2) + (w & 3) + 4 * (w >> 4); }
struct EpiKV {
    static constexpr bool PERM = true, AFTER_DRAIN = false;
    bf16_t* Kb; bf16_t* Vb; bf16_t* VTb; const float* ssq;
    __device__ __forceinline__ void operator()(const f32x4 (&acc)[2][2][4][2], const Unit& u, int wr, int wc, int fr, int fq) const {
        const int row0 = u.pm * BM + wr * 64 + fr, col0 = u.pn * BM + wc * 32 + 8 * fq;
#pragma unroll
        for (int ai = 0; ai < 2; ++ai)
#pragma unroll
            for (int m = 0; m < 4; ++m) { const int row = row0 + ai * HALF + m * 16; const float rs = row_rstd(ssq, 32, row, fq); const int b = row >> 8, key = row & 255;
#pragma unroll
                for (int bj = 0; bj < 2; ++bj) { const f32x4 v0 = acc[ai][bj][m][0] * rs, v1 = acc[ai][bj][m][1] * rs; const int col = col0 + bj * HALF;
                    u32x4 w; w.x = cvt_pk_bf16(v0[0], v0[1]); w.y = cvt_pk_bf16(v0[2], v0[3]); w.z = cvt_pk_bf16(v1[0], v1[1]); w.w = cvt_pk_bf16(v1[2], v1[3]);
                    if (col < 2048) { const int h = col >> 9, d = col & 511; *(u32x4*)(Kb + ((size_t)((b * 4 + h) * 256 + key)) * 512 + d) = w; }
                    else { const int c2 = col - 2048, h = c2 >> 9, d = c2 & 511; *(u32x4*)(Vb + ((size_t)((b * 4 + h) * 256 + key)) * 512 + d) = w;
                        bf16_t* vt = VTb + ((size_t)((b * 4 + h) * 512 + d)) * 256 + vt_pos(key);
                        vt[0 * 256] = (bf16_t)(w.x & 0xffffu); vt[1 * 256] = (bf16_t)(w.x >> 16); vt[2 * 256] = (bf16_t)(w.y & 0xffffu); vt[3 * 256] = (bf16_t)(w.y >> 16);
                        vt[4 * 256] = (bf16_t)(w.z & 0xffffu); vt[5 * 256] = (bf16_t)(w.z >> 16); vt[6 * 256] = (bf16_t)(w.w & 0xffffu); vt[7 * 256] = (bf16_t)(w.w >> 16); } }
            }
    }
};
template <class Epi, class Sched, bool ALIGN_EPI = false, bool SP2 = false>
__device__ __forceinline__ void gemm_phase(PG8_LAS unsigned char* lds, const Gemm g, const Sched& S, const Epi& E, const int wid  , const int lane) {
    const int tid = wid * 64 + lane, wr = wid >> 2, wc = wid & 3, fr = lane & 15, fq = lane >> 4;
    const int K = g.K, nt = K / BK;
    unsigned voffA[2], voffB[2];
#pragma unroll
    for (int i = 0; i < 2; ++i) { int R, C; stage_rc(tid * 16 + i * 8192, R, C); const int Rb = Epi::PERM ? ((R & ~31) + perm32(R & 31)) : R;
        voffA[i] = (unsigned)(R * K + C) * 2u; voffB[i] = (unsigned)(Rb * K + C) * 2u; }
    const size_t kstep = (size_t)(BK * 2);
    const size_t hstep = (size_t)HALF * K * 2;
    const size_t tstep = 2 * hstep;
    const unsigned ldsw = (unsigned)wid * 1024u;
    const int aoff = lds_byte(wr * 64 + fr, fq * 8), boff = lds_byte(wc * 32 + fr, fq * 8);
#define PG8_SA(b, h) (((b) * 2 + (h)) * HTB)
#define PG8_SB(b, h) ((4 + (b) * 2 + (h)) * HTB)
#define PG8_STAGE(bufoff, gbase, voff) do { _Pragma("unroll") for (int _i = 0; _i < 2; ++_i) \
        __builtin_amdgcn_global_load_lds((const unsigned*)((const char*)(gbase) + (voff)[_i]), (PG8_LAS unsigned*)(lds + (bufoff) + ldsw + _i * 8192), 16, 0, 0); } while (0)
#define PG8_LDA(dst, b, h) do { _Pragma("unroll") for (int m = 0; m < 4; ++m) _Pragma("unroll") for (int k = 0; k < 2; ++k) dst[m][k] = *(const PG8_LAS bf16x8*)(lds + PG8_SA(b, h) + aoff + m * 2048 + k * 1024); } while (0)
#define PG8_LDB(dst, b, h) do { _Pragma("unroll") for (int n = 0; n < 2; ++n) _Pragma("unroll") for (int k = 0; k < 2; ++k) dst[n][k] = *(const PG8_LAS bf16x8*)(lds + PG8_SB(b, h) + boff + n * 2048 + k * 1024); } while (0)
#define PG8_MMA(ai, bj, At, Bt) do { __builtin_amdgcn_s_setprio(1); _Pragma("unroll") for (int m = 0; m < 4; ++m) _Pragma("unroll") for (int n = 0; n < 2; ++n) _Pragma("unroll") for (int k = 0; k < 2; ++k) \
        acc[ai][bj][m][n] = __builtin_amdgcn_mfma_f32_16x16x32_bf16(Bt[n][k], At[m][k], acc[ai][bj][m][n], 0, 0, 0); __builtin_amdgcn_s_setprio(0); } while (0)
#define PG8_WAIT_V(n) asm volatile("s_waitcnt vmcnt(" #n ")" ::: "memory")
#define PG8_WAIT_L(n) asm volatile("s_waitcnt lgkmcnt(" #n ")" ::: "memory")
#define PG8_BAR __builtin_amdgcn_s_barrier()
#define PG8_SCHED __builtin_amdgcn_sched_barrier(0)
    Unit cur, nxt; int ui = 0;
    if (!S.next(0, cur)) return;
    f32x4 acc[2][2][4][2];
#pragma unroll
    for (int a = 0; a < 2; ++a)
#pragma unroll
        for (int b = 0; b < 2; ++b)
#pragma unroll
            for (int m = 0; m < 4; ++m)
#pragma unroll
                for (int n = 0; n < 2; ++n) acc[a][b][m][n] = (f32x4){0.f, 0.f, 0.f, 0.f};
    bf16x8 At[4][2], B0[2][2], B1[2][2];
    const char* cA = (const char*)g.A + (size_t)cur.pm * tstep; const char* cB = (const char*)g.Bt + (size_t)cur.pn * tstep;
    S.a_ready(cur);
    if constexpr (SP2) {
        PG8_STAGE(PG8_SB(0, 0), cB, voffB); PG8_STAGE(PG8_SB(0, 1), cB + hstep, voffB); PG8_STAGE(PG8_SA(0, 0), cA, voffA); PG8_STAGE(PG8_SA(0, 1), cA + hstep, voffA);
        if (wr == 1) PG8_BAR;
        PG8_WAIT_V(2); PG8_BAR;
        PG8_STAGE(PG8_SB(1, 0), cB + kstep, voffB); PG8_STAGE(PG8_SA(1, 0), cA + kstep, voffA); PG8_STAGE(PG8_SB(1, 1), cB + hstep + kstep, voffB);
        PG8_WAIT_V(6); PG8_BAR;
    } else {
        PG8_STAGE(PG8_SB(0, 0), cB, voffB); PG8_STAGE(PG8_SA(0, 0), cA, voffA); PG8_STAGE(PG8_SB(0, 1), cB + hstep, voffB); PG8_STAGE(PG8_SA(0, 1), cA + hstep, voffA);
        if (wr == 1) PG8_BAR;
        PG8_WAIT_V(4); PG8_BAR;
        PG8_STAGE(PG8_SB(1, 0), cB + kstep, voffB); PG8_STAGE(PG8_SA(1, 0), cA + kstep, voffA); PG8_STAGE(PG8_SB(1, 1), cB + hstep + kstep, voffB);
        PG8_WAIT_V(6); PG8_BAR;
    }
    for (;;) {
        const bool has_next = S.next(ui + 1, nxt);
        const char* nA = has_next ? (const char*)g.A + (size_t)nxt.pm * tstep : cA; const char* nB = has_next ? (const char*)g.Bt + (size_t)nxt.pn * tstep : cB;
        for (int t = 0; t < nt; t += 2) {
            const bool last = (t == nt - 2);
            const char* a1 = cA + (size_t)(t + 1) * kstep;
            const char* a2 = last ? nA : cA + (size_t)(t + 2) * kstep; const char* b2 = last ? nB : cB + (size_t)(t + 2) * kstep;
            const char* a3 = a2 + kstep; const char* b3 = b2 + kstep;
            if (last && has_next) S.a_ready(nxt);
            if constexpr (SP2) {
            PG8_LDB(B0, 0, 0); PG8_LDB(B1, 0, 1); PG8_SCHED; PG8_LDA(At, 0, 0); PG8_STAGE(PG8_SA(1, 1), a1 + hstep, voffA);
            PG8_WAIT_V(8); PG8_WAIT_L(0); PG8_BAR; PG8_MMA(0, 0, At, B0); PG8_MMA(0, 1, At, B1); PG8_BAR; PG8_SCHED;
            PG8_LDA(At, 0, 1); PG8_STAGE(PG8_SB(0, 0), b2, voffB); PG8_STAGE(PG8_SB(0, 1), b2 + hstep, voffB); PG8_STAGE(PG8_SA(0, 0), a2, voffA);
            PG8_WAIT_V(8); PG8_WAIT_L(0); PG8_BAR; PG8_MMA(1, 0, At, B0); PG8_MMA(1, 1, At, B1); PG8_BAR; PG8_SCHED;
            PG8_LDB(B0, 1, 0); PG8_LDB(B1, 1, 1); PG8_SCHED; PG8_LDA(At, 1, 0); PG8_STAGE(PG8_SA(0, 1), a2 + hstep, voffA);
            PG8_WAIT_V(8); PG8_WAIT_L(0); PG8_BAR; PG8_MMA(0, 0, At, B0); PG8_MMA(0, 1, At, B1); PG8_BAR; PG8_SCHED;
            PG8_LDA(At, 1, 1); PG8_STAGE(PG8_SB(1, 0), b3, voffB); PG8_STAGE(PG8_SB(1, 1), b3 + hstep, voffB); PG8_STAGE(PG8_SA(1, 0), a3, voffA);
            PG8_WAIT_V(8); PG8_WAIT_L(0); PG8_BAR; PG8_MMA(1, 0, At, B0); PG8_MMA(1, 1, At, B1); PG8_BAR; PG8_SCHED;
            } else {
            PG8_LDB(B0, 0, 0); PG8_SCHED; PG8_LDA(At, 0, 0); PG8_STAGE(PG8_SA(1, 1), a1 + hstep, voffA);
            PG8_WAIT_L(8); PG8_BAR; PG8_WAIT_L(0); PG8_MMA(0, 0, At, B0); PG8_BAR; PG8_SCHED;
            PG8_LDB(B1, 0, 1); PG8_STAGE(PG8_SB(0, 0), b2, voffB);
            PG8_BAR; PG8_WAIT_L(0); PG8_MMA(0, 1, At, B1); PG8_BAR;
            PG8_LDA(At, 0, 1); PG8_STAGE(PG8_SA(0, 0), a2, voffA);
            PG8_BAR; PG8_WAIT_L(0); PG8_MMA(1, 0, At, B0); PG8_BAR; PG8_SCHED;
            PG8_STAGE(PG8_SB(0, 1), b2 + hstep, voffB);
            PG8_WAIT_V(6); PG8_BAR; PG8_MMA(1, 1, At, B1); PG8_BAR;
            PG8_LDB(B0, 1, 0); PG8_SCHED; PG8_LDA(At, 1, 0); PG8_STAGE(PG8_SA(0, 1), a2 + hstep, voffA);
            PG8_WAIT_L(8); PG8_BAR; PG8_WAIT_L(0); PG8_MMA(0, 0, At, B0); PG8_BAR; PG8_SCHED;
            PG8_LDB(B1, 1, 1); PG8_STAGE(PG8_SB(1, 0), b3, voffB);
            PG8_BAR; PG8_WAIT_L(0); PG8_MMA(0, 1, At, B1); PG8_BAR;
            PG8_LDA(At, 1, 1); PG8_STAGE(PG8_SA(1, 0), a3, voffA);
            PG8_BAR; PG8_WAIT_L(0); PG8_MMA(1, 0, At, B0); PG8_BAR; PG8_SCHED;
            PG8_STAGE(PG8_SB(1, 1), b3 + hstep, voffB);
            PG8_WAIT_V(6); PG8_BAR; PG8_MMA(1, 1, At, B1); PG8_BAR;
            }
        }
        if constexpr (ALIGN_EPI) { if (wr == 0) PG8_BAR; }
        if constexpr (!Epi::AFTER_DRAIN) { Unit ue = cur; asm volatile("" : "+s"(ue.pm), "+s"(ue.pn));
            E(acc, ue, wr, wc, fr, fq); S.done(cur); }
        if (!has_next) break;
#pragma unroll
        for (int a = 0; a < 2; ++a)
#pragma unroll
            for (int b = 0; b < 2; ++b)
#pragma unroll
                for (int m = 0; m < 4; ++m)
#pragma unroll
                    for (int n = 0; n < 2; ++n) acc[a][b][m][n] = (f32x4){0.f, 0.f, 0.f, 0.f};
        cur = nxt; cA = nA; cB = nB; ++ui;
        if constexpr (ALIGN_EPI) { if (wr == 1) PG8_BAR; }
    }
    PG8_WAIT_V(0);
    if constexpr (!ALIGN_EPI) { if (wr == 0) PG8_BAR; }
    PG8_BAR;
    if constexpr (Epi::AFTER_DRAIN) { E.fused(acc, cur, wr, wc, fr, fq, lds, wid, lane); S.done(cur); }
#undef PG8_SA
#undef PG8_SB
#undef PG8_STAGE
#undef PG8_LDA
#undef PG8_LDB
#undef PG8_MMA
#undef PG8_WAIT_V
#undef PG8_WAIT_L
#undef PG8_BAR
#undef PG8_SCHED
}
}
#ifndef MK_N_LAUNCHES
#define MK_N_LAUNCHES 1
#endif
constexpr int BATCH = 2, SEQ = 4096, D = 2048, M = BATCH * SEQ, MEMLEN = 256, MROWS = BATCH * MEMLEN, FF = 8192;
constexpr int NWAVES = 8, NTHREADS = 512, NPH = 20;
constexpr int LDS_BYTES = 147456;
constexpr size_t MiB = 1u << 20;
constexpr size_t WS_W_AIN = 2 * MiB, WS_W_AOUT = 18 * MiB, WS_W_BIN = 26 * MiB, WS_W_BOUT = 34 * MiB, WS_W_Q = 50 * MiB, WS_W_KV = 66 * MiB, WS_W_O = 98 * MiB, WS_W_UP = 114 * MiB, WS_W_DN = 178 * MiB;
constexpr size_t WS_XB = 242 * MiB, WS_MEMB = 274 * MiB, WS_KB = 276 * MiB, WS_VB = 280 * MiB, WS_VTB = 284 * MiB, WS_SSQ = 288 * MiB, WS_VST = 290 * MiB, WS_SSQM = 292 * MiB, WS_S5ST = 294 * MiB;
constexpr size_t WS_R = 304 * MiB, WS_END = 432 * MiB;
#define GAS __attribute__((address_space(1)))
#define LAS __attribute__((address_space(3)))
typedef unsigned short bf16;
typedef unsigned v4u __attribute__((ext_vector_type(4)));
typedef unsigned v2u __attribute__((ext_vector_type(2)));
typedef float f32x4 __attribute__((ext_vector_type(4)));
typedef float f32x2 __attribute__((ext_vector_type(2)));
#define LDS_WAIT() asm volatile("s_waitcnt lgkmcnt(0)" ::: "memory")
__device__ __forceinline__ unsigned f2bf(float f) { unsigned u = __builtin_bit_cast(unsigned, f); return (u + 0x7fffu + ((u >> 16) & 1u)) >> 16; }
__device__ __forceinline__ unsigned pk2(float lo, float hi) { return f2bf(lo) | (f2bf(hi) << 16); }
__device__ __forceinline__ float bflo(unsigned w) { return __builtin_bit_cast(float, w << 16); }
__device__ __forceinline__ float bfhi(unsigned w) { return __builtin_bit_cast(float, w & 0xffff0000u); }
__device__ __forceinline__ float wave_sum(float v) {
#pragma unroll
    for (int o = 1; o < 64; o <<= 1) v += __shfl_xor(v, o);
    return v;
}
__device__ __forceinline__ float wave_max(float v) {
#pragma unroll
    for (int o = 1; o < 64; o <<= 1) v = fmaxf(v, __shfl_xor(v, o));
    return v;
}
__device__ __forceinline__ float gelu_exact(float v) { return 0.5f * v * (1.0f + erff(v * 0.70710678118654752f)); }

struct Args { const float* in[30]; float* out; unsigned char* ws; int ph_lo, ph_hi; };
__device__ __forceinline__ const float* ka_in(int i) { const __attribute__((address_space(4))) char* ka = (const __attribute__((address_space(4))) char*)__builtin_amdgcn_kernarg_segment_ptr(); asm volatile("" : "+s"(ka)); return *(const float* const __attribute__((address_space(4)))*)(ka + 8 * i); }

__device__ __forceinline__ int glu_rowmap(int n) { return n < 2048 ? 32 * (n >> 4) + (n & 15) : 32 * ((n - 2048) >> 4) + 16 + (n & 15); }
__device__ __forceinline__ void conv_item(const float* W, int K, int N, const float* gk, int mode, bf16* WT, LAS float* scr, int item, int lane) {
    const int nblk = N >> 6, kb = item / nblk, nb = item - kb * nblk, k0 = 64 * kb, n0 = 64 * nb;
    f32x4 v[16];
#pragma unroll
    for (int i = 0; i < 16; ++i) { const int kk = 4 * i + (lane >> 4); v[i] = *(const f32x4*)(W + (size_t)(k0 + kk) * N + n0 + 4 * (lane & 15)); }
#pragma unroll
    for (int i = 0; i < 16; ++i) { const int kk = 4 * i + (lane >> 4); const float s = gk ? gk[k0 + kk] : 1.0f; LAS float* d = scr + kk * 65 + 4 * (lane & 15);
        d[0] = v[i][0] * s; d[1] = v[i][1] * s; d[2] = v[i][2] * s; d[3] = v[i][3] * s; }
    LDS_WAIT();
    const int c = lane & 7;
#pragma unroll
    for (int j = 0; j < 8; ++j) { const int n = (lane >> 3) + 8 * j; const LAS float* s = scr + (8 * c) * 65 + n;
        v4u o; o.x = pk2(s[0 * 65], s[1 * 65]); o.y = pk2(s[2 * 65], s[3 * 65]); o.z = pk2(s[4 * 65], s[5 * 65]); o.w = pk2(s[6 * 65], s[7 * 65]);
        const int nr = mode ? glu_rowmap(n0 + n) : (n0 + n);
        *(v4u*)(WT + (size_t)nr * K + k0 + 8 * c) = o; }
    LDS_WAIT();
}
__device__ __forceinline__ void row_to_bf16(const float* xrow, bf16* orow, float* ssqrow, int lane) {
    f32x4 v[8]; float s = 0.f;
#pragma unroll
    for (int j = 0; j < 8; ++j) { v[j] = ((const f32x4*)xrow)[lane + 64 * j]; s += (v[j][0] * v[j][0] + v[j][1] * v[j][1]) + (v[j][2] * v[j][2] + v[j][3] * v[j][3]); }
    s = wave_sum(s);
#pragma unroll
    for (int j = 0; j < 8; ++j) { v2u w; w.x = pk2(v[j][0], v[j][1]); w.y = pk2(v[j][2], v[j][3]); ((v2u*)orow)[lane + 64 * j] = w; }
    if (lane < 32) ssqrow[lane] = (lane == 0) ? s : 0.f;
}
__device__ __forceinline__ void p0_prologue(unsigned char* ws, LAS unsigned char* lds, int wave, int lane) {
    LAS float* scr = (LAS float*)(lds + wave * 16640);
    const int gw = blockIdx.x * NWAVES + wave, NGW = gridDim.x * NWAVES;
    constexpr int NITEMS = 30720;
    for (int it0 = gw; it0 < NITEMS; it0 += NGW) {
        int r = __builtin_amdgcn_readfirstlane(it0);
        const float* W; const float* g = nullptr; bf16* WT; int K = 2048, N = 2048, mode = 0;
        if (r < 2048) { W = ka_in(7); g = ka_in(2); WT = (bf16*)(ws + WS_W_AIN); N = 4096; }
        else if ((r -= 2048) < 1024) { W = ka_in(13); WT = (bf16*)(ws + WS_W_AOUT); }
        else if ((r -= 1024) < 1024) { W = ka_in(14); g = ka_in(2) + 2048; WT = (bf16*)(ws + WS_W_BIN); }
        else if ((r -= 1024) < 2048) { W = ka_in(23); WT = (bf16*)(ws + WS_W_BOUT); N = 4096; mode = 1; }
        else if ((r -= 2048) < 2048) { const int i = r >> 10; r &= 1023; W = ka_in(25) + (size_t)i * 2048 * 2048; g = ka_in(3) + i * 2048; WT = (bf16*)(ws + WS_W_Q + i * 8 * MiB); }
        else if ((r -= 2048) < 4096) { const int i = r >> 11; r &= 2047; W = ka_in(26) + (size_t)i * 2048 * 4096; g = ka_in(4) + i * 2048; WT = (bf16*)(ws + WS_W_KV + i * 16 * MiB); N = 4096; }
        else if ((r -= 4096) < 2048) { const int i = r >> 10; r &= 1023; W = ka_in(27) + (size_t)i * 2048 * 2048; WT = (bf16*)(ws + WS_W_O + i * 8 * MiB); }
        else if ((r -= 2048) < 8192) { const int i = r >> 12; r &= 4095; W = ka_in(28) + (size_t)i * 2048 * 8192; g = ka_in(5) + i * 2048; WT = (bf16*)(ws + WS_W_UP + i * 32 * MiB); N = 8192; }
        else { r -= 8192; const int i = r >> 12; r &= 4095; W = ka_in(29) + (size_t)i * 8192 * 2048; WT = (bf16*)(ws + WS_W_DN + i * 32 * MiB); K = 8192; }
        conv_item(W, K, N, g, mode, WT, scr, r, lane);
    }
    for (int m = gw; m < M + MROWS; m += NGW) {
        if (m < M) row_to_bf16(ka_in(0) + (size_t)m * D, (bf16*)(ws + WS_XB) + (size_t)m * D, (float*)(ws + WS_SSQ) + (size_t)m * 64, lane);
        else { const int r = m - M; row_to_bf16(ka_in(1) + (size_t)r * D, (bf16*)(ws + WS_MEMB) + (size_t)r * D, (float*)(ws + WS_SSQM) + (size_t)r * 64, lane); }
    }
}
__device__ __forceinline__ void final_norm(float* x, const float* g, int wave, int lane) {
    const int gw = blockIdx.x * NWAVES + wave, NGW = gridDim.x * NWAVES;
    for (int m = gw; m < M; m += NGW) { f32x4* xr = (f32x4*)(x + (size_t)m * D); f32x4 v[8]; float s = 0.f;
#pragma unroll
        for (int j = 0; j < 8; ++j) { v[j] = xr[lane + 64 * j]; s += (v[j][0] * v[j][0] + v[j][1] * v[j][1]) + (v[j][2] * v[j][2] + v[j][3] * v[j][3]); }
        const float rs = 1.0f / sqrtf(wave_sum(s) * (1.0f / D) + 1e-6f);
#pragma unroll
        for (int j = 0; j < 8; ++j) { const f32x4 gv = ((const f32x4*)g)[lane + 64 * j]; xr[lane + 64 * j] = v[j] * rs * gv; } }
}
__device__ __forceinline__ void gating_simple(LAS unsigned char* lds, const bf16* z, const float* vst, const float* ln_g, const float* ln_b, const float* w_s, const float* b_s, bf16* gbuf, int tid) {
    LAS float* vln = (LAS float*)lds;
    LAS float* Wl = (LAS float*)(lds + 65536);
    LAS float* mu = (LAS float*)(lds + 65536 + 128 * 129 * 4);
    LAS float* rsd = mu + 128;
    for (int unit = blockIdx.x; unit < 1024; unit += gridDim.x) {
        const int h = unit & 15, tok0 = (unit >> 4) * 128;
        if (tid < 128) { const float* p = vst + (size_t)(tok0 + tid) * 64; float s1 = 0.f, s2 = 0.f;
#pragma unroll 8
            for (int i = 0; i < 32; ++i) { s1 += p[2 * i]; s2 += p[2 * i + 1]; }
            const float mean = s1 * (1.0f / 2048.0f), var = s2 * (1.0f / 2048.0f) - mean * mean; mu[tid] = mean; rsd[tid] = 1.0f / sqrtf(var + 1e-6f); }
        __syncthreads();
        { const int s = tid >> 2, db = (tid & 3) * 32; const float mean = mu[s], rs = rsd[s];
            const bf16* vp = z + (size_t)(tok0 + s) * 4096 + 2048 + h * 128 + db;
#pragma unroll
            for (int q = 0; q < 4; ++q) { const v4u w = *(const v4u*)(vp + 8 * q); const float* gp = ln_g + h * 128 + db + 8 * q; const float* bp = ln_b + h * 128 + db + 8 * q; LAS float* o = vln + s * 128 + db + 8 * q;
                o[0] = (bflo(w.x) - mean) * rs * gp[0] + bp[0]; o[1] = (bfhi(w.x) - mean) * rs * gp[1] + bp[1]; o[2] = (bflo(w.y) - mean) * rs * gp[2] + bp[2]; o[3] = (bfhi(w.y) - mean) * rs * gp[3] + bp[3];
                o[4] = (bflo(w.z) - mean) * rs * gp[4] + bp[4]; o[5] = (bfhi(w.z) - mean) * rs * gp[5] + bp[5]; o[6] = (bflo(w.w) - mean) * rs * gp[6] + bp[6]; o[7] = (bfhi(w.w) - mean) * rs * gp[7] + bp[7]; }
            const float* wp = w_s + ((size_t)h * 128 + s) * 128 + db;
#pragma unroll
            for (int q = 0; q < 8; ++q) { const f32x4 w4 = *(const f32x4*)(wp + 4 * q); LAS float* o = Wl + s * 129 + db + 4 * q; o[0] = w4[0]; o[1] = w4[1]; o[2] = w4[2]; o[3] = w4[3]; } }
        __syncthreads();
        { const int t = tid >> 2, d0 = (tid & 3) * 32, tmax = t | 15; float acc[32];
#pragma unroll
            for (int j = 0; j < 32; ++j) acc[j] = 0.f;
            for (int s = 0; s <= tmax; ++s) { const float w = (s <= t) ? Wl[t * 129 + s] : 0.f; const LAS f32x4* vr = (const LAS f32x4*)(vln + s * 128 + d0);
#pragma unroll
                for (int q = 0; q < 8; ++q) { const f32x4 vv = vr[q]; acc[4 * q] += w * vv[0]; acc[4 * q + 1] += w * vv[1]; acc[4 * q + 2] += w * vv[2]; acc[4 * q + 3] += w * vv[3]; } }
            const float bs = b_s[h * 128 + t];
            const bf16* up = z + (size_t)(tok0 + t) * 4096 + h * 128 + d0; bf16* op = gbuf + (size_t)(tok0 + t) * 2048 + h * 128 + d0;
#pragma unroll
            for (int q = 0; q < 4; ++q) { const v4u w = *(const v4u*)(up + 8 * q); v4u o;
                o.x = pk2(bflo(w.x) * (acc[8 * q] + bs), bfhi(w.x) * (acc[8 * q + 1] + bs)); o.y = pk2(bflo(w.y) * (acc[8 * q + 2] + bs), bfhi(w.y) * (acc[8 * q + 3] + bs));
                o.z = pk2(bflo(w.z) * (acc[8 * q + 4] + bs), bfhi(w.z) * (acc[8 * q + 5] + bs)); o.w = pk2(bflo(w.w) * (acc[8 * q + 6] + bs), bfhi(w.w) * (acc[8 * q + 7] + bs));
                *(v4u*)(op + 8 * q) = o; } }
        __syncthreads();
    }
}
__device__ __forceinline__ void attn_simple(LAS unsigned char* lds, const bf16* q, const bf16* Kb, const bf16* Vb, bf16* obuf, int wave, int lane) {
    LAS float* pl = (LAS float*)(lds + wave * 1024);
    const int gw = blockIdx.x * NWAVES + wave, NGW = gridDim.x * NWAVES;
    for (int task = gw; task < BATCH * 4 * SEQ; task += NGW) {
        const int bh = task >> 12, t = task & 4095, b = bh >> 2, h = bh & 3;
        float qf[8]; { const v4u w = *(const v4u*)(q + ((size_t)(b * SEQ + t)) * 2048 + h * 512 + 8 * lane);
            qf[0] = bflo(w.x); qf[1] = bfhi(w.x); qf[2] = bflo(w.y); qf[3] = bfhi(w.y); qf[4] = bflo(w.z); qf[5] = bfhi(w.z); qf[6] = bflo(w.w); qf[7] = bfhi(w.w); }
        const bf16* kp = Kb + (size_t)bh * 256 * 512 + 8 * lane;
        float sc[4];
#pragma unroll
        for (int kk = 0; kk < 4; ++kk) { float mine = 0.f;
            for (int l2 = 0; l2 < 64; ++l2) { const v4u w = *(const v4u*)(kp + (size_t)(kk * 64 + l2) * 512);
                float dsum = qf[0] * bflo(w.x) + qf[1] * bfhi(w.x) + qf[2] * bflo(w.y) + qf[3] * bfhi(w.y) + qf[4] * bflo(w.z) + qf[5] * bfhi(w.z) + qf[6] * bflo(w.w) + qf[7] * bfhi(w.w);
                dsum = wave_sum(dsum); if (lane == l2) mine = dsum; }
            sc[kk] = mine; }
        const float mx = wave_max(fmaxf(fmaxf(sc[0], sc[1]), fmaxf(sc[2], sc[3])));
        float p[4], ps = 0.f;
#pragma unroll
        for (int kk = 0; kk < 4; ++kk) { p[kk] = exp2f(sc[kk] - mx); ps += p[kk]; pl[kk * 64 + lane] = p[kk]; }
        const float inv = 1.0f / wave_sum(ps);
        LDS_WAIT();
        float o[8];
#pragma unroll
        for (int i = 0; i < 8; ++i) o[i] = 0.f;
        const bf16* vp = Vb + (size_t)bh * 256 * 512 + 8 * lane;
        for (int key = 0; key < 256; ++key) { const float pk = pl[key]; const v4u w = *(const v4u*)(vp + (size_t)key * 512);
            o[0] += pk * bflo(w.x); o[1] += pk * bfhi(w.x); o[2] += pk * bflo(w.y); o[3] += pk * bfhi(w.y); o[4] += pk * bflo(w.z); o[5] += pk * bfhi(w.z); o[6] += pk * bflo(w.w); o[7] += pk * bfhi(w.w); }
        v4u ow; ow.x = pk2(o[0] * inv, o[1] * inv); ow.y = pk2(o[2] * inv, o[3] * inv); ow.z = pk2(o[4] * inv, o[5] * inv); ow.w = pk2(o[6] * inv, o[7] * inv);
        *(v4u*)(obuf + ((size_t)(b * SEQ + t)) * 2048 + h * 512 + 8 * lane) = ow;
        LDS_WAIT();
    }
}
struct S5Lane { float lbr, lbi; float Br[16], Bi[16]; };
__device__ __forceinline__ void s5_lane_params(int g, int p, S5Lane& L) {
    const float lr = fminf(ka_in(15)[g * 64 + p], -1e-4f), li = ka_in(16)[g * 64 + p], dt = expf(ka_in(17)[g]);
    const float ar = lr * dt, th = li * dt; float sn, cs; sincosf(th, &sn, &cs); const float e = expf(ar), sh = sinf(0.5f * th);
    L.lbr = e * cs; L.lbi = e * sn;
    const float nr = expm1f(ar) * cs - 2.0f * sh * sh, ni = e * sn;
    const float den = 1.0f / (lr * lr + li * li), cr = (nr * lr + ni * li) * den, ci = (ni * lr - nr * li) * den;
#pragma unroll
    for (int c = 0; c < 16; ++c) { const float br = ka_in(18)[(size_t)(g * 64 + p) * 16 + c], bi = ka_in(19)[(size_t)(g * 64 + p) * 16 + c]; L.Br[c] = cr * br - ci * bi; L.Bi[c] = cr * bi + ci * br; }
}
__device__ __forceinline__ void s5_step(const S5Lane& L, const bf16* urow, float& xr, float& xi) {
    const v4u w0 = *(const v4u*)urow, w1 = *(const v4u*)(urow + 8);
    float u[16] = {bflo(w0.x), bfhi(w0.x), bflo(w0.y), bfhi(w0.y), bflo(w0.z), bfhi(w0.z), bflo(w0.w), bfhi(w0.w), bflo(w1.x), bfhi(w1.x), bflo(w1.y), bfhi(w1.y), bflo(w1.z), bfhi(w1.z), bflo(w1.w), bfhi(w1.w)};
    float br = 0.f, bi = 0.f;
#pragma unroll
    for (int c = 0; c < 16; ++c) { br += L.Br[c] * u[c]; bi += L.Bi[c] * u[c]; }
    const float nr = L.lbr * xr - L.lbi * xi + br, ni = L.lbr * xi + L.lbi * xr + bi; xr = nr; xi = ni;
}
__device__ __forceinline__ void s5_pass_a(const bf16* ub, f32x2* st, int wave, int lane) {
    const int gw = blockIdx.x * NWAVES + wave, NGW = gridDim.x * NWAVES;
    for (int task = gw; task < BATCH * 128 * 64; task += NGW) {
        const int seg = task & 63, g = (task >> 6) & 127, b = task >> 13;
        S5Lane L; s5_lane_params(g, lane, L);
        float xr = 0.f, xi = 0.f; const bf16* up = ub + (size_t)(b * SEQ + seg * 64) * 2048 + 16 * g;
#pragma unroll 2
        for (int s = 0; s < 64; ++s) s5_step(L, up + (size_t)s * 2048, xr, xi);
        st[(size_t)task * 64 + lane] = (f32x2){xr, xi};
    }
}
__device__ __forceinline__ void s5_pass_c(LAS unsigned char* lds, const bf16* ub, const f32x2* st, bf16* yb, int wave, int lane) {
    LAS f32x2* Cs = (LAS f32x2*)(lds + wave * 16640);
    LAS f32x2* xs = (LAS f32x2*)(lds + wave * 16640 + 8320);
    const int gw = blockIdx.x * NWAVES + wave, NGW = gridDim.x * NWAVES;
    for (int task = gw; task < BATCH * 128 * 64; task += NGW) {
        const int seg = task & 63, g = (task >> 6) & 127, b = task >> 13;
        S5Lane L; s5_lane_params(g, lane, L);
#pragma unroll
        for (int c = 0; c < 16; ++c) Cs[c * 65 + lane] = (f32x2){ka_in(20)[(size_t)(g * 16 + c) * 64 + lane], ka_in(21)[(size_t)(g * 16 + c) * 64 + lane]};
        float Ar = L.lbr, Ai = L.lbi;
#pragma unroll
        for (int i = 0; i < 6; ++i) { const float nr = Ar * Ar - Ai * Ai, ni = 2.0f * Ar * Ai; Ar = nr; Ai = ni; }
        float xr = 0.f, xi = 0.f; const f32x2* sp = st + (size_t)(task - seg) * 64 + lane;
#pragma unroll 2
        for (int n = 0; n < seg; ++n) { const f32x2 s = sp[(size_t)n * 64]; const float nr = Ar * xr - Ai * xi + s.x, ni = Ar * xi + Ai * xr + s.y; xr = nr; xi = ni; }
        const bf16* up = ub + (size_t)(b * SEQ + seg * 64) * 2048 + 16 * g; bf16* yp = yb + (size_t)(b * SEQ + seg * 64) * 2048 + 16 * g;
        const int t = lane & 15, cq = lane >> 4;
        f32x4 dsk = *(const f32x4*)(ka_in(22) + g * 16 + 4 * cq);
#pragma unroll 1
        for (int blk = 0; blk < 4; ++blk) {
#pragma unroll 2
            for (int s = 0; s < 16; ++s) { s5_step(L, up + (size_t)(blk * 16 + s) * 2048, xr, xi); xs[s * 65 + lane] = (f32x2){xr, xi}; }
            LDS_WAIT();
            float acc[4] = {0.f, 0.f, 0.f, 0.f};
#pragma unroll 4
            for (int p = 0; p < 64; ++p) { const f32x2 x = xs[t * 65 + p];
#pragma unroll
                for (int j = 0; j < 4; ++j) { const f32x2 c = Cs[(4 * cq + j) * 65 + p]; acc[j] += c.x * x.x - c.y * x.y; } }
            const v2u uw = *(const v2u*)(up + (size_t)(blk * 16 + t) * 2048 + 4 * cq);
            const float y0 = gelu_exact(acc[0] + dsk[0] * bflo(uw.x)), y1 = gelu_exact(acc[1] + dsk[1] * bfhi(uw.x)), y2 = gelu_exact(acc[2] + dsk[2] * bflo(uw.y)), y3 = gelu_exact(acc[3] + dsk[3] * bfhi(uw.y));
            v2u ow; ow.x = pk2(y0, y1); ow.y = pk2(y2, y3); *(v2u*)(yp + (size_t)(blk * 16 + t) * 2048 + 4 * cq) = ow;
            LDS_WAIT();
        }
    }
}
#ifndef EN
#define EN(k) 1
#endif
template <int PH> __device__ __forceinline__ void run_phase(unsigned char* ws, float* X, LAS unsigned char* lds, int wave, int lane) {
    const int G = gridDim.x, bx = blockIdx.x;
    bf16* XB = (bf16*)(ws + WS_XB); float* SSQ = (float*)(ws + WS_SSQ);
    bf16* R0 = (bf16*)(ws + WS_R);
    constexpr int layer = (PH >= 10) ? 1 : 0;
    if constexpr (!EN(PH)) { return; }
    else if constexpr (PH == 0) p0_prologue(ws, lds, wave, lane);
    else if constexpr (PH == 1) {
        if (bx < 64) { const int i = bx >> 5;
            pg8::Gemm g{(const pg8::bf16_t*)(ws + WS_MEMB), (const pg8::bf16_t*)(ws + WS_W_KV + (size_t)i * 16 * MiB), MROWS, 4096, 2048}; pg8::StaticOrder S; S.init(MROWS, 4096, 32, bx & 31);
            pg8::EpiKV E{(pg8::bf16_t*)(ws + WS_KB + (size_t)i * 2 * MiB), (pg8::bf16_t*)(ws + WS_VB + (size_t)i * 2 * MiB), (pg8::bf16_t*)(ws + WS_VTB + (size_t)i * 2 * MiB), (const float*)(ws + WS_SSQM)};
            pg8::gemm_phase<pg8::EpiKV, pg8::StaticOrder, true, true>(lds, g, S, E, wave, lane); }
    } else if constexpr (PH == 2) {
        pg8::Gemm g{XB, (const pg8::bf16_t*)(ws + WS_W_AIN), M, 4096, 2048}; pg8::StaticOrder S; S.init(M, 4096, G, bx);
        pg8::EpiAct<1, true> E{R0, 4096, ka_in(8), SSQ, 32, 1.0f, (float*)(ws + WS_VST), 8};
        pg8::gemm_phase<pg8::EpiAct<1, true>, pg8::StaticOrder, true, true>(lds, g, S, E, wave, lane);
    } else if constexpr (PH == 3) gating_simple(lds, R0, (const float*)(ws + WS_VST), ka_in(9), ka_in(10), ka_in(11), ka_in(12), R0 + (size_t)M * 4096, wave * 64 + lane);
    else if constexpr (PH == 4 || PH == 7 || PH == 9 || PH == 16 || PH == 18) {
        const pg8::bf16_t* A; const pg8::bf16_t* W; int K = 2048; const float* base = X;
        if constexpr (PH == 4) { A = R0 + (size_t)M * 4096; W = (const pg8::bf16_t*)(ws + WS_W_AOUT); base = ka_in(0); }
        else if constexpr (PH == 7 || PH == 16) { A = R0 + (size_t)M * 2048; W = (const pg8::bf16_t*)(ws + WS_W_O + (size_t)layer * 8 * MiB); }
        else { A = R0; W = (const pg8::bf16_t*)(ws + WS_W_DN + (size_t)layer * 32 * MiB); K = 8192; }
        pg8::Gemm g{A, W, M, 2048, K}; pg8::StaticOrder S; S.init(M, 2048, G, bx);
        pg8::EpiRes E{base, X, XB, SSQ};
        pg8::gemm_phase<pg8::EpiRes, pg8::StaticOrder, true, true>(lds, g, S, E, wave, lane);
    } else if constexpr (PH == 5 || PH == 14 || PH == 10) {
        const pg8::bf16_t* W = (PH == 10) ? (const pg8::bf16_t*)(ws + WS_W_BIN) : (const pg8::bf16_t*)(ws + WS_W_Q + (size_t)layer * 8 * MiB);
        pg8::Gemm g{XB, W, M, 2048, 2048}; pg8::StaticOrder S; S.init(M, 2048, G, bx);
        pg8::EpiAct<0, false> E{R0, 2048, nullptr, SSQ, (PH == 14) ? 64 : 32, (PH == 10) ? 1.0f : 0.044194173824159216f * 1.4426950408889634f, nullptr, 0};
        pg8::gemm_phase<pg8::EpiAct<0, false>, pg8::StaticOrder, true, true>(lds, g, S, E, wave, lane);
    } else if constexpr (PH == 6 || PH == 15) attn_simple(lds, R0, (const bf16*)(ws + WS_KB + (size_t)layer * 2 * MiB), (const bf16*)(ws + WS_VB + (size_t)layer * 2 * MiB), R0 + (size_t)M * 2048, wave, lane);
    else if constexpr (PH == 8 || PH == 17) {
        pg8::Gemm g{XB, (const pg8::bf16_t*)(ws + WS_W_UP + (size_t)layer * 32 * MiB), M, FF, 2048}; pg8::StaticOrder S; S.init(M, FF, G, bx);
        pg8::EpiAct<2, false> E{R0, FF, nullptr, SSQ, 32, 1.0f, nullptr, 0};
        pg8::gemm_phase<pg8::EpiAct<2, false>, pg8::StaticOrder, true, true>(lds, g, S, E, wave, lane);
    } else if constexpr (PH == 11) s5_pass_a(R0, (f32x2*)(ws + WS_S5ST), wave, lane);
    else if constexpr (PH == 12) s5_pass_c(lds, R0, (const f32x2*)(ws + WS_S5ST), R0 + (size_t)M * 2048, wave, lane);
    else if constexpr (PH == 13) {
        pg8::Gemm g{R0 + (size_t)M * 2048, (const pg8::bf16_t*)(ws + WS_W_BOUT), M, 4096, 2048}; pg8::StaticOrder S; S.init(M, 4096, G, bx);
        pg8::EpiGlu E{X, X, XB, SSQ, ka_in(24)};
        pg8::gemm_phase<pg8::EpiGlu, pg8::StaticOrder, true, true>(lds, g, S, E, wave, lane);
    } else if constexpr (PH == 19) final_norm(X, ka_in(6), wave, lane);
}
__device__ __forceinline__ int lane_id() { int l; asm volatile("v_mbcnt_lo_u32_b32 %0, -1, 0\n\tv_mbcnt_hi_u32_b32 %0, -1, %0" : "=v"(l)); return l; }

#define XB_TMO      128
#define XB_XCNT(j)  (256  + 64 * (j))
#define XB_XSUB(j)  (1280 + 64 * (j))
#define XB_XGEN(j)  (2304 + 64 * (j))
#define XB_TOP      3328
#define XB_TOPGEN   3392
#define XCD_BAR_WORDS 3456
#define XB_SPIN_CAP (1u << 22)
__device__ __forceinline__ unsigned xb_ld(unsigned* p)              { return __hip_atomic_load(p, __ATOMIC_RELAXED, __HIP_MEMORY_SCOPE_AGENT); }
__device__ __forceinline__ unsigned xb_add(unsigned* p, unsigned v) { return __hip_atomic_fetch_add(p, v, __ATOMIC_RELAXED, __HIP_MEMORY_SCOPE_AGENT); }
__device__ __forceinline__ unsigned xb_xcc_id() { return (unsigned)__builtin_amdgcn_s_getreg((3 << 11) | 20) & 0xFu; }
#define XB_SPIN(cond, bar) do { unsigned _sp = 0; while (cond) { __builtin_amdgcn_s_sleep(1); \
    if ((++_sp & 255u) == 0u) { if (xb_ld(&(bar)[XB_TMO])) break; if (_sp > XB_SPIN_CAP) { atomicAdd(&(bar)[XB_TMO], 1u); break; } } } } while (0)
__device__ __forceinline__ void xcd_barrier_complete(unsigned* bar, unsigned x, unsigned& nloc, unsigned& nx) {
    const unsigned G = gridDim.x * gridDim.y * gridDim.z;
    unsigned sum, cnt, mine, sp = 0u;
    for (;;) {
        sum = 0u; cnt = 0u; mine = 0u;
#pragma unroll
        for (unsigned j = 0; j < 16; ++j) { const unsigned c = xb_ld(&bar[XB_XCNT(j)]); sum += c; cnt += (c > 0u) ? 1u : 0u; mine = (j == x) ? c : mine; }
        if (sum == G) break;
        __builtin_amdgcn_s_sleep(1);
        if ((++sp & 255u) == 0u) { if (xb_ld(&bar[XB_TMO])) break; if (sp > XB_SPIN_CAP) { atomicAdd(&bar[XB_TMO], 1u); break; } }
    }
    nloc = mine > 0u ? mine : 1u; nx = cnt > 0u ? cnt : 1u;
}
__device__ __forceinline__ void xcd_barrier(unsigned* bar, volatile LAS unsigned* st, bool is_t0) {
    asm volatile("s_waitcnt vmcnt(0)" ::: "memory");
    __syncthreads();
    if (is_t0) {
        __builtin_amdgcn_s_waitcnt(0);
        const unsigned x = xb_xcc_id();
        unsigned nloc = st[0], nx = st[1];
        if (nloc == 0u) { xcd_barrier_complete(bar, x, nloc, nx); st[0] = nloc; st[1] = nx; }
        const unsigned old = xb_add(&bar[XB_XSUB(x)], 1u);
        const unsigned gen = old / nloc;
        if (old + 1u == (gen + 1u) * nloc) {
            __builtin_amdgcn_fence(__ATOMIC_RELEASE, "agent");
            asm volatile("s_waitcnt vmcnt(0)" ::: "memory");
            const unsigned og = xb_add(&bar[XB_TOP], 1u);
            const unsigned tg = og / nx;
            if (og + 1u == (tg + 1u) * nx) xb_add(&bar[XB_TOPGEN], 1u);
            else XB_SPIN(xb_ld(&bar[XB_TOPGEN]) == tg, bar);
            __builtin_amdgcn_fence(__ATOMIC_ACQUIRE, "agent");
            xb_add(&bar[XB_XGEN(x)], 1u);
            asm volatile("s_waitcnt vmcnt(0)" ::: "memory");
        } else {
            XB_SPIN(xb_ld(&bar[XB_XGEN(x)]) == gen, bar);
            __builtin_amdgcn_fence(__ATOMIC_ACQUIRE, "agent");
            asm volatile("s_waitcnt vmcnt(0)" ::: "memory");
        }
    }
    __syncthreads();
}

__global__ void __launch_bounds__(NTHREADS, 2) trunk_fwd(Args args) {
    extern __shared__ __attribute__((aligned(16))) unsigned char lds_raw[];
    LAS unsigned char* lds = (LAS unsigned char*)lds_raw;
    const int wave = __builtin_amdgcn_readfirstlane((int)threadIdx.x >> 6);
    const int lo = args.ph_lo, hi = args.ph_hi;
    unsigned* bar = (unsigned*)args.ws + 4096;
    volatile LAS unsigned* st = (volatile LAS unsigned*)(lds + LDS_BYTES - 64);
#if MK_N_LAUNCHES == 1
    { const int l0 = lane_id(); if (wave == 0 && l0 < 2) st[l0] = 0u; __syncthreads(); if (wave == 0 && l0 == 0) (void)xb_add(&bar[XB_XCNT(xb_xcc_id())], 1u); }
#define GRID_BAR(k) do { if ((k) == 1) cg::this_grid().sync(); else xcd_barrier(bar, st, wave == 0 && lane_id() == 0); } while (0)
#else
#define GRID_BAR(k) do { } while (0)
#endif
#define PHASE(k) if (lo <= (k) && (k) < hi) { if ((k) > lo) GRID_BAR(k); run_phase<k>(args.ws, args.out, lds, wave, lane_id()); }
    PHASE(0) PHASE(1) PHASE(2) PHASE(3) PHASE(4) PHASE(5) PHASE(6) PHASE(7) PHASE(8) PHASE(9)
    PHASE(10) PHASE(11) PHASE(12) PHASE(13) PHASE(14) PHASE(15) PHASE(16) PHASE(17) PHASE(18) PHASE(19)
#undef PHASE
}

extern "C" void kernel_launch(void* const* d_in, const int* in_sizes, int n_in, void* d_out, int out_size, void* d_ws, size_t ws_size, hipStream_t stream) {
    static int grid = 0;
    if (grid == 0) {
        if (n_in != 30 || out_size != M * D || ws_size < WS_END) { fprintf(stderr, "kernel_launch: unexpected shapes (n_in %d out %d ws %zu)\n", n_in, out_size, ws_size); grid = -1; return; }
        int dev = 0, cus = 0, per_cu = 0;
        if (hipGetDevice(&dev) != hipSuccess || hipDeviceGetAttribute(&cus, hipDeviceAttributeMultiprocessorCount, dev) != hipSuccess) { grid = -1; return; }
        if (hipFuncSetAttribute((const void*)trunk_fwd, hipFuncAttributeMaxDynamicSharedMemorySize, LDS_BYTES) != hipSuccess) { fprintf(stderr, "kernel_launch: hipFuncSetAttribute failed\n"); grid = -1; return; }
        if (hipOccupancyMaxActiveBlocksPerMultiprocessor(&per_cu, (const void*)trunk_fwd, NTHREADS, LDS_BYTES) != hipSuccess || per_cu < 1) { fprintf(stderr, "kernel_launch: occupancy query says %d\n", per_cu); grid = -1; return; }
        grid = cus;
    }
    if (grid < 0) return;
    if (hipMemsetAsync(d_ws, 0, 65536, stream) != hipSuccess) { fprintf(stderr, "kernel_launch: memset failed\n"); return; }
    Args a{};
    for (int i = 0; i < 30; ++i) a.in[i] = (const float*)d_in[i];
    a.out = (float*)d_out; a.ws = (unsigned char*)d_ws;
#if MK_N_LAUNCHES == 1
    a.ph_lo = 0; a.ph_hi = NPH;
    void* kargs[] = {&a};
    hipError_t e = hipLaunchCooperativeKernel((const void*)trunk_fwd, dim3(grid), dim3(NTHREADS), kargs, LDS_BYTES, stream);
    if (e != hipSuccess) fprintf(stderr, "kernel_launch: cooperative launch failed: %s\n", hipGetErrorString(e));
#else
    for (int ph = 0; ph < NPH; ++ph) { a.ph_lo = ph; a.ph_hi = ph + 1; hipLaunchKernelGGL(trunk_fwd, dim3(grid), dim3(NTHREADS), LDS_BYTES, stream, a); }
#endif
}
```

```cpp
#include <hip/hip_runtime.h>
#include <hip/hip_cooperative_groups.h>
#include <cstdio>
#include <cstdint>
namespace cg = cooperative_groups;
#define MK_N_LAUNCHES 1
namespace pg8 {
#define PG8_LAS __attribute__((address_space(3)))
typedef unsigned short bf16_t;
typedef short bf16x8 __attribute__((ext_vector_type(8)));
typedef float f32x4 __attribute__((ext_vector_type(4)));
typedef unsigned u32x4 __attribute__((ext_vector_type(4)));
constexpr int BM = 256, BK = 64, HALF = 128, HTB = HALF * BK * 2  , STAGE_BYTES = 8 * HTB, NXCD = 8, WGM = 8;

__host__ __device__ __forceinline__ int lds_byte(int r, int c) { const int st = (r >> 4) * 2 + (c >> 5), rr = r & 15, cc = c & 31, ob = rr * 64 + cc * 2; return st * 1024 + (ob ^ (((ob >> 9) & 1) << 5)); }
__host__ __device__ __forceinline__ void stage_rc(int b, int& R, int& C) { const int st = b / 1024, sb = b % 1024, swz = sb ^ (((sb >> 9) & 1) << 5); R = (st >> 1) * 16 + swz / 64; C = (st & 1) * 32 + (swz % 64) / 2; }
__host__ __device__ __forceinline__ int perm32(int rho) { const int n = rho >> 4, i = rho & 15; return 8 * (i >> 2) + 4 * n + (i & 3); }

struct Unit { int pm, pn; };
struct Gemm { const bf16_t* A; const bf16_t* Bt; int M, N, K; };

struct StaticOrder {
    int nM, nN, nwg, G, c;
    __host__ __device__ void init(int M, int N, int G_, int c_) { nM = M / BM; nN = N / BM; nwg = nM * nN; G = G_; c = c_; }
    __host__ __device__ bool next(int i, Unit& u) const {
        const long L = (long)i * G + c; if (L >= nwg) return false;
        int wgid = (int)L; { const int q = nwg / NXCD, r = nwg % NXCD, xcd = wgid % NXCD, off = wgid / NXCD; wgid = (xcd < r ? xcd * (q + 1) : r * (q + 1) + (xcd - r) * q) + off; }
        const int nig = WGM * nN, gid = wgid / nig, fm = gid * WGM, gsz = (nM - fm) < WGM ? (nM - fm) : WGM;
        u.pm = fm + ((wgid % nig) % gsz); u.pn = (wgid % nig) / gsz; return true;
    }
    __device__ __forceinline__ void a_ready(const Unit&) const {}
    __device__ __forceinline__ void done(const Unit&) const {}
};

__device__ __forceinline__ unsigned cvt_pk_bf16(float lo, float hi) { unsigned r; asm volatile("v_cvt_pk_bf16_f32 %0, %1, %2" : "=v"(r) : "v"(lo), "v"(hi)); return r; }
typedef float f32x2 __attribute__((ext_vector_type(2)));
__device__ __forceinline__ f32x2 gelu_pk(f32x2 v) {
    const f32x2 av = __builtin_elementwise_abs(v), d = av * 0.2316418882f + 1.0f;
    f32x2 t; t.x = __builtin_amdgcn_rcpf(d.x); t.y = __builtin_amdgcn_rcpf(d.y);
    f32x2 q = t * 0.5307027145f + (-0.7265760135f); q = q * t + 0.7107068705f; q = q * t + (-0.142248368f); q = q * t + 0.127414796f; q = q * t;
    const f32x2 s = (v * v) * (-0.72134752044f);
    f32x2 e; e.x = __builtin_amdgcn_exp2f(s.x); e.y = __builtin_amdgcn_exp2f(s.y);
    const f32x2 m = v * (q * e), r = v - m;
    f32x2 o; o.x = v.x < 0.f ? m.x : r.x; o.y = v.y < 0.f ? m.y : r.y; return o;
}
typedef unsigned u32x2 __attribute__((ext_vector_type(2)));
constexpr int SSQ_STRIDE = 64;
__device__ __forceinline__ float row_rstd(const float* ssq, int np, int row, int fq) {
    const float* p = ssq + (size_t)row * SSQ_STRIDE + fq * (np >> 2);
    f32x4 a = *(const f32x4*)p, b = *(const f32x4*)(p + 4);
    float s = (a[0] + a[1]) + (a[2] + a[3]) + (b[0] + b[1]) + (b[2] + b[3]);
    if (np == 64) { f32x4 c = *(const f32x4*)(p + 8), d = *(const f32x4*)(p + 12); s += (c[0] + c[1]) + (c[2] + c[3]) + (d[0] + d[1]) + (d[2] + d[3]); }
    s += __shfl_xor(s, 16); s += __shfl_xor(s, 32);
    return __builtin_amdgcn_rsqf(s * (1.0f / 2048.0f) + 1e-6f);
}
template <int ACT, bool STATS> struct EpiAct {
    static constexpr bool PERM = true, AFTER_DRAIN = false;
    bf16_t* O; int ldc; const float* bias; const float* ssq; int np; float oscale; float* vst; int stat_pn0;
    __device__ __forceinline__ void operator()(const f32x4 (&acc)[2][2][4][2], const Unit& u, int wr, int wc, int fr, int fq) const {
        const int row0 = u.pm * BM + wr * 64 + fr, col0 = u.pn * BM + wc * 32 + 8 * fq;
        f32x4 bv[2][2];
#pragma unroll
        for (int bj = 0; bj < 2; ++bj)
#pragma unroll
            for (int n = 0; n < 2; ++n) bv[bj][n] = bias ? *(const f32x4*)(bias + col0 + bj * HALF + 4 * n) : (f32x4){0.f, 0.f, 0.f, 0.f};
        float rsv[2][4];
#pragma unroll
        for (int ai = 0; ai < 2; ++ai) {
#pragma unroll
            for (int m = 0; m < 4; ++m) rsv[ai][m] = row_rstd(ssq, np, row0 + ai * HALF + m * 16, fq);
            asm volatile("" ::: "memory"); }
#pragma unroll
        for (int ai = 0; ai < 2; ++ai)
#pragma unroll
            for (int m = 0; m < 4; ++m) { const int row = row0 + ai * HALF + m * 16; const float rs = rsv[ai][m];
                bf16_t* rowp = O + (size_t)row * ldc + col0; float s1 = 0.f, s2 = 0.f;
#pragma unroll
                for (int bj = 0; bj < 2; ++bj) { f32x4 v0 = acc[ai][bj][m][0] * rs + bv[bj][0], v1 = acc[ai][bj][m][1] * rs + bv[bj][1];
                    if (ACT == 1) { f32x2 a = gelu_pk((f32x2){v0[0], v0[1]}), b = gelu_pk((f32x2){v0[2], v0[3]}), c = gelu_pk((f32x2){v1[0], v1[1]}), d = gelu_pk((f32x2){v1[2], v1[3]});
                        v0 = (f32x4){a.x, a.y, b.x, b.y}; v1 = (f32x4){c.x, c.y, d.x, d.y}; }
                    if (ACT == 2) {
#pragma unroll
                        for (int j = 0; j < 4; ++j) { const float a = fmaxf(v0[j], 0.f), b = fmaxf(v1[j], 0.f); v0[j] = a * a; v1[j] = b * b; } }
                    v0 = v0 * oscale; v1 = v1 * oscale;
                    if (STATS) { s1 += (v0[0] + v0[1]) + (v0[2] + v0[3]) + (v1[0] + v1[1]) + (v1[2] + v1[3]);
                        s2 += (v0[0] * v0[0] + v0[1] * v0[1]) + (v0[2] * v0[2] + v0[3] * v0[3]) + (v1[0] * v1[0] + v1[1] * v1[1]) + (v1[2] * v1[2] + v1[3] * v1[3]); }
                    u32x4 w; w.x = cvt_pk_bf16(v0[0], v0[1]); w.y = cvt_pk_bf16(v0[2], v0[3]); w.z = cvt_pk_bf16(v1[0], v1[1]); w.w = cvt_pk_bf16(v1[2], v1[3]);
                    *(u32x4*)(rowp + bj * HALF) = w; }
                if (STATS) { s1 += __shfl_xor(s1, 16); s1 += __shfl_xor(s1, 32); s2 += __shfl_xor(s2, 16); s2 += __shfl_xor(s2, 32);
                    if (u.pn >= stat_pn0 && fq == 0) *(f32x2*)(vst + (size_t)row * SSQ_STRIDE + ((u.pn - stat_pn0) * 4 + wc) * 2) = (f32x2){s1, s2}; }
            }
    }
};
struct EpiRes {
    static constexpr bool PERM = false, AFTER_DRAIN = false;
    const float* base; float* out; bf16_t* xb; float* ssq;
    __device__ __forceinline__ void operator()(const f32x4 (&acc)[2][2][4][2], const Unit& u, int wr, int wc, int fr, int fq) const {
        const int row0 = u.pm * BM + wr * 64 + fr, col0 = u.pn * BM + wc * 32 + 4 * fq;
#pragma unroll
        for (int ai = 0; ai < 2; ++ai)
#pragma unroll
            for (int m = 0; m < 4; ++m) { const int row = row0 + ai * HALF + m * 16; const size_t off = (size_t)row * 2048 + col0; float ss = 0.f;
#pragma unroll
                for (int bj = 0; bj < 2; ++bj)
#pragma unroll
                    for (int n = 0; n < 2; ++n) { const f32x4 o = *(const f32x4*)(base + off + bj * HALF + n * 16) + acc[ai][bj][m][n];
                        *(f32x4*)(out + off + bj * HALF + n * 16) = o; ss += (o[0] * o[0] + o[1] * o[1]) + (o[2] * o[2] + o[3] * o[3]);
                        u32x2 w; w.x = cvt_pk_bf16(o[0], o[1]); w.y = cvt_pk_bf16(o[2], o[3]); *(u32x2*)(xb + off + bj * HALF + n * 16) = w; }
                ss += __shfl_xor(ss, 16); ss += __shfl_xor(ss, 32);
                if (fq == 0) ssq[(size_t)row * SSQ_STRIDE + u.pn * 4 + wc] = ss;
                asm volatile("" ::: "memory"); }
    }
};
struct EpiGlu {
    static constexpr bool PERM = false, AFTER_DRAIN = false;
    const float* base; float* out; bf16_t* xb; float* ssq; const float* bias;
    __device__ __forceinline__ void operator()(const f32x4 (&acc)[2][2][4][2], const Unit& u, int wr, int wc, int fr, int fq) const {
        const int row0 = u.pm * BM + wr * 64 + fr, col0 = u.pn * 128 + wc * 16 + 4 * fq;
        f32x4 bval[2], bgate[2];
#pragma unroll
        for (int bj = 0; bj < 2; ++bj) { bval[bj] = *(const f32x4*)(bias + col0 + bj * 64); bgate[bj] = *(const f32x4*)(bias + 2048 + col0 + bj * 64); }
#pragma unroll
        for (int ai = 0; ai < 2; ++ai)
#pragma unroll
            for (int m = 0; m < 4; ++m) { const int row = row0 + ai * HALF + m * 16; const size_t off = (size_t)row * 2048 + col0; float ss = 0.f;
#pragma unroll
                for (int bj = 0; bj < 2; ++bj) { const f32x4 val = acc[ai][bj][m][0] + bval[bj], gate = acc[ai][bj][m][1] + bgate[bj]; f32x4 o = *(const f32x4*)(base + off + bj * 64);
#pragma unroll
                    for (int j = 0; j < 4; ++j) { const float sg = __builtin_amdgcn_rcpf(1.0f + __builtin_amdgcn_exp2f(-1.4426950408889634f * gate[j])); o[j] += val[j] * sg; }
                    *(f32x4*)(out + off + bj * 64) = o; ss += (o[0] * o[0] + o[1] * o[1]) + (o[2] * o[2] + o[3] * o[3]);
                    u32x2 w; w.x = cvt_pk_bf16(o[0], o[1]); w.y = cvt_pk_bf16(o[2], o[3]); *(u32x2*)(xb + off + bj * 64) = w; }
                ss += __shfl_xor(ss, 16); ss += __shfl_xor(ss, 32);
                if (fq == 0) ssq[(size_t)row * SSQ_STRIDE + u.pn * 4 + wc] = ss;
                asm volatile("" ::: "memory"); }
    }
};
__host__ __device__ __forceinline__ int vt_pos(int key) { const int s = key >> 5, w = key & 31; return 32 * s + 8 * ((w & 15) >> 2) + (w & 3) + 4 * (w >> 4); }
struct EpiKV {
    static constexpr bool PERM = true, AFTER_DRAIN = false;
    bf16_t* Kb; bf16_t* Vb; bf16_t* VTb; const float* ssq;
    __device__ __forceinline__ void operator()(const f32x4 (&acc)[2][2][4][2], const Unit& u, int wr, int wc, int fr, int fq) const {
        const int row0 = u.pm * BM + wr * 64 + fr, col0 = u.pn * BM + wc * 32 + 8 * fq;
#pragma unroll
        for (int ai = 0; ai < 2; ++ai)
#pragma unroll
            for (int m = 0; m < 4; ++m) { const int row = row0 + ai * HALF + m * 16; const float rs = row_rstd(ssq, 32, row, fq); const int b = row >> 8, key = row & 255;
#pragma unroll
                for (int bj = 0; bj < 2; ++bj) { const f32x4 v0 = acc[ai][bj][m][0] * rs, v1 = acc[ai][bj][m][1] * rs; const int col = col0 + bj * HALF;
                    u32x4 w; w.x = cvt_pk_bf16(v0[0], v0[1]); w.y = cvt_pk_bf16(v0[2], v0[3]); w.z = cvt_pk_bf16(v1[0], v1[1]); w.w = cvt_pk_bf16(v1[2], v1[3]);
                    if (col < 2048) { const int h = col >> 9, d = col & 511; *(u32x4*)(Kb + ((size_t)((b * 4 + h) * 256 + key)) * 512 + d) = w; }
                    else { const int c2 = col - 2048, h = c2 >> 9, d = c2 & 511; *(u32x4*)(Vb + ((size_t)((b * 4 + h) * 256 + key)) * 512 + d) = w;
                        bf16_t* vt = VTb + ((size_t)((b * 4 + h) * 512 + d)) * 256 + vt_pos(key);
                        vt[0 * 256] = (bf16_t)(w.x & 0xffffu); vt[1 * 256] = (bf16_t)(w.x >> 16); vt[2 * 256] = (bf16_t)(w.y & 0xffffu); vt[3 * 256] = (bf16_t)(w.y >> 16);
                        vt[4 * 256] = (bf16_t)(w.z & 0xffffu); vt[5 * 256] = (bf16_t)(w.z >> 16); vt[6 * 256] = (bf16_t)(w.w & 0xffffu); vt[7 * 256] = (bf16_t)(w.w >> 16); } }
            }
    }
};
template <class Epi, class Sched, bool ALIGN_EPI = false, bool SP2 = false>
__device__ __forceinline__ void gemm_phase(PG8_LAS unsigned char* lds, const Gemm g, const Sched& S, const Epi& E, const int wid  , const int lane) {
    const int tid = wid * 64 + lane, wr = wid >> 2, wc = wid & 3, fr = lane & 15, fq = lane >> 4;
    const int K = g.K, nt = K / BK;
    unsigned voffA[2], voffB[2];
#pragma unroll
    for (int i = 0; i < 2; ++i) { int R, C; stage_rc(tid * 16 + i * 8192, R, C); const int Rb = Epi::PERM ? ((R & ~31) + perm32(R & 31)) : R;
        voffA[i] = (unsigned)(R * K + C) * 2u; voffB[i] = (unsigned)(Rb * K + C) * 2u; }
    const size_t kstep = (size_t)(BK * 2);
    const size_t hstep = (size_t)HALF * K * 2;
    const size_t tstep = 2 * hstep;
    const unsigned ldsw = (unsigned)wid * 1024u;
    const int aoff = lds_byte(wr * 64 + fr, fq * 8), boff = lds_byte(wc * 32 + fr, fq * 8);
#define PG8_SA(b, h) (((b) * 2 + (h)) * HTB)
#define PG8_SB(b, h) ((4 + (b) * 2 + (h)) * HTB)
#define PG8_STAGE(bufoff, gbase, voff) do { _Pragma("unroll") for (int _i = 0; _i < 2; ++_i) \
        __builtin_amdgcn_global_load_lds((const unsigned*)((const char*)(gbase) + (voff)[_i]), (PG8_LAS unsigned*)(lds + (bufoff) + ldsw + _i * 8192), 16, 0, 0); } while (0)
#define PG8_LDA(dst, b, h) do { _Pragma("unroll") for (int m = 0; m < 4; ++m) _Pragma("unroll") for (int k = 0; k < 2; ++k) dst[m][k] = *(const PG8_LAS bf16x8*)(lds + PG8_SA(b, h) + aoff + m * 2048 + k * 1024); } while (0)
#define PG8_LDB(dst, b, h) do { _Pragma("unroll") for (int n = 0; n < 2; ++n) _Pragma("unroll") for (int k = 0; k < 2; ++k) dst[n][k] = *(const PG8_LAS bf16x8*)(lds + PG8_SB(b, h) + boff + n * 2048 + k * 1024); } while (0)
#define PG8_MMA(ai, bj, At, Bt) do { __builtin_amdgcn_s_setprio(1); _Pragma("unroll") for (int m = 0; m < 4; ++m) _Pragma("unroll") for (int n = 0; n < 2; ++n) _Pragma("unroll") for (int k = 0; k < 2; ++k) \
        acc[ai][bj][m][n] = __builtin_amdgcn_mfma_f32_16x16x32_bf16(Bt[n][k], At[m][k], acc[ai][bj][m][n], 0, 0, 0); __builtin_amdgcn_s_setprio(0); } while (0)
#define PG8_WAIT_V(n) asm volatile("s_waitcnt vmcnt(" #n ")" ::: "memory")
#define PG8_WAIT_L(n) asm volatile("s_waitcnt lgkmcnt(" #n ")" ::: "memory")
#define PG8_BAR __builtin_amdgcn_s_barrier()
#define PG8_SCHED __builtin_amdgcn_sched_barrier(0)
    Unit cur, nxt; int ui = 0;
    if (!S.next(0, cur)) return;
    f32x4 acc[2][2][4][2];
#pragma unroll
    for (int a = 0; a < 2; ++a)
#pragma unroll
        for (int b = 0; b < 2; ++b)
#pragma unroll
            for (int m = 0; m < 4; ++m)
#pragma unroll
                for (int n = 0; n < 2; ++n) acc[a][b][m][n] = (f32x4){0.f, 0.f, 0.f, 0.f};
    bf16x8 At[4][2], B0[2][2], B1[2][2];
    const char* cA = (const char*)g.A + (size_t)cur.pm * tstep; const char* cB = (const char*)g.Bt + (size_t)cur.pn * tstep;
    S.a_ready(cur);
    if constexpr (SP2) {
        PG8_STAGE(PG8_SB(0, 0), cB, voffB); PG8_STAGE(PG8_SB(0, 1), cB + hstep, voffB); PG8_STAGE(PG8_SA(0, 0), cA, voffA); PG8_STAGE(PG8_SA(0, 1), cA + hstep, voffA);
        if (wr == 1) PG8_BAR;
        PG8_WAIT_V(2); PG8_BAR;
        PG8_STAGE(PG8_SB(1, 0), cB + kstep, voffB); PG8_STAGE(PG8_SA(1, 0), cA + kstep, voffA); PG8_STAGE(PG8_SB(1, 1), cB + hstep + kstep, voffB);
        PG8_WAIT_V(6); PG8_BAR;
    } else {
        PG8_STAGE(PG8_SB(0, 0), cB, voffB); PG8_STAGE(PG8_SA(0, 0), cA, voffA); PG8_STAGE(PG8_SB(0, 1), cB + hstep, voffB); PG8_STAGE(PG8_SA(0, 1), cA + hstep, voffA);
        if (wr == 1) PG8_BAR;
        PG8_WAIT_V(4); PG8_BAR;
        PG8_STAGE(PG8_SB(1, 0), cB + kstep, voffB); PG8_STAGE(PG8_SA(1, 0), cA + kstep, voffA); PG8_STAGE(PG8_SB(1, 1), cB + hstep + kstep, voffB);
        PG8_WAIT_V(6); PG8_BAR;
    }
    for (;;) {
        const bool has_next = S.next(ui + 1, nxt);
        const char* nA = has_next ? (const char*)g.A + (size_t)nxt.pm * tstep : cA; const char* nB = has_next ? (const char*)g.Bt + (size_t)nxt.pn * tstep : cB;
        for (int t = 0; t < nt; t += 2) {
            const bool last = (t == nt - 2);
            const char* a1 = cA + (size_t)(t + 1) * kstep;
            const char* a2 = last ? nA : cA + (size_t)(t + 2) * kstep; const char* b2 = last ? nB : cB + (size_t)(t + 2) * kstep;
            const char* a3 = a2 + kstep; const char* b3 = b2 + kstep;
            if (last && has_next) S.a_ready(nxt);
            if constexpr (SP2) {
            PG8_LDB(B0, 0, 0); PG8_LDB(B1, 0, 1); PG8_SCHED; PG8_LDA(At, 0, 0); PG8_STAGE(PG8_SA(1, 1), a1 + hstep, voffA);
            PG8_WAIT_V(8); PG8_WAIT_L(0); PG8_BAR; PG8_MMA(0, 0, At, B0); PG8_MMA(0, 1, At, B1); PG8_BAR; PG8_SCHED;
            PG8_LDA(At, 0, 1); PG8_STAGE(PG8_SB(0, 0), b2, voffB); PG8_STAGE(PG8_SB(0, 1), b2 + hstep, voffB); PG8_STAGE(PG8_SA(0, 0), a2, voffA);
            PG8_WAIT_V(8); PG8_WAIT_L(0); PG8_BAR; PG8_MMA(1, 0, At, B0); PG8_MMA(1, 1, At, B1); PG8_BAR; PG8_SCHED;
            PG8_LDB(B0, 1, 0); PG8_LDB(B1, 1, 1); PG8_SCHED; PG8_LDA(At, 1, 0); PG8_STAGE(PG8_SA(0, 1), a2 + hstep, voffA);
            PG8_WAIT_V(8); PG8_WAIT_L(0); PG8_BAR; PG8_MMA(0, 0, At, B0); PG8_MMA(0, 1, At, B1); PG8_BAR; PG8_SCHED;
            PG8_LDA(At, 1, 1); PG8_STAGE(PG8_SB(1, 0), b3, voffB); PG8_STAGE(PG8_SB(1, 1), b3 + hstep, voffB); PG8_STAGE(PG8_SA(1, 0), a3, voffA);
            PG8_WAIT_V(8); PG8_WAIT_L(0); PG8_BAR; PG8_MMA(1, 0, At, B0); PG8_MMA(1, 1, At, B1); PG8_BAR; PG8_SCHED;
            } else {
            PG8_LDB(B0, 0, 0); PG8_SCHED; PG8_LDA(At, 0, 0); PG8_STAGE(PG8_SA(1, 1), a1 + hstep, voffA);
            PG8_WAIT_L(8); PG8_BAR; PG8_WAIT_L(0); PG8_MMA(0, 0, At, B0); PG8_BAR; PG8_SCHED;
            PG8_LDB(B1, 0, 1); PG8_STAGE(PG8_SB(0, 0), b2, voffB);
            PG8_BAR; PG8_WAIT_L(0); PG8_MMA(0, 1, At, B1); PG8_BAR;
            PG8_LDA(At, 0, 1); PG8_STAGE(PG8_SA(0, 0), a2, voffA);
            PG8_BAR; PG8_WAIT_L(0); PG8_MMA(1, 0, At, B0); PG8_BAR; PG8_SCHED;
            PG8_STAGE(PG8_SB(0, 1), b2 + hstep, voffB);
            PG8_WAIT_V(6); PG8_BAR; PG8_MMA(1, 1, At, B1); PG8_BAR;
            PG8_LDB(B0, 1, 0); PG8_SCHED; PG8_LDA(At, 1, 0); PG8_STAGE(PG8_SA(0, 1), a2 + hstep, voffA);
            PG8_WAIT_L(8); PG8_BAR; PG8_WAIT_L(0); PG8_MMA(0, 0, At, B0); PG8_BAR; PG8_SCHED;
            PG8_LDB(B1, 1, 1); PG8_STAGE(PG8_SB(1, 0), b3, voffB);
            PG8_BAR; PG8_WAIT_L(0); PG8_MMA(0, 1, At, B1); PG8_BAR;
            PG8_LDA(At, 1, 1); PG8_STAGE(PG8_SA(1, 0), a3, voffA);
            PG8_BAR; PG8_WAIT_L(0); PG8_MMA(1, 0, At, B0); PG8_BAR; PG8_SCHED;
            PG8_STAGE(PG8_SB(1, 1), b3 + hstep, voffB);
            PG8_WAIT_V(6); PG8_BAR; PG8_MMA(1, 1, At, B1); PG8_BAR;
            }
        }
        if constexpr (ALIGN_EPI) { if (wr == 0) PG8_BAR; }
        if constexpr (!Epi::AFTER_DRAIN) { Unit ue = cur; asm volatile("" : "+s"(ue.pm), "+s"(ue.pn));
            E(acc, ue, wr, wc, fr, fq); S.done(cur); }
        if (!has_next) break;
#pragma unroll
        for (int a = 0; a < 2; ++a)
#pragma unroll
            for (int b = 0; b < 2; ++b)
#pragma unroll
                for (int m = 0; m < 4; ++m)
#pragma unroll
                    for (int n = 0; n < 2; ++n) acc[a][b][m][n] = (f32x4){0.f, 0.f, 0.f, 0.f};
        cur = nxt; cA = nA; cB = nB; ++ui;
        if constexpr (ALIGN_EPI) { if (wr == 1) PG8_BAR; }
    }
    PG8_WAIT_V(0);
    if constexpr (!ALIGN_EPI) { if (wr == 0) PG8_BAR; }
    PG8_BAR;
    if constexpr (Epi::AFTER_DRAIN) { E.fused(acc, cur, wr, wc, fr, fq, lds, wid, lane); S.done(cur); }
#undef PG8_SA
#undef PG8_SB
#undef PG8_STAGE
#undef PG8_LDA
#undef PG8_LDB
#undef PG8_MMA
#undef PG8_WAIT_V
#undef PG8_WAIT_L
#undef PG8_BAR
#undef PG8_SCHED
}
}
#ifndef MK_N_LAUNCHES
#define MK_N_LAUNCHES 1
#endif
constexpr int BATCH = 2, SEQ = 4096, D = 2048, M = BATCH * SEQ, MEMLEN = 256, MROWS = BATCH * MEMLEN, FF = 8192;
constexpr int NWAVES = 8, NTHREADS = 512, NPH = 20;
constexpr int LDS_BYTES = 147456;
constexpr size_t MiB = 1u << 20;
constexpr size_t WS_W_AIN = 2 * MiB, WS_W_AOUT = 18 * MiB, WS_W_BIN = 26 * MiB, WS_W_BOUT = 34 * MiB, WS_W_Q = 50 * MiB, WS_W_KV = 66 * MiB, WS_W_O = 98 * MiB, WS_W_UP = 114 * MiB, WS_W_DN = 178 * MiB;
constexpr size_t WS_XB = 242 * MiB, WS_MEMB = 274 * MiB, WS_KB = 276 * MiB, WS_VB = 280 * MiB, WS_VTB = 284 * MiB, WS_SSQ = 288 * MiB, WS_VST = 290 * MiB, WS_SSQM = 292 * MiB, WS_S5ST = 294 * MiB;
constexpr size_t WS_R = 304 * MiB, WS_END = 432 * MiB;
#define GAS __attribute__((address_space(1)))
#define LAS __attribute__((address_space(3)))
typedef unsigned short bf16;
typedef unsigned v4u __attribute__((ext_vector_type(4)));
typedef unsigned v2u __attribute__((ext_vector_type(2)));
typedef float f32x4 __attribute__((ext_vector_type(4)));
typedef float f32x2 __attribute__((ext_vector_type(2)));
#define LDS_WAIT() asm volatile("s_waitcnt lgkmcnt(0)" ::: "memory")
__device__ __forceinline__ unsigned f2bf(float f) { unsigned u = __builtin_bit_cast(unsigned, f); return (u + 0x7fffu + ((u >> 16) & 1u)) >> 16; }
__device__ __forceinline__ unsigned pk2(float lo, float hi) { return f2bf(lo) | (f2bf(hi) << 16); }
__device__ __forceinline__ float bflo(unsigned w) { return __builtin_bit_cast(float, w << 16); }
__device__ __forceinline__ float bfhi(unsigned w) { return __builtin_bit_cast(float, w & 0xffff0000u); }
__device__ __forceinline__ float wave_sum(float v) {
#pragma unroll
    for (int o = 1; o < 64; o <<= 1) v += __shfl_xor(v, o);
    return v;
}
__device__ __forceinline__ float wave_max(float v) {
#pragma unroll
    for (int o = 1; o < 64; o <<= 1) v = fmaxf(v, __shfl_xor(v, o));
    return v;
}
__device__ __forceinline__ float gelu_exact(float v) { return 0.5f * v * (1.0f + erff(v * 0.70710678118654752f)); }

struct Args { const float* in[30]; float* out; unsigned char* ws; int ph_lo, ph_hi; };
__device__ __forceinline__ const float* ka_in(int i) { const __attribute__((address_space(4))) char* ka = (const __attribute__((address_space(4))) char*)__builtin_amdgcn_kernarg_segment_ptr(); asm volatile("" : "+s"(ka)); return *(const float* const __attribute__((address_space(4)))*)(ka + 8 * i); }

__device__ __forceinline__ int glu_rowmap(int n) { return n < 2048 ? 32 * (n >> 4) + (n & 15) : 32 * ((n - 2048) >> 4) + 16 + (n & 15); }
__device__ __forceinline__ void conv_item(const float* W, int K, int N, const float* gk, int mode, bf16* WT, LAS float* scr, int item, int lane) {
    const int nblk = N >> 6, kb = item / nblk, nb = item - kb * nblk, k0 = 64 * kb, n0 = 64 * nb;
    f32x4 v[16];
#pragma unroll
    for (int i = 0; i < 16; ++i) { const int kk = 4 * i + (lane >> 4); v[i] = *(const f32x4*)(W + (size_t)(k0 + kk) * N + n0 + 4 * (lane & 15)); }
#pragma unroll
    for (int i = 0; i < 16; ++i) { const int kk = 4 * i + (lane >> 4); const float s = gk ? gk[k0 + kk] : 1.0f; LAS float* d = scr + kk * 65 + 4 * (lane & 15);
        d[0] = v[i][0] * s; d[1] = v[i][1] * s; d[2] = v[i][2] * s; d[3] = v[i][3] * s; }
    LDS_WAIT();
    const int c = lane & 7;
#pragma unroll
    for (int j = 0; j < 8; ++j) { const int n = (lane >> 3) + 8 * j; const LAS float* s = scr + (8 * c) * 65 + n;
        v4u o; o.x = pk2(s[0 * 65], s[1 * 65]); o.y = pk2(s[2 * 65], s[3 * 65]); o.z = pk2(s[4 * 65], s[5 * 65]); o.w = pk2(s[6 * 65], s[7 * 65]);
        const int nr = mode ? glu_rowmap(n0 + n) : (n0 + n);
        *(v4u*)(WT + (size_t)nr * K + k0 + 8 * c) = o; }
    LDS_WAIT();
}
__device__ __forceinline__ void row_to_bf16(const float* xrow, bf16* orow, float* ssqrow, int lane) {
    f32x4 v[8]; float s = 0.f;
#pragma unroll
    for (int j = 0; j < 8; ++j) { v[j] = ((const f32x4*)xrow)[lane + 64 * j]; s += (v[j][0] * v[j][0] + v[j][1] * v[j][1]) + (v[j][2] * v[j][2] + v[j][3] * v[j][3]); }
    s = wave_sum(s);
#pragma unroll
    for (int j = 0; j < 8; ++j) { v2u w; w.x = pk2(v[j][0], v[j][1]); w.y = pk2(v[j][2], v[j][3]); ((v2u*)orow)[lane + 64 * j] = w; }
    if (lane < 32) ssqrow[lane] = (lane == 0) ? s : 0.f;
}
__device__ __forceinline__ void p0_prologue(unsigned char* ws, LAS unsigned char* lds, int wave, int lane) {
    LAS float* scr = (LAS float*)(lds + wave * 16640);
    const int gw = blockIdx.x * NWAVES + wave, NGW = gridDim.x * NWAVES;
    constexpr int NITEMS = 30720;
    for (int it0 = gw; it0 < NITEMS; it0 += NGW) {
        int r = __builtin_amdgcn_readfirstlane(it0);
        const float* W; const float* g = nullptr; bf16* WT; int K = 2048, N = 2048, mode = 0;
        if (r < 2048) { W = ka_in(7); g = ka_in(2); WT = (bf16*)(ws + WS_W_AIN); N = 4096; }
        else if ((r -= 2048) < 1024) { W = ka_in(13); WT = (bf16*)(ws + WS_W_AOUT); }
        else if ((r -= 1024) < 1024) { W = ka_in(14); g = ka_in(2) + 2048; WT = (bf16*)(ws + WS_W_BIN); }
        else if ((r -= 1024) < 2048) { W = ka_in(23); WT = (bf16*)(ws + WS_W_BOUT); N = 4096; mode = 1; }
        else if ((r -= 2048) < 2048) { const int i = r >> 10; r &= 1023; W = ka_in(25) + (size_t)i * 2048 * 2048; g = ka_in(3) + i * 2048; WT = (bf16*)(ws + WS_W_Q + i * 8 * MiB); }
        else if ((r -= 2048) < 4096) { const int i = r >> 11; r &= 2047; W = ka_in(26) + (size_t)i * 2048 * 4096; g = ka_in(4) + i * 2048; WT = (bf16*)(ws + WS_W_KV + i * 16 * MiB); N = 4096; }
        else if ((r -= 4096) < 2048) { const int i = r >> 10; r &= 1023; W = ka_in(27) + (size_t)i * 2048 * 2048; WT = (bf16*)(ws + WS_W_O + i * 8 * MiB); }
        else if ((r -= 2048) < 8192) { const int i = r >> 12; r &= 4095; W = ka_in(28) + (size_t)i * 2048 * 8192; g = ka_in(5) + i * 2048; WT = (bf16*)(ws + WS_W_UP + i * 32 * MiB); N = 8192; }
        else { r -= 8192; const int i = r >> 12; r &= 4095; W = ka_in(29) + (size_t)i * 8192 * 2048; WT = (bf16*)(ws + WS_W_DN + i * 32 * MiB); K = 8192; }
        conv_item(W, K, N, g, mode, WT, scr, r, lane);
    }
    for (int m = gw; m < M + MROWS; m += NGW) {
        if (m < M) row_to_bf16(ka_in(0) + (size_t)m * D, (bf16*)(ws + WS_XB) + (size_t)m * D, (float*)(ws + WS_SSQ) + (size_t)m * 64, lane);
        else { const int r = m - M; row_to_bf16(ka_in(1) + (size_t)r * D, (bf16*)(ws + WS_MEMB) + (size_t)r * D, (float*)(ws + WS_SSQM) + (size_t)r * 64, lane); }
    }
}
__device__ __forceinline__ void final_norm(float* x, const float* g, int wave, int lane) {
    const int gw = blockIdx.x * NWAVES + wave, NGW = gridDim.x * NWAVES;
    for (int m = gw; m < M; m += NGW) { f32x4* xr = (f32x4*)(x + (size_t)m * D); f32x4 v[8]; float s = 0.f;
#pragma unroll
        for (int j = 0; j < 8; ++j) { v[j] = xr[lane + 64 * j]; s += (v[j][0] * v[j][0] + v[j][1] * v[j][1]) + (v[j][2] * v[j][2] + v[j][3] * v[j][3]); }
        const float rs = 1.0f / sqrtf(wave_sum(s) * (1.0f / D) + 1e-6f);
#pragma unroll
        for (int j = 0; j < 8; ++j) { const f32x4 gv = ((const f32x4*)g)[lane + 64 * j]; xr[lane + 64 * j] = v[j] * rs * gv; } }
}
__device__ __forceinline__ void gating_simple(LAS unsigned char* lds, const bf16* z, const float* vst, const float* ln_g, const float* ln_b, const float* w_s, const float* b_s, bf16* gbuf, int tid) {
    LAS float* vln = (LAS float*)lds;
    LAS float* Wl = (LAS float*)(lds + 65536);
    LAS float* mu = (LAS float*)(lds + 65536 + 128 * 129 * 4);
    LAS float* rsd = mu + 128;
    for (int unit = blockIdx.x; unit < 1024; unit += gridDim.x) {
        const int h = unit & 15, tok0 = (unit >> 4) * 128;
        if (tid < 128) { const float* p = vst + (size_t)(tok0 + tid) * 64; float s1 = 0.f, s2 = 0.f;
#pragma unroll 8
            for (int i = 0; i < 32; ++i) { s1 += p[2 * i]; s2 += p[2 * i + 1]; }
            const float mean = s1 * (1.0f / 2048.0f), var = s2 * (1.0f / 2048.0f) - mean * mean; mu[tid] = mean; rsd[tid] = 1.0f / sqrtf(var + 1e-6f); }
        __syncthreads();
        { const int s = tid >> 2, db = (tid & 3) * 32; const float mean = mu[s], rs = rsd[s];
            const bf16* vp = z + (size_t)(tok0 + s) * 4096 + 2048 + h * 128 + db;
#pragma unroll
            for (int q = 0; q < 4; ++q) { const v4u w = *(const v4u*)(vp + 8 * q); const float* gp = ln_g + h * 128 + db + 8 * q; const float* bp = ln_b + h * 128 + db + 8 * q; LAS float* o = vln + s * 128 + db + 8 * q;
                o[0] = (bflo(w.x) - mean) * rs * gp[0] + bp[0]; o[1] = (bfhi(w.x) - mean) * rs * gp[1] + bp[1]; o[2] = (bflo(w.y) - mean) * rs * gp[2] + bp[2]; o[3] = (bfhi(w.y) - mean) * rs * gp[3] + bp[3];
                o[4] = (bflo(w.z) - mean) * rs * gp[4] + bp[4]; o[5] = (bfhi(w.z) - mean) * rs * gp[5] + bp[5]; o[6] = (bflo(w.w) - mean) * rs * gp[6] + bp[6]; o[7] = (bfhi(w.w) - mean) * rs * gp[7] + bp[7]; }
            const float* wp = w_s + ((size_t)h * 128 + s) * 128 + db;
#pragma unroll
            for (int q = 0; q < 8; ++q) { const f32x4 w4 = *(const f32x4*)(wp + 4 * q); LAS float* o = Wl + s * 129 + db + 4 * q; o[0] = w4[0]; o[1] = w4[1]; o[2] = w4[2]; o[3] = w4[3]; } }
        __syncthreads();
        { const int t = tid >> 2, d0 = (tid & 3) * 32, tmax = t | 15; float acc[32];
#pragma unroll
            for (int j = 0; j < 32; ++j) acc[j] = 0.f;
            for (int s = 0; s <= tmax; ++s) { const float w = (s <= t) ? Wl[t * 129 + s] : 0.f; const LAS f32x4* vr = (const LAS f32x4*)(vln + s * 128 + d0);
#pragma unroll
                for (int q = 0; q < 8; ++q) { const f32x4 vv = vr[q]; acc[4 * q] += w * vv[0]; acc[4 * q + 1] += w * vv[1]; acc[4 * q + 2] += w * vv[2]; acc[4 * q + 3] += w * vv[3]; } }
            const float bs = b_s[h * 128 + t];
            const bf16* up = z + (size_t)(tok0 + t) * 4096 + h * 128 + d0; bf16* op = gbuf + (size_t)(tok0 + t) * 2048 + h * 128 + d0;
#pragma unroll
            for (int q = 0; q < 4; ++q) { const v4u w = *(const v4u*)(up + 8 * q); v4u o;
                o.x = pk2(bflo(w.x) * (acc[8 * q] + bs), bfhi(w.x) * (acc[8 * q + 1] + bs)); o.y = pk2(bflo(w.y) * (acc[8 * q + 2] + bs), bfhi(w.y) * (acc[8 * q + 3] + bs));
                o.z = pk2(bflo(w.z) * (acc[8 * q + 4] + bs), bfhi(w.z) * (acc[8 * q + 5] + bs)); o.w = pk2(bflo(w.w) * (acc[8 * q + 6] + bs), bfhi(w.w) * (acc[8 * q + 7] + bs));
                *(v4u*)(op + 8 * q) = o; } }
        __syncthreads();
    }
}
__device__ __forceinline__ void attn_simple(LAS unsigned char* lds, const bf16* q, const bf16* Kb, const bf16* Vb, bf16* obuf, int wave, int lane) {
    LAS float* pl = (LAS float*)(lds + wave * 1024);
    const int gw = blockIdx.x * NWAVES + wave, NGW = gridDim.x * NWAVES;
    for (int task = gw; task < BATCH * 4 * SEQ; task += NGW) {
        const int bh = task >> 12, t = task & 4095, b = bh >> 2, h = bh & 3;
        float qf[8]; { const v4u w = *(const v4u*)(q + ((size_t)(b * SEQ + t)) * 2048 + h * 512 + 8 * lane);
            qf[0] = bflo(w.x); qf[1] = bfhi(w.x); qf[2] = bflo(w.y); qf[3] = bfhi(w.y); qf[4] = bflo(w.z); qf[5] = bfhi(w.z); qf[6] = bflo(w.w); qf[7] = bfhi(w.w); }
        const bf16* kp = Kb + (size_t)bh * 256 * 512 + 8 * lane;
        float sc[4];
#pragma unroll
        for (int kk = 0; kk < 4; ++kk) { float mine = 0.f;
            for (int l2 = 0; l2 < 64; ++l2) { const v4u w = *(const v4u*)(kp + (size_t)(kk * 64 + l2) * 512);
                float dsum = qf[0] * bflo(w.x) + qf[1] * bfhi(w.x) + qf[2] * bflo(w.y) + qf[3] * bfhi(w.y) + qf[4] * bflo(w.z) + qf[5] * bfhi(w.z) + qf[6] * bflo(w.w) + qf[7] * bfhi(w.w);
                dsum = wave_sum(dsum); if (lane == l2) mine = dsum; }
            sc[kk] = mine; }
        const float mx = wave_max(fmaxf(fmaxf(sc[0], sc[1]), fmaxf(sc[2], sc[3])));
        float p[4], ps = 0.f;
#pragma unroll
        for (int kk = 0; kk < 4; ++kk) { p[kk] = exp2f(sc[kk] - mx); ps += p[kk]; pl[kk * 64 + lane] = p[kk]; }
        const float inv = 1.0f / wave_sum(ps);
        LDS_WAIT();
        float o[8];
#pragma unroll
        for (int i = 0; i < 8; ++i) o[i] = 0.f;
        const bf16* vp = Vb + (size_t)bh * 256 * 512 + 8 * lane;
        for (int key = 0; key < 256; ++key) { const float pk = pl[key]; const v4u w = *(const v4u*)(vp + (size_t)key * 512);
            o[0] += pk * bflo(w.x); o[1] += pk * bfhi(w.x); o[2] += pk * bflo(w.y); o[3] += pk * bfhi(w.y); o[4] += pk * bflo(w.z); o[5] += pk * bfhi(w.z); o[6] += pk * bflo(w.w); o[7] += pk * bfhi(w.w); }
        v4u ow; ow.x = pk2(o[0] * inv, o[1] * inv); ow.y = pk2(o[2] * inv, o[3] * inv); ow.z = pk2(o[4] * inv, o[5] * inv); ow.w = pk2(o[6] * inv, o[7] * inv);
        *(v4u*)(obuf + ((size_t)(b * SEQ + t)) * 2048 + h * 512 + 8 * lane) = ow;
        LDS_WAIT();
    }
}
typedef short bf16x8 __attribute__((ext_vector_type(8)));
__device__ __forceinline__ void attn_mfma(LAS unsigned char* lds, const bf16* q, const bf16* Kb, const bf16* VTb, bf16* obuf, int wave, int lane) {
    const int tid = wave * 64 + lane, fr = lane & 15, fq = lane >> 4;
    unsigned voffK[2], voffV[2];
#pragma unroll
    for (int i = 0; i < 2; ++i) { int R, C; pg8::stage_rc(tid * 16 + i * 8192, R, C); voffK[i] = (unsigned)(R * 512 + C) * 2u; voffV[i] = (unsigned)(R * 256 + C) * 2u; }
    const unsigned ldsw = (unsigned)wave * 1024u;
    const int aoff0 = pg8::lds_byte(fr, fq * 8);
#define AT_STAGE_K(c, buf) do { _Pragma("unroll") for (int ht = 0; ht < 4; ++ht) { const char* src = Kg + ((size_t)(128 * (ht >> 1)) * 512 + 128 * (c) + 64 * (ht & 1)) * 2; \
        _Pragma("unroll") for (int i = 0; i < 2; ++i) __builtin_amdgcn_global_load_lds((const unsigned*)(src + voffK[i]), (LAS unsigned*)(lds + (buf) * 65536 + ht * 16384 + ldsw + i * 8192), 16, 0, 0); } } while (0)
#define AT_STAGE_V(cc, buf) do { _Pragma("unroll") for (int ht = 0; ht < 4; ++ht) { const char* src = Vg + ((size_t)(128 * ht) * 256 + 64 * (cc)) * 2; \
        _Pragma("unroll") for (int i = 0; i < 2; ++i) __builtin_amdgcn_global_load_lds((const unsigned*)(src + voffV[i]), (LAS unsigned*)(lds + (buf) * 65536 + ht * 16384 + ldsw + i * 8192), 16, 0, 0); } } while (0)
#define AT_WAIT() do { asm volatile("s_waitcnt vmcnt(0)" ::: "memory"); __syncthreads(); } while (0)
    for (int unit = blockIdx.x; unit < 256; unit += gridDim.x) {
        const int bh = unit >> 5, qb = unit & 31, b = bh >> 2, h = bh & 3;
        const char* Kg = (const char*)(Kb + (size_t)bh * 256 * 512);
        const char* Vg = (const char*)(VTb + (size_t)bh * 512 * 256);
        const size_t tok = (size_t)(b * SEQ + qb * 128 + 16 * wave + fr);
        bf16x8 qf[16];
        { const bf16* qp = q + tok * 2048 + h * 512 + 8 * fq;
#pragma unroll
            for (int s = 0; s < 16; ++s) qf[s] = *(const bf16x8*)(qp + 32 * s); }
        f32x4 acc[16];
#pragma unroll
        for (int n = 0; n < 16; ++n) acc[n] = (f32x4){0.f, 0.f, 0.f, 0.f};
        AT_STAGE_K(0, 0);
#pragma unroll
        for (int c = 0; c < 4; ++c) {
            AT_WAIT();
            if (c < 3) AT_STAGE_K(c + 1, (c + 1) & 1); else AT_STAGE_V(0, 0);
            const LAS unsigned char* bb = lds + (c & 1) * 65536 + aoff0; asm volatile("" : "+v"(bb));
#pragma unroll
            for (int kh = 0; kh < 2; ++kh)
#pragma unroll
                for (int k = 0; k < 2; ++k)
#pragma unroll
                    for (int ng = 0; ng < 2; ++ng) { bf16x8 a[8];
#pragma unroll
                        for (int n8 = 0; n8 < 8; ++n8) a[n8] = *(const LAS bf16x8*)(bb + (ng * 2 + kh) * 16384 + n8 * 2048 + k * 1024);
#pragma unroll
                        for (int n8 = 0; n8 < 8; ++n8) acc[ng * 8 + n8] = __builtin_amdgcn_mfma_f32_16x16x32_bf16(a[n8], qf[4 * c + 2 * kh + k], acc[ng * 8 + n8], 0, 0, 0);
                        __builtin_amdgcn_sched_barrier(0); }
        }
        float mx = acc[0][0];
#pragma unroll
        for (int n = 0; n < 16; ++n) mx = fmaxf(fmaxf(mx, fmaxf(acc[n][0], acc[n][1])), fmaxf(acc[n][2], acc[n][3]));
        mx = fmaxf(mx, __shfl_xor(mx, 16)); mx = fmaxf(mx, __shfl_xor(mx, 32));
        float l = 0.f;
#pragma unroll
        for (int n = 0; n < 16; ++n)
#pragma unroll
            for (int r = 0; r < 4; ++r) { const float pv = __builtin_amdgcn_exp2f(acc[n][r] - mx); acc[n][r] = pv; l += pv; }
        l += __shfl_xor(l, 16); l += __shfl_xor(l, 32);
        const float linv = 1.0f / l;
        bf16x8 pf[8];
#pragma unroll
        for (int s = 0; s < 8; ++s) { v4u w; w.x = pg8::cvt_pk_bf16(acc[2 * s][0], acc[2 * s][1]); w.y = pg8::cvt_pk_bf16(acc[2 * s][2], acc[2 * s][3]);
            w.z = pg8::cvt_pk_bf16(acc[2 * s + 1][0], acc[2 * s + 1][1]); w.w = pg8::cvt_pk_bf16(acc[2 * s + 1][2], acc[2 * s + 1][3]); pf[s] = __builtin_bit_cast(bf16x8, w); }
        __builtin_amdgcn_sched_barrier(0);
        f32x4 o[32];
#pragma unroll
        for (int mm = 0; mm < 32; ++mm) o[mm] = (f32x4){0.f, 0.f, 0.f, 0.f};
#pragma unroll
        for (int cc = 0; cc < 4; ++cc) {
            AT_WAIT();
            if (cc < 3) AT_STAGE_V(cc + 1, (cc + 1) & 1);
            const LAS unsigned char* bb = lds + (cc & 1) * 65536 + aoff0; asm volatile("" : "+v"(bb));
#pragma unroll
            for (int k = 0; k < 2; ++k)
#pragma unroll
                for (int mg = 0; mg < 4; ++mg) { bf16x8 a[8];
#pragma unroll
                    for (int m8 = 0; m8 < 8; ++m8) a[m8] = *(const LAS bf16x8*)(bb + mg * 16384 + m8 * 2048 + k * 1024);
#pragma unroll
                    for (int m8 = 0; m8 < 8; ++m8) o[mg * 8 + m8] = __builtin_amdgcn_mfma_f32_16x16x32_bf16(a[m8], pf[2 * cc + k], o[mg * 8 + m8], 0, 0, 0);
                    __builtin_amdgcn_sched_barrier(0); }
        }
        bf16* op = obuf + tok * 2048 + h * 512 + 4 * fq;
#pragma unroll
        for (int mm = 0; mm < 32; ++mm) { v2u w; w.x = pg8::cvt_pk_bf16(o[mm][0] * linv, o[mm][1] * linv); w.y = pg8::cvt_pk_bf16(o[mm][2] * linv, o[mm][3] * linv); *(v2u*)(op + 16 * mm) = w; }
    }
    asm volatile("s_waitcnt vmcnt(0)" ::: "memory"); __syncthreads();
#undef AT_STAGE_K
#undef AT_STAGE_V
#undef AT_WAIT
}
struct S5Lane { float lbr, lbi; float Br[16], Bi[16]; };
__device__ __forceinline__ void s5_lane_params(int g, int p, S5Lane& L) {
    const float lr = fminf(ka_in(15)[g * 64 + p], -1e-4f), li = ka_in(16)[g * 64 + p], dt = expf(ka_in(17)[g]);
    const float ar = lr * dt, th = li * dt; float sn, cs; sincosf(th, &sn, &cs); const float e = expf(ar), sh = sinf(0.5f * th);
    L.lbr = e * cs; L.lbi = e * sn;
    const float nr = expm1f(ar) * cs - 2.0f * sh * sh, ni = e * sn;
    const float den = 1.0f / (lr * lr + li * li), cr = (nr * lr + ni * li) * den, ci = (ni * lr - nr * li) * den;
#pragma unroll
    for (int c = 0; c < 16; ++c) { const float br = ka_in(18)[(size_t)(g * 64 + p) * 16 + c], bi = ka_in(19)[(size_t)(g * 64 + p) * 16 + c]; L.Br[c] = cr * br - ci * bi; L.Bi[c] = cr * bi + ci * br; }
}
__device__ __forceinline__ void s5_step(const S5Lane& L, const bf16* urow, float& xr, float& xi) {
    const v4u w0 = *(const v4u*)urow, w1 = *(const v4u*)(urow + 8);
    float u[16] = {bflo(w0.x), bfhi(w0.x), bflo(w0.y), bfhi(w0.y), bflo(w0.z), bfhi(w0.z), bflo(w0.w), bfhi(w0.w), bflo(w1.x), bfhi(w1.x), bflo(w1.y), bfhi(w1.y), bflo(w1.z), bfhi(w1.z), bflo(w1.w), bfhi(w1.w)};
    float br = 0.f, bi = 0.f;
#pragma unroll
    for (int c = 0; c < 16; ++c) { br += L.Br[c] * u[c]; bi += L.Bi[c] * u[c]; }
    const float nr = L.lbr * xr - L.lbi * xi + br, ni = L.lbr * xi + L.lbi * xr + bi; xr = nr; xi = ni;
}
__device__ __forceinline__ void s5_pass_a(const bf16* ub, f32x2* st, int wave, int lane) {
    const int gw = blockIdx.x * NWAVES + wave, NGW = gridDim.x * NWAVES;
    for (int task = gw; task < BATCH * 128 * 64; task += NGW) {
        const int seg = task & 63, g = (task >> 6) & 127, b = task >> 13;
        S5Lane L; s5_lane_params(g, lane, L);
        float xr = 0.f, xi = 0.f; const bf16* up = ub + (size_t)(b * SEQ + seg * 64) * 2048 + 16 * g;
#pragma unroll 2
        for (int s = 0; s < 64; ++s) s5_step(L, up + (size_t)s * 2048, xr, xi);
        st[(size_t)task * 64 + lane] = (f32x2){xr, xi};
    }
}
__device__ __forceinline__ void s5_pass_c(LAS unsigned char* lds, const bf16* ub, const f32x2* st, bf16* yb, int wave, int lane) {
    LAS f32x2* Cs = (LAS f32x2*)(lds + wave * 16640);
    LAS f32x2* xs = (LAS f32x2*)(lds + wave * 16640 + 8320);
    const int gw = blockIdx.x * NWAVES + wave, NGW = gridDim.x * NWAVES;
    for (int task = gw; task < BATCH * 128 * 64; task += NGW) {
        const int seg = task & 63, g = (task >> 6) & 127, b = task >> 13;
        S5Lane L; s5_lane_params(g, lane, L);
#pragma unroll
        for (int c = 0; c < 16; ++c) Cs[c * 65 + lane] = (f32x2){ka_in(20)[(size_t)(g * 16 + c) * 64 + lane], ka_in(21)[(size_t)(g * 16 + c) * 64 + lane]};
        float Ar = L.lbr, Ai = L.lbi;
#pragma unroll
        for (int i = 0; i < 6; ++i) { const float nr = Ar * Ar - Ai * Ai, ni = 2.0f * Ar * Ai; Ar = nr; Ai = ni; }
        float xr = 0.f, xi = 0.f; const f32x2* sp = st + (size_t)(task - seg) * 64 + lane;
#pragma unroll 2
        for (int n = 0; n < seg; ++n) { const f32x2 s = sp[(size_t)n * 64]; const float nr = Ar * xr - Ai * xi + s.x, ni = Ar * xi + Ai * xr + s.y; xr = nr; xi = ni; }
        const bf16* up = ub + (size_t)(b * SEQ + seg * 64) * 2048 + 16 * g; bf16* yp = yb + (size_t)(b * SEQ + seg * 64) * 2048 + 16 * g;
        const int t = lane & 15, cq = lane >> 4;
        f32x4 dsk = *(const f32x4*)(ka_in(22) + g * 16 + 4 * cq);
#pragma unroll 1
        for (int blk = 0; blk < 4; ++blk) {
#pragma unroll 2
            for (int s = 0; s < 16; ++s) { s5_step(L, up + (size_t)(blk * 16 + s) * 2048, xr, xi); xs[s * 65 + lane] = (f32x2){xr, xi}; }
            LDS_WAIT();
            float acc[4] = {0.f, 0.f, 0.f, 0.f};
#pragma unroll 4
            for (int p = 0; p < 64; ++p) { const f32x2 x = xs[t * 65 + p];
#pragma unroll
                for (int j = 0; j < 4; ++j) { const f32x2 c = Cs[(4 * cq + j) * 65 + p]; acc[j] += c.x * x.x - c.y * x.y; } }
            const v2u uw = *(const v2u*)(up + (size_t)(blk * 16 + t) * 2048 + 4 * cq);
            const float y0 = gelu_exact(acc[0] + dsk[0] * bflo(uw.x)), y1 = gelu_exact(acc[1] + dsk[1] * bfhi(uw.x)), y2 = gelu_exact(acc[2] + dsk[2] * bflo(uw.y)), y3 = gelu_exact(acc[3] + dsk[3] * bfhi(uw.y));
            v2u ow; ow.x = pk2(y0, y1); ow.y = pk2(y2, y3); *(v2u*)(yp + (size_t)(blk * 16 + t) * 2048 + 4 * cq) = ow;
            LDS_WAIT();
        }
    }
}
#ifndef EN
#define EN(k) 1
#endif
template <int PH> __device__ __forceinline__ void run_phase(unsigned char* ws, float* X, LAS unsigned char* lds, int wave, int lane) {
    const int G = gridDim.x, bx = blockIdx.x;
    bf16* XB = (bf16*)(ws + WS_XB); float* SSQ = (float*)(ws + WS_SSQ);
    bf16* R0 = (bf16*)(ws + WS_R);
    constexpr int layer = (PH >= 10) ? 1 : 0;
    if constexpr (!EN(PH)) { return; }
    else if constexpr (PH == 0) p0_prologue(ws, lds, wave, lane);
    else if constexpr (PH == 1) {
        if (bx < 64) { const int i = bx >> 5;
            pg8::Gemm g{(const pg8::bf16_t*)(ws + WS_MEMB), (const pg8::bf16_t*)(ws + WS_W_KV + (size_t)i * 16 * MiB), MROWS, 4096, 2048}; pg8::StaticOrder S; S.init(MROWS, 4096, 32, bx & 31);
            pg8::EpiKV E{(pg8::bf16_t*)(ws + WS_KB + (size_t)i * 2 * MiB), (pg8::bf16_t*)(ws + WS_VB + (size_t)i * 2 * MiB), (pg8::bf16_t*)(ws + WS_VTB + (size_t)i * 2 * MiB), (const float*)(ws + WS_SSQM)};
            pg8::gemm_phase<pg8::EpiKV, pg8::StaticOrder, true, true>(lds, g, S, E, wave, lane); }
    } else if constexpr (PH == 2) {
        pg8::Gemm g{XB, (const pg8::bf16_t*)(ws + WS_W_AIN), M, 4096, 2048}; pg8::StaticOrder S; S.init(M, 4096, G, bx);
        pg8::EpiAct<1, true> E{R0, 4096, ka_in(8), SSQ, 32, 1.0f, (float*)(ws + WS_VST), 8};
        pg8::gemm_phase<pg8::EpiAct<1, true>, pg8::StaticOrder, true, true>(lds, g, S, E, wave, lane);
    } else if constexpr (PH == 3) gating_simple(lds, R0, (const float*)(ws + WS_VST), ka_in(9), ka_in(10), ka_in(11), ka_in(12), R0 + (size_t)M * 4096, wave * 64 + lane);
    else if constexpr (PH == 4 || PH == 7 || PH == 9 || PH == 16 || PH == 18) {
        const pg8::bf16_t* A; const pg8::bf16_t* W; int K = 2048; const float* base = X;
        if constexpr (PH == 4) { A = R0 + (size_t)M * 4096; W = (const pg8::bf16_t*)(ws + WS_W_AOUT); base = ka_in(0); }
        else if constexpr (PH == 7 || PH == 16) { A = R0 + (size_t)M * 2048; W = (const pg8::bf16_t*)(ws + WS_W_O + (size_t)layer * 8 * MiB); }
        else { A = R0; W = (const pg8::bf16_t*)(ws + WS_W_DN + (size_t)layer * 32 * MiB); K = 8192; }
        pg8::Gemm g{A, W, M, 2048, K}; pg8::StaticOrder S; S.init(M, 2048, G, bx);
        pg8::EpiRes E{base, X, XB, SSQ};
        pg8::gemm_phase<pg8::EpiRes, pg8::StaticOrder, true, true>(lds, g, S, E, wave, lane);
    } else if constexpr (PH == 5 || PH == 14 || PH == 10) {
        const pg8::bf16_t* W = (PH == 10) ? (const pg8::bf16_t*)(ws + WS_W_BIN) : (const pg8::bf16_t*)(ws + WS_W_Q + (size_t)layer * 8 * MiB);
        pg8::Gemm g{XB, W, M, 2048, 2048}; pg8::StaticOrder S; S.init(M, 2048, G, bx);
        pg8::EpiAct<0, false> E{R0, 2048, nullptr, SSQ, (PH == 14) ? 64 : 32, (PH == 10) ? 1.0f : 0.044194173824159216f * 1.4426950408889634f, nullptr, 0};
        pg8::gemm_phase<pg8::EpiAct<0, false>, pg8::StaticOrder, true, true>(lds, g, S, E, wave, lane);
    } else if constexpr (PH == 6 || PH == 15) {
#if defined(ATTN_SIMPLE)
        attn_simple(lds, R0, (const bf16*)(ws + WS_KB + (size_t)layer * 2 * MiB), (const bf16*)(ws + WS_VB + (size_t)layer * 2 * MiB), R0 + (size_t)M * 2048, wave, lane);
#else
        attn_mfma(lds, R0, (const bf16*)(ws + WS_KB + (size_t)layer * 2 * MiB), (const bf16*)(ws + WS_VTB + (size_t)layer * 2 * MiB), R0 + (size_t)M * 2048, wave, lane);
#endif
    }
    else if constexpr (PH == 8 || PH == 17) {
        pg8::Gemm g{XB, (const pg8::bf16_t*)(ws + WS_W_UP + (size_t)layer * 32 * MiB), M, FF, 2048}; pg8::StaticOrder S; S.init(M, FF, G, bx);
        pg8::EpiAct<2, false> E{R0, FF, nullptr, SSQ, 32, 1.0f, nullptr, 0};
        pg8::gemm_phase<pg8::EpiAct<2, false>, pg8::StaticOrder, true, true>(lds, g, S, E, wave, lane);
    } else if constexpr (PH == 11) s5_pass_a(R0, (f32x2*)(ws + WS_S5ST), wave, lane);
    else if constexpr (PH == 12) s5_pass_c(lds, R0, (const f32x2*)(ws + WS_S5ST), R0 + (size_t)M * 2048, wave, lane);
    else if constexpr (PH == 13) {
        pg8::Gemm g{R0 + (size_t)M * 2048, (const pg8::bf16_t*)(ws + WS_W_BOUT), M, 4096, 2048}; pg8::StaticOrder S; S.init(M, 4096, G, bx);
        pg8::EpiGlu E{X, X, XB, SSQ, ka_in(24)};
        pg8::gemm_phase<pg8::EpiGlu, pg8::StaticOrder, true, true>(lds, g, S, E, wave, lane);
    } else if constexpr (PH == 19) final_norm(X, ka_in(6), wave, lane);
}
__device__ __forceinline__ int lane_id() { int l; asm volatile("v_mbcnt_lo_u32_b32 %0, -1, 0\n\tv_mbcnt_hi_u32_b32 %0, -1, %0" : "=v"(l)); return l; }

#define XB_TMO      128
#define XB_XCNT(j)  (256  + 64 * (j))
#define XB_XSUB(j)  (1280 + 64 * (j))
#define XB_XGEN(j)  (2304 + 64 * (j))
#define XB_TOP      3328
#define XB_TOPGEN   3392
#define XCD_BAR_WORDS 3456
#define XB_SPIN_CAP (1u << 22)
__device__ __forceinline__ unsigned xb_ld(unsigned* p)              { return __hip_atomic_load(p, __ATOMIC_RELAXED, __HIP_MEMORY_SCOPE_AGENT); }
__device__ __forceinline__ unsigned xb_add(unsigned* p, unsigned v) { return __hip_atomic_fetch_add(p, v, __ATOMIC_RELAXED, __HIP_MEMORY_SCOPE_AGENT); }
__device__ __forceinline__ unsigned xb_xcc_id() { return (unsigned)__builtin_amdgcn_s_getreg((3 << 11) | 20) & 0xFu; }
#define XB_SPIN(cond, bar) do { unsigned _sp = 0; while (cond) { __builtin_amdgcn_s_sleep(1); \
    if ((++_sp & 255u) == 0u) { if (xb_ld(&(bar)[XB_TMO])) break; if (_sp > XB_SPIN_CAP) { atomicAdd(&(bar)[XB_TMO], 1u); break; } } } } while (0)
__device__ __forceinline__ void xcd_barrier_complete(unsigned* bar, unsigned x, unsigned& nloc, unsigned& nx) {
    const unsigned G = gridDim.x * gridDim.y * gridDim.z;
    unsigned sum, cnt, mine, sp = 0u;
    for (;;) {
        sum = 0u; cnt = 0u; mine = 0u;
#pragma unroll
        for (unsigned j = 0; j < 16; ++j) { const unsigned c = xb_ld(&bar[XB_XCNT(j)]); sum += c; cnt += (c > 0u) ? 1u : 0u; mine = (j == x) ? c : mine; }
        if (sum == G) break;
        __builtin_amdgcn_s_sleep(1);
        if ((++sp & 255u) == 0u) { if (xb_ld(&bar[XB_TMO])) break; if (sp > XB_SPIN_CAP) { atomicAdd(&bar[XB_TMO], 1u); break; } }
    }
    nloc = mine > 0u ? mine : 1u; nx = cnt > 0u ? cnt : 1u;
}
__device__ __forceinline__ void xcd_barrier(unsigned* bar, volatile LAS unsigned* st, bool is_t0) {
    asm volatile("s_waitcnt vmcnt(0)" ::: "memory");
    __syncthreads();
    if (is_t0) {
        __builtin_amdgcn_s_waitcnt(0);
        const unsigned x = xb_xcc_id();
        unsigned nloc = st[0], nx = st[1];
        if (nloc == 0u) { xcd_barrier_complete(bar, x, nloc, nx); st[0] = nloc; st[1] = nx; }
        const unsigned old = xb_add(&bar[XB_XSUB(x)], 1u);
        const unsigned gen = old / nloc;
        if (old + 1u == (gen + 1u) * nloc) {
            __builtin_amdgcn_fence(__ATOMIC_RELEASE, "agent");
            asm volatile("s_waitcnt vmcnt(0)" ::: "memory");
            const unsigned og = xb_add(&bar[XB_TOP], 1u);
            const unsigned tg = og / nx;
            if (og + 1u == (tg + 1u) * nx) xb_add(&bar[XB_TOPGEN], 1u);
            else XB_SPIN(xb_ld(&bar[XB_TOPGEN]) == tg, bar);
            __builtin_amdgcn_fence(__ATOMIC_ACQUIRE, "agent");
            xb_add(&bar[XB_XGEN(x)], 1u);
            asm volatile("s_waitcnt vmcnt(0)" ::: "memory");
        } else {
            XB_SPIN(xb_ld(&bar[XB_XGEN(x)]) == gen, bar);
            __builtin_amdgcn_fence(__ATOMIC_ACQUIRE, "agent");
            asm volatile("s_waitcnt vmcnt(0)" ::: "memory");
        }
    }
    __syncthreads();
}

__global__ void __launch_bounds__(NTHREADS, 2) trunk_fwd(Args args) {
    extern __shared__ __attribute__((aligned(16))) unsigned char lds_raw[];
    LAS unsigned char* lds = (LAS unsigned char*)lds_raw;
    const int wave = __builtin_amdgcn_readfirstlane((int)threadIdx.x >> 6);
    const int lo = args.ph_lo, hi = args.ph_hi;
    unsigned* bar = (unsigned*)args.ws + 4096;
    volatile LAS unsigned* st = (volatile LAS unsigned*)(lds + LDS_BYTES - 64);
#if MK_N_LAUNCHES == 1
    { const int l0 = lane_id(); if (wave == 0 && l0 < 2) st[l0] = 0u; __syncthreads(); if (wave == 0 && l0 == 0) (void)xb_add(&bar[XB_XCNT(xb_xcc_id())], 1u); }
#define GRID_BAR(k) do { if ((k) == 1) cg::this_grid().sync(); else xcd_barrier(bar, st, wave == 0 && lane_id() == 0); } while (0)
#else
#define GRID_BAR(k) do { } while (0)
#endif
#ifndef DUP_PH
#define DUP_PH -1
#endif
#define PHASE(k) if (lo <= (k) && (k) < hi) { if ((k) > lo) GRID_BAR(k); run_phase<k>(args.ws, args.out, lds, wave, lane_id()); if ((k) == DUP_PH) { GRID_BAR(2); run_phase<k>(args.ws, args.out, lds, wave, lane_id()); } }
    PHASE(0) PHASE(1) PHASE(2) PHASE(3) PHASE(4) PHASE(5) PHASE(6) PHASE(7) PHASE(8) PHASE(9)
    PHASE(10) PHASE(11) PHASE(12) PHASE(13) PHASE(14) PHASE(15) PHASE(16) PHASE(17) PHASE(18) PHASE(19)
#undef PHASE
}

extern "C" void kernel_launch(void* const* d_in, const int* in_sizes, int n_in, void* d_out, int out_size, void* d_ws, size_t ws_size, hipStream_t stream) {
    static int grid = 0;
    if (grid == 0) {
        if (n_in != 30 || out_size != M * D || ws_size < WS_END) { fprintf(stderr, "kernel_launch: unexpected shapes (n_in %d out %d ws %zu)\n", n_in, out_size, ws_size); grid = -1; return; }
        int dev = 0, cus = 0, per_cu = 0;
        if (hipGetDevice(&dev) != hipSuccess || hipDeviceGetAttribute(&cus, hipDeviceAttributeMultiprocessorCount, dev) != hipSuccess) { grid = -1; return; }
        if (hipFuncSetAttribute((const void*)trunk_fwd, hipFuncAttributeMaxDynamicSharedMemorySize, LDS_BYTES) != hipSuccess) { fprintf(stderr, "kernel_launch: hipFuncSetAttribute failed\n"); grid = -1; return; }
        if (hipOccupancyMaxActiveBlocksPerMultiprocessor(&per_cu, (const void*)trunk_fwd, NTHREADS, LDS_BYTES) != hipSuccess || per_cu < 1) { fprintf(stderr, "kernel_launch: occupancy query says %d\n", per_cu); grid = -1; return; }
        grid = cus;
    }
    if (grid < 0) return;
    if (hipMemsetAsync(d_ws, 0, 65536, stream) != hipSuccess) { fprintf(stderr, "kernel_launch: memset failed\n"); return; }
    Args a{};
    for (int i = 0; i < 30; ++i) a.in[i] = (const float*)d_in[i];
    a.out = (float*)d_out; a.ws = (unsigned char*)d_ws;
#if MK_N_LAUNCHES == 1
    a.ph_lo = 0; a.ph_hi = NPH;
    void* kargs[] = {&a};
    hipError_t e = hipLaunchCooperativeKernel((const void*)trunk_fwd, dim3(grid), dim3(NTHREADS), kargs, LDS_BYTES, stream);
    if (e != hipSuccess) fprintf(stderr, "kernel_launch: cooperative launch failed: %s\n", hipGetErrorString(e));
#else
    for (int ph = 0; ph < NPH; ++ph) { a.ph_lo = ph; a.ph_hi = ph + 1; hipLaunchKernelGGL(trunk_fwd, dim3(grid), dim3(NTHREADS), LDS_BYTES, stream, a); }
#endif
}
```

```cpp
#include <hip/hip_runtime.h>
#include <hip/hip_cooperative_groups.h>
#include <cstdio>
#include <cstdint>
namespace cg = cooperative_groups;
#define MK_N_LAUNCHES 1
namespace pg8 {
#define PG8_LAS __attribute__((address_space(3)))
typedef unsigned short bf16_t;
typedef short bf16x8 __attribute__((ext_vector_type(8)));
typedef float f32x4 __attribute__((ext_vector_type(4)));
typedef unsigned u32x4 __attribute__((ext_vector_type(4)));
constexpr int BM = 256, BK = 64, HALF = 128, HTB = HALF * BK * 2  , STAGE_BYTES = 8 * HTB, NXCD = 8, WGM = 8;

__host__ __device__ __forceinline__ int lds_byte(int r, int c) { const int st = (r >> 4) * 2 + (c >> 5), rr = r & 15, cc = c & 31, ob = rr * 64 + cc * 2; return st * 1024 + (ob ^ (((ob >> 9) & 1) << 5)); }
__host__ __device__ __forceinline__ void stage_rc(int b, int& R, int& C) { const int st = b / 1024, sb = b % 1024, swz = sb ^ (((sb >> 9) & 1) << 5); R = (st >> 1) * 16 + swz / 64; C = (st & 1) * 32 + (swz % 64) / 2; }
__host__ __device__ __forceinline__ int perm32(int rho) { const int n = rho >> 4, i = rho & 15; return 8 * (i >> 2) + 4 * n + (i & 3); }

struct Unit { int pm, pn; };
struct Gemm { const bf16_t* A; const bf16_t* Bt; int M, N, K; };

struct StaticOrder {
    int nM, nN, nwg, G, c;
    __host__ __device__ void init(int M, int N, int G_, int c_) { nM = M / BM; nN = N / BM; nwg = nM * nN; G = G_; c = c_; }
    __host__ __device__ bool next(int i, Unit& u) const {
        const long L = (long)i * G + c; if (L >= nwg) return false;
        int wgid = (int)L; { const int q = nwg / NXCD, r = nwg % NXCD, xcd = wgid % NXCD, off = wgid / NXCD; wgid = (xcd < r ? xcd * (q + 1) : r * (q + 1) + (xcd - r) * q) + off; }
        const int nig = WGM * nN, gid = wgid / nig, fm = gid * WGM, gsz = (nM - fm) < WGM ? (nM - fm) : WGM;
        u.pm = fm + ((wgid % nig) % gsz); u.pn = (wgid % nig) / gsz; return true;
    }
    __device__ __forceinline__ void a_ready(const Unit&) const {}
    __device__ __forceinline__ void done(const Unit&) const {}
};

__device__ __forceinline__ unsigned cvt_pk_bf16(float lo, float hi) { unsigned r; asm volatile("v_cvt_pk_bf16_f32 %0, %1, %2" : "=v"(r) : "v"(lo), "v"(hi)); return r; }
typedef float f32x2 __attribute__((ext_vector_type(2)));
__device__ __forceinline__ f32x2 gelu_pk(f32x2 v) {
    const f32x2 av = __builtin_elementwise_abs(v), d = av * 0.2316418882f + 1.0f;
    f32x2 t; t.x = __builtin_amdgcn_rcpf(d.x); t.y = __builtin_amdgcn_rcpf(d.y);
    f32x2 q = t * 0.5307027145f + (-0.7265760135f); q = q * t + 0.7107068705f; q = q * t + (-0.142248368f); q = q * t + 0.127414796f; q = q * t;
    const f32x2 s = (v * v) * (-0.72134752044f);
    f32x2 e; e.x = __builtin_amdgcn_exp2f(s.x); e.y = __builtin_amdgcn_exp2f(s.y);
    const f32x2 m = v * (q * e), r = v - m;
    f32x2 o; o.x = v.x < 0.f ? m.x : r.x; o.y = v.y < 0.f ? m.y : r.y; return o;
}
typedef unsigned u32x2 __attribute__((ext_vector_type(2)));
constexpr int SSQ_STRIDE = 64;
__device__ __forceinline__ float row_rstd(const float* ssq, int np, int row, int fq) {
    const float* p = ssq + (size_t)row * SSQ_STRIDE + fq * (np >> 2);
    f32x4 a = *(const f32x4*)p, b = *(const f32x4*)(p + 4);
    float s = (a[0] + a[1]) + (a[2] + a[3]) + (b[0] + b[1]) + (b[2] + b[3]);
    if (np == 64) { f32x4 c = *(const f32x4*)(p + 8), d = *(const f32x4*)(p + 12); s += (c[0] + c[1]) + (c[2] + c[3]) + (d[0] + d[1]) + (d[2] + d[3]); }
    s += __shfl_xor(s, 16); s += __shfl_xor(s, 32);
    return __builtin_amdgcn_rsqf(s * (1.0f / 2048.0f) + 1e-6f);
}
template <int ACT, bool STATS> struct EpiAct {
    static constexpr bool PERM = true, AFTER_DRAIN = false;
    bf16_t* O; int ldc; const float* bias; const float* ssq; int np; float oscale; float* vst; int stat_pn0;
    __device__ __forceinline__ void operator()(const f32x4 (&acc)[2][2][4][2], const Unit& u, int wr, int wc, int fr, int fq) const {
        const int row0 = u.pm * BM + wr * 64 + fr, col0 = u.pn * BM + wc * 32 + 8 * fq;
        f32x4 bv[2][2];
#pragma unroll
        for (int bj = 0; bj < 2; ++bj)
#pragma unroll
            for (int n = 0; n < 2; ++n) bv[bj][n] = bias ? *(const f32x4*)(bias + col0 + bj * HALF + 4 * n) : (f32x4){0.f, 0.f, 0.f, 0.f};
        float rsv[2][4];
#pragma unroll
        for (int ai = 0; ai < 2; ++ai) {
#pragma unroll
            for (int m = 0; m < 4; ++m) rsv[ai][m] = row_rstd(ssq, np, row0 + ai * HALF + m * 16, fq);
            asm volatile("" ::: "memory"); }
#pragma unroll
        for (int ai = 0; ai < 2; ++ai)
#pragma unroll
            for (int m = 0; m < 4; ++m) { const int row = row0 + ai * HALF + m * 16; const float rs = rsv[ai][m];
                bf16_t* rowp = O + (size_t)row * ldc + col0; float s1 = 0.f, s2 = 0.f;
#pragma unroll
                for (int bj = 0; bj < 2; ++bj) { f32x4 v0 = acc[ai][bj][m][0] * rs + bv[bj][0], v1 = acc[ai][bj][m][1] * rs + bv[bj][1];
                    if (ACT == 1) { f32x2 a = gelu_pk((f32x2){v0[0], v0[1]}), b = gelu_pk((f32x2){v0[2], v0[3]}), c = gelu_pk((f32x2){v1[0], v1[1]}), d = gelu_pk((f32x2){v1[2], v1[3]});
                        v0 = (f32x4){a.x, a.y, b.x, b.y}; v1 = (f32x4){c.x, c.y, d.x, d.y}; }
                    if (ACT == 2) {
#pragma unroll
                        for (int j = 0; j < 4; ++j) { const float a = fmaxf(v0[j], 0.f), b = fmaxf(v1[j], 0.f); v0[j] = a * a; v1[j] = b * b; } }
                    v0 = v0 * oscale; v1 = v1 * oscale;
                    if (STATS) { s1 += (v0[0] + v0[1]) + (v0[2] + v0[3]) + (v1[0] + v1[1]) + (v1[2] + v1[3]);
                        s2 += (v0[0] * v0[0] + v0[1] * v0[1]) + (v0[2] * v0[2] + v0[3] * v0[3]) + (v1[0] * v1[0] + v1[1] * v1[1]) + (v1[2] * v1[2] + v1[3] * v1[3]); }
                    u32x4 w; w.x = cvt_pk_bf16(v0[0], v0[1]); w.y = cvt_pk_bf16(v0[2], v0[3]); w.z = cvt_pk_bf16(v1[0], v1[1]); w.w = cvt_pk_bf16(v1[2], v1[3]);
                    *(u32x4*)(rowp + bj * HALF) = w; }
                if (STATS) { s1 += __shfl_xor(s1, 16); s1 += __shfl_xor(s1, 32); s2 += __shfl_xor(s2, 16); s2 += __shfl_xor(s2, 32);
                    if (u.pn >= stat_pn0 && fq == 0) *(f32x2*)(vst + (size_t)row * SSQ_STRIDE + ((u.pn - stat_pn0) * 4 + wc) * 2) = (f32x2){s1, s2}; }
            }
    }
};
struct EpiRes {
    static constexpr bool PERM = false, AFTER_DRAIN = false;
    const float* base; float* out; bf16_t* xb; float* ssq;
    __device__ __forceinline__ void operator()(const f32x4 (&acc)[2][2][4][2], const Unit& u, int wr, int wc, int fr, int fq) const {
        const int row0 = u.pm * BM + wr * 64 + fr, col0 = u.pn * BM + wc * 32 + 4 * fq;
#pragma unroll
        for (int ai = 0; ai < 2; ++ai)
#pragma unroll
            for (int m = 0; m < 4; ++m) { const int row = row0 + ai * HALF + m * 16; const size_t off = (size_t)row * 2048 + col0; float ss = 0.f;
#pragma unroll
                for (int bj = 0; bj < 2; ++bj)
#pragma unroll
                    for (int n = 0; n < 2; ++n) { const f32x4 o = *(const f32x4*)(base + off + bj * HALF + n * 16) + acc[ai][bj][m][n];
                        *(f32x4*)(out + off + bj * HALF + n * 16) = o; ss += (o[0] * o[0] + o[1] * o[1]) + (o[2] * o[2] + o[3] * o[3]);
                        u32x2 w; w.x = cvt_pk_bf16(o[0], o[1]); w.y = cvt_pk_bf16(o[2], o[3]); *(u32x2*)(xb + off + bj * HALF + n * 16) = w; }
                ss += __shfl_xor(ss, 16); ss += __shfl_xor(ss, 32);
                if (fq == 0) ssq[(size_t)row * SSQ_STRIDE + u.pn * 4 + wc] = ss;
                asm volatile("" ::: "memory"); }
    }
};
struct EpiGlu {
    static constexpr bool PERM = false, AFTER_DRAIN = false;
    const float* base; float* out; bf16_t* xb; float* ssq; const float* bias;
    __device__ __forceinline__ void operator()(const f32x4 (&acc)[2][2][4][2], const Unit& u, int wr, int wc, int fr, int fq) const {
        const int row0 = u.pm * BM + wr * 64 + fr, col0 = u.pn * 128 + wc * 16 + 4 * fq;
        f32x4 bval[2], bgate[2];
#pragma unroll
        for (int bj = 0; bj < 2; ++bj) { bval[bj] = *(const f32x4*)(bias + col0 + bj * 64); bgate[bj] = *(const f32x4*)(bias + 2048 + col0 + bj * 64); }
#pragma unroll
        for (int ai = 0; ai < 2; ++ai)
#pragma unroll
            for (int m = 0; m < 4; ++m) { const int row = row0 + ai * HALF + m * 16; const size_t off = (size_t)row * 2048 + col0; float ss = 0.f;
#pragma unroll
                for (int bj = 0; bj < 2; ++bj) { const f32x4 val = acc[ai][bj][m][0] + bval[bj], gate = acc[ai][bj][m][1] + bgate[bj]; f32x4 o = *(const f32x4*)(base + off + bj * 64);
#pragma unroll
                    for (int j = 0; j < 4; ++j) { const float sg = __builtin_amdgcn_rcpf(1.0f + __builtin_amdgcn_exp2f(-1.4426950408889634f * gate[j])); o[j] += val[j] * sg; }
                    *(f32x4*)(out + off + bj * 64) = o; ss += (o[0] * o[0] + o[1] * o[1]) + (o[2] * o[2] + o[3] * o[3]);
                    u32x2 w; w.x = cvt_pk_bf16(o[0], o[1]); w.y = cvt_pk_bf16(o[2], o[3]); *(u32x2*)(xb + off + bj * 64) = w; }
                ss += __shfl_xor(ss, 16); ss += __shfl_xor(ss, 32);
                if (fq == 0) ssq[(size_t)row * SSQ_STRIDE + u.pn * 4 + wc] = ss;
                asm volatile("" ::: "memory"); }
    }
};
__host__ __device__ __forceinline__ int vt_pos(int key) { const int s = key >> 5, w = key & 31; return 32 * s + 8 * ((w & 15) >> 2) + (w & 3) + 4 * (w >> 4); }
struct EpiKV {
    static constexpr bool PERM = true, AFTER_DRAIN = false;
    bf16_t* Kb; bf16_t* Vb; bf16_t* VTb; const float* ssq;
    __device__ __forceinline__ void operator()(const f32x4 (&acc)[2][2][4][2], const Unit& u, int wr, int wc, int fr, int fq) const {
        const int row0 = u.pm * BM + wr * 64 + fr, col0 = u.pn * BM + wc * 32 + 8 * fq;
#pragma unroll
        for (int ai = 0; ai < 2; ++ai)
#pragma unroll
            for (int m = 0; m < 4; ++m) { const int row = row0 + ai * HALF + m * 16; const float rs = row_rstd(ssq, 32, row, fq); const int b = row >> 8, key = row & 255;
#pragma unroll
                for (int bj = 0; bj < 2; ++bj) { const f32x4 v0 = acc[ai][bj][m][0] * rs, v1 = acc[ai][bj][m][1] * rs; const int col = col0 + bj * HALF;
                    u32x4 w; w.x = cvt_pk_bf16(v0[0], v0[1]); w.y = cvt_pk_bf16(v0[2], v0[3]); w.z = cvt_pk_bf16(v1[0], v1[1]); w.w = cvt_pk_bf16(v1[2], v1[3]);
                    if (col < 2048) { const int h = col >> 9, d = col & 511; *(u32x4*)(Kb + ((size_t)((b * 4 + h) * 256 + key)) * 512 + d) = w; }
                    else { const int c2 = col - 2048, h = c2 >> 9, d = c2 & 511; *(u32x4*)(Vb + ((size_t)((b * 4 + h) * 256 + key)) * 512 + d) = w;
                        bf16_t* vt = VTb + ((size_t)((b * 4 + h) * 512 + d)) * 256 + vt_pos(key);
                        vt[0 * 256] = (bf16_t)(w.x & 0xffffu); vt[1 * 256] = (bf16_t)(w.x >> 16); vt[2 * 256] = (bf16_t)(w.y & 0xffffu); vt[3 * 256] = (bf16_t)(w.y >> 16);
                        vt[4 * 256] = (bf16_t)(w.z & 0xffffu); vt[5 * 256] = (bf16_t)(w.z >> 16); vt[6 * 256] = (bf16_t)(w.w & 0xffffu); vt[7 * 256] = (bf16_t)(w.w >> 16); } }
            }
    }
};
template <class Epi, class Sched, bool ALIGN_EPI = false, bool SP2 = false>
__device__ __forceinline__ void gemm_phase(PG8_LAS unsigned char* lds, const Gemm g, const Sched& S, const Epi& E, const int wid  , const int lane) {
    const int tid = wid * 64 + lane, wr = wid >> 2, wc = wid & 3, fr = lane & 15, fq = lane >> 4;
    const int K = g.K, nt = K / BK;
    unsigned voffA[2], voffB[2];
#pragma unroll
    for (int i = 0; i < 2; ++i) { int R, C; stage_rc(tid * 16 + i * 8192, R, C); const int Rb = Epi::PERM ? ((R & ~31) + perm32(R & 31)) : R;
        voffA[i] = (unsigned)(R * K + C) * 2u; voffB[i] = (unsigned)(Rb * K + C) * 2u; }
    const size_t kstep = (size_t)(BK * 2);
    const size_t hstep = (size_t)HALF * K * 2;
    const size_t tstep = 2 * hstep;
    const unsigned ldsw = (unsigned)wid * 1024u;
    const int aoff = lds_byte(wr * 64 + fr, fq * 8), boff = lds_byte(wc * 32 + fr, fq * 8);
#define PG8_SA(b, h) (((b) * 2 + (h)) * HTB)
#define PG8_SB(b, h) ((4 + (b) * 2 + (h)) * HTB)
#define PG8_STAGE(bufoff, gbase, voff) do { _Pragma("unroll") for (int _i = 0; _i < 2; ++_i) \
        __builtin_amdgcn_global_load_lds((const unsigned*)((const char*)(gbase) + (voff)[_i]), (PG8_LAS unsigned*)(lds + (bufoff) + ldsw + _i * 8192), 16, 0, 0); } while (0)
#define PG8_LDA(dst, b, h) do { _Pragma("unroll") for (int m = 0; m < 4; ++m) _Pragma("unroll") for (int k = 0; k < 2; ++k) dst[m][k] = *(const PG8_LAS bf16x8*)(lds + PG8_SA(b, h) + aoff + m * 2048 + k * 1024); } while (0)
#define PG8_LDB(dst, b, h) do { _Pragma("unroll") for (int n = 0; n < 2; ++n) _Pragma("unroll") for (int k = 0; k < 2; ++k) dst[n][k] = *(const PG8_LAS bf16x8*)(lds + PG8_SB(b, h) + boff + n * 2048 + k * 1024); } while (0)
#define PG8_MMA(ai, bj, At, Bt) do { __builtin_amdgcn_s_setprio(1); _Pragma("unroll") for (int m = 0; m < 4; ++m) _Pragma("unroll") for (int n = 0; n < 2; ++n) _Pragma("unroll") for (int k = 0; k < 2; ++k) \
        acc[ai][bj][m][n] = __builtin_amdgcn_mfma_f32_16x16x32_bf16(Bt[n][k], At[m][k], acc[ai][bj][m][n], 0, 0, 0); __builtin_amdgcn_s_setprio(0); } while (0)
#define PG8_WAIT_V(n) asm volatile("s_waitcnt vmcnt(" #n ")" ::: "memory")
#define PG8_WAIT_L(n) asm volatile("s_waitcnt lgkmcnt(" #n ")" ::: "memory")
#define PG8_BAR __builtin_amdgcn_s_barrier()
#define PG8_SCHED __builtin_amdgcn_sched_barrier(0)
    Unit cur, nxt; int ui = 0;
    if (!S.next(0, cur)) return;
    f32x4 acc[2][2][4][2];
#pragma unroll
    for (int a = 0; a < 2; ++a)
#pragma unroll
        for (int b = 0; b < 2; ++b)
#pragma unroll
            for (int m = 0; m < 4; ++m)
#pragma unroll
                for (int n = 0; n < 2; ++n) acc[a][b][m][n] = (f32x4){0.f, 0.f, 0.f, 0.f};
    bf16x8 At[4][2], B0[2][2], B1[2][2];
    const char* cA = (const char*)g.A + (size_t)cur.pm * tstep; const char* cB = (const char*)g.Bt + (size_t)cur.pn * tstep;
    S.a_ready(cur);
    if constexpr (SP2) {
        PG8_STAGE(PG8_SB(0, 0), cB, voffB); PG8_STAGE(PG8_SB(0, 1), cB + hstep, voffB); PG8_STAGE(PG8_SA(0, 0), cA, voffA); PG8_STAGE(PG8_SA(0, 1), cA + hstep, voffA);
        if (wr == 1) PG8_BAR;
        PG8_WAIT_V(2); PG8_BAR;
        PG8_STAGE(PG8_SB(1, 0), cB + kstep, voffB); PG8_STAGE(PG8_SA(1, 0), cA + kstep, voffA); PG8_STAGE(PG8_SB(1, 1), cB + hstep + kstep, voffB);
        PG8_WAIT_V(6); PG8_BAR;
    } else {
        PG8_STAGE(PG8_SB(0, 0), cB, voffB); PG8_STAGE(PG8_SA(0, 0), cA, voffA); PG8_STAGE(PG8_SB(0, 1), cB + hstep, voffB); PG8_STAGE(PG8_SA(0, 1), cA + hstep, voffA);
        if (wr == 1) PG8_BAR;
        PG8_WAIT_V(4); PG8_BAR;
        PG8_STAGE(PG8_SB(1, 0), cB + kstep, voffB); PG8_STAGE(PG8_SA(1, 0), cA + kstep, voffA); PG8_STAGE(PG8_SB(1, 1), cB + hstep + kstep, voffB);
        PG8_WAIT_V(6); PG8_BAR;
    }
    for (;;) {
        const bool has_next = S.next(ui + 1, nxt);
        const char* nA = has_next ? (const char*)g.A + (size_t)nxt.pm * tstep : cA; const char* nB = has_next ? (const char*)g.Bt + (size_t)nxt.pn * tstep : cB;
        for (int t = 0; t < nt; t += 2) {
            const bool last = (t == nt - 2);
            const char* a1 = cA + (size_t)(t + 1) * kstep;
            const char* a2 = last ? nA : cA + (size_t)(t + 2) * kstep; const char* b2 = last ? nB : cB + (size_t)(t + 2) * kstep;
            const char* a3 = a2 + kstep; const char* b3 = b2 + kstep;
            if (last && has_next) S.a_ready(nxt);
            if constexpr (SP2) {
            PG8_LDB(B0, 0, 0); PG8_LDB(B1, 0, 1); PG8_SCHED; PG8_LDA(At, 0, 0); PG8_STAGE(PG8_SA(1, 1), a1 + hstep, voffA);
            PG8_WAIT_V(8); PG8_WAIT_L(0); PG8_BAR; PG8_MMA(0, 0, At, B0); PG8_MMA(0, 1, At, B1); PG8_BAR; PG8_SCHED;
            PG8_LDA(At, 0, 1); PG8_STAGE(PG8_SB(0, 0), b2, voffB); PG8_STAGE(PG8_SB(0, 1), b2 + hstep, voffB); PG8_STAGE(PG8_SA(0, 0), a2, voffA);
            PG8_WAIT_V(8); PG8_WAIT_L(0); PG8_BAR; PG8_MMA(1, 0, At, B0); PG8_MMA(1, 1, At, B1); PG8_BAR; PG8_SCHED;
            PG8_LDB(B0, 1, 0); PG8_LDB(B1, 1, 1); PG8_SCHED; PG8_LDA(At, 1, 0); PG8_STAGE(PG8_SA(0, 1), a2 + hstep, voffA);
            PG8_WAIT_V(8); PG8_WAIT_L(0); PG8_BAR; PG8_MMA(0, 0, At, B0); PG8_MMA(0, 1, At, B1); PG8_BAR; PG8_SCHED;
            PG8_LDA(At, 1, 1); PG8_STAGE(PG8_SB(1, 0), b3, voffB); PG8_STAGE(PG8_SB(1, 1), b3 + hstep, voffB); PG8_STAGE(PG8_SA(1, 0), a3, voffA);
            PG8_WAIT_V(8); PG8_WAIT_L(0); PG8_BAR; PG8_MMA(1, 0, At, B0); PG8_MMA(1, 1, At, B1); PG8_BAR; PG8_SCHED;
            } else {
            PG8_LDB(B0, 0, 0); PG8_SCHED; PG8_LDA(At, 0, 0); PG8_STAGE(PG8_SA(1, 1), a1 + hstep, voffA);
            PG8_WAIT_L(8); PG8_BAR; PG8_WAIT_L(0); PG8_MMA(0, 0, At, B0); PG8_BAR; PG8_SCHED;
            PG8_LDB(B1, 0, 1); PG8_STAGE(PG8_SB(0, 0), b2, voffB);
            PG8_BAR; PG8_WAIT_L(0); PG8_MMA(0, 1, At, B1); PG8_BAR;
            PG8_LDA(At, 0, 1); PG8_STAGE(PG8_SA(0, 0), a2, voffA);
            PG8_BAR; PG8_WAIT_L(0); PG8_MMA(1, 0, At, B0); PG8_BAR; PG8_SCHED;
            PG8_STAGE(PG8_SB(0, 1), b2 + hstep, voffB);
            PG8_WAIT_V(6); PG8_BAR; PG8_MMA(1, 1, At, B1); PG8_BAR;
            PG8_LDB(B0, 1, 0); PG8_SCHED; PG8_LDA(At, 1, 0); PG8_STAGE(PG8_SA(0, 1), a2 + hstep, voffA);
            PG8_WAIT_L(8); PG8_BAR; PG8_WAIT_L(0); PG8_MMA(0, 0, At, B0); PG8_BAR; PG8_SCHED;
            PG8_LDB(B1, 1, 1); PG8_STAGE(PG8_SB(1, 0), b3, voffB);
            PG8_BAR; PG8_WAIT_L(0); PG8_MMA(0, 1, At, B1); PG8_BAR;
            PG8_LDA(At, 1, 1); PG8_STAGE(PG8_SA(1, 0), a3, voffA);
            PG8_BAR; PG8_WAIT_L(0); PG8_MMA(1, 0, At, B0); PG8_BAR; PG8_SCHED;
            PG8_STAGE(PG8_SB(1, 1), b3 + hstep, voffB);
            PG8_WAIT_V(6); PG8_BAR; PG8_MMA(1, 1, At, B1); PG8_BAR;
            }
        }
        if constexpr (ALIGN_EPI) { if (wr == 0) PG8_BAR; }
        if constexpr (!Epi::AFTER_DRAIN) { Unit ue = cur; asm volatile("" : "+s"(ue.pm), "+s"(ue.pn));
            E(acc, ue, wr, wc, fr, fq); S.done(cur); }
        if (!has_next) break;
#pragma unroll
        for (int a = 0; a < 2; ++a)
#pragma unroll
            for (int b = 0; b < 2; ++b)
#pragma unroll
                for (int m = 0; m < 4; ++m)
#pragma unroll
                    for (int n = 0; n < 2; ++n) acc[a][b][m][n] = (f32x4){0.f, 0.f, 0.f, 0.f};
        cur = nxt; cA = nA; cB = nB; ++ui;
        if constexpr (ALIGN_EPI) { if (wr == 1) PG8_BAR; }
    }
    PG8_WAIT_V(0);
    if constexpr (!ALIGN_EPI) { if (wr == 0) PG8_BAR; }
    PG8_BAR;
    if constexpr (Epi::AFTER_DRAIN) { E.fused(acc, cur, wr, wc, fr, fq, lds, wid, lane); S.done(cur); }
#undef PG8_SA
#undef PG8_SB
#undef PG8_STAGE
#undef PG8_LDA
#undef PG8_LDB
#undef PG8_MMA
#undef PG8_WAIT_V
#undef PG8_WAIT_L
#undef PG8_BAR
#undef PG8_SCHED
}
}
#ifndef MK_N_LAUNCHES
#define MK_N_LAUNCHES 1
#endif
constexpr int BATCH = 2, SEQ = 4096, D = 2048, M = BATCH * SEQ, MEMLEN = 256, MROWS = BATCH * MEMLEN, FF = 8192;
constexpr int NWAVES = 8, NTHREADS = 512, NPH = 20;
constexpr int LDS_BYTES = 147456;
constexpr size_t MiB = 1u << 20;
constexpr size_t WS_W_AIN = 2 * MiB, WS_W_AOUT = 18 * MiB, WS_W_BIN = 26 * MiB, WS_W_BOUT = 34 * MiB, WS_W_Q = 50 * MiB, WS_W_KV = 66 * MiB, WS_W_O = 98 * MiB, WS_W_UP = 114 * MiB, WS_W_DN = 178 * MiB;
constexpr size_t WS_XB = 242 * MiB, WS_MEMB = 274 * MiB, WS_KB = 276 * MiB, WS_VB = 280 * MiB, WS_VTB = 284 * MiB, WS_SSQ = 288 * MiB, WS_VST = 290 * MiB, WS_SSQM = 292 * MiB, WS_S5ST = 294 * MiB;
constexpr size_t WS_R = 304 * MiB, WS_END = 432 * MiB;
#define GAS __attribute__((address_space(1)))
#define LAS __attribute__((address_space(3)))
typedef unsigned short bf16;
typedef unsigned v4u __attribute__((ext_vector_type(4)));
typedef unsigned v2u __attribute__((ext_vector_type(2)));
typedef float f32x4 __attribute__((ext_vector_type(4)));
typedef float f32x2 __attribute__((ext_vector_type(2)));
#define LDS_WAIT() asm volatile("s_waitcnt lgkmcnt(0)" ::: "memory")
__device__ __forceinline__ unsigned f2bf(float f) { unsigned u = __builtin_bit_cast(unsigned, f); return (u + 0x7fffu + ((u >> 16) & 1u)) >> 16; }
__device__ __forceinline__ unsigned pk2(float lo, float hi) { return f2bf(lo) | (f2bf(hi) << 16); }
__device__ __forceinline__ float bflo(unsigned w) { return __builtin_bit_cast(float, w << 16); }
__device__ __forceinline__ float bfhi(unsigned w) { return __builtin_bit_cast(float, w & 0xffff0000u); }
__device__ __forceinline__ float wave_sum(float v) {
#pragma unroll
    for (int o = 1; o < 64; o <<= 1) v += __shfl_xor(v, o);
    return v;
}
__device__ __forceinline__ float wave_max(float v) {
#pragma unroll
    for (int o = 1; o < 64; o <<= 1) v = fmaxf(v, __shfl_xor(v, o));
    return v;
}
__device__ __forceinline__ float gelu_exact(float v) { return 0.5f * v * (1.0f + erff(v * 0.70710678118654752f)); }

struct Args { const float* in[30]; float* out; unsigned char* ws; int ph_lo, ph_hi; };
__device__ __forceinline__ const float* ka_in(int i) { const __attribute__((address_space(4))) char* ka = (const __attribute__((address_space(4))) char*)__builtin_amdgcn_kernarg_segment_ptr(); asm volatile("" : "+s"(ka)); return *(const float* const __attribute__((address_space(4)))*)(ka + 8 * i); }

__device__ __forceinline__ int glu_rowmap(int n) { return n < 2048 ? 32 * (n >> 4) + (n & 15) : 32 * ((n - 2048) >> 4) + 16 + (n & 15); }
__device__ __forceinline__ void conv_item(const float* W, int K, int N, const float* gk, int mode, bf16* WT, LAS float* scr, int item, int lane) {
    const int nblk = N >> 6, kb = item / nblk, nb = item - kb * nblk, k0 = 64 * kb, n0 = 64 * nb;
    f32x4 v[16];
#pragma unroll
    for (int i = 0; i < 16; ++i) { const int kk = 4 * i + (lane >> 4); v[i] = *(const f32x4*)(W + (size_t)(k0 + kk) * N + n0 + 4 * (lane & 15)); }
#pragma unroll
    for (int i = 0; i < 16; ++i) { const int kk = 4 * i + (lane >> 4); const float s = gk ? gk[k0 + kk] : 1.0f; LAS float* d = scr + kk * 65 + 4 * (lane & 15);
        d[0] = v[i][0] * s; d[1] = v[i][1] * s; d[2] = v[i][2] * s; d[3] = v[i][3] * s; }
    LDS_WAIT();
    const int c = lane & 7;
#pragma unroll
    for (int j = 0; j < 8; ++j) { const int n = (lane >> 3) + 8 * j; const LAS float* s = scr + (8 * c) * 65 + n;
        v4u o; o.x = pk2(s[0 * 65], s[1 * 65]); o.y = pk2(s[2 * 65], s[3 * 65]); o.z = pk2(s[4 * 65], s[5 * 65]); o.w = pk2(s[6 * 65], s[7 * 65]);
        const int nr = mode ? glu_rowmap(n0 + n) : (n0 + n);
        *(v4u*)(WT + (size_t)nr * K + k0 + 8 * c) = o; }
    LDS_WAIT();
}
__device__ __forceinline__ void row_to_bf16(const float* xrow, bf16* orow, float* ssqrow, int lane) {
    f32x4 v[8]; float s = 0.f;
#pragma unroll
    for (int j = 0; j < 8; ++j) { v[j] = ((const f32x4*)xrow)[lane + 64 * j]; s += (v[j][0] * v[j][0] + v[j][1] * v[j][1]) + (v[j][2] * v[j][2] + v[j][3] * v[j][3]); }
    s = wave_sum(s);
#pragma unroll
    for (int j = 0; j < 8; ++j) { v2u w; w.x = pk2(v[j][0], v[j][1]); w.y = pk2(v[j][2], v[j][3]); ((v2u*)orow)[lane + 64 * j] = w; }
    if (lane < 32) ssqrow[lane] = (lane == 0) ? s : 0.f;
}
__device__ __forceinline__ void p0_prologue(unsigned char* ws, LAS unsigned char* lds, int wave, int lane) {
    LAS float* scr = (LAS float*)(lds + wave * 16640);
    const int gw = blockIdx.x * NWAVES + wave, NGW = gridDim.x * NWAVES;
    constexpr int NITEMS = 30720;
    for (int it0 = gw; it0 < NITEMS; it0 += NGW) {
        int r = __builtin_amdgcn_readfirstlane(it0);
        const float* W; const float* g = nullptr; bf16* WT; int K = 2048, N = 2048, mode = 0;
        if (r < 2048) { W = ka_in(7); g = ka_in(2); WT = (bf16*)(ws + WS_W_AIN); N = 4096; }
        else if ((r -= 2048) < 1024) { W = ka_in(13); WT = (bf16*)(ws + WS_W_AOUT); }
        else if ((r -= 1024) < 1024) { W = ka_in(14); g = ka_in(2) + 2048; WT = (bf16*)(ws + WS_W_BIN); }
        else if ((r -= 1024) < 2048) { W = ka_in(23); WT = (bf16*)(ws + WS_W_BOUT); N = 4096; mode = 1; }
        else if ((r -= 2048) < 2048) { const int i = r >> 10; r &= 1023; W = ka_in(25) + (size_t)i * 2048 * 2048; g = ka_in(3) + i * 2048; WT = (bf16*)(ws + WS_W_Q + i * 8 * MiB); }
        else if ((r -= 2048) < 4096) { const int i = r >> 11; r &= 2047; W = ka_in(26) + (size_t)i * 2048 * 4096; g = ka_in(4) + i * 2048; WT = (bf16*)(ws + WS_W_KV + i * 16 * MiB); N = 4096; }
        else if ((r -= 4096) < 2048) { const int i = r >> 10; r &= 1023; W = ka_in(27) + (size_t)i * 2048 * 2048; WT = (bf16*)(ws + WS_W_O + i * 8 * MiB); }
        else if ((r -= 2048) < 8192) { const int i = r >> 12; r &= 4095; W = ka_in(28) + (size_t)i * 2048 * 8192; g = ka_in(5) + i * 2048; WT = (bf16*)(ws + WS_W_UP + i * 32 * MiB); N = 8192; }
        else { r -= 8192; const int i = r >> 12; r &= 4095; W = ka_in(29) + (size_t)i * 8192 * 2048; WT = (bf16*)(ws + WS_W_DN + i * 32 * MiB); K = 8192; }
        conv_item(W, K, N, g, mode, WT, scr, r, lane);
    }
    for (int m = gw; m < M + MROWS; m += NGW) {
        if (m < M) row_to_bf16(ka_in(0) + (size_t)m * D, (bf16*)(ws + WS_XB) + (size_t)m * D, (float*)(ws + WS_SSQ) + (size_t)m * 64, lane);
        else { const int r = m - M; row_to_bf16(ka_in(1) + (size_t)r * D, (bf16*)(ws + WS_MEMB) + (size_t)r * D, (float*)(ws + WS_SSQM) + (size_t)r * 64, lane); }
    }
}
__device__ __forceinline__ void final_norm(float* x, const float* g, int wave, int lane) {
    const int gw = blockIdx.x * NWAVES + wave, NGW = gridDim.x * NWAVES;
    for (int m = gw; m < M; m += NGW) { f32x4* xr = (f32x4*)(x + (size_t)m * D); f32x4 v[8]; float s = 0.f;
#pragma unroll
        for (int j = 0; j < 8; ++j) { v[j] = xr[lane + 64 * j]; s += (v[j][0] * v[j][0] + v[j][1] * v[j][1]) + (v[j][2] * v[j][2] + v[j][3] * v[j][3]); }
        const float rs = 1.0f / sqrtf(wave_sum(s) * (1.0f / D) + 1e-6f);
#pragma unroll
        for (int j = 0; j < 8; ++j) { const f32x4 gv = ((const f32x4*)g)[lane + 64 * j]; xr[lane + 64 * j] = v[j] * rs * gv; } }
}
__device__ __forceinline__ void gating_simple(LAS unsigned char* lds, const bf16* z, const float* vst, const float* ln_g, const float* ln_b, const float* w_s, const float* b_s, bf16* gbuf, int tid) {
    LAS float* vln = (LAS float*)lds;
    LAS float* Wl = (LAS float*)(lds + 65536);
    LAS float* mu = (LAS float*)(lds + 65536 + 128 * 129 * 4);
    LAS float* rsd = mu + 128;
    for (int unit = blockIdx.x; unit < 1024; unit += gridDim.x) {
        const int h = unit & 15, tok0 = (unit >> 4) * 128;
        if (tid < 128) { const float* p = vst + (size_t)(tok0 + tid) * 64; float s1 = 0.f, s2 = 0.f;
#pragma unroll 8
            for (int i = 0; i < 32; ++i) { s1 += p[2 * i]; s2 += p[2 * i + 1]; }
            const float mean = s1 * (1.0f / 2048.0f), var = s2 * (1.0f / 2048.0f) - mean * mean; mu[tid] = mean; rsd[tid] = 1.0f / sqrtf(var + 1e-6f); }
        __syncthreads();
        { const int s = tid >> 2, db = (tid & 3) * 32; const float mean = mu[s], rs = rsd[s];
            const bf16* vp = z + (size_t)(tok0 + s) * 4096 + 2048 + h * 128 + db;
#pragma unroll
            for (int q = 0; q < 4; ++q) { const v4u w = *(const v4u*)(vp + 8 * q); const float* gp = ln_g + h * 128 + db + 8 * q; const float* bp = ln_b + h * 128 + db + 8 * q; LAS float* o = vln + s * 128 + db + 8 * q;
                o[0] = (bflo(w.x) - mean) * rs * gp[0] + bp[0]; o[1] = (bfhi(w.x) - mean) * rs * gp[1] + bp[1]; o[2] = (bflo(w.y) - mean) * rs * gp[2] + bp[2]; o[3] = (bfhi(w.y) - mean) * rs * gp[3] + bp[3];
                o[4] = (bflo(w.z) - mean) * rs * gp[4] + bp[4]; o[5] = (bfhi(w.z) - mean) * rs * gp[5] + bp[5]; o[6] = (bflo(w.w) - mean) * rs * gp[6] + bp[6]; o[7] = (bfhi(w.w) - mean) * rs * gp[7] + bp[7]; }
            const float* wp = w_s + ((size_t)h * 128 + s) * 128 + db;
#pragma unroll
            for (int q = 0; q < 8; ++q) { const f32x4 w4 = *(const f32x4*)(wp + 4 * q); LAS float* o = Wl + s * 129 + db + 4 * q; o[0] = w4[0]; o[1] = w4[1]; o[2] = w4[2]; o[3] = w4[3]; } }
        __syncthreads();
        { const int t = tid >> 2, d0 = (tid & 3) * 32, tmax = t | 15; float acc[32];
#pragma unroll
            for (int j = 0; j < 32; ++j) acc[j] = 0.f;
            for (int s = 0; s <= tmax; ++s) { const float w = (s <= t) ? Wl[t * 129 + s] : 0.f; const LAS f32x4* vr = (const LAS f32x4*)(vln + s * 128 + d0);
#pragma unroll
                for (int q = 0; q < 8; ++q) { const f32x4 vv = vr[q]; acc[4 * q] += w * vv[0]; acc[4 * q + 1] += w * vv[1]; acc[4 * q + 2] += w * vv[2]; acc[4 * q + 3] += w * vv[3]; } }
            const float bs = b_s[h * 128 + t];
            const bf16* up = z + (size_t)(tok0 + t) * 4096 + h * 128 + d0; bf16* op = gbuf + (size_t)(tok0 + t) * 2048 + h * 128 + d0;
#pragma unroll
            for (int q = 0; q < 4; ++q) { const v4u w = *(const v4u*)(up + 8 * q); v4u o;
                o.x = pk2(bflo(w.x) * (acc[8 * q] + bs), bfhi(w.x) * (acc[8 * q + 1] + bs)); o.y = pk2(bflo(w.y) * (acc[8 * q + 2] + bs), bfhi(w.y) * (acc[8 * q + 3] + bs));
                o.z = pk2(bflo(w.z) * (acc[8 * q + 4] + bs), bfhi(w.z) * (acc[8 * q + 5] + bs)); o.w = pk2(bflo(w.w) * (acc[8 * q + 6] + bs), bfhi(w.w) * (acc[8 * q + 7] + bs));
                *(v4u*)(op + 8 * q) = o; } }
        __syncthreads();
    }
}
__device__ __forceinline__ void attn_simple(LAS unsigned char* lds, const bf16* q, const bf16* Kb, const bf16* Vb, bf16* obuf, int wave, int lane) {
    LAS float* pl = (LAS float*)(lds + wave * 1024);
    const int gw = blockIdx.x * NWAVES + wave, NGW = gridDim.x * NWAVES;
    for (int task = gw; task < BATCH * 4 * SEQ; task += NGW) {
        const int bh = task >> 12, t = task & 4095, b = bh >> 2, h = bh & 3;
        float qf[8]; { const v4u w = *(const v4u*)(q + ((size_t)(b * SEQ + t)) * 2048 + h * 512 + 8 * lane);
            qf[0] = bflo(w.x); qf[1] = bfhi(w.x); qf[2] = bflo(w.y); qf[3] = bfhi(w.y); qf[4] = bflo(w.z); qf[5] = bfhi(w.z); qf[6] = bflo(w.w); qf[7] = bfhi(w.w); }
        const bf16* kp = Kb + (size_t)bh * 256 * 512 + 8 * lane;
        float sc[4];
#pragma unroll
        for (int kk = 0; kk < 4; ++kk) { float mine = 0.f;
            for (int l2 = 0; l2 < 64; ++l2) { const v4u w = *(const v4u*)(kp + (size_t)(kk * 64 + l2) * 512);
                float dsum = qf[0] * bflo(w.x) + qf[1] * bfhi(w.x) + qf[2] * bflo(w.y) + qf[3] * bfhi(w.y) + qf[4] * bflo(w.z) + qf[5] * bfhi(w.z) + qf[6] * bflo(w.w) + qf[7] * bfhi(w.w);
                dsum = wave_sum(dsum); if (lane == l2) mine = dsum; }
            sc[kk] = mine; }
        const float mx = wave_max(fmaxf(fmaxf(sc[0], sc[1]), fmaxf(sc[2], sc[3])));
        float p[4], ps = 0.f;
#pragma unroll
        for (int kk = 0; kk < 4; ++kk) { p[kk] = exp2f(sc[kk] - mx); ps += p[kk]; pl[kk * 64 + lane] = p[kk]; }
        const float inv = 1.0f / wave_sum(ps);
        LDS_WAIT();
        float o[8];
#pragma unroll
        for (int i = 0; i < 8; ++i) o[i] = 0.f;
        const bf16* vp = Vb + (size_t)bh * 256 * 512 + 8 * lane;
        for (int key = 0; key < 256; ++key) { const float pk = pl[key]; const v4u w = *(const v4u*)(vp + (size_t)key * 512);
            o[0] += pk * bflo(w.x); o[1] += pk * bfhi(w.x); o[2] += pk * bflo(w.y); o[3] += pk * bfhi(w.y); o[4] += pk * bflo(w.z); o[5] += pk * bfhi(w.z); o[6] += pk * bflo(w.w); o[7] += pk * bfhi(w.w); }
        v4u ow; ow.x = pk2(o[0] * inv, o[1] * inv); ow.y = pk2(o[2] * inv, o[3] * inv); ow.z = pk2(o[4] * inv, o[5] * inv); ow.w = pk2(o[6] * inv, o[7] * inv);
        *(v4u*)(obuf + ((size_t)(b * SEQ + t)) * 2048 + h * 512 + 8 * lane) = ow;
        LDS_WAIT();
    }
}
typedef short bf16x8 __attribute__((ext_vector_type(8)));
__device__ __forceinline__ void attn_mfma(LAS unsigned char* lds, const bf16* q, const bf16* Kb, const bf16* VTb, bf16* obuf, int wave, int lane) {
    const int tid = wave * 64 + lane, fr = lane & 15, fq = lane >> 4;
    unsigned voffK[2], voffV[2];
#pragma unroll
    for (int i = 0; i < 2; ++i) { int R, C; pg8::stage_rc(tid * 16 + i * 8192, R, C); voffK[i] = (unsigned)(R * 512 + C) * 2u; voffV[i] = (unsigned)(R * 256 + C) * 2u; }
    const unsigned ldsw = (unsigned)wave * 1024u;
    const int aoff0 = pg8::lds_byte(fr, fq * 8);
#define AT_STAGE_K(c, buf) do { _Pragma("unroll") for (int ht = 0; ht < 4; ++ht) { const char* src = Kg + ((size_t)(128 * (ht >> 1)) * 512 + 128 * (c) + 64 * (ht & 1)) * 2; \
        _Pragma("unroll") for (int i = 0; i < 2; ++i) __builtin_amdgcn_global_load_lds((const unsigned*)(src + voffK[i]), (LAS unsigned*)(lds + (buf) * 65536 + ht * 16384 + ldsw + i * 8192), 16, 0, 0); } } while (0)
#define AT_STAGE_V(cc, buf) do { _Pragma("unroll") for (int ht = 0; ht < 4; ++ht) { const char* src = Vg + ((size_t)(128 * ht) * 256 + 64 * (cc)) * 2; \
        _Pragma("unroll") for (int i = 0; i < 2; ++i) __builtin_amdgcn_global_load_lds((const unsigned*)(src + voffV[i]), (LAS unsigned*)(lds + (buf) * 65536 + ht * 16384 + ldsw + i * 8192), 16, 0, 0); } } while (0)
#define AT_WAIT() do { asm volatile("s_waitcnt vmcnt(0)" ::: "memory"); __syncthreads(); } while (0)
    for (int unit = blockIdx.x; unit < 256; unit += gridDim.x) {
        const int bh = unit >> 5, qb = unit & 31, b = bh >> 2, h = bh & 3;
        const char* Kg = (const char*)(Kb + (size_t)bh * 256 * 512);
        const char* Vg = (const char*)(VTb + (size_t)bh * 512 * 256);
        const size_t tok = (size_t)(b * SEQ + qb * 128 + 16 * wave + fr);
        bf16x8 qf[16];
        { const bf16* qp = q + tok * 2048 + h * 512 + 8 * fq;
#pragma unroll
            for (int s = 0; s < 16; ++s) qf[s] = *(const bf16x8*)(qp + 32 * s); }
        f32x4 acc[16];
#pragma unroll
        for (int n = 0; n < 16; ++n) acc[n] = (f32x4){0.f, 0.f, 0.f, 0.f};
        AT_STAGE_K(0, 0);
#pragma unroll
        for (int c = 0; c < 4; ++c) {
            AT_WAIT();
            if (c < 3) AT_STAGE_K(c + 1, (c + 1) & 1); else AT_STAGE_V(0, 0);
            const LAS unsigned char* bb = lds + (c & 1) * 65536 + aoff0; asm volatile("" : "+v"(bb));
#pragma unroll
            for (int kh = 0; kh < 2; ++kh)
#pragma unroll
                for (int k = 0; k < 2; ++k)
#pragma unroll
                    for (int ng = 0; ng < 2; ++ng) { bf16x8 a[8];
#pragma unroll
                        for (int n8 = 0; n8 < 8; ++n8) a[n8] = *(const LAS bf16x8*)(bb + (ng * 2 + kh) * 16384 + n8 * 2048 + k * 1024);
#pragma unroll
                        for (int n8 = 0; n8 < 8; ++n8) acc[ng * 8 + n8] = __builtin_amdgcn_mfma_f32_16x16x32_bf16(a[n8], qf[4 * c + 2 * kh + k], acc[ng * 8 + n8], 0, 0, 0);
                        __builtin_amdgcn_sched_barrier(0); }
        }
        float mx = acc[0][0];
#pragma unroll
        for (int n = 0; n < 16; ++n) mx = fmaxf(fmaxf(mx, fmaxf(acc[n][0], acc[n][1])), fmaxf(acc[n][2], acc[n][3]));
        mx = fmaxf(mx, __shfl_xor(mx, 16)); mx = fmaxf(mx, __shfl_xor(mx, 32));
        float l = 0.f;
#pragma unroll
        for (int n = 0; n < 16; ++n)
#pragma unroll
            for (int r = 0; r < 4; ++r) { const float pv = __builtin_amdgcn_exp2f(acc[n][r] - mx); acc[n][r] = pv; l += pv; }
        l += __shfl_xor(l, 16); l += __shfl_xor(l, 32);
        const float linv = 1.0f / l;
        bf16x8 pf[8];
#pragma unroll
        for (int s = 0; s < 8; ++s) { v4u w; w.x = pg8::cvt_pk_bf16(acc[2 * s][0], acc[2 * s][1]); w.y = pg8::cvt_pk_bf16(acc[2 * s][2], acc[2 * s][3]);
            w.z = pg8::cvt_pk_bf16(acc[2 * s + 1][0], acc[2 * s + 1][1]); w.w = pg8::cvt_pk_bf16(acc[2 * s + 1][2], acc[2 * s + 1][3]); pf[s] = __builtin_bit_cast(bf16x8, w); }
        __builtin_amdgcn_sched_barrier(0);
        f32x4 o[32];
#pragma unroll
        for (int mm = 0; mm < 32; ++mm) o[mm] = (f32x4){0.f, 0.f, 0.f, 0.f};
#pragma unroll
        for (int cc = 0; cc < 4; ++cc) {
            AT_WAIT();
            if (cc < 3) AT_STAGE_V(cc + 1, (cc + 1) & 1);
            const LAS unsigned char* bb = lds + (cc & 1) * 65536 + aoff0; asm volatile("" : "+v"(bb));
#pragma unroll
            for (int k = 0; k < 2; ++k)
#pragma unroll
                for (int mg = 0; mg < 4; ++mg) { bf16x8 a[8];
#pragma unroll
                    for (int m8 = 0; m8 < 8; ++m8) a[m8] = *(const LAS bf16x8*)(bb + mg * 16384 + m8 * 2048 + k * 1024);
#pragma unroll
                    for (int m8 = 0; m8 < 8; ++m8) o[mg * 8 + m8] = __builtin_amdgcn_mfma_f32_16x16x32_bf16(a[m8], pf[2 * cc + k], o[mg * 8 + m8], 0, 0, 0);
                    __builtin_amdgcn_sched_barrier(0); }
        }
        bf16* op = obuf + tok * 2048 + h * 512 + 4 * fq;
#pragma unroll
        for (int mm = 0; mm < 32; ++mm) { v2u w; w.x = pg8::cvt_pk_bf16(o[mm][0] * linv, o[mm][1] * linv); w.y = pg8::cvt_pk_bf16(o[mm][2] * linv, o[mm][3] * linv); *(v2u*)(op + 16 * mm) = w; }
    }
    asm volatile("s_waitcnt vmcnt(0)" ::: "memory"); __syncthreads();
#undef AT_STAGE_K
#undef AT_STAGE_V
#undef AT_WAIT
}
struct S5Lane { float lbr, lbi; float Br[16], Bi[16]; };
__device__ __forceinline__ void s5_lane_params(int g, int p, S5Lane& L) {
    const float lr = fminf(ka_in(15)[g * 64 + p], -1e-4f), li = ka_in(16)[g * 64 + p], dt = expf(ka_in(17)[g]);
    const float ar = lr * dt, th = li * dt; float sn, cs; sincosf(th, &sn, &cs); const float e = expf(ar), sh = sinf(0.5f * th);
    L.lbr = e * cs; L.lbi = e * sn;
    const float nr = expm1f(ar) * cs - 2.0f * sh * sh, ni = e * sn;
    const float den = 1.0f / (lr * lr + li * li), cr = (nr * lr + ni * li) * den, ci = (ni * lr - nr * li) * den;
#pragma unroll
    for (int c = 0; c < 16; ++c) { const float br = ka_in(18)[(size_t)(g * 64 + p) * 16 + c], bi = ka_in(19)[(size_t)(g * 64 + p) * 16 + c]; L.Br[c] = cr * br - ci * bi; L.Bi[c] = cr * bi + ci * br; }
}
__device__ __forceinline__ void s5_step(const S5Lane& L, const bf16* urow, float& xr, float& xi) {
    const v4u w0 = *(const v4u*)urow, w1 = *(const v4u*)(urow + 8);
    float u[16] = {bflo(w0.x), bfhi(w0.x), bflo(w0.y), bfhi(w0.y), bflo(w0.z), bfhi(w0.z), bflo(w0.w), bfhi(w0.w), bflo(w1.x), bfhi(w1.x), bflo(w1.y), bfhi(w1.y), bflo(w1.z), bfhi(w1.z), bflo(w1.w), bfhi(w1.w)};
    float br = 0.f, bi = 0.f;
#pragma unroll
    for (int c = 0; c < 16; ++c) { br += L.Br[c] * u[c]; bi += L.Bi[c] * u[c]; }
    const float nr = L.lbr * xr - L.lbi * xi + br, ni = L.lbr * xi + L.lbi * xr + bi; xr = nr; xi = ni;
}
__device__ __forceinline__ void s5_pass_a(const bf16* ub, f32x2* st, int wave, int lane) {
    const int gw = blockIdx.x * NWAVES + wave, NGW = gridDim.x * NWAVES;
    for (int task = gw; task < BATCH * 128 * 64; task += NGW) {
        const int seg = task & 63, g = (task >> 6) & 127, b = task >> 13;
        S5Lane L; s5_lane_params(g, lane, L);
        float xr = 0.f, xi = 0.f; const bf16* up = ub + (size_t)(b * SEQ + seg * 64) * 2048 + 16 * g;
#pragma unroll 2
        for (int s = 0; s < 64; ++s) s5_step(L, up + (size_t)s * 2048, xr, xi);
        st[(size_t)task * 64 + lane] = (f32x2){xr, xi};
    }
}
__device__ __forceinline__ void s5_pass_c(LAS unsigned char* lds, const bf16* ub, const f32x2* st, bf16* yb, int wave, int lane) {
    LAS f32x2* Cs = (LAS f32x2*)(lds + wave * 16640);
    LAS f32x2* xs = (LAS f32x2*)(lds + wave * 16640 + 8320);
    const int gw = blockIdx.x * NWAVES + wave, NGW = gridDim.x * NWAVES;
    for (int task = gw; task < BATCH * 128 * 64; task += NGW) {
        const int seg = task & 63, g = (task >> 6) & 127, b = task >> 13;
        S5Lane L; s5_lane_params(g, lane, L);
#pragma unroll
        for (int c = 0; c < 16; ++c) Cs[c * 65 + lane] = (f32x2){ka_in(20)[(size_t)(g * 16 + c) * 64 + lane], ka_in(21)[(size_t)(g * 16 + c) * 64 + lane]};
        float Ar = L.lbr, Ai = L.lbi;
#pragma unroll
        for (int i = 0; i < 6; ++i) { const float nr = Ar * Ar - Ai * Ai, ni = 2.0f * Ar * Ai; Ar = nr; Ai = ni; }
        float xr = 0.f, xi = 0.f; const f32x2* sp = st + (size_t)(task - seg) * 64 + lane;
#pragma unroll 2
        for (int n = 0; n < seg; ++n) { const f32x2 s = sp[(size_t)n * 64]; const float nr = Ar * xr - Ai * xi + s.x, ni = Ar * xi + Ai * xr + s.y; xr = nr; xi = ni; }
        const bf16* up = ub + (size_t)(b * SEQ + seg * 64) * 2048 + 16 * g; bf16* yp = yb + (size_t)(b * SEQ + seg * 64) * 2048 + 16 * g;
        const int t = lane & 15, cq = lane >> 4;
        f32x4 dsk = *(const f32x4*)(ka_in(22) + g * 16 + 4 * cq);
#pragma unroll 1
        for (int blk = 0; blk < 4; ++blk) {
#pragma unroll 2
            for (int s = 0; s < 16; ++s) { s5_step(L, up + (size_t)(blk * 16 + s) * 2048, xr, xi); xs[s * 65 + lane] = (f32x2){xr, xi}; }
            LDS_WAIT();
            float acc[4] = {0.f, 0.f, 0.f, 0.f};
#pragma unroll 4
            for (int p = 0; p < 64; ++p) { const f32x2 x = xs[t * 65 + p];
#pragma unroll
                for (int j = 0; j < 4; ++j) { const f32x2 c = Cs[(4 * cq + j) * 65 + p]; acc[j] += c.x * x.x - c.y * x.y; } }
            const v2u uw = *(const v2u*)(up + (size_t)(blk * 16 + t) * 2048 + 4 * cq);
            const float y0 = gelu_exact(acc[0] + dsk[0] * bflo(uw.x)), y1 = gelu_exact(acc[1] + dsk[1] * bfhi(uw.x)), y2 = gelu_exact(acc[2] + dsk[2] * bflo(uw.y)), y3 = gelu_exact(acc[3] + dsk[3] * bfhi(uw.y));
            v2u ow; ow.x = pk2(y0, y1); ow.y = pk2(y2, y3); *(v2u*)(yp + (size_t)(blk * 16 + t) * 2048 + 4 * cq) = ow;
            LDS_WAIT();
        }
    }
}
__device__ __forceinline__ void s5_mfma(LAS unsigned char* lds, const bf16* ub, bf16* yb, int wave, int lane) {
    LAS f32x2* PW = (LAS f32x2*)(lds);
    LAS f32x2* BB = (LAS f32x2*)(lds + 8704);
    LAS f32x2* CC = (LAS f32x2*)(lds + 16896);
    LAS bf16* KST = (LAS bf16*)(lds + 25088);
    LAS unsigned char* UI = lds + 33280;
    LAS float* SL = (LAS float*)(lds + 66048);
    LAS bf16* XP = (LAS bf16*)(lds + 99840);
    const int tid = wave * 64 + lane, fr = lane & 15, fq = lane >> 4;
    for (int unit = blockIdx.x; unit < 256; unit += gridDim.x) {
        const int b = unit >> 7, g = unit & 127;
        const float dt = expf(ka_in(17)[g]);
        __syncthreads();
        for (int idx = tid; idx < 17 * 64; idx += NTHREADS) { const int e = idx >> 6, p = idx & 63;
            const float lr = fminf(ka_in(15)[g * 64 + p], -1e-4f), li = ka_in(16)[g * 64 + p]; float sn, cs; sincosf(li * dt * (float)e, &sn, &cs); const float ex = expf(lr * dt * (float)e);
            PW[idx] = (f32x2){ex * cs, ex * sn}; }
        for (int idx = tid; idx < 1024; idx += NTHREADS) { const int p = idx >> 4, c = idx & 15;
            const float lr = fminf(ka_in(15)[g * 64 + p], -1e-4f), li = ka_in(16)[g * 64 + p]; const float ar = lr * dt, th = li * dt; float sn, cs; sincosf(th, &sn, &cs); const float e = expf(ar), sh = sinf(0.5f * th);
            const float nr = expm1f(ar) * cs - 2.0f * sh * sh, ni = e * sn, den = 1.0f / (lr * lr + li * li), cr = (nr * lr + ni * li) * den, ci = (ni * lr - nr * li) * den;
            const float br = ka_in(18)[(size_t)(g * 64 + p) * 16 + c], bi = ka_in(19)[(size_t)(g * 64 + p) * 16 + c];
            BB[idx] = (f32x2){cr * br - ci * bi, cr * bi + ci * br};
            CC[idx] = (f32x2){ka_in(20)[(size_t)g * 1024 + idx], ka_in(21)[(size_t)g * 1024 + idx]}; }
        __syncthreads();
        bf16x8 A1[8];
        { const int ri = wave >> 2, p = 16 * (wave & 3) + fr;
#pragma unroll
            for (int ks = 0; ks < 8; ++ks) { const int s = 2 * ks + (fq >> 1); const f32x2 pw = PW[(15 - s) * 64 + p]; float v[8];
#pragma unroll
                for (int j = 0; j < 8; ++j) { const f32x2 bb = BB[p * 16 + 8 * (fq & 1) + j]; v[j] = ri ? (pw.x * bb.y + pw.y * bb.x) : (pw.x * bb.x - pw.y * bb.y); }
                v4u w; w.x = pk2(v[0], v[1]); w.y = pk2(v[2], v[3]); w.z = pk2(v[4], v[5]); w.w = pk2(v[6], v[7]); A1[ks] = __builtin_bit_cast(bf16x8, w); } }
        const int t0 = wave, t1 = 15 - wave;
        bf16x8 CM[2][4];
#pragma unroll
        for (int ti = 0; ti < 2; ++ti) { const int t = ti ? t1 : t0;
#pragma unroll
            for (int ks = 0; ks < 4; ++ks) { float v[8];
#pragma unroll
                for (int j = 0; j < 8; ++j) { const int p = 32 * (ks & 1) + 8 * fq + j; const f32x2 c = CC[fr * 64 + p], pw = PW[(t + 1) * 64 + p];
                    v[j] = (ks >> 1) ? -(c.x * pw.y + c.y * pw.x) : (c.x * pw.x - c.y * pw.y); }
                v4u w; w.x = pk2(v[0], v[1]); w.y = pk2(v[2], v[3]); w.z = pk2(v[4], v[5]); w.w = pk2(v[6], v[7]); CM[ti][ks] = __builtin_bit_cast(bf16x8, w); } }
        { bf16x8 ct[4];
#pragma unroll
            for (int ks = 0; ks < 4; ++ks) { float v[8];
#pragma unroll
                for (int j = 0; j < 8; ++j) { const f32x2 c = CC[fr * 64 + 32 * (ks & 1) + 8 * fq + j]; v[j] = (ks >> 1) ? -c.y : c.x; }
                v4u w; w.x = pk2(v[0], v[1]); w.y = pk2(v[2], v[3]); w.z = pk2(v[4], v[5]); w.w = pk2(v[6], v[7]); ct[ks] = __builtin_bit_cast(bf16x8, w); }
#pragma unroll
            for (int si = 0; si < 2; ++si) { const int s = 2 * wave + si; f32x4 kacc = (f32x4){0.f, 0.f, 0.f, 0.f};
#pragma unroll
                for (int ks = 0; ks < 4; ++ks) { float v[8];
#pragma unroll
                    for (int j = 0; j < 8; ++j) { const int p = 32 * (ks & 1) + 8 * fq + j; const f32x2 pw = PW[(15 - s) * 64 + p], bb = BB[p * 16 + fr];
                        v[j] = (ks >> 1) ? (pw.x * bb.y + pw.y * bb.x) : (pw.x * bb.x - pw.y * bb.y); }
                    v4u w; w.x = pk2(v[0], v[1]); w.y = pk2(v[2], v[3]); w.z = pk2(v[4], v[5]); w.w = pk2(v[6], v[7]);
                    kacc = __builtin_amdgcn_mfma_f32_16x16x32_bf16(__builtin_bit_cast(bf16x8, w), ct[ks], kacc, 0, 0, 0); }
                v2u kw; kw.x = pk2(kacc[0], kacc[1]); kw.y = pk2(kacc[2], kacc[3]);
                *(LAS v2u*)(KST + ((15 - s) * 16 + fr) * 16 + 4 * fq) = kw; } }
        const f32x4 dsk = *(const f32x4*)(ka_in(22) + g * 16 + 4 * fq);
        float Xr = 0.f, Xi = 0.f;
#pragma unroll 1
        for (int q = 0; q < 4; ++q) {
            __syncthreads();
            { const bf16* src0 = ub + (size_t)(b * SEQ + q * 1024) * 2048 + 16 * g;
#pragma unroll
                for (int i = 0; i < 4; ++i) { const int piece = tid + NTHREADS * i, tok = piece >> 1, half = piece & 1;
                    const v4u w = *(const v4u*)(src0 + (size_t)tok * 2048 + 8 * half);
                    *(LAS v4u*)(UI + ((((tok & 15) * 64 + (tok >> 4)) * 2 + half) * 16)) = w; } }
            __syncthreads();
#pragma unroll 1
            for (int nf = 0; nf < 4; ++nf) { f32x4 acc = (f32x4){0.f, 0.f, 0.f, 0.f};
#pragma unroll
                for (int ks = 0; ks < 8; ++ks) { const bf16x8 bfr = *(const LAS bf16x8*)(UI + ((((2 * ks + (fq >> 1)) * 64 + 16 * nf + fr) * 2 + (fq & 1)) * 16));
                    acc = __builtin_amdgcn_mfma_f32_16x16x32_bf16(A1[ks], bfr, acc, 0, 0, 0); }
                *(LAS f32x4*)(SL + (16 * nf + fr) * 132 + 16 * wave + 4 * fq) = acc; }
            __syncthreads();
            if (wave == 0) { const f32x2 a16 = PW[16 * 64 + lane];
#pragma unroll 4
                for (int n = 0; n < 64; ++n) { XP[n * 136 + lane] = (bf16)f2bf(Xr); XP[n * 136 + 64 + lane] = (bf16)f2bf(Xi);
                    const float sr = SL[n * 132 + lane], si = SL[n * 132 + 64 + lane];
                    const float nr = a16.x * Xr - a16.y * Xi + sr, ni = a16.x * Xi + a16.y * Xr + si; Xr = nr; Xi = ni; } }
            __syncthreads();
#pragma unroll 1
            for (int nf = 0; nf < 4; ++nf) { f32x4 acc0 = (f32x4){0.f, 0.f, 0.f, 0.f}, acc1 = acc0;
#pragma unroll
                for (int ks = 0; ks < 8; ++ks) { if (2 * ks <= t1 || 2 * ks <= t0) {
                    const int s = 2 * ks + (fq >> 1);
                    const bf16x8 bfr = *(const LAS bf16x8*)(UI + (((s * 64 + 16 * nf + fr) * 2 + (fq & 1)) * 16));
                    if (2 * ks <= t0) { bf16x8 tf = (bf16x8){0, 0, 0, 0, 0, 0, 0, 0}; if (s <= t0) tf = *(const LAS bf16x8*)(KST + ((t0 - s) * 16 + fr) * 16 + 8 * (fq & 1)); acc0 = __builtin_amdgcn_mfma_f32_16x16x32_bf16(tf, bfr, acc0, 0, 0, 0); }
                    if (2 * ks <= t1) { bf16x8 tf = (bf16x8){0, 0, 0, 0, 0, 0, 0, 0}; if (s <= t1) tf = *(const LAS bf16x8*)(KST + ((t1 - s) * 16 + fr) * 16 + 8 * (fq & 1)); acc1 = __builtin_amdgcn_mfma_f32_16x16x32_bf16(tf, bfr, acc1, 0, 0, 0); } } }
#pragma unroll
                for (int ks = 0; ks < 4; ++ks) { const bf16x8 xf = *(const LAS bf16x8*)(XP + (16 * nf + fr) * 136 + 32 * ks + 8 * fq);
                    acc0 = __builtin_amdgcn_mfma_f32_16x16x32_bf16(CM[0][ks], xf, acc0, 0, 0, 0); acc1 = __builtin_amdgcn_mfma_f32_16x16x32_bf16(CM[1][ks], xf, acc1, 0, 0, 0); }
#pragma unroll
                for (int ti = 0; ti < 2; ++ti) { const int t = ti ? t1 : t0; const f32x4 a = ti ? acc1 : acc0; const int n = 16 * nf + fr;
                    const v2u uw = *(const LAS v2u*)(UI + (((t * 64 + n) * 2 + (fq >> 1)) * 16) + 8 * (fq & 1));
                    const pg8::f32x2 g0 = pg8::gelu_pk((pg8::f32x2){a[0] + dsk[0] * bflo(uw.x), a[1] + dsk[1] * bfhi(uw.x)}), g1 = pg8::gelu_pk((pg8::f32x2){a[2] + dsk[2] * bflo(uw.y), a[3] + dsk[3] * bfhi(uw.y)});
                    v2u ow; ow.x = pg8::cvt_pk_bf16(g0.x, g0.y); ow.y = pg8::cvt_pk_bf16(g1.x, g1.y);
                    *(v2u*)(yb + (size_t)(b * SEQ + q * 1024 + 16 * n + t) * 2048 + 16 * g + 4 * fq) = ow; } }
        }
    }
    __syncthreads();
}
#ifndef EN
#define EN(k) 1
#endif
template <int PH> __device__ __forceinline__ void run_phase(unsigned char* ws, float* X, LAS unsigned char* lds, int wave, int lane) {
    const int G = gridDim.x, bx = blockIdx.x;
    bf16* XB = (bf16*)(ws + WS_XB); float* SSQ = (float*)(ws + WS_SSQ);
    bf16* R0 = (bf16*)(ws + WS_R);
    constexpr int layer = (PH >= 10) ? 1 : 0;
    if constexpr (!EN(PH)) { return; }
    else if constexpr (PH == 0) p0_prologue(ws, lds, wave, lane);
    else if constexpr (PH == 1) {
        if (bx < 64) { const int i = bx >> 5;
            pg8::Gemm g{(const pg8::bf16_t*)(ws + WS_MEMB), (const pg8::bf16_t*)(ws + WS_W_KV + (size_t)i * 16 * MiB), MROWS, 4096, 2048}; pg8::StaticOrder S; S.init(MROWS, 4096, 32, bx & 31);
            pg8::EpiKV E{(pg8::bf16_t*)(ws + WS_KB + (size_t)i * 2 * MiB), (pg8::bf16_t*)(ws + WS_VB + (size_t)i * 2 * MiB), (pg8::bf16_t*)(ws + WS_VTB + (size_t)i * 2 * MiB), (const float*)(ws + WS_SSQM)};
            pg8::gemm_phase<pg8::EpiKV, pg8::StaticOrder, true, true>(lds, g, S, E, wave, lane); }
    } else if constexpr (PH == 2) {
        pg8::Gemm g{XB, (const pg8::bf16_t*)(ws + WS_W_AIN), M, 4096, 2048}; pg8::StaticOrder S; S.init(M, 4096, G, bx);
        pg8::EpiAct<1, true> E{R0, 4096, ka_in(8), SSQ, 32, 1.0f, (float*)(ws + WS_VST), 8};
        pg8::gemm_phase<pg8::EpiAct<1, true>, pg8::StaticOrder, true, true>(lds, g, S, E, wave, lane);
    } else if constexpr (PH == 3) gating_simple(lds, R0, (const float*)(ws + WS_VST), ka_in(9), ka_in(10), ka_in(11), ka_in(12), R0 + (size_t)M * 4096, wave * 64 + lane);
    else if constexpr (PH == 4 || PH == 7 || PH == 9 || PH == 16 || PH == 18) {
        const pg8::bf16_t* A; const pg8::bf16_t* W; int K = 2048; const float* base = X;
        if constexpr (PH == 4) { A = R0 + (size_t)M * 4096; W = (const pg8::bf16_t*)(ws + WS_W_AOUT); base = ka_in(0); }
        else if constexpr (PH == 7 || PH == 16) { A = R0 + (size_t)M * 2048; W = (const pg8::bf16_t*)(ws + WS_W_O + (size_t)layer * 8 * MiB); }
        else { A = R0; W = (const pg8::bf16_t*)(ws + WS_W_DN + (size_t)layer * 32 * MiB); K = 8192; }
        pg8::Gemm g{A, W, M, 2048, K}; pg8::StaticOrder S; S.init(M, 2048, G, bx);
        pg8::EpiRes E{base, X, XB, SSQ};
        pg8::gemm_phase<pg8::EpiRes, pg8::StaticOrder, true, true>(lds, g, S, E, wave, lane);
    } else if constexpr (PH == 5 || PH == 14 || PH == 10) {
        const pg8::bf16_t* W = (PH == 10) ? (const pg8::bf16_t*)(ws + WS_W_BIN) : (const pg8::bf16_t*)(ws + WS_W_Q + (size_t)layer * 8 * MiB);
        pg8::Gemm g{XB, W, M, 2048, 2048}; pg8::StaticOrder S; S.init(M, 2048, G, bx);
        pg8::EpiAct<0, false> E{R0, 2048, nullptr, SSQ, (PH == 14) ? 64 : 32, (PH == 10) ? 1.0f : 0.044194173824159216f * 1.4426950408889634f, nullptr, 0};
        pg8::gemm_phase<pg8::EpiAct<0, false>, pg8::StaticOrder, true, true>(lds, g, S, E, wave, lane);
    } else if constexpr (PH == 6 || PH == 15) {
#if defined(ATTN_SIMPLE)
        attn_simple(lds, R0, (const bf16*)(ws + WS_KB + (size_t)layer * 2 * MiB), (const bf16*)(ws + WS_VB + (size_t)layer * 2 * MiB), R0 + (size_t)M * 2048, wave, lane);
#else
        attn_mfma(lds, R0, (const bf16*)(ws + WS_KB + (size_t)layer * 2 * MiB), (const bf16*)(ws + WS_VTB + (size_t)layer * 2 * MiB), R0 + (size_t)M * 2048, wave, lane);
#endif
    }
    else if constexpr (PH == 8 || PH == 17) {
        pg8::Gemm g{XB, (const pg8::bf16_t*)(ws + WS_W_UP + (size_t)layer * 32 * MiB), M, FF, 2048}; pg8::StaticOrder S; S.init(M, FF, G, bx);
        pg8::EpiAct<2, false> E{R0, FF, nullptr, SSQ, 32, 1.0f, nullptr, 0};
        pg8::gemm_phase<pg8::EpiAct<2, false>, pg8::StaticOrder, true, true>(lds, g, S, E, wave, lane);
    } else if constexpr (PH == 11) {
#if defined(S5_SIMPLE)
        s5_pass_a(R0, (f32x2*)(ws + WS_S5ST), wave, lane);
#endif
    } else if constexpr (PH == 12) {
#if defined(S5_SIMPLE)
        s5_pass_c(lds, R0, (const f32x2*)(ws + WS_S5ST), R0 + (size_t)M * 2048, wave, lane);
#else
        s5_mfma(lds, R0, R0 + (size_t)M * 2048, wave, lane);
#endif
    }
    else if constexpr (PH == 13) {
        pg8::Gemm g{R0 + (size_t)M * 2048, (const pg8::bf16_t*)(ws + WS_W_BOUT), M, 4096, 2048}; pg8::StaticOrder S; S.init(M, 4096, G, bx);
        pg8::EpiGlu E{X, X, XB, SSQ, ka_in(24)};
        pg8::gemm_phase<pg8::EpiGlu, pg8::StaticOrder, true, true>(lds, g, S, E, wave, lane);
    } else if constexpr (PH == 19) final_norm(X, ka_in(6), wave, lane);
}
__device__ __forceinline__ int lane_id() { int l; asm volatile("v_mbcnt_lo_u32_b32 %0, -1, 0\n\tv_mbcnt_hi_u32_b32 %0, -1, %0" : "=v"(l)); return l; }

#define XB_TMO      128
#define XB_XCNT(j)  (256  + 64 * (j))
#define XB_XSUB(j)  (1280 + 64 * (j))
#define XB_XGEN(j)  (2304 + 64 * (j))
#define XB_TOP      3328
#define XB_TOPGEN   3392
#define XCD_BAR_WORDS 3456
#define XB_SPIN_CAP (1u << 22)
__device__ __forceinline__ unsigned xb_ld(unsigned* p)              { return __hip_atomic_load(p, __ATOMIC_RELAXED, __HIP_MEMORY_SCOPE_AGENT); }
__device__ __forceinline__ unsigned xb_add(unsigned* p, unsigned v) { return __hip_atomic_fetch_add(p, v, __ATOMIC_RELAXED, __HIP_MEMORY_SCOPE_AGENT); }
__device__ __forceinline__ unsigned xb_xcc_id() { return (unsigned)__builtin_amdgcn_s_getreg((3 << 11) | 20) & 0xFu; }
#define XB_SPIN(cond, bar) do { unsigned _sp = 0; while (cond) { __builtin_amdgcn_s_sleep(1); \
    if ((++_sp & 255u) == 0u) { if (xb_ld(&(bar)[XB_TMO])) break; if (_sp > XB_SPIN_CAP) { atomicAdd(&(bar)[XB_TMO], 1u); break; } } } } while (0)
__device__ __forceinline__ void xcd_barrier_complete(unsigned* bar, unsigned x, unsigned& nloc, unsigned& nx) {
    const unsigned G = gridDim.x * gridDim.y * gridDim.z;
    unsigned sum, cnt, mine, sp = 0u;
    for (;;) {
        sum = 0u; cnt = 0u; mine = 0u;
#pragma unroll
        for (unsigned j = 0; j < 16; ++j) { const unsigned c = xb_ld(&bar[XB_XCNT(j)]); sum += c; cnt += (c > 0u) ? 1u : 0u; mine = (j == x) ? c : mine; }
        if (sum == G) break;
        __builtin_amdgcn_s_sleep(1);
        if ((++sp & 255u) == 0u) { if (xb_ld(&bar[XB_TMO])) break; if (sp > XB_SPIN_CAP) { atomicAdd(&bar[XB_TMO], 1u); break; } }
    }
    nloc = mine > 0u ? mine : 1u; nx = cnt > 0u ? cnt : 1u;
}
__device__ __forceinline__ void xcd_barrier(unsigned* bar, volatile LAS unsigned* st, bool is_t0) {
    asm volatile("s_waitcnt vmcnt(0)" ::: "memory");
    __syncthreads();
    if (is_t0) {
        __builtin_amdgcn_s_waitcnt(0);
        const unsigned x = xb_xcc_id();
        unsigned nloc = st[0], nx = st[1];
        if (nloc == 0u) { xcd_barrier_complete(bar, x, nloc, nx); st[0] = nloc; st[1] = nx; }
        const unsigned old = xb_add(&bar[XB_XSUB(x)], 1u);
        const unsigned gen = old / nloc;
        if (old + 1u == (gen + 1u) * nloc) {
            __builtin_amdgcn_fence(__ATOMIC_RELEASE, "agent");
            asm volatile("s_waitcnt vmcnt(0)" ::: "memory");
            const unsigned og = xb_add(&bar[XB_TOP], 1u);
            const unsigned tg = og / nx;
            if (og + 1u == (tg + 1u) * nx) xb_add(&bar[XB_TOPGEN], 1u);
            else XB_SPIN(xb_ld(&bar[XB_TOPGEN]) == tg, bar);
            __builtin_amdgcn_fence(__ATOMIC_ACQUIRE, "agent");
            xb_add(&bar[XB_XGEN(x)], 1u);
            asm volatile("s_waitcnt vmcnt(0)" ::: "memory");
        } else {
            XB_SPIN(xb_ld(&bar[XB_XGEN(x)]) == gen, bar);
            __builtin_amdgcn_fence(__ATOMIC_ACQUIRE, "agent");
            asm volatile("s_waitcnt vmcnt(0)" ::: "memory");
        }
    }
    __syncthreads();
}

__global__ void __launch_bounds__(NTHREADS, 2) trunk_fwd(Args args) {
    extern __shared__ __attribute__((aligned(16))) unsigned char lds_raw[];
    LAS unsigned char* lds = (LAS unsigned char*)lds_raw;
    const int wave = __builtin_amdgcn_readfirstlane((int)threadIdx.x >> 6);
    const int lo = args.ph_lo, hi = args.ph_hi;
    unsigned* bar = (unsigned*)args.ws + 4096;
    volatile LAS unsigned* st = (volatile LAS unsigned*)(lds + LDS_BYTES - 64);
#if MK_N_LAUNCHES == 1
    { const int l0 = lane_id(); if (wave == 0 && l0 < 2) st[l0] = 0u; __syncthreads(); if (wave == 0 && l0 == 0) (void)xb_add(&bar[XB_XCNT(xb_xcc_id())], 1u); }
#define GRID_BAR(k) do { if ((k) == 1) cg::this_grid().sync(); else xcd_barrier(bar, st, wave == 0 && lane_id() == 0); } while (0)
#else
#define GRID_BAR(k) do { } while (0)
#endif
#ifndef DUP_PH
#define DUP_PH -1
#endif
#define PHASE(k) if (lo <= (k) && (k) < hi) { if ((k) > lo) GRID_BAR(k); run_phase<k>(args.ws, args.out, lds, wave, lane_id()); if ((k) == DUP_PH) { GRID_BAR(2); run_phase<k>(args.ws, args.out, lds, wave, lane_id()); } }
    PHASE(0) PHASE(1) PHASE(2) PHASE(3) PHASE(4) PHASE(5) PHASE(6) PHASE(7) PHASE(8) PHASE(9)
    PHASE(10) PHASE(11) PHASE(12) PHASE(13) PHASE(14) PHASE(15) PHASE(16) PHASE(17) PHASE(18) PHASE(19)
#undef PHASE
}

extern "C" void kernel_launch(void* const* d_in, const int* in_sizes, int n_in, void* d_out, int out_size, void* d_ws, size_t ws_size, hipStream_t stream) {
    static int grid = 0;
    if (grid == 0) {
        if (n_in != 30 || out_size != M * D || ws_size < WS_END) { fprintf(stderr, "kernel_launch: unexpected shapes (n_in %d out %d ws %zu)\n", n_in, out_size, ws_size); grid = -1; return; }
        int dev = 0, cus = 0, per_cu = 0;
        if (hipGetDevice(&dev) != hipSuccess || hipDeviceGetAttribute(&cus, hipDeviceAttributeMultiprocessorCount, dev) != hipSuccess) { grid = -1; return; }
        if (hipFuncSetAttribute((const void*)trunk_fwd, hipFuncAttributeMaxDynamicSharedMemorySize, LDS_BYTES) != hipSuccess) { fprintf(stderr, "kernel_launch: hipFuncSetAttribute failed\n"); grid = -1; return; }
        if (hipOccupancyMaxActiveBlocksPerMultiprocessor(&per_cu, (const void*)trunk_fwd, NTHREADS, LDS_BYTES) != hipSuccess || per_cu < 1) { fprintf(stderr, "kernel_launch: occupancy query says %d\n", per_cu); grid = -1; return; }
        grid = cus;
    }
    if (grid < 0) return;
    if (hipMemsetAsync(d_ws, 0, 65536, stream) != hipSuccess) { fprintf(stderr, "kernel_launch: memset failed\n"); return; }
    Args a{};
    for (int i = 0; i < 30; ++i) a.in[i] = (const float*)d_in[i];
    a.out = (float*)d_out; a.ws = (unsigned char*)d_ws;
#if MK_N_LAUNCHES == 1
    a.ph_lo = 0; a.ph_hi = NPH;
    void* kargs[] = {&a};
    hipError_t e = hipLaunchCooperativeKernel((const void*)trunk_fwd, dim3(grid), dim3(NTHREADS), kargs, LDS_BYTES, stream);
    if (e != hipSuccess) fprintf(stderr, "kernel_launch: cooperative launch failed: %s\n", hipGetErrorString(e));
#else
    for (int ph = 0; ph < NPH; ++ph) { a.ph_lo = ph; a.ph_hi = ph + 1; hipLaunchKernelGGL(trunk_fwd, dim3(grid), dim3(NTHREADS), LDS_BYTES, stream, a); }
#endif
}
```

```cpp
#include <hip/hip_runtime.h>
#include <hip/hip_cooperative_groups.h>
#include <cstdio>
#include <cstdint>
namespace cg = cooperative_groups;
#define MK_N_LAUNCHES 1
namespace pg8 {
#define PG8_LAS __attribute__((address_space(3)))
typedef unsigned short bf16_t;
typedef short bf16x8 __attribute__((ext_vector_type(8)));
typedef float f32x4 __attribute__((ext_vector_type(4)));
typedef unsigned u32x4 __attribute__((ext_vector_type(4)));
constexpr int BM = 256, BK = 64, HALF = 128, HTB = HALF * BK * 2  , STAGE_BYTES = 8 * HTB, NXCD = 8, WGM = 8;

__host__ __device__ __forceinline__ int lds_byte(int r, int c) { const int st = (r >> 4) * 2 + (c >> 5), rr = r & 15, cc = c & 31, ob = rr * 64 + cc * 2; return st * 1024 + (ob ^ (((ob >> 9) & 1) << 5)); }
__host__ __device__ __forceinline__ void stage_rc(int b, int& R, int& C) { const int st = b / 1024, sb = b % 1024, swz = sb ^ (((sb >> 9) & 1) << 5); R = (st >> 1) * 16 + swz / 64; C = (st & 1) * 32 + (swz % 64) / 2; }
__host__ __device__ __forceinline__ int perm32(int rho) { const int n = rho >> 4, i = rho & 15; return 8 * (i >> 2) + 4 * n + (i & 3); }

struct Unit { int pm, pn; };
struct Gemm { const bf16_t* A; const bf16_t* Bt; int M, N, K; };

struct StaticOrder {
    int nM, nN, nwg, G, c;
    __host__ __device__ void init(int M, int N, int G_, int c_) { nM = M / BM; nN = N / BM; nwg = nM * nN; G = G_; c = c_; }
    __host__ __device__ bool next(int i, Unit& u) const {
        const long L = (long)i * G + c; if (L >= nwg) return false;
        int wgid = (int)L; { const int q = nwg / NXCD, r = nwg % NXCD, xcd = wgid % NXCD, off = wgid / NXCD; wgid = (xcd < r ? xcd * (q + 1) : r * (q + 1) + (xcd - r) * q) + off; }
        const int nig = WGM * nN, gid = wgid / nig, fm = gid * WGM, gsz = (nM - fm) < WGM ? (nM - fm) : WGM;
        u.pm = fm + ((wgid % nig) % gsz); u.pn = (wgid % nig) / gsz; return true;
    }
    __device__ __forceinline__ void a_ready(const Unit&) const {}
    __device__ __forceinline__ void done(const Unit&) const {}
};

__device__ __forceinline__ unsigned cvt_pk_bf16(float lo, float hi) { unsigned r; asm volatile("v_cvt_pk_bf16_f32 %0, %1, %2" : "=v"(r) : "v"(lo), "v"(hi)); return r; }
typedef float f32x2 __attribute__((ext_vector_type(2)));
__device__ __forceinline__ f32x2 gelu_pk(f32x2 v) {
    const f32x2 av = __builtin_elementwise_abs(v), d = av * 0.2316418882f + 1.0f;
    f32x2 t; t.x = __builtin_amdgcn_rcpf(d.x); t.y = __builtin_amdgcn_rcpf(d.y);
    f32x2 q = t * 0.5307027145f + (-0.7265760135f); q = q * t + 0.7107068705f; q = q * t + (-0.142248368f); q = q * t + 0.127414796f; q = q * t;
    const f32x2 s = (v * v) * (-0.72134752044f);
    f32x2 e; e.x = __builtin_amdgcn_exp2f(s.x); e.y = __builtin_amdgcn_exp2f(s.y);
    const f32x2 m = v * (q * e), r = v - m;
    f32x2 o; o.x = v.x < 0.f ? m.x : r.x; o.y = v.y < 0.f ? m.y : r.y; return o;
}
typedef unsigned u32x2 __attribute__((ext_vector_type(2)));
constexpr int SSQ_STRIDE = 64;
__device__ __forceinline__ float row_rstd(const float* ssq, int np, int row, int fq) {
    const float* p = ssq + (size_t)row * SSQ_STRIDE + fq * (np >> 2);
    f32x4 a = *(const f32x4*)p, b = *(const f32x4*)(p + 4);
    float s = (a[0] + a[1]) + (a[2] + a[3]) + (b[0] + b[1]) + (b[2] + b[3]);
    if (np == 64) { f32x4 c = *(const f32x4*)(p + 8), d = *(const f32x4*)(p + 12); s += (c[0] + c[1]) + (c[2] + c[3]) + (d[0] + d[1]) + (d[2] + d[3]); }
    s += __shfl_xor(s, 16); s += __shfl_xor(s, 32);
    return __builtin_amdgcn_rsqf(s * (1.0f / 2048.0f) + 1e-6f);
}
template <int ACT, bool STATS> struct EpiAct {
    static constexpr bool PERM = true, AFTER_DRAIN = false;
    bf16_t* O; int ldc; const float* bias; const float* ssq; int np; float oscale; float* vst; int stat_pn0;
    __device__ __forceinline__ void operator()(const f32x4 (&acc)[2][2][4][2], const Unit& u, int wr, int wc, int fr, int fq) const {
        const int row0 = u.pm * BM + wr * 64 + fr, col0 = u.pn * BM + wc * 32 + 8 * fq;
        f32x4 bv[2][2];
#pragma unroll
        for (int bj = 0; bj < 2; ++bj)
#pragma unroll
            for (int n = 0; n < 2; ++n) bv[bj][n] = bias ? *(const f32x4*)(bias + col0 + bj * HALF + 4 * n) : (f32x4){0.f, 0.f, 0.f, 0.f};
        float rsv[2][4];
#pragma unroll
        for (int ai = 0; ai < 2; ++ai) {
#pragma unroll
            for (int m = 0; m < 4; ++m) rsv[ai][m] = row_rstd(ssq, np, row0 + ai * HALF + m * 16, fq);
            asm volatile("" ::: "memory"); }
#pragma unroll
        for (int ai = 0; ai < 2; ++ai)
#pragma unroll
            for (int m = 0; m < 4; ++m) { const int row = row0 + ai * HALF + m * 16; const float rs = rsv[ai][m];
                bf16_t* rowp = O + (size_t)row * ldc + col0; float s1 = 0.f, s2 = 0.f;
#pragma unroll
                for (int bj = 0; bj < 2; ++bj) { f32x4 v0 = acc[ai][bj][m][0] * rs + bv[bj][0], v1 = acc[ai][bj][m][1] * rs + bv[bj][1];
                    if (ACT == 1) { f32x2 a = gelu_pk((f32x2){v0[0], v0[1]}), b = gelu_pk((f32x2){v0[2], v0[3]}), c = gelu_pk((f32x2){v1[0], v1[1]}), d = gelu_pk((f32x2){v1[2], v1[3]});
                        v0 = (f32x4){a.x, a.y, b.x, b.y}; v1 = (f32x4){c.x, c.y, d.x, d.y}; }
                    if (ACT == 2) {
#pragma unroll
                        for (int j = 0; j < 4; ++j) { const float a = fmaxf(v0[j], 0.f), b = fmaxf(v1[j], 0.f); v0[j] = a * a; v1[j] = b * b; } }
                    v0 = v0 * oscale; v1 = v1 * oscale;
                    if (STATS) { s1 += (v0[0] + v0[1]) + (v0[2] + v0[3]) + (v1[0] + v1[1]) + (v1[2] + v1[3]);
                        s2 += (v0[0] * v0[0] + v0[1] * v0[1]) + (v0[2] * v0[2] + v0[3] * v0[3]) + (v1[0] * v1[0] + v1[1] * v1[1]) + (v1[2] * v1[2] + v1[3] * v1[3]); }
                    u32x4 w; w.x = cvt_pk_bf16(v0[0], v0[1]); w.y = cvt_pk_bf16(v0[2], v0[3]); w.z = cvt_pk_bf16(v1[0], v1[1]); w.w = cvt_pk_bf16(v1[2], v1[3]);
                    *(u32x4*)(rowp + bj * HALF) = w; }
                if (STATS) { s1 += __shfl_xor(s1, 16); s1 += __shfl_xor(s1, 32); s2 += __shfl_xor(s2, 16); s2 += __shfl_xor(s2, 32);
                    if (u.pn >= stat_pn0 && fq == 0) *(f32x2*)(vst + (size_t)row * SSQ_STRIDE + ((u.pn - stat_pn0) * 4 + wc) * 2) = (f32x2){s1, s2}; }
            }
    }
};
struct EpiRes {
    static constexpr bool PERM = false, AFTER_DRAIN = false;
    const float* base; float* out; bf16_t* xb; float* ssq;
    __device__ __forceinline__ void operator()(const f32x4 (&acc)[2][2][4][2], const Unit& u, int wr, int wc, int fr, int fq) const {
        const int row0 = u.pm * BM + wr * 64 + fr, col0 = u.pn * BM + wc * 32 + 4 * fq;
#pragma unroll
        for (int ai = 0; ai < 2; ++ai)
#pragma unroll
            for (int m = 0; m < 4; ++m) { const int row = row0 + ai * HALF + m * 16; const size_t off = (size_t)row * 2048 + col0; float ss = 0.f;
#pragma unroll
                for (int bj = 0; bj < 2; ++bj)
#pragma unroll
                    for (int n = 0; n < 2; ++n) { const f32x4 o = *(const f32x4*)(base + off + bj * HALF + n * 16) + acc[ai][bj][m][n];
                        *(f32x4*)(out + off + bj * HALF + n * 16) = o; ss += (o[0] * o[0] + o[1] * o[1]) + (o[2] * o[2] + o[3] * o[3]);
                        u32x2 w; w.x = cvt_pk_bf16(o[0], o[1]); w.y = cvt_pk_bf16(o[2], o[3]); *(u32x2*)(xb + off + bj * HALF + n * 16) = w; }
                ss += __shfl_xor(ss, 16); ss += __shfl_xor(ss, 32);
                if (fq == 0) ssq[(size_t)row * SSQ_STRIDE + u.pn * 4 + wc] = ss;
                asm volatile("" ::: "memory"); }
    }
};
struct EpiGlu {
    static constexpr bool PERM = false, AFTER_DRAIN = false;
    const float* base; float* out; bf16_t* xb; float* ssq; const float* bias;
    __device__ __forceinline__ void operator()(const f32x4 (&acc)[2][2][4][2], const Unit& u, int wr, int wc, int fr, int fq) const {
        const int row0 = u.pm * BM + wr * 64 + fr, col0 = u.pn * 128 + wc * 16 + 4 * fq;
        f32x4 bval[2], bgate[2];
#pragma unroll
        for (int bj = 0; bj < 2; ++bj) { bval[bj] = *(const f32x4*)(bias + col0 + bj * 64); bgate[bj] = *(const f32x4*)(bias + 2048 + col0 + bj * 64); }
#pragma unroll
        for (int ai = 0; ai < 2; ++ai)
#pragma unroll
            for (int m = 0; m < 4; ++m) { const int row = row0 + ai * HALF + m * 16; const size_t off = (size_t)row * 2048 + col0; float ss = 0.f;
#pragma unroll
                for (int bj = 0; bj < 2; ++bj) { const f32x4 val = acc[ai][bj][m][0] + bval[bj], gate = acc[ai][bj][m][1] + bgate[bj]; f32x4 o = *(const f32x4*)(base + off + bj * 64);
#pragma unroll
                    for (int j = 0; j < 4; ++j) { const float sg = __builtin_amdgcn_rcpf(1.0f + __builtin_amdgcn_exp2f(-1.4426950408889634f * gate[j])); o[j] += val[j] * sg; }
                    *(f32x4*)(out + off + bj * 64) = o; ss += (o[0] * o[0] + o[1] * o[1]) + (o[2] * o[2] + o[3] * o[3]);
                    u32x2 w; w.x = cvt_pk_bf16(o[0], o[1]); w.y = cvt_pk_bf16(o[2], o[3]); *(u32x2*)(xb + off + bj * 64) = w; }
                ss += __shfl_xor(ss, 16); ss += __shfl_xor(ss, 32);
                if (fq == 0) ssq[(size_t)row * SSQ_STRIDE + u.pn * 4 + wc] = ss;
                asm volatile("" ::: "memory"); }
    }
};
__host__ __device__ __forceinline__ int vt_pos(int key) { const int s = key >> 5, w = key & 31; return 32 * s + 8 * ((w & 15) >> 2) + (w & 3) + 4 * (w >> 4); }
struct EpiKV {
    static constexpr bool PERM = true, AFTER_DRAIN = false;
    bf16_t* Kb; bf16_t* Vb; bf16_t* VTb; const float* ssq;
    __device__ __forceinline__ void operator()(const f32x4 (&acc)[2][2][4][2], const Unit& u, int wr, int wc, int fr, int fq) const {
        const int row0 = u.pm * BM + wr * 64 + fr, col0 = u.pn * BM + wc * 32 + 8 * fq;
#pragma unroll
        for (int ai = 0; ai < 2; ++ai)
#pragma unroll
            for (int m = 0; m < 4; ++m) { const int row = row0 + ai * HALF + m * 16; const float rs = row_rstd(ssq, 32, row, fq); const int b = row >> 8, key = row & 255;
#pragma unroll
                for (int bj = 0; bj < 2; ++bj) { const f32x4 v0 = acc[ai][bj][m][0] * rs, v1 = acc[ai][bj][m][1] * rs; const int col = col0 + bj * HALF;
                    u32x4 w; w.x = cvt_pk_bf16(v0[0], v0[1]); w.y = cvt_pk_bf16(v0[2], v0[3]); w.z = cvt_pk_bf16(v1[0], v1[1]); w.w = cvt_pk_bf16(v1[2], v1[3]);
                    if (col < 2048) { const int h = col >> 9, d = col & 511; *(u32x4*)(Kb + ((size_t)((b * 4 + h) * 256 + key)) * 512 + d) = w; }
                    else { const int c2 = col - 2048, h = c2 >> 9, d = c2 & 511; *(u32x4*)(Vb + ((size_t)((b * 4 + h) * 256 + key)) * 512 + d) = w;
                        bf16_t* vt = VTb + ((size_t)((b * 4 + h) * 512 + d)) * 256 + vt_pos(key);
                        vt[0 * 256] = (bf16_t)(w.x & 0xffffu); vt[1 * 256] = (bf16_t)(w.x >> 16); vt[2 * 256] = (bf16_t)(w.y & 0xffffu); vt[3 * 256] = (bf16_t)(w.y >> 16);
                        vt[4 * 256] = (bf16_t)(w.z & 0xffffu); vt[5 * 256] = (bf16_t)(w.z >> 16); vt[6 * 256] = (bf16_t)(w.w & 0xffffu); vt[7 * 256] = (bf16_t)(w.w >> 16); } }
            }
    }
};
template <class Epi, class Sched, bool ALIGN_EPI = false, bool SP2 = false>
__device__ __forceinline__ void gemm_phase(PG8_LAS unsigned char* lds, const Gemm g, const Sched& S, const Epi& E, const int wid  , const int lane) {
    const int tid = wid * 64 + lane, wr = wid >> 2, wc = wid & 3, fr = lane & 15, fq = lane >> 4;
    const int K = g.K, nt = K / BK;
    unsigned voffA[2], voffB[2];
#pragma unroll
    for (int i = 0; i < 2; ++i) { int R, C; stage_rc(tid * 16 + i * 8192, R, C); const int Rb = Epi::PERM ? ((R & ~31) + perm32(R & 31)) : R;
        voffA[i] = (unsigned)(R * K + C) * 2u; voffB[i] = (unsigned)(Rb * K + C) * 2u; }
    const size_t kstep = (size_t)(BK * 2);
    const size_t hstep = (size_t)HALF * K * 2;
    const size_t tstep = 2 * hstep;
    const unsigned ldsw = (unsigned)wid * 1024u;
    const int aoff = lds_byte(wr * 64 + fr, fq * 8), boff = lds_byte(wc * 32 + fr, fq * 8);
#define PG8_SA(b, h) (((b) * 2 + (h)) * HTB)
#define PG8_SB(b, h) ((4 + (b) * 2 + (h)) * HTB)
#define PG8_STAGE(bufoff, gbase, voff) do { _Pragma("unroll") for (int _i = 0; _i < 2; ++_i) \
        __builtin_amdgcn_global_load_lds((const unsigned*)((const char*)(gbase) + (voff)[_i]), (PG8_LAS unsigned*)(lds + (bufoff) + ldsw + _i * 8192), 16, 0, 0); } while (0)
#define PG8_LDA(dst, b, h) do { _Pragma("unroll") for (int m = 0; m < 4; ++m) _Pragma("unroll") for (int k = 0; k < 2; ++k) dst[m][k] = *(const PG8_LAS bf16x8*)(lds + PG8_SA(b, h) + aoff + m * 2048 + k * 1024); } while (0)
#define PG8_LDB(dst, b, h) do { _Pragma("unroll") for (int n = 0; n < 2; ++n) _Pragma("unroll") for (int k = 0; k < 2; ++k) dst[n][k] = *(const PG8_LAS bf16x8*)(lds + PG8_SB(b, h) + boff + n * 2048 + k * 1024); } while (0)
#define PG8_MMA(ai, bj, At, Bt) do { __builtin_amdgcn_s_setprio(1); _Pragma("unroll") for (int m = 0; m < 4; ++m) _Pragma("unroll") for (int n = 0; n < 2; ++n) _Pragma("unroll") for (int k = 0; k < 2; ++k) \
        acc[ai][bj][m][n] = __builtin_amdgcn_mfma_f32_16x16x32_bf16(Bt[n][k], At[m][k], acc[ai][bj][m][n], 0, 0, 0); __builtin_amdgcn_s_setprio(0); } while (0)
#define PG8_WAIT_V(n) asm volatile("s_waitcnt vmcnt(" #n ")" ::: "memory")
#define PG8_WAIT_L(n) asm volatile("s_waitcnt lgkmcnt(" #n ")" ::: "memory")
#define PG8_BAR __builtin_amdgcn_s_barrier()
#define PG8_SCHED __builtin_amdgcn_sched_barrier(0)
    Unit cur, nxt; int ui = 0;
    if (!S.next(0, cur)) return;
    f32x4 acc[2][2][4][2];
#pragma unroll
    for (int a = 0; a < 2; ++a)
#pragma unroll
        for (int b = 0; b < 2; ++b)
#pragma unroll
            for (int m = 0; m < 4; ++m)
#pragma unroll
                for (int n = 0; n < 2; ++n) acc[a][b][m][n] = (f32x4){0.f, 0.f, 0.f, 0.f};
    bf16x8 At[4][2], B0[2][2], B1[2][2];
    const char* cA = (const char*)g.A + (size_t)cur.pm * tstep; const char* cB = (const char*)g.Bt + (size_t)cur.pn * tstep;
    S.a_ready(cur);
    if constexpr (SP2) {
        PG8_STAGE(PG8_SB(0, 0), cB, voffB); PG8_STAGE(PG8_SB(0, 1), cB + hstep, voffB); PG8_STAGE(PG8_SA(0, 0), cA, voffA); PG8_STAGE(PG8_SA(0, 1), cA + hstep, voffA);
        if (wr == 1) PG8_BAR;
        PG8_WAIT_V(2); PG8_BAR;
        PG8_STAGE(PG8_SB(1, 0), cB + kstep, voffB); PG8_STAGE(PG8_SA(1, 0), cA + kstep, voffA); PG8_STAGE(PG8_SB(1, 1), cB + hstep + kstep, voffB);
        PG8_WAIT_V(6); PG8_BAR;
    } else {
        PG8_STAGE(PG8_SB(0, 0), cB, voffB); PG8_STAGE(PG8_SA(0, 0), cA, voffA); PG8_STAGE(PG8_SB(0, 1), cB + hstep, voffB); PG8_STAGE(PG8_SA(0, 1), cA + hstep, voffA);
        if (wr == 1) PG8_BAR;
        PG8_WAIT_V(4); PG8_BAR;
        PG8_STAGE(PG8_SB(1, 0), cB + kstep, voffB); PG8_STAGE(PG8_SA(1, 0), cA + kstep, voffA); PG8_STAGE(PG8_SB(1, 1), cB + hstep + kstep, voffB);
        PG8_WAIT_V(6); PG8_BAR;
    }
    for (;;) {
        const bool has_next = S.next(ui + 1, nxt);
        const char* nA = has_next ? (const char*)g.A + (size_t)nxt.pm * tstep : cA; const char* nB = has_next ? (const char*)g.Bt + (size_t)nxt.pn * tstep : cB;
        for (int t = 0; t < nt; t += 2) {
            const bool last = (t == nt - 2);
            const char* a1 = cA + (size_t)(t + 1) * kstep;
            const char* a2 = last ? nA : cA + (size_t)(t + 2) * kstep; const char* b2 = last ? nB : cB + (size_t)(t + 2) * kstep;
            const char* a3 = a2 + kstep; const char* b3 = b2 + kstep;
            if (last && has_next) S.a_ready(nxt);
            if constexpr (SP2) {
            PG8_LDB(B0, 0, 0); PG8_LDB(B1, 0, 1); PG8_SCHED; PG8_LDA(At, 0, 0); PG8_STAGE(PG8_SA(1, 1), a1 + hstep, voffA);
            PG8_WAIT_V(8); PG8_WAIT_L(0); PG8_BAR; PG8_MMA(0, 0, At, B0); PG8_MMA(0, 1, At, B1); PG8_BAR; PG8_SCHED;
            PG8_LDA(At, 0, 1); PG8_STAGE(PG8_SB(0, 0), b2, voffB); PG8_STAGE(PG8_SB(0, 1), b2 + hstep, voffB); PG8_STAGE(PG8_SA(0, 0), a2, voffA);
            PG8_WAIT_V(8); PG8_WAIT_L(0); PG8_BAR; PG8_MMA(1, 0, At, B0); PG8_MMA(1, 1, At, B1); PG8_BAR; PG8_SCHED;
            PG8_LDB(B0, 1, 0); PG8_LDB(B1, 1, 1); PG8_SCHED; PG8_LDA(At, 1, 0); PG8_STAGE(PG8_SA(0, 1), a2 + hstep, voffA);
            PG8_WAIT_V(8); PG8_WAIT_L(0); PG8_BAR; PG8_MMA(0, 0, At, B0); PG8_MMA(0, 1, At, B1); PG8_BAR; PG8_SCHED;
            PG8_LDA(At, 1, 1); PG8_STAGE(PG8_SB(1, 0), b3, voffB); PG8_STAGE(PG8_SB(1, 1), b3 + hstep, voffB); PG8_STAGE(PG8_SA(1, 0), a3, voffA);
            PG8_WAIT_V(8); PG8_WAIT_L(0); PG8_BAR; PG8_MMA(1, 0, At, B0); PG8_MMA(1, 1, At, B1); PG8_BAR; PG8_SCHED;
            } else {
            PG8_LDB(B0, 0, 0); PG8_SCHED; PG8_LDA(At, 0, 0); PG8_STAGE(PG8_SA(1, 1), a1 + hstep, voffA);
            PG8_WAIT_L(8); PG8_BAR; PG8_WAIT_L(0); PG8_MMA(0, 0, At, B0); PG8_BAR; PG8_SCHED;
            PG8_LDB(B1, 0, 1); PG8_STAGE(PG8_SB(0, 0), b2, voffB);
            PG8_BAR; PG8_WAIT_L(0); PG8_MMA(0, 1, At, B1); PG8_BAR;
            PG8_LDA(At, 0, 1); PG8_STAGE(PG8_SA(0, 0), a2, voffA);
            PG8_BAR; PG8_WAIT_L(0); PG8_MMA(1, 0, At, B0); PG8_BAR; PG8_SCHED;
            PG8_STAGE(PG8_SB(0, 1), b2 + hstep, voffB);
            PG8_WAIT_V(6); PG8_BAR; PG8_MMA(1, 1, At, B1); PG8_BAR;
            PG8_LDB(B0, 1, 0); PG8_SCHED; PG8_LDA(At, 1, 0); PG8_STAGE(PG8_SA(0, 1), a2 + hstep, voffA);
            PG8_WAIT_L(8); PG8_BAR; PG8_WAIT_L(0); PG8_MMA(0, 0, At, B0); PG8_BAR; PG8_SCHED;
            PG8_LDB(B1, 1, 1); PG8_STAGE(PG8_SB(1, 0), b3, voffB);
            PG8_BAR; PG8_WAIT_L(0); PG8_MMA(0, 1, At, B1); PG8_BAR;
            PG8_LDA(At, 1, 1); PG8_STAGE(PG8_SA(1, 0), a3, voffA);
            PG8_BAR; PG8_WAIT_L(0); PG8_MMA(1, 0, At, B0); PG8_BAR; PG8_SCHED;
            PG8_STAGE(PG8_SB(1, 1), b3 + hstep, voffB);
            PG8_WAIT_V(6); PG8_BAR; PG8_MMA(1, 1, At, B1); PG8_BAR;
            }
        }
        if constexpr (ALIGN_EPI) { if (wr == 0) PG8_BAR; }
        if constexpr (!Epi::AFTER_DRAIN) { Unit ue = cur; asm volatile("" : "+s"(ue.pm), "+s"(ue.pn));
            E(acc, ue, wr, wc, fr, fq); S.done(cur); }
        if (!has_next) break;
#pragma unroll
        for (int a = 0; a < 2; ++a)
#pragma unroll
            for (int b = 0; b < 2; ++b)
#pragma unroll
                for (int m = 0; m < 4; ++m)
#pragma unroll
                    for (int n = 0; n < 2; ++n) acc[a][b][m][n] = (f32x4){0.f, 0.f, 0.f, 0.f};
        cur = nxt; cA = nA; cB = nB; ++ui;
        if constexpr (ALIGN_EPI) { if (wr == 1) PG8_BAR; }
    }
    PG8_WAIT_V(0);
    if constexpr (!ALIGN_EPI) { if (wr == 0) PG8_BAR; }
    PG8_BAR;
    if constexpr (Epi::AFTER_DRAIN) { E.fused(acc, cur, wr, wc, fr, fq, lds, wid, lane); S.done(cur); }
#undef PG8_SA
#undef PG8_SB
#undef PG8_STAGE
#undef PG8_LDA
#undef PG8_LDB
#undef PG8_MMA
#undef PG8_WAIT_V
#undef PG8_WAIT_L
#undef PG8_BAR
#undef PG8_SCHED
}
}
#ifndef MK_N_LAUNCHES
#define MK_N_LAUNCHES 1
#endif
constexpr int BATCH = 2, SEQ = 4096, D = 2048, M = BATCH * SEQ, MEMLEN = 256, MROWS = BATCH * MEMLEN, FF = 8192;
constexpr int NWAVES = 8, NTHREADS = 512, NPH = 20;
constexpr int LDS_BYTES = 147456;
constexpr size_t MiB = 1u << 20;
constexpr size_t WS_W_AIN = 2 * MiB, WS_W_AOUT = 18 * MiB, WS_W_BIN = 26 * MiB, WS_W_BOUT = 34 * MiB, WS_W_Q = 50 * MiB, WS_W_KV = 66 * MiB, WS_W_O = 98 * MiB, WS_W_UP = 114 * MiB, WS_W_DN = 178 * MiB;
constexpr size_t WS_XB = 242 * MiB, WS_MEMB = 274 * MiB, WS_KB = 276 * MiB, WS_VB = 280 * MiB, WS_VTB = 284 * MiB, WS_SSQ = 288 * MiB, WS_VST = 290 * MiB, WS_SSQM = 292 * MiB, WS_S5ST = 294 * MiB;
constexpr size_t WS_R = 304 * MiB, WS_END = 432 * MiB;
#define GAS __attribute__((address_space(1)))
#define LAS __attribute__((address_space(3)))
typedef unsigned short bf16;
typedef unsigned v4u __attribute__((ext_vector_type(4)));
typedef unsigned v2u __attribute__((ext_vector_type(2)));
typedef float f32x4 __attribute__((ext_vector_type(4)));
typedef float f32x2 __attribute__((ext_vector_type(2)));
typedef short bf16x8 __attribute__((ext_vector_type(8)));
#define LDS_WAIT() asm volatile("s_waitcnt lgkmcnt(0)" ::: "memory")
__device__ __forceinline__ unsigned f2bf(float f) { unsigned u = __builtin_bit_cast(unsigned, f); return (u + 0x7fffu + ((u >> 16) & 1u)) >> 16; }
__device__ __forceinline__ unsigned pk2(float lo, float hi) { return f2bf(lo) | (f2bf(hi) << 16); }
__device__ __forceinline__ float bflo(unsigned w) { return __builtin_bit_cast(float, w << 16); }
__device__ __forceinline__ float bfhi(unsigned w) { return __builtin_bit_cast(float, w & 0xffff0000u); }
__device__ __forceinline__ float wave_sum(float v) {
#pragma unroll
    for (int o = 1; o < 64; o <<= 1) v += __shfl_xor(v, o);
    return v;
}
__device__ __forceinline__ float wave_max(float v) {
#pragma unroll
    for (int o = 1; o < 64; o <<= 1) v = fmaxf(v, __shfl_xor(v, o));
    return v;
}
__device__ __forceinline__ float gelu_exact(float v) { return 0.5f * v * (1.0f + erff(v * 0.70710678118654752f)); }

struct Args { const float* in[30]; float* out; unsigned char* ws; int ph_lo, ph_hi; };
__device__ __forceinline__ const float* ka_in(int i) { const __attribute__((address_space(4))) char* ka = (const __attribute__((address_space(4))) char*)__builtin_amdgcn_kernarg_segment_ptr(); asm volatile("" : "+s"(ka)); return *(const float* const __attribute__((address_space(4)))*)(ka + 8 * i); }

__device__ __forceinline__ int glu_rowmap(int n) { return n < 2048 ? 32 * (n >> 4) + (n & 15) : 32 * ((n - 2048) >> 4) + 16 + (n & 15); }
__device__ __forceinline__ void conv_item(const float* W, int K, int N, const float* gk, int mode, bf16* WT, LAS float* scr, int item, int lane) {
    const int nblk = N >> 6, kb = item / nblk, nb = item - kb * nblk, k0 = 64 * kb, n0 = 64 * nb;
    f32x4 v[16];
#pragma unroll
    for (int i = 0; i < 16; ++i) { const int kk = 4 * i + (lane >> 4); v[i] = *(const f32x4*)(W + (size_t)(k0 + kk) * N + n0 + 4 * (lane & 15)); }
#pragma unroll
    for (int i = 0; i < 16; ++i) { const int kk = 4 * i + (lane >> 4); const float s = gk ? gk[k0 + kk] : 1.0f; LAS float* d = scr + kk * 65 + 4 * (lane & 15);
        d[0] = v[i][0] * s; d[1] = v[i][1] * s; d[2] = v[i][2] * s; d[3] = v[i][3] * s; }
    LDS_WAIT();
    const int c = lane & 7;
#pragma unroll
    for (int j = 0; j < 8; ++j) { const int n = (lane >> 3) + 8 * j; const LAS float* s = scr + (8 * c) * 65 + n;
        v4u o; o.x = pk2(s[0 * 65], s[1 * 65]); o.y = pk2(s[2 * 65], s[3 * 65]); o.z = pk2(s[4 * 65], s[5 * 65]); o.w = pk2(s[6 * 65], s[7 * 65]);
        const int nr = mode ? glu_rowmap(n0 + n) : (n0 + n);
        *(v4u*)(WT + (size_t)nr * K + k0 + 8 * c) = o; }
    LDS_WAIT();
}
__device__ __forceinline__ void row_to_bf16(const float* xrow, bf16* orow, float* ssqrow, int lane) {
    f32x4 v[8]; float s = 0.f;
#pragma unroll
    for (int j = 0; j < 8; ++j) { v[j] = ((const f32x4*)xrow)[lane + 64 * j]; s += (v[j][0] * v[j][0] + v[j][1] * v[j][1]) + (v[j][2] * v[j][2] + v[j][3] * v[j][3]); }
    s = wave_sum(s);
#pragma unroll
    for (int j = 0; j < 8; ++j) { v2u w; w.x = pk2(v[j][0], v[j][1]); w.y = pk2(v[j][2], v[j][3]); ((v2u*)orow)[lane + 64 * j] = w; }
    if (lane < 32) ssqrow[lane] = (lane == 0) ? s : 0.f;
}
__device__ __forceinline__ void p0_prologue(unsigned char* ws, LAS unsigned char* lds, int wave, int lane) {
    LAS float* scr = (LAS float*)(lds + wave * 16640);
    const int gw = blockIdx.x * NWAVES + wave, NGW = gridDim.x * NWAVES;
    constexpr int NITEMS = 30720;
    for (int it0 = gw; it0 < NITEMS; it0 += NGW) {
        int r = __builtin_amdgcn_readfirstlane(it0);
        const float* W; const float* g = nullptr; bf16* WT; int K = 2048, N = 2048, mode = 0;
        if (r < 2048) { W = ka_in(7); g = ka_in(2); WT = (bf16*)(ws + WS_W_AIN); N = 4096; }
        else if ((r -= 2048) < 1024) { W = ka_in(13); WT = (bf16*)(ws + WS_W_AOUT); }
        else if ((r -= 1024) < 1024) { W = ka_in(14); g = ka_in(2) + 2048; WT = (bf16*)(ws + WS_W_BIN); }
        else if ((r -= 1024) < 2048) { W = ka_in(23); WT = (bf16*)(ws + WS_W_BOUT); N = 4096; mode = 1; }
        else if ((r -= 2048) < 2048) { const int i = r >> 10; r &= 1023; W = ka_in(25) + (size_t)i * 2048 * 2048; g = ka_in(3) + i * 2048; WT = (bf16*)(ws + WS_W_Q + i * 8 * MiB); }
        else if ((r -= 2048) < 4096) { const int i = r >> 11; r &= 2047; W = ka_in(26) + (size_t)i * 2048 * 4096; g = ka_in(4) + i * 2048; WT = (bf16*)(ws + WS_W_KV + i * 16 * MiB); N = 4096; }
        else if ((r -= 4096) < 2048) { const int i = r >> 10; r &= 1023; W = ka_in(27) + (size_t)i * 2048 * 2048; WT = (bf16*)(ws + WS_W_O + i * 8 * MiB); }
        else if ((r -= 2048) < 8192) { const int i = r >> 12; r &= 4095; W = ka_in(28) + (size_t)i * 2048 * 8192; g = ka_in(5) + i * 2048; WT = (bf16*)(ws + WS_W_UP + i * 32 * MiB); N = 8192; }
        else { r -= 8192; const int i = r >> 12; r &= 4095; W = ka_in(29) + (size_t)i * 8192 * 2048; WT = (bf16*)(ws + WS_W_DN + i * 32 * MiB); K = 8192; }
        conv_item(W, K, N, g, mode, WT, scr, r, lane);
    }
    for (int m = gw; m < M + MROWS; m += NGW) {
        if (m < M) row_to_bf16(ka_in(0) + (size_t)m * D, (bf16*)(ws + WS_XB) + (size_t)m * D, (float*)(ws + WS_SSQ) + (size_t)m * 64, lane);
        else { const int r = m - M; row_to_bf16(ka_in(1) + (size_t)r * D, (bf16*)(ws + WS_MEMB) + (size_t)r * D, (float*)(ws + WS_SSQM) + (size_t)r * 64, lane); }
    }
}
__device__ __forceinline__ void final_norm(float* x, const float* g, int wave, int lane) {
    const int gw = blockIdx.x * NWAVES + wave, NGW = gridDim.x * NWAVES;
    for (int m = gw; m < M; m += NGW) { f32x4* xr = (f32x4*)(x + (size_t)m * D); f32x4 v[8]; float s = 0.f;
#pragma unroll
        for (int j = 0; j < 8; ++j) { v[j] = xr[lane + 64 * j]; s += (v[j][0] * v[j][0] + v[j][1] * v[j][1]) + (v[j][2] * v[j][2] + v[j][3] * v[j][3]); }
        const float rs = 1.0f / sqrtf(wave_sum(s) * (1.0f / D) + 1e-6f);
#pragma unroll
        for (int j = 0; j < 8; ++j) { const f32x4 gv = ((const f32x4*)g)[lane + 64 * j]; xr[lane + 64 * j] = v[j] * rs * gv; } }
}
__device__ __forceinline__ void gating_simple(LAS unsigned char* lds, const bf16* z, const float* vst, const float* ln_g, const float* ln_b, const float* w_s, const float* b_s, bf16* gbuf, int tid) {
    LAS float* vln = (LAS float*)lds;
    LAS float* Wl = (LAS float*)(lds + 65536);
    LAS float* mu = (LAS float*)(lds + 65536 + 128 * 129 * 4);
    LAS float* rsd = mu + 128;
    for (int unit = blockIdx.x; unit < 1024; unit += gridDim.x) {
        const int h = unit & 15, tok0 = (unit >> 4) * 128;
        if (tid < 128) { const float* p = vst + (size_t)(tok0 + tid) * 64; float s1 = 0.f, s2 = 0.f;
#pragma unroll 8
            for (int i = 0; i < 32; ++i) { s1 += p[2 * i]; s2 += p[2 * i + 1]; }
            const float mean = s1 * (1.0f / 2048.0f), var = s2 * (1.0f / 2048.0f) - mean * mean; mu[tid] = mean; rsd[tid] = 1.0f / sqrtf(var + 1e-6f); }
        __syncthreads();
        { const int s = tid >> 2, db = (tid & 3) * 32; const float mean = mu[s], rs = rsd[s];
            const bf16* vp = z + (size_t)(tok0 + s) * 4096 + 2048 + h * 128 + db;
#pragma unroll
            for (int q = 0; q < 4; ++q) { const v4u w = *(const v4u*)(vp + 8 * q); const float* gp = ln_g + h * 128 + db + 8 * q; const float* bp = ln_b + h * 128 + db + 8 * q; LAS float* o = vln + s * 128 + db + 8 * q;
                o[0] = (bflo(w.x) - mean) * rs * gp[0] + bp[0]; o[1] = (bfhi(w.x) - mean) * rs * gp[1] + bp[1]; o[2] = (bflo(w.y) - mean) * rs * gp[2] + bp[2]; o[3] = (bfhi(w.y) - mean) * rs * gp[3] + bp[3];
                o[4] = (bflo(w.z) - mean) * rs * gp[4] + bp[4]; o[5] = (bfhi(w.z) - mean) * rs * gp[5] + bp[5]; o[6] = (bflo(w.w) - mean) * rs * gp[6] + bp[6]; o[7] = (bfhi(w.w) - mean) * rs * gp[7] + bp[7]; }
            const float* wp = w_s + ((size_t)h * 128 + s) * 128 + db;
#pragma unroll
            for (int q = 0; q < 8; ++q) { const f32x4 w4 = *(const f32x4*)(wp + 4 * q); LAS float* o = Wl + s * 129 + db + 4 * q; o[0] = w4[0]; o[1] = w4[1]; o[2] = w4[2]; o[3] = w4[3]; } }
        __syncthreads();
        { const int t = tid >> 2, d0 = (tid & 3) * 32, tmax = t | 15; float acc[32];
#pragma unroll
            for (int j = 0; j < 32; ++j) acc[j] = 0.f;
            for (int s = 0; s <= tmax; ++s) { const float w = (s <= t) ? Wl[t * 129 + s] : 0.f; const LAS f32x4* vr = (const LAS f32x4*)(vln + s * 128 + d0);
#pragma unroll
                for (int q = 0; q < 8; ++q) { const f32x4 vv = vr[q]; acc[4 * q] += w * vv[0]; acc[4 * q + 1] += w * vv[1]; acc[4 * q + 2] += w * vv[2]; acc[4 * q + 3] += w * vv[3]; } }
            const float bs = b_s[h * 128 + t];
            const bf16* up = z + (size_t)(tok0 + t) * 4096 + h * 128 + d0; bf16* op = gbuf + (size_t)(tok0 + t) * 2048 + h * 128 + d0;
#pragma unroll
            for (int q = 0; q < 4; ++q) { const v4u w = *(const v4u*)(up + 8 * q); v4u o;
                o.x = pk2(bflo(w.x) * (acc[8 * q] + bs), bfhi(w.x) * (acc[8 * q + 1] + bs)); o.y = pk2(bflo(w.y) * (acc[8 * q + 2] + bs), bfhi(w.y) * (acc[8 * q + 3] + bs));
                o.z = pk2(bflo(w.z) * (acc[8 * q + 4] + bs), bfhi(w.z) * (acc[8 * q + 5] + bs)); o.w = pk2(bflo(w.w) * (acc[8 * q + 6] + bs), bfhi(w.w) * (acc[8 * q + 7] + bs));
                *(v4u*)(op + 8 * q) = o; } }
        __syncthreads();
    }
}
__device__ __forceinline__ void gating_mfma(LAS unsigned char* lds, const bf16* z, const float* vst, const float* ln_g, const float* ln_b, const float* w_s, const float* b_s, bf16* gbuf, int wave, int lane) {
    LAS float* MU = (LAS float*)(lds + 69632);
    const int tid = wave * 64 + lane, fr = lane & 15, fq = lane >> 4;
    const int ss = tid >> 2, db = (tid & 3) * 32;
    for (int unit = blockIdx.x; unit < 256; unit += gridDim.x) {
        const int tok0 = (unit >> 2) * 128, hg = unit & 3;
        __syncthreads();
        if (tid < 128) { const float* sp = vst + (size_t)(tok0 + tid) * 64; float s1 = 0.f, s2 = 0.f;
#pragma unroll
            for (int i = 0; i < 16; ++i) { const f32x4 a = *(const f32x4*)(sp + 4 * i); s1 += a[0] + a[2]; s2 += a[1] + a[3]; }
            const float mean = s1 * (1.0f / 2048.0f), var = s2 * (1.0f / 2048.0f) - mean * mean; MU[tid] = mean; MU[128 + tid] = 1.0f / sqrtf(var + 1e-6f); }
        v4u raw[4];
        { const bf16* vp = z + (size_t)(tok0 + ss) * 4096 + 2048 + (hg * 4) * 128 + db;
#pragma unroll
            for (int q4 = 0; q4 < 4; ++q4) raw[q4] = *(const v4u*)(vp + 8 * q4); }
        __syncthreads();
        const float mean = MU[ss], rs = MU[128 + ss];
#pragma unroll 1
        for (int hh = 0; hh < 4; ++hh) { const int h = hg * 4 + hh; LAS unsigned char* VT = lds + (hh & 1) * 34816;
            { const float* gp = ln_g + h * 128 + db; const float* bp = ln_b + h * 128 + db; LAS unsigned char* wp = VT + db * 272 + ss * 2;
#pragma unroll
                for (int q4 = 0; q4 < 4; ++q4) { const f32x4 g0 = *(const f32x4*)(gp + 8 * q4), g1 = *(const f32x4*)(gp + 8 * q4 + 4), b0 = *(const f32x4*)(bp + 8 * q4), b1 = *(const f32x4*)(bp + 8 * q4 + 4); const v4u w = raw[q4];
                    const float v0 = (bflo(w.x) - mean) * rs * g0[0] + b0[0], v1 = (bfhi(w.x) - mean) * rs * g0[1] + b0[1], v2 = (bflo(w.y) - mean) * rs * g0[2] + b0[2], v3 = (bfhi(w.y) - mean) * rs * g0[3] + b0[3];
                    const float v4 = (bflo(w.z) - mean) * rs * g1[0] + b1[0], v5 = (bfhi(w.z) - mean) * rs * g1[1] + b1[1], v6 = (bflo(w.w) - mean) * rs * g1[2] + b1[2], v7 = (bfhi(w.w) - mean) * rs * g1[3] + b1[3];
                    LAS unsigned char* o = wp + (8 * q4) * 272;
                    *(LAS bf16*)(o + 0 * 272) = (bf16)f2bf(v0); *(LAS bf16*)(o + 1 * 272) = (bf16)f2bf(v1); *(LAS bf16*)(o + 2 * 272) = (bf16)f2bf(v2); *(LAS bf16*)(o + 3 * 272) = (bf16)f2bf(v3);
                    *(LAS bf16*)(o + 4 * 272) = (bf16)f2bf(v4); *(LAS bf16*)(o + 5 * 272) = (bf16)f2bf(v5); *(LAS bf16*)(o + 6 * 272) = (bf16)f2bf(v6); *(LAS bf16*)(o + 7 * 272) = (bf16)f2bf(v7); } }
            if (hh < 3) { const bf16* vp = z + (size_t)(tok0 + ss) * 4096 + 2048 + (h + 1) * 128 + db;
#pragma unroll
                for (int q4 = 0; q4 < 4; ++q4) raw[q4] = *(const v4u*)(vp + 8 * q4); }
            __syncthreads();
            const int t = 16 * wave + fr, nks = (wave >> 1) + 1;
            bf16x8 wf[4];
#pragma unroll
            for (int ks = 0; ks < 4; ++ks) { wf[ks] = (bf16x8){0, 0, 0, 0, 0, 0, 0, 0};
                if (ks < nks) { const float* wp = w_s + ((size_t)h * 128 + t) * 128 + 32 * ks + 8 * fq; const f32x4 a = *(const f32x4*)wp, c = *(const f32x4*)(wp + 4); const int s0 = 32 * ks + 8 * fq;
                    float v[8] = {a[0], a[1], a[2], a[3], c[0], c[1], c[2], c[3]};
#pragma unroll
                    for (int j = 0; j < 8; ++j) v[j] = (s0 + j <= t) ? v[j] : 0.f;
                    v4u w; w.x = pk2(v[0], v[1]); w.y = pk2(v[2], v[3]); w.z = pk2(v[4], v[5]); w.w = pk2(v[6], v[7]); wf[ks] = __builtin_bit_cast(bf16x8, w); } }
            const float bs = b_s[h * 128 + t];
            const bf16* up = z + (size_t)(tok0 + t) * 4096 + h * 128 + 4 * fq; bf16* op = gbuf + (size_t)(tok0 + t) * 2048 + h * 128 + 4 * fq;
            const LAS unsigned char* ab = VT + fr * 272 + fq * 16;
#pragma unroll
            for (int df = 0; df < 8; ++df) { f32x4 acc = (f32x4){0.f, 0.f, 0.f, 0.f};
#pragma unroll
                for (int ks = 0; ks < 4; ++ks) if (ks < nks) { const bf16x8 a = *(const LAS bf16x8*)(ab + df * 16 * 272 + ks * 64); acc = __builtin_amdgcn_mfma_f32_16x16x32_bf16(a, wf[ks], acc, 0, 0, 0); }
                const v2u uw = *(const v2u*)(up + 16 * df); v2u ow;
                ow.x = pg8::cvt_pk_bf16(bflo(uw.x) * (acc[0] + bs), bfhi(uw.x) * (acc[1] + bs)); ow.y = pg8::cvt_pk_bf16(bflo(uw.y) * (acc[2] + bs), bfhi(uw.y) * (acc[3] + bs));
                *(v2u*)(op + 16 * df) = ow; }
        }
    }
    __syncthreads();
}
__device__ __forceinline__ void attn_simple(LAS unsigned char* lds, const bf16* q, const bf16* Kb, const bf16* Vb, bf16* obuf, int wave, int lane) {
    LAS float* pl = (LAS float*)(lds + wave * 1024);
    const int gw = blockIdx.x * NWAVES + wave, NGW = gridDim.x * NWAVES;
    for (int task = gw; task < BATCH * 4 * SEQ; task += NGW) {
        const int bh = task >> 12, t = task & 4095, b = bh >> 2, h = bh & 3;
        float qf[8]; { const v4u w = *(const v4u*)(q + ((size_t)(b * SEQ + t)) * 2048 + h * 512 + 8 * lane);
            qf[0] = bflo(w.x); qf[1] = bfhi(w.x); qf[2] = bflo(w.y); qf[3] = bfhi(w.y); qf[4] = bflo(w.z); qf[5] = bfhi(w.z); qf[6] = bflo(w.w); qf[7] = bfhi(w.w); }
        const bf16* kp = Kb + (size_t)bh * 256 * 512 + 8 * lane;
        float sc[4];
#pragma unroll
        for (int kk = 0; kk < 4; ++kk) { float mine = 0.f;
            for (int l2 = 0; l2 < 64; ++l2) { const v4u w = *(const v4u*)(kp + (size_t)(kk * 64 + l2) * 512);
                float dsum = qf[0] * bflo(w.x) + qf[1] * bfhi(w.x) + qf[2] * bflo(w.y) + qf[3] * bfhi(w.y) + qf[4] * bflo(w.z) + qf[5] * bfhi(w.z) + qf[6] * bflo(w.w) + qf[7] * bfhi(w.w);
                dsum = wave_sum(dsum); if (lane == l2) mine = dsum; }
            sc[kk] = mine; }
        const float mx = wave_max(fmaxf(fmaxf(sc[0], sc[1]), fmaxf(sc[2], sc[3])));
        float p[4], ps = 0.f;
#pragma unroll
        for (int kk = 0; kk < 4; ++kk) { p[kk] = exp2f(sc[kk] - mx); ps += p[kk]; pl[kk * 64 + lane] = p[kk]; }
        const float inv = 1.0f / wave_sum(ps);
        LDS_WAIT();
        float o[8];
#pragma unroll
        for (int i = 0; i < 8; ++i) o[i] = 0.f;
        const bf16* vp = Vb + (size_t)bh * 256 * 512 + 8 * lane;
        for (int key = 0; key < 256; ++key) { const float pk = pl[key]; const v4u w = *(const v4u*)(vp + (size_t)key * 512);
            o[0] += pk * bflo(w.x); o[1] += pk * bfhi(w.x); o[2] += pk * bflo(w.y); o[3] += pk * bfhi(w.y); o[4] += pk * bflo(w.z); o[5] += pk * bfhi(w.z); o[6] += pk * bflo(w.w); o[7] += pk * bfhi(w.w); }
        v4u ow; ow.x = pk2(o[0] * inv, o[1] * inv); ow.y = pk2(o[2] * inv, o[3] * inv); ow.z = pk2(o[4] * inv, o[5] * inv); ow.w = pk2(o[6] * inv, o[7] * inv);
        *(v4u*)(obuf + ((size_t)(b * SEQ + t)) * 2048 + h * 512 + 8 * lane) = ow;
        LDS_WAIT();
    }
}
__device__ __forceinline__ void attn_mfma(LAS unsigned char* lds, const bf16* q, const bf16* Kb, const bf16* VTb, bf16* obuf, int wave, int lane) {
    const int tid = wave * 64 + lane, fr = lane & 15, fq = lane >> 4;
    unsigned voffK[2], voffV[2];
#pragma unroll
    for (int i = 0; i < 2; ++i) { int R, C; pg8::stage_rc(tid * 16 + i * 8192, R, C); voffK[i] = (unsigned)(R * 512 + C) * 2u; voffV[i] = (unsigned)(R * 256 + C) * 2u; }
    const unsigned ldsw = (unsigned)wave * 1024u;
    const int aoff0 = pg8::lds_byte(fr, fq * 8);
#define AT_STAGE_K(c, buf) do { _Pragma("unroll") for (int ht = 0; ht < 4; ++ht) { const char* src = Kg + ((size_t)(128 * (ht >> 1)) * 512 + 128 * (c) + 64 * (ht & 1)) * 2; \
        _Pragma("unroll") for (int i = 0; i < 2; ++i) __builtin_amdgcn_global_load_lds((const unsigned*)(src + voffK[i]), (LAS unsigned*)(lds + (buf) * 65536 + ht * 16384 + ldsw + i * 8192), 16, 0, 0); } } while (0)
#define AT_STAGE_V(cc, buf) do { _Pragma("unroll") for (int ht = 0; ht < 4; ++ht) { const char* src = Vg + ((size_t)(128 * ht) * 256 + 64 * (cc)) * 2; \
        _Pragma("unroll") for (int i = 0; i < 2; ++i) __builtin_amdgcn_global_load_lds((const unsigned*)(src + voffV[i]), (LAS unsigned*)(lds + (buf) * 65536 + ht * 16384 + ldsw + i * 8192), 16, 0, 0); } } while (0)
#define AT_WAIT() do { asm volatile("s_waitcnt vmcnt(0)" ::: "memory"); __syncthreads(); } while (0)
    for (int unit = blockIdx.x; unit < 256; unit += gridDim.x) {
        const int bh = unit >> 5, qb = unit & 31, b = bh >> 2, h = bh & 3;
        const char* Kg = (const char*)(Kb + (size_t)bh * 256 * 512);
        const char* Vg = (const char*)(VTb + (size_t)bh * 512 * 256);
        const size_t tok = (size_t)(b * SEQ + qb * 128 + 16 * wave + fr);
        bf16x8 qf[16];
        { const bf16* qp = q + tok * 2048 + h * 512 + 8 * fq;
#pragma unroll
            for (int s = 0; s < 16; ++s) qf[s] = *(const bf16x8*)(qp + 32 * s); }
        f32x4 acc[16];
#pragma unroll
        for (int n = 0; n < 16; ++n) acc[n] = (f32x4){0.f, 0.f, 0.f, 0.f};
        AT_STAGE_K(0, 0);
#pragma unroll
        for (int c = 0; c < 4; ++c) {
            AT_WAIT();
            if (c < 3) AT_STAGE_K(c + 1, (c + 1) & 1); else AT_STAGE_V(0, 0);
            const LAS unsigned char* bb = lds + (c & 1) * 65536 + aoff0; asm volatile("" : "+v"(bb));
#pragma unroll
            for (int kh = 0; kh < 2; ++kh)
#pragma unroll
                for (int k = 0; k < 2; ++k)
#pragma unroll
                    for (int ng = 0; ng < 2; ++ng) { bf16x8 a[8];
#pragma unroll
                        for (int n8 = 0; n8 < 8; ++n8) a[n8] = *(const LAS bf16x8*)(bb + (ng * 2 + kh) * 16384 + n8 * 2048 + k * 1024);
#pragma unroll
                        for (int n8 = 0; n8 < 8; ++n8) acc[ng * 8 + n8] = __builtin_amdgcn_mfma_f32_16x16x32_bf16(a[n8], qf[4 * c + 2 * kh + k], acc[ng * 8 + n8], 0, 0, 0);
                        __builtin_amdgcn_sched_barrier(0); }
        }
        float mx = acc[0][0];
#pragma unroll
        for (int n = 0; n < 16; ++n) mx = fmaxf(fmaxf(mx, fmaxf(acc[n][0], acc[n][1])), fmaxf(acc[n][2], acc[n][3]));
        mx = fmaxf(mx, __shfl_xor(mx, 16)); mx = fmaxf(mx, __shfl_xor(mx, 32));
        float l = 0.f;
#pragma unroll
        for (int n = 0; n < 16; ++n)
#pragma unroll
            for (int r = 0; r < 4; ++r) { const float pv = __builtin_amdgcn_exp2f(acc[n][r] - mx); acc[n][r] = pv; l += pv; }
        l += __shfl_xor(l, 16); l += __shfl_xor(l, 32);
        const float linv = 1.0f / l;
        bf16x8 pf[8];
#pragma unroll
        for (int s = 0; s < 8; ++s) { v4u w; w.x = pg8::cvt_pk_bf16(acc[2 * s][0], acc[2 * s][1]); w.y = pg8::cvt_pk_bf16(acc[2 * s][2], acc[2 * s][3]);
            w.z = pg8::cvt_pk_bf16(acc[2 * s + 1][0], acc[2 * s + 1][1]); w.w = pg8::cvt_pk_bf16(acc[2 * s + 1][2], acc[2 * s + 1][3]); pf[s] = __builtin_bit_cast(bf16x8, w); }
        __builtin_amdgcn_sched_barrier(0);
        f32x4 o[32];
#pragma unroll
        for (int mm = 0; mm < 32; ++mm) o[mm] = (f32x4){0.f, 0.f, 0.f, 0.f};
#pragma unroll
        for (int cc = 0; cc < 4; ++cc) {
            AT_WAIT();
            if (cc < 3) AT_STAGE_V(cc + 1, (cc + 1) & 1);
            const LAS unsigned char* bb = lds + (cc & 1) * 65536 + aoff0; asm volatile("" : "+v"(bb));
#pragma unroll
            for (int k = 0; k < 2; ++k)
#pragma unroll
                for (int mg = 0; mg < 4; ++mg) { bf16x8 a[8];
#pragma unroll
                    for (int m8 = 0; m8 < 8; ++m8) a[m8] = *(const LAS bf16x8*)(bb + mg * 16384 + m8 * 2048 + k * 1024);
#pragma unroll
                    for (int m8 = 0; m8 < 8; ++m8) o[mg * 8 + m8] = __builtin_amdgcn_mfma_f32_16x16x32_bf16(a[m8], pf[2 * cc + k], o[mg * 8 + m8], 0, 0, 0);
                    __builtin_amdgcn_sched_barrier(0); }
        }
        bf16* op = obuf + tok * 2048 + h * 512 + 4 * fq;
#pragma unroll
        for (int mm = 0; mm < 32; ++mm) { v2u w; w.x = pg8::cvt_pk_bf16(o[mm][0] * linv, o[mm][1] * linv); w.y = pg8::cvt_pk_bf16(o[mm][2] * linv, o[mm][3] * linv); *(v2u*)(op + 16 * mm) = w; }
    }
    asm volatile("s_waitcnt vmcnt(0)" ::: "memory"); __syncthreads();
#undef AT_STAGE_K
#undef AT_STAGE_V
#undef AT_WAIT
}
struct S5Lane { float lbr, lbi; float Br[16], Bi[16]; };
__device__ __forceinline__ void s5_lane_params(int g, int p, S5Lane& L) {
    const float lr = fminf(ka_in(15)[g * 64 + p], -1e-4f), li = ka_in(16)[g * 64 + p], dt = expf(ka_in(17)[g]);
    const float ar = lr * dt, th = li * dt; float sn, cs; sincosf(th, &sn, &cs); const float e = expf(ar), sh = sinf(0.5f * th);
    L.lbr = e * cs; L.lbi = e * sn;
    const float nr = expm1f(ar) * cs - 2.0f * sh * sh, ni = e * sn;
    const float den = 1.0f / (lr * lr + li * li), cr = (nr * lr + ni * li) * den, ci = (ni * lr - nr * li) * den;
#pragma unroll
    for (int c = 0; c < 16; ++c) { const float br = ka_in(18)[(size_t)(g * 64 + p) * 16 + c], bi = ka_in(19)[(size_t)(g * 64 + p) * 16 + c]; L.Br[c] = cr * br - ci * bi; L.Bi[c] = cr * bi + ci * br; }
}
__device__ __forceinline__ void s5_step(const S5Lane& L, const bf16* urow, float& xr, float& xi) {
    const v4u w0 = *(const v4u*)urow, w1 = *(const v4u*)(urow + 8);
    float u[16] = {bflo(w0.x), bfhi(w0.x), bflo(w0.y), bfhi(w0.y), bflo(w0.z), bfhi(w0.z), bflo(w0.w), bfhi(w0.w), bflo(w1.x), bfhi(w1.x), bflo(w1.y), bfhi(w1.y), bflo(w1.z), bfhi(w1.z), bflo(w1.w), bfhi(w1.w)};
    float br = 0.f, bi = 0.f;
#pragma unroll
    for (int c = 0; c < 16; ++c) { br += L.Br[c] * u[c]; bi += L.Bi[c] * u[c]; }
    const float nr = L.lbr * xr - L.lbi * xi + br, ni = L.lbr * xi + L.lbi * xr + bi; xr = nr; xi = ni;
}
__device__ __forceinline__ void s5_pass_a(const bf16* ub, f32x2* st, int wave, int lane) {
    const int gw = blockIdx.x * NWAVES + wave, NGW = gridDim.x * NWAVES;
    for (int task = gw; task < BATCH * 128 * 64; task += NGW) {
        const int seg = task & 63, g = (task >> 6) & 127, b = task >> 13;
        S5Lane L; s5_lane_params(g, lane, L);
        float xr = 0.f, xi = 0.f; const bf16* up = ub + (size_t)(b * SEQ + seg * 64) * 2048 + 16 * g;
#pragma unroll 2
        for (int s = 0; s < 64; ++s) s5_step(L, up + (size_t)s * 2048, xr, xi);
        st[(size_t)task * 64 + lane] = (f32x2){xr, xi};
    }
}
__device__ __forceinline__ void s5_pass_c(LAS unsigned char* lds, const bf16* ub, const f32x2* st, bf16* yb, int wave, int lane) {
    LAS f32x2* Cs = (LAS f32x2*)(lds + wave * 16640);
    LAS f32x2* xs = (LAS f32x2*)(lds + wave * 16640 + 8320);
    const int gw = blockIdx.x * NWAVES + wave, NGW = gridDim.x * NWAVES;
    for (int task = gw; task < BATCH * 128 * 64; task += NGW) {
        const int seg = task & 63, g = (task >> 6) & 127, b = task >> 13;
        S5Lane L; s5_lane_params(g, lane, L);
#pragma unroll
        for (int c = 0; c < 16; ++c) Cs[c * 65 + lane] = (f32x2){ka_in(20)[(size_t)(g * 16 + c) * 64 + lane], ka_in(21)[(size_t)(g * 16 + c) * 64 + lane]};
        float Ar = L.lbr, Ai = L.lbi;
#pragma unroll
        for (int i = 0; i < 6; ++i) { const float nr = Ar * Ar - Ai * Ai, ni = 2.0f * Ar * Ai; Ar = nr; Ai = ni; }
        float xr = 0.f, xi = 0.f; const f32x2* sp = st + (size_t)(task - seg) * 64 + lane;
#pragma unroll 2
        for (int n = 0; n < seg; ++n) { const f32x2 s = sp[(size_t)n * 64]; const float nr = Ar * xr - Ai * xi + s.x, ni = Ar * xi + Ai * xr + s.y; xr = nr; xi = ni; }
        const bf16* up = ub + (size_t)(b * SEQ + seg * 64) * 2048 + 16 * g; bf16* yp = yb + (size_t)(b * SEQ + seg * 64) * 2048 + 16 * g;
        const int t = lane & 15, cq = lane >> 4;
        f32x4 dsk = *(const f32x4*)(ka_in(22) + g * 16 + 4 * cq);
#pragma unroll 1
        for (int blk = 0; blk < 4; ++blk) {
#pragma unroll 2
            for (int s = 0; s < 16; ++s) { s5_step(L, up + (size_t)(blk * 16 + s) * 2048, xr, xi); xs[s * 65 + lane] = (f32x2){xr, xi}; }
            LDS_WAIT();
            float acc[4] = {0.f, 0.f, 0.f, 0.f};
#pragma unroll 4
            for (int p = 0; p < 64; ++p) { const f32x2 x = xs[t * 65 + p];
#pragma unroll
                for (int j = 0; j < 4; ++j) { const f32x2 c = Cs[(4 * cq + j) * 65 + p]; acc[j] += c.x * x.x - c.y * x.y; } }
            const v2u uw = *(const v2u*)(up + (size_t)(blk * 16 + t) * 2048 + 4 * cq);
            const float y0 = gelu_exact(acc[0] + dsk[0] * bflo(uw.x)), y1 = gelu_exact(acc[1] + dsk[1] * bfhi(uw.x)), y2 = gelu_exact(acc[2] + dsk[2] * bflo(uw.y)), y3 = gelu_exact(acc[3] + dsk[3] * bfhi(uw.y));
            v2u ow; ow.x = pk2(y0, y1); ow.y = pk2(y2, y3); *(v2u*)(yp + (size_t)(blk * 16 + t) * 2048 + 4 * cq) = ow;
            LDS_WAIT();
        }
    }
}
__device__ __forceinline__ void s5_mfma(LAS unsigned char* lds, const bf16* ub, bf16* yb, int wave, int lane) {
    LAS f32x2* PW = (LAS f32x2*)(lds);
    LAS f32x2* BB = (LAS f32x2*)(lds + 8704);
    LAS f32x2* CC = (LAS f32x2*)(lds + 16896);
    LAS bf16* KST = (LAS bf16*)(lds + 25088);
    LAS unsigned char* UI = lds + 33280;
    LAS float* SL = (LAS float*)(lds + 66048);
    LAS bf16* XP = (LAS bf16*)(lds + 99840);
    const int tid = wave * 64 + lane, fr = lane & 15, fq = lane >> 4;
    for (int unit = blockIdx.x; unit < 256; unit += gridDim.x) {
        const int b = unit >> 7, g = unit & 127;
        const float dt = expf(ka_in(17)[g]);
        __syncthreads();
        for (int idx = tid; idx < 17 * 64; idx += NTHREADS) { const int e = idx >> 6, p = idx & 63;
            const float lr = fminf(ka_in(15)[g * 64 + p], -1e-4f), li = ka_in(16)[g * 64 + p]; float sn, cs; sincosf(li * dt * (float)e, &sn, &cs); const float ex = expf(lr * dt * (float)e);
            PW[idx] = (f32x2){ex * cs, ex * sn}; }
        for (int idx = tid; idx < 1024; idx += NTHREADS) { const int p = idx >> 4, c = idx & 15;
            const float lr = fminf(ka_in(15)[g * 64 + p], -1e-4f), li = ka_in(16)[g * 64 + p]; const float ar = lr * dt, th = li * dt; float sn, cs; sincosf(th, &sn, &cs); const float e = expf(ar), sh = sinf(0.5f * th);
            const float nr = expm1f(ar) * cs - 2.0f * sh * sh, ni = e * sn, den = 1.0f / (lr * lr + li * li), cr = (nr * lr + ni * li) * den, ci = (ni * lr - nr * li) * den;
            const float br = ka_in(18)[(size_t)(g * 64 + p) * 16 + c], bi = ka_in(19)[(size_t)(g * 64 + p) * 16 + c];
            BB[idx] = (f32x2){cr * br - ci * bi, cr * bi + ci * br};
            CC[idx] = (f32x2){ka_in(20)[(size_t)g * 1024 + idx], ka_in(21)[(size_t)g * 1024 + idx]}; }
        __syncthreads();
        bf16x8 A1[8];
        { const int ri = wave >> 2, p = 16 * (wave & 3) + fr;
#pragma unroll
            for (int ks = 0; ks < 8; ++ks) { const int s = 2 * ks + (fq >> 1); const f32x2 pw = PW[(15 - s) * 64 + p]; float v[8];
#pragma unroll
                for (int j = 0; j < 8; ++j) { const f32x2 bb = BB[p * 16 + 8 * (fq & 1) + j]; v[j] = ri ? (pw.x * bb.y + pw.y * bb.x) : (pw.x * bb.x - pw.y * bb.y); }
                v4u w; w.x = pk2(v[0], v[1]); w.y = pk2(v[2], v[3]); w.z = pk2(v[4], v[5]); w.w = pk2(v[6], v[7]); A1[ks] = __builtin_bit_cast(bf16x8, w); } }
        const int t0 = wave, t1 = 15 - wave;
        bf16x8 CM[2][4];
#pragma unroll
        for (int ti = 0; ti < 2; ++ti) { const int t = ti ? t1 : t0;
#pragma unroll
            for (int ks = 0; ks < 4; ++ks) { float v[8];
#pragma unroll
                for (int j = 0; j < 8; ++j) { const int p = 32 * (ks & 1) + 8 * fq + j; const f32x2 c = CC[fr * 64 + p], pw = PW[(t + 1) * 64 + p];
                    v[j] = (ks >> 1) ? -(c.x * pw.y + c.y * pw.x) : (c.x * pw.x - c.y * pw.y); }
                v4u w; w.x = pk2(v[0], v[1]); w.y = pk2(v[2], v[3]); w.z = pk2(v[4], v[5]); w.w = pk2(v[6], v[7]); CM[ti][ks] = __builtin_bit_cast(bf16x8, w); } }
        { bf16x8 ct[4];
#pragma unroll
            for (int ks = 0; ks < 4; ++ks) { float v[8];
#pragma unroll
                for (int j = 0; j < 8; ++j) { const f32x2 c = CC[fr * 64 + 32 * (ks & 1) + 8 * fq + j]; v[j] = (ks >> 1) ? -c.y : c.x; }
                v4u w; w.x = pk2(v[0], v[1]); w.y = pk2(v[2], v[3]); w.z = pk2(v[4], v[5]); w.w = pk2(v[6], v[7]); ct[ks] = __builtin_bit_cast(bf16x8, w); }
#pragma unroll
            for (int si = 0; si < 2; ++si) { const int s = 2 * wave + si; f32x4 kacc = (f32x4){0.f, 0.f, 0.f, 0.f};
#pragma unroll
                for (int ks = 0; ks < 4; ++ks) { float v[8];
#pragma unroll
                    for (int j = 0; j < 8; ++j) { const int p = 32 * (ks & 1) + 8 * fq + j; const f32x2 pw = PW[(15 - s) * 64 + p], bb = BB[p * 16 + fr];
                        v[j] = (ks >> 1) ? (pw.x * bb.y + pw.y * bb.x) : (pw.x * bb.x - pw.y * bb.y); }
                    v4u w; w.x = pk2(v[0], v[1]); w.y = pk2(v[2], v[3]); w.z = pk2(v[4], v[5]); w.w = pk2(v[6], v[7]);
                    kacc = __builtin_amdgcn_mfma_f32_16x16x32_bf16(__builtin_bit_cast(bf16x8, w), ct[ks], kacc, 0, 0, 0); }
                v2u kw; kw.x = pk2(kacc[0], kacc[1]); kw.y = pk2(kacc[2], kacc[3]);
                *(LAS v2u*)(KST + ((15 - s) * 16 + fr) * 16 + 4 * fq) = kw; } }
        const f32x4 dsk = *(const f32x4*)(ka_in(22) + g * 16 + 4 * fq);
        float Xr = 0.f, Xi = 0.f;
#pragma unroll 1
        for (int q = 0; q < 4; ++q) {
            __syncthreads();
            { const bf16* src0 = ub + (size_t)(b * SEQ + q * 1024) * 2048 + 16 * g;
#pragma unroll
                for (int i = 0; i < 4; ++i) { const int piece = tid + NTHREADS * i, tok = piece >> 1, half = piece & 1;
                    const v4u w = *(const v4u*)(src0 + (size_t)tok * 2048 + 8 * half);
                    *(LAS v4u*)(UI + ((((tok & 15) * 64 + (tok >> 4)) * 2 + half) * 16)) = w; } }
            __syncthreads();
#pragma unroll 1
            for (int nf = 0; nf < 4; ++nf) { f32x4 acc = (f32x4){0.f, 0.f, 0.f, 0.f};
#pragma unroll
                for (int ks = 0; ks < 8; ++ks) { const bf16x8 bfr = *(const LAS bf16x8*)(UI + ((((2 * ks + (fq >> 1)) * 64 + 16 * nf + fr) * 2 + (fq & 1)) * 16));
                    acc = __builtin_amdgcn_mfma_f32_16x16x32_bf16(A1[ks], bfr, acc, 0, 0, 0); }
                *(LAS f32x4*)(SL + (16 * nf + fr) * 132 + 16 * wave + 4 * fq) = acc; }
            __syncthreads();
            if (wave == 0) { const f32x2 a16 = PW[16 * 64 + lane];
#pragma unroll 4
                for (int n = 0; n < 64; ++n) { XP[n * 136 + lane] = (bf16)f2bf(Xr); XP[n * 136 + 64 + lane] = (bf16)f2bf(Xi);
                    const float sr = SL[n * 132 + lane], si = SL[n * 132 + 64 + lane];
                    const float nr = a16.x * Xr - a16.y * Xi + sr, ni = a16.x * Xi + a16.y * Xr + si; Xr = nr; Xi = ni; } }
            __syncthreads();
#pragma unroll 1
            for (int nf = 0; nf < 4; ++nf) { f32x4 acc0 = (f32x4){0.f, 0.f, 0.f, 0.f}, acc1 = acc0;
#pragma unroll
                for (int ks = 0; ks < 8; ++ks) { if (2 * ks <= t1 || 2 * ks <= t0) {
                    const int s = 2 * ks + (fq >> 1);
                    const bf16x8 bfr = *(const LAS bf16x8*)(UI + (((s * 64 + 16 * nf + fr) * 2 + (fq & 1)) * 16));
                    if (2 * ks <= t0) { bf16x8 tf = (bf16x8){0, 0, 0, 0, 0, 0, 0, 0}; if (s <= t0) tf = *(const LAS bf16x8*)(KST + ((t0 - s) * 16 + fr) * 16 + 8 * (fq & 1)); acc0 = __builtin_amdgcn_mfma_f32_16x16x32_bf16(tf, bfr, acc0, 0, 0, 0); }
                    if (2 * ks <= t1) { bf16x8 tf = (bf16x8){0, 0, 0, 0, 0, 0, 0, 0}; if (s <= t1) tf = *(const LAS bf16x8*)(KST + ((t1 - s) * 16 + fr) * 16 + 8 * (fq & 1)); acc1 = __builtin_amdgcn_mfma_f32_16x16x32_bf16(tf, bfr, acc1, 0, 0, 0); } } }
#pragma unroll
                for (int ks = 0; ks < 4; ++ks) { const bf16x8 xf = *(const LAS bf16x8*)(XP + (16 * nf + fr) * 136 + 32 * ks + 8 * fq);
                    acc0 = __builtin_amdgcn_mfma_f32_16x16x32_bf16(CM[0][ks], xf, acc0, 0, 0, 0); acc1 = __builtin_amdgcn_mfma_f32_16x16x32_bf16(CM[1][ks], xf, acc1, 0, 0, 0); }
#pragma unroll
                for (int ti = 0; ti < 2; ++ti) { const int t = ti ? t1 : t0; const f32x4 a = ti ? acc1 : acc0; const int n = 16 * nf + fr;
                    const v2u uw = *(const LAS v2u*)(UI + (((t * 64 + n) * 2 + (fq >> 1)) * 16) + 8 * (fq & 1));
                    const pg8::f32x2 g0 = pg8::gelu_pk((pg8::f32x2){a[0] + dsk[0] * bflo(uw.x), a[1] + dsk[1] * bfhi(uw.x)}), g1 = pg8::gelu_pk((pg8::f32x2){a[2] + dsk[2] * bflo(uw.y), a[3] + dsk[3] * bfhi(uw.y)});
                    v2u ow; ow.x = pg8::cvt_pk_bf16(g0.x, g0.y); ow.y = pg8::cvt_pk_bf16(g1.x, g1.y);
                    *(v2u*)(yb + (size_t)(b * SEQ + q * 1024 + 16 * n + t) * 2048 + 16 * g + 4 * fq) = ow; } }
        }
    }
    __syncthreads();
}
#ifndef EN
#define EN(k) 1
#endif
template <int PH> __device__ __forceinline__ void run_phase(unsigned char* ws, float* X, LAS unsigned char* lds, int wave, int lane) {
    const int G = gridDim.x, bx = blockIdx.x;
    bf16* XB = (bf16*)(ws + WS_XB); float* SSQ = (float*)(ws + WS_SSQ);
    bf16* R0 = (bf16*)(ws + WS_R);
    constexpr int layer = (PH >= 10) ? 1 : 0;
    if constexpr (!EN(PH)) { return; }
    else if constexpr (PH == 0) p0_prologue(ws, lds, wave, lane);
    else if constexpr (PH == 1) {
        if (bx < 64) { const int i = bx >> 5;
            pg8::Gemm g{(const pg8::bf16_t*)(ws + WS_MEMB), (const pg8::bf16_t*)(ws + WS_W_KV + (size_t)i * 16 * MiB), MROWS, 4096, 2048}; pg8::StaticOrder S; S.init(MROWS, 4096, 32, bx & 31);
            pg8::EpiKV E{(pg8::bf16_t*)(ws + WS_KB + (size_t)i * 2 * MiB), (pg8::bf16_t*)(ws + WS_VB + (size_t)i * 2 * MiB), (pg8::bf16_t*)(ws + WS_VTB + (size_t)i * 2 * MiB), (const float*)(ws + WS_SSQM)};
            pg8::gemm_phase<pg8::EpiKV, pg8::StaticOrder, true, true>(lds, g, S, E, wave, lane); }
    } else if constexpr (PH == 2) {
        pg8::Gemm g{XB, (const pg8::bf16_t*)(ws + WS_W_AIN), M, 4096, 2048}; pg8::StaticOrder S; S.init(M, 4096, G, bx);
        pg8::EpiAct<1, true> E{R0, 4096, ka_in(8), SSQ, 32, 1.0f, (float*)(ws + WS_VST), 8};
        pg8::gemm_phase<pg8::EpiAct<1, true>, pg8::StaticOrder, true, true>(lds, g, S, E, wave, lane);
    } else if constexpr (PH == 3) {
#if defined(GATING_SIMPLE)
        gating_simple(lds, R0, (const float*)(ws + WS_VST), ka_in(9), ka_in(10), ka_in(11), ka_in(12), R0 + (size_t)M * 4096, wave * 64 + lane);
#else
        gating_mfma(lds, R0, (const float*)(ws + WS_VST), ka_in(9), ka_in(10), ka_in(11), ka_in(12), R0 + (size_t)M * 4096, wave, lane);
#endif
    }
    else if constexpr (PH == 4 || PH == 7 || PH == 9 || PH == 16 || PH == 18) {
        const pg8::bf16_t* A; const pg8::bf16_t* W; int K = 2048; const float* base = X;
        if constexpr (PH == 4) { A = R0 + (size_t)M * 4096; W = (const pg8::bf16_t*)(ws + WS_W_AOUT); base = ka_in(0); }
        else if constexpr (PH == 7 || PH == 16) { A = R0 + (size_t)M * 2048; W = (const pg8::bf16_t*)(ws + WS_W_O + (size_t)layer * 8 * MiB); }
        else { A = R0; W = (const pg8::bf16_t*)(ws + WS_W_DN + (size_t)layer * 32 * MiB); K = 8192; }
        pg8::Gemm g{A, W, M, 2048, K}; pg8::StaticOrder S; S.init(M, 2048, G, bx);
        pg8::EpiRes E{base, X, XB, SSQ};
        pg8::gemm_phase<pg8::EpiRes, pg8::StaticOrder, true, true>(lds, g, S, E, wave, lane);
    } else if constexpr (PH == 5 || PH == 14 || PH == 10) {
        const pg8::bf16_t* W = (PH == 10) ? (const pg8::bf16_t*)(ws + WS_W_BIN) : (const pg8::bf16_t*)(ws + WS_W_Q + (size_t)layer * 8 * MiB);
        pg8::Gemm g{XB, W, M, 2048, 2048}; pg8::StaticOrder S; S.init(M, 2048, G, bx);
        pg8::EpiAct<0, false> E{R0, 2048, nullptr, SSQ, (PH == 14) ? 64 : 32, (PH == 10) ? 1.0f : 0.044194173824159216f * 1.4426950408889634f, nullptr, 0};
        pg8::gemm_phase<pg8::EpiAct<0, false>, pg8::StaticOrder, true, true>(lds, g, S, E, wave, lane);
    } else if constexpr (PH == 6 || PH == 15) {
#if defined(ATTN_SIMPLE)
        attn_simple(lds, R0, (const bf16*)(ws + WS_KB + (size_t)layer * 2 * MiB), (const bf16*)(ws + WS_VB + (size_t)layer * 2 * MiB), R0 + (size_t)M * 2048, wave, lane);
#else
        attn_mfma(lds, R0, (const bf16*)(ws + WS_KB + (size_t)layer * 2 * MiB), (const bf16*)(ws + WS_VTB + (size_t)layer * 2 * MiB), R0 + (size_t)M * 2048, wave, lane);
#endif
    }
    else if constexpr (PH == 8 || PH == 17) {
        pg8::Gemm g{XB, (const pg8::bf16_t*)(ws + WS_W_UP + (size_t)layer * 32 * MiB), M, FF, 2048}; pg8::StaticOrder S; S.init(M, FF, G, bx);
        pg8::EpiAct<2, false> E{R0, FF, nullptr, SSQ, 32, 1.0f, nullptr, 0};
        pg8::gemm_phase<pg8::EpiAct<2, false>, pg8::StaticOrder, true, true>(lds, g, S, E, wave, lane);
    } else if constexpr (PH == 11) {
#if defined(S5_SIMPLE)
        s5_pass_a(R0, (f32x2*)(ws + WS_S5ST), wave, lane);
#endif
    } else if constexpr (PH == 12) {
#if defined(S5_SIMPLE)
        s5_pass_c(lds, R0, (const f32x2*)(ws + WS_S5ST), R0 + (size_t)M * 2048, wave, lane);
#else
        s5_mfma(lds, R0, R0 + (size_t)M * 2048, wave, lane);
#endif
    }
    else if constexpr (PH == 13) {
        pg8::Gemm g{R0 + (size_t)M * 2048, (const pg8::bf16_t*)(ws + WS_W_BOUT), M, 4096, 2048}; pg8::StaticOrder S; S.init(M, 4096, G, bx);
        pg8::EpiGlu E{X, X, XB, SSQ, ka_in(24)};
        pg8::gemm_phase<pg8::EpiGlu, pg8::StaticOrder, true, true>(lds, g, S, E, wave, lane);
    } else if constexpr (PH == 19) final_norm(X, ka_in(6), wave, lane);
}
__device__ __forceinline__ int lane_id() { int l; asm volatile("v_mbcnt_lo_u32_b32 %0, -1, 0\n\tv_mbcnt_hi_u32_b32 %0, -1, %0" : "=v"(l)); return l; }

#define XB_TMO      128
#define XB_XCNT(j)  (256  + 64 * (j))
#define XB_XSUB(j)  (1280 + 64 * (j))
#define XB_XGEN(j)  (2304 + 64 * (j))
#define XB_TOP      3328
#define XB_TOPGEN   3392
#define XCD_BAR_WORDS 3456
#define XB_SPIN_CAP (1u << 22)
__device__ __forceinline__ unsigned xb_ld(unsigned* p)              { return __hip_atomic_load(p, __ATOMIC_RELAXED, __HIP_MEMORY_SCOPE_AGENT); }
__device__ __forceinline__ unsigned xb_add(unsigned* p, unsigned v) { return __hip_atomic_fetch_add(p, v, __ATOMIC_RELAXED, __HIP_MEMORY_SCOPE_AGENT); }
__device__ __forceinline__ unsigned xb_xcc_id() { return (unsigned)__builtin_amdgcn_s_getreg((3 << 11) | 20) & 0xFu; }
#define XB_SPIN(cond, bar) do { unsigned _sp = 0; while (cond) { __builtin_amdgcn_s_sleep(1); \
    if ((++_sp & 255u) == 0u) { if (xb_ld(&(bar)[XB_TMO])) break; if (_sp > XB_SPIN_CAP) { atomicAdd(&(bar)[XB_TMO], 1u); break; } } } } while (0)
__device__ __forceinline__ void xcd_barrier_complete(unsigned* bar, unsigned x, unsigned& nloc, unsigned& nx) {
    const unsigned G = gridDim.x * gridDim.y * gridDim.z;
    unsigned sum, cnt, mine, sp = 0u;
    for (;;) {
        sum = 0u; cnt = 0u; mine = 0u;
#pragma unroll
        for (unsigned j = 0; j < 16; ++j) { const unsigned c = xb_ld(&bar[XB_XCNT(j)]); sum += c; cnt += (c > 0u) ? 1u : 0u; mine = (j == x) ? c : mine; }
        if (sum == G) break;
        __builtin_amdgcn_s_sleep(1);
        if ((++sp & 255u) == 0u) { if (xb_ld(&bar[XB_TMO])) break; if (sp > XB_SPIN_CAP) { atomicAdd(&bar[XB_TMO], 1u); break; } }
    }
    nloc = mine > 0u ? mine : 1u; nx = cnt > 0u ? cnt : 1u;
}
__device__ __forceinline__ void xcd_barrier(unsigned* bar, volatile LAS unsigned* st, bool is_t0) {
    asm volatile("s_waitcnt vmcnt(0)" ::: "memory");
    __syncthreads();
    if (is_t0) {
        __builtin_amdgcn_s_waitcnt(0);
        const unsigned x = xb_xcc_id();
        unsigned nloc = st[0], nx = st[1];
        if (nloc == 0u) { xcd_barrier_complete(bar, x, nloc, nx); st[0] = nloc; st[1] = nx; }
        const unsigned old = xb_add(&bar[XB_XSUB(x)], 1u);
        const unsigned gen = old / nloc;
        if (old + 1u == (gen + 1u) * nloc) {
            __builtin_amdgcn_fence(__ATOMIC_RELEASE, "agent");
            asm volatile("s_waitcnt vmcnt(0)" ::: "memory");
            const unsigned og = xb_add(&bar[XB_TOP], 1u);
            const unsigned tg = og / nx;
            if (og + 1u == (tg + 1u) * nx) xb_add(&bar[XB_TOPGEN], 1u);
            else XB_SPIN(xb_ld(&bar[XB_TOPGEN]) == tg, bar);
            __builtin_amdgcn_fence(__ATOMIC_ACQUIRE, "agent");
            xb_add(&bar[XB_XGEN(x)], 1u);
            asm volatile("s_waitcnt vmcnt(0)" ::: "memory");
        } else {
            XB_SPIN(xb_ld(&bar[XB_XGEN(x)]) == gen, bar);
            __builtin_amdgcn_fence(__ATOMIC_ACQUIRE, "agent");
            asm volatile("s_waitcnt vmcnt(0)" ::: "memory");
        }
    }
    __syncthreads();
}

__global__ void __launch_bounds__(NTHREADS, 2) trunk_fwd(Args args) {
    extern __shared__ __attribute__((aligned(16))) unsigned char lds_raw[];
    LAS unsigned char* lds = (LAS unsigned char*)lds_raw;
    const int wave = __builtin_amdgcn_readfirstlane((int)threadIdx.x >> 6);
    const int lo = args.ph_lo, hi = args.ph_hi;
    unsigned* bar = (unsigned*)args.ws + 4096;
    volatile LAS unsigned* st = (volatile LAS unsigned*)(lds + LDS_BYTES - 64);
#if MK_N_LAUNCHES == 1
    { const int l0 = lane_id(); if (wave == 0 && l0 < 2) st[l0] = 0u; __syncthreads(); if (wave == 0 && l0 == 0) (void)xb_add(&bar[XB_XCNT(xb_xcc_id())], 1u); }
#define GRID_BAR(k) do { if ((k) == 1) cg::this_grid().sync(); else xcd_barrier(bar, st, wave == 0 && lane_id() == 0); } while (0)
#else
#define GRID_BAR(k) do { } while (0)
#endif
#ifndef DUP_PH
#define DUP_PH -1
#endif
#define PHASE(k) if (lo <= (k) && (k) < hi) { if ((k) > lo) GRID_BAR(k); run_phase<k>(args.ws, args.out, lds, wave, lane_id()); if ((k) == DUP_PH) { GRID_BAR(2); run_phase<k>(args.ws, args.out, lds, wave, lane_id()); } }
    PHASE(0) PHASE(1) PHASE(2) PHASE(3) PHASE(4) PHASE(5) PHASE(6) PHASE(7) PHASE(8) PHASE(9)
    PHASE(10)
#if defined(S5_SIMPLE)
    PHASE(11)
#endif
    PHASE(12) PHASE(13) PHASE(14) PHASE(15) PHASE(16) PHASE(17) PHASE(18) PHASE(19)
#undef PHASE
}

extern "C" void kernel_launch(void* const* d_in, const int* in_sizes, int n_in, void* d_out, int out_size, void* d_ws, size_t ws_size, hipStream_t stream) {
    static int grid = 0;
    if (grid == 0) {
        if (n_in != 30 || out_size != M * D || ws_size < WS_END) { fprintf(stderr, "kernel_launch: unexpected shapes (n_in %d out %d ws %zu)\n", n_in, out_size, ws_size); grid = -1; return; }
        int dev = 0, cus = 0, per_cu = 0;
        if (hipGetDevice(&dev) != hipSuccess || hipDeviceGetAttribute(&cus, hipDeviceAttributeMultiprocessorCount, dev) != hipSuccess) { grid = -1; return; }
        if (hipFuncSetAttribute((const void*)trunk_fwd, hipFuncAttributeMaxDynamicSharedMemorySize, LDS_BYTES) != hipSuccess) { fprintf(stderr, "kernel_launch: hipFuncSetAttribute failed\n"); grid = -1; return; }
        if (hipOccupancyMaxActiveBlocksPerMultiprocessor(&per_cu, (const void*)trunk_fwd, NTHREADS, LDS_BYTES) != hipSuccess || per_cu < 1) { fprintf(stderr, "kernel_launch: occupancy query says %d\n", per_cu); grid = -1; return; }
        grid = cus;
    }
    if (grid < 0) return;
    if (hipMemsetAsync(d_ws, 0, 65536, stream) != hipSuccess) { fprintf(stderr, "kernel_launch: memset failed\n"); return; }
    Args a{};
    for (int i = 0; i < 30; ++i) a.in[i] = (const float*)d_in[i];
    a.out = (float*)d_out; a.ws = (unsigned char*)d_ws;
#if MK_N_LAUNCHES == 1
    a.ph_lo = 0; a.ph_hi = NPH;
    void* kargs[] = {&a};
    hipError_t e = hipLaunchCooperativeKernel((const void*)trunk_fwd, dim3(grid), dim3(NTHREADS), kargs, LDS_BYTES, stream);
    if (e != hipSuccess) fprintf(stderr, "kernel_launch: cooperative launch failed: %s\n", hipGetErrorString(e));
#else
    for (int ph = 0; ph < NPH; ++ph) { a.ph_lo = ph; a.ph_hi = ph + 1; hipLaunchKernelGGL(trunk_fwd, dim3(grid), dim3(NTHREADS), LDS_BYTES, stream, a); }
#endif
}
```

```cpp
#include <hip/hip_runtime.h>
#include <hip/hip_cooperative_groups.h>
#include <cstdio>
#include <cstdint>
namespace cg = cooperative_groups;
#define MK_N_LAUNCHES 1
namespace pg8 {
#define PG8_LAS __attribute__((address_space(3)))
typedef unsigned short bf16_t;
typedef short bf16x8 __attribute__((ext_vector_type(8)));
typedef float f32x4 __attribute__((ext_vector_type(4)));
typedef unsigned u32x4 __attribute__((ext_vector_type(4)));
constexpr int BM = 256, BK = 64, HALF = 128, HTB = HALF * BK * 2  , STAGE_BYTES = 8 * HTB, NXCD = 8, WGM = 8;

__host__ __device__ __forceinline__ int lds_byte(int r, int c) { const int st = (r >> 4) * 2 + (c >> 5), rr = r & 15, cc = c & 31, ob = rr * 64 + cc * 2; return st * 1024 + (ob ^ (((ob >> 9) & 1) << 5)); }
__host__ __device__ __forceinline__ void stage_rc(int b, int& R, int& C) { const int st = b / 1024, sb = b % 1024, swz = sb ^ (((sb >> 9) & 1) << 5); R = (st >> 1) * 16 + swz / 64; C = (st & 1) * 32 + (swz % 64) / 2; }
__host__ __device__ __forceinline__ int perm32(int rho) { const int n = rho >> 4, i = rho & 15; return 8 * (i >> 2) + 4 * n + (i & 3); }

struct Unit { int pm, pn; };
struct Gemm { const bf16_t* A; const bf16_t* Bt; int M, N, K; };

struct StaticOrder {
    int nM, nN, nwg, G, c;
    __host__ __device__ void init(int M, int N, int G_, int c_) { nM = M / BM; nN = N / BM; nwg = nM * nN; G = G_; c = c_; }
    __host__ __device__ bool next(int i, Unit& u) const {
        const long L = (long)i * G + c; if (L >= nwg) return false;
        int wgid = (int)L; { const int q = nwg / NXCD, r = nwg % NXCD, xcd = wgid % NXCD, off = wgid / NXCD; wgid = (xcd < r ? xcd * (q + 1) : r * (q + 1) + (xcd - r) * q) + off; }
        const int nig = WGM * nN, gid = wgid / nig, fm = gid * WGM, gsz = (nM - fm) < WGM ? (nM - fm) : WGM;
        u.pm = fm + ((wgid % nig) % gsz); u.pn = (wgid % nig) / gsz; return true;
    }
    __device__ __forceinline__ void a_ready(const Unit&) const {}
    __device__ __forceinline__ void done(const Unit&) const {}
};

__device__ __forceinline__ unsigned cvt_pk_bf16(float lo, float hi) { unsigned r; asm volatile("v_cvt_pk_bf16_f32 %0, %1, %2" : "=v"(r) : "v"(lo), "v"(hi)); return r; }
typedef float f32x2 __attribute__((ext_vector_type(2)));
__device__ __forceinline__ f32x2 gelu_pk(f32x2 v) {
    const f32x2 av = __builtin_elementwise_abs(v), d = av * 0.2316418882f + 1.0f;
    f32x2 t; t.x = __builtin_amdgcn_rcpf(d.x); t.y = __builtin_amdgcn_rcpf(d.y);
    f32x2 q = t * 0.5307027145f + (-0.7265760135f); q = q * t + 0.7107068705f; q = q * t + (-0.142248368f); q = q * t + 0.127414796f; q = q * t;
    const f32x2 s = (v * v) * (-0.72134752044f);
    f32x2 e; e.x = __builtin_amdgcn_exp2f(s.x); e.y = __builtin_amdgcn_exp2f(s.y);
    const f32x2 m = v * (q * e), r = v - m;
    f32x2 o; o.x = v.x < 0.f ? m.x : r.x; o.y = v.y < 0.f ? m.y : r.y; return o;
}
typedef unsigned u32x2 __attribute__((ext_vector_type(2)));
constexpr int SSQ_STRIDE = 64;
__device__ __forceinline__ float row_rstd(const float* ssq, int np, int row, int fq) {
    const float* p = ssq + (size_t)row * SSQ_STRIDE + fq * (np >> 2);
    f32x4 a = *(const f32x4*)p, b = *(const f32x4*)(p + 4);
    float s = (a[0] + a[1]) + (a[2] + a[3]) + (b[0] + b[1]) + (b[2] + b[3]);
    if (np == 64) { f32x4 c = *(const f32x4*)(p + 8), d = *(const f32x4*)(p + 12); s += (c[0] + c[1]) + (c[2] + c[3]) + (d[0] + d[1]) + (d[2] + d[3]); }
    s += __shfl_xor(s, 16); s += __shfl_xor(s, 32);
    return __builtin_amdgcn_rsqf(s * (1.0f / 2048.0f) + 1e-6f);
}
template <int ACT, bool STATS> struct EpiAct {
    static constexpr bool PERM = true, AFTER_DRAIN = false;
    bf16_t* O; int ldc; const float* bias; const float* ssq; int np; float oscale; float* vst; int stat_pn0;
    __device__ __forceinline__ void operator()(const f32x4 (&acc)[2][2][4][2], const Unit& u, int wr, int wc, int fr, int fq) const {
        const int row0 = u.pm * BM + wr * 64 + fr, col0 = u.pn * BM + wc * 32 + 8 * fq;
        f32x4 bv[2][2];
#pragma unroll
        for (int bj = 0; bj < 2; ++bj)
#pragma unroll
            for (int n = 0; n < 2; ++n) bv[bj][n] = bias ? *(const f32x4*)(bias + col0 + bj * HALF + 4 * n) : (f32x4){0.f, 0.f, 0.f, 0.f};
        float rsv[2][4];
#pragma unroll
        for (int ai = 0; ai < 2; ++ai) {
#pragma unroll
            for (int m = 0; m < 4; ++m) rsv[ai][m] = row_rstd(ssq, np, row0 + ai * HALF + m * 16, fq); }
#pragma unroll
        for (int ai = 0; ai < 2; ++ai)
#pragma unroll
            for (int m = 0; m < 4; ++m) { const int row = row0 + ai * HALF + m * 16; const float rs = rsv[ai][m];
                bf16_t* rowp = O + (size_t)row * ldc + col0; float s1 = 0.f, s2 = 0.f;
#pragma unroll
                for (int bj = 0; bj < 2; ++bj) { f32x4 v0 = acc[ai][bj][m][0] * rs + bv[bj][0], v1 = acc[ai][bj][m][1] * rs + bv[bj][1];
                    if (ACT == 1) { f32x2 a = gelu_pk((f32x2){v0[0], v0[1]}), b = gelu_pk((f32x2){v0[2], v0[3]}), c = gelu_pk((f32x2){v1[0], v1[1]}), d = gelu_pk((f32x2){v1[2], v1[3]});
                        v0 = (f32x4){a.x, a.y, b.x, b.y}; v1 = (f32x4){c.x, c.y, d.x, d.y}; }
                    if (ACT == 2) {
#pragma unroll
                        for (int j = 0; j < 4; ++j) { const float a = fmaxf(v0[j], 0.f), b = fmaxf(v1[j], 0.f); v0[j] = a * a; v1[j] = b * b; } }
                    v0 = v0 * oscale; v1 = v1 * oscale;
                    if (STATS) { s1 += (v0[0] + v0[1]) + (v0[2] + v0[3]) + (v1[0] + v1[1]) + (v1[2] + v1[3]);
                        s2 += (v0[0] * v0[0] + v0[1] * v0[1]) + (v0[2] * v0[2] + v0[3] * v0[3]) + (v1[0] * v1[0] + v1[1] * v1[1]) + (v1[2] * v1[2] + v1[3] * v1[3]); }
                    u32x4 w; w.x = cvt_pk_bf16(v0[0], v0[1]); w.y = cvt_pk_bf16(v0[2], v0[3]); w.z = cvt_pk_bf16(v1[0], v1[1]); w.w = cvt_pk_bf16(v1[2], v1[3]);
                    *(u32x4*)(rowp + bj * HALF) = w; }
                if (STATS) { s1 += __shfl_xor(s1, 16); s1 += __shfl_xor(s1, 32); s2 += __shfl_xor(s2, 16); s2 += __shfl_xor(s2, 32);
                    if (u.pn >= stat_pn0 && fq == 0) *(f32x2*)(vst + (size_t)row * SSQ_STRIDE + ((u.pn - stat_pn0) * 4 + wc) * 2) = (f32x2){s1, s2}; }
            }
    }
};
struct EpiRes {
    static constexpr bool PERM = false, AFTER_DRAIN = false;
    const float* base; float* out; bf16_t* xb; float* ssq;
    __device__ __forceinline__ void operator()(const f32x4 (&acc)[2][2][4][2], const Unit& u, int wr, int wc, int fr, int fq) const {
        const int row0 = u.pm * BM + wr * 64 + fr, col0 = u.pn * BM + wc * 32 + 4 * fq;
#pragma unroll
        for (int ai = 0; ai < 2; ++ai) {
            f32x4 pre[4][2][2];
#pragma unroll
            for (int m = 0; m < 4; ++m) { const size_t off = (size_t)(row0 + ai * HALF + m * 16) * 2048 + col0;
#pragma unroll
                for (int bj = 0; bj < 2; ++bj)
#pragma unroll
                    for (int n = 0; n < 2; ++n) pre[m][bj][n] = *(const f32x4*)(base + off + bj * HALF + n * 16); }
            asm volatile("" ::: "memory");
#pragma unroll
            for (int m = 0; m < 4; ++m) { const int row = row0 + ai * HALF + m * 16; const size_t off = (size_t)row * 2048 + col0; float ss = 0.f;
#pragma unroll
                for (int bj = 0; bj < 2; ++bj)
#pragma unroll
                    for (int n = 0; n < 2; ++n) { const f32x4 o = pre[m][bj][n] + acc[ai][bj][m][n];
                        *(f32x4*)(out + off + bj * HALF + n * 16) = o; ss += (o[0] * o[0] + o[1] * o[1]) + (o[2] * o[2] + o[3] * o[3]);
                        u32x2 w; w.x = cvt_pk_bf16(o[0], o[1]); w.y = cvt_pk_bf16(o[2], o[3]); *(u32x2*)(xb + off + bj * HALF + n * 16) = w; }
                ss += __shfl_xor(ss, 16); ss += __shfl_xor(ss, 32);
                if (fq == 0) ssq[(size_t)row * SSQ_STRIDE + u.pn * 4 + wc] = ss; }
            asm volatile("" ::: "memory"); }
    }
};
struct EpiGlu {
    static constexpr bool PERM = false, AFTER_DRAIN = false;
    const float* base; float* out; bf16_t* xb; float* ssq; const float* bias;
    __device__ __forceinline__ void operator()(const f32x4 (&acc)[2][2][4][2], const Unit& u, int wr, int wc, int fr, int fq) const {
        const int row0 = u.pm * BM + wr * 64 + fr, col0 = u.pn * 128 + wc * 16 + 4 * fq;
        f32x4 bval[2], bgate[2];
#pragma unroll
        for (int bj = 0; bj < 2; ++bj) { bval[bj] = *(const f32x4*)(bias + col0 + bj * 64); bgate[bj] = *(const f32x4*)(bias + 2048 + col0 + bj * 64); }
#pragma unroll
        for (int ai = 0; ai < 2; ++ai) {
            f32x4 pre[4][2];
#pragma unroll
            for (int m = 0; m < 4; ++m) { const size_t off = (size_t)(row0 + ai * HALF + m * 16) * 2048 + col0;
#pragma unroll
                for (int bj = 0; bj < 2; ++bj) pre[m][bj] = *(const f32x4*)(base + off + bj * 64); }
            asm volatile("" ::: "memory");
#pragma unroll
            for (int m = 0; m < 4; ++m) { const int row = row0 + ai * HALF + m * 16; const size_t off = (size_t)row * 2048 + col0; float ss = 0.f;
#pragma unroll
                for (int bj = 0; bj < 2; ++bj) { const f32x4 val = acc[ai][bj][m][0] + bval[bj], gate = acc[ai][bj][m][1] + bgate[bj]; f32x4 o = pre[m][bj];
#pragma unroll
                    for (int j = 0; j < 4; ++j) { const float sg = __builtin_amdgcn_rcpf(1.0f + __builtin_amdgcn_exp2f(-1.4426950408889634f * gate[j])); o[j] += val[j] * sg; }
                    *(f32x4*)(out + off + bj * 64) = o; ss += (o[0] * o[0] + o[1] * o[1]) + (o[2] * o[2] + o[3] * o[3]);
                    u32x2 w; w.x = cvt_pk_bf16(o[0], o[1]); w.y = cvt_pk_bf16(o[2], o[3]); *(u32x2*)(xb + off + bj * 64) = w; }
                ss += __shfl_xor(ss, 16); ss += __shfl_xor(ss, 32);
                if (fq == 0) ssq[(size_t)row * SSQ_STRIDE + u.pn * 4 + wc] = ss; }
            asm volatile("" ::: "memory"); }
    }
};
__host__ __device__ __forceinline__ int vt_pos(int key) { const int s = key >> 5, w = key & 31; return 32 * s + 8 * ((w & 15) >> 2) + (w & 3) + 4 * (w >> 4); }
struct EpiKV {
    static constexpr bool PERM = true, AFTER_DRAIN = false;
    bf16_t* Kb; bf16_t* Vb; bf16_t* VTb; const float* ssq;
    __device__ __forceinline__ void operator()(const f32x4 (&acc)[2][2][4][2], const Unit& u, int wr, int wc, int fr, int fq) const {
        const int row0 = u.pm * BM + wr * 64 + fr, col0 = u.pn * BM + wc * 32 + 8 * fq;
#pragma unroll
        for (int ai = 0; ai < 2; ++ai)
#pragma unroll
            for (int m = 0; m < 4; ++m) { const int row = row0 + ai * HALF + m * 16; const float rs = row_rstd(ssq, 32, row, fq); const int b = row >> 8, key = row & 255;
#pragma unroll
                for (int bj = 0; bj < 2; ++bj) { const f32x4 v0 = acc[ai][bj][m][0] * rs, v1 = acc[ai][bj][m][1] * rs; const int col = col0 + bj * HALF;
                    u32x4 w; w.x = cvt_pk_bf16(v0[0], v0[1]); w.y = cvt_pk_bf16(v0[2], v0[3]); w.z = cvt_pk_bf16(v1[0], v1[1]); w.w = cvt_pk_bf16(v1[2], v1[3]);
                    if (col < 2048) { const int h = col >> 9, d = col & 511; *(u32x4*)(Kb + ((size_t)((b * 4 + h) * 256 + key)) * 512 + d) = w; }
                    else { const int c2 = col - 2048, h = c2 >> 9, d = c2 & 511; *(u32x4*)(Vb + ((size_t)((b * 4 + h) * 256 + key)) * 512 + d) = w;
                        bf16_t* vt = VTb + ((size_t)((b * 4 + h) * 512 + d)) * 256 + vt_pos(key);
                        vt[0 * 256] = (bf16_t)(w.x & 0xffffu); vt[1 * 256] = (bf16_t)(w.x >> 16); vt[2 * 256] = (bf16_t)(w.y & 0xffffu); vt[3 * 256] = (bf16_t)(w.y >> 16);
                        vt[4 * 256] = (bf16_t)(w.z & 0xffffu); vt[5 * 256] = (bf16_t)(w.z >> 16); vt[6 * 256] = (bf16_t)(w.w & 0xffffu); vt[7 * 256] = (bf16_t)(w.w >> 16); } }
            }
    }
};
template <class Epi, class Sched, bool ALIGN_EPI = false, bool SP2 = false>
__device__ __forceinline__ void gemm_phase(PG8_LAS unsigned char* lds, const Gemm g, const Sched& S, const Epi& E, const int wid  , const int lane) {
    const int tid = wid * 64 + lane, wr = wid >> 2, wc = wid & 3, fr = lane & 15, fq = lane >> 4;
    const int K = g.K, nt = K / BK;
    unsigned voffA[2], voffB[2];
#pragma unroll
    for (int i = 0; i < 2; ++i) { int R, C; stage_rc(tid * 16 + i * 8192, R, C); const int Rb = Epi::PERM ? ((R & ~31) + perm32(R & 31)) : R;
        voffA[i] = (unsigned)(R * K + C) * 2u; voffB[i] = (unsigned)(Rb * K + C) * 2u; }
    const size_t kstep = (size_t)(BK * 2);
    const size_t hstep = (size_t)HALF * K * 2;
    const size_t tstep = 2 * hstep;
    const unsigned ldsw = (unsigned)wid * 1024u;
    const int aoff = lds_byte(wr * 64 + fr, fq * 8), boff = lds_byte(wc * 32 + fr, fq * 8);
#define PG8_SA(b, h) (((b) * 2 + (h)) * HTB)
#define PG8_SB(b, h) ((4 + (b) * 2 + (h)) * HTB)
#define PG8_STAGE(bufoff, gbase, voff) do { _Pragma("unroll") for (int _i = 0; _i < 2; ++_i) \
        __builtin_amdgcn_global_load_lds((const unsigned*)((const char*)(gbase) + (voff)[_i]), (PG8_LAS unsigned*)(lds + (bufoff) + ldsw + _i * 8192), 16, 0, 0); } while (0)
#define PG8_LDA(dst, b, h) do { _Pragma("unroll") for (int m = 0; m < 4; ++m) _Pragma("unroll") for (int k = 0; k < 2; ++k) dst[m][k] = *(const PG8_LAS bf16x8*)(lds + PG8_SA(b, h) + aoff + m * 2048 + k * 1024); } while (0)
#define PG8_LDB(dst, b, h) do { _Pragma("unroll") for (int n = 0; n < 2; ++n) _Pragma("unroll") for (int k = 0; k < 2; ++k) dst[n][k] = *(const PG8_LAS bf16x8*)(lds + PG8_SB(b, h) + boff + n * 2048 + k * 1024); } while (0)
#define PG8_MMA(ai, bj, At, Bt) do { __builtin_amdgcn_s_setprio(1); _Pragma("unroll") for (int m = 0; m < 4; ++m) _Pragma("unroll") for (int n = 0; n < 2; ++n) _Pragma("unroll") for (int k = 0; k < 2; ++k) \
        acc[ai][bj][m][n] = __builtin_amdgcn_mfma_f32_16x16x32_bf16(Bt[n][k], At[m][k], acc[ai][bj][m][n], 0, 0, 0); __builtin_amdgcn_s_setprio(0); } while (0)
#define PG8_WAIT_V(n) asm volatile("s_waitcnt vmcnt(" #n ")" ::: "memory")
#define PG8_WAIT_L(n) asm volatile("s_waitcnt lgkmcnt(" #n ")" ::: "memory")
#define PG8_BAR __builtin_amdgcn_s_barrier()
#define PG8_SCHED __builtin_amdgcn_sched_barrier(0)
    Unit cur, nxt; int ui = 0;
    if (!S.next(0, cur)) return;
    f32x4 acc[2][2][4][2];
#pragma unroll
    for (int a = 0; a < 2; ++a)
#pragma unroll
        for (int b = 0; b < 2; ++b)
#pragma unroll
            for (int m = 0; m < 4; ++m)
#pragma unroll
                for (int n = 0; n < 2; ++n) acc[a][b][m][n] = (f32x4){0.f, 0.f, 0.f, 0.f};
    bf16x8 At[4][2], B0[2][2], B1[2][2];
    const char* cA = (const char*)g.A + (size_t)cur.pm * tstep; const char* cB = (const char*)g.Bt + (size_t)cur.pn * tstep;
    S.a_ready(cur);
    if constexpr (SP2) {
        PG8_STAGE(PG8_SB(0, 0), cB, voffB); PG8_STAGE(PG8_SB(0, 1), cB + hstep, voffB); PG8_STAGE(PG8_SA(0, 0), cA, voffA); PG8_STAGE(PG8_SA(0, 1), cA + hstep, voffA);
        if (wr == 1) PG8_BAR;
        PG8_WAIT_V(2); PG8_BAR;
        PG8_STAGE(PG8_SB(1, 0), cB + kstep, voffB); PG8_STAGE(PG8_SA(1, 0), cA + kstep, voffA); PG8_STAGE(PG8_SB(1, 1), cB + hstep + kstep, voffB);
        PG8_WAIT_V(6); PG8_BAR;
    } else {
        PG8_STAGE(PG8_SB(0, 0), cB, voffB); PG8_STAGE(PG8_SA(0, 0), cA, voffA); PG8_STAGE(PG8_SB(0, 1), cB + hstep, voffB); PG8_STAGE(PG8_SA(0, 1), cA + hstep, voffA);
        if (wr == 1) PG8_BAR;
        PG8_WAIT_V(4); PG8_BAR;
        PG8_STAGE(PG8_SB(1, 0), cB + kstep, voffB); PG8_STAGE(PG8_SA(1, 0), cA + kstep, voffA); PG8_STAGE(PG8_SB(1, 1), cB + hstep + kstep, voffB);
        PG8_WAIT_V(6); PG8_BAR;
    }
    for (;;) {
        const bool has_next = S.next(ui + 1, nxt);
        const char* nA = has_next ? (const char*)g.A + (size_t)nxt.pm * tstep : cA; const char* nB = has_next ? (const char*)g.Bt + (size_t)nxt.pn * tstep : cB;
        for (int t = 0; t < nt; t += 2) {
            const bool last = (t == nt - 2);
            const char* a1 = cA + (size_t)(t + 1) * kstep;
            const char* a2 = last ? nA : cA + (size_t)(t + 2) * kstep; const char* b2 = last ? nB : cB + (size_t)(t + 2) * kstep;
            const char* a3 = a2 + kstep; const char* b3 = b2 + kstep;
            if (last && has_next) S.a_ready(nxt);
            if constexpr (SP2) {
            PG8_LDB(B0, 0, 0); PG8_LDB(B1, 0, 1); PG8_SCHED; PG8_LDA(At, 0, 0); PG8_STAGE(PG8_SA(1, 1), a1 + hstep, voffA);
            PG8_WAIT_V(8); PG8_WAIT_L(0); PG8_BAR; PG8_MMA(0, 0, At, B0); PG8_MMA(0, 1, At, B1); PG8_BAR; PG8_SCHED;
            PG8_LDA(At, 0, 1); PG8_STAGE(PG8_SB(0, 0), b2, voffB); PG8_STAGE(PG8_SB(0, 1), b2 + hstep, voffB); PG8_STAGE(PG8_SA(0, 0), a2, voffA);
            PG8_WAIT_V(8); PG8_WAIT_L(0); PG8_BAR; PG8_MMA(1, 0, At, B0); PG8_MMA(1, 1, At, B1); PG8_BAR; PG8_SCHED;
            PG8_LDB(B0, 1, 0); PG8_LDB(B1, 1, 1); PG8_SCHED; PG8_LDA(At, 1, 0); PG8_STAGE(PG8_SA(0, 1), a2 + hstep, voffA);
            PG8_WAIT_V(8); PG8_WAIT_L(0); PG8_BAR; PG8_MMA(0, 0, At, B0); PG8_MMA(0, 1, At, B1); PG8_BAR; PG8_SCHED;
            PG8_LDA(At, 1, 1); PG8_STAGE(PG8_SB(1, 0), b3, voffB); PG8_STAGE(PG8_SB(1, 1), b3 + hstep, voffB); PG8_STAGE(PG8_SA(1, 0), a3, voffA);
            PG8_WAIT_V(8); PG8_WAIT_L(0); PG8_BAR; PG8_MMA(1, 0, At, B0); PG8_MMA(1, 1, At, B1); PG8_BAR; PG8_SCHED;
            } else {
            PG8_LDB(B0, 0, 0); PG8_SCHED; PG8_LDA(At, 0, 0); PG8_STAGE(PG8_SA(1, 1), a1 + hstep, voffA);
            PG8_WAIT_L(8); PG8_BAR; PG8_WAIT_L(0); PG8_MMA(0, 0, At, B0); PG8_BAR; PG8_SCHED;
            PG8_LDB(B1, 0, 1); PG8_STAGE(PG8_SB(0, 0), b2, voffB);
            PG8_BAR; PG8_WAIT_L(0); PG8_MMA(0, 1, At, B1); PG8_BAR;
            PG8_LDA(At, 0, 1); PG8_STAGE(PG8_SA(0, 0), a2, voffA);
            PG8_BAR; PG8_WAIT_L(0); PG8_MMA(1, 0, At, B0); PG8_BAR; PG8_SCHED;
            PG8_STAGE(PG8_SB(0, 1), b2 + hstep, voffB);
            PG8_WAIT_V(6); PG8_BAR; PG8_MMA(1, 1, At, B1); PG8_BAR;
            PG8_LDB(B0, 1, 0); PG8_SCHED; PG8_LDA(At, 1, 0); PG8_STAGE(PG8_SA(0, 1), a2 + hstep, voffA);
            PG8_WAIT_L(8); PG8_BAR; PG8_WAIT_L(0); PG8_MMA(0, 0, At, B0); PG8_BAR; PG8_SCHED;
            PG8_LDB(B1, 1, 1); PG8_STAGE(PG8_SB(1, 0), b3, voffB);
            PG8_BAR; PG8_WAIT_L(0); PG8_MMA(0, 1, At, B1); PG8_BAR;
            PG8_LDA(At, 1, 1); PG8_STAGE(PG8_SA(1, 0), a3, voffA);
            PG8_BAR; PG8_WAIT_L(0); PG8_MMA(1, 0, At, B0); PG8_BAR; PG8_SCHED;
            PG8_STAGE(PG8_SB(1, 1), b3 + hstep, voffB);
            PG8_WAIT_V(6); PG8_BAR; PG8_MMA(1, 1, At, B1); PG8_BAR;
            }
        }
        if constexpr (ALIGN_EPI) { if (wr == 0) PG8_BAR; }
        if constexpr (!Epi::AFTER_DRAIN) { Unit ue = cur; asm volatile("" : "+s"(ue.pm), "+s"(ue.pn));
            E(acc, ue, wr, wc, fr, fq); S.done(cur); }
        if (!has_next) break;
#pragma unroll
        for (int a = 0; a < 2; ++a)
#pragma unroll
            for (int b = 0; b < 2; ++b)
#pragma unroll
                for (int m = 0; m < 4; ++m)
#pragma unroll
                    for (int n = 0; n < 2; ++n) acc[a][b][m][n] = (f32x4){0.f, 0.f, 0.f, 0.f};
        cur = nxt; cA = nA; cB = nB; ++ui;
        if constexpr (ALIGN_EPI) { if (wr == 1) PG8_BAR; }
    }
    PG8_WAIT_V(0);
    if constexpr (!ALIGN_EPI) { if (wr == 0) PG8_BAR; }
    PG8_BAR;
    if constexpr (Epi::AFTER_DRAIN) { E.fused(acc, cur, wr, wc, fr, fq, lds, wid, lane); S.done(cur); }
#undef PG8_SA
#undef PG8_SB
#undef PG8_STAGE
#undef PG8_LDA
#undef PG8_LDB
#undef PG8_MMA
#undef PG8_WAIT_V
#undef PG8_WAIT_L
#undef PG8_BAR
#undef PG8_SCHED
}
}
#ifndef MK_N_LAUNCHES
#define MK_N_LAUNCHES 1
#endif
constexpr int BATCH = 2, SEQ = 4096, D = 2048, M = BATCH * SEQ, MEMLEN = 256, MROWS = BATCH * MEMLEN, FF = 8192;
constexpr int NWAVES = 8, NTHREADS = 512, NPH = 20;
constexpr int LDS_BYTES = 147456;
constexpr size_t MiB = 1u << 20;
constexpr size_t WS_W_AIN = 2 * MiB, WS_W_AOUT = 18 * MiB, WS_W_BIN = 26 * MiB, WS_W_BOUT = 34 * MiB, WS_W_Q = 50 * MiB, WS_W_KV = 66 * MiB, WS_W_O = 98 * MiB, WS_W_UP = 114 * MiB, WS_W_DN = 178 * MiB;
constexpr size_t WS_XB = 242 * MiB, WS_MEMB = 274 * MiB, WS_KB = 276 * MiB, WS_VB = 280 * MiB, WS_VTB = 284 * MiB, WS_SSQ = 288 * MiB, WS_VST = 290 * MiB, WS_SSQM = 292 * MiB, WS_S5ST = 294 * MiB;
constexpr size_t WS_R = 304 * MiB, WS_END = 432 * MiB;
#define GAS __attribute__((address_space(1)))
#define LAS __attribute__((address_space(3)))
typedef unsigned short bf16;
typedef unsigned v4u __attribute__((ext_vector_type(4)));
typedef unsigned v2u __attribute__((ext_vector_type(2)));
typedef float f32x4 __attribute__((ext_vector_type(4)));
typedef float f32x2 __attribute__((ext_vector_type(2)));
typedef short bf16x8 __attribute__((ext_vector_type(8)));
#define LDS_WAIT() asm volatile("s_waitcnt lgkmcnt(0)" ::: "memory")
__device__ __forceinline__ unsigned f2bf(float f) { unsigned u = __builtin_bit_cast(unsigned, f); return (u + 0x7fffu + ((u >> 16) & 1u)) >> 16; }
__device__ __forceinline__ unsigned pk2(float lo, float hi) { return f2bf(lo) | (f2bf(hi) << 16); }
__device__ __forceinline__ float bflo(unsigned w) { return __builtin_bit_cast(float, w << 16); }
__device__ __forceinline__ float bfhi(unsigned w) { return __builtin_bit_cast(float, w & 0xffff0000u); }
__device__ __forceinline__ float wave_sum(float v) {
#pragma unroll
    for (int o = 1; o < 64; o <<= 1) v += __shfl_xor(v, o);
    return v;
}
__device__ __forceinline__ float wave_max(float v) {
#pragma unroll
    for (int o = 1; o < 64; o <<= 1) v = fmaxf(v, __shfl_xor(v, o));
    return v;
}
__device__ __forceinline__ float gelu_exact(float v) { return 0.5f * v * (1.0f + erff(v * 0.70710678118654752f)); }

struct Args { const float* in[30]; float* out; unsigned char* ws; int ph_lo, ph_hi; };
__device__ __forceinline__ const float* ka_in(int i) { const __attribute__((address_space(4))) char* ka = (const __attribute__((address_space(4))) char*)__builtin_amdgcn_kernarg_segment_ptr(); asm volatile("" : "+s"(ka)); return *(const float* const __attribute__((address_space(4)))*)(ka + 8 * i); }

__device__ __forceinline__ int glu_rowmap(int n) { return n < 2048 ? 32 * (n >> 4) + (n & 15) : 32 * ((n - 2048) >> 4) + 16 + (n & 15); }
__device__ __forceinline__ void conv_item(const float* W, int K, int N, const float* gk, int mode, bf16* WT, LAS float* scr, int item, int lane) {
    const int nblk = N >> 6, kb = item / nblk, nb = item - kb * nblk, k0 = 64 * kb, n0 = 64 * nb;
    f32x4 v[16];
#pragma unroll
    for (int i = 0; i < 16; ++i) { const int kk = 4 * i + (lane >> 4); v[i] = *(const f32x4*)(W + (size_t)(k0 + kk) * N + n0 + 4 * (lane & 15)); }
#pragma unroll
    for (int i = 0; i < 16; ++i) { const int kk = 4 * i + (lane >> 4); const float s = gk ? gk[k0 + kk] : 1.0f; LAS float* d = scr + kk * 65 + 4 * (lane & 15);
        d[0] = v[i][0] * s; d[1] = v[i][1] * s; d[2] = v[i][2] * s; d[3] = v[i][3] * s; }
    LDS_WAIT();
    const int c = lane & 7;
#pragma unroll
    for (int j = 0; j < 8; ++j) { const int n = (lane >> 3) + 8 * j; const LAS float* s = scr + (8 * c) * 65 + n;
        v4u o; o.x = pk2(s[0 * 65], s[1 * 65]); o.y = pk2(s[2 * 65], s[3 * 65]); o.z = pk2(s[4 * 65], s[5 * 65]); o.w = pk2(s[6 * 65], s[7 * 65]);
        const int nr = mode ? glu_rowmap(n0 + n) : (n0 + n);
        *(v4u*)(WT + (size_t)nr * K + k0 + 8 * c) = o; }
    LDS_WAIT();
}
__device__ __forceinline__ void row_to_bf16(const float* xrow, bf16* orow, float* ssqrow, int lane) {
    f32x4 v[8]; float s = 0.f;
#pragma unroll
    for (int j = 0; j < 8; ++j) { v[j] = ((const f32x4*)xrow)[lane + 64 * j]; s += (v[j][0] * v[j][0] + v[j][1] * v[j][1]) + (v[j][2] * v[j][2] + v[j][3] * v[j][3]); }
    s = wave_sum(s);
#pragma unroll
    for (int j = 0; j < 8; ++j) { v2u w; w.x = pk2(v[j][0], v[j][1]); w.y = pk2(v[j][2], v[j][3]); ((v2u*)orow)[lane + 64 * j] = w; }
    if (lane < 32) ssqrow[lane] = (lane == 0) ? s : 0.f;
}
__device__ __forceinline__ void p0_prologue(unsigned char* ws, LAS unsigned char* lds, int wave, int lane) {
    LAS float* scr = (LAS float*)(lds + wave * 16640);
    const int gw = blockIdx.x * NWAVES + wave, NGW = gridDim.x * NWAVES;
    constexpr int NITEMS = 30720;
    for (int it0 = gw; it0 < NITEMS; it0 += NGW) {
        int r = __builtin_amdgcn_readfirstlane(it0);
        const float* W; const float* g = nullptr; bf16* WT; int K = 2048, N = 2048, mode = 0;
        if (r < 2048) { W = ka_in(7); g = ka_in(2); WT = (bf16*)(ws + WS_W_AIN); N = 4096; }
        else if ((r -= 2048) < 1024) { W = ka_in(13); WT = (bf16*)(ws + WS_W_AOUT); }
        else if ((r -= 1024) < 1024) { W = ka_in(14); g = ka_in(2) + 2048; WT = (bf16*)(ws + WS_W_BIN); }
        else if ((r -= 1024) < 2048) { W = ka_in(23); WT = (bf16*)(ws + WS_W_BOUT); N = 4096; mode = 1; }
        else if ((r -= 2048) < 2048) { const int i = r >> 10; r &= 1023; W = ka_in(25) + (size_t)i * 2048 * 2048; g = ka_in(3) + i * 2048; WT = (bf16*)(ws + WS_W_Q + i * 8 * MiB); }
        else if ((r -= 2048) < 4096) { const int i = r >> 11; r &= 2047; W = ka_in(26) + (size_t)i * 2048 * 4096; g = ka_in(4) + i * 2048; WT = (bf16*)(ws + WS_W_KV + i * 16 * MiB); N = 4096; }
        else if ((r -= 4096) < 2048) { const int i = r >> 10; r &= 1023; W = ka_in(27) + (size_t)i * 2048 * 2048; WT = (bf16*)(ws + WS_W_O + i * 8 * MiB); }
        else if ((r -= 2048) < 8192) { const int i = r >> 12; r &= 4095; W = ka_in(28) + (size_t)i * 2048 * 8192; g = ka_in(5) + i * 2048; WT = (bf16*)(ws + WS_W_UP + i * 32 * MiB); N = 8192; }
        else { r -= 8192; const int i = r >> 12; r &= 4095; W = ka_in(29) + (size_t)i * 8192 * 2048; WT = (bf16*)(ws + WS_W_DN + i * 32 * MiB); K = 8192; }
        conv_item(W, K, N, g, mode, WT, scr, r, lane);
    }
    for (int m = gw; m < M + MROWS; m += NGW) {
        if (m < M) row_to_bf16(ka_in(0) + (size_t)m * D, (bf16*)(ws + WS_XB) + (size_t)m * D, (float*)(ws + WS_SSQ) + (size_t)m * 64, lane);
        else { const int r = m - M; row_to_bf16(ka_in(1) + (size_t)r * D, (bf16*)(ws + WS_MEMB) + (size_t)r * D, (float*)(ws + WS_SSQM) + (size_t)r * 64, lane); }
    }
}
__device__ __forceinline__ void final_norm(float* x, const float* g, int wave, int lane) {
    const int gw = blockIdx.x * NWAVES + wave, NGW = gridDim.x * NWAVES;
    for (int m = gw; m < M; m += NGW) { f32x4* xr = (f32x4*)(x + (size_t)m * D); f32x4 v[8]; float s = 0.f;
#pragma unroll
        for (int j = 0; j < 8; ++j) { v[j] = xr[lane + 64 * j]; s += (v[j][0] * v[j][0] + v[j][1] * v[j][1]) + (v[j][2] * v[j][2] + v[j][3] * v[j][3]); }
        const float rs = 1.0f / sqrtf(wave_sum(s) * (1.0f / D) + 1e-6f);
#pragma unroll
        for (int j = 0; j < 8; ++j) { const f32x4 gv = ((const f32x4*)g)[lane + 64 * j]; xr[lane + 64 * j] = v[j] * rs * gv; } }
}
__device__ __forceinline__ void gating_simple(LAS unsigned char* lds, const bf16* z, const float* vst, const float* ln_g, const float* ln_b, const float* w_s, const float* b_s, bf16* gbuf, int tid) {
    LAS float* vln = (LAS float*)lds;
    LAS float* Wl = (LAS float*)(lds + 65536);
    LAS float* mu = (LAS float*)(lds + 65536 + 128 * 129 * 4);
    LAS float* rsd = mu + 128;
    for (int unit = blockIdx.x; unit < 1024; unit += gridDim.x) {
        const int h = unit & 15, tok0 = (unit >> 4) * 128;
        if (tid < 128) { const float* p = vst + (size_t)(tok0 + tid) * 64; float s1 = 0.f, s2 = 0.f;
#pragma unroll 8
            for (int i = 0; i < 32; ++i) { s1 += p[2 * i]; s2 += p[2 * i + 1]; }
            const float mean = s1 * (1.0f / 2048.0f), var = s2 * (1.0f / 2048.0f) - mean * mean; mu[tid] = mean; rsd[tid] = 1.0f / sqrtf(var + 1e-6f); }
        __syncthreads();
        { const int s = tid >> 2, db = (tid & 3) * 32; const float mean = mu[s], rs = rsd[s];
            const bf16* vp = z + (size_t)(tok0 + s) * 4096 + 2048 + h * 128 + db;
#pragma unroll
            for (int q = 0; q < 4; ++q) { const v4u w = *(const v4u*)(vp + 8 * q); const float* gp = ln_g + h * 128 + db + 8 * q; const float* bp = ln_b + h * 128 + db + 8 * q; LAS float* o = vln + s * 128 + db + 8 * q;
                o[0] = (bflo(w.x) - mean) * rs * gp[0] + bp[0]; o[1] = (bfhi(w.x) - mean) * rs * gp[1] + bp[1]; o[2] = (bflo(w.y) - mean) * rs * gp[2] + bp[2]; o[3] = (bfhi(w.y) - mean) * rs * gp[3] + bp[3];
                o[4] = (bflo(w.z) - mean) * rs * gp[4] + bp[4]; o[5] = (bfhi(w.z) - mean) * rs * gp[5] + bp[5]; o[6] = (bflo(w.w) - mean) * rs * gp[6] + bp[6]; o[7] = (bfhi(w.w) - mean) * rs * gp[7] + bp[7]; }
            const float* wp = w_s + ((size_t)h * 128 + s) * 128 + db;
#pragma unroll
            for (int q = 0; q < 8; ++q) { const f32x4 w4 = *(const f32x4*)(wp + 4 * q); LAS float* o = Wl + s * 129 + db + 4 * q; o[0] = w4[0]; o[1] = w4[1]; o[2] = w4[2]; o[3] = w4[3]; } }
        __syncthreads();
        { const int t = tid >> 2, d0 = (tid & 3) * 32, tmax = t | 15; float acc[32];
#pragma unroll
            for (int j = 0; j < 32; ++j) acc[j] = 0.f;
            for (int s = 0; s <= tmax; ++s) { const float w = (s <= t) ? Wl[t * 129 + s] : 0.f; const LAS f32x4* vr = (const LAS f32x4*)(vln + s * 128 + d0);
#pragma unroll
                for (int q = 0; q < 8; ++q) { const f32x4 vv = vr[q]; acc[4 * q] += w * vv[0]; acc[4 * q + 1] += w * vv[1]; acc[4 * q + 2] += w * vv[2]; acc[4 * q + 3] += w * vv[3]; } }
            const float bs = b_s[h * 128 + t];
            const bf16* up = z + (size_t)(tok0 + t) * 4096 + h * 128 + d0; bf16* op = gbuf + (size_t)(tok0 + t) * 2048 + h * 128 + d0;
#pragma unroll
            for (int q = 0; q < 4; ++q) { const v4u w = *(const v4u*)(up + 8 * q); v4u o;
                o.x = pk2(bflo(w.x) * (acc[8 * q] + bs), bfhi(w.x) * (acc[8 * q + 1] + bs)); o.y = pk2(bflo(w.y) * (acc[8 * q + 2] + bs), bfhi(w.y) * (acc[8 * q + 3] + bs));
                o.z = pk2(bflo(w.z) * (acc[8 * q + 4] + bs), bfhi(w.z) * (acc[8 * q + 5] + bs)); o.w = pk2(bflo(w.w) * (acc[8 * q + 6] + bs), bfhi(w.w) * (acc[8 * q + 7] + bs));
                *(v4u*)(op + 8 * q) = o; } }
        __syncthreads();
    }
}
__device__ __forceinline__ void gating_mfma(LAS unsigned char* lds, const bf16* z, const float* vst, const float* ln_g, const float* ln_b, const float* w_s, const float* b_s, bf16* gbuf, int wave, int lane) {
    LAS float* MU = (LAS float*)(lds + 69632);
    const int tid = wave * 64 + lane, fr = lane & 15, fq = lane >> 4;
    const int ss = tid >> 2, db = (tid & 3) * 32;
    for (int unit = blockIdx.x; unit < 256; unit += gridDim.x) {
        const int tok0 = (unit >> 2) * 128, hg = unit & 3;
        __syncthreads();
        if (tid < 128) { const float* sp = vst + (size_t)(tok0 + tid) * 64; float s1 = 0.f, s2 = 0.f;
#pragma unroll
            for (int i = 0; i < 16; ++i) { const f32x4 a = *(const f32x4*)(sp + 4 * i); s1 += a[0] + a[2]; s2 += a[1] + a[3]; }
            const float mean = s1 * (1.0f / 2048.0f), var = s2 * (1.0f / 2048.0f) - mean * mean; MU[tid] = mean; MU[128 + tid] = 1.0f / sqrtf(var + 1e-6f); }
        v4u raw[4];
        { const bf16* vp = z + (size_t)(tok0 + ss) * 4096 + 2048 + (hg * 4) * 128 + db;
#pragma unroll
            for (int q4 = 0; q4 < 4; ++q4) raw[q4] = *(const v4u*)(vp + 8 * q4); }
        __syncthreads();
        const float mean = MU[ss], rs = MU[128 + ss];
#pragma unroll 1
        for (int hh = 0; hh < 4; ++hh) { const int h = hg * 4 + hh; LAS unsigned char* VT = lds + (hh & 1) * 34816;
            { const float* gp = ln_g + h * 128 + db; const float* bp = ln_b + h * 128 + db; LAS unsigned char* wp = VT + db * 272 + ss * 2;
#pragma unroll
                for (int q4 = 0; q4 < 4; ++q4) { const f32x4 g0 = *(const f32x4*)(gp + 8 * q4), g1 = *(const f32x4*)(gp + 8 * q4 + 4), b0 = *(const f32x4*)(bp + 8 * q4), b1 = *(const f32x4*)(bp + 8 * q4 + 4); const v4u w = raw[q4];
                    const float v0 = (bflo(w.x) - mean) * rs * g0[0] + b0[0], v1 = (bfhi(w.x) - mean) * rs * g0[1] + b0[1], v2 = (bflo(w.y) - mean) * rs * g0[2] + b0[2], v3 = (bfhi(w.y) - mean) * rs * g0[3] + b0[3];
                    const float v4 = (bflo(w.z) - mean) * rs * g1[0] + b1[0], v5 = (bfhi(w.z) - mean) * rs * g1[1] + b1[1], v6 = (bflo(w.w) - mean) * rs * g1[2] + b1[2], v7 = (bfhi(w.w) - mean) * rs * g1[3] + b1[3];
                    LAS unsigned char* o = wp + (8 * q4) * 272;
                    *(LAS bf16*)(o + 0 * 272) = (bf16)f2bf(v0); *(LAS bf16*)(o + 1 * 272) = (bf16)f2bf(v1); *(LAS bf16*)(o + 2 * 272) = (bf16)f2bf(v2); *(LAS bf16*)(o + 3 * 272) = (bf16)f2bf(v3);
                    *(LAS bf16*)(o + 4 * 272) = (bf16)f2bf(v4); *(LAS bf16*)(o + 5 * 272) = (bf16)f2bf(v5); *(LAS bf16*)(o + 6 * 272) = (bf16)f2bf(v6); *(LAS bf16*)(o + 7 * 272) = (bf16)f2bf(v7); } }
            if (hh < 3) { const bf16* vp = z + (size_t)(tok0 + ss) * 4096 + 2048 + (h + 1) * 128 + db;
#pragma unroll
                for (int q4 = 0; q4 < 4; ++q4) raw[q4] = *(const v4u*)(vp + 8 * q4); }
            __syncthreads();
            const int t = 16 * wave + fr, nks = (wave >> 1) + 1;
            bf16x8 wf[4];
#pragma unroll
            for (int ks = 0; ks < 4; ++ks) { wf[ks] = (bf16x8){0, 0, 0, 0, 0, 0, 0, 0};
                if (ks < nks) { const float* wp = w_s + ((size_t)h * 128 + t) * 128 + 32 * ks + 8 * fq; const f32x4 a = *(const f32x4*)wp, c = *(const f32x4*)(wp + 4); const int s0 = 32 * ks + 8 * fq;
                    float v[8] = {a[0], a[1], a[2], a[3], c[0], c[1], c[2], c[3]};
#pragma unroll
                    for (int j = 0; j < 8; ++j) v[j] = (s0 + j <= t) ? v[j] : 0.f;
                    v4u w; w.x = pk2(v[0], v[1]); w.y = pk2(v[2], v[3]); w.z = pk2(v[4], v[5]); w.w = pk2(v[6], v[7]); wf[ks] = __builtin_bit_cast(bf16x8, w); } }
            const float bs = b_s[h * 128 + t];
            const bf16* up = z + (size_t)(tok0 + t) * 4096 + h * 128 + 4 * fq; bf16* op = gbuf + (size_t)(tok0 + t) * 2048 + h * 128 + 4 * fq;
            const LAS unsigned char* ab = VT + fr * 272 + fq * 16;
#pragma unroll
            for (int df = 0; df < 8; ++df) { f32x4 acc = (f32x4){0.f, 0.f, 0.f, 0.f};
#pragma unroll
                for (int ks = 0; ks < 4; ++ks) if (ks < nks) { const bf16x8 a = *(const LAS bf16x8*)(ab + df * 16 * 272 + ks * 64); acc = __builtin_amdgcn_mfma_f32_16x16x32_bf16(a, wf[ks], acc, 0, 0, 0); }
                const v2u uw = *(const v2u*)(up + 16 * df); v2u ow;
                ow.x = pg8::cvt_pk_bf16(bflo(uw.x) * (acc[0] + bs), bfhi(uw.x) * (acc[1] + bs)); ow.y = pg8::cvt_pk_bf16(bflo(uw.y) * (acc[2] + bs), bfhi(uw.y) * (acc[3] + bs));
                *(v2u*)(op + 16 * df) = ow; }
        }
    }
    __syncthreads();
}
__device__ __forceinline__ void attn_simple(LAS unsigned char* lds, const bf16* q, const bf16* Kb, const bf16* Vb, bf16* obuf, int wave, int lane) {
    LAS float* pl = (LAS float*)(lds + wave * 1024);
    const int gw = blockIdx.x * NWAVES + wave, NGW = gridDim.x * NWAVES;
    for (int task = gw; task < BATCH * 4 * SEQ; task += NGW) {
        const int bh = task >> 12, t = task & 4095, b = bh >> 2, h = bh & 3;
        float qf[8]; { const v4u w = *(const v4u*)(q + ((size_t)(b * SEQ + t)) * 2048 + h * 512 + 8 * lane);
            qf[0] = bflo(w.x); qf[1] = bfhi(w.x); qf[2] = bflo(w.y); qf[3] = bfhi(w.y); qf[4] = bflo(w.z); qf[5] = bfhi(w.z); qf[6] = bflo(w.w); qf[7] = bfhi(w.w); }
        const bf16* kp = Kb + (size_t)bh * 256 * 512 + 8 * lane;
        float sc[4];
#pragma unroll
        for (int kk = 0; kk < 4; ++kk) { float mine = 0.f;
            for (int l2 = 0; l2 < 64; ++l2) { const v4u w = *(const v4u*)(kp + (size_t)(kk * 64 + l2) * 512);
                float dsum = qf[0] * bflo(w.x) + qf[1] * bfhi(w.x) + qf[2] * bflo(w.y) + qf[3] * bfhi(w.y) + qf[4] * bflo(w.z) + qf[5] * bfhi(w.z) + qf[6] * bflo(w.w) + qf[7] * bfhi(w.w);
                dsum = wave_sum(dsum); if (lane == l2) mine = dsum; }
            sc[kk] = mine; }
        const float mx = wave_max(fmaxf(fmaxf(sc[0], sc[1]), fmaxf(sc[2], sc[3])));
        float p[4], ps = 0.f;
#pragma unroll
        for (int kk = 0; kk < 4; ++kk) { p[kk] = exp2f(sc[kk] - mx); ps += p[kk]; pl[kk * 64 + lane] = p[kk]; }
        const float inv = 1.0f / wave_sum(ps);
        LDS_WAIT();
        float o[8];
#pragma unroll
        for (int i = 0; i < 8; ++i) o[i] = 0.f;
        const bf16* vp = Vb + (size_t)bh * 256 * 512 + 8 * lane;
        for (int key = 0; key < 256; ++key) { const float pk = pl[key]; const v4u w = *(const v4u*)(vp + (size_t)key * 512);
            o[0] += pk * bflo(w.x); o[1] += pk * bfhi(w.x); o[2] += pk * bflo(w.y); o[3] += pk * bfhi(w.y); o[4] += pk * bflo(w.z); o[5] += pk * bfhi(w.z); o[6] += pk * bflo(w.w); o[7] += pk * bfhi(w.w); }
        v4u ow; ow.x = pk2(o[0] * inv, o[1] * inv); ow.y = pk2(o[2] * inv, o[3] * inv); ow.z = pk2(o[4] * inv, o[5] * inv); ow.w = pk2(o[6] * inv, o[7] * inv);
        *(v4u*)(obuf + ((size_t)(b * SEQ + t)) * 2048 + h * 512 + 8 * lane) = ow;
        LDS_WAIT();
    }
}
__device__ __forceinline__ void attn_mfma(LAS unsigned char* lds, const bf16* q, const bf16* Kb, const bf16* VTb, bf16* obuf, int wave, int lane) {
    const int tid = wave * 64 + lane, fr = lane & 15, fq = lane >> 4;
    unsigned voffK[2], voffV[2];
#pragma unroll
    for (int i = 0; i < 2; ++i) { int R, C; pg8::stage_rc(tid * 16 + i * 8192, R, C); voffK[i] = (unsigned)(R * 512 + C) * 2u; voffV[i] = (unsigned)(R * 256 + C) * 2u; }
    const unsigned ldsw = (unsigned)wave * 1024u;
    const int aoff0 = pg8::lds_byte(fr, fq * 8);
#define AT_STAGE_K(c, buf) do { _Pragma("unroll") for (int ht = 0; ht < 4; ++ht) { const char* src = Kg + ((size_t)(128 * (ht >> 1)) * 512 + 128 * (c) + 64 * (ht & 1)) * 2; \
        _Pragma("unroll") for (int i = 0; i < 2; ++i) __builtin_amdgcn_global_load_lds((const unsigned*)(src + voffK[i]), (LAS unsigned*)(lds + (buf) * 65536 + ht * 16384 + ldsw + i * 8192), 16, 0, 0); } } while (0)
#define AT_STAGE_V(cc, buf) do { _Pragma("unroll") for (int ht = 0; ht < 4; ++ht) { const char* src = Vg + ((size_t)(128 * ht) * 256 + 64 * (cc)) * 2; \
        _Pragma("unroll") for (int i = 0; i < 2; ++i) __builtin_amdgcn_global_load_lds((const unsigned*)(src + voffV[i]), (LAS unsigned*)(lds + (buf) * 65536 + ht * 16384 + ldsw + i * 8192), 16, 0, 0); } } while (0)
#define AT_WAIT() do { asm volatile("s_waitcnt vmcnt(0)" ::: "memory"); __syncthreads(); } while (0)
    for (int unit = blockIdx.x; unit < 256; unit += gridDim.x) {
        const int bh = unit >> 5, qb = unit & 31, b = bh >> 2, h = bh & 3;
        const char* Kg = (const char*)(Kb + (size_t)bh * 256 * 512);
        const char* Vg = (const char*)(VTb + (size_t)bh * 512 * 256);
        const size_t tok = (size_t)(b * SEQ + qb * 128 + 16 * wave + fr);
        bf16x8 qf[16];
        { const bf16* qp = q + tok * 2048 + h * 512 + 8 * fq;
#pragma unroll
            for (int s = 0; s < 16; ++s) qf[s] = *(const bf16x8*)(qp + 32 * s); }
        f32x4 acc[16];
#pragma unroll
        for (int n = 0; n < 16; ++n) acc[n] = (f32x4){0.f, 0.f, 0.f, 0.f};
        AT_STAGE_K(0, 0);
#pragma unroll
        for (int c = 0; c < 4; ++c) {
            AT_WAIT();
            if (c < 3) AT_STAGE_K(c + 1, (c + 1) & 1); else AT_STAGE_V(0, 0);
            const LAS unsigned char* bb = lds + (c & 1) * 65536 + aoff0; asm volatile("" : "+v"(bb));
#pragma unroll
            for (int kh = 0; kh < 2; ++kh)
#pragma unroll
                for (int k = 0; k < 2; ++k)
#pragma unroll
                    for (int ng = 0; ng < 2; ++ng) { bf16x8 a[8];
#pragma unroll
                        for (int n8 = 0; n8 < 8; ++n8) a[n8] = *(const LAS bf16x8*)(bb + (ng * 2 + kh) * 16384 + n8 * 2048 + k * 1024);
#pragma unroll
                        for (int n8 = 0; n8 < 8; ++n8) acc[ng * 8 + n8] = __builtin_amdgcn_mfma_f32_16x16x32_bf16(a[n8], qf[4 * c + 2 * kh + k], acc[ng * 8 + n8], 0, 0, 0);
                        __builtin_amdgcn_sched_barrier(0); }
        }
        float mx = acc[0][0];
#pragma unroll
        for (int n = 0; n < 16; ++n) mx = fmaxf(fmaxf(mx, fmaxf(acc[n][0], acc[n][1])), fmaxf(acc[n][2], acc[n][3]));
        mx = fmaxf(mx, __shfl_xor(mx, 16)); mx = fmaxf(mx, __shfl_xor(mx, 32));
        float l = 0.f;
#pragma unroll
        for (int n = 0; n < 16; ++n)
#pragma unroll
            for (int r = 0; r < 4; ++r) { const float pv = __builtin_amdgcn_exp2f(acc[n][r] - mx); acc[n][r] = pv; l += pv; }
        l += __shfl_xor(l, 16); l += __shfl_xor(l, 32);
        const float linv = 1.0f / l;
        bf16x8 pf[8];
#pragma unroll
        for (int s = 0; s < 8; ++s) { v4u w; w.x = pg8::cvt_pk_bf16(acc[2 * s][0], acc[2 * s][1]); w.y = pg8::cvt_pk_bf16(acc[2 * s][2], acc[2 * s][3]);
            w.z = pg8::cvt_pk_bf16(acc[2 * s + 1][0], acc[2 * s + 1][1]); w.w = pg8::cvt_pk_bf16(acc[2 * s + 1][2], acc[2 * s + 1][3]); pf[s] = __builtin_bit_cast(bf16x8, w); }
        __builtin_amdgcn_sched_barrier(0);
        f32x4 o[32];
#pragma unroll
        for (int mm = 0; mm < 32; ++mm) o[mm] = (f32x4){0.f, 0.f, 0.f, 0.f};
#pragma unroll
        for (int cc = 0; cc < 4; ++cc) {
            AT_WAIT();
            if (cc < 3) AT_STAGE_V(cc + 1, (cc + 1) & 1);
            const LAS unsigned char* bb = lds + (cc & 1) * 65536 + aoff0; asm volatile("" : "+v"(bb));
#pragma unroll
            for (int k = 0; k < 2; ++k)
#pragma unroll
                for (int mg = 0; mg < 4; ++mg) { bf16x8 a[8];
#pragma unroll
                    for (int m8 = 0; m8 < 8; ++m8) a[m8] = *(const LAS bf16x8*)(bb + mg * 16384 + m8 * 2048 + k * 1024);
#pragma unroll
                    for (int m8 = 0; m8 < 8; ++m8) o[mg * 8 + m8] = __builtin_amdgcn_mfma_f32_16x16x32_bf16(a[m8], pf[2 * cc + k], o[mg * 8 + m8], 0, 0, 0);
                    __builtin_amdgcn_sched_barrier(0); }
        }
        bf16* op = obuf + tok * 2048 + h * 512 + 4 * fq;
#pragma unroll
        for (int mm = 0; mm < 32; ++mm) { v2u w; w.x = pg8::cvt_pk_bf16(o[mm][0] * linv, o[mm][1] * linv); w.y = pg8::cvt_pk_bf16(o[mm][2] * linv, o[mm][3] * linv); *(v2u*)(op + 16 * mm) = w; }
    }
    asm volatile("s_waitcnt vmcnt(0)" ::: "memory"); __syncthreads();
#undef AT_STAGE_K
#undef AT_STAGE_V
#undef AT_WAIT
}
struct S5Lane { float lbr, lbi; float Br[16], Bi[16]; };
__device__ __forceinline__ void s5_lane_params(int g, int p, S5Lane& L) {
    const float lr = fminf(ka_in(15)[g * 64 + p], -1e-4f), li = ka_in(16)[g * 64 + p], dt = expf(ka_in(17)[g]);
    const float ar = lr * dt, th = li * dt; float sn, cs; sincosf(th, &sn, &cs); const float e = expf(ar), sh = sinf(0.5f * th);
    L.lbr = e * cs; L.lbi = e * sn;
    const float nr = expm1f(ar) * cs - 2.0f * sh * sh, ni = e * sn;
    const float den = 1.0f / (lr * lr + li * li), cr = (nr * lr + ni * li) * den, ci = (ni * lr - nr * li) * den;
#pragma unroll
    for (int c = 0; c < 16; ++c) { const float br = ka_in(18)[(size_t)(g * 64 + p) * 16 + c], bi = ka_in(19)[(size_t)(g * 64 + p) * 16 + c]; L.Br[c] = cr * br - ci * bi; L.Bi[c] = cr * bi + ci * br; }
}
__device__ __forceinline__ void s5_step(const S5Lane& L, const bf16* urow, float& xr, float& xi) {
    const v4u w0 = *(const v4u*)urow, w1 = *(const v4u*)(urow + 8);
    float u[16] = {bflo(w0.x), bfhi(w0.x), bflo(w0.y), bfhi(w0.y), bflo(w0.z), bfhi(w0.z), bflo(w0.w), bfhi(w0.w), bflo(w1.x), bfhi(w1.x), bflo(w1.y), bfhi(w1.y), bflo(w1.z), bfhi(w1.z), bflo(w1.w), bfhi(w1.w)};
    float br = 0.f, bi = 0.f;
#pragma unroll
    for (int c = 0; c < 16; ++c) { br += L.Br[c] * u[c]; bi += L.Bi[c] * u[c]; }
    const float nr = L.lbr * xr - L.lbi * xi + br, ni = L.lbr * xi + L.lbi * xr + bi; xr = nr; xi = ni;
}
__device__ __forceinline__ void s5_pass_a(const bf16* ub, f32x2* st, int wave, int lane) {
    const int gw = blockIdx.x * NWAVES + wave, NGW = gridDim.x * NWAVES;
    for (int task = gw; task < BATCH * 128 * 64; task += NGW) {
        const int seg = task & 63, g = (task >> 6) & 127, b = task >> 13;
        S5Lane L; s5_lane_params(g, lane, L);
        float xr = 0.f, xi = 0.f; const bf16* up = ub + (size_t)(b * SEQ + seg * 64) * 2048 + 16 * g;
#pragma unroll 2
        for (int s = 0; s < 64; ++s) s5_step(L, up + (size_t)s * 2048, xr, xi);
        st[(size_t)task * 64 + lane] = (f32x2){xr, xi};
    }
}
__device__ __forceinline__ void s5_pass_c(LAS unsigned char* lds, const bf16* ub, const f32x2* st, bf16* yb, int wave, int lane) {
    LAS f32x2* Cs = (LAS f32x2*)(lds + wave * 16640);
    LAS f32x2* xs = (LAS f32x2*)(lds + wave * 16640 + 8320);
    const int gw = blockIdx.x * NWAVES + wave, NGW = gridDim.x * NWAVES;
    for (int task = gw; task < BATCH * 128 * 64; task += NGW) {
        const int seg = task & 63, g = (task >> 6) & 127, b = task >> 13;
        S5Lane L; s5_lane_params(g, lane, L);
#pragma unroll
        for (int c = 0; c < 16; ++c) Cs[c * 65 + lane] = (f32x2){ka_in(20)[(size_t)(g * 16 + c) * 64 + lane], ka_in(21)[(size_t)(g * 16 + c) * 64 + lane]};
        float Ar = L.lbr, Ai = L.lbi;
#pragma unroll
        for (int i = 0; i < 6; ++i) { const float nr = Ar * Ar - Ai * Ai, ni = 2.0f * Ar * Ai; Ar = nr; Ai = ni; }
        float xr = 0.f, xi = 0.f; const f32x2* sp = st + (size_t)(task - seg) * 64 + lane;
#pragma unroll 2
        for (int n = 0; n < seg; ++n) { const f32x2 s = sp[(size_t)n * 64]; const float nr = Ar * xr - Ai * xi + s.x, ni = Ar * xi + Ai * xr + s.y; xr = nr; xi = ni; }
        const bf16* up = ub + (size_t)(b * SEQ + seg * 64) * 2048 + 16 * g; bf16* yp = yb + (size_t)(b * SEQ + seg * 64) * 2048 + 16 * g;
        const int t = lane & 15, cq = lane >> 4;
        f32x4 dsk = *(const f32x4*)(ka_in(22) + g * 16 + 4 * cq);
#pragma unroll 1
        for (int blk = 0; blk < 4; ++blk) {
#pragma unroll 2
            for (int s = 0; s < 16; ++s) { s5_step(L, up + (size_t)(blk * 16 + s) * 2048, xr, xi); xs[s * 65 + lane] = (f32x2){xr, xi}; }
            LDS_WAIT();
            float acc[4] = {0.f, 0.f, 0.f, 0.f};
#pragma unroll 4
            for (int p = 0; p < 64; ++p) { const f32x2 x = xs[t * 65 + p];
#pragma unroll
                for (int j = 0; j < 4; ++j) { const f32x2 c = Cs[(4 * cq + j) * 65 + p]; acc[j] += c.x * x.x - c.y * x.y; } }
            const v2u uw = *(const v2u*)(up + (size_t)(blk * 16 + t) * 2048 + 4 * cq);
            const float y0 = gelu_exact(acc[0] + dsk[0] * bflo(uw.x)), y1 = gelu_exact(acc[1] + dsk[1] * bfhi(uw.x)), y2 = gelu_exact(acc[2] + dsk[2] * bflo(uw.y)), y3 = gelu_exact(acc[3] + dsk[3] * bfhi(uw.y));
            v2u ow; ow.x = pk2(y0, y1); ow.y = pk2(y2, y3); *(v2u*)(yp + (size_t)(blk * 16 + t) * 2048 + 4 * cq) = ow;
            LDS_WAIT();
        }
    }
}
__device__ __forceinline__ void s5_mfma(LAS unsigned char* lds, const bf16* ub, bf16* yb, int wave, int lane) {
    LAS f32x2* PW = (LAS f32x2*)(lds);
    LAS f32x2* BB = (LAS f32x2*)(lds + 8704);
    LAS f32x2* CC = (LAS f32x2*)(lds + 16896);
    LAS bf16* KST = (LAS bf16*)(lds + 25088);
    LAS unsigned char* UI = lds + 33280;
    LAS float* SL = (LAS float*)(lds + 66048);
    LAS bf16* XP = (LAS bf16*)(lds + 99840);
    const int tid = wave * 64 + lane, fr = lane & 15, fq = lane >> 4;
    for (int unit = blockIdx.x; unit < 256; unit += gridDim.x) {
        const int b = unit >> 7, g = unit & 127;
        const float dt = expf(ka_in(17)[g]);
        __syncthreads();
        for (int idx = tid; idx < 17 * 64; idx += NTHREADS) { const int e = idx >> 6, p = idx & 63;
            const float lr = fminf(ka_in(15)[g * 64 + p], -1e-4f), li = ka_in(16)[g * 64 + p]; float sn, cs; sincosf(li * dt * (float)e, &sn, &cs); const float ex = expf(lr * dt * (float)e);
            PW[idx] = (f32x2){ex * cs, ex * sn}; }
        for (int idx = tid; idx < 1024; idx += NTHREADS) { const int p = idx >> 4, c = idx & 15;
            const float lr = fminf(ka_in(15)[g * 64 + p], -1e-4f), li = ka_in(16)[g * 64 + p]; const float ar = lr * dt, th = li * dt; float sn, cs; sincosf(th, &sn, &cs); const float e = expf(ar), sh = sinf(0.5f * th);
            const float nr = expm1f(ar) * cs - 2.0f * sh * sh, ni = e * sn, den = 1.0f / (lr * lr + li * li), cr = (nr * lr + ni * li) * den, ci = (ni * lr - nr * li) * den;
            const float br = ka_in(18)[(size_t)(g * 64 + p) * 16 + c], bi = ka_in(19)[(size_t)(g * 64 + p) * 16 + c];
            BB[idx] = (f32x2){cr * br - ci * bi, cr * bi + ci * br};
            CC[idx] = (f32x2){ka_in(20)[(size_t)g * 1024 + idx], ka_in(21)[(size_t)g * 1024 + idx]}; }
        __syncthreads();
        bf16x8 A1[8];
        { const int ri = wave >> 2, p = 16 * (wave & 3) + fr;
#pragma unroll
            for (int ks = 0; ks < 8; ++ks) { const int s = 2 * ks + (fq >> 1); const f32x2 pw = PW[(15 - s) * 64 + p]; float v[8];
#pragma unroll
                for (int j = 0; j < 8; ++j) { const f32x2 bb = BB[p * 16 + 8 * (fq & 1) + j]; v[j] = ri ? (pw.x * bb.y + pw.y * bb.x) : (pw.x * bb.x - pw.y * bb.y); }
                v4u w; w.x = pk2(v[0], v[1]); w.y = pk2(v[2], v[3]); w.z = pk2(v[4], v[5]); w.w = pk2(v[6], v[7]); A1[ks] = __builtin_bit_cast(bf16x8, w); } }
        const int t0 = wave, t1 = 15 - wave;
        bf16x8 CM[2][4];
#pragma unroll
        for (int ti = 0; ti < 2; ++ti) { const int t = ti ? t1 : t0;
#pragma unroll
            for (int ks = 0; ks < 4; ++ks) { float v[8];
#pragma unroll
                for (int j = 0; j < 8; ++j) { const int p = 32 * (ks & 1) + 8 * fq + j; const f32x2 c = CC[fr * 64 + p], pw = PW[(t + 1) * 64 + p];
                    v[j] = (ks >> 1) ? -(c.x * pw.y + c.y * pw.x) : (c.x * pw.x - c.y * pw.y); }
                v4u w; w.x = pk2(v[0], v[1]); w.y = pk2(v[2], v[3]); w.z = pk2(v[4], v[5]); w.w = pk2(v[6], v[7]); CM[ti][ks] = __builtin_bit_cast(bf16x8, w); } }
        { bf16x8 ct[4];
#pragma unroll
            for (int ks = 0; ks < 4; ++ks) { float v[8];
#pragma unroll
                for (int j = 0; j < 8; ++j) { const f32x2 c = CC[fr * 64 + 32 * (ks & 1) + 8 * fq + j]; v[j] = (ks >> 1) ? -c.y : c.x; }
                v4u w; w.x = pk2(v[0], v[1]); w.y = pk2(v[2], v[3]); w.z = pk2(v[4], v[5]); w.w = pk2(v[6], v[7]); ct[ks] = __builtin_bit_cast(bf16x8, w); }
#pragma unroll
            for (int si = 0; si < 2; ++si) { const int s = 2 * wave + si; f32x4 kacc = (f32x4){0.f, 0.f, 0.f, 0.f};
#pragma unroll
                for (int ks = 0; ks < 4; ++ks) { float v[8];
#pragma unroll
                    for (int j = 0; j < 8; ++j) { const int p = 32 * (ks & 1) + 8 * fq + j; const f32x2 pw = PW[(15 - s) * 64 + p], bb = BB[p * 16 + fr];
                        v[j] = (ks >> 1) ? (pw.x * bb.y + pw.y * bb.x) : (pw.x * bb.x - pw.y * bb.y); }
                    v4u w; w.x = pk2(v[0], v[1]); w.y = pk2(v[2], v[3]); w.z = pk2(v[4], v[5]); w.w = pk2(v[6], v[7]);
                    kacc = __builtin_amdgcn_mfma_f32_16x16x32_bf16(__builtin_bit_cast(bf16x8, w), ct[ks], kacc, 0, 0, 0); }
                v2u kw; kw.x = pk2(kacc[0], kacc[1]); kw.y = pk2(kacc[2], kacc[3]);
                *(LAS v2u*)(KST + ((15 - s) * 16 + fr) * 16 + 4 * fq) = kw; } }
        const f32x4 dsk = *(const f32x4*)(ka_in(22) + g * 16 + 4 * fq);
        float Xr = 0.f, Xi = 0.f;
#pragma unroll 1
        for (int q = 0; q < 4; ++q) {
            __syncthreads();
            { const bf16* src0 = ub + (size_t)(b * SEQ + q * 1024) * 2048 + 16 * g;
#pragma unroll
                for (int i = 0; i < 4; ++i) { const int piece = tid + NTHREADS * i, tok = piece >> 1, half = piece & 1;
                    const v4u w = *(const v4u*)(src0 + (size_t)tok * 2048 + 8 * half);
                    *(LAS v4u*)(UI + ((((tok & 15) * 64 + (tok >> 4)) * 2 + half) * 16)) = w; } }
            __syncthreads();
#pragma unroll 1
            for (int nf = 0; nf < 4; ++nf) { f32x4 acc = (f32x4){0.f, 0.f, 0.f, 0.f};
#pragma unroll
                for (int ks = 0; ks < 8; ++ks) { const bf16x8 bfr = *(const LAS bf16x8*)(UI + ((((2 * ks + (fq >> 1)) * 64 + 16 * nf + fr) * 2 + (fq & 1)) * 16));
                    acc = __builtin_amdgcn_mfma_f32_16x16x32_bf16(A1[ks], bfr, acc, 0, 0, 0); }
                *(LAS f32x4*)(SL + (16 * nf + fr) * 132 + 16 * wave + 4 * fq) = acc; }
            __syncthreads();
            if (wave == 0) { const f32x2 a16 = PW[16 * 64 + lane];
#pragma unroll 4
                for (int n = 0; n < 64; ++n) { XP[n * 136 + lane] = (bf16)f2bf(Xr); XP[n * 136 + 64 + lane] = (bf16)f2bf(Xi);
                    const float sr = SL[n * 132 + lane], si = SL[n * 132 + 64 + lane];
                    const float nr = a16.x * Xr - a16.y * Xi + sr, ni = a16.x * Xi + a16.y * Xr + si; Xr = nr; Xi = ni; } }
            __syncthreads();
#pragma unroll 1
            for (int nf = 0; nf < 4; ++nf) { f32x4 acc0 = (f32x4){0.f, 0.f, 0.f, 0.f}, acc1 = acc0;
#pragma unroll
                for (int ks = 0; ks < 8; ++ks) { if (2 * ks <= t1 || 2 * ks <= t0) {
                    const int s = 2 * ks + (fq >> 1);
                    const bf16x8 bfr = *(const LAS bf16x8*)(UI + (((s * 64 + 16 * nf + fr) * 2 + (fq & 1)) * 16));
                    if (2 * ks <= t0) { bf16x8 tf = (bf16x8){0, 0, 0, 0, 0, 0, 0, 0}; if (s <= t0) tf = *(const LAS bf16x8*)(KST + ((t0 - s) * 16 + fr) * 16 + 8 * (fq & 1)); acc0 = __builtin_amdgcn_mfma_f32_16x16x32_bf16(tf, bfr, acc0, 0, 0, 0); }
                    if (2 * ks <= t1) { bf16x8 tf = (bf16x8){0, 0, 0, 0, 0, 0, 0, 0}; if (s <= t1) tf = *(const LAS bf16x8*)(KST + ((t1 - s) * 16 + fr) * 16 + 8 * (fq & 1)); acc1 = __builtin_amdgcn_mfma_f32_16x16x32_bf16(tf, bfr, acc1, 0, 0, 0); } } }
#pragma unroll
                for (int ks = 0; ks < 4; ++ks) { const bf16x8 xf = *(const LAS bf16x8*)(XP + (16 * nf + fr) * 136 + 32 * ks + 8 * fq);
                    acc0 = __builtin_amdgcn_mfma_f32_16x16x32_bf16(CM[0][ks], xf, acc0, 0, 0, 0); acc1 = __builtin_amdgcn_mfma_f32_16x16x32_bf16(CM[1][ks], xf, acc1, 0, 0, 0); }
#pragma unroll
                for (int ti = 0; ti < 2; ++ti) { const int t = ti ? t1 : t0; const f32x4 a = ti ? acc1 : acc0; const int n = 16 * nf + fr;
                    const v2u uw = *(const LAS v2u*)(UI + (((t * 64 + n) * 2 + (fq >> 1)) * 16) + 8 * (fq & 1));
                    const pg8::f32x2 g0 = pg8::gelu_pk((pg8::f32x2){a[0] + dsk[0] * bflo(uw.x), a[1] + dsk[1] * bfhi(uw.x)}), g1 = pg8::gelu_pk((pg8::f32x2){a[2] + dsk[2] * bflo(uw.y), a[3] + dsk[3] * bfhi(uw.y)});
                    v2u ow; ow.x = pg8::cvt_pk_bf16(g0.x, g0.y); ow.y = pg8::cvt_pk_bf16(g1.x, g1.y);
                    *(v2u*)(yb + (size_t)(b * SEQ + q * 1024 + 16 * n + t) * 2048 + 16 * g + 4 * fq) = ow; } }
        }
    }
    __syncthreads();
}
#ifndef EN
#define EN(k) 1
#endif
template <int PH> __device__ __forceinline__ void run_phase(unsigned char* ws, float* X, LAS unsigned char* lds, int wave, int lane) {
    const int G = gridDim.x, bx = blockIdx.x;
    bf16* XB = (bf16*)(ws + WS_XB); float* SSQ = (float*)(ws + WS_SSQ);
    bf16* R0 = (bf16*)(ws + WS_R);
    constexpr int layer = (PH >= 10) ? 1 : 0;
    if constexpr (!EN(PH)) { return; }
    else if constexpr (PH == 0) p0_prologue(ws, lds, wave, lane);
    else if constexpr (PH == 1) {
        if (bx < 64) { const int i = bx >> 5;
            pg8::Gemm g{(const pg8::bf16_t*)(ws + WS_MEMB), (const pg8::bf16_t*)(ws + WS_W_KV + (size_t)i * 16 * MiB), MROWS, 4096, 2048}; pg8::StaticOrder S; S.init(MROWS, 4096, 32, bx & 31);
            pg8::EpiKV E{(pg8::bf16_t*)(ws + WS_KB + (size_t)i * 2 * MiB), (pg8::bf16_t*)(ws + WS_VB + (size_t)i * 2 * MiB), (pg8::bf16_t*)(ws + WS_VTB + (size_t)i * 2 * MiB), (const float*)(ws + WS_SSQM)};
            pg8::gemm_phase<pg8::EpiKV, pg8::StaticOrder, true, true>(lds, g, S, E, wave, lane); }
    } else if constexpr (PH == 2) {
        pg8::Gemm g{XB, (const pg8::bf16_t*)(ws + WS_W_AIN), M, 4096, 2048}; pg8::StaticOrder S; S.init(M, 4096, G, bx);
        pg8::EpiAct<1, true> E{R0, 4096, ka_in(8), SSQ, 32, 1.0f, (float*)(ws + WS_VST), 8};
        pg8::gemm_phase<pg8::EpiAct<1, true>, pg8::StaticOrder, true, true>(lds, g, S, E, wave, lane);
    } else if constexpr (PH == 3) {
#if defined(GATING_SIMPLE)
        gating_simple(lds, R0, (const float*)(ws + WS_VST), ka_in(9), ka_in(10), ka_in(11), ka_in(12), R0 + (size_t)M * 4096, wave * 64 + lane);
#else
        gating_mfma(lds, R0, (const float*)(ws + WS_VST), ka_in(9), ka_in(10), ka_in(11), ka_in(12), R0 + (size_t)M * 4096, wave, lane);
#endif
    }
    else if constexpr (PH == 4 || PH == 7 || PH == 9 || PH == 16 || PH == 18) {
        const pg8::bf16_t* A; const pg8::bf16_t* W; int K = 2048; const float* base = X;
        if constexpr (PH == 4) { A = R0 + (size_t)M * 4096; W = (const pg8::bf16_t*)(ws + WS_W_AOUT); base = ka_in(0); }
        else if constexpr (PH == 7 || PH == 16) { A = R0 + (size_t)M * 2048; W = (const pg8::bf16_t*)(ws + WS_W_O + (size_t)layer * 8 * MiB); }
        else { A = R0; W = (const pg8::bf16_t*)(ws + WS_W_DN + (size_t)layer * 32 * MiB); K = 8192; }
        pg8::Gemm g{A, W, M, 2048, K}; pg8::StaticOrder S; S.init(M, 2048, G, bx);
        pg8::EpiRes E{base, X, XB, SSQ};
        pg8::gemm_phase<pg8::EpiRes, pg8::StaticOrder, true, true>(lds, g, S, E, wave, lane);
    } else if constexpr (PH == 5 || PH == 14 || PH == 10) {
        const pg8::bf16_t* W = (PH == 10) ? (const pg8::bf16_t*)(ws + WS_W_BIN) : (const pg8::bf16_t*)(ws + WS_W_Q + (size_t)layer * 8 * MiB);
        pg8::Gemm g{XB, W, M, 2048, 2048}; pg8::StaticOrder S; S.init(M, 2048, G, bx);
        pg8::EpiAct<0, false> E{R0, 2048, nullptr, SSQ, (PH == 14) ? 64 : 32, (PH == 10) ? 1.0f : 0.044194173824159216f * 1.4426950408889634f, nullptr, 0};
        pg8::gemm_phase<pg8::EpiAct<0, false>, pg8::StaticOrder, true, true>(lds, g, S, E, wave, lane);
    } else if constexpr (PH == 6 || PH == 15) {
#if defined(ATTN_SIMPLE)
        attn_simple(lds, R0, (const bf16*)(ws + WS_KB + (size_t)layer * 2 * MiB), (const bf16*)(ws + WS_VB + (size_t)layer * 2 * MiB), R0 + (size_t)M * 2048, wave, lane);
#else
        attn_mfma(lds, R0, (const bf16*)(ws + WS_KB + (size_t)layer * 2 * MiB), (const bf16*)(ws + WS_VTB + (size_t)layer * 2 * MiB), R0 + (size_t)M * 2048, wave, lane);
#endif
    }
    else if constexpr (PH == 8 || PH == 17) {
        pg8::Gemm g{XB, (const pg8::bf16_t*)(ws + WS_W_UP + (size_t)layer * 32 * MiB), M, FF, 2048}; pg8::StaticOrder S; S.init(M, FF, G, bx);
        pg8::EpiAct<2, false> E{R0, FF, nullptr, SSQ, 32, 1.0f, nullptr, 0};
        pg8::gemm_phase<pg8::EpiAct<2, false>, pg8::StaticOrder, true, true>(lds, g, S, E, wave, lane);
    } else if constexpr (PH == 11) {
#if defined(S5_SIMPLE)
        s5_pass_a(R0, (f32x2*)(ws + WS_S5ST), wave, lane);
#endif
    } else if constexpr (PH == 12) {
#if defined(S5_SIMPLE)
        s5_pass_c(lds, R0, (const f32x2*)(ws + WS_S5ST), R0 + (size_t)M * 2048, wave, lane);
#else
        s5_mfma(lds, R0, R0 + (size_t)M * 2048, wave, lane);
#endif
    }
    else if constexpr (PH == 13) {
        pg8::Gemm g{R0 + (size_t)M * 2048, (const pg8::bf16_t*)(ws + WS_W_BOUT), M, 4096, 2048}; pg8::StaticOrder S; S.init(M, 4096, G, bx);
        pg8::EpiGlu E{X, X, XB, SSQ, ka_in(24)};
        pg8::gemm_phase<pg8::EpiGlu, pg8::StaticOrder, true, true>(lds, g, S, E, wave, lane);
    } else if constexpr (PH == 19) final_norm(X, ka_in(6), wave, lane);
}
__device__ __forceinline__ int lane_id() { int l; asm volatile("v_mbcnt_lo_u32_b32 %0, -1, 0\n\tv_mbcnt_hi_u32_b32 %0, -1, %0" : "=v"(l)); return l; }

#define XB_TMO      128
#define XB_XCNT(j)  (256  + 64 * (j))
#define XB_XSUB(j)  (1280 + 64 * (j))
#define XB_XGEN(j)  (2304 + 64 * (j))
#define XB_TOP      3328
#define XB_TOPGEN   3392
#define XCD_BAR_WORDS 3456
#define XB_SPIN_CAP (1u << 22)
__device__ __forceinline__ unsigned xb_ld(unsigned* p)              { return __hip_atomic_load(p, __ATOMIC_RELAXED, __HIP_MEMORY_SCOPE_AGENT); }
__device__ __forceinline__ unsigned xb_add(unsigned* p, unsigned v) { return __hip_atomic_fetch_add(p, v, __ATOMIC_RELAXED, __HIP_MEMORY_SCOPE_AGENT); }
__device__ __forceinline__ unsigned xb_xcc_id() { return (unsigned)__builtin_amdgcn_s_getreg((3 << 11) | 20) & 0xFu; }
#define XB_SPIN(cond, bar) do { unsigned _sp = 0; while (cond) { __builtin_amdgcn_s_sleep(1); \
    if ((++_sp & 255u) == 0u) { if (xb_ld(&(bar)[XB_TMO])) break; if (_sp > XB_SPIN_CAP) { atomicAdd(&(bar)[XB_TMO], 1u); break; } } } } while (0)
__device__ __forceinline__ void xcd_barrier_complete(unsigned* bar, unsigned x, unsigned& nloc, unsigned& nx) {
    const unsigned G = gridDim.x * gridDim.y * gridDim.z;
    unsigned sum, cnt, mine, sp = 0u;
    for (;;) {
        sum = 0u; cnt = 0u; mine = 0u;
#pragma unroll
        for (unsigned j = 0; j < 16; ++j) { const unsigned c = xb_ld(&bar[XB_XCNT(j)]); sum += c; cnt += (c > 0u) ? 1u : 0u; mine = (j == x) ? c : mine; }
        if (sum == G) break;
        __builtin_amdgcn_s_sleep(1);
        if ((++sp & 255u) == 0u) { if (xb_ld(&bar[XB_TMO])) break; if (sp > XB_SPIN_CAP) { atomicAdd(&bar[XB_TMO], 1u); break; } }
    }
    nloc = mine > 0u ? mine : 1u; nx = cnt > 0u ? cnt : 1u;
}
__device__ __forceinline__ void xcd_barrier(unsigned* bar, volatile LAS unsigned* st, bool is_t0) {
    asm volatile("s_waitcnt vmcnt(0)" ::: "memory");
    __syncthreads();
    if (is_t0) {
        __builtin_amdgcn_s_waitcnt(0);
        const unsigned x = xb_xcc_id();
        unsigned nloc = st[0], nx = st[1];
        if (nloc == 0u) { xcd_barrier_complete(bar, x, nloc, nx); st[0] = nloc; st[1] = nx; }
        const unsigned old = xb_add(&bar[XB_XSUB(x)], 1u);
        const unsigned gen = old / nloc;
        if (old + 1u == (gen + 1u) * nloc) {
            __builtin_amdgcn_fence(__ATOMIC_RELEASE, "agent");
            asm volatile("s_waitcnt vmcnt(0)" ::: "memory");
            const unsigned og = xb_add(&bar[XB_TOP], 1u);
            const unsigned tg = og / nx;
            if (og + 1u == (tg + 1u) * nx) xb_add(&bar[XB_TOPGEN], 1u);
            else XB_SPIN(xb_ld(&bar[XB_TOPGEN]) == tg, bar);
            __builtin_amdgcn_fence(__ATOMIC_ACQUIRE, "agent");
            xb_add(&bar[XB_XGEN(x)], 1u);
            asm volatile("s_waitcnt vmcnt(0)" ::: "memory");
        } else {
            XB_SPIN(xb_ld(&bar[XB_XGEN(x)]) == gen, bar);
            __builtin_amdgcn_fence(__ATOMIC_ACQUIRE, "agent");
            asm volatile("s_waitcnt vmcnt(0)" ::: "memory");
        }
    }
    __syncthreads();
}

__global__ void __launch_bounds__(NTHREADS, 2) trunk_fwd(Args args) {
    extern __shared__ __attribute__((aligned(16))) unsigned char lds_raw[];
    LAS unsigned char* lds = (LAS unsigned char*)lds_raw;
    const int wave = __builtin_amdgcn_readfirstlane((int)threadIdx.x >> 6);
    const int lo = args.ph_lo, hi = args.ph_hi;
    unsigned* bar = (unsigned*)args.ws + 4096;
    volatile LAS unsigned* st = (volatile LAS unsigned*)(lds + LDS_BYTES - 64);
#if MK_N_LAUNCHES == 1
    { const int l0 = lane_id(); if (wave == 0 && l0 < 2) st[l0] = 0u; __syncthreads(); if (wave == 0 && l0 == 0) (void)xb_add(&bar[XB_XCNT(xb_xcc_id())], 1u); }
#define GRID_BAR(k) do { if ((k) == 1) cg::this_grid().sync(); else xcd_barrier(bar, st, wave == 0 && lane_id() == 0); } while (0)
#else
#define GRID_BAR(k) do { } while (0)
#endif
#ifndef DUP_PH
#define DUP_PH -1
#endif
#define PHASE(k) if (lo <= (k) && (k) < hi) { if ((k) > lo) GRID_BAR(k); run_phase<k>(args.ws, args.out, lds, wave, lane_id()); if ((k) == DUP_PH) { GRID_BAR(2); run_phase<k>(args.ws, args.out, lds, wave, lane_id()); } }
    PHASE(0) PHASE(1) PHASE(2) PHASE(3) PHASE(4) PHASE(5) PHASE(6) PHASE(7) PHASE(8) PHASE(9)
    PHASE(10)
#if defined(S5_SIMPLE)
    PHASE(11)
#endif
    PHASE(12) PHASE(13) PHASE(14) PHASE(15) PHASE(16) PHASE(17) PHASE(18) PHASE(19)
#undef PHASE
}

extern "C" void kernel_launch(void* const* d_in, const int* in_sizes, int n_in, void* d_out, int out_size, void* d_ws, size_t ws_size, hipStream_t stream) {
    static int grid = 0;
    if (grid == 0) {
        if (n_in != 30 || out_size != M * D || ws_size < WS_END) { fprintf(stderr, "kernel_launch: unexpected shapes (n_in %d out %d ws %zu)\n", n_in, out_size, ws_size); grid = -1; return; }
        int dev = 0, cus = 0, per_cu = 0;
        if (hipGetDevice(&dev) != hipSuccess || hipDeviceGetAttribute(&cus, hipDeviceAttributeMultiprocessorCount, dev) != hipSuccess) { grid = -1; return; }
        if (hipFuncSetAttribute((const void*)trunk_fwd, hipFuncAttributeMaxDynamicSharedMemorySize, LDS_BYTES) != hipSuccess) { fprintf(stderr, "kernel_launch: hipFuncSetAttribute failed\n"); grid = -1; return; }
        if (hipOccupancyMaxActiveBlocksPerMultiprocessor(&per_cu, (const void*)trunk_fwd, NTHREADS, LDS_BYTES) != hipSuccess || per_cu < 1) { fprintf(stderr, "kernel_launch: occupancy query says %d\n", per_cu); grid = -1; return; }
        grid = cus;
    }
    if (grid < 0) return;
    if (hipMemsetAsync(d_ws, 0, 65536, stream) != hipSuccess) { fprintf(stderr, "kernel_launch: memset failed\n"); return; }
    Args a{};
    for (int i = 0; i < 30; ++i) a.in[i] = (const float*)d_in[i];
    a.out = (float*)d_out; a.ws = (unsigned char*)d_ws;
#if MK_N_LAUNCHES == 1
    a.ph_lo = 0; a.ph_hi = NPH;
    void* kargs[] = {&a};
    hipError_t e = hipLaunchCooperativeKernel((const void*)trunk_fwd, dim3(grid), dim3(NTHREADS), kargs, LDS_BYTES, stream);
    if (e != hipSuccess) fprintf(stderr, "kernel_launch: cooperative launch failed: %s\n", hipGetErrorString(e));
#else
    for (int ph = 0; ph < NPH; ++ph) { a.ph_lo = ph; a.ph_hi = ph + 1; hipLaunchKernelGGL(trunk_fwd, dim3(grid), dim3(NTHREADS), LDS_BYTES, stream, a); }
#endif
}
```

```cpp
#include <hip/hip_runtime.h>
#include <hip/hip_cooperative_groups.h>
#include <cstdio>
#include <cstdint>
namespace cg = cooperative_groups;
#define MK_N_LAUNCHES 1
#define PG8_SP2V true
namespace pg8 {
#define PG8_LAS __attribute__((address_space(3)))
typedef unsigned short bf16_t;
typedef short bf16x8 __attribute__((ext_vector_type(8)));
typedef float f32x4 __attribute__((ext_vector_type(4)));
typedef unsigned u32x4 __attribute__((ext_vector_type(4)));
constexpr int BM = 256, BK = 64, HALF = 128, HTB = HALF * BK * 2  , STAGE_BYTES = 8 * HTB, NXCD = 8, WGM = 8;

__host__ __device__ __forceinline__ int lds_byte(int r, int c) { const int st = (r >> 4) * 2 + (c >> 5), rr = r & 15, cc = c & 31, ob = rr * 64 + cc * 2; return st * 1024 + (ob ^ (((ob >> 9) & 1) << 5)); }
__host__ __device__ __forceinline__ void stage_rc(int b, int& R, int& C) { const int st = b / 1024, sb = b % 1024, swz = sb ^ (((sb >> 9) & 1) << 5); R = (st >> 1) * 16 + swz / 64; C = (st & 1) * 32 + (swz % 64) / 2; }
__host__ __device__ __forceinline__ int perm32(int rho) { const int n = rho >> 4, i = rho & 15; return 8 * (i >> 2) + 4 * n + (i & 3); }

struct Unit { int pm, pn; };
struct Gemm { const bf16_t* A; const bf16_t* Bt; int M, N, K; };

struct StaticOrder {
    int nM, nN, nwg, G, c;
    __host__ __device__ void init(int M, int N, int G_, int c_) { nM = M / BM; nN = N / BM; nwg = nM * nN; G = G_; c = c_; }
    __host__ __device__ bool next(int i, Unit& u) const {
        const long L = (long)i * G + c; if (L >= nwg) return false;
        int wgid = (int)L; { const int q = nwg / NXCD, r = nwg % NXCD, xcd = wgid % NXCD, off = wgid / NXCD; wgid = (xcd < r ? xcd * (q + 1) : r * (q + 1) + (xcd - r) * q) + off; }
        const int nig = WGM * nN, gid = wgid / nig, fm = gid * WGM, gsz = (nM - fm) < WGM ? (nM - fm) : WGM;
        u.pm = fm + ((wgid % nig) % gsz); u.pn = (wgid % nig) / gsz; return true;
    }
    __device__ __forceinline__ void a_ready(const Unit&) const {}
    __device__ __forceinline__ void done(const Unit&) const {}
};

__device__ __forceinline__ unsigned cvt_pk_bf16(float lo, float hi) { unsigned r; asm volatile("v_cvt_pk_bf16_f32 %0, %1, %2" : "=v"(r) : "v"(lo), "v"(hi)); return r; }
typedef float f32x2 __attribute__((ext_vector_type(2)));
__device__ __forceinline__ f32x2 gelu_pk(f32x2 v) {
    const f32x2 av = __builtin_elementwise_abs(v), d = av * 0.2316418882f + 1.0f;
    f32x2 t; t.x = __builtin_amdgcn_rcpf(d.x); t.y = __builtin_amdgcn_rcpf(d.y);
    f32x2 q = t * 0.5307027145f + (-0.7265760135f); q = q * t + 0.7107068705f; q = q * t + (-0.142248368f); q = q * t + 0.127414796f; q = q * t;
    const f32x2 s = (v * v) * (-0.72134752044f);
    f32x2 e; e.x = __builtin_amdgcn_exp2f(s.x); e.y = __builtin_amdgcn_exp2f(s.y);
    const f32x2 m = v * (q * e), r = v - m;
    f32x2 o; o.x = v.x < 0.f ? m.x : r.x; o.y = v.y < 0.f ? m.y : r.y; return o;
}
typedef unsigned u32x2 __attribute__((ext_vector_type(2)));
constexpr int SSQ_STRIDE = 64;
__device__ __forceinline__ float row_rstd(const float* ssq, int np, int row, int fq) {
    const float* p = ssq + (size_t)row * SSQ_STRIDE + fq * (np >> 2);
    f32x4 a = *(const f32x4*)p, b = *(const f32x4*)(p + 4);
    float s = (a[0] + a[1]) + (a[2] + a[3]) + (b[0] + b[1]) + (b[2] + b[3]);
    if (np == 64) { f32x4 c = *(const f32x4*)(p + 8), d = *(const f32x4*)(p + 12); s += (c[0] + c[1]) + (c[2] + c[3]) + (d[0] + d[1]) + (d[2] + d[3]); }
    s += __shfl_xor(s, 16); s += __shfl_xor(s, 32);
    return __builtin_amdgcn_rsqf(s * (1.0f / 2048.0f) + 1e-6f);
}
template <int ACT, bool STATS> struct EpiAct {
    static constexpr bool PERM = true, AFTER_DRAIN = false;
    bf16_t* O; int ldc; const float* bias; const float* ssq; int np; float oscale; float* vst; int stat_pn0;
    __device__ __forceinline__ void operator()(const f32x4 (&acc)[2][2][4][2], const Unit& u, int wr, int wc, int fr, int fq) const {
        const int row0 = u.pm * BM + wr * 64 + fr, col0 = u.pn * BM + wc * 32 + 8 * fq;
        f32x4 bv[2][2];
#pragma unroll
        for (int bj = 0; bj < 2; ++bj)
#pragma unroll
            for (int n = 0; n < 2; ++n) bv[bj][n] = bias ? *(const f32x4*)(bias + col0 + bj * HALF + 4 * n) : (f32x4){0.f, 0.f, 0.f, 0.f};
        float rsv[2][4];
#pragma unroll
        for (int ai = 0; ai < 2; ++ai) {
#pragma unroll
            for (int m = 0; m < 4; ++m) rsv[ai][m] = row_rstd(ssq, np, row0 + ai * HALF + m * 16, fq); }
#pragma unroll
        for (int ai = 0; ai < 2; ++ai)
#pragma unroll
            for (int m = 0; m < 4; ++m) { const int row = row0 + ai * HALF + m * 16; const float rs = rsv[ai][m];
                bf16_t* rowp = O + (size_t)row * ldc + col0; float s1 = 0.f, s2 = 0.f;
#pragma unroll
                for (int bj = 0; bj < 2; ++bj) { f32x4 v0 = acc[ai][bj][m][0] * rs + bv[bj][0], v1 = acc[ai][bj][m][1] * rs + bv[bj][1];
                    if (ACT == 1) { f32x2 a = gelu_pk((f32x2){v0[0], v0[1]}), b = gelu_pk((f32x2){v0[2], v0[3]}), c = gelu_pk((f32x2){v1[0], v1[1]}), d = gelu_pk((f32x2){v1[2], v1[3]});
                        v0 = (f32x4){a.x, a.y, b.x, b.y}; v1 = (f32x4){c.x, c.y, d.x, d.y}; }
                    if (ACT == 2) {
#pragma unroll
                        for (int j = 0; j < 4; ++j) { const float a = fmaxf(v0[j], 0.f), b = fmaxf(v1[j], 0.f); v0[j] = a * a; v1[j] = b * b; } }
                    v0 = v0 * oscale; v1 = v1 * oscale;
                    if (STATS) { s1 += (v0[0] + v0[1]) + (v0[2] + v0[3]) + (v1[0] + v1[1]) + (v1[2] + v1[3]);
                        s2 += (v0[0] * v0[0] + v0[1] * v0[1]) + (v0[2] * v0[2] + v0[3] * v0[3]) + (v1[0] * v1[0] + v1[1] * v1[1]) + (v1[2] * v1[2] + v1[3] * v1[3]); }
                    u32x4 w; w.x = cvt_pk_bf16(v0[0], v0[1]); w.y = cvt_pk_bf16(v0[2], v0[3]); w.z = cvt_pk_bf16(v1[0], v1[1]); w.w = cvt_pk_bf16(v1[2], v1[3]);
                    *(u32x4*)(rowp + bj * HALF) = w; }
                if (STATS) { s1 += __shfl_xor(s1, 16); s1 += __shfl_xor(s1, 32); s2 += __shfl_xor(s2, 16); s2 += __shfl_xor(s2, 32);
                    if (u.pn >= stat_pn0 && fq == 0) *(f32x2*)(vst + (size_t)row * SSQ_STRIDE + ((u.pn - stat_pn0) * 4 + wc) * 2) = (f32x2){s1, s2}; }
            }
    }
};
struct EpiRes {
    static constexpr bool PERM = false, AFTER_DRAIN = false;
    const float* base; float* out; bf16_t* xb; float* ssq;
    __device__ __forceinline__ void operator()(const f32x4 (&acc)[2][2][4][2], const Unit& u, int wr, int wc, int fr, int fq) const {
        const int row0 = u.pm * BM + wr * 64 + fr, col0 = u.pn * BM + wc * 32 + 4 * fq;
#pragma unroll
        for (int ai = 0; ai < 2; ++ai) {
            f32x4 pre[4][2][2];
#pragma unroll
            for (int m = 0; m < 4; ++m) { const size_t off = (size_t)(row0 + ai * HALF + m * 16) * 2048 + col0;
#pragma unroll
                for (int bj = 0; bj < 2; ++bj)
#pragma unroll
                    for (int n = 0; n < 2; ++n) pre[m][bj][n] = *(const f32x4*)(base + off + bj * HALF + n * 16); }
            asm volatile("" ::: "memory");
#pragma unroll
            for (int m = 0; m < 4; ++m) { const int row = row0 + ai * HALF + m * 16; const size_t off = (size_t)row * 2048 + col0; float ss = 0.f;
#pragma unroll
                for (int bj = 0; bj < 2; ++bj)
#pragma unroll
                    for (int n = 0; n < 2; ++n) { const f32x4 o = pre[m][bj][n] + acc[ai][bj][m][n];
                        *(f32x4*)(out + off + bj * HALF + n * 16) = o; ss += (o[0] * o[0] + o[1] * o[1]) + (o[2] * o[2] + o[3] * o[3]);
                        u32x2 w; w.x = cvt_pk_bf16(o[0], o[1]); w.y = cvt_pk_bf16(o[2], o[3]); *(u32x2*)(xb + off + bj * HALF + n * 16) = w; }
                ss += __shfl_xor(ss, 16); ss += __shfl_xor(ss, 32);
                if (fq == 0) ssq[(size_t)row * SSQ_STRIDE + u.pn * 4 + wc] = ss; }
            asm volatile("" ::: "memory"); }
    }
};
struct EpiGlu {
    static constexpr bool PERM = false, AFTER_DRAIN = false;
    const float* base; float* out; bf16_t* xb; float* ssq; const float* bias;
    __device__ __forceinline__ void operator()(const f32x4 (&acc)[2][2][4][2], const Unit& u, int wr, int wc, int fr, int fq) const {
        const int row0 = u.pm * BM + wr * 64 + fr, col0 = u.pn * 128 + wc * 16 + 4 * fq;
        f32x4 bval[2], bgate[2];
#pragma unroll
        for (int bj = 0; bj < 2; ++bj) { bval[bj] = *(const f32x4*)(bias + col0 + bj * 64); bgate[bj] = *(const f32x4*)(bias + 2048 + col0 + bj * 64); }
#pragma unroll
        for (int ai = 0; ai < 2; ++ai) {
            f32x4 pre[4][2];
#pragma unroll
            for (int m = 0; m < 4; ++m) { const size_t off = (size_t)(row0 + ai * HALF + m * 16) * 2048 + col0;
#pragma unroll
                for (int bj = 0; bj < 2; ++bj) pre[m][bj] = *(const f32x4*)(base + off + bj * 64); }
            asm volatile("" ::: "memory");
#pragma unroll
            for (int m = 0; m < 4; ++m) { const int row = row0 + ai * HALF + m * 16; const size_t off = (size_t)row * 2048 + col0; float ss = 0.f;
#pragma unroll
                for (int bj = 0; bj < 2; ++bj) { const f32x4 val = acc[ai][bj][m][0] + bval[bj], gate = acc[ai][bj][m][1] + bgate[bj]; f32x4 o = pre[m][bj];
#pragma unroll
                    for (int j = 0; j < 4; ++j) { const float sg = __builtin_amdgcn_rcpf(1.0f + __builtin_amdgcn_exp2f(-1.4426950408889634f * gate[j])); o[j] += val[j] * sg; }
                    *(f32x4*)(out + off + bj * 64) = o; ss += (o[0] * o[0] + o[1] * o[1]) + (o[2] * o[2] + o[3] * o[3]);
                    u32x2 w; w.x = cvt_pk_bf16(o[0], o[1]); w.y = cvt_pk_bf16(o[2], o[3]); *(u32x2*)(xb + off + bj * 64) = w; }
                ss += __shfl_xor(ss, 16); ss += __shfl_xor(ss, 32);
                if (fq == 0) ssq[(size_t)row * SSQ_STRIDE + u.pn * 4 + wc] = ss; }
            asm volatile("" ::: "memory"); }
    }
};
__host__ __device__ __forceinline__ int vt_pos(int key) { const int s = key >> 5, w = key & 31; return 32 * s + 8 * ((w & 15) >> 2) + (w & 3) + 4 * (w >> 4); }
struct EpiKV {
    static constexpr bool PERM = true, AFTER_DRAIN = false;
    bf16_t* Kb; bf16_t* Vb; bf16_t* VTb; const float* ssq;
    __device__ __forceinline__ void operator()(const f32x4 (&acc)[2][2][4][2], const Unit& u, int wr, int wc, int fr, int fq) const {
        const int row0 = u.pm * BM + wr * 64 + fr, col0 = u.pn * BM + wc * 32 + 8 * fq;
#pragma unroll
        for (int ai = 0; ai < 2; ++ai)
#pragma unroll
            for (int m = 0; m < 4; ++m) { const int row = row0 + ai * HALF + m * 16; const float rs = row_rstd(ssq, 32, row, fq); const int b = row >> 8, key = row & 255;
#pragma unroll
                for (int bj = 0; bj < 2; ++bj) { const f32x4 v0 = acc[ai][bj][m][0] * rs, v1 = acc[ai][bj][m][1] * rs; const int col = col0 + bj * HALF;
                    u32x4 w; w.x = cvt_pk_bf16(v0[0], v0[1]); w.y = cvt_pk_bf16(v0[2], v0[3]); w.z = cvt_pk_bf16(v1[0], v1[1]); w.w = cvt_pk_bf16(v1[2], v1[3]);
                    if (col < 2048) { const int h = col >> 9, d = col & 511; *(u32x4*)(Kb + ((size_t)((b * 4 + h) * 256 + key)) * 512 + d) = w; }
                    else { const int c2 = col - 2048, h = c2 >> 9, d = c2 & 511; *(u32x4*)(Vb + ((size_t)((b * 4 + h) * 256 + key)) * 512 + d) = w;
                        bf16_t* vt = VTb + ((size_t)((b * 4 + h) * 512 + d)) * 256 + vt_pos(key);
                        vt[0 * 256] = (bf16_t)(w.x & 0xffffu); vt[1 * 256] = (bf16_t)(w.x >> 16); vt[2 * 256] = (bf16_t)(w.y & 0xffffu); vt[3 * 256] = (bf16_t)(w.y >> 16);
                        vt[4 * 256] = (bf16_t)(w.z & 0xffffu); vt[5 * 256] = (bf16_t)(w.z >> 16); vt[6 * 256] = (bf16_t)(w.w & 0xffffu); vt[7 * 256] = (bf16_t)(w.w >> 16); } }
            }
    }
};
template <class Epi, class Sched, bool ALIGN_EPI = false, bool SP2 = false>
__device__ __forceinline__ void gemm_phase(PG8_LAS unsigned char* lds, const Gemm g, const Sched& S, const Epi& E, const int wid  , const int lane) {
    const int tid = wid * 64 + lane, wr = wid >> 2, wc = wid & 3, fr = lane & 15, fq = lane >> 4;
    const int K = g.K, nt = K / BK;
    unsigned voffA[2], voffB[2];
#pragma unroll
    for (int i = 0; i < 2; ++i) { int R, C; stage_rc(tid * 16 + i * 8192, R, C); const int Rb = Epi::PERM ? ((R & ~31) + perm32(R & 31)) : R;
        voffA[i] = (unsigned)(R * K + C) * 2u; voffB[i] = (unsigned)(Rb * K + C) * 2u; }
    const size_t kstep = (size_t)(BK * 2);
    const size_t hstep = (size_t)HALF * K * 2;
    const size_t tstep = 2 * hstep;
    const unsigned ldsw = (unsigned)wid * 1024u;
    const int aoff = lds_byte(wr * 64 + fr, fq * 8), boff = lds_byte(wc * 32 + fr, fq * 8);
#define PG8_SA(b, h) (((b) * 2 + (h)) * HTB)
#define PG8_SB(b, h) ((4 + (b) * 2 + (h)) * HTB)
#define PG8_STAGE(bufoff, gbase, voff) do { _Pragma("unroll") for (int _i = 0; _i < 2; ++_i) \
        __builtin_amdgcn_global_load_lds((const unsigned*)((const char*)(gbase) + (voff)[_i]), (PG8_LAS unsigned*)(lds + (bufoff) + ldsw + _i * 8192), 16, 0, 0); } while (0)
#define PG8_LDA(dst, b, h) do { _Pragma("unroll") for (int m = 0; m < 4; ++m) _Pragma("unroll") for (int k = 0; k < 2; ++k) dst[m][k] = *(const PG8_LAS bf16x8*)(lds + PG8_SA(b, h) + aoff + m * 2048 + k * 1024); } while (0)
#define PG8_LDB(dst, b, h) do { _Pragma("unroll") for (int n = 0; n < 2; ++n) _Pragma("unroll") for (int k = 0; k < 2; ++k) dst[n][k] = *(const PG8_LAS bf16x8*)(lds + PG8_SB(b, h) + boff + n * 2048 + k * 1024); } while (0)
#define PG8_MMA(ai, bj, At, Bt) do { __builtin_amdgcn_s_setprio(1); _Pragma("unroll") for (int m = 0; m < 4; ++m) _Pragma("unroll") for (int n = 0; n < 2; ++n) _Pragma("unroll") for (int k = 0; k < 2; ++k) \
        acc[ai][bj][m][n] = __builtin_amdgcn_mfma_f32_16x16x32_bf16(Bt[n][k], At[m][k], acc[ai][bj][m][n], 0, 0, 0); __builtin_amdgcn_s_setprio(0); } while (0)
#define PG8_WAIT_V(n) asm volatile("s_waitcnt vmcnt(" #n ")" ::: "memory")
#define PG8_WAIT_L(n) asm volatile("s_waitcnt lgkmcnt(" #n ")" ::: "memory")
#define PG8_BAR __builtin_amdgcn_s_barrier()
#define PG8_SCHED __builtin_amdgcn_sched_barrier(0)
    Unit cur, nxt; int ui = 0;
    if (!S.next(0, cur)) return;
    f32x4 acc[2][2][4][2];
#pragma unroll
    for (int a = 0; a < 2; ++a)
#pragma unroll
        for (int b = 0; b < 2; ++b)
#pragma unroll
            for (int m = 0; m < 4; ++m)
#pragma unroll
                for (int n = 0; n < 2; ++n) acc[a][b][m][n] = (f32x4){0.f, 0.f, 0.f, 0.f};
    bf16x8 At[4][2], B0[2][2], B1[2][2];
    const char* cA = (const char*)g.A + (size_t)cur.pm * tstep; const char* cB = (const char*)g.Bt + (size_t)cur.pn * tstep;
    S.a_ready(cur);
    if constexpr (SP2) {
        PG8_STAGE(PG8_SB(0, 0), cB, voffB); PG8_STAGE(PG8_SB(0, 1), cB + hstep, voffB); PG8_STAGE(PG8_SA(0, 0), cA, voffA); PG8_STAGE(PG8_SA(0, 1), cA + hstep, voffA);
        if (wr == 1) PG8_BAR;
        PG8_WAIT_V(2); PG8_BAR;
        PG8_STAGE(PG8_SB(1, 0), cB + kstep, voffB); PG8_STAGE(PG8_SA(1, 0), cA + kstep, voffA); PG8_STAGE(PG8_SB(1, 1), cB + hstep + kstep, voffB);
        PG8_WAIT_V(6); PG8_BAR;
    } else {
        PG8_STAGE(PG8_SB(0, 0), cB, voffB); PG8_STAGE(PG8_SA(0, 0), cA, voffA); PG8_STAGE(PG8_SB(0, 1), cB + hstep, voffB); PG8_STAGE(PG8_SA(0, 1), cA + hstep, voffA);
        if (wr == 1) PG8_BAR;
        PG8_WAIT_V(4); PG8_BAR;
        PG8_STAGE(PG8_SB(1, 0), cB + kstep, voffB); PG8_STAGE(PG8_SA(1, 0), cA + kstep, voffA); PG8_STAGE(PG8_SB(1, 1), cB + hstep + kstep, voffB);
        PG8_WAIT_V(6); PG8_BAR;
    }
    for (;;) {
        const bool has_next = S.next(ui + 1, nxt);
        const char* nA = has_next ? (const char*)g.A + (size_t)nxt.pm * tstep : cA; const char* nB = has_next ? (const char*)g.Bt + (size_t)nxt.pn * tstep : cB;
        for (int t = 0; t < nt; t += 2) {
            const bool last = (t == nt - 2);
            const char* a1 = cA + (size_t)(t + 1) * kstep;
            const char* a2 = last ? nA : cA + (size_t)(t + 2) * kstep; const char* b2 = last ? nB : cB + (size_t)(t + 2) * kstep;
            const char* a3 = a2 + kstep; const char* b3 = b2 + kstep;
            if (last && has_next) S.a_ready(nxt);
            if constexpr (SP2) {
            PG8_LDB(B0, 0, 0); PG8_LDB(B1, 0, 1); PG8_SCHED; PG8_LDA(At, 0, 0); PG8_STAGE(PG8_SA(1, 1), a1 + hstep, voffA);
            PG8_WAIT_V(8); PG8_WAIT_L(0); PG8_BAR; PG8_MMA(0, 0, At, B0); PG8_MMA(0, 1, At, B1); PG8_BAR; PG8_SCHED;
            PG8_LDA(At, 0, 1); PG8_STAGE(PG8_SB(0, 0), b2, voffB); PG8_STAGE(PG8_SB(0, 1), b2 + hstep, voffB); PG8_STAGE(PG8_SA(0, 0), a2, voffA);
            PG8_WAIT_V(8); PG8_WAIT_L(0); PG8_BAR; PG8_MMA(1, 0, At, B0); PG8_MMA(1, 1, At, B1); PG8_BAR; PG8_SCHED;
            PG8_LDB(B0, 1, 0); PG8_LDB(B1, 1, 1); PG8_SCHED; PG8_LDA(At, 1, 0); PG8_STAGE(PG8_SA(0, 1), a2 + hstep, voffA);
            PG8_WAIT_V(8); PG8_WAIT_L(0); PG8_BAR; PG8_MMA(0, 0, At, B0); PG8_MMA(0, 1, At, B1); PG8_BAR; PG8_SCHED;
            PG8_LDA(At, 1, 1); PG8_STAGE(PG8_SB(1, 0), b3, voffB); PG8_STAGE(PG8_SB(1, 1), b3 + hstep, voffB); PG8_STAGE(PG8_SA(1, 0), a3, voffA);
            PG8_WAIT_V(8); PG8_WAIT_L(0); PG8_BAR; PG8_MMA(1, 0, At, B0); PG8_MMA(1, 1, At, B1); PG8_BAR; PG8_SCHED;
            } else {
            PG8_LDB(B0, 0, 0); PG8_SCHED; PG8_LDA(At, 0, 0); PG8_STAGE(PG8_SA(1, 1), a1 + hstep, voffA);
            PG8_WAIT_L(8); PG8_BAR; PG8_WAIT_L(0); PG8_MMA(0, 0, At, B0); PG8_BAR; PG8_SCHED;
            PG8_LDB(B1, 0, 1); PG8_STAGE(PG8_SB(0, 0), b2, voffB);
            PG8_BAR; PG8_WAIT_L(0); PG8_MMA(0, 1, At, B1); PG8_BAR;
            PG8_LDA(At, 0, 1); PG8_STAGE(PG8_SA(0, 0), a2, voffA);
            PG8_BAR; PG8_WAIT_L(0); PG8_MMA(1, 0, At, B0); PG8_BAR; PG8_SCHED;
            PG8_STAGE(PG8_SB(0, 1), b2 + hstep, voffB);
            PG8_WAIT_V(6); PG8_BAR; PG8_MMA(1, 1, At, B1); PG8_BAR;
            PG8_LDB(B0, 1, 0); PG8_SCHED; PG8_LDA(At, 1, 0); PG8_STAGE(PG8_SA(0, 1), a2 + hstep, voffA);
            PG8_WAIT_L(8); PG8_BAR; PG8_WAIT_L(0); PG8_MMA(0, 0, At, B0); PG8_BAR; PG8_SCHED;
            PG8_LDB(B1, 1, 1); PG8_STAGE(PG8_SB(1, 0), b3, voffB);
            PG8_BAR; PG8_WAIT_L(0); PG8_MMA(0, 1, At, B1); PG8_BAR;
            PG8_LDA(At, 1, 1); PG8_STAGE(PG8_SA(1, 0), a3, voffA);
            PG8_BAR; PG8_WAIT_L(0); PG8_MMA(1, 0, At, B0); PG8_BAR; PG8_SCHED;
            PG8_STAGE(PG8_SB(1, 1), b3 + hstep, voffB);
            PG8_WAIT_V(6); PG8_BAR; PG8_MMA(1, 1, At, B1); PG8_BAR;
            }
        }
        if constexpr (ALIGN_EPI) { if (wr == 0) PG8_BAR; }
        if constexpr (!Epi::AFTER_DRAIN) { Unit ue = cur; asm volatile("" : "+s"(ue.pm), "+s"(ue.pn));
            int fre = fr, fqe = fq; asm volatile("" : "+v"(fre), "+v"(fqe)); E(acc, ue, wr, wc, fre, fqe); S.done(cur); }
        if (!has_next) break;
#pragma unroll
        for (int a = 0; a < 2; ++a)
#pragma unroll
            for (int b = 0; b < 2; ++b)
#pragma unroll
                for (int m = 0; m < 4; ++m)
#pragma unroll
                    for (int n = 0; n < 2; ++n) acc[a][b][m][n] = (f32x4){0.f, 0.f, 0.f, 0.f};
        cur = nxt; cA = nA; cB = nB; ++ui;
        if constexpr (ALIGN_EPI) { if (wr == 1) PG8_BAR; }
    }
    PG8_WAIT_V(0);
    if constexpr (!ALIGN_EPI) { if (wr == 0) PG8_BAR; }
    PG8_BAR;
    if constexpr (Epi::AFTER_DRAIN) { E.fused(acc, cur, wr, wc, fr, fq, lds, wid, lane); S.done(cur); }
#undef PG8_SA
#undef PG8_SB
#undef PG8_STAGE
#undef PG8_LDA
#undef PG8_LDB
#undef PG8_MMA
#undef PG8_WAIT_V
#undef PG8_WAIT_L
#undef PG8_BAR
#undef PG8_SCHED
}
}
#ifndef MK_N_LAUNCHES
#define MK_N_LAUNCHES 1
#endif
constexpr int BATCH = 2, SEQ = 4096, D = 2048, M = BATCH * SEQ, MEMLEN = 256, MROWS = BATCH * MEMLEN, FF = 8192;
constexpr int NWAVES = 8, NTHREADS = 512, NPH = 20;
constexpr int LDS_BYTES = 147456;
constexpr size_t MiB = 1u << 20;
constexpr size_t WS_W_AIN = 2 * MiB, WS_W_AOUT = 18 * MiB, WS_W_BIN = 26 * MiB, WS_W_BOUT = 34 * MiB, WS_W_Q = 50 * MiB, WS_W_KV = 66 * MiB, WS_W_O = 98 * MiB, WS_W_UP = 114 * MiB, WS_W_DN = 178 * MiB;
constexpr size_t WS_XB = 242 * MiB, WS_MEMB = 274 * MiB, WS_KB = 276 * MiB, WS_VB = 280 * MiB, WS_VTB = 284 * MiB, WS_SSQ = 288 * MiB, WS_VST = 290 * MiB, WS_SSQM = 292 * MiB, WS_S5ST = 294 * MiB;
constexpr size_t WS_R = 304 * MiB, WS_END = 432 * MiB;
#define GAS __attribute__((address_space(1)))
#define LAS __attribute__((address_space(3)))
typedef unsigned short bf16;
typedef unsigned v4u __attribute__((ext_vector_type(4)));
typedef unsigned v2u __attribute__((ext_vector_type(2)));
typedef float f32x4 __attribute__((ext_vector_type(4)));
typedef float f32x2 __attribute__((ext_vector_type(2)));
typedef short bf16x8 __attribute__((ext_vector_type(8)));
#define LDS_WAIT() asm volatile("s_waitcnt lgkmcnt(0)" ::: "memory")
__device__ __forceinline__ unsigned f2bf(float f) { unsigned u = __builtin_bit_cast(unsigned, f); return (u + 0x7fffu + ((u >> 16) & 1u)) >> 16; }
__device__ __forceinline__ unsigned pk2(float lo, float hi) { return f2bf(lo) | (f2bf(hi) << 16); }
__device__ __forceinline__ float bflo(unsigned w) { return __builtin_bit_cast(float, w << 16); }
__device__ __forceinline__ float bfhi(unsigned w) { return __builtin_bit_cast(float, w & 0xffff0000u); }
__device__ __forceinline__ float wave_sum(float v) {
#pragma unroll
    for (int o = 1; o < 64; o <<= 1) v += __shfl_xor(v, o);
    return v;
}
__device__ __forceinline__ float wave_max(float v) {
#pragma unroll
    for (int o = 1; o < 64; o <<= 1) v = fmaxf(v, __shfl_xor(v, o));
    return v;
}
__device__ __forceinline__ float gelu_exact(float v) { return 0.5f * v * (1.0f + erff(v * 0.70710678118654752f)); }

struct Args { const float* in[30]; float* out; unsigned char* ws; int ph_lo, ph_hi; };
__device__ __forceinline__ const float* ka_in(int i) { const __attribute__((address_space(4))) char* ka = (const __attribute__((address_space(4))) char*)__builtin_amdgcn_kernarg_segment_ptr(); asm volatile("" : "+s"(ka)); return *(const float* const __attribute__((address_space(4)))*)(ka + 8 * i); }

__device__ __forceinline__ int glu_rowmap(int n) { return n < 2048 ? 32 * (n >> 4) + (n & 15) : 32 * ((n - 2048) >> 4) + 16 + (n & 15); }
struct ConvSel { const float* W; const float* g; bf16* WT; int K, N, mode, item; };
__device__ __forceinline__ ConvSel conv_select(unsigned char* ws, int r) {
    ConvSel s; s.g = nullptr; s.K = 2048; s.N = 2048; s.mode = 0;
    if (r < 2048) { s.W = ka_in(7); s.g = ka_in(2); s.WT = (bf16*)(ws + WS_W_AIN); s.N = 4096; }
    else if ((r -= 2048) < 1024) { s.W = ka_in(13); s.WT = (bf16*)(ws + WS_W_AOUT); }
    else if ((r -= 1024) < 1024) { s.W = ka_in(14); s.g = ka_in(2) + 2048; s.WT = (bf16*)(ws + WS_W_BIN); }
    else if ((r -= 1024) < 2048) { s.W = ka_in(23); s.WT = (bf16*)(ws + WS_W_BOUT); s.N = 4096; s.mode = 1; }
    else if ((r -= 2048) < 2048) { const int i = r >> 10; r &= 1023; s.W = ka_in(25) + (size_t)i * 2048 * 2048; s.g = ka_in(3) + i * 2048; s.WT = (bf16*)(ws + WS_W_Q + i * 8 * MiB); }
    else if ((r -= 2048) < 4096) { const int i = r >> 11; r &= 2047; s.W = ka_in(26) + (size_t)i * 2048 * 4096; s.g = ka_in(4) + i * 2048; s.WT = (bf16*)(ws + WS_W_KV + i * 16 * MiB); s.N = 4096; }
    else if ((r -= 4096) < 2048) { const int i = r >> 10; r &= 1023; s.W = ka_in(27) + (size_t)i * 2048 * 2048; s.WT = (bf16*)(ws + WS_W_O + i * 8 * MiB); }
    else if ((r -= 2048) < 8192) { const int i = r >> 12; r &= 4095; s.W = ka_in(28) + (size_t)i * 2048 * 8192; s.g = ka_in(5) + i * 2048; s.WT = (bf16*)(ws + WS_W_UP + i * 32 * MiB); s.N = 8192; }
    else { r -= 8192; const int i = r >> 12; r &= 4095; s.W = ka_in(29) + (size_t)i * 8192 * 2048; s.WT = (bf16*)(ws + WS_W_DN + i * 32 * MiB); s.K = 8192; }
    s.item = r; return s;
}
__device__ __forceinline__ void conv_load(const ConvSel& s, f32x4 (&v)[16], int lane) {
    const int nblk = s.N >> 6, kb = s.item / nblk, nb = s.item - kb * nblk, k0 = 64 * kb, n0 = 64 * nb;
#pragma unroll
    for (int i = 0; i < 16; ++i) { const int kk = 4 * i + (lane >> 4); v[i] = *(const f32x4*)(s.W + (size_t)(k0 + kk) * s.N + n0 + 4 * (lane & 15)); }
}
__device__ __forceinline__ void conv_finish(const ConvSel& s, const f32x4 (&v)[16], LAS float* scr, int lane) {
    const int nblk = s.N >> 6, kb = s.item / nblk, nb = s.item - kb * nblk, k0 = 64 * kb, n0 = 64 * nb;
#pragma unroll
    for (int i = 0; i < 16; ++i) { const int kk = 4 * i + (lane >> 4); const float sc = s.g ? s.g[k0 + kk] : 1.0f; LAS float* d = scr + kk * 65 + 4 * (lane & 15);
        d[0] = v[i][0] * sc; d[1] = v[i][1] * sc; d[2] = v[i][2] * sc; d[3] = v[i][3] * sc; }
    LDS_WAIT();
    const int c = lane & 7;
#pragma unroll
    for (int j = 0; j < 8; ++j) { const int n = (lane >> 3) + 8 * j; const LAS float* sp = scr + (8 * c) * 65 + n;
        v4u o; o.x = pk2(sp[0 * 65], sp[1 * 65]); o.y = pk2(sp[2 * 65], sp[3 * 65]); o.z = pk2(sp[4 * 65], sp[5 * 65]); o.w = pk2(sp[6 * 65], sp[7 * 65]);
        const int nr = s.mode ? glu_rowmap(n0 + n) : (n0 + n);
        *(v4u*)(s.WT + (size_t)nr * s.K + k0 + 8 * c) = o; }
    LDS_WAIT();
}
template <int PART> __device__ __forceinline__ int conv_index(int j) { return PART == 0 ? 8192 + j : (j < 8192 ? j : j + 4096); }
template <int PART> __device__ __forceinline__ void conv_run(unsigned char* ws, LAS float* scr, int first, int step, int limit, int lane) {
    if (first >= limit) return;
    f32x4 va[16], vb[16];
    ConvSel sa = conv_select(ws, conv_index<PART>(__builtin_amdgcn_readfirstlane(first))), sb = sa;
    conv_load(sa, va, lane);
    for (int j = first; j < limit; j += 2 * step) {
        const bool hb = (j + step) < limit;
        if (hb) { sb = conv_select(ws, conv_index<PART>(__builtin_amdgcn_readfirstlane(j + step))); conv_load(sb, vb, lane); }
        conv_finish(sa, va, scr, lane);
        if (!hb) break;
        const bool ha = (j + 2 * step) < limit;
        if (ha) { sa = conv_select(ws, conv_index<PART>(__builtin_amdgcn_readfirstlane(j + 2 * step))); conv_load(sa, va, lane); }
        conv_finish(sb, vb, scr, lane);
    }
}
__device__ __forceinline__ void row_to_bf16(const float* xrow, bf16* orow, float* ssqrow, int lane) {
    f32x4 v[8]; float s = 0.f;
#pragma unroll
    for (int j = 0; j < 8; ++j) { v[j] = ((const f32x4*)xrow)[lane + 64 * j]; s += (v[j][0] * v[j][0] + v[j][1] * v[j][1]) + (v[j][2] * v[j][2] + v[j][3] * v[j][3]); }
    s = wave_sum(s);
#pragma unroll
    for (int j = 0; j < 8; ++j) { v2u w; w.x = pk2(v[j][0], v[j][1]); w.y = pk2(v[j][2], v[j][3]); ((v2u*)orow)[lane + 64 * j] = w; }
    if (lane < 32) ssqrow[lane] = (lane == 0) ? s : 0.f;
}
__device__ __forceinline__ void p0_prologue(unsigned char* ws, LAS unsigned char* lds, int wave, int lane) {
    LAS float* scr = (LAS float*)(lds + wave * 16640);
    const int gw = blockIdx.x * NWAVES + wave, NGW = gridDim.x * NWAVES;
    conv_run<0>(ws, scr, gw, NGW, 4096, lane);
    for (int m = gw; m < M + MROWS; m += NGW) {
        if (m < M) row_to_bf16(ka_in(0) + (size_t)m * D, (bf16*)(ws + WS_XB) + (size_t)m * D, (float*)(ws + WS_SSQ) + (size_t)m * 64, lane);
        else { const int r = m - M; row_to_bf16(ka_in(1) + (size_t)r * D, (bf16*)(ws + WS_MEMB) + (size_t)r * D, (float*)(ws + WS_SSQM) + (size_t)r * 64, lane); }
    }
}
constexpr int CONV_REST = 26624, CONV_SPLIT = 22272;
__device__ __forceinline__ void p1_convert(unsigned char* ws, LAS unsigned char* lds, int wave, int lane) {
    LAS float* scr = (LAS float*)(lds + wave * 16640);
    const int bx = blockIdx.x, G = gridDim.x;
    if (G <= 64) { conv_run<1>(ws, scr, bx * NWAVES + wave, G * NWAVES, CONV_REST, lane); return; }
    if (bx >= 64) conv_run<1>(ws, scr, (bx - 64) * NWAVES + wave, (G - 64) * NWAVES, CONV_SPLIT, lane);
    else conv_run<1>(ws, scr, CONV_SPLIT + bx * NWAVES + wave, 64 * NWAVES, CONV_REST, lane);
}
__device__ __forceinline__ void final_norm(float* x, const float* g, int wave, int lane) {
    const int gw = blockIdx.x * NWAVES + wave, NGW = gridDim.x * NWAVES;
    for (int m = gw; m < M; m += NGW) { f32x4* xr = (f32x4*)(x + (size_t)m * D); f32x4 v[8]; float s = 0.f;
#pragma unroll
        for (int j = 0; j < 8; ++j) { v[j] = xr[lane + 64 * j]; s += (v[j][0] * v[j][0] + v[j][1] * v[j][1]) + (v[j][2] * v[j][2] + v[j][3] * v[j][3]); }
        const float rs = 1.0f / sqrtf(wave_sum(s) * (1.0f / D) + 1e-6f);
#pragma unroll
        for (int j = 0; j < 8; ++j) { const f32x4 gv = ((const f32x4*)g)[lane + 64 * j]; xr[lane + 64 * j] = v[j] * rs * gv; } }
}
__device__ __forceinline__ void gating_simple(LAS unsigned char* lds, const bf16* z, const float* vst, const float* ln_g, const float* ln_b, const float* w_s, const float* b_s, bf16* gbuf, int tid) {
    LAS float* vln = (LAS float*)lds;
    LAS float* Wl = (LAS float*)(lds + 65536);
    LAS float* mu = (LAS float*)(lds + 65536 + 128 * 129 * 4);
    LAS float* rsd = mu + 128;
    for (int unit = blockIdx.x; unit < 1024; unit += gridDim.x) {
        const int h = unit & 15, tok0 = (unit >> 4) * 128;
        if (tid < 128) { const float* p = vst + (size_t)(tok0 + tid) * 64; float s1 = 0.f, s2 = 0.f;
#pragma unroll 8
            for (int i = 0; i < 32; ++i) { s1 += p[2 * i]; s2 += p[2 * i + 1]; }
            const float mean = s1 * (1.0f / 2048.0f), var = s2 * (1.0f / 2048.0f) - mean * mean; mu[tid] = mean; rsd[tid] = 1.0f / sqrtf(var + 1e-6f); }
        __syncthreads();
        { const int s = tid >> 2, db = (tid & 3) * 32; const float mean = mu[s], rs = rsd[s];
            const bf16* vp = z + (size_t)(tok0 + s) * 4096 + 2048 + h * 128 + db;
#pragma unroll
            for (int q = 0; q < 4; ++q) { const v4u w = *(const v4u*)(vp + 8 * q); const float* gp = ln_g + h * 128 + db + 8 * q; const float* bp = ln_b + h * 128 + db + 8 * q; LAS float* o = vln + s * 128 + db + 8 * q;
                o[0] = (bflo(w.x) - mean) * rs * gp[0] + bp[0]; o[1] = (bfhi(w.x) - mean) * rs * gp[1] + bp[1]; o[2] = (bflo(w.y) - mean) * rs * gp[2] + bp[2]; o[3] = (bfhi(w.y) - mean) * rs * gp[3] + bp[3];
                o[4] = (bflo(w.z) - mean) * rs * gp[4] + bp[4]; o[5] = (bfhi(w.z) - mean) * rs * gp[5] + bp[5]; o[6] = (bflo(w.w) - mean) * rs * gp[6] + bp[6]; o[7] = (bfhi(w.w) - mean) * rs * gp[7] + bp[7]; }
            const float* wp = w_s + ((size_t)h * 128 + s) * 128 + db;
#pragma unroll
            for (int q = 0; q < 8; ++q) { const f32x4 w4 = *(const f32x4*)(wp + 4 * q); LAS float* o = Wl + s * 129 + db + 4 * q; o[0] = w4[0]; o[1] = w4[1]; o[2] = w4[2]; o[3] = w4[3]; } }
        __syncthreads();
        { const int t = tid >> 2, d0 = (tid & 3) * 32, tmax = t | 15; float acc[32];
#pragma unroll
            for (int j = 0; j < 32; ++j) acc[j] = 0.f;
            for (int s = 0; s <= tmax; ++s) { const float w = (s <= t) ? Wl[t * 129 + s] : 0.f; const LAS f32x4* vr = (const LAS f32x4*)(vln + s * 128 + d0);
#pragma unroll
                for (int q = 0; q < 8; ++q) { const f32x4 vv = vr[q]; acc[4 * q] += w * vv[0]; acc[4 * q + 1] += w * vv[1]; acc[4 * q + 2] += w * vv[2]; acc[4 * q + 3] += w * vv[3]; } }
            const float bs = b_s[h * 128 + t];
            const bf16* up = z + (size_t)(tok0 + t) * 4096 + h * 128 + d0; bf16* op = gbuf + (size_t)(tok0 + t) * 2048 + h * 128 + d0;
#pragma unroll
            for (int q = 0; q < 4; ++q) { const v4u w = *(const v4u*)(up + 8 * q); v4u o;
                o.x = pk2(bflo(w.x) * (acc[8 * q] + bs), bfhi(w.x) * (acc[8 * q + 1] + bs)); o.y = pk2(bflo(w.y) * (acc[8 * q + 2] + bs), bfhi(w.y) * (acc[8 * q + 3] + bs));
                o.z = pk2(bflo(w.z) * (acc[8 * q + 4] + bs), bfhi(w.z) * (acc[8 * q + 5] + bs)); o.w = pk2(bflo(w.w) * (acc[8 * q + 6] + bs), bfhi(w.w) * (acc[8 * q + 7] + bs));
                *(v4u*)(op + 8 * q) = o; } }
        __syncthreads();
    }
}
__device__ __forceinline__ void gating_mfma(LAS unsigned char* lds, const bf16* z, const float* vst, const float* ln_g, const float* ln_b, const float* w_s, const float* b_s, bf16* gbuf, int wave, int lane) {
    LAS float* MU = (LAS float*)(lds + 69632);
    const int tid = wave * 64 + lane, fr = lane & 15, fq = lane >> 4;
    const int ss = tid >> 2, db = (tid & 3) * 32;
    for (int unit = blockIdx.x; unit < 256; unit += gridDim.x) {
        const int tok0 = (unit >> 2) * 128, hg = unit & 3;
        __syncthreads();
        if (tid < 128) { const float* sp = vst + (size_t)(tok0 + tid) * 64; float s1 = 0.f, s2 = 0.f;
#pragma unroll
            for (int i = 0; i < 16; ++i) { const f32x4 a = *(const f32x4*)(sp + 4 * i); s1 += a[0] + a[2]; s2 += a[1] + a[3]; }
            const float mean = s1 * (1.0f / 2048.0f), var = s2 * (1.0f / 2048.0f) - mean * mean; MU[tid] = mean; MU[128 + tid] = 1.0f / sqrtf(var + 1e-6f); }
        v4u raw[4];
        { const bf16* vp = z + (size_t)(tok0 + ss) * 4096 + 2048 + (hg * 4) * 128 + db;
#pragma unroll
            for (int q4 = 0; q4 < 4; ++q4) raw[q4] = *(const v4u*)(vp + 8 * q4); }
        __syncthreads();
        const float mean = MU[ss], rs = MU[128 + ss];
#pragma unroll 1
        for (int hh = 0; hh < 4; ++hh) { const int h = hg * 4 + hh; LAS unsigned char* VT = lds + (hh & 1) * 34816;
            { const float* gp = ln_g + h * 128 + db; const float* bp = ln_b + h * 128 + db; LAS unsigned char* wp = VT + db * 272 + ss * 2;
#pragma unroll
                for (int q4 = 0; q4 < 4; ++q4) { const f32x4 g0 = *(const f32x4*)(gp + 8 * q4), g1 = *(const f32x4*)(gp + 8 * q4 + 4), b0 = *(const f32x4*)(bp + 8 * q4), b1 = *(const f32x4*)(bp + 8 * q4 + 4); const v4u w = raw[q4];
                    const float v0 = (bflo(w.x) - mean) * rs * g0[0] + b0[0], v1 = (bfhi(w.x) - mean) * rs * g0[1] + b0[1], v2 = (bflo(w.y) - mean) * rs * g0[2] + b0[2], v3 = (bfhi(w.y) - mean) * rs * g0[3] + b0[3];
                    const float v4 = (bflo(w.z) - mean) * rs * g1[0] + b1[0], v5 = (bfhi(w.z) - mean) * rs * g1[1] + b1[1], v6 = (bflo(w.w) - mean) * rs * g1[2] + b1[2], v7 = (bfhi(w.w) - mean) * rs * g1[3] + b1[3];
                    LAS unsigned char* o = wp + (8 * q4) * 272;
                    *(LAS bf16*)(o + 0 * 272) = (bf16)f2bf(v0); *(LAS bf16*)(o + 1 * 272) = (bf16)f2bf(v1); *(LAS bf16*)(o + 2 * 272) = (bf16)f2bf(v2); *(LAS bf16*)(o + 3 * 272) = (bf16)f2bf(v3);
                    *(LAS bf16*)(o + 4 * 272) = (bf16)f2bf(v4); *(LAS bf16*)(o + 5 * 272) = (bf16)f2bf(v5); *(LAS bf16*)(o + 6 * 272) = (bf16)f2bf(v6); *(LAS bf16*)(o + 7 * 272) = (bf16)f2bf(v7); } }
            if (hh < 3) { const bf16* vp = z + (size_t)(tok0 + ss) * 4096 + 2048 + (h + 1) * 128 + db;
#pragma unroll
                for (int q4 = 0; q4 < 4; ++q4) raw[q4] = *(const v4u*)(vp + 8 * q4); }
            __syncthreads();
            const int t = 16 * wave + fr, nks = (wave >> 1) + 1;
            bf16x8 wf[4];
#pragma unroll
            for (int ks = 0; ks < 4; ++ks) { wf[ks] = (bf16x8){0, 0, 0, 0, 0, 0, 0, 0};
                if (ks < nks) { const float* wp = w_s + ((size_t)h * 128 + t) * 128 + 32 * ks + 8 * fq; const f32x4 a = *(const f32x4*)wp, c = *(const f32x4*)(wp + 4); const int s0 = 32 * ks + 8 * fq;
                    float v[8] = {a[0], a[1], a[2], a[3], c[0], c[1], c[2], c[3]};
#pragma unroll
                    for (int j = 0; j < 8; ++j) v[j] = (s0 + j <= t) ? v[j] : 0.f;
                    v4u w; w.x = pk2(v[0], v[1]); w.y = pk2(v[2], v[3]); w.z = pk2(v[4], v[5]); w.w = pk2(v[6], v[7]); wf[ks] = __builtin_bit_cast(bf16x8, w); } }
            const float bs = b_s[h * 128 + t];
            const bf16* up = z + (size_t)(tok0 + t) * 4096 + h * 128 + 4 * fq; bf16* op = gbuf + (size_t)(tok0 + t) * 2048 + h * 128 + 4 * fq;
            const LAS unsigned char* ab = VT + fr * 272 + fq * 16;
#pragma unroll
            for (int df = 0; df < 8; ++df) { f32x4 acc = (f32x4){0.f, 0.f, 0.f, 0.f};
#pragma unroll
                for (int ks = 0; ks < 4; ++ks) if (ks < nks) { const bf16x8 a = *(const LAS bf16x8*)(ab + df * 16 * 272 + ks * 64); acc = __builtin_amdgcn_mfma_f32_16x16x32_bf16(a, wf[ks], acc, 0, 0, 0); }
                const v2u uw = *(const v2u*)(up + 16 * df); v2u ow;
                ow.x = pg8::cvt_pk_bf16(bflo(uw.x) * (acc[0] + bs), bfhi(uw.x) * (acc[1] + bs)); ow.y = pg8::cvt_pk_bf16(bflo(uw.y) * (acc[2] + bs), bfhi(uw.y) * (acc[3] + bs));
                *(v2u*)(op + 16 * df) = ow; }
        }
    }
    __syncthreads();
}
__device__ __forceinline__ void attn_simple(LAS unsigned char* lds, const bf16* q, const bf16* Kb, const bf16* Vb, bf16* obuf, int wave, int lane) {
    LAS float* pl = (LAS float*)(lds + wave * 1024);
    const int gw = blockIdx.x * NWAVES + wave, NGW = gridDim.x * NWAVES;
    for (int task = gw; task < BATCH * 4 * SEQ; task += NGW) {
        const int bh = task >> 12, t = task & 4095, b = bh >> 2, h = bh & 3;
        float qf[8]; { const v4u w = *(const v4u*)(q + ((size_t)(b * SEQ + t)) * 2048 + h * 512 + 8 * lane);
            qf[0] = bflo(w.x); qf[1] = bfhi(w.x); qf[2] = bflo(w.y); qf[3] = bfhi(w.y); qf[4] = bflo(w.z); qf[5] = bfhi(w.z); qf[6] = bflo(w.w); qf[7] = bfhi(w.w); }
        const bf16* kp = Kb + (size_t)bh * 256 * 512 + 8 * lane;
        float sc[4];
#pragma unroll
        for (int kk = 0; kk < 4; ++kk) { float mine = 0.f;
            for (int l2 = 0; l2 < 64; ++l2) { const v4u w = *(const v4u*)(kp + (size_t)(kk * 64 + l2) * 512);
                float dsum = qf[0] * bflo(w.x) + qf[1] * bfhi(w.x) + qf[2] * bflo(w.y) + qf[3] * bfhi(w.y) + qf[4] * bflo(w.z) + qf[5] * bfhi(w.z) + qf[6] * bflo(w.w) + qf[7] * bfhi(w.w);
                dsum = wave_sum(dsum); if (lane == l2) mine = dsum; }
            sc[kk] = mine; }
        const float mx = wave_max(fmaxf(fmaxf(sc[0], sc[1]), fmaxf(sc[2], sc[3])));
        float p[4], ps = 0.f;
#pragma unroll
        for (int kk = 0; kk < 4; ++kk) { p[kk] = exp2f(sc[kk] - mx); ps += p[kk]; pl[kk * 64 + lane] = p[kk]; }
        const float inv = 1.0f / wave_sum(ps);
        LDS_WAIT();
        float o[8];
#pragma unroll
        for (int i = 0; i < 8; ++i) o[i] = 0.f;
        const bf16* vp = Vb + (size_t)bh * 256 * 512 + 8 * lane;
        for (int key = 0; key < 256; ++key) { const float pk = pl[key]; const v4u w = *(const v4u*)(vp + (size_t)key * 512);
            o[0] += pk * bflo(w.x); o[1] += pk * bfhi(w.x); o[2] += pk * bflo(w.y); o[3] += pk * bfhi(w.y); o[4] += pk * bflo(w.z); o[5] += pk * bfhi(w.z); o[6] += pk * bflo(w.w); o[7] += pk * bfhi(w.w); }
        v4u ow; ow.x = pk2(o[0] * inv, o[1] * inv); ow.y = pk2(o[2] * inv, o[3] * inv); ow.z = pk2(o[4] * inv, o[5] * inv); ow.w = pk2(o[6] * inv, o[7] * inv);
        *(v4u*)(obuf + ((size_t)(b * SEQ + t)) * 2048 + h * 512 + 8 * lane) = ow;
        LDS_WAIT();
    }
}
__device__ __forceinline__ void attn_mfma(LAS unsigned char* lds, const bf16* q, const bf16* Kb, const bf16* VTb, bf16* obuf, int wave, int lane) {
    const int tid = wave * 64 + lane, fr = lane & 15, fq = lane >> 4;
    unsigned voffK[2], voffV[2];
#pragma unroll
    for (int i = 0; i < 2; ++i) { int R, C; pg8::stage_rc(tid * 16 + i * 8192, R, C); voffK[i] = (unsigned)(R * 512 + C) * 2u; voffV[i] = (unsigned)(R * 256 + C) * 2u; }
    const unsigned ldsw = (unsigned)wave * 1024u;
    const int aoff0 = pg8::lds_byte(fr, fq * 8);
#define AT_STAGE_K(c, buf) do { _Pragma("unroll") for (int ht = 0; ht < 4; ++ht) { const char* src = Kg + ((size_t)(128 * (ht >> 1)) * 512 + 128 * (c) + 64 * (ht & 1)) * 2; \
        _Pragma("unroll") for (int i = 0; i < 2; ++i) __builtin_amdgcn_global_load_lds((const unsigned*)(src + voffK[i]), (LAS unsigned*)(lds + (buf) * 65536 + ht * 16384 + ldsw + i * 8192), 16, 0, 0); } } while (0)
#define AT_STAGE_V(cc, buf) do { _Pragma("unroll") for (int ht = 0; ht < 4; ++ht) { const char* src = Vg + ((size_t)(128 * ht) * 256 + 64 * (cc)) * 2; \
        _Pragma("unroll") for (int i = 0; i < 2; ++i) __builtin_amdgcn_global_load_lds((const unsigned*)(src + voffV[i]), (LAS unsigned*)(lds + (buf) * 65536 + ht * 16384 + ldsw + i * 8192), 16, 0, 0); } } while (0)
#define AT_WAIT() do { asm volatile("s_waitcnt vmcnt(0)" ::: "memory"); __syncthreads(); } while (0)
    for (int unit = blockIdx.x; unit < 256; unit += gridDim.x) {
        const int bh = unit >> 5, qb = unit & 31, b = bh >> 2, h = bh & 3;
        const char* Kg = (const char*)(Kb + (size_t)bh * 256 * 512);
        const char* Vg = (const char*)(VTb + (size_t)bh * 512 * 256);
        const size_t tok = (size_t)(b * SEQ + qb * 128 + 16 * wave + fr);
        bf16x8 qf[16];
        { const bf16* qp = q + tok * 2048 + h * 512 + 8 * fq;
#pragma unroll
            for (int s = 0; s < 16; ++s) qf[s] = *(const bf16x8*)(qp + 32 * s); }
        f32x4 acc[16];
#pragma unroll
        for (int n = 0; n < 16; ++n) acc[n] = (f32x4){0.f, 0.f, 0.f, 0.f};
        AT_STAGE_K(0, 0);
#pragma unroll
        for (int c = 0; c < 4; ++c) {
            AT_WAIT();
            if (c < 3) AT_STAGE_K(c + 1, (c + 1) & 1); else AT_STAGE_V(0, 0);
            const LAS unsigned char* bb = lds + (c & 1) * 65536 + aoff0; asm volatile("" : "+v"(bb));
#pragma unroll
            for (int kh = 0; kh < 2; ++kh)
#pragma unroll
                for (int k = 0; k < 2; ++k)
#pragma unroll
                    for (int ng = 0; ng < 2; ++ng) { bf16x8 a[8];
#pragma unroll
                        for (int n8 = 0; n8 < 8; ++n8) a[n8] = *(const LAS bf16x8*)(bb + (ng * 2 + kh) * 16384 + n8 * 2048 + k * 1024);
#pragma unroll
                        for (int n8 = 0; n8 < 8; ++n8) acc[ng * 8 + n8] = __builtin_amdgcn_mfma_f32_16x16x32_bf16(a[n8], qf[4 * c + 2 * kh + k], acc[ng * 8 + n8], 0, 0, 0);
                        __builtin_amdgcn_sched_barrier(0); }
        }
        float mx = acc[0][0];
#pragma unroll
        for (int n = 0; n < 16; ++n) mx = fmaxf(fmaxf(mx, fmaxf(acc[n][0], acc[n][1])), fmaxf(acc[n][2], acc[n][3]));
        mx = fmaxf(mx, __shfl_xor(mx, 16)); mx = fmaxf(mx, __shfl_xor(mx, 32));
        float l = 0.f;
#pragma unroll
        for (int n = 0; n < 16; ++n)
#pragma unroll
            for (int r = 0; r < 4; ++r) { const float pv = __builtin_amdgcn_exp2f(acc[n][r] - mx); acc[n][r] = pv; l += pv; }
        l += __shfl_xor(l, 16); l += __shfl_xor(l, 32);
        const float linv = 1.0f / l;
        bf16x8 pf[8];
#pragma unroll
        for (int s = 0; s < 8; ++s) { v4u w; w.x = pg8::cvt_pk_bf16(acc[2 * s][0], acc[2 * s][1]); w.y = pg8::cvt_pk_bf16(acc[2 * s][2], acc[2 * s][3]);
            w.z = pg8::cvt_pk_bf16(acc[2 * s + 1][0], acc[2 * s + 1][1]); w.w = pg8::cvt_pk_bf16(acc[2 * s + 1][2], acc[2 * s + 1][3]); pf[s] = __builtin_bit_cast(bf16x8, w); }
        __builtin_amdgcn_sched_barrier(0);
        f32x4 o[32];
#pragma unroll
        for (int mm = 0; mm < 32; ++mm) o[mm] = (f32x4){0.f, 0.f, 0.f, 0.f};
#pragma unroll
        for (int cc = 0; cc < 4; ++cc) {
            AT_WAIT();
            if (cc < 3) AT_STAGE_V(cc + 1, (cc + 1) & 1);
            const LAS unsigned char* bb = lds + (cc & 1) * 65536 + aoff0; asm volatile("" : "+v"(bb));
#pragma unroll
            for (int k = 0; k < 2; ++k)
#pragma unroll
                for (int mg = 0; mg < 4; ++mg) { bf16x8 a[8];
#pragma unroll
                    for (int m8 = 0; m8 < 8; ++m8) a[m8] = *(const LAS bf16x8*)(bb + mg * 16384 + m8 * 2048 + k * 1024);
#pragma unroll
                    for (int m8 = 0; m8 < 8; ++m8) o[mg * 8 + m8] = __builtin_amdgcn_mfma_f32_16x16x32_bf16(a[m8], pf[2 * cc + k], o[mg * 8 + m8], 0, 0, 0);
                    __builtin_amdgcn_sched_barrier(0); }
        }
        bf16* op = obuf + tok * 2048 + h * 512 + 4 * fq;
#pragma unroll
        for (int mm = 0; mm < 32; ++mm) { v2u w; w.x = pg8::cvt_pk_bf16(o[mm][0] * linv, o[mm][1] * linv); w.y = pg8::cvt_pk_bf16(o[mm][2] * linv, o[mm][3] * linv); *(v2u*)(op + 16 * mm) = w; }
    }
    asm volatile("s_waitcnt vmcnt(0)" ::: "memory"); __syncthreads();
#undef AT_STAGE_K
#undef AT_STAGE_V
#undef AT_WAIT
}
struct S5Lane { float lbr, lbi; float Br[16], Bi[16]; };
__device__ __forceinline__ void s5_lane_params(int g, int p, S5Lane& L) {
    const float lr = fminf(ka_in(15)[g * 64 + p], -1e-4f), li = ka_in(16)[g * 64 + p], dt = expf(ka_in(17)[g]);
    const float ar = lr * dt, th = li * dt; float sn, cs; sincosf(th, &sn, &cs); const float e = expf(ar), sh = sinf(0.5f * th);
    L.lbr = e * cs; L.lbi = e * sn;
    const float nr = expm1f(ar) * cs - 2.0f * sh * sh, ni = e * sn;
    const float den = 1.0f / (lr * lr + li * li), cr = (nr * lr + ni * li) * den, ci = (ni * lr - nr * li) * den;
#pragma unroll
    for (int c = 0; c < 16; ++c) { const float br = ka_in(18)[(size_t)(g * 64 + p) * 16 + c], bi = ka_in(19)[(size_t)(g * 64 + p) * 16 + c]; L.Br[c] = cr * br - ci * bi; L.Bi[c] = cr * bi + ci * br; }
}
__device__ __forceinline__ void s5_step(const S5Lane& L, const bf16* urow, float& xr, float& xi) {
    const v4u w0 = *(const v4u*)urow, w1 = *(const v4u*)(urow + 8);
    float u[16] = {bflo(w0.x), bfhi(w0.x), bflo(w0.y), bfhi(w0.y), bflo(w0.z), bfhi(w0.z), bflo(w0.w), bfhi(w0.w), bflo(w1.x), bfhi(w1.x), bflo(w1.y), bfhi(w1.y), bflo(w1.z), bfhi(w1.z), bflo(w1.w), bfhi(w1.w)};
    float br = 0.f, bi = 0.f;
#pragma unroll
    for (int c = 0; c < 16; ++c) { br += L.Br[c] * u[c]; bi += L.Bi[c] * u[c]; }
    const float nr = L.lbr * xr - L.lbi * xi + br, ni = L.lbr * xi + L.lbi * xr + bi; xr = nr; xi = ni;
}
__device__ __forceinline__ void s5_pass_a(const bf16* ub, f32x2* st, int wave, int lane) {
    const int gw = blockIdx.x * NWAVES + wave, NGW = gridDim.x * NWAVES;
    for (int task = gw; task < BATCH * 128 * 64; task += NGW) {
        const int seg = task & 63, g = (task >> 6) & 127, b = task >> 13;
        S5Lane L; s5_lane_params(g, lane, L);
        float xr = 0.f, xi = 0.f; const bf16* up = ub + (size_t)(b * SEQ + seg * 64) * 2048 + 16 * g;
#pragma unroll 2
        for (int s = 0; s < 64; ++s) s5_step(L, up + (size_t)s * 2048, xr, xi);
        st[(size_t)task * 64 + lane] = (f32x2){xr, xi};
    }
}
__device__ __forceinline__ void s5_pass_c(LAS unsigned char* lds, const bf16* ub, const f32x2* st, bf16* yb, int wave, int lane) {
    LAS f32x2* Cs = (LAS f32x2*)(lds + wave * 16640);
    LAS f32x2* xs = (LAS f32x2*)(lds + wave * 16640 + 8320);
    const int gw = blockIdx.x * NWAVES + wave, NGW = gridDim.x * NWAVES;
    for (int task = gw; task < BATCH * 128 * 64; task += NGW) {
        const int seg = task & 63, g = (task >> 6) & 127, b = task >> 13;
        S5Lane L; s5_lane_params(g, lane, L);
#pragma unroll
        for (int c = 0; c < 16; ++c) Cs[c * 65 + lane] = (f32x2){ka_in(20)[(size_t)(g * 16 + c) * 64 + lane], ka_in(21)[(size_t)(g * 16 + c) * 64 + lane]};
        float Ar = L.lbr, Ai = L.lbi;
#pragma unroll
        for (int i = 0; i < 6; ++i) { const float nr = Ar * Ar - Ai * Ai, ni = 2.0f * Ar * Ai; Ar = nr; Ai = ni; }
        float xr = 0.f, xi = 0.f; const f32x2* sp = st + (size_t)(task - seg) * 64 + lane;
#pragma unroll 2
        for (int n = 0; n < seg; ++n) { const f32x2 s = sp[(size_t)n * 64]; const float nr = Ar * xr - Ai * xi + s.x, ni = Ar * xi + Ai * xr + s.y; xr = nr; xi = ni; }
        const bf16* up = ub + (size_t)(b * SEQ + seg * 64) * 2048 + 16 * g; bf16* yp = yb + (size_t)(b * SEQ + seg * 64) * 2048 + 16 * g;
        const int t = lane & 15, cq = lane >> 4;
        f32x4 dsk = *(const f32x4*)(ka_in(22) + g * 16 + 4 * cq);
#pragma unroll 1
        for (int blk = 0; blk < 4; ++blk) {
#pragma unroll 2
            for (int s = 0; s < 16; ++s) { s5_step(L, up + (size_t)(blk * 16 + s) * 2048, xr, xi); xs[s * 65 + lane] = (f32x2){xr, xi}; }
            LDS_WAIT();
            float acc[4] = {0.f, 0.f, 0.f, 0.f};
#pragma unroll 4
            for (int p = 0; p < 64; ++p) { const f32x2 x = xs[t * 65 + p];
#pragma unroll
                for (int j = 0; j < 4; ++j) { const f32x2 c = Cs[(4 * cq + j) * 65 + p]; acc[j] += c.x * x.x - c.y * x.y; } }
            const v2u uw = *(const v2u*)(up + (size_t)(blk * 16 + t) * 2048 + 4 * cq);
            const float y0 = gelu_exact(acc[0] + dsk[0] * bflo(uw.x)), y1 = gelu_exact(acc[1] + dsk[1] * bfhi(uw.x)), y2 = gelu_exact(acc[2] + dsk[2] * bflo(uw.y)), y3 = gelu_exact(acc[3] + dsk[3] * bfhi(uw.y));
            v2u ow; ow.x = pk2(y0, y1); ow.y = pk2(y2, y3); *(v2u*)(yp + (size_t)(blk * 16 + t) * 2048 + 4 * cq) = ow;
            LDS_WAIT();
        }
    }
}
__device__ __forceinline__ void s5_mfma(LAS unsigned char* lds, const bf16* ub, bf16* yb, int wave, int lane) {
    LAS f32x2* PW = (LAS f32x2*)(lds);
    LAS f32x2* BB = (LAS f32x2*)(lds + 8704);
    LAS f32x2* CC = (LAS f32x2*)(lds + 16896);
    LAS bf16* KST = (LAS bf16*)(lds + 25088);
    LAS unsigned char* UI = lds + 33280;
    LAS float* SL = (LAS float*)(lds + 66048);
    LAS bf16* XP = (LAS bf16*)(lds + 99840);
    const int tid = wave * 64 + lane, fr = lane & 15, fq = lane >> 4;
    for (int unit = blockIdx.x; unit < 256; unit += gridDim.x) {
        const int b = unit >> 7, g = unit & 127;
        const float dt = expf(ka_in(17)[g]);
        __syncthreads();
        for (int idx = tid; idx < 17 * 64; idx += NTHREADS) { const int e = idx >> 6, p = idx & 63;
            const float lr = fminf(ka_in(15)[g * 64 + p], -1e-4f), li = ka_in(16)[g * 64 + p]; float sn, cs; sincosf(li * dt * (float)e, &sn, &cs); const float ex = expf(lr * dt * (float)e);
            PW[idx] = (f32x2){ex * cs, ex * sn}; }
        for (int idx = tid; idx < 1024; idx += NTHREADS) { const int p = idx >> 4, c = idx & 15;
            const float lr = fminf(ka_in(15)[g * 64 + p], -1e-4f), li = ka_in(16)[g * 64 + p]; const float ar = lr * dt, th = li * dt; float sn, cs; sincosf(th, &sn, &cs); const float e = expf(ar), sh = sinf(0.5f * th);
            const float nr = expm1f(ar) * cs - 2.0f * sh * sh, ni = e * sn, den = 1.0f / (lr * lr + li * li), cr = (nr * lr + ni * li) * den, ci = (ni * lr - nr * li) * den;
            const float br = ka_in(18)[(size_t)(g * 64 + p) * 16 + c], bi = ka_in(19)[(size_t)(g * 64 + p) * 16 + c];
            BB[idx] = (f32x2){cr * br - ci * bi, cr * bi + ci * br};
            CC[idx] = (f32x2){ka_in(20)[(size_t)g * 1024 + idx], ka_in(21)[(size_t)g * 1024 + idx]}; }
        __syncthreads();
        bf16x8 A1[8];
        { const int ri = wave >> 2, p = 16 * (wave & 3) + fr;
#pragma unroll
            for (int ks = 0; ks < 8; ++ks) { const int s = 2 * ks + (fq >> 1); const f32x2 pw = PW[(15 - s) * 64 + p]; float v[8];
#pragma unroll
                for (int j = 0; j < 8; ++j) { const f32x2 bb = BB[p * 16 + 8 * (fq & 1) + j]; v[j] = ri ? (pw.x * bb.y + pw.y * bb.x) : (pw.x * bb.x - pw.y * bb.y); }
                v4u w; w.x = pk2(v[0], v[1]); w.y = pk2(v[2], v[3]); w.z = pk2(v[4], v[5]); w.w = pk2(v[6], v[7]); A1[ks] = __builtin_bit_cast(bf16x8, w); } }
        const int t0 = wave, t1 = 15 - wave;
        bf16x8 CM[2][4];
#pragma unroll
        for (int ti = 0; ti < 2; ++ti) { const int t = ti ? t1 : t0;
#pragma unroll
            for (int ks = 0; ks < 4; ++ks) { float v[8];
#pragma unroll
                for (int j = 0; j < 8; ++j) { const int p = 32 * (ks & 1) + 8 * fq + j; const f32x2 c = CC[fr * 64 + p], pw = PW[(t + 1) * 64 + p];
                    v[j] = (ks >> 1) ? -(c.x * pw.y + c.y * pw.x) : (c.x * pw.x - c.y * pw.y); }
                v4u w; w.x = pk2(v[0], v[1]); w.y = pk2(v[2], v[3]); w.z = pk2(v[4], v[5]); w.w = pk2(v[6], v[7]); CM[ti][ks] = __builtin_bit_cast(bf16x8, w); } }
        { bf16x8 ct[4];
#pragma unroll
            for (int ks = 0; ks < 4; ++ks) { float v[8];
#pragma unroll
                for (int j = 0; j < 8; ++j) { const f32x2 c = CC[fr * 64 + 32 * (ks & 1) + 8 * fq + j]; v[j] = (ks >> 1) ? -c.y : c.x; }
                v4u w; w.x = pk2(v[0], v[1]); w.y = pk2(v[2], v[3]); w.z = pk2(v[4], v[5]); w.w = pk2(v[6], v[7]); ct[ks] = __builtin_bit_cast(bf16x8, w); }
#pragma unroll
            for (int si = 0; si < 2; ++si) { const int s = 2 * wave + si; f32x4 kacc = (f32x4){0.f, 0.f, 0.f, 0.f};
#pragma unroll
                for (int ks = 0; ks < 4; ++ks) { float v[8];
#pragma unroll
                    for (int j = 0; j < 8; ++j) { const int p = 32 * (ks & 1) + 8 * fq + j; const f32x2 pw = PW[(15 - s) * 64 + p], bb = BB[p * 16 + fr];
                        v[j] = (ks >> 1) ? (pw.x * bb.y + pw.y * bb.x) : (pw.x * bb.x - pw.y * bb.y); }
                    v4u w; w.x = pk2(v[0], v[1]); w.y = pk2(v[2], v[3]); w.z = pk2(v[4], v[5]); w.w = pk2(v[6], v[7]);
                    kacc = __builtin_amdgcn_mfma_f32_16x16x32_bf16(__builtin_bit_cast(bf16x8, w), ct[ks], kacc, 0, 0, 0); }
                v2u kw; kw.x = pk2(kacc[0], kacc[1]); kw.y = pk2(kacc[2], kacc[3]);
                *(LAS v2u*)(KST + ((15 - s) * 16 + fr) * 16 + 4 * fq) = kw; } }
        const f32x4 dsk = *(const f32x4*)(ka_in(22) + g * 16 + 4 * fq);
        float Xr = 0.f, Xi = 0.f;
#pragma unroll 1
        for (int q = 0; q < 4; ++q) {
            __syncthreads();
            { const bf16* src0 = ub + (size_t)(b * SEQ + q * 1024) * 2048 + 16 * g;
#pragma unroll
                for (int i = 0; i < 4; ++i) { const int piece = tid + NTHREADS * i, tok = piece >> 1, half = piece & 1;
                    const v4u w = *(const v4u*)(src0 + (size_t)tok * 2048 + 8 * half);
                    *(LAS v4u*)(UI + ((((tok & 15) * 64 + (tok >> 4)) * 2 + half) * 16)) = w; } }
            __syncthreads();
#pragma unroll 1
            for (int nf = 0; nf < 4; ++nf) { f32x4 acc = (f32x4){0.f, 0.f, 0.f, 0.f};
#pragma unroll
                for (int ks = 0; ks < 8; ++ks) { const bf16x8 bfr = *(const LAS bf16x8*)(UI + ((((2 * ks + (fq >> 1)) * 64 + 16 * nf + fr) * 2 + (fq & 1)) * 16));
                    acc = __builtin_amdgcn_mfma_f32_16x16x32_bf16(A1[ks], bfr, acc, 0, 0, 0); }
                *(LAS f32x4*)(SL + (16 * nf + fr) * 132 + 16 * wave + 4 * fq) = acc; }
            __syncthreads();
            if (wave == 0) { const f32x2 a16 = PW[16 * 64 + lane];
#pragma unroll 4
                for (int n = 0; n < 64; ++n) { XP[n * 136 + lane] = (bf16)f2bf(Xr); XP[n * 136 + 64 + lane] = (bf16)f2bf(Xi);
                    const float sr = SL[n * 132 + lane], si = SL[n * 132 + 64 + lane];
                    const float nr = a16.x * Xr - a16.y * Xi + sr, ni = a16.x * Xi + a16.y * Xr + si; Xr = nr; Xi = ni; } }
            __syncthreads();
#pragma unroll 1
            for (int nf = 0; nf < 4; ++nf) { f32x4 acc0 = (f32x4){0.f, 0.f, 0.f, 0.f}, acc1 = acc0;
#pragma unroll
                for (int ks = 0; ks < 8; ++ks) { if (2 * ks <= t1 || 2 * ks <= t0) {
                    const int s = 2 * ks + (fq >> 1);
                    const bf16x8 bfr = *(const LAS bf16x8*)(UI + (((s * 64 + 16 * nf + fr) * 2 + (fq & 1)) * 16));
                    if (2 * ks <= t0) { bf16x8 tf = (bf16x8){0, 0, 0, 0, 0, 0, 0, 0}; if (s <= t0) tf = *(const LAS bf16x8*)(KST + ((t0 - s) * 16 + fr) * 16 + 8 * (fq & 1)); acc0 = __builtin_amdgcn_mfma_f32_16x16x32_bf16(tf, bfr, acc0, 0, 0, 0); }
                    if (2 * ks <= t1) { bf16x8 tf = (bf16x8){0, 0, 0, 0, 0, 0, 0, 0}; if (s <= t1) tf = *(const LAS bf16x8*)(KST + ((t1 - s) * 16 + fr) * 16 + 8 * (fq & 1)); acc1 = __builtin_amdgcn_mfma_f32_16x16x32_bf16(tf, bfr, acc1, 0, 0, 0); } } }
#pragma unroll
                for (int ks = 0; ks < 4; ++ks) { const bf16x8 xf = *(const LAS bf16x8*)(XP + (16 * nf + fr) * 136 + 32 * ks + 8 * fq);
                    acc0 = __builtin_amdgcn_mfma_f32_16x16x32_bf16(CM[0][ks], xf, acc0, 0, 0, 0); acc1 = __builtin_amdgcn_mfma_f32_16x16x32_bf16(CM[1][ks], xf, acc1, 0, 0, 0); }
#pragma unroll
                for (int ti = 0; ti < 2; ++ti) { const int t = ti ? t1 : t0; const f32x4 a = ti ? acc1 : acc0; const int n = 16 * nf + fr;
                    const v2u uw = *(const LAS v2u*)(UI + (((t * 64 + n) * 2 + (fq >> 1)) * 16) + 8 * (fq & 1));
                    const pg8::f32x2 g0 = pg8::gelu_pk((pg8::f32x2){a[0] + dsk[0] * bflo(uw.x), a[1] + dsk[1] * bfhi(uw.x)}), g1 = pg8::gelu_pk((pg8::f32x2){a[2] + dsk[2] * bflo(uw.y), a[3] + dsk[3] * bfhi(uw.y)});
                    v2u ow; ow.x = pg8::cvt_pk_bf16(g0.x, g0.y); ow.y = pg8::cvt_pk_bf16(g1.x, g1.y);
                    *(v2u*)(yb + (size_t)(b * SEQ + q * 1024 + 16 * n + t) * 2048 + 16 * g + 4 * fq) = ow; } }
        }
    }
    __syncthreads();
}
#ifndef EN
#define EN(k) 1
#endif
template <int PH> __device__ __forceinline__ void run_phase(unsigned char* ws, float* X, LAS unsigned char* lds, int wave, int lane) {
    const int G = gridDim.x, bx = blockIdx.x;
    bf16* XB = (bf16*)(ws + WS_XB); float* SSQ = (float*)(ws + WS_SSQ);
    bf16* R0 = (bf16*)(ws + WS_R);
    constexpr int layer = (PH >= 10) ? 1 : 0;
    if constexpr (!EN(PH)) { return; }
    else if constexpr (PH == 0) p0_prologue(ws, lds, wave, lane);
    else if constexpr (PH == 1) {
        if (bx < 64) { const int i = bx >> 5;
            pg8::Gemm g{(const pg8::bf16_t*)(ws + WS_MEMB), (const pg8::bf16_t*)(ws + WS_W_KV + (size_t)i * 16 * MiB), MROWS, 4096, 2048}; pg8::StaticOrder S; S.init(MROWS, 4096, 32, bx & 31);
            pg8::EpiKV E{(pg8::bf16_t*)(ws + WS_KB + (size_t)i * 2 * MiB), (pg8::bf16_t*)(ws + WS_VB + (size_t)i * 2 * MiB), (pg8::bf16_t*)(ws + WS_VTB + (size_t)i * 2 * MiB), (const float*)(ws + WS_SSQM)};
            pg8::gemm_phase<pg8::EpiKV, pg8::StaticOrder, true, PG8_SP2V>(lds, g, S, E, wave, lane); }
        p1_convert(ws, lds, wave, lane);
    } else if constexpr (PH == 2) {
        pg8::Gemm g{XB, (const pg8::bf16_t*)(ws + WS_W_AIN), M, 4096, 2048}; pg8::StaticOrder S; S.init(M, 4096, G, bx);
        pg8::EpiAct<1, true> E{R0, 4096, ka_in(8), SSQ, 32, 1.0f, (float*)(ws + WS_VST), 8};
        pg8::gemm_phase<pg8::EpiAct<1, true>, pg8::StaticOrder, true, PG8_SP2V>(lds, g, S, E, wave, lane);
    } else if constexpr (PH == 3) {
#if defined(GATING_SIMPLE)
        gating_simple(lds, R0, (const float*)(ws + WS_VST), ka_in(9), ka_in(10), ka_in(11), ka_in(12), R0 + (size_t)M * 4096, wave * 64 + lane);
#else
        gating_mfma(lds, R0, (const float*)(ws + WS_VST), ka_in(9), ka_in(10), ka_in(11), ka_in(12), R0 + (size_t)M * 4096, wave, lane);
#endif
    }
    else if constexpr (PH == 4 || PH == 7 || PH == 9 || PH == 16 || PH == 18) {
        const pg8::bf16_t* A; const pg8::bf16_t* W; int K = 2048; const float* base = X;
        if constexpr (PH == 4) { A = R0 + (size_t)M * 4096; W = (const pg8::bf16_t*)(ws + WS_W_AOUT); base = ka_in(0); }
        else if constexpr (PH == 7 || PH == 16) { A = R0 + (size_t)M * 2048; W = (const pg8::bf16_t*)(ws + WS_W_O + (size_t)layer * 8 * MiB); }
        else { A = R0; W = (const pg8::bf16_t*)(ws + WS_W_DN + (size_t)layer * 32 * MiB); K = 8192; }
        pg8::Gemm g{A, W, M, 2048, K}; pg8::StaticOrder S; S.init(M, 2048, G, bx);
        pg8::EpiRes E{base, X, XB, SSQ};
        pg8::gemm_phase<pg8::EpiRes, pg8::StaticOrder, true, PG8_SP2V>(lds, g, S, E, wave, lane);
    } else if constexpr (PH == 5 || PH == 14 || PH == 10) {
        const pg8::bf16_t* W = (PH == 10) ? (const pg8::bf16_t*)(ws + WS_W_BIN) : (const pg8::bf16_t*)(ws + WS_W_Q + (size_t)layer * 8 * MiB);
        pg8::Gemm g{XB, W, M, 2048, 2048}; pg8::StaticOrder S; S.init(M, 2048, G, bx);
        pg8::EpiAct<0, false> E{R0, 2048, nullptr, SSQ, (PH == 14) ? 64 : 32, (PH == 10) ? 1.0f : 0.044194173824159216f * 1.4426950408889634f, nullptr, 0};
        pg8::gemm_phase<pg8::EpiAct<0, false>, pg8::StaticOrder, true, PG8_SP2V>(lds, g, S, E, wave, lane);
    } else if constexpr (PH == 6 || PH == 15) {
#if defined(ATTN_SIMPLE)
        attn_simple(lds, R0, (const bf16*)(ws + WS_KB + (size_t)layer * 2 * MiB), (const bf16*)(ws + WS_VB + (size_t)layer * 2 * MiB), R0 + (size_t)M * 2048, wave, lane);
#else
        attn_mfma(lds, R0, (const bf16*)(ws + WS_KB + (size_t)layer * 2 * MiB), (const bf16*)(ws + WS_VTB + (size_t)layer * 2 * MiB), R0 + (size_t)M * 2048, wave, lane);
#endif
    }
    else if constexpr (PH == 8 || PH == 17) {
        pg8::Gemm g{XB, (const pg8::bf16_t*)(ws + WS_W_UP + (size_t)layer * 32 * MiB), M, FF, 2048}; pg8::StaticOrder S; S.init(M, FF, G, bx);
        pg8::EpiAct<2, false> E{R0, FF, nullptr, SSQ, 32, 1.0f, nullptr, 0};
        pg8::gemm_phase<pg8::EpiAct<2, false>, pg8::StaticOrder, true, PG8_SP2V>(lds, g, S, E, wave, lane);
    } else if constexpr (PH == 11) {
#if defined(S5_SIMPLE)
        s5_pass_a(R0, (f32x2*)(ws + WS_S5ST), wave, lane);
#endif
    } else if constexpr (PH == 12) {
#if defined(S5_SIMPLE)
        s5_pass_c(lds, R0, (const f32x2*)(ws + WS_S5ST), R0 + (size_t)M * 2048, wave, lane);
#else
        s5_mfma(lds, R0, R0 + (size_t)M * 2048, wave, lane);
#endif
    }
    else if constexpr (PH == 13) {
        pg8::Gemm g{R0 + (size_t)M * 2048, (const pg8::bf16_t*)(ws + WS_W_BOUT), M, 4096, 2048}; pg8::StaticOrder S; S.init(M, 4096, G, bx);
        pg8::EpiGlu E{X, X, XB, SSQ, ka_in(24)};
        pg8::gemm_phase<pg8::EpiGlu, pg8::StaticOrder, true, PG8_SP2V>(lds, g, S, E, wave, lane);
    } else if constexpr (PH == 19) final_norm(X, ka_in(6), wave, lane);
}
__device__ __forceinline__ int lane_id() { int l; asm volatile("v_mbcnt_lo_u32_b32 %0, -1, 0\n\tv_mbcnt_hi_u32_b32 %0, -1, %0" : "=v"(l)); return l; }

#define XB_TMO      128
#define XB_XCNT(j)  (256  + 64 * (j))
#define XB_XSUB(j)  (1280 + 64 * (j))
#define XB_XGEN(j)  (2304 + 64 * (j))
#define XB_TOP      3328
#define XB_TOPGEN   3392
#define XCD_BAR_WORDS 3456
#define XB_SPIN_CAP (1u << 22)
__device__ __forceinline__ unsigned xb_ld(unsigned* p)              { return __hip_atomic_load(p, __ATOMIC_RELAXED, __HIP_MEMORY_SCOPE_AGENT); }
__device__ __forceinline__ unsigned xb_add(unsigned* p, unsigned v) { return __hip_atomic_fetch_add(p, v, __ATOMIC_RELAXED, __HIP_MEMORY_SCOPE_AGENT); }
__device__ __forceinline__ unsigned xb_xcc_id() { return (unsigned)__builtin_amdgcn_s_getreg((3 << 11) | 20) & 0xFu; }
#define XB_SPIN(cond, bar) do { unsigned _sp = 0; while (cond) { __builtin_amdgcn_s_sleep(1); \
    if ((++_sp & 255u) == 0u) { if (xb_ld(&(bar)[XB_TMO])) break; if (_sp > XB_SPIN_CAP) { atomicAdd(&(bar)[XB_TMO], 1u); break; } } } } while (0)
__device__ __forceinline__ void xcd_barrier_complete(unsigned* bar, unsigned x, unsigned& nloc, unsigned& nx) {
    const unsigned G = gridDim.x * gridDim.y * gridDim.z;
    unsigned sum, cnt, mine, sp = 0u;
    for (;;) {
        sum = 0u; cnt = 0u; mine = 0u;
#pragma unroll
        for (unsigned j = 0; j < 16; ++j) { const unsigned c = xb_ld(&bar[XB_XCNT(j)]); sum += c; cnt += (c > 0u) ? 1u : 0u; mine = (j == x) ? c : mine; }
        if (sum == G) break;
        __builtin_amdgcn_s_sleep(1);
        if ((++sp & 255u) == 0u) { if (xb_ld(&bar[XB_TMO])) break; if (sp > XB_SPIN_CAP) { atomicAdd(&bar[XB_TMO], 1u); break; } }
    }
    nloc = mine > 0u ? mine : 1u; nx = cnt > 0u ? cnt : 1u;
}
__device__ __forceinline__ void xcd_barrier(unsigned* bar, volatile LAS unsigned* st, bool is_t0) {
    asm volatile("s_waitcnt vmcnt(0)" ::: "memory");
    __syncthreads();
    if (is_t0) {
        __builtin_amdgcn_s_waitcnt(0);
        const unsigned x = xb_xcc_id();
        unsigned nloc = st[0], nx = st[1];
        if (nloc == 0u) { xcd_barrier_complete(bar, x, nloc, nx); st[0] = nloc; st[1] = nx; }
        const unsigned old = xb_add(&bar[XB_XSUB(x)], 1u);
        const unsigned gen = old / nloc;
        if (old + 1u == (gen + 1u) * nloc) {
            __builtin_amdgcn_fence(__ATOMIC_RELEASE, "agent");
            asm volatile("s_waitcnt vmcnt(0)" ::: "memory");
            const unsigned og = xb_add(&bar[XB_TOP], 1u);
            const unsigned tg = og / nx;
            if (og + 1u == (tg + 1u) * nx) xb_add(&bar[XB_TOPGEN], 1u);
            else XB_SPIN(xb_ld(&bar[XB_TOPGEN]) == tg, bar);
            __builtin_amdgcn_fence(__ATOMIC_ACQUIRE, "agent");
            xb_add(&bar[XB_XGEN(x)], 1u);
            asm volatile("s_waitcnt vmcnt(0)" ::: "memory");
        } else {
            XB_SPIN(xb_ld(&bar[XB_XGEN(x)]) == gen, bar);
            __builtin_amdgcn_fence(__ATOMIC_ACQUIRE, "agent");
            asm volatile("s_waitcnt vmcnt(0)" ::: "memory");
        }
    }
    __syncthreads();
}

__global__ void __launch_bounds__(NTHREADS, 2) trunk_fwd(Args args) {
    extern __shared__ __attribute__((aligned(16))) unsigned char lds_raw[];
    LAS unsigned char* lds = (LAS unsigned char*)lds_raw;
    const int wave = __builtin_amdgcn_readfirstlane((int)threadIdx.x >> 6);
    const int lo = args.ph_lo, hi = args.ph_hi;
    unsigned* bar = (unsigned*)args.ws + 4096;
    volatile LAS unsigned* st = (volatile LAS unsigned*)(lds + LDS_BYTES - 64);
#if MK_N_LAUNCHES == 1
    { const int l0 = lane_id(); if (wave == 0 && l0 < 2) st[l0] = 0u; __syncthreads(); if (wave == 0 && l0 == 0) (void)xb_add(&bar[XB_XCNT(xb_xcc_id())], 1u); }
#define GRID_BAR(k) do { if ((k) == 1) cg::this_grid().sync(); else xcd_barrier(bar, st, wave == 0 && lane_id() == 0); } while (0)
#else
#define GRID_BAR(k) do { } while (0)
#endif
#ifndef DUP_PH
#define DUP_PH -1
#endif
#if defined(PROBE_GEMM)
#if PROBE_GEMM == 3
typedef pg8::StaticOrder ProbeOrder;
#else
struct ProbeOrder { int c;
    __device__ __forceinline__ void init(int, int, int, int c_) { c = c_; }
    __device__ __forceinline__ bool next(int i, pg8::Unit& u) const { if (i >= 4) return false;
#if PROBE_GEMM == 1
        u.pm = 0; u.pn = 0;
#else
        u.pm = c >> 3; u.pn = c & 7;
#endif
        return true; }
    __device__ __forceinline__ void a_ready(const pg8::Unit&) const {}
    __device__ __forceinline__ void done(const pg8::Unit&) const {} };
#endif
#endif
#define PHASE(k) if (lo <= (k) && (k) < hi) { if ((k) > lo) GRID_BAR(k); run_phase<k>(args.ws, args.out, lds, wave, lane_id()); if ((k) == DUP_PH) { GRID_BAR(2); run_phase<k>(args.ws, args.out, lds, wave, lane_id()); } }
    PHASE(0) PHASE(1) PHASE(2) PHASE(3) PHASE(4) PHASE(5) PHASE(6) PHASE(7) PHASE(8) PHASE(9)
#if defined(PROBE_GEMM)
    { GRID_BAR(2); const int lane = lane_id(); unsigned char* ws = args.ws; bf16* R0 = (bf16*)(ws + WS_R);
      pg8::Gemm g{(bf16*)(ws + WS_XB), (const pg8::bf16_t*)(ws + WS_W_UP), M, FF, 2048}; ProbeOrder S; S.init(M, FF, gridDim.x, blockIdx.x);
      pg8::EpiAct<2, false> E{R0, FF, nullptr, (float*)(ws + WS_SSQ), 32, 1.0f, nullptr, 0};
      pg8::gemm_phase<pg8::EpiAct<2, false>, ProbeOrder, true, true>(lds, g, S, E, wave, lane); }
#endif
    PHASE(10)
#if defined(S5_SIMPLE)
    PHASE(11)
#endif
    PHASE(12) PHASE(13) PHASE(14) PHASE(15) PHASE(16) PHASE(17) PHASE(18) PHASE(19)
#undef PHASE
}

extern "C" void kernel_launch(void* const* d_in, const int* in_sizes, int n_in, void* d_out, int out_size, void* d_ws, size_t ws_size, hipStream_t stream) {
    static int grid = 0;
    if (grid == 0) {
        if (n_in != 30 || out_size != M * D || ws_size < WS_END) { fprintf(stderr, "kernel_launch: unexpected shapes (n_in %d out %d ws %zu)\n", n_in, out_size, ws_size); grid = -1; return; }
        int dev = 0, cus = 0, per_cu = 0;
        if (hipGetDevice(&dev) != hipSuccess || hipDeviceGetAttribute(&cus, hipDeviceAttributeMultiprocessorCount, dev) != hipSuccess) { grid = -1; return; }
        if (hipFuncSetAttribute((const void*)trunk_fwd, hipFuncAttributeMaxDynamicSharedMemorySize, LDS_BYTES) != hipSuccess) { fprintf(stderr, "kernel_launch: hipFuncSetAttribute failed\n"); grid = -1; return; }
        if (hipOccupancyMaxActiveBlocksPerMultiprocessor(&per_cu, (const void*)trunk_fwd, NTHREADS, LDS_BYTES) != hipSuccess || per_cu < 1) { fprintf(stderr, "kernel_launch: occupancy query says %d\n", per_cu); grid = -1; return; }
        grid = cus;
    }
    if (grid < 0) return;
    if (hipMemsetAsync(d_ws, 0, 65536, stream) != hipSuccess) { fprintf(stderr, "kernel_launch: memset failed\n"); return; }
    Args a{};
    for (int i = 0; i < 30; ++i) a.in[i] = (const float*)d_in[i];
    a.out = (float*)d_out; a.ws = (unsigned char*)d_ws;
#if MK_N_LAUNCHES == 1
    a.ph_lo = 0; a.ph_hi = NPH;
    void* kargs[] = {&a};
    hipError_t e = hipLaunchCooperativeKernel((const void*)trunk_fwd, dim3(grid), dim3(NTHREADS), kargs, LDS_BYTES, stream);
    if (e != hipSuccess) fprintf(stderr, "kernel_launch: cooperative launch failed: %s\n", hipGetErrorString(e));
#else
    for (int ph = 0; ph < NPH; ++ph) { a.ph_lo = ph; a.ph_hi = ph + 1; hipLaunchKernelGGL(trunk_fwd, dim3(grid), dim3(NTHREADS), LDS_BYTES, stream, a); }
#endif
}
```

```cpp
#include <hip/hip_runtime.h>
#include <hip/hip_cooperative_groups.h>
#include <cstdio>
#include <cstdint>
namespace cg = cooperative_groups;
#define MK_N_LAUNCHES 1
#define PG8_SP2V true
namespace pg8 {
#define PG8_LAS __attribute__((address_space(3)))
typedef unsigned short bf16_t;
typedef short bf16x8 __attribute__((ext_vector_type(8)));
typedef float f32x4 __attribute__((ext_vector_type(4)));
typedef unsigned u32x4 __attribute__((ext_vector_type(4)));
constexpr int BM = 256, BK = 64, HALF = 128, HTB = HALF * BK * 2  , STAGE_BYTES = 8 * HTB, NXCD = 8, WGM = 8;

__host__ __device__ __forceinline__ int lds_byte(int r, int c) { const int st = (r >> 4) * 2 + (c >> 5), rr = r & 15, cc = c & 31, ob = rr * 64 + cc * 2; return st * 1024 + (ob ^ (((ob >> 9) & 1) << 5)); }
__host__ __device__ __forceinline__ void stage_rc(int b, int& R, int& C) { const int st = b / 1024, sb = b % 1024, swz = sb ^ (((sb >> 9) & 1) << 5); R = (st >> 1) * 16 + swz / 64; C = (st & 1) * 32 + (swz % 64) / 2; }
__host__ __device__ __forceinline__ int perm32(int rho) { const int n = rho >> 4, i = rho & 15; return 8 * (i >> 2) + 4 * n + (i & 3); }

struct Unit { int pm, pn; };
struct Gemm { const bf16_t* A; const bf16_t* Bt; int M, N, K; };

struct StaticOrder {
    int nM, nN, nwg, G, c;
    __host__ __device__ void init(int M, int N, int G_, int c_) { nM = M / BM; nN = N / BM; nwg = nM * nN; G = G_; c = c_; }
    __host__ __device__ bool next(int i, Unit& u) const {
        const long L = (long)i * G + c; if (L >= nwg) return false;
        int wgid = (int)L; { const int q = nwg / NXCD, r = nwg % NXCD, xcd = wgid % NXCD, off = wgid / NXCD; wgid = (xcd < r ? xcd * (q + 1) : r * (q + 1) + (xcd - r) * q) + off; }
        const int nig = WGM * nN, gid = wgid / nig, fm = gid * WGM, gsz = (nM - fm) < WGM ? (nM - fm) : WGM;
        u.pm = fm + ((wgid % nig) % gsz); u.pn = (wgid % nig) / gsz; return true;
    }
    __device__ __forceinline__ void a_ready(const Unit&) const {}
    __device__ __forceinline__ void done(const Unit&) const {}
};

__device__ __forceinline__ unsigned cvt_pk_bf16(float lo, float hi) { unsigned r; asm volatile("v_cvt_pk_bf16_f32 %0, %1, %2" : "=v"(r) : "v"(lo), "v"(hi)); return r; }
typedef float f32x2 __attribute__((ext_vector_type(2)));
__device__ __forceinline__ f32x2 gelu_pk(f32x2 v) {
    const f32x2 av = __builtin_elementwise_abs(v), d = av * 0.2316418882f + 1.0f;
    f32x2 t; t.x = __builtin_amdgcn_rcpf(d.x); t.y = __builtin_amdgcn_rcpf(d.y);
    f32x2 q = t * 0.5307027145f + (-0.7265760135f); q = q * t + 0.7107068705f; q = q * t + (-0.142248368f); q = q * t + 0.127414796f; q = q * t;
    const f32x2 s = (v * v) * (-0.72134752044f);
    f32x2 e; e.x = __builtin_amdgcn_exp2f(s.x); e.y = __builtin_amdgcn_exp2f(s.y);
    const f32x2 m = v * (q * e), r = v - m;
    f32x2 o; o.x = v.x < 0.f ? m.x : r.x; o.y = v.y < 0.f ? m.y : r.y; return o;
}
typedef unsigned u32x2 __attribute__((ext_vector_type(2)));
constexpr int SSQ_STRIDE = 64;
__device__ __forceinline__ float row_rstd(const float* ssq, int np, int row, int fq) {
    const float* p = ssq + (size_t)row * SSQ_STRIDE + fq * (np >> 2);
    f32x4 a = *(const f32x4*)p, b = *(const f32x4*)(p + 4);
    float s = (a[0] + a[1]) + (a[2] + a[3]) + (b[0] + b[1]) + (b[2] + b[3]);
    if (np == 64) { f32x4 c = *(const f32x4*)(p + 8), d = *(const f32x4*)(p + 12); s += (c[0] + c[1]) + (c[2] + c[3]) + (d[0] + d[1]) + (d[2] + d[3]); }
    s += __shfl_xor(s, 16); s += __shfl_xor(s, 32);
    return __builtin_amdgcn_rsqf(s * (1.0f / 2048.0f) + 1e-6f);
}
template <int ACT, bool STATS> struct EpiAct {
    static constexpr bool PERM = true, AFTER_DRAIN = false;
    bf16_t* O; int ldc; const float* bias; const float* ssq; int np; float oscale; float* vst; int stat_pn0;
    __device__ __forceinline__ void operator()(const f32x4 (&acc)[2][2][4][2], const Unit& u, int wr, int wc, int fr, int fq) const {
        const int row0 = u.pm * BM + wr * 64 + fr, col0 = u.pn * BM + wc * 32 + 8 * fq;
        f32x4 bv[2][2];
#pragma unroll
        for (int bj = 0; bj < 2; ++bj)
#pragma unroll
            for (int n = 0; n < 2; ++n) bv[bj][n] = bias ? *(const f32x4*)(bias + col0 + bj * HALF + 4 * n) : (f32x4){0.f, 0.f, 0.f, 0.f};
        float rsv[2][4];
#pragma unroll
        for (int ai = 0; ai < 2; ++ai) {
#pragma unroll
            for (int m = 0; m < 4; ++m) rsv[ai][m] = row_rstd(ssq, np, row0 + ai * HALF + m * 16, fq); }
#pragma unroll
        for (int ai = 0; ai < 2; ++ai)
#pragma unroll
            for (int m = 0; m < 4; ++m) { const int row = row0 + ai * HALF + m * 16; const float rs = rsv[ai][m];
                bf16_t* rowp = O + (size_t)row * ldc + col0; float s1 = 0.f, s2 = 0.f;
#pragma unroll
                for (int bj = 0; bj < 2; ++bj) { f32x4 v0 = acc[ai][bj][m][0] * rs + bv[bj][0], v1 = acc[ai][bj][m][1] * rs + bv[bj][1];
                    if (ACT == 1) { f32x2 a = gelu_pk((f32x2){v0[0], v0[1]}), b = gelu_pk((f32x2){v0[2], v0[3]}), c = gelu_pk((f32x2){v1[0], v1[1]}), d = gelu_pk((f32x2){v1[2], v1[3]});
                        v0 = (f32x4){a.x, a.y, b.x, b.y}; v1 = (f32x4){c.x, c.y, d.x, d.y}; }
                    if (ACT == 2) {
#pragma unroll
                        for (int j = 0; j < 4; ++j) { const float a = fmaxf(v0[j], 0.f), b = fmaxf(v1[j], 0.f); v0[j] = a * a; v1[j] = b * b; } }
                    v0 = v0 * oscale; v1 = v1 * oscale;
                    if (STATS) { s1 += (v0[0] + v0[1]) + (v0[2] + v0[3]) + (v1[0] + v1[1]) + (v1[2] + v1[3]);
                        s2 += (v0[0] * v0[0] + v0[1] * v0[1]) + (v0[2] * v0[2] + v0[3] * v0[3]) + (v1[0] * v1[0] + v1[1] * v1[1]) + (v1[2] * v1[2] + v1[3] * v1[3]); }
                    u32x4 w; w.x = cvt_pk_bf16(v0[0], v0[1]); w.y = cvt_pk_bf16(v0[2], v0[3]); w.z = cvt_pk_bf16(v1[0], v1[1]); w.w = cvt_pk_bf16(v1[2], v1[3]);
                    *(u32x4*)(rowp + bj * HALF) = w; }
                if (STATS) { s1 += __shfl_xor(s1, 16); s1 += __shfl_xor(s1, 32); s2 += __shfl_xor(s2, 16); s2 += __shfl_xor(s2, 32);
                    if (u.pn >= stat_pn0 && fq == 0) *(f32x2*)(vst + (size_t)row * SSQ_STRIDE + ((u.pn - stat_pn0) * 4 + wc) * 2) = (f32x2){s1, s2}; }
            }
    }
};
struct EpiRes {
    static constexpr bool PERM = true, AFTER_DRAIN = false;
    bf16_t* xb; float* ssq;
    __device__ __forceinline__ void operator()(const f32x4 (&acc)[2][2][4][2], const Unit& u, int wr, int wc, int fr, int fq) const {
        const int row0 = u.pm * BM + wr * 64 + fr, col0 = u.pn * BM + wc * 32 + 8 * fq;
#pragma unroll
        for (int ai = 0; ai < 2; ++ai) {
            u32x4 pre[4][2];
#pragma unroll
            for (int m = 0; m < 4; ++m) { const size_t off = (size_t)(row0 + ai * HALF + m * 16) * 2048 + col0;
#pragma unroll
                for (int bj = 0; bj < 2; ++bj) pre[m][bj] = *(const u32x4*)(xb + off + bj * HALF); }
            asm volatile("" ::: "memory");
#pragma unroll
            for (int m = 0; m < 4; ++m) { const int row = row0 + ai * HALF + m * 16; const size_t off = (size_t)row * 2048 + col0; float ss = 0.f;
#pragma unroll
                for (int bj = 0; bj < 2; ++bj) { const u32x4 b = pre[m][bj]; const f32x4 a0 = acc[ai][bj][m][0], a1 = acc[ai][bj][m][1];
                    const float o0 = __builtin_bit_cast(float, b.x << 16) + a0[0], o1 = __builtin_bit_cast(float, b.x & 0xffff0000u) + a0[1], o2 = __builtin_bit_cast(float, b.y << 16) + a0[2], o3 = __builtin_bit_cast(float, b.y & 0xffff0000u) + a0[3];
                    const float o4 = __builtin_bit_cast(float, b.z << 16) + a1[0], o5 = __builtin_bit_cast(float, b.z & 0xffff0000u) + a1[1], o6 = __builtin_bit_cast(float, b.w << 16) + a1[2], o7 = __builtin_bit_cast(float, b.w & 0xffff0000u) + a1[3];
                    ss += (o0 * o0 + o1 * o1) + (o2 * o2 + o3 * o3) + (o4 * o4 + o5 * o5) + (o6 * o6 + o7 * o7);
                    u32x4 w; w.x = cvt_pk_bf16(o0, o1); w.y = cvt_pk_bf16(o2, o3); w.z = cvt_pk_bf16(o4, o5); w.w = cvt_pk_bf16(o6, o7); *(u32x4*)(xb + off + bj * HALF) = w; }
                ss += __shfl_xor(ss, 16); ss += __shfl_xor(ss, 32);
                if (fq == 0) ssq[(size_t)row * SSQ_STRIDE + u.pn * 4 + wc] = ss; }
            asm volatile("" ::: "memory"); }
    }
};
struct EpiGlu {
    static constexpr bool PERM = false, AFTER_DRAIN = false;
    bf16_t* xb; float* ssq; const float* bias;
    __device__ __forceinline__ void operator()(const f32x4 (&acc)[2][2][4][2], const Unit& u, int wr, int wc, int fr, int fq) const {
        const int row0 = u.pm * BM + wr * 64 + fr, col0 = u.pn * 128 + wc * 16 + 4 * fq;
        f32x4 bval[2], bgate[2];
#pragma unroll
        for (int bj = 0; bj < 2; ++bj) { bval[bj] = *(const f32x4*)(bias + col0 + bj * 64); bgate[bj] = *(const f32x4*)(bias + 2048 + col0 + bj * 64); }
#pragma unroll
        for (int ai = 0; ai < 2; ++ai) {
            u32x2 pre[4][2];
#pragma unroll
            for (int m = 0; m < 4; ++m) { const size_t off = (size_t)(row0 + ai * HALF + m * 16) * 2048 + col0;
#pragma unroll
                for (int bj = 0; bj < 2; ++bj) pre[m][bj] = *(const u32x2*)(xb + off + bj * 64); }
            asm volatile("" ::: "memory");
#pragma unroll
            for (int m = 0; m < 4; ++m) { const int row = row0 + ai * HALF + m * 16; const size_t off = (size_t)row * 2048 + col0; float ss = 0.f;
#pragma unroll
                for (int bj = 0; bj < 2; ++bj) { const f32x4 val = acc[ai][bj][m][0] + bval[bj], gate = acc[ai][bj][m][1] + bgate[bj]; const u32x2 pb = pre[m][bj]; f32x4 o = (f32x4){__builtin_bit_cast(float, pb.x << 16), __builtin_bit_cast(float, pb.x & 0xffff0000u), __builtin_bit_cast(float, pb.y << 16), __builtin_bit_cast(float, pb.y & 0xffff0000u)};
#pragma unroll
                    for (int j = 0; j < 4; ++j) { const float sg = __builtin_amdgcn_rcpf(1.0f + __builtin_amdgcn_exp2f(-1.4426950408889634f * gate[j])); o[j] += val[j] * sg; }
                    ss += (o[0] * o[0] + o[1] * o[1]) + (o[2] * o[2] + o[3] * o[3]);
                    u32x2 w; w.x = cvt_pk_bf16(o[0], o[1]); w.y = cvt_pk_bf16(o[2], o[3]); *(u32x2*)(xb + off + bj * 64) = w; }
                ss += __shfl_xor(ss, 16); ss += __shfl_xor(ss, 32);
                if (fq == 0) ssq[(size_t)row * SSQ_STRIDE + u.pn * 4 + wc] = ss; }
            asm volatile("" ::: "memory"); }
    }
};
__host__ __device__ __forceinline__ int vt_pos(int key) { const int s = key >> 5, w = key & 31; return 32 * s + 8 * ((w & 15) >> 2) + (w & 3) + 4 * (w >> 4); }
struct EpiKV {
    static constexpr bool PERM = true, AFTER_DRAIN = false;
    bf16_t* Kb; bf16_t* Vb; bf16_t* VTb; const float* ssq;
    __device__ __forceinline__ void operator()(const f32x4 (&acc)[2][2][4][2], const Unit& u, int wr, int wc, int fr, int fq) const {
        const int row0 = u.pm * BM + wr * 64 + fr, col0 = u.pn * BM + wc * 32 + 8 * fq;
#pragma unroll
        for (int ai = 0; ai < 2; ++ai)
#pragma unroll
            for (int m = 0; m < 4; ++m) { const int row = row0 + ai * HALF + m * 16; const float rs = row_rstd(ssq, 32, row, fq); const int b = row >> 8, key = row & 255;
#pragma unroll
                for (int bj = 0; bj < 2; ++bj) { const f32x4 v0 = acc[ai][bj][m][0] * rs, v1 = acc[ai][bj][m][1] * rs; const int col = col0 + bj * HALF;
                    u32x4 w; w.x = cvt_pk_bf16(v0[0], v0[1]); w.y = cvt_pk_bf16(v0[2], v0[3]); w.z = cvt_pk_bf16(v1[0], v1[1]); w.w = cvt_pk_bf16(v1[2], v1[3]);
                    if (col < 2048) { const int h = col >> 9, d = col & 511; *(u32x4*)(Kb + ((size_t)((b * 4 + h) * 256 + key)) * 512 + d) = w; }
                    else { const int c2 = col - 2048, h = c2 >> 9, d = c2 & 511; *(u32x4*)(Vb + ((size_t)((b * 4 + h) * 256 + key)) * 512 + d) = w;
                        bf16_t* vt = VTb + ((size_t)((b * 4 + h) * 512 + d)) * 256 + vt_pos(key);
                        vt[0 * 256] = (bf16_t)(w.x & 0xffffu); vt[1 * 256] = (bf16_t)(w.x >> 16); vt[2 * 256] = (bf16_t)(w.y & 0xffffu); vt[3 * 256] = (bf16_t)(w.y >> 16);
                        vt[4 * 256] = (bf16_t)(w.z & 0xffffu); vt[5 * 256] = (bf16_t)(w.z >> 16); vt[6 * 256] = (bf16_t)(w.w & 0xffffu); vt[7 * 256] = (bf16_t)(w.w >> 16); } }
            }
    }
};
template <class Epi, class Sched, bool ALIGN_EPI = false, bool SP2 = false>
__device__ __forceinline__ void gemm_phase(PG8_LAS unsigned char* lds, const Gemm g, const Sched& S, const Epi& E, const int wid  , const int lane) {
    const int tid = wid * 64 + lane, wr = wid >> 2, wc = wid & 3, fr = lane & 15, fq = lane >> 4;
    const int K = g.K, nt = K / BK;
    unsigned voffA[2], voffB[2];
#pragma unroll
    for (int i = 0; i < 2; ++i) { int R, C; stage_rc(tid * 16 + i * 8192, R, C); const int Rb = Epi::PERM ? ((R & ~31) + perm32(R & 31)) : R;
        voffA[i] = (unsigned)(R * K + C) * 2u; voffB[i] = (unsigned)(Rb * K + C) * 2u; }
    const size_t kstep = (size_t)(BK * 2);
    const size_t hstep = (size_t)HALF * K * 2;
    const size_t tstep = 2 * hstep;
    const unsigned ldsw = (unsigned)wid * 1024u;
    const int aoff = lds_byte(wr * 64 + fr, fq * 8), boff = lds_byte(wc * 32 + fr, fq * 8);
#define PG8_SA(b, h) (((b) * 2 + (h)) * HTB)
#define PG8_SB(b, h) ((4 + (b) * 2 + (h)) * HTB)
#define PG8_STAGE(bufoff, gbase, voff) do { _Pragma("unroll") for (int _i = 0; _i < 2; ++_i) \
        __builtin_amdgcn_global_load_lds((const unsigned*)((const char*)(gbase) + (voff)[_i]), (PG8_LAS unsigned*)(lds + (bufoff) + ldsw + _i * 8192), 16, 0, 0); } while (0)
#define PG8_LDA(dst, b, h) do { _Pragma("unroll") for (int m = 0; m < 4; ++m) _Pragma("unroll") for (int k = 0; k < 2; ++k) dst[m][k] = *(const PG8_LAS bf16x8*)(lds + PG8_SA(b, h) + aoff + m * 2048 + k * 1024); } while (0)
#define PG8_LDB(dst, b, h) do { _Pragma("unroll") for (int n = 0; n < 2; ++n) _Pragma("unroll") for (int k = 0; k < 2; ++k) dst[n][k] = *(const PG8_LAS bf16x8*)(lds + PG8_SB(b, h) + boff + n * 2048 + k * 1024); } while (0)
#define PG8_MMA(ai, bj, At, Bt) do { __builtin_amdgcn_s_setprio(1); _Pragma("unroll") for (int m = 0; m < 4; ++m) _Pragma("unroll") for (int n = 0; n < 2; ++n) _Pragma("unroll") for (int k = 0; k < 2; ++k) \
        acc[ai][bj][m][n] = __builtin_amdgcn_mfma_f32_16x16x32_bf16(Bt[n][k], At[m][k], acc[ai][bj][m][n], 0, 0, 0); __builtin_amdgcn_s_setprio(0); } while (0)
#define PG8_WAIT_V(n) asm volatile("s_waitcnt vmcnt(" #n ")" ::: "memory")
#define PG8_WAIT_L(n) asm volatile("s_waitcnt lgkmcnt(" #n ")" ::: "memory")
#define PG8_BAR __builtin_amdgcn_s_barrier()
#define PG8_SCHED __builtin_amdgcn_sched_barrier(0)
    Unit cur, nxt; int ui = 0;
    if (!S.next(0, cur)) return;
    f32x4 acc[2][2][4][2];
#pragma unroll
    for (int a = 0; a < 2; ++a)
#pragma unroll
        for (int b = 0; b < 2; ++b)
#pragma unroll
            for (int m = 0; m < 4; ++m)
#pragma unroll
                for (int n = 0; n < 2; ++n) acc[a][b][m][n] = (f32x4){0.f, 0.f, 0.f, 0.f};
    bf16x8 At[4][2], B0[2][2], B1[2][2];
    const char* cA = (const char*)g.A + (size_t)cur.pm * tstep; const char* cB = (const char*)g.Bt + (size_t)cur.pn * tstep;
    S.a_ready(cur);
    if constexpr (SP2) {
        PG8_STAGE(PG8_SB(0, 0), cB, voffB); PG8_STAGE(PG8_SB(0, 1), cB + hstep, voffB); PG8_STAGE(PG8_SA(0, 0), cA, voffA); PG8_STAGE(PG8_SA(0, 1), cA + hstep, voffA);
        if (wr == 1) PG8_BAR;
        PG8_WAIT_V(2); PG8_BAR;
        PG8_STAGE(PG8_SB(1, 0), cB + kstep, voffB); PG8_STAGE(PG8_SA(1, 0), cA + kstep, voffA); PG8_STAGE(PG8_SB(1, 1), cB + hstep + kstep, voffB);
        PG8_WAIT_V(6); PG8_BAR;
    } else {
        PG8_STAGE(PG8_SB(0, 0), cB, voffB); PG8_STAGE(PG8_SA(0, 0), cA, voffA); PG8_STAGE(PG8_SB(0, 1), cB + hstep, voffB); PG8_STAGE(PG8_SA(0, 1), cA + hstep, voffA);
        if (wr == 1) PG8_BAR;
        PG8_WAIT_V(4); PG8_BAR;
        PG8_STAGE(PG8_SB(1, 0), cB + kstep, voffB); PG8_STAGE(PG8_SA(1, 0), cA + kstep, voffA); PG8_STAGE(PG8_SB(1, 1), cB + hstep + kstep, voffB);
        PG8_WAIT_V(6); PG8_BAR;
    }
    for (;;) {
        const bool has_next = S.next(ui + 1, nxt);
        const char* nA = has_next ? (const char*)g.A + (size_t)nxt.pm * tstep : cA; const char* nB = has_next ? (const char*)g.Bt + (size_t)nxt.pn * tstep : cB;
        for (int t = 0; t < nt; t += 2) {
            const bool last = (t == nt - 2);
            const char* a1 = cA + (size_t)(t + 1) * kstep;
            const char* a2 = last ? nA : cA + (size_t)(t + 2) * kstep; const char* b2 = last ? nB : cB + (size_t)(t + 2) * kstep;
            const char* a3 = a2 + kstep; const char* b3 = b2 + kstep;
            if (last && has_next) S.a_ready(nxt);
            if constexpr (SP2) {
            PG8_LDB(B0, 0, 0); PG8_LDB(B1, 0, 1); PG8_SCHED; PG8_LDA(At, 0, 0); PG8_STAGE(PG8_SA(1, 1), a1 + hstep, voffA);
            PG8_WAIT_V(8); PG8_WAIT_L(0); PG8_BAR; PG8_MMA(0, 0, At, B0); PG8_MMA(0, 1, At, B1); PG8_BAR; PG8_SCHED;
            PG8_LDA(At, 0, 1); PG8_STAGE(PG8_SB(0, 0), b2, voffB); PG8_STAGE(PG8_SB(0, 1), b2 + hstep, voffB); PG8_STAGE(PG8_SA(0, 0), a2, voffA);
            PG8_WAIT_V(8); PG8_WAIT_L(0); PG8_BAR; PG8_MMA(1, 0, At, B0); PG8_MMA(1, 1, At, B1); PG8_BAR; PG8_SCHED;
            PG8_LDB(B0, 1, 0); PG8_LDB(B1, 1, 1); PG8_SCHED; PG8_LDA(At, 1, 0); PG8_STAGE(PG8_SA(0, 1), a2 + hstep, voffA);
            PG8_WAIT_V(8); PG8_WAIT_L(0); PG8_BAR; PG8_MMA(0, 0, At, B0); PG8_MMA(0, 1, At, B1); PG8_BAR; PG8_SCHED;
            PG8_LDA(At, 1, 1); PG8_STAGE(PG8_SB(1, 0), b3, voffB); PG8_STAGE(PG8_SB(1, 1), b3 + hstep, voffB); PG8_STAGE(PG8_SA(1, 0), a3, voffA);
            PG8_WAIT_V(8); PG8_WAIT_L(0); PG8_BAR; PG8_MMA(1, 0, At, B0); PG8_MMA(1, 1, At, B1); PG8_BAR; PG8_SCHED;
            } else {
            PG8_LDB(B0, 0, 0); PG8_SCHED; PG8_LDA(At, 0, 0); PG8_STAGE(PG8_SA(1, 1), a1 + hstep, voffA);
            PG8_WAIT_L(8); PG8_BAR; PG8_WAIT_L(0); PG8_MMA(0, 0, At, B0); PG8_BAR; PG8_SCHED;
            PG8_LDB(B1, 0, 1); PG8_STAGE(PG8_SB(0, 0), b2, voffB);
            PG8_BAR; PG8_WAIT_L(0); PG8_MMA(0, 1, At, B1); PG8_BAR;
            PG8_LDA(At, 0, 1); PG8_STAGE(PG8_SA(0, 0), a2, voffA);
            PG8_BAR; PG8_WAIT_L(0); PG8_MMA(1, 0, At, B0); PG8_BAR; PG8_SCHED;
            PG8_STAGE(PG8_SB(0, 1), b2 + hstep, voffB);
            PG8_WAIT_V(6); PG8_BAR; PG8_MMA(1, 1, At, B1); PG8_BAR;
            PG8_LDB(B0, 1, 0); PG8_SCHED; PG8_LDA(At, 1, 0); PG8_STAGE(PG8_SA(0, 1), a2 + hstep, voffA);
            PG8_WAIT_L(8); PG8_BAR; PG8_WAIT_L(0); PG8_MMA(0, 0, At, B0); PG8_BAR; PG8_SCHED;
            PG8_LDB(B1, 1, 1); PG8_STAGE(PG8_SB(1, 0), b3, voffB);
            PG8_BAR; PG8_WAIT_L(0); PG8_MMA(0, 1, At, B1); PG8_BAR;
            PG8_LDA(At, 1, 1); PG8_STAGE(PG8_SA(1, 0), a3, voffA);
            PG8_BAR; PG8_WAIT_L(0); PG8_MMA(1, 0, At, B0); PG8_BAR; PG8_SCHED;
            PG8_STAGE(PG8_SB(1, 1), b3 + hstep, voffB);
            PG8_WAIT_V(6); PG8_BAR; PG8_MMA(1, 1, At, B1); PG8_BAR;
            }
        }
        if constexpr (ALIGN_EPI) { if (wr == 0) PG8_BAR; }
        if constexpr (!Epi::AFTER_DRAIN) { Unit ue = cur; asm volatile("" : "+s"(ue.pm), "+s"(ue.pn));
            int fre = fr, fqe = fq; asm volatile("" : "+v"(fre), "+v"(fqe)); E(acc, ue, wr, wc, fre, fqe); S.done(cur); }
        if (!has_next) break;
#pragma unroll
        for (int a = 0; a < 2; ++a)
#pragma unroll
            for (int b = 0; b < 2; ++b)
#pragma unroll
                for (int m = 0; m < 4; ++m)
#pragma unroll
                    for (int n = 0; n < 2; ++n) acc[a][b][m][n] = (f32x4){0.f, 0.f, 0.f, 0.f};
        cur = nxt; cA = nA; cB = nB; ++ui;
        if constexpr (ALIGN_EPI) { if (wr == 1) PG8_BAR; }
    }
    PG8_WAIT_V(0);
    if constexpr (!ALIGN_EPI) { if (wr == 0) PG8_BAR; }
    PG8_BAR;
    if constexpr (Epi::AFTER_DRAIN) { E.fused(acc, cur, wr, wc, fr, fq, lds, wid, lane); S.done(cur); }
#undef PG8_SA
#undef PG8_SB
#undef PG8_STAGE
#undef PG8_LDA
#undef PG8_LDB
#undef PG8_MMA
#undef PG8_WAIT_V
#undef PG8_WAIT_L
#undef PG8_BAR
#undef PG8_SCHED
}
}
#ifndef MK_N_LAUNCHES
#define MK_N_LAUNCHES 1
#endif
constexpr int BATCH = 2, SEQ = 4096, D = 2048, M = BATCH * SEQ, MEMLEN = 256, MROWS = BATCH * MEMLEN, FF = 8192;
constexpr int NWAVES = 8, NTHREADS = 512, NPH = 20;
constexpr int LDS_BYTES = 147456;
constexpr size_t MiB = 1u << 20;
constexpr size_t WS_W_AIN = 2 * MiB, WS_W_AOUT = 18 * MiB, WS_W_BIN = 26 * MiB, WS_W_BOUT = 34 * MiB, WS_W_Q = 50 * MiB, WS_W_KV = 66 * MiB, WS_W_O = 98 * MiB, WS_W_UP = 114 * MiB, WS_W_DN = 178 * MiB;
constexpr size_t WS_XB = 242 * MiB, WS_MEMB = 274 * MiB, WS_KB = 276 * MiB, WS_VB = 280 * MiB, WS_VTB = 284 * MiB, WS_SSQ = 288 * MiB, WS_VST = 290 * MiB, WS_SSQM = 292 * MiB, WS_S5ST = 294 * MiB;
constexpr size_t WS_R = 304 * MiB, WS_END = 432 * MiB;
#define GAS __attribute__((address_space(1)))
#define LAS __attribute__((address_space(3)))
typedef unsigned short bf16;
typedef unsigned v4u __attribute__((ext_vector_type(4)));
typedef unsigned v2u __attribute__((ext_vector_type(2)));
typedef float f32x4 __attribute__((ext_vector_type(4)));
typedef float f32x2 __attribute__((ext_vector_type(2)));
typedef short bf16x8 __attribute__((ext_vector_type(8)));
#define LDS_WAIT() asm volatile("s_waitcnt lgkmcnt(0)" ::: "memory")
__device__ __forceinline__ unsigned f2bf(float f) { unsigned u = __builtin_bit_cast(unsigned, f); return (u + 0x7fffu + ((u >> 16) & 1u)) >> 16; }
__device__ __forceinline__ unsigned pk2(float lo, float hi) { return f2bf(lo) | (f2bf(hi) << 16); }
__device__ __forceinline__ float bflo(unsigned w) { return __builtin_bit_cast(float, w << 16); }
__device__ __forceinline__ float bfhi(unsigned w) { return __builtin_bit_cast(float, w & 0xffff0000u); }
__device__ __forceinline__ float wave_sum(float v) {
#pragma unroll
    for (int o = 1; o < 64; o <<= 1) v += __shfl_xor(v, o);
    return v;
}
__device__ __forceinline__ float wave_max(float v) {
#pragma unroll
    for (int o = 1; o < 64; o <<= 1) v = fmaxf(v, __shfl_xor(v, o));
    return v;
}
__device__ __forceinline__ float gelu_exact(float v) { return 0.5f * v * (1.0f + erff(v * 0.70710678118654752f)); }

struct Args { const float* in[30]; float* out; unsigned char* ws; int ph_lo, ph_hi; };
__device__ __forceinline__ const float* ka_in(int i) { const __attribute__((address_space(4))) char* ka = (const __attribute__((address_space(4))) char*)__builtin_amdgcn_kernarg_segment_ptr(); asm volatile("" : "+s"(ka)); return *(const float* const __attribute__((address_space(4)))*)(ka + 8 * i); }

__device__ __forceinline__ int glu_rowmap(int n) { return n < 2048 ? 32 * (n >> 4) + (n & 15) : 32 * ((n - 2048) >> 4) + 16 + (n & 15); }
struct ConvSel { const float* W; const float* g; bf16* WT; int K, N, mode, item; };
__device__ __forceinline__ ConvSel conv_select(unsigned char* ws, int r) {
    ConvSel s; s.g = nullptr; s.K = 2048; s.N = 2048; s.mode = 0;
    if (r < 2048) { s.W = ka_in(7); s.g = ka_in(2); s.WT = (bf16*)(ws + WS_W_AIN); s.N = 4096; }
    else if ((r -= 2048) < 1024) { s.W = ka_in(13); s.WT = (bf16*)(ws + WS_W_AOUT); }
    else if ((r -= 1024) < 1024) { s.W = ka_in(14); s.g = ka_in(2) + 2048; s.WT = (bf16*)(ws + WS_W_BIN); }
    else if ((r -= 1024) < 2048) { s.W = ka_in(23); s.WT = (bf16*)(ws + WS_W_BOUT); s.N = 4096; s.mode = 1; }
    else if ((r -= 2048) < 2048) { const int i = r >> 10; r &= 1023; s.W = ka_in(25) + (size_t)i * 2048 * 2048; s.g = ka_in(3) + i * 2048; s.WT = (bf16*)(ws + WS_W_Q + i * 8 * MiB); }
    else if ((r -= 2048) < 4096) { const int i = r >> 11; r &= 2047; s.W = ka_in(26) + (size_t)i * 2048 * 4096; s.g = ka_in(4) + i * 2048; s.WT = (bf16*)(ws + WS_W_KV + i * 16 * MiB); s.N = 4096; }
    else if ((r -= 4096) < 2048) { const int i = r >> 10; r &= 1023; s.W = ka_in(27) + (size_t)i * 2048 * 2048; s.WT = (bf16*)(ws + WS_W_O + i * 8 * MiB); }
    else if ((r -= 2048) < 8192) { const int i = r >> 12; r &= 4095; s.W = ka_in(28) + (size_t)i * 2048 * 8192; s.g = ka_in(5) + i * 2048; s.WT = (bf16*)(ws + WS_W_UP + i * 32 * MiB); s.N = 8192; }
    else { r -= 8192; const int i = r >> 12; r &= 4095; s.W = ka_in(29) + (size_t)i * 8192 * 2048; s.WT = (bf16*)(ws + WS_W_DN + i * 32 * MiB); s.K = 8192; }
    s.item = r; return s;
}
__device__ __forceinline__ void conv_load(const ConvSel& s, f32x4 (&v)[16], int lane) {
    const int nblk = s.N >> 6, kb = s.item / nblk, nb = s.item - kb * nblk, k0 = 64 * kb, n0 = 64 * nb;
#pragma unroll
    for (int i = 0; i < 16; ++i) { const int kk = 4 * i + (lane >> 4); v[i] = *(const f32x4*)(s.W + (size_t)(k0 + kk) * s.N + n0 + 4 * (lane & 15)); }
}
__device__ __forceinline__ void conv_finish(const ConvSel& s, const f32x4 (&v)[16], LAS float* scr, int lane) {
    const int nblk = s.N >> 6, kb = s.item / nblk, nb = s.item - kb * nblk, k0 = 64 * kb, n0 = 64 * nb;
#pragma unroll
    for (int i = 0; i < 16; ++i) { const int kk = 4 * i + (lane >> 4); const float sc = s.g ? s.g[k0 + kk] : 1.0f; LAS float* d = scr + kk * 65 + 4 * (lane & 15);
        d[0] = v[i][0] * sc; d[1] = v[i][1] * sc; d[2] = v[i][2] * sc; d[3] = v[i][3] * sc; }
    LDS_WAIT();
    const int c = lane & 7;
#pragma unroll
    for (int j = 0; j < 8; ++j) { const int n = (lane >> 3) + 8 * j; const LAS float* sp = scr + (8 * c) * 65 + n;
        v4u o; o.x = pk2(sp[0 * 65], sp[1 * 65]); o.y = pk2(sp[2 * 65], sp[3 * 65]); o.z = pk2(sp[4 * 65], sp[5 * 65]); o.w = pk2(sp[6 * 65], sp[7 * 65]);
        const int nr = s.mode ? glu_rowmap(n0 + n) : (n0 + n);
        *(v4u*)(s.WT + (size_t)nr * s.K + k0 + 8 * c) = o; }
    LDS_WAIT();
}
template <int PART> __device__ __forceinline__ int conv_index(int j) { return PART == 0 ? 8192 + j : (j < 8192 ? j : j + 4096); }
template <int PART> __device__ __forceinline__ void conv_run(unsigned char* ws, LAS float* scr, int first, int step, int limit, int lane) {
    if (first >= limit) return;
    f32x4 va[16], vb[16];
    ConvSel sa = conv_select(ws, conv_index<PART>(__builtin_amdgcn_readfirstlane(first))), sb = sa;
    conv_load(sa, va, lane);
    for (int j = first; j < limit; j += 2 * step) {
        const bool hb = (j + step) < limit;
        if (hb) { sb = conv_select(ws, conv_index<PART>(__builtin_amdgcn_readfirstlane(j + step))); conv_load(sb, vb, lane); }
        conv_finish(sa, va, scr, lane);
        if (!hb) break;
        const bool ha = (j + 2 * step) < limit;
        if (ha) { sa = conv_select(ws, conv_index<PART>(__builtin_amdgcn_readfirstlane(j + 2 * step))); conv_load(sa, va, lane); }
        conv_finish(sb, vb, scr, lane);
    }
}
__device__ __forceinline__ void row_to_bf16(const float* xrow, bf16* orow, float* ssqrow, int lane) {
    f32x4 v[8]; float s = 0.f;
#pragma unroll
    for (int j = 0; j < 8; ++j) { v[j] = ((const f32x4*)xrow)[lane + 64 * j]; s += (v[j][0] * v[j][0] + v[j][1] * v[j][1]) + (v[j][2] * v[j][2] + v[j][3] * v[j][3]); }
    s = wave_sum(s);
#pragma unroll
    for (int j = 0; j < 8; ++j) { v2u w; w.x = pk2(v[j][0], v[j][1]); w.y = pk2(v[j][2], v[j][3]); ((v2u*)orow)[lane + 64 * j] = w; }
    if (lane < 32) ssqrow[lane] = (lane == 0) ? s : 0.f;
}
__device__ __forceinline__ void p0_prologue(unsigned char* ws, LAS unsigned char* lds, int wave, int lane) {
    LAS float* scr = (LAS float*)(lds + wave * 16640);
    const int gw = blockIdx.x * NWAVES + wave, NGW = gridDim.x * NWAVES;
    conv_run<0>(ws, scr, gw, NGW, 4096, lane);
    for (int m = gw; m < M + MROWS; m += NGW) {
        if (m < M) row_to_bf16(ka_in(0) + (size_t)m * D, (bf16*)(ws + WS_XB) + (size_t)m * D, (float*)(ws + WS_SSQ) + (size_t)m * 64, lane);
        else { const int r = m - M; row_to_bf16(ka_in(1) + (size_t)r * D, (bf16*)(ws + WS_MEMB) + (size_t)r * D, (float*)(ws + WS_SSQM) + (size_t)r * 64, lane); }
    }
}
constexpr int CONV_REST = 26624, CONV_SPLIT = 22272;
__device__ __forceinline__ void p1_convert(unsigned char* ws, LAS unsigned char* lds, int wave, int lane) {
    LAS float* scr = (LAS float*)(lds + wave * 16640);
    const int bx = blockIdx.x, G = gridDim.x;
    if (G <= 64) { conv_run<1>(ws, scr, bx * NWAVES + wave, G * NWAVES, CONV_REST, lane); return; }
    if (bx >= 64) conv_run<1>(ws, scr, (bx - 64) * NWAVES + wave, (G - 64) * NWAVES, CONV_SPLIT, lane);
    else conv_run<1>(ws, scr, CONV_SPLIT + bx * NWAVES + wave, 64 * NWAVES, CONV_REST, lane);
}
__device__ __forceinline__ void final_norm(const bf16* xb, const float* ssq, const float* g, float* out, int wave, int lane) {
    const int gw = blockIdx.x * NWAVES + wave, NGW = gridDim.x * NWAVES;
    for (int m = gw; m < M; m += NGW) {
        float s = (lane < 32) ? ssq[(size_t)m * 64 + lane] : 0.f; s = wave_sum(s);
        const float rs = 1.0f / sqrtf(s * (1.0f / D) + 1e-6f);
        const v4u* xr = (const v4u*)(xb + (size_t)m * D); f32x4* orow = (f32x4*)(out + (size_t)m * D);
#pragma unroll
        for (int j = 0; j < 4; ++j) { const v4u w = xr[lane + 64 * j]; const f32x4 g0 = ((const f32x4*)g)[2 * (lane + 64 * j)], g1 = ((const f32x4*)g)[2 * (lane + 64 * j) + 1];
            orow[2 * (lane + 64 * j)] = (f32x4){bflo(w.x) * rs * g0[0], bfhi(w.x) * rs * g0[1], bflo(w.y) * rs * g0[2], bfhi(w.y) * rs * g0[3]};
            orow[2 * (lane + 64 * j) + 1] = (f32x4){bflo(w.z) * rs * g1[0], bfhi(w.z) * rs * g1[1], bflo(w.w) * rs * g1[2], bfhi(w.w) * rs * g1[3]}; } }
}
__device__ __forceinline__ void gating_simple(LAS unsigned char* lds, const bf16* z, const float* vst, const float* ln_g, const float* ln_b, const float* w_s, const float* b_s, bf16* gbuf, int tid) {
    LAS float* vln = (LAS float*)lds;
    LAS float* Wl = (LAS float*)(lds + 65536);
    LAS float* mu = (LAS float*)(lds + 65536 + 128 * 129 * 4);
    LAS float* rsd = mu + 128;
    for (int unit = blockIdx.x; unit < 1024; unit += gridDim.x) {
        const int h = unit & 15, tok0 = (unit >> 4) * 128;
        if (tid < 128) { const float* p = vst + (size_t)(tok0 + tid) * 64; float s1 = 0.f, s2 = 0.f;
#pragma unroll 8
            for (int i = 0; i < 32; ++i) { s1 += p[2 * i]; s2 += p[2 * i + 1]; }
            const float mean = s1 * (1.0f / 2048.0f), var = s2 * (1.0f / 2048.0f) - mean * mean; mu[tid] = mean; rsd[tid] = 1.0f / sqrtf(var + 1e-6f); }
        __syncthreads();
        { const int s = tid >> 2, db = (tid & 3) * 32; const float mean = mu[s], rs = rsd[s];
            const bf16* vp = z + (size_t)(tok0 + s) * 4096 + 2048 + h * 128 + db;
#pragma unroll
            for (int q = 0; q < 4; ++q) { const v4u w = *(const v4u*)(vp + 8 * q); const float* gp = ln_g + h * 128 + db + 8 * q; const float* bp = ln_b + h * 128 + db + 8 * q; LAS float* o = vln + s * 128 + db + 8 * q;
                o[0] = (bflo(w.x) - mean) * rs * gp[0] + bp[0]; o[1] = (bfhi(w.x) - mean) * rs * gp[1] + bp[1]; o[2] = (bflo(w.y) - mean) * rs * gp[2] + bp[2]; o[3] = (bfhi(w.y) - mean) * rs * gp[3] + bp[3];
                o[4] = (bflo(w.z) - mean) * rs * gp[4] + bp[4]; o[5] = (bfhi(w.z) - mean) * rs * gp[5] + bp[5]; o[6] = (bflo(w.w) - mean) * rs * gp[6] + bp[6]; o[7] = (bfhi(w.w) - mean) * rs * gp[7] + bp[7]; }
            const float* wp = w_s + ((size_t)h * 128 + s) * 128 + db;
#pragma unroll
            for (int q = 0; q < 8; ++q) { const f32x4 w4 = *(const f32x4*)(wp + 4 * q); LAS float* o = Wl + s * 129 + db + 4 * q; o[0] = w4[0]; o[1] = w4[1]; o[2] = w4[2]; o[3] = w4[3]; } }
        __syncthreads();
        { const int t = tid >> 2, d0 = (tid & 3) * 32, tmax = t | 15; float acc[32];
#pragma unroll
            for (int j = 0; j < 32; ++j) acc[j] = 0.f;
            for (int s = 0; s <= tmax; ++s) { const float w = (s <= t) ? Wl[t * 129 + s] : 0.f; const LAS f32x4* vr = (const LAS f32x4*)(vln + s * 128 + d0);
#pragma unroll
                for (int q = 0; q < 8; ++q) { const f32x4 vv = vr[q]; acc[4 * q] += w * vv[0]; acc[4 * q + 1] += w * vv[1]; acc[4 * q + 2] += w * vv[2]; acc[4 * q + 3] += w * vv[3]; } }
            const float bs = b_s[h * 128 + t];
            const bf16* up = z + (size_t)(tok0 + t) * 4096 + h * 128 + d0; bf16* op = gbuf + (size_t)(tok0 + t) * 2048 + h * 128 + d0;
#pragma unroll
            for (int q = 0; q < 4; ++q) { const v4u w = *(const v4u*)(up + 8 * q); v4u o;
                o.x = pk2(bflo(w.x) * (acc[8 * q] + bs), bfhi(w.x) * (acc[8 * q + 1] + bs)); o.y = pk2(bflo(w.y) * (acc[8 * q + 2] + bs), bfhi(w.y) * (acc[8 * q + 3] + bs));
                o.z = pk2(bflo(w.z) * (acc[8 * q + 4] + bs), bfhi(w.z) * (acc[8 * q + 5] + bs)); o.w = pk2(bflo(w.w) * (acc[8 * q + 6] + bs), bfhi(w.w) * (acc[8 * q + 7] + bs));
                *(v4u*)(op + 8 * q) = o; } }
        __syncthreads();
    }
}
__device__ __forceinline__ void gating_mfma(LAS unsigned char* lds, const bf16* z, const float* vst, const float* ln_g, const float* ln_b, const float* w_s, const float* b_s, bf16* gbuf, int wave, int lane) {
    LAS float* MU = (LAS float*)(lds + 69632);
    const int tid = wave * 64 + lane, fr = lane & 15, fq = lane >> 4;
    const int ss = tid >> 2, db = (tid & 3) * 32;
    for (int unit = blockIdx.x; unit < 256; unit += gridDim.x) {
        const int tok0 = (unit >> 2) * 128, hg = unit & 3;
        __syncthreads();
        if (tid < 128) { const float* sp = vst + (size_t)(tok0 + tid) * 64; float s1 = 0.f, s2 = 0.f;
#pragma unroll
            for (int i = 0; i < 16; ++i) { const f32x4 a = *(const f32x4*)(sp + 4 * i); s1 += a[0] + a[2]; s2 += a[1] + a[3]; }
            const float mean = s1 * (1.0f / 2048.0f), var = s2 * (1.0f / 2048.0f) - mean * mean; MU[tid] = mean; MU[128 + tid] = 1.0f / sqrtf(var + 1e-6f); }
        v4u raw[4];
        { const bf16* vp = z + (size_t)(tok0 + ss) * 4096 + 2048 + (hg * 4) * 128 + db;
#pragma unroll
            for (int q4 = 0; q4 < 4; ++q4) raw[q4] = *(const v4u*)(vp + 8 * q4); }
        __syncthreads();
        const float mean = MU[ss], rs = MU[128 + ss];
#pragma unroll 1
        for (int hh = 0; hh < 4; ++hh) { const int h = hg * 4 + hh; LAS unsigned char* VT = lds + (hh & 1) * 34816;
            { const float* gp = ln_g + h * 128 + db; const float* bp = ln_b + h * 128 + db; LAS unsigned char* wp = VT + db * 272 + ss * 2;
#pragma unroll
                for (int q4 = 0; q4 < 4; ++q4) { const f32x4 g0 = *(const f32x4*)(gp + 8 * q4), g1 = *(const f32x4*)(gp + 8 * q4 + 4), b0 = *(const f32x4*)(bp + 8 * q4), b1 = *(const f32x4*)(bp + 8 * q4 + 4); const v4u w = raw[q4];
                    const float v0 = (bflo(w.x) - mean) * rs * g0[0] + b0[0], v1 = (bfhi(w.x) - mean) * rs * g0[1] + b0[1], v2 = (bflo(w.y) - mean) * rs * g0[2] + b0[2], v3 = (bfhi(w.y) - mean) * rs * g0[3] + b0[3];
                    const float v4 = (bflo(w.z) - mean) * rs * g1[0] + b1[0], v5 = (bfhi(w.z) - mean) * rs * g1[1] + b1[1], v6 = (bflo(w.w) - mean) * rs * g1[2] + b1[2], v7 = (bfhi(w.w) - mean) * rs * g1[3] + b1[3];
                    LAS unsigned char* o = wp + (8 * q4) * 272;
                    *(LAS bf16*)(o + 0 * 272) = (bf16)f2bf(v0); *(LAS bf16*)(o + 1 * 272) = (bf16)f2bf(v1); *(LAS bf16*)(o + 2 * 272) = (bf16)f2bf(v2); *(LAS bf16*)(o + 3 * 272) = (bf16)f2bf(v3);
                    *(LAS bf16*)(o + 4 * 272) = (bf16)f2bf(v4); *(LAS bf16*)(o + 5 * 272) = (bf16)f2bf(v5); *(LAS bf16*)(o + 6 * 272) = (bf16)f2bf(v6); *(LAS bf16*)(o + 7 * 272) = (bf16)f2bf(v7); } }
            if (hh < 3) { const bf16* vp = z + (size_t)(tok0 + ss) * 4096 + 2048 + (h + 1) * 128 + db;
#pragma unroll
                for (int q4 = 0; q4 < 4; ++q4) raw[q4] = *(const v4u*)(vp + 8 * q4); }
            __syncthreads();
            const int t = 16 * wave + fr, nks = (wave >> 1) + 1;
            bf16x8 wf[4];
#pragma unroll
            for (int ks = 0; ks < 4; ++ks) { wf[ks] = (bf16x8){0, 0, 0, 0, 0, 0, 0, 0};
                if (ks < nks) { const float* wp = w_s + ((size_t)h * 128 + t) * 128 + 32 * ks + 8 * fq; const f32x4 a = *(const f32x4*)wp, c = *(const f32x4*)(wp + 4); const int s0 = 32 * ks + 8 * fq;
                    float v[8] = {a[0], a[1], a[2], a[3], c[0], c[1], c[2], c[3]};
#pragma unroll
                    for (int j = 0; j < 8; ++j) v[j] = (s0 + j <= t) ? v[j] : 0.f;
                    v4u w; w.x = pk2(v[0], v[1]); w.y = pk2(v[2], v[3]); w.z = pk2(v[4], v[5]); w.w = pk2(v[6], v[7]); wf[ks] = __builtin_bit_cast(bf16x8, w); } }
            const float bs = b_s[h * 128 + t];
            const bf16* up = z + (size_t)(tok0 + t) * 4096 + h * 128 + 4 * fq; bf16* op = gbuf + (size_t)(tok0 + t) * 2048 + h * 128 + 4 * fq;
            const LAS unsigned char* ab = VT + fr * 272 + fq * 16;
#pragma unroll
            for (int df = 0; df < 8; ++df) { f32x4 acc = (f32x4){0.f, 0.f, 0.f, 0.f};
#pragma unroll
                for (int ks = 0; ks < 4; ++ks) if (ks < nks) { const bf16x8 a = *(const LAS bf16x8*)(ab + df * 16 * 272 + ks * 64); acc = __builtin_amdgcn_mfma_f32_16x16x32_bf16(a, wf[ks], acc, 0, 0, 0); }
                const v2u uw = *(const v2u*)(up + 16 * df); v2u ow;
                ow.x = pg8::cvt_pk_bf16(bflo(uw.x) * (acc[0] + bs), bfhi(uw.x) * (acc[1] + bs)); ow.y = pg8::cvt_pk_bf16(bflo(uw.y) * (acc[2] + bs), bfhi(uw.y) * (acc[3] + bs));
                *(v2u*)(op + 16 * df) = ow; }
        }
    }
    __syncthreads();
}
__device__ __forceinline__ void attn_simple(LAS unsigned char* lds, const bf16* q, const bf16* Kb, const bf16* Vb, bf16* obuf, int wave, int lane) {
    LAS float* pl = (LAS float*)(lds + wave * 1024);
    const int gw = blockIdx.x * NWAVES + wave, NGW = gridDim.x * NWAVES;
    for (int task = gw; task < BATCH * 4 * SEQ; task += NGW) {
        const int bh = task >> 12, t = task & 4095, b = bh >> 2, h = bh & 3;
        float qf[8]; { const v4u w = *(const v4u*)(q + ((size_t)(b * SEQ + t)) * 2048 + h * 512 + 8 * lane);
            qf[0] = bflo(w.x); qf[1] = bfhi(w.x); qf[2] = bflo(w.y); qf[3] = bfhi(w.y); qf[4] = bflo(w.z); qf[5] = bfhi(w.z); qf[6] = bflo(w.w); qf[7] = bfhi(w.w); }
        const bf16* kp = Kb + (size_t)bh * 256 * 512 + 8 * lane;
        float sc[4];
#pragma unroll
        for (int kk = 0; kk < 4; ++kk) { float mine = 0.f;
            for (int l2 = 0; l2 < 64; ++l2) { const v4u w = *(const v4u*)(kp + (size_t)(kk * 64 + l2) * 512);
                float dsum = qf[0] * bflo(w.x) + qf[1] * bfhi(w.x) + qf[2] * bflo(w.y) + qf[3] * bfhi(w.y) + qf[4] * bflo(w.z) + qf[5] * bfhi(w.z) + qf[6] * bflo(w.w) + qf[7] * bfhi(w.w);
                dsum = wave_sum(dsum); if (lane == l2) mine = dsum; }
            sc[kk] = mine; }
        const float mx = wave_max(fmaxf(fmaxf(sc[0], sc[1]), fmaxf(sc[2], sc[3])));
        float p[4], ps = 0.f;
#pragma unroll
        for (int kk = 0; kk < 4; ++kk) { p[kk] = exp2f(sc[kk] - mx); ps += p[kk]; pl[kk * 64 + lane] = p[kk]; }
        const float inv = 1.0f / wave_sum(ps);
        LDS_WAIT();
        float o[8];
#pragma unroll
        for (int i = 0; i < 8; ++i) o[i] = 0.f;
        const bf16* vp = Vb + (size_t)bh * 256 * 512 + 8 * lane;
        for (int key = 0; key < 256; ++key) { const float pk = pl[key]; const v4u w = *(const v4u*)(vp + (size_t)key * 512);
            o[0] += pk * bflo(w.x); o[1] += pk * bfhi(w.x); o[2] += pk * bflo(w.y); o[3] += pk * bfhi(w.y); o[4] += pk * bflo(w.z); o[5] += pk * bfhi(w.z); o[6] += pk * bflo(w.w); o[7] += pk * bfhi(w.w); }
        v4u ow; ow.x = pk2(o[0] * inv, o[1] * inv); ow.y = pk2(o[2] * inv, o[3] * inv); ow.z = pk2(o[4] * inv, o[5] * inv); ow.w = pk2(o[6] * inv, o[7] * inv);
        *(v4u*)(obuf + ((size_t)(b * SEQ + t)) * 2048 + h * 512 + 8 * lane) = ow;
        LDS_WAIT();
    }
}
__device__ __forceinline__ void attn_mfma(LAS unsigned char* lds, const bf16* q, const bf16* Kb, const bf16* VTb, bf16* obuf, int wave, int lane) {
    const int tid = wave * 64 + lane, fr = lane & 15, fq = lane >> 4;
    unsigned voffK[2], voffV[2];
#pragma unroll
    for (int i = 0; i < 2; ++i) { int R, C; pg8::stage_rc(tid * 16 + i * 8192, R, C); voffK[i] = (unsigned)(R * 512 + C) * 2u; voffV[i] = (unsigned)(R * 256 + C) * 2u; }
    const unsigned ldsw = (unsigned)wave * 1024u;
    const int aoff0 = pg8::lds_byte(fr, fq * 8);
#define AT_STAGE_K(c, buf) do { _Pragma("unroll") for (int ht = 0; ht < 4; ++ht) { const char* src = Kg + ((size_t)(128 * (ht >> 1)) * 512 + 128 * (c) + 64 * (ht & 1)) * 2; \
        _Pragma("unroll") for (int i = 0; i < 2; ++i) __builtin_amdgcn_global_load_lds((const unsigned*)(src + voffK[i]), (LAS unsigned*)(lds + (buf) * 65536 + ht * 16384 + ldsw + i * 8192), 16, 0, 0); } } while (0)
#define AT_STAGE_V(cc, buf) do { _Pragma("unroll") for (int ht = 0; ht < 4; ++ht) { const char* src = Vg + ((size_t)(128 * ht) * 256 + 64 * (cc)) * 2; \
        _Pragma("unroll") for (int i = 0; i < 2; ++i) __builtin_amdgcn_global_load_lds((const unsigned*)(src + voffV[i]), (LAS unsigned*)(lds + (buf) * 65536 + ht * 16384 + ldsw + i * 8192), 16, 0, 0); } } while (0)
#define AT_WAIT() do { asm volatile("s_waitcnt vmcnt(0)" ::: "memory"); __syncthreads(); } while (0)
    for (int unit = blockIdx.x; unit < 256; unit += gridDim.x) {
        const int bh = unit >> 5, qb = unit & 31, b = bh >> 2, h = bh & 3;
        const char* Kg = (const char*)(Kb + (size_t)bh * 256 * 512);
        const char* Vg = (const char*)(VTb + (size_t)bh * 512 * 256);
        const size_t tok = (size_t)(b * SEQ + qb * 128 + 16 * wave + fr);
        bf16x8 qf[16];
        { const bf16* qp = q + tok * 2048 + h * 512 + 8 * fq;
#pragma unroll
            for (int s = 0; s < 16; ++s) qf[s] = *(const bf16x8*)(qp + 32 * s); }
        f32x4 acc[16];
#pragma unroll
        for (int n = 0; n < 16; ++n) acc[n] = (f32x4){0.f, 0.f, 0.f, 0.f};
        AT_STAGE_K(0, 0);
#pragma unroll
        for (int c = 0; c < 4; ++c) {
            AT_WAIT();
            if (c < 3) AT_STAGE_K(c + 1, (c + 1) & 1); else AT_STAGE_V(0, 0);
            const LAS unsigned char* bb = lds + (c & 1) * 65536 + aoff0; asm volatile("" : "+v"(bb));
#pragma unroll
            for (int kh = 0; kh < 2; ++kh)
#pragma unroll
                for (int k = 0; k < 2; ++k)
#pragma unroll
                    for (int ng = 0; ng < 2; ++ng) { bf16x8 a[8];
#pragma unroll
                        for (int n8 = 0; n8 < 8; ++n8) a[n8] = *(const LAS bf16x8*)(bb + (ng * 2 + kh) * 16384 + n8 * 2048 + k * 1024);
#pragma unroll
                        for (int n8 = 0; n8 < 8; ++n8) acc[ng * 8 + n8] = __builtin_amdgcn_mfma_f32_16x16x32_bf16(a[n8], qf[4 * c + 2 * kh + k], acc[ng * 8 + n8], 0, 0, 0);
                        __builtin_amdgcn_sched_barrier(0); }
        }
        float mx = acc[0][0];
#pragma unroll
        for (int n = 0; n < 16; ++n) mx = fmaxf(fmaxf(mx, fmaxf(acc[n][0], acc[n][1])), fmaxf(acc[n][2], acc[n][3]));
        mx = fmaxf(mx, __shfl_xor(mx, 16)); mx = fmaxf(mx, __shfl_xor(mx, 32));
        float l = 0.f;
#pragma unroll
        for (int n = 0; n < 16; ++n)
#pragma unroll
            for (int r = 0; r < 4; ++r) { const float pv = __builtin_amdgcn_exp2f(acc[n][r] - mx); acc[n][r] = pv; l += pv; }
        l += __shfl_xor(l, 16); l += __shfl_xor(l, 32);
        const float linv = 1.0f / l;
        bf16x8 pf[8];
#pragma unroll
        for (int s = 0; s < 8; ++s) { v4u w; w.x = pg8::cvt_pk_bf16(acc[2 * s][0], acc[2 * s][1]); w.y = pg8::cvt_pk_bf16(acc[2 * s][2], acc[2 * s][3]);
            w.z = pg8::cvt_pk_bf16(acc[2 * s + 1][0], acc[2 * s + 1][1]); w.w = pg8::cvt_pk_bf16(acc[2 * s + 1][2], acc[2 * s + 1][3]); pf[s] = __builtin_bit_cast(bf16x8, w); }
        __builtin_amdgcn_sched_barrier(0);
        f32x4 o[32];
#pragma unroll
        for (int mm = 0; mm < 32; ++mm) o[mm] = (f32x4){0.f, 0.f, 0.f, 0.f};
#pragma unroll
        for (int cc = 0; cc < 4; ++cc) {
            AT_WAIT();
            if (cc < 3) AT_STAGE_V(cc + 1, (cc + 1) & 1);
            const LAS unsigned char* bb = lds + (cc & 1) * 65536 + aoff0; asm volatile("" : "+v"(bb));
#pragma unroll
            for (int k = 0; k < 2; ++k)
#pragma unroll
                for (int mg = 0; mg < 4; ++mg) { bf16x8 a[8];
#pragma unroll
                    for (int m8 = 0; m8 < 8; ++m8) a[m8] = *(const LAS bf16x8*)(bb + mg * 16384 + m8 * 2048 + k * 1024);
#pragma unroll
                    for (int m8 = 0; m8 < 8; ++m8) o[mg * 8 + m8] = __builtin_amdgcn_mfma_f32_16x16x32_bf16(a[m8], pf[2 * cc + k], o[mg * 8 + m8], 0, 0, 0);
                    __builtin_amdgcn_sched_barrier(0); }
        }
        bf16* op = obuf + tok * 2048 + h * 512 + 4 * fq;
#pragma unroll
        for (int mm = 0; mm < 32; ++mm) { v2u w; w.x = pg8::cvt_pk_bf16(o[mm][0] * linv, o[mm][1] * linv); w.y = pg8::cvt_pk_bf16(o[mm][2] * linv, o[mm][3] * linv); *(v2u*)(op + 16 * mm) = w; }
    }
    asm volatile("s_waitcnt vmcnt(0)" ::: "memory"); __syncthreads();
#undef AT_STAGE_K
#undef AT_STAGE_V
#undef AT_WAIT
}
struct S5Lane { float lbr, lbi; float Br[16], Bi[16]; };
__device__ __forceinline__ void s5_lane_params(int g, int p, S5Lane& L) {
    const float lr = fminf(ka_in(15)[g * 64 + p], -1e-4f), li = ka_in(16)[g * 64 + p], dt = expf(ka_in(17)[g]);
    const float ar = lr * dt, th = li * dt; float sn, cs; sincosf(th, &sn, &cs); const float e = expf(ar), sh = sinf(0.5f * th);
    L.lbr = e * cs; L.lbi = e * sn;
    const float nr = expm1f(ar) * cs - 2.0f * sh * sh, ni = e * sn;
    const float den = 1.0f / (lr * lr + li * li), cr = (nr * lr + ni * li) * den, ci = (ni * lr - nr * li) * den;
#pragma unroll
    for (int c = 0; c < 16; ++c) { const float br = ka_in(18)[(size_t)(g * 64 + p) * 16 + c], bi = ka_in(19)[(size_t)(g * 64 + p) * 16 + c]; L.Br[c] = cr * br - ci * bi; L.Bi[c] = cr * bi + ci * br; }
}
__device__ __forceinline__ void s5_step(const S5Lane& L, const bf16* urow, float& xr, float& xi) {
    const v4u w0 = *(const v4u*)urow, w1 = *(const v4u*)(urow + 8);
    float u[16] = {bflo(w0.x), bfhi(w0.x), bflo(w0.y), bfhi(w0.y), bflo(w0.z), bfhi(w0.z), bflo(w0.w), bfhi(w0.w), bflo(w1.x), bfhi(w1.x), bflo(w1.y), bfhi(w1.y), bflo(w1.z), bfhi(w1.z), bflo(w1.w), bfhi(w1.w)};
    float br = 0.f, bi = 0.f;
#pragma unroll
    for (int c = 0; c < 16; ++c) { br += L.Br[c] * u[c]; bi += L.Bi[c] * u[c]; }
    const float nr = L.lbr * xr - L.lbi * xi + br, ni = L.lbr * xi + L.lbi * xr + bi; xr = nr; xi = ni;
}
__device__ __forceinline__ void s5_pass_a(const bf16* ub, f32x2* st, int wave, int lane) {
    const int gw = blockIdx.x * NWAVES + wave, NGW = gridDim.x * NWAVES;
    for (int task = gw; task < BATCH * 128 * 64; task += NGW) {
        const int seg = task & 63, g = (task >> 6) & 127, b = task >> 13;
        S5Lane L; s5_lane_params(g, lane, L);
        float xr = 0.f, xi = 0.f; const bf16* up = ub + (size_t)(b * SEQ + seg * 64) * 2048 + 16 * g;
#pragma unroll 2
        for (int s = 0; s < 64; ++s) s5_step(L, up + (size_t)s * 2048, xr, xi);
        st[(size_t)task * 64 + lane] = (f32x2){xr, xi};
    }
}
__device__ __forceinline__ void s5_pass_c(LAS unsigned char* lds, const bf16* ub, const f32x2* st, bf16* yb, int wave, int lane) {
    LAS f32x2* Cs = (LAS f32x2*)(lds + wave * 16640);
    LAS f32x2* xs = (LAS f32x2*)(lds + wave * 16640 + 8320);
    const int gw = blockIdx.x * NWAVES + wave, NGW = gridDim.x * NWAVES;
    for (int task = gw; task < BATCH * 128 * 64; task += NGW) {
        const int seg = task & 63, g = (task >> 6) & 127, b = task >> 13;
        S5Lane L; s5_lane_params(g, lane, L);
#pragma unroll
        for (int c = 0; c < 16; ++c) Cs[c * 65 + lane] = (f32x2){ka_in(20)[(size_t)(g * 16 + c) * 64 + lane], ka_in(21)[(size_t)(g * 16 + c) * 64 + lane]};
        float Ar = L.lbr, Ai = L.lbi;
#pragma unroll
        for (int i = 0; i < 6; ++i) { const float nr = Ar * Ar - Ai * Ai, ni = 2.0f * Ar * Ai; Ar = nr; Ai = ni; }
        float xr = 0.f, xi = 0.f; const f32x2* sp = st + (size_t)(task - seg) * 64 + lane;
#pragma unroll 2
        for (int n = 0; n < seg; ++n) { const f32x2 s = sp[(size_t)n * 64]; const float nr = Ar * xr - Ai * xi + s.x, ni = Ar * xi + Ai * xr + s.y; xr = nr; xi = ni; }
        const bf16* up = ub + (size_t)(b * SEQ + seg * 64) * 2048 + 16 * g; bf16* yp = yb + (size_t)(b * SEQ + seg * 64) * 2048 + 16 * g;
        const int t = lane & 15, cq = lane >> 4;
        f32x4 dsk = *(const f32x4*)(ka_in(22) + g * 16 + 4 * cq);
#pragma unroll 1
        for (int blk = 0; blk < 4; ++blk) {
#pragma unroll 2
            for (int s = 0; s < 16; ++s) { s5_step(L, up + (size_t)(blk * 16 + s) * 2048, xr, xi); xs[s * 65 + lane] = (f32x2){xr, xi}; }
            LDS_WAIT();
            float acc[4] = {0.f, 0.f, 0.f, 0.f};
#pragma unroll 4
            for (int p = 0; p < 64; ++p) { const f32x2 x = xs[t * 65 + p];
#pragma unroll
                for (int j = 0; j < 4; ++j) { const f32x2 c = Cs[(4 * cq + j) * 65 + p]; acc[j] += c.x * x.x - c.y * x.y; } }
            const v2u uw = *(const v2u*)(up + (size_t)(blk * 16 + t) * 2048 + 4 * cq);
            const float y0 = gelu_exact(acc[0] + dsk[0] * bflo(uw.x)), y1 = gelu_exact(acc[1] + dsk[1] * bfhi(uw.x)), y2 = gelu_exact(acc[2] + dsk[2] * bflo(uw.y)), y3 = gelu_exact(acc[3] + dsk[3] * bfhi(uw.y));
            v2u ow; ow.x = pk2(y0, y1); ow.y = pk2(y2, y3); *(v2u*)(yp + (size_t)(blk * 16 + t) * 2048 + 4 * cq) = ow;
            LDS_WAIT();
        }
    }
}
__device__ __forceinline__ void s5_mfma(LAS unsigned char* lds, const bf16* ub, bf16* yb, int wave, int lane) {
    LAS f32x2* PW = (LAS f32x2*)(lds);
    LAS f32x2* BB = (LAS f32x2*)(lds + 8704);
    LAS f32x2* CC = (LAS f32x2*)(lds + 16896);
    LAS bf16* KST = (LAS bf16*)(lds + 25088);
    LAS unsigned char* UI = lds + 33280;
    LAS float* SL = (LAS float*)(lds + 66048);
    LAS bf16* XP = (LAS bf16*)(lds + 99840);
    const int tid = wave * 64 + lane, fr = lane & 15, fq = lane >> 4;
    for (int unit = blockIdx.x; unit < 256; unit += gridDim.x) {
        const int b = unit >> 7, g = unit & 127;
        const float dt = expf(ka_in(17)[g]);
        __syncthreads();
        for (int idx = tid; idx < 17 * 64; idx += NTHREADS) { const int e = idx >> 6, p = idx & 63;
            const float lr = fminf(ka_in(15)[g * 64 + p], -1e-4f), li = ka_in(16)[g * 64 + p]; float sn, cs; sincosf(li * dt * (float)e, &sn, &cs); const float ex = expf(lr * dt * (float)e);
            PW[idx] = (f32x2){ex * cs, ex * sn}; }
        for (int idx = tid; idx < 1024; idx += NTHREADS) { const int p = idx >> 4, c = idx & 15;
            const float lr = fminf(ka_in(15)[g * 64 + p], -1e-4f), li = ka_in(16)[g * 64 + p]; const float ar = lr * dt, th = li * dt; float sn, cs; sincosf(th, &sn, &cs); const float e = expf(ar), sh = sinf(0.5f * th);
            const float nr = expm1f(ar) * cs - 2.0f * sh * sh, ni = e * sn, den = 1.0f / (lr * lr + li * li), cr = (nr * lr + ni * li) * den, ci = (ni * lr - nr * li) * den;
            const float br = ka_in(18)[(size_t)(g * 64 + p) * 16 + c], bi = ka_in(19)[(size_t)(g * 64 + p) * 16 + c];
            BB[idx] = (f32x2){cr * br - ci * bi, cr * bi + ci * br};
            CC[idx] = (f32x2){ka_in(20)[(size_t)g * 1024 + idx], ka_in(21)[(size_t)g * 1024 + idx]}; }
        __syncthreads();
        bf16x8 A1[8];
        { const int ri = wave >> 2, p = 16 * (wave & 3) + fr;
#pragma unroll
            for (int ks = 0; ks < 8; ++ks) { const int s = 2 * ks + (fq >> 1); const f32x2 pw = PW[(15 - s) * 64 + p]; float v[8];
#pragma unroll
                for (int j = 0; j < 8; ++j) { const f32x2 bb = BB[p * 16 + 8 * (fq & 1) + j]; v[j] = ri ? (pw.x * bb.y + pw.y * bb.x) : (pw.x * bb.x - pw.y * bb.y); }
                v4u w; w.x = pk2(v[0], v[1]); w.y = pk2(v[2], v[3]); w.z = pk2(v[4], v[5]); w.w = pk2(v[6], v[7]); A1[ks] = __builtin_bit_cast(bf16x8, w); } }
        const int t0 = wave, t1 = 15 - wave;
        bf16x8 CM[2][4];
#pragma unroll
        for (int ti = 0; ti < 2; ++ti) { const int t = ti ? t1 : t0;
#pragma unroll
            for (int ks = 0; ks < 4; ++ks) { float v[8];
#pragma unroll
                for (int j = 0; j < 8; ++j) { const int p = 32 * (ks & 1) + 8 * fq + j; const f32x2 c = CC[fr * 64 + p], pw = PW[(t + 1) * 64 + p];
                    v[j] = (ks >> 1) ? -(c.x * pw.y + c.y * pw.x) : (c.x * pw.x - c.y * pw.y); }
                v4u w; w.x = pk2(v[0], v[1]); w.y = pk2(v[2], v[3]); w.z = pk2(v[4], v[5]); w.w = pk2(v[6], v[7]); CM[ti][ks] = __builtin_bit_cast(bf16x8, w); } }
        { bf16x8 ct[4];
#pragma unroll
            for (int ks = 0; ks < 4; ++ks) { float v[8];
#pragma unroll
                for (int j = 0; j < 8; ++j) { const f32x2 c = CC[fr * 64 + 32 * (ks & 1) + 8 * fq + j]; v[j] = (ks >> 1) ? -c.y : c.x; }
                v4u w; w.x = pk2(v[0], v[1]); w.y = pk2(v[2], v[3]); w.z = pk2(v[4], v[5]); w.w = pk2(v[6], v[7]); ct[ks] = __builtin_bit_cast(bf16x8, w); }
#pragma unroll
            for (int si = 0; si < 2; ++si) { const int s = 2 * wave + si; f32x4 kacc = (f32x4){0.f, 0.f, 0.f, 0.f};
#pragma unroll
                for (int ks = 0; ks < 4; ++ks) { float v[8];
#pragma unroll
                    for (int j = 0; j < 8; ++j) { const int p = 32 * (ks & 1) + 8 * fq + j; const f32x2 pw = PW[(15 - s) * 64 + p], bb = BB[p * 16 + fr];
                        v[j] = (ks >> 1) ? (pw.x * bb.y + pw.y * bb.x) : (pw.x * bb.x - pw.y * bb.y); }
                    v4u w; w.x = pk2(v[0], v[1]); w.y = pk2(v[2], v[3]); w.z = pk2(v[4], v[5]); w.w = pk2(v[6], v[7]);
                    kacc = __builtin_amdgcn_mfma_f32_16x16x32_bf16(__builtin_bit_cast(bf16x8, w), ct[ks], kacc, 0, 0, 0); }
                v2u kw; kw.x = pk2(kacc[0], kacc[1]); kw.y = pk2(kacc[2], kacc[3]);
                *(LAS v2u*)(KST + ((15 - s) * 16 + fr) * 16 + 4 * fq) = kw; } }
        const f32x4 dsk = *(const f32x4*)(ka_in(22) + g * 16 + 4 * fq);
        float Xr = 0.f, Xi = 0.f;
#pragma unroll 1
        for (int q = 0; q < 4; ++q) {
            __syncthreads();
            { const bf16* src0 = ub + (size_t)(b * SEQ + q * 1024) * 2048 + 16 * g;
#pragma unroll
                for (int i = 0; i < 4; ++i) { const int piece = tid + NTHREADS * i, tok = piece >> 1, half = piece & 1;
                    const v4u w = *(const v4u*)(src0 + (size_t)tok * 2048 + 8 * half);
                    *(LAS v4u*)(UI + ((((tok & 15) * 64 + (tok >> 4)) * 2 + half) * 16)) = w; } }
            __syncthreads();
#pragma unroll 1
            for (int nf = 0; nf < 4; ++nf) { f32x4 acc = (f32x4){0.f, 0.f, 0.f, 0.f};
#pragma unroll
                for (int ks = 0; ks < 8; ++ks) { const bf16x8 bfr = *(const LAS bf16x8*)(UI + ((((2 * ks + (fq >> 1)) * 64 + 16 * nf + fr) * 2 + (fq & 1)) * 16));
                    acc = __builtin_amdgcn_mfma_f32_16x16x32_bf16(A1[ks], bfr, acc, 0, 0, 0); }
                *(LAS f32x4*)(SL + (16 * nf + fr) * 132 + 16 * wave + 4 * fq) = acc; }
            __syncthreads();
            if (wave == 0) { const f32x2 a16 = PW[16 * 64 + lane];
#pragma unroll 4
                for (int n = 0; n < 64; ++n) { XP[n * 136 + lane] = (bf16)f2bf(Xr); XP[n * 136 + 64 + lane] = (bf16)f2bf(Xi);
                    const float sr = SL[n * 132 + lane], si = SL[n * 132 + 64 + lane];
                    const float nr = a16.x * Xr - a16.y * Xi + sr, ni = a16.x * Xi + a16.y * Xr + si; Xr = nr; Xi = ni; } }
            __syncthreads();
#pragma unroll 1
            for (int nf = 0; nf < 4; ++nf) { f32x4 acc0 = (f32x4){0.f, 0.f, 0.f, 0.f}, acc1 = acc0;
#pragma unroll
                for (int ks = 0; ks < 8; ++ks) { if (2 * ks <= t1 || 2 * ks <= t0) {
                    const int s = 2 * ks + (fq >> 1);
                    const bf16x8 bfr = *(const LAS bf16x8*)(UI + (((s * 64 + 16 * nf + fr) * 2 + (fq & 1)) * 16));
                    if (2 * ks <= t0) { bf16x8 tf = (bf16x8){0, 0, 0, 0, 0, 0, 0, 0}; if (s <= t0) tf = *(const LAS bf16x8*)(KST + ((t0 - s) * 16 + fr) * 16 + 8 * (fq & 1)); acc0 = __builtin_amdgcn_mfma_f32_16x16x32_bf16(tf, bfr, acc0, 0, 0, 0); }
                    if (2 * ks <= t1) { bf16x8 tf = (bf16x8){0, 0, 0, 0, 0, 0, 0, 0}; if (s <= t1) tf = *(const LAS bf16x8*)(KST + ((t1 - s) * 16 + fr) * 16 + 8 * (fq & 1)); acc1 = __builtin_amdgcn_mfma_f32_16x16x32_bf16(tf, bfr, acc1, 0, 0, 0); } } }
#pragma unroll
                for (int ks = 0; ks < 4; ++ks) { const bf16x8 xf = *(const LAS bf16x8*)(XP + (16 * nf + fr) * 136 + 32 * ks + 8 * fq);
                    acc0 = __builtin_amdgcn_mfma_f32_16x16x32_bf16(CM[0][ks], xf, acc0, 0, 0, 0); acc1 = __builtin_amdgcn_mfma_f32_16x16x32_bf16(CM[1][ks], xf, acc1, 0, 0, 0); }
#pragma unroll
                for (int ti = 0; ti < 2; ++ti) { const int t = ti ? t1 : t0; const f32x4 a = ti ? acc1 : acc0; const int n = 16 * nf + fr;
                    const v2u uw = *(const LAS v2u*)(UI + (((t * 64 + n) * 2 + (fq >> 1)) * 16) + 8 * (fq & 1));
                    const pg8::f32x2 g0 = pg8::gelu_pk((pg8::f32x2){a[0] + dsk[0] * bflo(uw.x), a[1] + dsk[1] * bfhi(uw.x)}), g1 = pg8::gelu_pk((pg8::f32x2){a[2] + dsk[2] * bflo(uw.y), a[3] + dsk[3] * bfhi(uw.y)});
                    v2u ow; ow.x = pg8::cvt_pk_bf16(g0.x, g0.y); ow.y = pg8::cvt_pk_bf16(g1.x, g1.y);
                    *(v2u*)(yb + (size_t)(b * SEQ + q * 1024 + 16 * n + t) * 2048 + 16 * g + 4 * fq) = ow; } }
        }
    }
    __syncthreads();
}
#ifndef EN
#define EN(k) 1
#endif
template <int PH> __device__ __forceinline__ void run_phase(unsigned char* ws, float* X, LAS unsigned char* lds, int wave, int lane) {
    const int G = gridDim.x, bx = blockIdx.x;
    bf16* XB = (bf16*)(ws + WS_XB); float* SSQ = (float*)(ws + WS_SSQ);
    bf16* R0 = (bf16*)(ws + WS_R);
    constexpr int layer = (PH >= 10) ? 1 : 0;
    if constexpr (!EN(PH)) { return; }
    else if constexpr (PH == 0) p0_prologue(ws, lds, wave, lane);
    else if constexpr (PH == 1) {
        if (bx < 64) { const int i = bx >> 5;
            pg8::Gemm g{(const pg8::bf16_t*)(ws + WS_MEMB), (const pg8::bf16_t*)(ws + WS_W_KV + (size_t)i * 16 * MiB), MROWS, 4096, 2048}; pg8::StaticOrder S; S.init(MROWS, 4096, 32, bx & 31);
            pg8::EpiKV E{(pg8::bf16_t*)(ws + WS_KB + (size_t)i * 2 * MiB), (pg8::bf16_t*)(ws + WS_VB + (size_t)i * 2 * MiB), (pg8::bf16_t*)(ws + WS_VTB + (size_t)i * 2 * MiB), (const float*)(ws + WS_SSQM)};
            pg8::gemm_phase<pg8::EpiKV, pg8::StaticOrder, true, PG8_SP2V>(lds, g, S, E, wave, lane); }
        p1_convert(ws, lds, wave, lane);
    } else if constexpr (PH == 2) {
        pg8::Gemm g{XB, (const pg8::bf16_t*)(ws + WS_W_AIN), M, 4096, 2048}; pg8::StaticOrder S; S.init(M, 4096, G, bx);
        pg8::EpiAct<1, true> E{R0, 4096, ka_in(8), SSQ, 32, 1.0f, (float*)(ws + WS_VST), 8};
        pg8::gemm_phase<pg8::EpiAct<1, true>, pg8::StaticOrder, true, PG8_SP2V>(lds, g, S, E, wave, lane);
    } else if constexpr (PH == 3) {
#if defined(GATING_SIMPLE)
        gating_simple(lds, R0, (const float*)(ws + WS_VST), ka_in(9), ka_in(10), ka_in(11), ka_in(12), R0 + (size_t)M * 4096, wave * 64 + lane);
#else
        gating_mfma(lds, R0, (const float*)(ws + WS_VST), ka_in(9), ka_in(10), ka_in(11), ka_in(12), R0 + (size_t)M * 4096, wave, lane);
#endif
    }
    else if constexpr (PH == 4 || PH == 7 || PH == 9 || PH == 16 || PH == 18) {
        const pg8::bf16_t* A; const pg8::bf16_t* W; int K = 2048;
        if constexpr (PH == 4) { A = R0 + (size_t)M * 4096; W = (const pg8::bf16_t*)(ws + WS_W_AOUT); }
        else if constexpr (PH == 7 || PH == 16) { A = R0 + (size_t)M * 2048; W = (const pg8::bf16_t*)(ws + WS_W_O + (size_t)layer * 8 * MiB); }
        else { A = R0; W = (const pg8::bf16_t*)(ws + WS_W_DN + (size_t)layer * 32 * MiB); K = 8192; }
        pg8::Gemm g{A, W, M, 2048, K}; pg8::StaticOrder S; S.init(M, 2048, G, bx);
        pg8::EpiRes E{XB, SSQ};
        pg8::gemm_phase<pg8::EpiRes, pg8::StaticOrder, true, PG8_SP2V>(lds, g, S, E, wave, lane);
    } else if constexpr (PH == 5 || PH == 14 || PH == 10) {
        const pg8::bf16_t* W = (PH == 10) ? (const pg8::bf16_t*)(ws + WS_W_BIN) : (const pg8::bf16_t*)(ws + WS_W_Q + (size_t)layer * 8 * MiB);
        pg8::Gemm g{XB, W, M, 2048, 2048}; pg8::StaticOrder S; S.init(M, 2048, G, bx);
        pg8::EpiAct<0, false> E{R0, 2048, nullptr, SSQ, (PH == 14) ? 64 : 32, (PH == 10) ? 1.0f : 0.044194173824159216f * 1.4426950408889634f, nullptr, 0};
        pg8::gemm_phase<pg8::EpiAct<0, false>, pg8::StaticOrder, true, PG8_SP2V>(lds, g, S, E, wave, lane);
    } else if constexpr (PH == 6 || PH == 15) {
#if defined(ATTN_SIMPLE)
        attn_simple(lds, R0, (const bf16*)(ws + WS_KB + (size_t)layer * 2 * MiB), (const bf16*)(ws + WS_VB + (size_t)layer * 2 * MiB), R0 + (size_t)M * 2048, wave, lane);
#else
        attn_mfma(lds, R0, (const bf16*)(ws + WS_KB + (size_t)layer * 2 * MiB), (const bf16*)(ws + WS_VTB + (size_t)layer * 2 * MiB), R0 + (size_t)M * 2048, wave, lane);
#endif
    }
    else if constexpr (PH == 8 || PH == 17) {
        pg8::Gemm g{XB, (const pg8::bf16_t*)(ws + WS_W_UP + (size_t)layer * 32 * MiB), M, FF, 2048}; pg8::StaticOrder S; S.init(M, FF, G, bx);
        pg8::EpiAct<2, false> E{R0, FF, nullptr, SSQ, 32, 1.0f, nullptr, 0};
        pg8::gemm_phase<pg8::EpiAct<2, false>, pg8::StaticOrder, true, PG8_SP2V>(lds, g, S, E, wave, lane);
    } else if constexpr (PH == 11) {
#if defined(S5_SIMPLE)
        s5_pass_a(R0, (f32x2*)(ws + WS_S5ST), wave, lane);
#endif
    } else if constexpr (PH == 12) {
#if defined(S5_SIMPLE)
        s5_pass_c(lds, R0, (const f32x2*)(ws + WS_S5ST), R0 + (size_t)M * 2048, wave, lane);
#else
        s5_mfma(lds, R0, R0 + (size_t)M * 2048, wave, lane);
#endif
    }
    else if constexpr (PH == 13) {
        pg8::Gemm g{R0 + (size_t)M * 2048, (const pg8::bf16_t*)(ws + WS_W_BOUT), M, 4096, 2048}; pg8::StaticOrder S; S.init(M, 4096, G, bx);
        pg8::EpiGlu E{XB, SSQ, ka_in(24)};
        pg8::gemm_phase<pg8::EpiGlu, pg8::StaticOrder, true, PG8_SP2V>(lds, g, S, E, wave, lane);
    } else if constexpr (PH == 19) final_norm(XB, SSQ, ka_in(6), X, wave, lane);
}
__device__ __forceinline__ int lane_id() { int l; asm volatile("v_mbcnt_lo_u32_b32 %0, -1, 0\n\tv_mbcnt_hi_u32_b32 %0, -1, %0" : "=v"(l)); return l; }

#define XB_TMO      128
#define XB_XCNT(j)  (256  + 64 * (j))
#define XB_XSUB(j)  (1280 + 64 * (j))
#define XB_XGEN(j)  (2304 + 64 * (j))
#define XB_TOP      3328
#define XB_TOPGEN   3392
#define XCD_BAR_WORDS 3456
#define XB_SPIN_CAP (1u << 22)
__device__ __forceinline__ unsigned xb_ld(unsigned* p)              { return __hip_atomic_load(p, __ATOMIC_RELAXED, __HIP_MEMORY_SCOPE_AGENT); }
__device__ __forceinline__ unsigned xb_add(unsigned* p, unsigned v) { return __hip_atomic_fetch_add(p, v, __ATOMIC_RELAXED, __HIP_MEMORY_SCOPE_AGENT); }
__device__ __forceinline__ unsigned xb_xcc_id() { return (unsigned)__builtin_amdgcn_s_getreg((3 << 11) | 20) & 0xFu; }
#define XB_SPIN(cond, bar) do { unsigned _sp = 0; while (cond) { __builtin_amdgcn_s_sleep(1); \
    if ((++_sp & 255u) == 0u) { if (xb_ld(&(bar)[XB_TMO])) break; if (_sp > XB_SPIN_CAP) { atomicAdd(&(bar)[XB_TMO], 1u); break; } } } } while (0)
__device__ __forceinline__ void xcd_barrier_complete(unsigned* bar, unsigned x, unsigned& nloc, unsigned& nx) {
    const unsigned G = gridDim.x * gridDim.y * gridDim.z;
    unsigned sum, cnt, mine, sp = 0u;
    for (;;) {
        sum = 0u; cnt = 0u; mine = 0u;
#pragma unroll
        for (unsigned j = 0; j < 16; ++j) { const unsigned c = xb_ld(&bar[XB_XCNT(j)]); sum += c; cnt += (c > 0u) ? 1u : 0u; mine = (j == x) ? c : mine; }
        if (sum == G) break;
        __builtin_amdgcn_s_sleep(1);
        if ((++sp & 255u) == 0u) { if (xb_ld(&bar[XB_TMO])) break; if (sp > XB_SPIN_CAP) { atomicAdd(&bar[XB_TMO], 1u); break; } }
    }
    nloc = mine > 0u ? mine : 1u; nx = cnt > 0u ? cnt : 1u;
}
__device__ __forceinline__ void xcd_barrier(unsigned* bar, volatile LAS unsigned* st, bool is_t0) {
    asm volatile("s_waitcnt vmcnt(0)" ::: "memory");
    __syncthreads();
    if (is_t0) {
        __builtin_amdgcn_s_waitcnt(0);
        const unsigned x = xb_xcc_id();
        unsigned nloc = st[0], nx = st[1];
        if (nloc == 0u) { xcd_barrier_complete(bar, x, nloc, nx); st[0] = nloc; st[1] = nx; }
        const unsigned old = xb_add(&bar[XB_XSUB(x)], 1u);
        const unsigned gen = old / nloc;
        if (old + 1u == (gen + 1u) * nloc) {
            __builtin_amdgcn_fence(__ATOMIC_RELEASE, "agent");
            asm volatile("s_waitcnt vmcnt(0)" ::: "memory");
            const unsigned og = xb_add(&bar[XB_TOP], 1u);
            const unsigned tg = og / nx;
            if (og + 1u == (tg + 1u) * nx) xb_add(&bar[XB_TOPGEN], 1u);
            else XB_SPIN(xb_ld(&bar[XB_TOPGEN]) == tg, bar);
            __builtin_amdgcn_fence(__ATOMIC_ACQUIRE, "agent");
            xb_add(&bar[XB_XGEN(x)], 1u);
            asm volatile("s_waitcnt vmcnt(0)" ::: "memory");
        } else {
            XB_SPIN(xb_ld(&bar[XB_XGEN(x)]) == gen, bar);
            __builtin_amdgcn_fence(__ATOMIC_ACQUIRE, "agent");
            asm volatile("s_waitcnt vmcnt(0)" ::: "memory");
        }
    }
    __syncthreads();
}

__global__ void __launch_bounds__(NTHREADS, 2) trunk_fwd(Args args) {
    extern __shared__ __attribute__((aligned(16))) unsigned char lds_raw[];
    LAS unsigned char* lds = (LAS unsigned char*)lds_raw;
    const int wave = __builtin_amdgcn_readfirstlane((int)threadIdx.x >> 6);
    const int lo = args.ph_lo, hi = args.ph_hi;
    unsigned* bar = (unsigned*)args.ws + 4096;
    volatile LAS unsigned* st = (volatile LAS unsigned*)(lds + LDS_BYTES - 64);
#if MK_N_LAUNCHES == 1
    { const int l0 = lane_id(); if (wave == 0 && l0 < 2) st[l0] = 0u; __syncthreads(); if (wave == 0 && l0 == 0) (void)xb_add(&bar[XB_XCNT(xb_xcc_id())], 1u); }
#define GRID_BAR(k) do { if ((k) == 1) cg::this_grid().sync(); else xcd_barrier(bar, st, wave == 0 && lane_id() == 0); } while (0)
#else
#define GRID_BAR(k) do { } while (0)
#endif
#ifndef DUP_PH
#define DUP_PH -1
#endif
#if defined(PROBE_GEMM)
#if PROBE_GEMM == 3
typedef pg8::StaticOrder ProbeOrder;
#else
struct ProbeOrder { int c;
    __device__ __forceinline__ void init(int, int, int, int c_) { c = c_; }
    __device__ __forceinline__ bool next(int i, pg8::Unit& u) const { if (i >= 4) return false;
#if PROBE_GEMM == 1
        u.pm = 0; u.pn = 0;
#else
        u.pm = c >> 3; u.pn = c & 7;
#endif
        return true; }
    __device__ __forceinline__ void a_ready(const pg8::Unit&) const {}
    __device__ __forceinline__ void done(const pg8::Unit&) const {} };
#endif
#endif
#if defined(STAMP_SEL)
#define STAMP(k) do { if (blockIdx.x == 0 && wave == 0 && lane_id() == 0) st[4 + (k)] = (unsigned)__builtin_amdgcn_s_memrealtime(); } while (0)
#else
#define STAMP(k) do { } while (0)
#endif
#define PHASE(k) if (lo <= (k) && (k) < hi) { if ((k) > lo) GRID_BAR(k); STAMP(k); run_phase<k>(args.ws, args.out, lds, wave, lane_id()); if ((k) == DUP_PH) { GRID_BAR(2); run_phase<k>(args.ws, args.out, lds, wave, lane_id()); } }
    PHASE(0) PHASE(1) PHASE(2) PHASE(3) PHASE(4) PHASE(5) PHASE(6) PHASE(7) PHASE(8) PHASE(9)
#if defined(PROBE_GEMM)
    { GRID_BAR(2); const int lane = lane_id(); unsigned char* ws = args.ws; bf16* R0 = (bf16*)(ws + WS_R);
      pg8::Gemm g{(bf16*)(ws + WS_XB), (const pg8::bf16_t*)(ws + WS_W_UP), M, FF, 2048}; ProbeOrder S; S.init(M, FF, gridDim.x, blockIdx.x);
      pg8::EpiAct<2, false> E{R0, FF, nullptr, (float*)(ws + WS_SSQ), 32, 1.0f, nullptr, 0};
      pg8::gemm_phase<pg8::EpiAct<2, false>, ProbeOrder, true, true>(lds, g, S, E, wave, lane); }
#endif
    PHASE(10)
#if defined(S5_SIMPLE)
    PHASE(11)
#endif
    PHASE(12) PHASE(13) PHASE(14) PHASE(15) PHASE(16) PHASE(17) PHASE(18) PHASE(19)
#undef PHASE
#if defined(STAMP_SEL)
    asm volatile("s_waitcnt vmcnt(0)" ::: "memory"); __syncthreads(); STAMP(20);
    if (blockIdx.x == 0 && wave == 0 && lane_id() == 0) { const unsigned d = (st[4 + STAMP_SEL_END] - st[4 + STAMP_SEL]) * STAMP_MUL; const unsigned t0 = (unsigned)__builtin_amdgcn_s_memrealtime();
        while ((unsigned)__builtin_amdgcn_s_memrealtime() - t0 < d) __builtin_amdgcn_s_sleep(8); }
#endif
}

extern "C" void kernel_launch(void* const* d_in, const int* in_sizes, int n_in, void* d_out, int out_size, void* d_ws, size_t ws_size, hipStream_t stream) {
    static int grid = 0;
    if (grid == 0) {
        if (n_in != 30 || out_size != M * D || ws_size < WS_END) { fprintf(stderr, "kernel_launch: unexpected shapes (n_in %d out %d ws %zu)\n", n_in, out_size, ws_size); grid = -1; return; }
        int dev = 0, cus = 0, per_cu = 0;
        if (hipGetDevice(&dev) != hipSuccess || hipDeviceGetAttribute(&cus, hipDeviceAttributeMultiprocessorCount, dev) != hipSuccess) { grid = -1; return; }
        if (hipFuncSetAttribute((const void*)trunk_fwd, hipFuncAttributeMaxDynamicSharedMemorySize, LDS_BYTES) != hipSuccess) { fprintf(stderr, "kernel_launch: hipFuncSetAttribute failed\n"); grid = -1; return; }
        if (hipOccupancyMaxActiveBlocksPerMultiprocessor(&per_cu, (const void*)trunk_fwd, NTHREADS, LDS_BYTES) != hipSuccess || per_cu < 1) { fprintf(stderr, "kernel_launch: occupancy query says %d\n", per_cu); grid = -1; return; }
        grid = cus;
    }
    if (grid < 0) return;
    if (hipMemsetAsync(d_ws, 0, 65536, stream) != hipSuccess) { fprintf(stderr, "kernel_launch: memset failed\n"); return; }
    Args a{};
    for (int i = 0; i < 30; ++i) a.in[i] = (const float*)d_in[i];
    a.out = (float*)d_out; a.ws = (unsigned char*)d_ws;
#if MK_N_LAUNCHES == 1
    a.ph_lo = 0; a.ph_hi = NPH;
    void* kargs[] = {&a};
    hipError_t e = hipLaunchCooperativeKernel((const void*)trunk_fwd, dim3(grid), dim3(NTHREADS), kargs, LDS_BYTES, stream);
    if (e != hipSuccess) fprintf(stderr, "kernel_launch: cooperative launch failed: %s\n", hipGetErrorString(e));
#else
    for (int ph = 0; ph < NPH; ++ph) { a.ph_lo = ph; a.ph_hi = ph + 1; hipLaunchKernelGGL(trunk_fwd, dim3(grid), dim3(NTHREADS), LDS_BYTES, stream, a); }
#endif
}
```

```cpp
#include <hip/hip_runtime.h>
#include <hip/hip_cooperative_groups.h>
#include <cstdio>
#include <cstdint>
namespace cg = cooperative_groups;
#define MK_N_LAUNCHES 1
#define PG8_SP2V true
namespace pg8 {
#define PG8_LAS __attribute__((address_space(3)))
typedef unsigned short bf16_t;
typedef short bf16x8 __attribute__((ext_vector_type(8)));
typedef float f32x4 __attribute__((ext_vector_type(4)));
typedef unsigned u32x4 __attribute__((ext_vector_type(4)));
constexpr int BM = 256, BK = 64, HALF = 128, HTB = HALF * BK * 2  , STAGE_BYTES = 8 * HTB, NXCD = 8, WGM = 8;

__host__ __device__ __forceinline__ int lds_byte(int r, int c) { const int st = (r >> 4) * 2 + (c >> 5), rr = r & 15, cc = c & 31, ob = rr * 64 + cc * 2; return st * 1024 + (ob ^ (((ob >> 9) & 1) << 5)); }
__host__ __device__ __forceinline__ void stage_rc(int b, int& R, int& C) { const int st = b / 1024, sb = b % 1024, swz = sb ^ (((sb >> 9) & 1) << 5); R = (st >> 1) * 16 + swz / 64; C = (st & 1) * 32 + (swz % 64) / 2; }
__host__ __device__ __forceinline__ int perm32(int rho) { const int n = rho >> 4, i = rho & 15; return 8 * (i >> 2) + 4 * n + (i & 3); }

struct Unit { int pm, pn; };
struct Gemm { const bf16_t* A; const bf16_t* Bt; int M, N, K; };

struct StaticOrder {
    int nM, nN, nwg, G, c;
    __host__ __device__ void init(int M, int N, int G_, int c_) { nM = M / BM; nN = N / BM; nwg = nM * nN; G = G_; c = c_; }
    __host__ __device__ bool next(int i, Unit& u) const {
        const long L = (long)i * G + c; if (L >= nwg) return false;
        int wgid = (int)L; { const int q = nwg / NXCD, r = nwg % NXCD, xcd = wgid % NXCD, off = wgid / NXCD; wgid = (xcd < r ? xcd * (q + 1) : r * (q + 1) + (xcd - r) * q) + off; }
        const int nig = WGM * nN, gid = wgid / nig, fm = gid * WGM, gsz = (nM - fm) < WGM ? (nM - fm) : WGM;
        u.pm = fm + ((wgid % nig) % gsz); u.pn = (wgid % nig) / gsz; return true;
    }
    __device__ __forceinline__ void a_ready(const Unit&) const {}
    __device__ __forceinline__ void done(const Unit&) const {}
};

__device__ __forceinline__ unsigned cvt_pk_bf16(float lo, float hi) { unsigned r; asm volatile("v_cvt_pk_bf16_f32 %0, %1, %2" : "=v"(r) : "v"(lo), "v"(hi)); return r; }
typedef float f32x2 __attribute__((ext_vector_type(2)));
__device__ __forceinline__ f32x2 gelu_pk(f32x2 v) {
    const f32x2 av = __builtin_elementwise_abs(v), d = av * 0.2316418882f + 1.0f;
    f32x2 t; t.x = __builtin_amdgcn_rcpf(d.x); t.y = __builtin_amdgcn_rcpf(d.y);
    f32x2 q = t * 0.5307027145f + (-0.7265760135f); q = q * t + 0.7107068705f; q = q * t + (-0.142248368f); q = q * t + 0.127414796f; q = q * t;
    const f32x2 s = (v * v) * (-0.72134752044f);
    f32x2 e; e.x = __builtin_amdgcn_exp2f(s.x); e.y = __builtin_amdgcn_exp2f(s.y);
    const f32x2 m = v * (q * e), r = v - m;
    f32x2 o; o.x = v.x < 0.f ? m.x : r.x; o.y = v.y < 0.f ? m.y : r.y; return o;
}
typedef unsigned u32x2 __attribute__((ext_vector_type(2)));
constexpr int SSQ_STRIDE = 64;
__device__ __forceinline__ float row_rstd(const float* ssq, int np, int row, int fq) {
    const float* p = ssq + (size_t)row * SSQ_STRIDE + fq * (np >> 2);
    f32x4 a = *(const f32x4*)p, b = *(const f32x4*)(p + 4);
    float s = (a[0] + a[1]) + (a[2] + a[3]) + (b[0] + b[1]) + (b[2] + b[3]);
    if (np == 64) { f32x4 c = *(const f32x4*)(p + 8), d = *(const f32x4*)(p + 12); s += (c[0] + c[1]) + (c[2] + c[3]) + (d[0] + d[1]) + (d[2] + d[3]); }
    s += __shfl_xor(s, 16); s += __shfl_xor(s, 32);
    return __builtin_amdgcn_rsqf(s * (1.0f / 2048.0f) + 1e-6f);
}
template <int ACT, bool STATS> struct EpiAct {
    static constexpr bool PERM = true, AFTER_DRAIN = false;
    bf16_t* O; int ldc; const float* bias; const float* ssq; int np; float oscale; float* vst; int stat_pn0;
    __device__ __forceinline__ void operator()(const f32x4 (&acc)[2][2][4][2], const Unit& u, int wr, int wc, int fr, int fq) const {
        const int row0 = u.pm * BM + wr * 64 + fr, col0 = u.pn * BM + wc * 32 + 8 * fq;
        f32x4 bv[2][2];
#pragma unroll
        for (int bj = 0; bj < 2; ++bj)
#pragma unroll
            for (int n = 0; n < 2; ++n) bv[bj][n] = bias ? *(const f32x4*)(bias + col0 + bj * HALF + 4 * n) : (f32x4){0.f, 0.f, 0.f, 0.f};
        float rsv[2][4];
#pragma unroll
        for (int ai = 0; ai < 2; ++ai) {
#pragma unroll
            for (int m = 0; m < 4; ++m) rsv[ai][m] = row_rstd(ssq, np, row0 + ai * HALF + m * 16, fq); }
#pragma unroll
        for (int ai = 0; ai < 2; ++ai)
#pragma unroll
            for (int m = 0; m < 4; ++m) { const int row = row0 + ai * HALF + m * 16; const float rs = rsv[ai][m];
                bf16_t* rowp = O + (size_t)row * ldc + col0; float s1 = 0.f, s2 = 0.f;
#pragma unroll
                for (int bj = 0; bj < 2; ++bj) { f32x4 v0 = acc[ai][bj][m][0] * rs + bv[bj][0], v1 = acc[ai][bj][m][1] * rs + bv[bj][1];
                    if (ACT == 1) { f32x2 a = gelu_pk((f32x2){v0[0], v0[1]}), b = gelu_pk((f32x2){v0[2], v0[3]}), c = gelu_pk((f32x2){v1[0], v1[1]}), d = gelu_pk((f32x2){v1[2], v1[3]});
                        v0 = (f32x4){a.x, a.y, b.x, b.y}; v1 = (f32x4){c.x, c.y, d.x, d.y}; }
                    if (ACT == 2) {
#pragma unroll
                        for (int j = 0; j < 4; ++j) { const float a = fmaxf(v0[j], 0.f), b = fmaxf(v1[j], 0.f); v0[j] = a * a; v1[j] = b * b; } }
                    v0 = v0 * oscale; v1 = v1 * oscale;
                    if (STATS) { s1 += (v0[0] + v0[1]) + (v0[2] + v0[3]) + (v1[0] + v1[1]) + (v1[2] + v1[3]);
                        s2 += (v0[0] * v0[0] + v0[1] * v0[1]) + (v0[2] * v0[2] + v0[3] * v0[3]) + (v1[0] * v1[0] + v1[1] * v1[1]) + (v1[2] * v1[2] + v1[3] * v1[3]); }
                    u32x4 w; w.x = cvt_pk_bf16(v0[0], v0[1]); w.y = cvt_pk_bf16(v0[2], v0[3]); w.z = cvt_pk_bf16(v1[0], v1[1]); w.w = cvt_pk_bf16(v1[2], v1[3]);
                    *(u32x4*)(rowp + bj * HALF) = w; }
                if (STATS) { s1 += __shfl_xor(s1, 16); s1 += __shfl_xor(s1, 32); s2 += __shfl_xor(s2, 16); s2 += __shfl_xor(s2, 32);
                    if (u.pn >= stat_pn0 && fq == 0) *(f32x2*)(vst + (size_t)row * SSQ_STRIDE + ((u.pn - stat_pn0) * 4 + wc) * 2) = (f32x2){s1, s2}; }
            }
    }
};
struct EpiRes {
    static constexpr bool PERM = true, AFTER_DRAIN = false;
    bf16_t* xb; float* ssq;
    __device__ __forceinline__ void operator()(const f32x4 (&acc)[2][2][4][2], const Unit& u, int wr, int wc, int fr, int fq) const {
        const int row0 = u.pm * BM + wr * 64 + fr, col0 = u.pn * BM + wc * 32 + 8 * fq;
#pragma unroll
        for (int ai = 0; ai < 2; ++ai) {
            u32x4 pre[4][2];
#pragma unroll
            for (int m = 0; m < 4; ++m) { const size_t off = (size_t)(row0 + ai * HALF + m * 16) * 2048 + col0;
#pragma unroll
                for (int bj = 0; bj < 2; ++bj) pre[m][bj] = *(const u32x4*)(xb + off + bj * HALF); }
            asm volatile("" ::: "memory");
#pragma unroll
            for (int m = 0; m < 4; ++m) { const int row = row0 + ai * HALF + m * 16; const size_t off = (size_t)row * 2048 + col0; float ss = 0.f;
#pragma unroll
                for (int bj = 0; bj < 2; ++bj) { const u32x4 b = pre[m][bj]; const f32x4 a0 = acc[ai][bj][m][0], a1 = acc[ai][bj][m][1];
                    const float o0 = __builtin_bit_cast(float, b.x << 16) + a0[0], o1 = __builtin_bit_cast(float, b.x & 0xffff0000u) + a0[1], o2 = __builtin_bit_cast(float, b.y << 16) + a0[2], o3 = __builtin_bit_cast(float, b.y & 0xffff0000u) + a0[3];
                    const float o4 = __builtin_bit_cast(float, b.z << 16) + a1[0], o5 = __builtin_bit_cast(float, b.z & 0xffff0000u) + a1[1], o6 = __builtin_bit_cast(float, b.w << 16) + a1[2], o7 = __builtin_bit_cast(float, b.w & 0xffff0000u) + a1[3];
                    ss += (o0 * o0 + o1 * o1) + (o2 * o2 + o3 * o3) + (o4 * o4 + o5 * o5) + (o6 * o6 + o7 * o7);
                    u32x4 w; w.x = cvt_pk_bf16(o0, o1); w.y = cvt_pk_bf16(o2, o3); w.z = cvt_pk_bf16(o4, o5); w.w = cvt_pk_bf16(o6, o7); *(u32x4*)(xb + off + bj * HALF) = w; }
                ss += __shfl_xor(ss, 16); ss += __shfl_xor(ss, 32);
                if (fq == 0) ssq[(size_t)row * SSQ_STRIDE + u.pn * 4 + wc] = ss; }
            asm volatile("" ::: "memory"); }
    }
};
struct EpiGlu {
    static constexpr bool PERM = false, AFTER_DRAIN = false;
    bf16_t* xb; float* ssq; const float* bias;
    __device__ __forceinline__ void operator()(const f32x4 (&acc)[2][2][4][2], const Unit& u, int wr, int wc, int fr, int fq) const {
        const int row0 = u.pm * BM + wr * 64 + fr, col0 = u.pn * 128 + wc * 16 + 4 * fq;
        f32x4 bval[2], bgate[2];
#pragma unroll
        for (int bj = 0; bj < 2; ++bj) { bval[bj] = *(const f32x4*)(bias + col0 + bj * 64); bgate[bj] = *(const f32x4*)(bias + 2048 + col0 + bj * 64); }
#pragma unroll
        for (int ai = 0; ai < 2; ++ai) {
            u32x2 pre[4][2];
#pragma unroll
            for (int m = 0; m < 4; ++m) { const size_t off = (size_t)(row0 + ai * HALF + m * 16) * 2048 + col0;
#pragma unroll
                for (int bj = 0; bj < 2; ++bj) pre[m][bj] = *(const u32x2*)(xb + off + bj * 64); }
            asm volatile("" ::: "memory");
#pragma unroll
            for (int m = 0; m < 4; ++m) { const int row = row0 + ai * HALF + m * 16; const size_t off = (size_t)row * 2048 + col0; float ss = 0.f;
#pragma unroll
                for (int bj = 0; bj < 2; ++bj) { const f32x4 val = acc[ai][bj][m][0] + bval[bj], gate = acc[ai][bj][m][1] + bgate[bj]; const u32x2 pb = pre[m][bj]; f32x4 o = (f32x4){__builtin_bit_cast(float, pb.x << 16), __builtin_bit_cast(float, pb.x & 0xffff0000u), __builtin_bit_cast(float, pb.y << 16), __builtin_bit_cast(float, pb.y & 0xffff0000u)};
#pragma unroll
                    for (int j = 0; j < 4; ++j) { const float sg = __builtin_amdgcn_rcpf(1.0f + __builtin_amdgcn_exp2f(-1.4426950408889634f * gate[j])); o[j] += val[j] * sg; }
                    ss += (o[0] * o[0] + o[1] * o[1]) + (o[2] * o[2] + o[3] * o[3]);
                    u32x2 w; w.x = cvt_pk_bf16(o[0], o[1]); w.y = cvt_pk_bf16(o[2], o[3]); *(u32x2*)(xb + off + bj * 64) = w; }
                ss += __shfl_xor(ss, 16); ss += __shfl_xor(ss, 32);
                if (fq == 0) ssq[(size_t)row * SSQ_STRIDE + u.pn * 4 + wc] = ss; }
            asm volatile("" ::: "memory"); }
    }
};
__host__ __device__ __forceinline__ int vt_pos(int key) { const int s = key >> 5, w = key & 31; return 32 * s + 8 * ((w & 15) >> 2) + (w & 3) + 4 * (w >> 4); }
struct EpiKV {
    static constexpr bool PERM = true, AFTER_DRAIN = false;
    bf16_t* Kb; bf16_t* Vb; bf16_t* VTb; const float* ssq;
    __device__ __forceinline__ void operator()(const f32x4 (&acc)[2][2][4][2], const Unit& u, int wr, int wc, int fr, int fq) const {
        const int row0 = u.pm * BM + wr * 64 + fr, col0 = u.pn * BM + wc * 32 + 8 * fq;
#pragma unroll
        for (int ai = 0; ai < 2; ++ai)
#pragma unroll
            for (int m = 0; m < 4; ++m) { const int row = row0 + ai * HALF + m * 16; const float rs = row_rstd(ssq, 32, row, fq); const int b = row >> 8, key = row & 255;
#pragma unroll
                for (int bj = 0; bj < 2; ++bj) { const f32x4 v0 = acc[ai][bj][m][0] * rs, v1 = acc[ai][bj][m][1] * rs; const int col = col0 + bj * HALF;
                    u32x4 w; w.x = cvt_pk_bf16(v0[0], v0[1]); w.y = cvt_pk_bf16(v0[2], v0[3]); w.z = cvt_pk_bf16(v1[0], v1[1]); w.w = cvt_pk_bf16(v1[2], v1[3]);
                    if (col < 2048) { const int h = col >> 9, d = col & 511; *(u32x4*)(Kb + ((size_t)((b * 4 + h) * 256 + key)) * 512 + d) = w; }
                    else { const int c2 = col - 2048, h = c2 >> 9, d = c2 & 511; *(u32x4*)(Vb + ((size_t)((b * 4 + h) * 256 + key)) * 512 + d) = w;
                        bf16_t* vt = VTb + ((size_t)((b * 4 + h) * 512 + d)) * 256 + vt_pos(key);
                        vt[0 * 256] = (bf16_t)(w.x & 0xffffu); vt[1 * 256] = (bf16_t)(w.x >> 16); vt[2 * 256] = (bf16_t)(w.y & 0xffffu); vt[3 * 256] = (bf16_t)(w.y >> 16);
                        vt[4 * 256] = (bf16_t)(w.z & 0xffffu); vt[5 * 256] = (bf16_t)(w.z >> 16); vt[6 * 256] = (bf16_t)(w.w & 0xffffu); vt[7 * 256] = (bf16_t)(w.w >> 16); } }
            }
    }
};
template <class Epi, class Sched, bool ALIGN_EPI = false, bool SP2 = false>
__device__ __forceinline__ void gemm_phase(PG8_LAS unsigned char* lds, const Gemm g, const Sched& S, const Epi& E, const int wid  , const int lane) {
    const int tid = wid * 64 + lane, wr = wid >> 2, wc = wid & 3, fr = lane & 15, fq = lane >> 4;
    const int K = g.K, nt = K / BK;
    unsigned voffA[2], voffB[2];
#pragma unroll
    for (int i = 0; i < 2; ++i) { int R, C; stage_rc(tid * 16 + i * 8192, R, C); const int Rb = Epi::PERM ? ((R & ~31) + perm32(R & 31)) : R;
        voffA[i] = (unsigned)(R * K + C) * 2u; voffB[i] = (unsigned)(Rb * K + C) * 2u; }
    const size_t kstep = (size_t)(BK * 2);
    const size_t hstep = (size_t)HALF * K * 2;
    const size_t tstep = 2 * hstep;
    const unsigned ldsw = (unsigned)wid * 1024u;
    const int aoff = lds_byte(wr * 64 + fr, fq * 8), boff = lds_byte(wc * 32 + fr, fq * 8);
#define PG8_SA(b, h) (((b) * 2 + (h)) * HTB)
#define PG8_SB(b, h) ((4 + (b) * 2 + (h)) * HTB)
#define PG8_STAGE(bufoff, gbase, voff) do { _Pragma("unroll") for (int _i = 0; _i < 2; ++_i) \
        __builtin_amdgcn_global_load_lds((const unsigned*)((const char*)(gbase) + (voff)[_i]), (PG8_LAS unsigned*)(lds + (bufoff) + ldsw + _i * 8192), 16, 0, 0); } while (0)
#define PG8_LDA(dst, b, h) do { _Pragma("unroll") for (int m = 0; m < 4; ++m) _Pragma("unroll") for (int k = 0; k < 2; ++k) dst[m][k] = *(const PG8_LAS bf16x8*)(lds + PG8_SA(b, h) + aoff + m * 2048 + k * 1024); } while (0)
#define PG8_LDB(dst, b, h) do { _Pragma("unroll") for (int n = 0; n < 2; ++n) _Pragma("unroll") for (int k = 0; k < 2; ++k) dst[n][k] = *(const PG8_LAS bf16x8*)(lds + PG8_SB(b, h) + boff + n * 2048 + k * 1024); } while (0)
#define PG8_MMA(ai, bj, At, Bt) do { __builtin_amdgcn_s_setprio(1); _Pragma("unroll") for (int m = 0; m < 4; ++m) _Pragma("unroll") for (int n = 0; n < 2; ++n) _Pragma("unroll") for (int k = 0; k < 2; ++k) \
        acc[ai][bj][m][n] = __builtin_amdgcn_mfma_f32_16x16x32_bf16(Bt[n][k], At[m][k], acc[ai][bj][m][n], 0, 0, 0); __builtin_amdgcn_s_setprio(0); } while (0)
#define PG8_WAIT_V(n) asm volatile("s_waitcnt vmcnt(" #n ")" ::: "memory")
#define PG8_WAIT_L(n) asm volatile("s_waitcnt lgkmcnt(" #n ")" ::: "memory")
#define PG8_BAR __builtin_amdgcn_s_barrier()
#define PG8_SCHED __builtin_amdgcn_sched_barrier(0)
    Unit cur, nxt; int ui = 0;
    if (!S.next(0, cur)) return;
    f32x4 acc[2][2][4][2];
#pragma unroll
    for (int a = 0; a < 2; ++a)
#pragma unroll
        for (int b = 0; b < 2; ++b)
#pragma unroll
            for (int m = 0; m < 4; ++m)
#pragma unroll
                for (int n = 0; n < 2; ++n) acc[a][b][m][n] = (f32x4){0.f, 0.f, 0.f, 0.f};
    bf16x8 At[4][2], B0[2][2], B1[2][2];
    const char* cA = (const char*)g.A + (size_t)cur.pm * tstep; const char* cB = (const char*)g.Bt + (size_t)cur.pn * tstep;
    S.a_ready(cur);
    if constexpr (SP2) {
        PG8_STAGE(PG8_SB(0, 0), cB, voffB); PG8_STAGE(PG8_SB(0, 1), cB + hstep, voffB); PG8_STAGE(PG8_SA(0, 0), cA, voffA); PG8_STAGE(PG8_SA(0, 1), cA + hstep, voffA);
        if (wr == 1) PG8_BAR;
        PG8_WAIT_V(2); PG8_BAR;
        PG8_STAGE(PG8_SB(1, 0), cB + kstep, voffB); PG8_STAGE(PG8_SA(1, 0), cA + kstep, voffA); PG8_STAGE(PG8_SB(1, 1), cB + hstep + kstep, voffB);
        PG8_WAIT_V(6); PG8_BAR;
    } else {
        PG8_STAGE(PG8_SB(0, 0), cB, voffB); PG8_STAGE(PG8_SA(0, 0), cA, voffA); PG8_STAGE(PG8_SB(0, 1), cB + hstep, voffB); PG8_STAGE(PG8_SA(0, 1), cA + hstep, voffA);
        if (wr == 1) PG8_BAR;
        PG8_WAIT_V(4); PG8_BAR;
        PG8_STAGE(PG8_SB(1, 0), cB + kstep, voffB); PG8_STAGE(PG8_SA(1, 0), cA + kstep, voffA); PG8_STAGE(PG8_SB(1, 1), cB + hstep + kstep, voffB);
        PG8_WAIT_V(6); PG8_BAR;
    }
    for (;;) {
        const bool has_next = S.next(ui + 1, nxt);
        const char* nA = has_next ? (const char*)g.A + (size_t)nxt.pm * tstep : cA; const char* nB = has_next ? (const char*)g.Bt + (size_t)nxt.pn * tstep : cB;
        for (int t = 0; t < nt; t += 2) {
            const bool last = (t == nt - 2);
            const char* a1 = cA + (size_t)(t + 1) * kstep;
            const char* a2 = last ? nA : cA + (size_t)(t + 2) * kstep; const char* b2 = last ? nB : cB + (size_t)(t + 2) * kstep;
            const char* a3 = a2 + kstep; const char* b3 = b2 + kstep;
            if (last && has_next) S.a_ready(nxt);
            if constexpr (SP2) {
            PG8_LDB(B0, 0, 0); PG8_LDB(B1, 0, 1); PG8_SCHED; PG8_LDA(At, 0, 0); PG8_STAGE(PG8_SA(1, 1), a1 + hstep, voffA);
            PG8_WAIT_V(8); PG8_WAIT_L(0); PG8_BAR; PG8_MMA(0, 0, At, B0); PG8_MMA(0, 1, At, B1); PG8_BAR; PG8_SCHED;
            PG8_LDA(At, 0, 1); PG8_STAGE(PG8_SB(0, 0), b2, voffB); PG8_STAGE(PG8_SB(0, 1), b2 + hstep, voffB); PG8_STAGE(PG8_SA(0, 0), a2, voffA);
            PG8_WAIT_V(8); PG8_WAIT_L(0); PG8_BAR; PG8_MMA(1, 0, At, B0); PG8_MMA(1, 1, At, B1); PG8_BAR; PG8_SCHED;
            PG8_LDB(B0, 1, 0); PG8_LDB(B1, 1, 1); PG8_SCHED; PG8_LDA(At, 1, 0); PG8_STAGE(PG8_SA(0, 1), a2 + hstep, voffA);
            PG8_WAIT_V(8); PG8_WAIT_L(0); PG8_BAR; PG8_MMA(0, 0, At, B0); PG8_MMA(0, 1, At, B1); PG8_BAR; PG8_SCHED;
            PG8_LDA(At, 1, 1); PG8_STAGE(PG8_SB(1, 0), b3, voffB); PG8_STAGE(PG8_SB(1, 1), b3 + hstep, voffB); PG8_STAGE(PG8_SA(1, 0), a3, voffA);
            PG8_WAIT_V(8); PG8_WAIT_L(0); PG8_BAR; PG8_MMA(1, 0, At, B0); PG8_MMA(1, 1, At, B1); PG8_BAR; PG8_SCHED;
            } else {
            PG8_LDB(B0, 0, 0); PG8_SCHED; PG8_LDA(At, 0, 0); PG8_STAGE(PG8_SA(1, 1), a1 + hstep, voffA);
            PG8_WAIT_L(8); PG8_BAR; PG8_WAIT_L(0); PG8_MMA(0, 0, At, B0); PG8_BAR; PG8_SCHED;
            PG8_LDB(B1, 0, 1); PG8_STAGE(PG8_SB(0, 0), b2, voffB);
            PG8_BAR; PG8_WAIT_L(0); PG8_MMA(0, 1, At, B1); PG8_BAR;
            PG8_LDA(At, 0, 1); PG8_STAGE(PG8_SA(0, 0), a2, voffA);
            PG8_BAR; PG8_WAIT_L(0); PG8_MMA(1, 0, At, B0); PG8_BAR; PG8_SCHED;
            PG8_STAGE(PG8_SB(0, 1), b2 + hstep, voffB);
            PG8_WAIT_V(6); PG8_BAR; PG8_MMA(1, 1, At, B1); PG8_BAR;
            PG8_LDB(B0, 1, 0); PG8_SCHED; PG8_LDA(At, 1, 0); PG8_STAGE(PG8_SA(0, 1), a2 + hstep, voffA);
            PG8_WAIT_L(8); PG8_BAR; PG8_WAIT_L(0); PG8_MMA(0, 0, At, B0); PG8_BAR; PG8_SCHED;
            PG8_LDB(B1, 1, 1); PG8_STAGE(PG8_SB(1, 0), b3, voffB);
            PG8_BAR; PG8_WAIT_L(0); PG8_MMA(0, 1, At, B1); PG8_BAR;
            PG8_LDA(At, 1, 1); PG8_STAGE(PG8_SA(1, 0), a3, voffA);
            PG8_BAR; PG8_WAIT_L(0); PG8_MMA(1, 0, At, B0); PG8_BAR; PG8_SCHED;
            PG8_STAGE(PG8_SB(1, 1), b3 + hstep, voffB);
            PG8_WAIT_V(6); PG8_BAR; PG8_MMA(1, 1, At, B1); PG8_BAR;
            }
        }
        if constexpr (ALIGN_EPI) { if (wr == 0) PG8_BAR; }
        if constexpr (!Epi::AFTER_DRAIN) { Unit ue = cur; asm volatile("" : "+s"(ue.pm), "+s"(ue.pn));
            int fre = fr, fqe = fq; asm volatile("" : "+v"(fre), "+v"(fqe)); E(acc, ue, wr, wc, fre, fqe); S.done(cur); }
        if (!has_next) break;
#pragma unroll
        for (int a = 0; a < 2; ++a)
#pragma unroll
            for (int b = 0; b < 2; ++b)
#pragma unroll
                for (int m = 0; m < 4; ++m)
#pragma unroll
                    for (int n = 0; n < 2; ++n) acc[a][b][m][n] = (f32x4){0.f, 0.f, 0.f, 0.f};
        cur = nxt; cA = nA; cB = nB; ++ui;
        if constexpr (ALIGN_EPI) { if (wr == 1) PG8_BAR; }
    }
    PG8_WAIT_V(0);
    if constexpr (!ALIGN_EPI) { if (wr == 0) PG8_BAR; }
    PG8_BAR;
    if constexpr (Epi::AFTER_DRAIN) { E.fused(acc, cur, wr, wc, fr, fq, lds, wid, lane); S.done(cur); }
#undef PG8_SA
#undef PG8_SB
#undef PG8_STAGE
#undef PG8_LDA
#undef PG8_LDB
#undef PG8_MMA
#undef PG8_WAIT_V
#undef PG8_WAIT_L
#undef PG8_BAR
#undef PG8_SCHED
}
}
#ifndef MK_N_LAUNCHES
#define MK_N_LAUNCHES 1
#endif
constexpr int BATCH = 2, SEQ = 4096, D = 2048, M = BATCH * SEQ, MEMLEN = 256, MROWS = BATCH * MEMLEN, FF = 8192;
constexpr int NWAVES = 8, NTHREADS = 512, NPH = 20;
constexpr int LDS_BYTES = 147456;
constexpr size_t MiB = 1u << 20;
constexpr size_t WS_W_AIN = 2 * MiB, WS_W_AOUT = 18 * MiB, WS_W_BIN = 26 * MiB, WS_W_BOUT = 34 * MiB, WS_W_Q = 50 * MiB, WS_W_KV = 66 * MiB, WS_W_O = 98 * MiB, WS_W_UP = 114 * MiB, WS_W_DN = 178 * MiB;
constexpr size_t WS_XB = 242 * MiB, WS_MEMB = 274 * MiB, WS_KB = 276 * MiB, WS_VB = 280 * MiB, WS_VTB = 284 * MiB, WS_SSQ = 288 * MiB, WS_VST = 290 * MiB, WS_SSQM = 292 * MiB, WS_S5ST = 294 * MiB;
constexpr size_t WS_R = 304 * MiB, WS_END = 432 * MiB;
#define GAS __attribute__((address_space(1)))
#define LAS __attribute__((address_space(3)))
typedef unsigned short bf16;
typedef unsigned v4u __attribute__((ext_vector_type(4)));
typedef unsigned v2u __attribute__((ext_vector_type(2)));
typedef float f32x4 __attribute__((ext_vector_type(4)));
typedef float f32x2 __attribute__((ext_vector_type(2)));
typedef short bf16x8 __attribute__((ext_vector_type(8)));
#define LDS_WAIT() asm volatile("s_waitcnt lgkmcnt(0)" ::: "memory")
__device__ __forceinline__ unsigned f2bf(float f) { unsigned u = __builtin_bit_cast(unsigned, f); return (u + 0x7fffu + ((u >> 16) & 1u)) >> 16; }
__device__ __forceinline__ unsigned pk2(float lo, float hi) { return f2bf(lo) | (f2bf(hi) << 16); }
__device__ __forceinline__ float bflo(unsigned w) { return __builtin_bit_cast(float, w << 16); }
__device__ __forceinline__ float bfhi(unsigned w) { return __builtin_bit_cast(float, w & 0xffff0000u); }
__device__ __forceinline__ float wave_sum(float v) {
#pragma unroll
    for (int o = 1; o < 64; o <<= 1) v += __shfl_xor(v, o);
    return v;
}
__device__ __forceinline__ float wave_max(float v) {
#pragma unroll
    for (int o = 1; o < 64; o <<= 1) v = fmaxf(v, __shfl_xor(v, o));
    return v;
}
__device__ __forceinline__ float gelu_exact(float v) { return 0.5f * v * (1.0f + erff(v * 0.70710678118654752f)); }

struct Args { const float* in[30]; float* out; unsigned char* ws; int ph_lo, ph_hi; };
__device__ __forceinline__ const float* ka_in(int i) { const __attribute__((address_space(4))) char* ka = (const __attribute__((address_space(4))) char*)__builtin_amdgcn_kernarg_segment_ptr(); asm volatile("" : "+s"(ka)); return *(const float* const __attribute__((address_space(4)))*)(ka + 8 * i); }

__device__ __forceinline__ int glu_rowmap(int n) { return n < 2048 ? 32 * (n >> 4) + (n & 15) : 32 * ((n - 2048) >> 4) + 16 + (n & 15); }
struct ConvSel { const float* W; const float* g; bf16* WT; int K, N, mode, item; };
__device__ __forceinline__ ConvSel conv_select(unsigned char* ws, int r) {
    ConvSel s; s.g = nullptr; s.K = 2048; s.N = 2048; s.mode = 0;
    if (r < 2048) { s.W = ka_in(7); s.g = ka_in(2); s.WT = (bf16*)(ws + WS_W_AIN); s.N = 4096; }
    else if ((r -= 2048) < 1024) { s.W = ka_in(13); s.WT = (bf16*)(ws + WS_W_AOUT); }
    else if ((r -= 1024) < 1024) { s.W = ka_in(14); s.g = ka_in(2) + 2048; s.WT = (bf16*)(ws + WS_W_BIN); }
    else if ((r -= 1024) < 2048) { s.W = ka_in(23); s.WT = (bf16*)(ws + WS_W_BOUT); s.N = 4096; s.mode = 1; }
    else if ((r -= 2048) < 2048) { const int i = r >> 10; r &= 1023; s.W = ka_in(25) + (size_t)i * 2048 * 2048; s.g = ka_in(3) + i * 2048; s.WT = (bf16*)(ws + WS_W_Q + i * 8 * MiB); }
    else if ((r -= 2048) < 4096) { const int i = r >> 11; r &= 2047; s.W = ka_in(26) + (size_t)i * 2048 * 4096; s.g = ka_in(4) + i * 2048; s.WT = (bf16*)(ws + WS_W_KV + i * 16 * MiB); s.N = 4096; }
    else if ((r -= 4096) < 2048) { const int i = r >> 10; r &= 1023; s.W = ka_in(27) + (size_t)i * 2048 * 2048; s.WT = (bf16*)(ws + WS_W_O + i * 8 * MiB); }
    else if ((r -= 2048) < 8192) { const int i = r >> 12; r &= 4095; s.W = ka_in(28) + (size_t)i * 2048 * 8192; s.g = ka_in(5) + i * 2048; s.WT = (bf16*)(ws + WS_W_UP + i * 32 * MiB); s.N = 8192; }
    else { r -= 8192; const int i = r >> 12; r &= 4095; s.W = ka_in(29) + (size_t)i * 8192 * 2048; s.WT = (bf16*)(ws + WS_W_DN + i * 32 * MiB); s.K = 8192; }
    s.item = r; return s;
}
__device__ __forceinline__ void conv_load(const ConvSel& s, f32x4 (&v)[16], int lane) {
    const int nblk = s.N >> 6, kb = s.item / nblk, nb = s.item - kb * nblk, k0 = 64 * kb, n0 = 64 * nb;
#pragma unroll
    for (int i = 0; i < 16; ++i) { const int kk = 4 * i + (lane >> 4); v[i] = *(const f32x4*)(s.W + (size_t)(k0 + kk) * s.N + n0 + 4 * (lane & 15)); }
}
__device__ __forceinline__ void conv_finish(const ConvSel& s, const f32x4 (&v)[16], LAS float* scr, int lane) {
    const int nblk = s.N >> 6, kb = s.item / nblk, nb = s.item - kb * nblk, k0 = 64 * kb, n0 = 64 * nb;
#pragma unroll
    for (int i = 0; i < 16; ++i) { const int kk = 4 * i + (lane >> 4); const float sc = s.g ? s.g[k0 + kk] : 1.0f; LAS float* d = scr + kk * 65 + 4 * (lane & 15);
        d[0] = v[i][0] * sc; d[1] = v[i][1] * sc; d[2] = v[i][2] * sc; d[3] = v[i][3] * sc; }
    LDS_WAIT();
    const int c = lane & 7;
#pragma unroll
    for (int j = 0; j < 8; ++j) { const int n = (lane >> 3) + 8 * j; const LAS float* sp = scr + (8 * c) * 65 + n;
        v4u o; o.x = pk2(sp[0 * 65], sp[1 * 65]); o.y = pk2(sp[2 * 65], sp[3 * 65]); o.z = pk2(sp[4 * 65], sp[5 * 65]); o.w = pk2(sp[6 * 65], sp[7 * 65]);
        const int nr = s.mode ? glu_rowmap(n0 + n) : (n0 + n);
        *(v4u*)(s.WT + (size_t)nr * s.K + k0 + 8 * c) = o; }
    LDS_WAIT();
}
template <int PART> __device__ __forceinline__ int conv_index(int j) { return PART == 0 ? 8192 + j : (j < 8192 ? j : j + 4096); }
template <int PART> __device__ __forceinline__ void conv_run(unsigned char* ws, LAS float* scr, int first, int step, int limit, int lane) {
    if (first >= limit) return;
    f32x4 va[16], vb[16];
    ConvSel sa = conv_select(ws, conv_index<PART>(__builtin_amdgcn_readfirstlane(first))), sb = sa;
    conv_load(sa, va, lane);
    for (int j = first; j < limit; j += 2 * step) {
        const bool hb = (j + step) < limit;
        if (hb) { sb = conv_select(ws, conv_index<PART>(__builtin_amdgcn_readfirstlane(j + step))); conv_load(sb, vb, lane); }
        conv_finish(sa, va, scr, lane);
        if (!hb) break;
        const bool ha = (j + 2 * step) < limit;
        if (ha) { sa = conv_select(ws, conv_index<PART>(__builtin_amdgcn_readfirstlane(j + 2 * step))); conv_load(sa, va, lane); }
        conv_finish(sb, vb, scr, lane);
    }
}
__device__ __forceinline__ void row_to_bf16(const float* xrow, bf16* orow, float* ssqrow, int lane) {
    f32x4 v[8]; float s = 0.f;
#pragma unroll
    for (int j = 0; j < 8; ++j) { v[j] = ((const f32x4*)xrow)[lane + 64 * j]; s += (v[j][0] * v[j][0] + v[j][1] * v[j][1]) + (v[j][2] * v[j][2] + v[j][3] * v[j][3]); }
    s = wave_sum(s);
#pragma unroll
    for (int j = 0; j < 8; ++j) { v2u w; w.x = pk2(v[j][0], v[j][1]); w.y = pk2(v[j][2], v[j][3]); ((v2u*)orow)[lane + 64 * j] = w; }
    if (lane < 32) ssqrow[lane] = (lane == 0) ? s : 0.f;
}
__device__ __forceinline__ void p0_prologue(unsigned char* ws, LAS unsigned char* lds, int wave, int lane) {
    LAS float* scr = (LAS float*)(lds + wave * 16640);
    const int gw = blockIdx.x * NWAVES + wave, NGW = gridDim.x * NWAVES;
    conv_run<0>(ws, scr, gw, NGW, 4096, lane);
    for (int m = gw; m < M + MROWS; m += NGW) {
        if (m < M) row_to_bf16(ka_in(0) + (size_t)m * D, (bf16*)(ws + WS_XB) + (size_t)m * D, (float*)(ws + WS_SSQ) + (size_t)m * 64, lane);
        else { const int r = m - M; row_to_bf16(ka_in(1) + (size_t)r * D, (bf16*)(ws + WS_MEMB) + (size_t)r * D, (float*)(ws + WS_SSQM) + (size_t)r * 64, lane); }
    }
}
constexpr int CONV_REST = 26624, CONV_SPLIT = 22272;
__device__ __forceinline__ void p1_convert(unsigned char* ws, LAS unsigned char* lds, int wave, int lane) {
    LAS float* scr = (LAS float*)(lds + wave * 16640);
    const int bx = blockIdx.x, G = gridDim.x;
    if (G <= 64) { conv_run<1>(ws, scr, bx * NWAVES + wave, G * NWAVES, CONV_REST, lane); return; }
    if (bx >= 64) conv_run<1>(ws, scr, (bx - 64) * NWAVES + wave, (G - 64) * NWAVES, CONV_SPLIT, lane);
    else conv_run<1>(ws, scr, CONV_SPLIT + bx * NWAVES + wave, 64 * NWAVES, CONV_REST, lane);
}
__device__ __forceinline__ void final_norm(const bf16* xb, const float* ssq, const float* g, float* out, int wave, int lane) {
    const int gw = blockIdx.x * NWAVES + wave, NGW = gridDim.x * NWAVES;
    for (int m = gw; m < M; m += NGW) {
        float s = (lane < 32) ? ssq[(size_t)m * 64 + lane] : 0.f; s = wave_sum(s);
        const float rs = 1.0f / sqrtf(s * (1.0f / D) + 1e-6f);
        const v4u* xr = (const v4u*)(xb + (size_t)m * D); f32x4* orow = (f32x4*)(out + (size_t)m * D);
#pragma unroll
        for (int j = 0; j < 4; ++j) { const v4u w = xr[lane + 64 * j]; const f32x4 g0 = ((const f32x4*)g)[2 * (lane + 64 * j)], g1 = ((const f32x4*)g)[2 * (lane + 64 * j) + 1];
            orow[2 * (lane + 64 * j)] = (f32x4){bflo(w.x) * rs * g0[0], bfhi(w.x) * rs * g0[1], bflo(w.y) * rs * g0[2], bfhi(w.y) * rs * g0[3]};
            orow[2 * (lane + 64 * j) + 1] = (f32x4){bflo(w.z) * rs * g1[0], bfhi(w.z) * rs * g1[1], bflo(w.w) * rs * g1[2], bfhi(w.w) * rs * g1[3]}; } }
}
__device__ __forceinline__ void gating_simple(LAS unsigned char* lds, const bf16* z, const float* vst, const float* ln_g, const float* ln_b, const float* w_s, const float* b_s, bf16* gbuf, int tid) {
    LAS float* vln = (LAS float*)lds;
    LAS float* Wl = (LAS float*)(lds + 65536);
    LAS float* mu = (LAS float*)(lds + 65536 + 128 * 129 * 4);
    LAS float* rsd = mu + 128;
    for (int unit = blockIdx.x; unit < 1024; unit += gridDim.x) {
        const int h = unit & 15, tok0 = (unit >> 4) * 128;
        if (tid < 128) { const float* p = vst + (size_t)(tok0 + tid) * 64; float s1 = 0.f, s2 = 0.f;
#pragma unroll 8
            for (int i = 0; i < 32; ++i) { s1 += p[2 * i]; s2 += p[2 * i + 1]; }
            const float mean = s1 * (1.0f / 2048.0f), var = s2 * (1.0f / 2048.0f) - mean * mean; mu[tid] = mean; rsd[tid] = 1.0f / sqrtf(var + 1e-6f); }
        __syncthreads();
        { const int s = tid >> 2, db = (tid & 3) * 32; const float mean = mu[s], rs = rsd[s];
            const bf16* vp = z + (size_t)(tok0 + s) * 4096 + 2048 + h * 128 + db;
#pragma unroll
            for (int q = 0; q < 4; ++q) { const v4u w = *(const v4u*)(vp + 8 * q); const float* gp = ln_g + h * 128 + db + 8 * q; const float* bp = ln_b + h * 128 + db + 8 * q; LAS float* o = vln + s * 128 + db + 8 * q;
                o[0] = (bflo(w.x) - mean) * rs * gp[0] + bp[0]; o[1] = (bfhi(w.x) - mean) * rs * gp[1] + bp[1]; o[2] = (bflo(w.y) - mean) * rs * gp[2] + bp[2]; o[3] = (bfhi(w.y) - mean) * rs * gp[3] + bp[3];
                o[4] = (bflo(w.z) - mean) * rs * gp[4] + bp[4]; o[5] = (bfhi(w.z) - mean) * rs * gp[5] + bp[5]; o[6] = (bflo(w.w) - mean) * rs * gp[6] + bp[6]; o[7] = (bfhi(w.w) - mean) * rs * gp[7] + bp[7]; }
            const float* wp = w_s + ((size_t)h * 128 + s) * 128 + db;
#pragma unroll
            for (int q = 0; q < 8; ++q) { const f32x4 w4 = *(const f32x4*)(wp + 4 * q); LAS float* o = Wl + s * 129 + db + 4 * q; o[0] = w4[0]; o[1] = w4[1]; o[2] = w4[2]; o[3] = w4[3]; } }
        __syncthreads();
        { const int t = tid >> 2, d0 = (tid & 3) * 32, tmax = t | 15; float acc[32];
#pragma unroll
            for (int j = 0; j < 32; ++j) acc[j] = 0.f;
            for (int s = 0; s <= tmax; ++s) { const float w = (s <= t) ? Wl[t * 129 + s] : 0.f; const LAS f32x4* vr = (const LAS f32x4*)(vln + s * 128 + d0);
#pragma unroll
                for (int q = 0; q < 8; ++q) { const f32x4 vv = vr[q]; acc[4 * q] += w * vv[0]; acc[4 * q + 1] += w * vv[1]; acc[4 * q + 2] += w * vv[2]; acc[4 * q + 3] += w * vv[3]; } }
            const float bs = b_s[h * 128 + t];
            const bf16* up = z + (size_t)(tok0 + t) * 4096 + h * 128 + d0; bf16* op = gbuf + (size_t)(tok0 + t) * 2048 + h * 128 + d0;
#pragma unroll
            for (int q = 0; q < 4; ++q) { const v4u w = *(const v4u*)(up + 8 * q); v4u o;
                o.x = pk2(bflo(w.x) * (acc[8 * q] + bs), bfhi(w.x) * (acc[8 * q + 1] + bs)); o.y = pk2(bflo(w.y) * (acc[8 * q + 2] + bs), bfhi(w.y) * (acc[8 * q + 3] + bs));
                o.z = pk2(bflo(w.z) * (acc[8 * q + 4] + bs), bfhi(w.z) * (acc[8 * q + 5] + bs)); o.w = pk2(bflo(w.w) * (acc[8 * q + 6] + bs), bfhi(w.w) * (acc[8 * q + 7] + bs));
                *(v4u*)(op + 8 * q) = o; } }
        __syncthreads();
    }
}
__device__ __forceinline__ void gating_mfma(LAS unsigned char* lds, const bf16* z, const float* vst, const float* ln_g, const float* ln_b, const float* w_s, const float* b_s, bf16* gbuf, int wave, int lane) {
    LAS float* MU = (LAS float*)(lds + 69632);
    const int tid = wave * 64 + lane, fr = lane & 15, fq = lane >> 4;
    const int ss = tid >> 2, db = (tid & 3) * 32;
    for (int unit = blockIdx.x; unit < 256; unit += gridDim.x) {
        const int tok0 = (unit >> 2) * 128, hg = unit & 3;
        __syncthreads();
        if (tid < 128) { const float* sp = vst + (size_t)(tok0 + tid) * 64; float s1 = 0.f, s2 = 0.f;
#pragma unroll
            for (int i = 0; i < 16; ++i) { const f32x4 a = *(const f32x4*)(sp + 4 * i); s1 += a[0] + a[2]; s2 += a[1] + a[3]; }
            const float mean = s1 * (1.0f / 2048.0f), var = s2 * (1.0f / 2048.0f) - mean * mean; MU[tid] = mean; MU[128 + tid] = 1.0f / sqrtf(var + 1e-6f); }
        v4u raw[4];
        { const bf16* vp = z + (size_t)(tok0 + ss) * 4096 + 2048 + (hg * 4) * 128 + db;
#pragma unroll
            for (int q4 = 0; q4 < 4; ++q4) raw[q4] = *(const v4u*)(vp + 8 * q4); }
        __syncthreads();
        const float mean = MU[ss], rs = MU[128 + ss];
#pragma unroll 1
        for (int hh = 0; hh < 4; ++hh) { const int h = hg * 4 + hh; LAS unsigned char* VT = lds + (hh & 1) * 34816;
            { const float* gp = ln_g + h * 128 + db; const float* bp = ln_b + h * 128 + db; LAS unsigned char* wp = VT + db * 272 + ss * 2;
#pragma unroll
                for (int q4 = 0; q4 < 4; ++q4) { const f32x4 g0 = *(const f32x4*)(gp + 8 * q4), g1 = *(const f32x4*)(gp + 8 * q4 + 4), b0 = *(const f32x4*)(bp + 8 * q4), b1 = *(const f32x4*)(bp + 8 * q4 + 4); const v4u w = raw[q4];
                    const float v0 = (bflo(w.x) - mean) * rs * g0[0] + b0[0], v1 = (bfhi(w.x) - mean) * rs * g0[1] + b0[1], v2 = (bflo(w.y) - mean) * rs * g0[2] + b0[2], v3 = (bfhi(w.y) - mean) * rs * g0[3] + b0[3];
                    const float v4 = (bflo(w.z) - mean) * rs * g1[0] + b1[0], v5 = (bfhi(w.z) - mean) * rs * g1[1] + b1[1], v6 = (bflo(w.w) - mean) * rs * g1[2] + b1[2], v7 = (bfhi(w.w) - mean) * rs * g1[3] + b1[3];
                    LAS unsigned char* o = wp + (8 * q4) * 272;
                    *(LAS bf16*)(o + 0 * 272) = (bf16)f2bf(v0); *(LAS bf16*)(o + 1 * 272) = (bf16)f2bf(v1); *(LAS bf16*)(o + 2 * 272) = (bf16)f2bf(v2); *(LAS bf16*)(o + 3 * 272) = (bf16)f2bf(v3);
                    *(LAS bf16*)(o + 4 * 272) = (bf16)f2bf(v4); *(LAS bf16*)(o + 5 * 272) = (bf16)f2bf(v5); *(LAS bf16*)(o + 6 * 272) = (bf16)f2bf(v6); *(LAS bf16*)(o + 7 * 272) = (bf16)f2bf(v7); } }
            if (hh < 3) { const bf16* vp = z + (size_t)(tok0 + ss) * 4096 + 2048 + (h + 1) * 128 + db;
#pragma unroll
                for (int q4 = 0; q4 < 4; ++q4) raw[q4] = *(const v4u*)(vp + 8 * q4); }
            __syncthreads();
            const int t = 16 * wave + fr, nks = (wave >> 1) + 1;
            bf16x8 wf[4];
#pragma unroll
            for (int ks = 0; ks < 4; ++ks) { wf[ks] = (bf16x8){0, 0, 0, 0, 0, 0, 0, 0};
                if (ks < nks) { const float* wp = w_s + ((size_t)h * 128 + t) * 128 + 32 * ks + 8 * fq; const f32x4 a = *(const f32x4*)wp, c = *(const f32x4*)(wp + 4); const int s0 = 32 * ks + 8 * fq;
                    float v[8] = {a[0], a[1], a[2], a[3], c[0], c[1], c[2], c[3]};
#pragma unroll
                    for (int j = 0; j < 8; ++j) v[j] = (s0 + j <= t) ? v[j] : 0.f;
                    v4u w; w.x = pk2(v[0], v[1]); w.y = pk2(v[2], v[3]); w.z = pk2(v[4], v[5]); w.w = pk2(v[6], v[7]); wf[ks] = __builtin_bit_cast(bf16x8, w); } }
            const float bs = b_s[h * 128 + t];
            const bf16* up = z + (size_t)(tok0 + t) * 4096 + h * 128 + 4 * fq; bf16* op = gbuf + (size_t)(tok0 + t) * 2048 + h * 128 + 4 * fq;
            const LAS unsigned char* ab = VT + fr * 272 + fq * 16;
#pragma unroll
            for (int df = 0; df < 8; ++df) { f32x4 acc = (f32x4){0.f, 0.f, 0.f, 0.f};
#pragma unroll
                for (int ks = 0; ks < 4; ++ks) if (ks < nks) { const bf16x8 a = *(const LAS bf16x8*)(ab + df * 16 * 272 + ks * 64); acc = __builtin_amdgcn_mfma_f32_16x16x32_bf16(a, wf[ks], acc, 0, 0, 0); }
                const v2u uw = *(const v2u*)(up + 16 * df); v2u ow;
                ow.x = pg8::cvt_pk_bf16(bflo(uw.x) * (acc[0] + bs), bfhi(uw.x) * (acc[1] + bs)); ow.y = pg8::cvt_pk_bf16(bflo(uw.y) * (acc[2] + bs), bfhi(uw.y) * (acc[3] + bs));
                *(v2u*)(op + 16 * df) = ow; }
        }
    }
    __syncthreads();
}
__device__ __forceinline__ void attn_simple(LAS unsigned char* lds, const bf16* q, const bf16* Kb, const bf16* Vb, bf16* obuf, int wave, int lane) {
    LAS float* pl = (LAS float*)(lds + wave * 1024);
    const int gw = blockIdx.x * NWAVES + wave, NGW = gridDim.x * NWAVES;
    for (int task = gw; task < BATCH * 4 * SEQ; task += NGW) {
        const int bh = task >> 12, t = task & 4095, b = bh >> 2, h = bh & 3;
        float qf[8]; { const v4u w = *(const v4u*)(q + ((size_t)(b * SEQ + t)) * 2048 + h * 512 + 8 * lane);
            qf[0] = bflo(w.x); qf[1] = bfhi(w.x); qf[2] = bflo(w.y); qf[3] = bfhi(w.y); qf[4] = bflo(w.z); qf[5] = bfhi(w.z); qf[6] = bflo(w.w); qf[7] = bfhi(w.w); }
        const bf16* kp = Kb + (size_t)bh * 256 * 512 + 8 * lane;
        float sc[4];
#pragma unroll
        for (int kk = 0; kk < 4; ++kk) { float mine = 0.f;
            for (int l2 = 0; l2 < 64; ++l2) { const v4u w = *(const v4u*)(kp + (size_t)(kk * 64 + l2) * 512);
                float dsum = qf[0] * bflo(w.x) + qf[1] * bfhi(w.x) + qf[2] * bflo(w.y) + qf[3] * bfhi(w.y) + qf[4] * bflo(w.z) + qf[5] * bfhi(w.z) + qf[6] * bflo(w.w) + qf[7] * bfhi(w.w);
                dsum = wave_sum(dsum); if (lane == l2) mine = dsum; }
            sc[kk] = mine; }
        const float mx = wave_max(fmaxf(fmaxf(sc[0], sc[1]), fmaxf(sc[2], sc[3])));
        float p[4], ps = 0.f;
#pragma unroll
        for (int kk = 0; kk < 4; ++kk) { p[kk] = exp2f(sc[kk] - mx); ps += p[kk]; pl[kk * 64 + lane] = p[kk]; }
        const float inv = 1.0f / wave_sum(ps);
        LDS_WAIT();
        float o[8];
#pragma unroll
        for (int i = 0; i < 8; ++i) o[i] = 0.f;
        const bf16* vp = Vb + (size_t)bh * 256 * 512 + 8 * lane;
        for (int key = 0; key < 256; ++key) { const float pk = pl[key]; const v4u w = *(const v4u*)(vp + (size_t)key * 512);
            o[0] += pk * bflo(w.x); o[1] += pk * bfhi(w.x); o[2] += pk * bflo(w.y); o[3] += pk * bfhi(w.y); o[4] += pk * bflo(w.z); o[5] += pk * bfhi(w.z); o[6] += pk * bflo(w.w); o[7] += pk * bfhi(w.w); }
        v4u ow; ow.x = pk2(o[0] * inv, o[1] * inv); ow.y = pk2(o[2] * inv, o[3] * inv); ow.z = pk2(o[4] * inv, o[5] * inv); ow.w = pk2(o[6] * inv, o[7] * inv);
        *(v4u*)(obuf + ((size_t)(b * SEQ + t)) * 2048 + h * 512 + 8 * lane) = ow;
        LDS_WAIT();
    }
}
__device__ __forceinline__ void attn_mfma(LAS unsigned char* lds, const bf16* q, const bf16* Kb, const bf16* VTb, bf16* obuf, int wave, int lane) {
    const int tid = wave * 64 + lane, fr = lane & 15, fq = lane >> 4;
    unsigned voffK[2], voffV[2];
#pragma unroll
    for (int i = 0; i < 2; ++i) { int R, C; pg8::stage_rc(tid * 16 + i * 8192, R, C); voffK[i] = (unsigned)(R * 512 + C) * 2u; voffV[i] = (unsigned)(R * 256 + C) * 2u; }
    const unsigned ldsw = (unsigned)wave * 1024u;
    const int aoff0 = pg8::lds_byte(fr, fq * 8);
#define AT_STAGE_K(c, buf) do { _Pragma("unroll") for (int ht = 0; ht < 4; ++ht) { const char* src = Kg + ((size_t)(128 * (ht >> 1)) * 512 + 128 * (c) + 64 * (ht & 1)) * 2; \
        _Pragma("unroll") for (int i = 0; i < 2; ++i) __builtin_amdgcn_global_load_lds((const unsigned*)(src + voffK[i]), (LAS unsigned*)(lds + (buf) * 65536 + ht * 16384 + ldsw + i * 8192), 16, 0, 0); } } while (0)
#define AT_STAGE_V(cc, buf) do { _Pragma("unroll") for (int ht = 0; ht < 4; ++ht) { const char* src = Vg + ((size_t)(128 * ht) * 256 + 64 * (cc)) * 2; \
        _Pragma("unroll") for (int i = 0; i < 2; ++i) __builtin_amdgcn_global_load_lds((const unsigned*)(src + voffV[i]), (LAS unsigned*)(lds + (buf) * 65536 + ht * 16384 + ldsw + i * 8192), 16, 0, 0); } } while (0)
#define AT_WAIT() do { asm volatile("s_waitcnt vmcnt(0)" ::: "memory"); __syncthreads(); } while (0)
    for (int unit = blockIdx.x; unit < 256; unit += gridDim.x) {
        const int bh = unit >> 5, qb = unit & 31, b = bh >> 2, h = bh & 3;
        const char* Kg = (const char*)(Kb + (size_t)bh * 256 * 512);
        const char* Vg = (const char*)(VTb + (size_t)bh * 512 * 256);
        const size_t tok = (size_t)(b * SEQ + qb * 128 + 16 * wave + fr);
        bf16x8 qf[16];
        { const bf16* qp = q + tok * 2048 + h * 512 + 8 * fq;
#pragma unroll
            for (int s = 0; s < 16; ++s) qf[s] = *(const bf16x8*)(qp + 32 * s); }
        f32x4 acc[16];
#pragma unroll
        for (int n = 0; n < 16; ++n) acc[n] = (f32x4){0.f, 0.f, 0.f, 0.f};
        AT_STAGE_K(0, 0);
#pragma unroll
        for (int c = 0; c < 4; ++c) {
            AT_WAIT();
            if (c < 3) AT_STAGE_K(c + 1, (c + 1) & 1); else AT_STAGE_V(0, 0);
            const LAS unsigned char* bb = lds + (c & 1) * 65536 + aoff0; asm volatile("" : "+v"(bb));
#pragma unroll
            for (int kh = 0; kh < 2; ++kh)
#pragma unroll
                for (int k = 0; k < 2; ++k)
#pragma unroll
                    for (int ng = 0; ng < 2; ++ng) { bf16x8 a[8];
#pragma unroll
                        for (int n8 = 0; n8 < 8; ++n8) a[n8] = *(const LAS bf16x8*)(bb + (ng * 2 + kh) * 16384 + n8 * 2048 + k * 1024);
#pragma unroll
                        for (int n8 = 0; n8 < 8; ++n8) acc[ng * 8 + n8] = __builtin_amdgcn_mfma_f32_16x16x32_bf16(a[n8], qf[4 * c + 2 * kh + k], acc[ng * 8 + n8], 0, 0, 0);
                        __builtin_amdgcn_sched_barrier(0); }
        }
        float mx = acc[0][0];
#pragma unroll
        for (int n = 0; n < 16; ++n) mx = fmaxf(fmaxf(mx, fmaxf(acc[n][0], acc[n][1])), fmaxf(acc[n][2], acc[n][3]));
        mx = fmaxf(mx, __shfl_xor(mx, 16)); mx = fmaxf(mx, __shfl_xor(mx, 32));
        float l = 0.f;
#pragma unroll
        for (int n = 0; n < 16; ++n)
#pragma unroll
            for (int r = 0; r < 4; ++r) { const float pv = __builtin_amdgcn_exp2f(acc[n][r] - mx); acc[n][r] = pv; l += pv; }
        l += __shfl_xor(l, 16); l += __shfl_xor(l, 32);
        const float linv = 1.0f / l;
        bf16x8 pf[8];
#pragma unroll
        for (int s = 0; s < 8; ++s) { v4u w; w.x = pg8::cvt_pk_bf16(acc[2 * s][0], acc[2 * s][1]); w.y = pg8::cvt_pk_bf16(acc[2 * s][2], acc[2 * s][3]);
            w.z = pg8::cvt_pk_bf16(acc[2 * s + 1][0], acc[2 * s + 1][1]); w.w = pg8::cvt_pk_bf16(acc[2 * s + 1][2], acc[2 * s + 1][3]); pf[s] = __builtin_bit_cast(bf16x8, w); }
        __builtin_amdgcn_sched_barrier(0);
        f32x4 o[32];
#pragma unroll
        for (int mm = 0; mm < 32; ++mm) o[mm] = (f32x4){0.f, 0.f, 0.f, 0.f};
#pragma unroll
        for (int cc = 0; cc < 4; ++cc) {
            AT_WAIT();
            if (cc < 3) AT_STAGE_V(cc + 1, (cc + 1) & 1);
            const LAS unsigned char* bb = lds + (cc & 1) * 65536 + aoff0; asm volatile("" : "+v"(bb));
#pragma unroll
            for (int k = 0; k < 2; ++k)
#pragma unroll
                for (int mg = 0; mg < 4; ++mg) { bf16x8 a[8];
#pragma unroll
                    for (int m8 = 0; m8 < 8; ++m8) a[m8] = *(const LAS bf16x8*)(bb + mg * 16384 + m8 * 2048 + k * 1024);
#pragma unroll
                    for (int m8 = 0; m8 < 8; ++m8) o[mg * 8 + m8] = __builtin_amdgcn_mfma_f32_16x16x32_bf16(a[m8], pf[2 * cc + k], o[mg * 8 + m8], 0, 0, 0);
                    __builtin_amdgcn_sched_barrier(0); }
        }
        bf16* op = obuf + tok * 2048 + h * 512 + 4 * fq;
#pragma unroll
        for (int mm = 0; mm < 32; ++mm) { v2u w; w.x = pg8::cvt_pk_bf16(o[mm][0] * linv, o[mm][1] * linv); w.y = pg8::cvt_pk_bf16(o[mm][2] * linv, o[mm][3] * linv); *(v2u*)(op + 16 * mm) = w; }
    }
    asm volatile("s_waitcnt vmcnt(0)" ::: "memory"); __syncthreads();
#undef AT_STAGE_K
#undef AT_STAGE_V
#undef AT_WAIT
}
struct S5Lane { float lbr, lbi; float Br[16], Bi[16]; };
__device__ __forceinline__ void s5_lane_params(int g, int p, S5Lane& L) {
    const float lr = fminf(ka_in(15)[g * 64 + p], -1e-4f), li = ka_in(16)[g * 64 + p], dt = expf(ka_in(17)[g]);
    const float ar = lr * dt, th = li * dt; float sn, cs; sincosf(th, &sn, &cs); const float e = expf(ar), sh = sinf(0.5f * th);
    L.lbr = e * cs; L.lbi = e * sn;
    const float nr = expm1f(ar) * cs - 2.0f * sh * sh, ni = e * sn;
    const float den = 1.0f / (lr * lr + li * li), cr = (nr * lr + ni * li) * den, ci = (ni * lr - nr * li) * den;
#pragma unroll
    for (int c = 0; c < 16; ++c) { const float br = ka_in(18)[(size_t)(g * 64 + p) * 16 + c], bi = ka_in(19)[(size_t)(g * 64 + p) * 16 + c]; L.Br[c] = cr * br - ci * bi; L.Bi[c] = cr * bi + ci * br; }
}
__device__ __forceinline__ void s5_step(const S5Lane& L, const bf16* urow, float& xr, float& xi) {
    const v4u w0 = *(const v4u*)urow, w1 = *(const v4u*)(urow + 8);
    float u[16] = {bflo(w0.x), bfhi(w0.x), bflo(w0.y), bfhi(w0.y), bflo(w0.z), bfhi(w0.z), bflo(w0.w), bfhi(w0.w), bflo(w1.x), bfhi(w1.x), bflo(w1.y), bfhi(w1.y), bflo(w1.z), bfhi(w1.z), bflo(w1.w), bfhi(w1.w)};
    float br = 0.f, bi = 0.f;
#pragma unroll
    for (int c = 0; c < 16; ++c) { br += L.Br[c] * u[c]; bi += L.Bi[c] * u[c]; }
    const float nr = L.lbr * xr - L.lbi * xi + br, ni = L.lbr * xi + L.lbi * xr + bi; xr = nr; xi = ni;
}
__device__ __forceinline__ void s5_pass_a(const bf16* ub, f32x2* st, int wave, int lane) {
    const int gw = blockIdx.x * NWAVES + wave, NGW = gridDim.x * NWAVES;
    for (int task = gw; task < BATCH * 128 * 64; task += NGW) {
        const int seg = task & 63, g = (task >> 6) & 127, b = task >> 13;
        S5Lane L; s5_lane_params(g, lane, L);
        float xr = 0.f, xi = 0.f; const bf16* up = ub + (size_t)(b * SEQ + seg * 64) * 2048 + 16 * g;
#pragma unroll 2
        for (int s = 0; s < 64; ++s) s5_step(L, up + (size_t)s * 2048, xr, xi);
        st[(size_t)task * 64 + lane] = (f32x2){xr, xi};
    }
}
__device__ __forceinline__ void s5_pass_c(LAS unsigned char* lds, const bf16* ub, const f32x2* st, bf16* yb, int wave, int lane) {
    LAS f32x2* Cs = (LAS f32x2*)(lds + wave * 16640);
    LAS f32x2* xs = (LAS f32x2*)(lds + wave * 16640 + 8320);
    const int gw = blockIdx.x * NWAVES + wave, NGW = gridDim.x * NWAVES;
    for (int task = gw; task < BATCH * 128 * 64; task += NGW) {
        const int seg = task & 63, g = (task >> 6) & 127, b = task >> 13;
        S5Lane L; s5_lane_params(g, lane, L);
#pragma unroll
        for (int c = 0; c < 16; ++c) Cs[c * 65 + lane] = (f32x2){ka_in(20)[(size_t)(g * 16 + c) * 64 + lane], ka_in(21)[(size_t)(g * 16 + c) * 64 + lane]};
        float Ar = L.lbr, Ai = L.lbi;
#pragma unroll
        for (int i = 0; i < 6; ++i) { const float nr = Ar * Ar - Ai * Ai, ni = 2.0f * Ar * Ai; Ar = nr; Ai = ni; }
        float xr = 0.f, xi = 0.f; const f32x2* sp = st + (size_t)(task - seg) * 64 + lane;
#pragma unroll 2
        for (int n = 0; n < seg; ++n) { const f32x2 s = sp[(size_t)n * 64]; const float nr = Ar * xr - Ai * xi + s.x, ni = Ar * xi + Ai * xr + s.y; xr = nr; xi = ni; }
        const bf16* up = ub + (size_t)(b * SEQ + seg * 64) * 2048 + 16 * g; bf16* yp = yb + (size_t)(b * SEQ + seg * 64) * 2048 + 16 * g;
        const int t = lane & 15, cq = lane >> 4;
        f32x4 dsk = *(const f32x4*)(ka_in(22) + g * 16 + 4 * cq);
#pragma unroll 1
        for (int blk = 0; blk < 4; ++blk) {
#pragma unroll 2
            for (int s = 0; s < 16; ++s) { s5_step(L, up + (size_t)(blk * 16 + s) * 2048, xr, xi); xs[s * 65 + lane] = (f32x2){xr, xi}; }
            LDS_WAIT();
            float acc[4] = {0.f, 0.f, 0.f, 0.f};
#pragma unroll 4
            for (int p = 0; p < 64; ++p) { const f32x2 x = xs[t * 65 + p];
#pragma unroll
                for (int j = 0; j < 4; ++j) { const f32x2 c = Cs[(4 * cq + j) * 65 + p]; acc[j] += c.x * x.x - c.y * x.y; } }
            const v2u uw = *(const v2u*)(up + (size_t)(blk * 16 + t) * 2048 + 4 * cq);
            const float y0 = gelu_exact(acc[0] + dsk[0] * bflo(uw.x)), y1 = gelu_exact(acc[1] + dsk[1] * bfhi(uw.x)), y2 = gelu_exact(acc[2] + dsk[2] * bflo(uw.y)), y3 = gelu_exact(acc[3] + dsk[3] * bfhi(uw.y));
            v2u ow; ow.x = pk2(y0, y1); ow.y = pk2(y2, y3); *(v2u*)(yp + (size_t)(blk * 16 + t) * 2048 + 4 * cq) = ow;
            LDS_WAIT();
        }
    }
}
__device__ __forceinline__ void s5_mfma(LAS unsigned char* lds, const bf16* ub, bf16* yb, int wave, int lane) {
    LAS f32x2* PW = (LAS f32x2*)(lds);
    LAS f32x2* BB = (LAS f32x2*)(lds + 8704);
    LAS f32x2* CC = (LAS f32x2*)(lds + 16896);
    LAS bf16* KST = (LAS bf16*)(lds + 25088);
    LAS unsigned char* UI = lds + 33280;
    LAS float* SL = (LAS float*)(lds + 66048);
    LAS bf16* XP = (LAS bf16*)(lds + 99840);
    const int tid = wave * 64 + lane, fr = lane & 15, fq = lane >> 4;
    for (int unit = blockIdx.x; unit < 256; unit += gridDim.x) {
        const int b = unit >> 7, g = unit & 127;
        const float dt = expf(ka_in(17)[g]);
        __syncthreads();
        for (int idx = tid; idx < 17 * 64; idx += NTHREADS) { const int e = idx >> 6, p = idx & 63;
            const float lr = fminf(ka_in(15)[g * 64 + p], -1e-4f), li = ka_in(16)[g * 64 + p]; float sn, cs; sincosf(li * dt * (float)e, &sn, &cs); const float ex = expf(lr * dt * (float)e);
            PW[idx] = (f32x2){ex * cs, ex * sn}; }
        for (int idx = tid; idx < 1024; idx += NTHREADS) { const int p = idx >> 4, c = idx & 15;
            const float lr = fminf(ka_in(15)[g * 64 + p], -1e-4f), li = ka_in(16)[g * 64 + p]; const float ar = lr * dt, th = li * dt; float sn, cs; sincosf(th, &sn, &cs); const float e = expf(ar), sh = sinf(0.5f * th);
            const float nr = expm1f(ar) * cs - 2.0f * sh * sh, ni = e * sn, den = 1.0f / (lr * lr + li * li), cr = (nr * lr + ni * li) * den, ci = (ni * lr - nr * li) * den;
            const float br = ka_in(18)[(size_t)(g * 64 + p) * 16 + c], bi = ka_in(19)[(size_t)(g * 64 + p) * 16 + c];
            BB[idx] = (f32x2){cr * br - ci * bi, cr * bi + ci * br};
            CC[idx] = (f32x2){ka_in(20)[(size_t)g * 1024 + idx], ka_in(21)[(size_t)g * 1024 + idx]}; }
        __syncthreads();
        bf16x8 A1[8];
        { const int ri = wave >> 2, p = 16 * (wave & 3) + fr;
#pragma unroll
            for (int ks = 0; ks < 8; ++ks) { const int s = 2 * ks + (fq >> 1); const f32x2 pw = PW[(15 - s) * 64 + p]; float v[8];
#pragma unroll
                for (int j = 0; j < 8; ++j) { const f32x2 bb = BB[p * 16 + 8 * (fq & 1) + j]; v[j] = ri ? (pw.x * bb.y + pw.y * bb.x) : (pw.x * bb.x - pw.y * bb.y); }
                v4u w; w.x = pk2(v[0], v[1]); w.y = pk2(v[2], v[3]); w.z = pk2(v[4], v[5]); w.w = pk2(v[6], v[7]); A1[ks] = __builtin_bit_cast(bf16x8, w); } }
        const int t0 = wave, t1 = 15 - wave;
        bf16x8 CM[2][4];
#pragma unroll
        for (int ti = 0; ti < 2; ++ti) { const int t = ti ? t1 : t0;
#pragma unroll
            for (int ks = 0; ks < 4; ++ks) { float v[8];
#pragma unroll
                for (int j = 0; j < 8; ++j) { const int p = 32 * (ks & 1) + 8 * fq + j; const f32x2 c = CC[fr * 64 + p], pw = PW[(t + 1) * 64 + p];
                    v[j] = (ks >> 1) ? -(c.x * pw.y + c.y * pw.x) : (c.x * pw.x - c.y * pw.y); }
                v4u w; w.x = pk2(v[0], v[1]); w.y = pk2(v[2], v[3]); w.z = pk2(v[4], v[5]); w.w = pk2(v[6], v[7]); CM[ti][ks] = __builtin_bit_cast(bf16x8, w); } }
        { bf16x8 ct[4];
#pragma unroll
            for (int ks = 0; ks < 4; ++ks) { float v[8];
#pragma unroll
                for (int j = 0; j < 8; ++j) { const f32x2 c = CC[fr * 64 + 32 * (ks & 1) + 8 * fq + j]; v[j] = (ks >> 1) ? -c.y : c.x; }
                v4u w; w.x = pk2(v[0], v[1]); w.y = pk2(v[2], v[3]); w.z = pk2(v[4], v[5]); w.w = pk2(v[6], v[7]); ct[ks] = __builtin_bit_cast(bf16x8, w); }
#pragma unroll
            for (int si = 0; si < 2; ++si) { const int s = 2 * wave + si; f32x4 kacc = (f32x4){0.f, 0.f, 0.f, 0.f};
#pragma unroll
                for (int ks = 0; ks < 4; ++ks) { float v[8];
#pragma unroll
                    for (int j = 0; j < 8; ++j) { const int p = 32 * (ks & 1) + 8 * fq + j; const f32x2 pw = PW[(15 - s) * 64 + p], bb = BB[p * 16 + fr];
                        v[j] = (ks >> 1) ? (pw.x * bb.y + pw.y * bb.x) : (pw.x * bb.x - pw.y * bb.y); }
                    v4u w; w.x = pk2(v[0], v[1]); w.y = pk2(v[2], v[3]); w.z = pk2(v[4], v[5]); w.w = pk2(v[6], v[7]);
                    kacc = __builtin_amdgcn_mfma_f32_16x16x32_bf16(__builtin_bit_cast(bf16x8, w), ct[ks], kacc, 0, 0, 0); }
                v2u kw; kw.x = pk2(kacc[0], kacc[1]); kw.y = pk2(kacc[2], kacc[3]);
                *(LAS v2u*)(KST + ((15 - s) * 16 + fr) * 16 + 4 * fq) = kw; } }
        const f32x4 dsk = *(const f32x4*)(ka_in(22) + g * 16 + 4 * fq);
        float Xr = 0.f, Xi = 0.f;
#pragma unroll 1
        for (int q = 0; q < 4; ++q) {
            __syncthreads();
            { const bf16* src0 = ub + (size_t)(b * SEQ + q * 1024) * 2048 + 16 * g;
#pragma unroll
                for (int i = 0; i < 4; ++i) { const int piece = tid + NTHREADS * i, tok = piece >> 1, half = piece & 1;
                    const v4u w = *(const v4u*)(src0 + (size_t)tok * 2048 + 8 * half);
                    *(LAS v4u*)(UI + ((((tok & 15) * 64 + (tok >> 4)) * 2 + half) * 16)) = w; } }
            __syncthreads();
#pragma unroll 1
            for (int nf = 0; nf < 4; ++nf) { f32x4 acc = (f32x4){0.f, 0.f, 0.f, 0.f};
#pragma unroll
                for (int ks = 0; ks < 8; ++ks) { const bf16x8 bfr = *(const LAS bf16x8*)(UI + ((((2 * ks + (fq >> 1)) * 64 + 16 * nf + fr) * 2 + (fq & 1)) * 16));
                    acc = __builtin_amdgcn_mfma_f32_16x16x32_bf16(A1[ks], bfr, acc, 0, 0, 0); }
                *(LAS f32x4*)(SL + (16 * nf + fr) * 132 + 16 * wave + 4 * fq) = acc; }
            __syncthreads();
            if (wave == 0) { const f32x2 a16 = PW[16 * 64 + lane];
#pragma unroll 4
                for (int n = 0; n < 64; ++n) { XP[n * 136 + lane] = (bf16)f2bf(Xr); XP[n * 136 + 64 + lane] = (bf16)f2bf(Xi);
                    const float sr = SL[n * 132 + lane], si = SL[n * 132 + 64 + lane];
                    const float nr = a16.x * Xr - a16.y * Xi + sr, ni = a16.x * Xi + a16.y * Xr + si; Xr = nr; Xi = ni; } }
            __syncthreads();
#pragma unroll 1
            for (int nf = 0; nf < 4; ++nf) { f32x4 acc0 = (f32x4){0.f, 0.f, 0.f, 0.f}, acc1 = acc0;
#pragma unroll
                for (int ks = 0; ks < 8; ++ks) { if (2 * ks <= t1 || 2 * ks <= t0) {
                    const int s = 2 * ks + (fq >> 1);
                    const bf16x8 bfr = *(const LAS bf16x8*)(UI + (((s * 64 + 16 * nf + fr) * 2 + (fq & 1)) * 16));
                    if (2 * ks <= t0) { bf16x8 tf = (bf16x8){0, 0, 0, 0, 0, 0, 0, 0}; if (s <= t0) tf = *(const LAS bf16x8*)(KST + ((t0 - s) * 16 + fr) * 16 + 8 * (fq & 1)); acc0 = __builtin_amdgcn_mfma_f32_16x16x32_bf16(tf, bfr, acc0, 0, 0, 0); }
                    if (2 * ks <= t1) { bf16x8 tf = (bf16x8){0, 0, 0, 0, 0, 0, 0, 0}; if (s <= t1) tf = *(const LAS bf16x8*)(KST + ((t1 - s) * 16 + fr) * 16 + 8 * (fq & 1)); acc1 = __builtin_amdgcn_mfma_f32_16x16x32_bf16(tf, bfr, acc1, 0, 0, 0); } } }
#pragma unroll
                for (int ks = 0; ks < 4; ++ks) { const bf16x8 xf = *(const LAS bf16x8*)(XP + (16 * nf + fr) * 136 + 32 * ks + 8 * fq);
                    acc0 = __builtin_amdgcn_mfma_f32_16x16x32_bf16(CM[0][ks], xf, acc0, 0, 0, 0); acc1 = __builtin_amdgcn_mfma_f32_16x16x32_bf16(CM[1][ks], xf, acc1, 0, 0, 0); }
#pragma unroll
                for (int ti = 0; ti < 2; ++ti) { const int t = ti ? t1 : t0; const f32x4 a = ti ? acc1 : acc0; const int n = 16 * nf + fr;
                    const v2u uw = *(const LAS v2u*)(UI + (((t * 64 + n) * 2 + (fq >> 1)) * 16) + 8 * (fq & 1));
                    const pg8::f32x2 g0 = pg8::gelu_pk((pg8::f32x2){a[0] + dsk[0] * bflo(uw.x), a[1] + dsk[1] * bfhi(uw.x)}), g1 = pg8::gelu_pk((pg8::f32x2){a[2] + dsk[2] * bflo(uw.y), a[3] + dsk[3] * bfhi(uw.y)});
                    v2u ow; ow.x = pg8::cvt_pk_bf16(g0.x, g0.y); ow.y = pg8::cvt_pk_bf16(g1.x, g1.y);
                    *(v2u*)(yb + (size_t)(b * SEQ + q * 1024 + 16 * n + t) * 2048 + 16 * g + 4 * fq) = ow; } }
        }
    }
    __syncthreads();
}
#ifndef EN
#define EN(k) 1
#endif
template <int PH> __device__ __forceinline__ void run_phase(unsigned char* ws, float* X, LAS unsigned char* lds, int wave, int lane) {
    const int G = gridDim.x, bx = blockIdx.x;
    bf16* XB = (bf16*)(ws + WS_XB); float* SSQ = (float*)(ws + WS_SSQ);
    bf16* R0 = (bf16*)(ws + WS_R);
    constexpr int layer = (PH >= 10) ? 1 : 0;
    if constexpr (!EN(PH)) { return; }
    else if constexpr (PH == 0) p0_prologue(ws, lds, wave, lane);
    else if constexpr (PH == 1) {
        if (bx < 64) { const int i = bx >> 5;
            pg8::Gemm g{(const pg8::bf16_t*)(ws + WS_MEMB), (const pg8::bf16_t*)(ws + WS_W_KV + (size_t)i * 16 * MiB), MROWS, 4096, 2048}; pg8::StaticOrder S; S.init(MROWS, 4096, 32, bx & 31);
            pg8::EpiKV E{(pg8::bf16_t*)(ws + WS_KB + (size_t)i * 2 * MiB), (pg8::bf16_t*)(ws + WS_VB + (size_t)i * 2 * MiB), (pg8::bf16_t*)(ws + WS_VTB + (size_t)i * 2 * MiB), (const float*)(ws + WS_SSQM)};
            pg8::gemm_phase<pg8::EpiKV, pg8::StaticOrder, true, PG8_SP2V>(lds, g, S, E, wave, lane); }
        p1_convert(ws, lds, wave, lane);
    } else if constexpr (PH == 2) {
        pg8::Gemm g{XB, (const pg8::bf16_t*)(ws + WS_W_AIN), M, 4096, 2048}; pg8::StaticOrder S; S.init(M, 4096, G, bx);
        pg8::EpiAct<1, true> E{R0, 4096, ka_in(8), SSQ, 32, 1.0f, (float*)(ws + WS_VST), 8};
        pg8::gemm_phase<pg8::EpiAct<1, true>, pg8::StaticOrder, true, PG8_SP2V>(lds, g, S, E, wave, lane);
    } else if constexpr (PH == 3) {
#if defined(GATING_SIMPLE)
        gating_simple(lds, R0, (const float*)(ws + WS_VST), ka_in(9), ka_in(10), ka_in(11), ka_in(12), R0 + (size_t)M * 4096, wave * 64 + lane);
#else
        gating_mfma(lds, R0, (const float*)(ws + WS_VST), ka_in(9), ka_in(10), ka_in(11), ka_in(12), R0 + (size_t)M * 4096, wave, lane);
#endif
    }
    else if constexpr (PH == 4 || PH == 7 || PH == 9 || PH == 16 || PH == 18) {
        const pg8::bf16_t* A; const pg8::bf16_t* W; int K = 2048;
        if constexpr (PH == 4) { A = R0 + (size_t)M * 4096; W = (const pg8::bf16_t*)(ws + WS_W_AOUT); }
        else if constexpr (PH == 7 || PH == 16) { A = R0 + (size_t)M * 2048; W = (const pg8::bf16_t*)(ws + WS_W_O + (size_t)layer * 8 * MiB); }
        else { A = R0; W = (const pg8::bf16_t*)(ws + WS_W_DN + (size_t)layer * 32 * MiB); K = 8192; }
        pg8::Gemm g{A, W, M, 2048, K}; pg8::StaticOrder S; S.init(M, 2048, G, bx);
        pg8::EpiRes E{XB, SSQ};
        pg8::gemm_phase<pg8::EpiRes, pg8::StaticOrder, true, PG8_SP2V>(lds, g, S, E, wave, lane);
    } else if constexpr (PH == 5 || PH == 14 || PH == 10) {
        const pg8::bf16_t* W = (PH == 10) ? (const pg8::bf16_t*)(ws + WS_W_BIN) : (const pg8::bf16_t*)(ws + WS_W_Q + (size_t)layer * 8 * MiB);
        pg8::Gemm g{XB, W, M, 2048, 2048}; pg8::StaticOrder S; S.init(M, 2048, G, bx);
        pg8::EpiAct<0, false> E{R0, 2048, nullptr, SSQ, (PH == 14) ? 64 : 32, (PH == 10) ? 1.0f : 0.044194173824159216f * 1.4426950408889634f, nullptr, 0};
        pg8::gemm_phase<pg8::EpiAct<0, false>, pg8::StaticOrder, true, PG8_SP2V>(lds, g, S, E, wave, lane);
    } else if constexpr (PH == 6 || PH == 15) {
#if defined(ATTN_SIMPLE)
        attn_simple(lds, R0, (const bf16*)(ws + WS_KB + (size_t)layer * 2 * MiB), (const bf16*)(ws + WS_VB + (size_t)layer * 2 * MiB), R0 + (size_t)M * 2048, wave, lane);
#else
        attn_mfma(lds, R0, (const bf16*)(ws + WS_KB + (size_t)layer * 2 * MiB), (const bf16*)(ws + WS_VTB + (size_t)layer * 2 * MiB), R0 + (size_t)M * 2048, wave, lane);
#endif
    }
    else if constexpr (PH == 8 || PH == 17) {
        pg8::Gemm g{XB, (const pg8::bf16_t*)(ws + WS_W_UP + (size_t)layer * 32 * MiB), M, FF, 2048}; pg8::StaticOrder S; S.init(M, FF, G, bx);
        pg8::EpiAct<2, false> E{R0, FF, nullptr, SSQ, 32, 1.0f, nullptr, 0};
        pg8::gemm_phase<pg8::EpiAct<2, false>, pg8::StaticOrder, true, PG8_SP2V>(lds, g, S, E, wave, lane);
    } else if constexpr (PH == 11) {
#if defined(S5_SIMPLE)
        s5_pass_a(R0, (f32x2*)(ws + WS_S5ST), wave, lane);
#endif
    } else if constexpr (PH == 12) {
#if defined(S5_SIMPLE)
        s5_pass_c(lds, R0, (const f32x2*)(ws + WS_S5ST), R0 + (size_t)M * 2048, wave, lane);
#else
        s5_mfma(lds, R0, R0 + (size_t)M * 2048, wave, lane);
#endif
    }
    else if constexpr (PH == 13) {
        pg8::Gemm g{R0 + (size_t)M * 2048, (const pg8::bf16_t*)(ws + WS_W_BOUT), M, 4096, 2048}; pg8::StaticOrder S; S.init(M, 4096, G, bx);
        pg8::EpiGlu E{XB, SSQ, ka_in(24)};
        pg8::gemm_phase<pg8::EpiGlu, pg8::StaticOrder, true, PG8_SP2V>(lds, g, S, E, wave, lane);
    } else if constexpr (PH == 19) final_norm(XB, SSQ, ka_in(6), X, wave, lane);
}
__device__ __forceinline__ int lane_id() { int l; asm volatile("v_mbcnt_lo_u32_b32 %0, -1, 0\n\tv_mbcnt_hi_u32_b32 %0, -1, %0" : "=v"(l)); return l; }

#define XB_TMO      128
#define XB_XCNT(j)  (256  + 64 * (j))
#define XB_XSUB(j)  (1280 + 64 * (j))
#define XB_XGEN(j)  (2304 + 64 * (j))
#define XB_TOP      3328
#define XB_TOPGEN   3392
#define XCD_BAR_WORDS 3456
#define XB_SPIN_CAP (1u << 22)
__device__ __forceinline__ unsigned xb_ld(unsigned* p)              { return __hip_atomic_load(p, __ATOMIC_RELAXED, __HIP_MEMORY_SCOPE_AGENT); }
__device__ __forceinline__ unsigned xb_add(unsigned* p, unsigned v) { return __hip_atomic_fetch_add(p, v, __ATOMIC_RELAXED, __HIP_MEMORY_SCOPE_AGENT); }
__device__ __forceinline__ unsigned xb_xcc_id() { return (unsigned)__builtin_amdgcn_s_getreg((3 << 11) | 20) & 0xFu; }
#define XB_SPIN(cond, bar) do { unsigned _sp = 0; while (cond) { __builtin_amdgcn_s_sleep(1); \
    if ((++_sp & 255u) == 0u) { if (xb_ld(&(bar)[XB_TMO])) break; if (_sp > XB_SPIN_CAP) { atomicAdd(&(bar)[XB_TMO], 1u); break; } } } } while (0)
__device__ __forceinline__ void xcd_barrier_complete(unsigned* bar, unsigned x, unsigned& nloc, unsigned& nx) {
    const unsigned G = gridDim.x * gridDim.y * gridDim.z;
    unsigned sum, cnt, mine, sp = 0u;
    for (;;) {
        sum = 0u; cnt = 0u; mine = 0u;
#pragma unroll
        for (unsigned j = 0; j < 16; ++j) { const unsigned c = xb_ld(&bar[XB_XCNT(j)]); sum += c; cnt += (c > 0u) ? 1u : 0u; mine = (j == x) ? c : mine; }
        if (sum == G) break;
        __builtin_amdgcn_s_sleep(1);
        if ((++sp & 255u) == 0u) { if (xb_ld(&bar[XB_TMO])) break; if (sp > XB_SPIN_CAP) { atomicAdd(&bar[XB_TMO], 1u); break; } }
    }
    nloc = mine > 0u ? mine : 1u; nx = cnt > 0u ? cnt : 1u;
}
__device__ __forceinline__ void xcd_barrier(unsigned* bar, volatile LAS unsigned* st, bool is_t0) {
    asm volatile("s_waitcnt vmcnt(0)" ::: "memory");
    __syncthreads();
    if (is_t0) {
        __builtin_amdgcn_s_waitcnt(0);
        const unsigned x = xb_xcc_id();
        unsigned nloc = st[0], nx = st[1];
        if (nloc == 0u) { xcd_barrier_complete(bar, x, nloc, nx); st[0] = nloc; st[1] = nx; }
        const unsigned old = xb_add(&bar[XB_XSUB(x)], 1u);
        const unsigned gen = old / nloc;
        if (old + 1u == (gen + 1u) * nloc) {
            __builtin_amdgcn_fence(__ATOMIC_RELEASE, "agent");
            asm volatile("s_waitcnt vmcnt(0)" ::: "memory");
            const unsigned og = xb_add(&bar[XB_TOP], 1u);
            const unsigned tg = og / nx;
            if (og + 1u == (tg + 1u) * nx) xb_add(&bar[XB_TOPGEN], 1u);
            else XB_SPIN(xb_ld(&bar[XB_TOPGEN]) == tg, bar);
            __builtin_amdgcn_fence(__ATOMIC_ACQUIRE, "agent");
            xb_add(&bar[XB_XGEN(x)], 1u);
            asm volatile("s_waitcnt vmcnt(0)" ::: "memory");
        } else {
            XB_SPIN(xb_ld(&bar[XB_XGEN(x)]) == gen, bar);
            __builtin_amdgcn_fence(__ATOMIC_ACQUIRE, "agent");
            asm volatile("s_waitcnt vmcnt(0)" ::: "memory");
        }
    }
    __syncthreads();
}

__global__ void __launch_bounds__(NTHREADS, 2) trunk_fwd(Args args) {
    extern __shared__ __attribute__((aligned(16))) unsigned char lds_raw[];
    LAS unsigned char* lds = (LAS unsigned char*)lds_raw;
    const int wave = __builtin_amdgcn_readfirstlane((int)threadIdx.x >> 6);
    const int lo = args.ph_lo, hi = args.ph_hi;
    unsigned* bar = (unsigned*)args.ws + 4096;
    volatile LAS unsigned* st = (volatile LAS unsigned*)(lds + LDS_BYTES - 64);
#if MK_N_LAUNCHES == 1
    { const int l0 = lane_id(); if (wave == 0 && l0 < 2) st[l0] = 0u; __syncthreads(); if (wave == 0 && l0 == 0) (void)xb_add(&bar[XB_XCNT(xb_xcc_id())], 1u); }
#if defined(USE_CG_SYNC)
#define GRID_BAR(k) do { if ((k) == 1) cg::this_grid().sync(); else xcd_barrier(bar, st, wave == 0 && lane_id() == 0); } while (0)
#else
#define GRID_BAR(k) do { xcd_barrier(bar, st, wave == 0 && lane_id() == 0); } while (0)
#endif
#else
#define GRID_BAR(k) do { } while (0)
#endif
#ifndef DUP_PH
#define DUP_PH -1
#endif
#if defined(PROBE_GEMM)
#if PROBE_GEMM == 3
typedef pg8::StaticOrder ProbeOrder;
#else
struct ProbeOrder { int c;
    __device__ __forceinline__ void init(int, int, int, int c_) { c = c_; }
    __device__ __forceinline__ bool next(int i, pg8::Unit& u) const { if (i >= 4) return false;
#if PROBE_GEMM == 1
        u.pm = 0; u.pn = 0;
#else
        u.pm = c >> 3; u.pn = c & 7;
#endif
        return true; }
    __device__ __forceinline__ void a_ready(const pg8::Unit&) const {}
    __device__ __forceinline__ void done(const pg8::Unit&) const {} };
#endif
#endif
#if defined(STAMP_SEL)
#define STAMP(k) do { if (blockIdx.x == 0 && wave == 0 && lane_id() == 0) st[4 + (k)] = (unsigned)__builtin_amdgcn_s_memrealtime(); } while (0)
#else
#define STAMP(k) do { } while (0)
#endif
#define PHASE(k) if (lo <= (k) && (k) < hi) { if ((k) > lo) GRID_BAR(k); STAMP(k); run_phase<k>(args.ws, args.out, lds, wave, lane_id()); if ((k) == DUP_PH) { GRID_BAR(2); run_phase<k>(args.ws, args.out, lds, wave, lane_id()); } }
    PHASE(0) PHASE(1) PHASE(2) PHASE(3) PHASE(4) PHASE(5) PHASE(6) PHASE(7) PHASE(8) PHASE(9)
#if defined(PROBE_GEMM)
    { GRID_BAR(2); const int lane = lane_id(); unsigned char* ws = args.ws; bf16* R0 = (bf16*)(ws + WS_R);
      pg8::Gemm g{(bf16*)(ws + WS_XB), (const pg8::bf16_t*)(ws + WS_W_UP), M, FF, 2048}; ProbeOrder S; S.init(M, FF, gridDim.x, blockIdx.x);
      pg8::EpiAct<2, false> E{R0, FF, nullptr, (float*)(ws + WS_SSQ), 32, 1.0f, nullptr, 0};
      pg8::gemm_phase<pg8::EpiAct<2, false>, ProbeOrder, true, true>(lds, g, S, E, wave, lane); }
#endif
    PHASE(10)
#if defined(S5_SIMPLE)
    PHASE(11)
#endif
    PHASE(12) PHASE(13) PHASE(14) PHASE(15) PHASE(16) PHASE(17) PHASE(18) PHASE(19)
#undef PHASE
#if defined(STAMP_SEL)
    asm volatile("s_waitcnt vmcnt(0)" ::: "memory"); __syncthreads(); STAMP(20);
    if (blockIdx.x == 0 && wave == 0 && lane_id() == 0) { const unsigned d = (st[4 + STAMP_SEL_END] - st[4 + STAMP_SEL]) * STAMP_MUL; const unsigned t0 = (unsigned)__builtin_amdgcn_s_memrealtime();
        while ((unsigned)__builtin_amdgcn_s_memrealtime() - t0 < d) __builtin_amdgcn_s_sleep(8); }
#endif
}

extern "C" void kernel_launch(void* const* d_in, const int* in_sizes, int n_in, void* d_out, int out_size, void* d_ws, size_t ws_size, hipStream_t stream) {
    static int grid = 0;
    if (grid == 0) {
        if (n_in != 30 || out_size != M * D || ws_size < WS_END) { fprintf(stderr, "kernel_launch: unexpected shapes (n_in %d out %d ws %zu)\n", n_in, out_size, ws_size); grid = -1; return; }
        int dev = 0, cus = 0, per_cu = 0;
        if (hipGetDevice(&dev) != hipSuccess || hipDeviceGetAttribute(&cus, hipDeviceAttributeMultiprocessorCount, dev) != hipSuccess) { grid = -1; return; }
        if (hipFuncSetAttribute((const void*)trunk_fwd, hipFuncAttributeMaxDynamicSharedMemorySize, LDS_BYTES) != hipSuccess) { fprintf(stderr, "kernel_launch: hipFuncSetAttribute failed\n"); grid = -1; return; }
        if (hipOccupancyMaxActiveBlocksPerMultiprocessor(&per_cu, (const void*)trunk_fwd, NTHREADS, LDS_BYTES) != hipSuccess || per_cu < 1) { fprintf(stderr, "kernel_launch: occupancy query says %d\n", per_cu); grid = -1; return; }
        grid = cus;
    }
    if (grid < 0) return;
    if (hipMemsetAsync(d_ws, 0, 65536, stream) != hipSuccess) { fprintf(stderr, "kernel_launch: memset failed\n"); return; }
    Args a{};
    for (int i = 0; i < 30; ++i) a.in[i] = (const float*)d_in[i];
    a.out = (float*)d_out; a.ws = (unsigned char*)d_ws;
#if MK_N_LAUNCHES == 1
    a.ph_lo = 0; a.ph_hi = NPH;
    void* kargs[] = {&a};
    hipError_t e = hipLaunchCooperativeKernel((const void*)trunk_fwd, dim3(grid), dim3(NTHREADS), kargs, LDS_BYTES, stream);
    if (e != hipSuccess) fprintf(stderr, "kernel_launch: cooperative launch failed: %s\n", hipGetErrorString(e));
#else
    for (int ph = 0; ph < NPH; ++ph) { a.ph_lo = ph; a.ph_hi = ph + 1; hipLaunchKernelGGL(trunk_fwd, dim3(grid), dim3(NTHREADS), LDS_BYTES, stream, a); }
#endif
}
```

```cpp
#include <hip/hip_runtime.h>
#include <hip/hip_cooperative_groups.h>
#include <cstdio>
#include <cstdint>
namespace cg = cooperative_groups;
#define MK_N_LAUNCHES 1
#define PG8_SP2V true

namespace pg8 {
#define PG8_LAS __attribute__((address_space(3)))
typedef unsigned short bf16_t;
typedef short bf16x8 __attribute__((ext_vector_type(8)));
typedef float f32x4 __attribute__((ext_vector_type(4)));
typedef unsigned u32x4 __attribute__((ext_vector_type(4)));
constexpr int BM = 256, BK = 64, HALF = 128, HTB = HALF * BK * 2  , STAGE_BYTES = 8 * HTB, NXCD = 8, WGM = 8;

__host__ __device__ __forceinline__ int lds_byte(int r, int c) { const int st = (r >> 4) * 2 + (c >> 5), rr = r & 15, cc = c & 31, ob = rr * 64 + cc * 2; return st * 1024 + (ob ^ (((ob >> 9) & 1) << 5)); }
__host__ __device__ __forceinline__ void stage_rc(int b, int& R, int& C) { const int st = b / 1024, sb = b % 1024, swz = sb ^ (((sb >> 9) & 1) << 5); R = (st >> 1) * 16 + swz / 64; C = (st & 1) * 32 + (swz % 64) / 2; }
__host__ __device__ __forceinline__ int perm32(int rho) { const int n = rho >> 4, i = rho & 15; return 8 * (i >> 2) + 4 * n + (i & 3); }

struct Unit { int pm, pn; };
struct Gemm { const bf16_t* A; const bf16_t* Bt; int M, N, K; };

struct StaticOrder {
    int nM, nN, nwg, G, c;
    __host__ __device__ void init(int M, int N, int G_, int c_) { nM = M / BM; nN = N / BM; nwg = nM * nN; G = G_; c = c_; }
    __host__ __device__ bool next(int i, Unit& u) const {
        const long L = (long)i * G + c; if (L >= nwg) return false;
        int wgid = (int)L; { const int q = nwg / NXCD, r = nwg % NXCD, xcd = wgid % NXCD, off = wgid / NXCD; wgid = (xcd < r ? xcd * (q + 1) : r * (q + 1) + (xcd - r) * q) + off; }
        const int nig = WGM * nN, gid = wgid / nig, fm = gid * WGM, gsz = (nM - fm) < WGM ? (nM - fm) : WGM;
        u.pm = fm + ((wgid % nig) % gsz); u.pn = (wgid % nig) / gsz; return true;
    }
    __device__ __forceinline__ void a_ready(const Unit&) const {}
    __device__ __forceinline__ void done(const Unit&) const {}
};

__device__ __forceinline__ unsigned cvt_pk_bf16(float lo, float hi) { unsigned r; asm volatile("v_cvt_pk_bf16_f32 %0, %1, %2" : "=v"(r) : "v"(lo), "v"(hi)); return r; }
typedef float f32x2 __attribute__((ext_vector_type(2)));
__device__ __forceinline__ f32x2 gelu_pk(f32x2 v) {
    const f32x2 av = __builtin_elementwise_abs(v), d = av * 0.2316418882f + 1.0f;
    f32x2 t; t.x = __builtin_amdgcn_rcpf(d.x); t.y = __builtin_amdgcn_rcpf(d.y);
    f32x2 q = t * 0.5307027145f + (-0.7265760135f); q = q * t + 0.7107068705f; q = q * t + (-0.142248368f); q = q * t + 0.127414796f; q = q * t;
    const f32x2 s = (v * v) * (-0.72134752044f);
    f32x2 e; e.x = __builtin_amdgcn_exp2f(s.x); e.y = __builtin_amdgcn_exp2f(s.y);
    const f32x2 m = v * (q * e), r = v - m;
    f32x2 o; o.x = v.x < 0.f ? m.x : r.x; o.y = v.y < 0.f ? m.y : r.y; return o;
}
typedef unsigned u32x2 __attribute__((ext_vector_type(2)));
constexpr int SSQ_STRIDE = 64;
__device__ __forceinline__ float row_rstd(const float* ssq, int np, int row, int fq) {
    const float* p = ssq + (size_t)row * SSQ_STRIDE + fq * (np >> 2);
    f32x4 a = *(const f32x4*)p, b = *(const f32x4*)(p + 4);
    float s = (a[0] + a[1]) + (a[2] + a[3]) + (b[0] + b[1]) + (b[2] + b[3]);
    if (np == 64) { f32x4 c = *(const f32x4*)(p + 8), d = *(const f32x4*)(p + 12); s += (c[0] + c[1]) + (c[2] + c[3]) + (d[0] + d[1]) + (d[2] + d[3]); }
    s += __shfl_xor(s, 16); s += __shfl_xor(s, 32);
    return __builtin_amdgcn_rsqf(s * (1.0f / 2048.0f) + 1e-6f);
}
template <int ACT, bool STATS> struct EpiAct {
    static constexpr bool PERM = true, AFTER_DRAIN = false;
    bf16_t* O; int ldc; const float* bias; const float* ssq; int np; float oscale; float* vst; int stat_pn0;
    __device__ __forceinline__ void operator()(const f32x4 (&acc)[2][2][4][2], const Unit& u, int wr, int wc, int fr, int fq) const {
        const int row0 = u.pm * BM + wr * 64 + fr, col0 = u.pn * BM + wc * 32 + 8 * fq;
        f32x4 bv[2][2];
#pragma unroll
        for (int bj = 0; bj < 2; ++bj)
#pragma unroll
            for (int n = 0; n < 2; ++n) bv[bj][n] = bias ? *(const f32x4*)(bias + col0 + bj * HALF + 4 * n) : (f32x4){0.f, 0.f, 0.f, 0.f};
        float rsv[2][4];
#pragma unroll
        for (int ai = 0; ai < 2; ++ai) {
#pragma unroll
            for (int m = 0; m < 4; ++m) rsv[ai][m] = row_rstd(ssq, np, row0 + ai * HALF + m * 16, fq); }
#pragma unroll
        for (int ai = 0; ai < 2; ++ai)
#pragma unroll
            for (int m = 0; m < 4; ++m) { const int row = row0 + ai * HALF + m * 16; const float rs = rsv[ai][m];
                bf16_t* rowp = O + (size_t)row * ldc + col0; float s1 = 0.f, s2 = 0.f;
#pragma unroll
                for (int bj = 0; bj < 2; ++bj) { f32x4 v0 = acc[ai][bj][m][0] * rs + bv[bj][0], v1 = acc[ai][bj][m][1] * rs + bv[bj][1];
                    if (ACT == 1) { f32x2 a = gelu_pk((f32x2){v0[0], v0[1]}), b = gelu_pk((f32x2){v0[2], v0[3]}), c = gelu_pk((f32x2){v1[0], v1[1]}), d = gelu_pk((f32x2){v1[2], v1[3]});
                        v0 = (f32x4){a.x, a.y, b.x, b.y}; v1 = (f32x4){c.x, c.y, d.x, d.y}; }
                    if (ACT == 2) {
#pragma unroll
                        for (int j = 0; j < 4; ++j) { const float a = fmaxf(v0[j], 0.f), b = fmaxf(v1[j], 0.f); v0[j] = a * a; v1[j] = b * b; } }
                    v0 = v0 * oscale; v1 = v1 * oscale;
                    if (STATS) { s1 += (v0[0] + v0[1]) + (v0[2] + v0[3]) + (v1[0] + v1[1]) + (v1[2] + v1[3]);
                        s2 += (v0[0] * v0[0] + v0[1] * v0[1]) + (v0[2] * v0[2] + v0[3] * v0[3]) + (v1[0] * v1[0] + v1[1] * v1[1]) + (v1[2] * v1[2] + v1[3] * v1[3]); }
                    u32x4 w; w.x = cvt_pk_bf16(v0[0], v0[1]); w.y = cvt_pk_bf16(v0[2], v0[3]); w.z = cvt_pk_bf16(v1[0], v1[1]); w.w = cvt_pk_bf16(v1[2], v1[3]);
                    *(u32x4*)(rowp + bj * HALF) = w; }
                if (STATS) { s1 += __shfl_xor(s1, 16); s1 += __shfl_xor(s1, 32); s2 += __shfl_xor(s2, 16); s2 += __shfl_xor(s2, 32);
                    if (u.pn >= stat_pn0 && fq == 0) *(f32x2*)(vst + (size_t)row * SSQ_STRIDE + ((u.pn - stat_pn0) * 4 + wc) * 2) = (f32x2){s1, s2}; }
            }
    }
};
struct EpiRes {
    static constexpr bool PERM = true, AFTER_DRAIN = false;
    bf16_t* xb; float* ssq;
    __device__ __forceinline__ void operator()(const f32x4 (&acc)[2][2][4][2], const Unit& u, int wr, int wc, int fr, int fq) const {
        const int row0 = u.pm * BM + wr * 64 + fr, col0 = u.pn * BM + wc * 32 + 8 * fq;
#pragma unroll
        for (int ai = 0; ai < 2; ++ai) {
            u32x4 pre[4][2];
#pragma unroll
            for (int m = 0; m < 4; ++m) { const size_t off = (size_t)(row0 + ai * HALF + m * 16) * 2048 + col0;
#pragma unroll
                for (int bj = 0; bj < 2; ++bj) pre[m][bj] = *(const u32x4*)(xb + off + bj * HALF); }
            asm volatile("" ::: "memory");
#pragma unroll
            for (int m = 0; m < 4; ++m) { const int row = row0 + ai * HALF + m * 16; const size_t off = (size_t)row * 2048 + col0; float ss = 0.f;
#pragma unroll
                for (int bj = 0; bj < 2; ++bj) { const u32x4 b = pre[m][bj]; const f32x4 a0 = acc[ai][bj][m][0], a1 = acc[ai][bj][m][1];
                    const float o0 = __builtin_bit_cast(float, b.x << 16) + a0[0], o1 = __builtin_bit_cast(float, b.x & 0xffff0000u) + a0[1], o2 = __builtin_bit_cast(float, b.y << 16) + a0[2], o3 = __builtin_bit_cast(float, b.y & 0xffff0000u) + a0[3];
                    const float o4 = __builtin_bit_cast(float, b.z << 16) + a1[0], o5 = __builtin_bit_cast(float, b.z & 0xffff0000u) + a1[1], o6 = __builtin_bit_cast(float, b.w << 16) + a1[2], o7 = __builtin_bit_cast(float, b.w & 0xffff0000u) + a1[3];
                    ss += (o0 * o0 + o1 * o1) + (o2 * o2 + o3 * o3) + (o4 * o4 + o5 * o5) + (o6 * o6 + o7 * o7);
                    u32x4 w; w.x = cvt_pk_bf16(o0, o1); w.y = cvt_pk_bf16(o2, o3); w.z = cvt_pk_bf16(o4, o5); w.w = cvt_pk_bf16(o6, o7); *(u32x4*)(xb + off + bj * HALF) = w; }
                ss += __shfl_xor(ss, 16); ss += __shfl_xor(ss, 32);
                if (fq == 0) ssq[(size_t)row * SSQ_STRIDE + u.pn * 4 + wc] = ss; }
            asm volatile("" ::: "memory"); }
    }
};
struct EpiGlu {
    static constexpr bool PERM = false, AFTER_DRAIN = false;
    bf16_t* xb; float* ssq; const float* bias;
    __device__ __forceinline__ void operator()(const f32x4 (&acc)[2][2][4][2], const Unit& u, int wr, int wc, int fr, int fq) const {
        const int row0 = u.pm * BM + wr * 64 + fr, col0 = u.pn * 128 + wc * 16 + 4 * fq;
        f32x4 bval[2], bgate[2];
#pragma unroll
        for (int bj = 0; bj < 2; ++bj) { bval[bj] = *(const f32x4*)(bias + col0 + bj * 64); bgate[bj] = *(const f32x4*)(bias + 2048 + col0 + bj * 64); }
#pragma unroll
        for (int ai = 0; ai < 2; ++ai) {
            u32x2 pre[4][2];
#pragma unroll
            for (int m = 0; m < 4; ++m) { const size_t off = (size_t)(row0 + ai * HALF + m * 16) * 2048 + col0;
#pragma unroll
                for (int bj = 0; bj < 2; ++bj) pre[m][bj] = *(const u32x2*)(xb + off + bj * 64); }
            asm volatile("" ::: "memory");
#pragma unroll
            for (int m = 0; m < 4; ++m) { const int row = row0 + ai * HALF + m * 16; const size_t off = (size_t)row * 2048 + col0; float ss = 0.f;
#pragma unroll
                for (int bj = 0; bj < 2; ++bj) { const f32x4 val = acc[ai][bj][m][0] + bval[bj], gate = acc[ai][bj][m][1] + bgate[bj]; const u32x2 pb = pre[m][bj]; f32x4 o = (f32x4){__builtin_bit_cast(float, pb.x << 16), __builtin_bit_cast(float, pb.x & 0xffff0000u), __builtin_bit_cast(float, pb.y << 16), __builtin_bit_cast(float, pb.y & 0xffff0000u)};
#pragma unroll
                    for (int j = 0; j < 4; ++j) { const float sg = __builtin_amdgcn_rcpf(1.0f + __builtin_amdgcn_exp2f(-1.4426950408889634f * gate[j])); o[j] += val[j] * sg; }
                    ss += (o[0] * o[0] + o[1] * o[1]) + (o[2] * o[2] + o[3] * o[3]);
                    u32x2 w; w.x = cvt_pk_bf16(o[0], o[1]); w.y = cvt_pk_bf16(o[2], o[3]); *(u32x2*)(xb + off + bj * 64) = w; }
                ss += __shfl_xor(ss, 16); ss += __shfl_xor(ss, 32);
                if (fq == 0) ssq[(size_t)row * SSQ_STRIDE + u.pn * 4 + wc] = ss; }
            asm volatile("" ::: "memory"); }
    }
};
__host__ __device__ __forceinline__ int vt_pos(int key) { const int s = key >> 5, w = key & 31; return 32 * s + 8 * ((w & 15) >> 2) + (w & 3) + 4 * (w >> 4); }
struct EpiKV {
    static constexpr bool PERM = true, AFTER_DRAIN = false;
    bf16_t* Kb; bf16_t* Vb; bf16_t* VTb; const float* ssq;
    __device__ __forceinline__ void operator()(const f32x4 (&acc)[2][2][4][2], const Unit& u, int wr, int wc, int fr, int fq) const {
        const int row0 = u.pm * BM + wr * 64 + fr, col0 = u.pn * BM + wc * 32 + 8 * fq;
#pragma unroll
        for (int ai = 0; ai < 2; ++ai)
#pragma unroll
            for (int m = 0; m < 4; ++m) { const int row = row0 + ai * HALF + m * 16; const float rs = row_rstd(ssq, 32, row, fq); const int b = row >> 8, key = row & 255;
#pragma unroll
                for (int bj = 0; bj < 2; ++bj) { const f32x4 v0 = acc[ai][bj][m][0] * rs, v1 = acc[ai][bj][m][1] * rs; const int col = col0 + bj * HALF;
                    u32x4 w; w.x = cvt_pk_bf16(v0[0], v0[1]); w.y = cvt_pk_bf16(v0[2], v0[3]); w.z = cvt_pk_bf16(v1[0], v1[1]); w.w = cvt_pk_bf16(v1[2], v1[3]);
                    if (col < 2048) { const int h = col >> 9, d = col & 511; *(u32x4*)(Kb + ((size_t)((b * 4 + h) * 256 + key)) * 512 + d) = w; }
                    else { const int c2 = col - 2048, h = c2 >> 9, d = c2 & 511; *(u32x4*)(Vb + ((size_t)((b * 4 + h) * 256 + key)) * 512 + d) = w;
                        bf16_t* vt = VTb + ((size_t)((b * 4 + h) * 512 + d)) * 256 + vt_pos(key);
                        vt[0 * 256] = (bf16_t)(w.x & 0xffffu); vt[1 * 256] = (bf16_t)(w.x >> 16); vt[2 * 256] = (bf16_t)(w.y & 0xffffu); vt[3 * 256] = (bf16_t)(w.y >> 16);
                        vt[4 * 256] = (bf16_t)(w.z & 0xffffu); vt[5 * 256] = (bf16_t)(w.z >> 16); vt[6 * 256] = (bf16_t)(w.w & 0xffffu); vt[7 * 256] = (bf16_t)(w.w >> 16); } }
            }
    }
};
template <class Epi, class Sched, bool ALIGN_EPI = false, bool SP2 = false>
__device__ __forceinline__ void gemm_phase(PG8_LAS unsigned char* lds, const Gemm g, const Sched& S, const Epi& E, const int wid  , const int lane) {
    const int tid = wid * 64 + lane, wr = wid >> 2, wc = wid & 3, fr = lane & 15, fq = lane >> 4;
    const int K = g.K, nt = K / BK;
    unsigned voffA[2], voffB[2];
#pragma unroll
    for (int i = 0; i < 2; ++i) { int R, C; stage_rc(tid * 16 + i * 8192, R, C); const int Rb = Epi::PERM ? ((R & ~31) + perm32(R & 31)) : R;
        voffA[i] = (unsigned)(R * K + C) * 2u; voffB[i] = (unsigned)(Rb * K + C) * 2u; }
    const size_t kstep = (size_t)(BK * 2);
    const size_t hstep = (size_t)HALF * K * 2;
    const size_t tstep = 2 * hstep;
    const unsigned ldsw = (unsigned)wid * 1024u;
    const int aoff = lds_byte(wr * 64 + fr, fq * 8), boff = lds_byte(wc * 32 + fr, fq * 8);
#define PG8_SA(b, h) (((b) * 2 + (h)) * HTB)
#define PG8_SB(b, h) ((4 + (b) * 2 + (h)) * HTB)
#define PG8_STAGE(bufoff, gbase, voff) do { _Pragma("unroll") for (int _i = 0; _i < 2; ++_i) \
        __builtin_amdgcn_global_load_lds((const unsigned*)((const char*)(gbase) + (voff)[_i]), (PG8_LAS unsigned*)(lds + (bufoff) + ldsw + _i * 8192), 16, 0, 0); } while (0)
#define PG8_LDA(dst, b, h) do { _Pragma("unroll") for (int m = 0; m < 4; ++m) _Pragma("unroll") for (int k = 0; k < 2; ++k) dst[m][k] = *(const PG8_LAS bf16x8*)(lds + PG8_SA(b, h) + aoff + m * 2048 + k * 1024); } while (0)
#define PG8_LDB(dst, b, h) do { _Pragma("unroll") for (int n = 0; n < 2; ++n) _Pragma("unroll") for (int k = 0; k < 2; ++k) dst[n][k] = *(const PG8_LAS bf16x8*)(lds + PG8_SB(b, h) + boff + n * 2048 + k * 1024); } while (0)
#define PG8_MMA(ai, bj, At, Bt) do { __builtin_amdgcn_s_setprio(1); _Pragma("unroll") for (int m = 0; m < 4; ++m) _Pragma("unroll") for (int n = 0; n < 2; ++n) _Pragma("unroll") for (int k = 0; k < 2; ++k) \
        acc[ai][bj][m][n] = __builtin_amdgcn_mfma_f32_16x16x32_bf16(Bt[n][k], At[m][k], acc[ai][bj][m][n], 0, 0, 0); __builtin_amdgcn_s_setprio(0); } while (0)
#define PG8_WAIT_V(n) asm volatile("s_waitcnt vmcnt(" #n ")" ::: "memory")
#define PG8_WAIT_L(n) asm volatile("s_waitcnt lgkmcnt(" #n ")" ::: "memory")
#define PG8_BAR __builtin_amdgcn_s_barrier()
#define PG8_SCHED __builtin_amdgcn_sched_barrier(0)
    Unit cur, nxt; int ui = 0;
    if (!S.next(0, cur)) return;
    f32x4 acc[2][2][4][2];
#pragma unroll
    for (int a = 0; a < 2; ++a)
#pragma unroll
        for (int b = 0; b < 2; ++b)
#pragma unroll
            for (int m = 0; m < 4; ++m)
#pragma unroll
                for (int n = 0; n < 2; ++n) acc[a][b][m][n] = (f32x4){0.f, 0.f, 0.f, 0.f};
    bf16x8 At[4][2], B0[2][2], B1[2][2];
    const char* cA = (const char*)g.A + (size_t)cur.pm * tstep; const char* cB = (const char*)g.Bt + (size_t)cur.pn * tstep;
    S.a_ready(cur);
    if constexpr (SP2) {
        PG8_STAGE(PG8_SB(0, 0), cB, voffB); PG8_STAGE(PG8_SB(0, 1), cB + hstep, voffB); PG8_STAGE(PG8_SA(0, 0), cA, voffA); PG8_STAGE(PG8_SA(0, 1), cA + hstep, voffA);
        if (wr == 1) PG8_BAR;
        PG8_WAIT_V(2); PG8_BAR;
        PG8_STAGE(PG8_SB(1, 0), cB + kstep, voffB); PG8_STAGE(PG8_SA(1, 0), cA + kstep, voffA); PG8_STAGE(PG8_SB(1, 1), cB + hstep + kstep, voffB);
        PG8_WAIT_V(6); PG8_BAR;
    } else {
        PG8_STAGE(PG8_SB(0, 0), cB, voffB); PG8_STAGE(PG8_SA(0, 0), cA, voffA); PG8_STAGE(PG8_SB(0, 1), cB + hstep, voffB); PG8_STAGE(PG8_SA(0, 1), cA + hstep, voffA);
        if (wr == 1) PG8_BAR;
        PG8_WAIT_V(4); PG8_BAR;
        PG8_STAGE(PG8_SB(1, 0), cB + kstep, voffB); PG8_STAGE(PG8_SA(1, 0), cA + kstep, voffA); PG8_STAGE(PG8_SB(1, 1), cB + hstep + kstep, voffB);
        PG8_WAIT_V(6); PG8_BAR;
    }
    for (;;) {
        const bool has_next = S.next(ui + 1, nxt);
        const char* nA = has_next ? (const char*)g.A + (size_t)nxt.pm * tstep : cA; const char* nB = has_next ? (const char*)g.Bt + (size_t)nxt.pn * tstep : cB;
        for (int t = 0; t < nt; t += 2) {
            const bool last = (t == nt - 2);
            const char* a1 = cA + (size_t)(t + 1) * kstep;
            const char* a2 = last ? nA : cA + (size_t)(t + 2) * kstep; const char* b2 = last ? nB : cB + (size_t)(t + 2) * kstep;
            const char* a3 = a2 + kstep; const char* b3 = b2 + kstep;
            if (last && has_next) S.a_ready(nxt);
            if constexpr (SP2) {
            PG8_LDB(B0, 0, 0); PG8_LDB(B1, 0, 1); PG8_SCHED; PG8_LDA(At, 0, 0); PG8_STAGE(PG8_SA(1, 1), a1 + hstep, voffA);
            PG8_WAIT_V(8); PG8_WAIT_L(0); PG8_BAR; PG8_MMA(0, 0, At, B0); PG8_MMA(0, 1, At, B1); PG8_BAR; PG8_SCHED;
            PG8_LDA(At, 0, 1); PG8_STAGE(PG8_SB(0, 0), b2, voffB); PG8_STAGE(PG8_SB(0, 1), b2 + hstep, voffB); PG8_STAGE(PG8_SA(0, 0), a2, voffA);
            PG8_WAIT_V(8); PG8_WAIT_L(0); PG8_BAR; PG8_MMA(1, 0, At, B0); PG8_MMA(1, 1, At, B1); PG8_BAR; PG8_SCHED;
            PG8_LDB(B0, 1, 0); PG8_LDB(B1, 1, 1); PG8_SCHED; PG8_LDA(At, 1, 0); PG8_STAGE(PG8_SA(0, 1), a2 + hstep, voffA);
            PG8_WAIT_V(8); PG8_WAIT_L(0); PG8_BAR; PG8_MMA(0, 0, At, B0); PG8_MMA(0, 1, At, B1); PG8_BAR; PG8_SCHED;
            PG8_LDA(At, 1, 1); PG8_STAGE(PG8_SB(1, 0), b3, voffB); PG8_STAGE(PG8_SB(1, 1), b3 + hstep, voffB); PG8_STAGE(PG8_SA(1, 0), a3, voffA);
            PG8_WAIT_V(8); PG8_WAIT_L(0); PG8_BAR; PG8_MMA(1, 0, At, B0); PG8_MMA(1, 1, At, B1); PG8_BAR; PG8_SCHED;
            } else {
            PG8_LDB(B0, 0, 0); PG8_SCHED; PG8_LDA(At, 0, 0); PG8_STAGE(PG8_SA(1, 1), a1 + hstep, voffA);
            PG8_WAIT_L(8); PG8_BAR; PG8_WAIT_L(0); PG8_MMA(0, 0, At, B0); PG8_BAR; PG8_SCHED;
            PG8_LDB(B1, 0, 1); PG8_STAGE(PG8_SB(0, 0), b2, voffB);
            PG8_BAR; PG8_WAIT_L(0); PG8_MMA(0, 1, At, B1); PG8_BAR;
            PG8_LDA(At, 0, 1); PG8_STAGE(PG8_SA(0, 0), a2, voffA);
            PG8_BAR; PG8_WAIT_L(0); PG8_MMA(1, 0, At, B0); PG8_BAR; PG8_SCHED;
            PG8_STAGE(PG8_SB(0, 1), b2 + hstep, voffB);
            PG8_WAIT_V(6); PG8_BAR; PG8_MMA(1, 1, At, B1); PG8_BAR;
            PG8_LDB(B0, 1, 0); PG8_SCHED; PG8_LDA(At, 1, 0); PG8_STAGE(PG8_SA(0, 1), a2 + hstep, voffA);
            PG8_WAIT_L(8); PG8_BAR; PG8_WAIT_L(0); PG8_MMA(0, 0, At, B0); PG8_BAR; PG8_SCHED;
            PG8_LDB(B1, 1, 1); PG8_STAGE(PG8_SB(1, 0), b3, voffB);
            PG8_BAR; PG8_WAIT_L(0); PG8_MMA(0, 1, At, B1); PG8_BAR;
            PG8_LDA(At, 1, 1); PG8_STAGE(PG8_SA(1, 0), a3, voffA);
            PG8_BAR; PG8_WAIT_L(0); PG8_MMA(1, 0, At, B0); PG8_BAR; PG8_SCHED;
            PG8_STAGE(PG8_SB(1, 1), b3 + hstep, voffB);
            PG8_WAIT_V(6); PG8_BAR; PG8_MMA(1, 1, At, B1); PG8_BAR;
            }
        }
        if constexpr (ALIGN_EPI) { if (wr == 0) PG8_BAR; }
        if constexpr (!Epi::AFTER_DRAIN) { Unit ue = cur; asm volatile("" : "+s"(ue.pm), "+s"(ue.pn));
            int fre = fr, fqe = fq; asm volatile("" : "+v"(fre), "+v"(fqe)); E(acc, ue, wr, wc, fre, fqe); S.done(cur); }
        if (!has_next) break;
#pragma unroll
        for (int a = 0; a < 2; ++a)
#pragma unroll
            for (int b = 0; b < 2; ++b)
#pragma unroll
                for (int m = 0; m < 4; ++m)
#pragma unroll
                    for (int n = 0; n < 2; ++n) acc[a][b][m][n] = (f32x4){0.f, 0.f, 0.f, 0.f};
        cur = nxt; cA = nA; cB = nB; ++ui;
        if constexpr (ALIGN_EPI) { if (wr == 1) PG8_BAR; }
    }
    PG8_WAIT_V(0);
    if constexpr (!ALIGN_EPI) { if (wr == 0) PG8_BAR; }
    PG8_BAR;
    if constexpr (Epi::AFTER_DRAIN) { E.fused(acc, cur, wr, wc, fr, fq, lds, wid, lane); S.done(cur); }
#undef PG8_SA
#undef PG8_SB
#undef PG8_STAGE
#undef PG8_LDA
#undef PG8_LDB
#undef PG8_MMA
#undef PG8_WAIT_V
#undef PG8_WAIT_L
#undef PG8_BAR
#undef PG8_SCHED
}
}
#ifndef MK_N_LAUNCHES
#define MK_N_LAUNCHES 1
#endif
constexpr int BATCH = 2, SEQ = 4096, D = 2048, M = BATCH * SEQ, MEMLEN = 256, MROWS = BATCH * MEMLEN, FF = 8192;
constexpr int NWAVES = 8, NTHREADS = 512, NPH = 20;
constexpr int LDS_BYTES = 147456;
constexpr size_t MiB = 1u << 20;
constexpr size_t WS_W_AIN = 2 * MiB, WS_W_AOUT = 18 * MiB, WS_W_BIN = 26 * MiB, WS_W_BOUT = 34 * MiB, WS_W_Q = 50 * MiB, WS_W_KV = 66 * MiB, WS_W_O = 98 * MiB, WS_W_UP = 114 * MiB, WS_W_DN = 178 * MiB;
constexpr size_t WS_XB = 242 * MiB, WS_MEMB = 274 * MiB, WS_KB = 276 * MiB, WS_VB = 280 * MiB, WS_VTB = 284 * MiB, WS_SSQ = 288 * MiB, WS_VST = 290 * MiB, WS_SSQM = 292 * MiB, WS_S5ST = 294 * MiB;
constexpr size_t WS_R = 304 * MiB, WS_END = 432 * MiB;
#define GAS __attribute__((address_space(1)))
#define LAS __attribute__((address_space(3)))
typedef unsigned short bf16;
typedef unsigned v4u __attribute__((ext_vector_type(4)));
typedef unsigned v2u __attribute__((ext_vector_type(2)));
typedef float f32x4 __attribute__((ext_vector_type(4)));
typedef float f32x2 __attribute__((ext_vector_type(2)));
typedef short bf16x8 __attribute__((ext_vector_type(8)));
#define LDS_WAIT() asm volatile("s_waitcnt lgkmcnt(0)" ::: "memory")
__device__ __forceinline__ unsigned f2bf(float f) { unsigned u = __builtin_bit_cast(unsigned, f); return (u + 0x7fffu + ((u >> 16) & 1u)) >> 16; }
__device__ __forceinline__ unsigned pk2(float lo, float hi) { return f2bf(lo) | (f2bf(hi) << 16); }
__device__ __forceinline__ float bflo(unsigned w) { return __builtin_bit_cast(float, w << 16); }
__device__ __forceinline__ float bfhi(unsigned w) { return __builtin_bit_cast(float, w & 0xffff0000u); }
__device__ __forceinline__ float wave_sum(float v) {
#pragma unroll
    for (int o = 1; o < 64; o <<= 1) v += __shfl_xor(v, o);
    return v;
}
__device__ __forceinline__ float wave_max(float v) {
#pragma unroll
    for (int o = 1; o < 64; o <<= 1) v = fmaxf(v, __shfl_xor(v, o));
    return v;
}
__device__ __forceinline__ float gelu_exact(float v) { return 0.5f * v * (1.0f + erff(v * 0.70710678118654752f)); }

struct Args { const float* in[30]; float* out; unsigned char* ws; int ph_lo, ph_hi; };
__device__ __forceinline__ const float* ka_in(int i) { const __attribute__((address_space(4))) char* ka = (const __attribute__((address_space(4))) char*)__builtin_amdgcn_kernarg_segment_ptr(); asm volatile("" : "+s"(ka)); return *(const float* const __attribute__((address_space(4)))*)(ka + 8 * i); }

#if defined(STAMP_SEL)
#define STAMP2(lds_, id) do { __syncthreads(); if (blockIdx.x == 0 && wave == 0 && lane_id2() == 0) ((volatile LAS unsigned*)((lds_) + LDS_BYTES - 512))[4 + (id)] = (unsigned)__builtin_amdgcn_s_memrealtime(); } while (0)
__device__ __forceinline__ int lane_id2() { int l; asm volatile("v_mbcnt_lo_u32_b32 %0, -1, 0\n\tv_mbcnt_hi_u32_b32 %0, -1, %0" : "=v"(l)); return l; }
#else
#define STAMP2(lds_, id) do { } while (0)
#endif
__device__ __forceinline__ int glu_rowmap(int n) { return n < 2048 ? 32 * (n >> 4) + (n & 15) : 32 * ((n - 2048) >> 4) + 16 + (n & 15); }
struct ConvSel { const float* W; const float* g; bf16* WT; int K, N, mode, item; };
__device__ __forceinline__ ConvSel conv_select(unsigned char* ws, int r) {
    ConvSel s; s.g = nullptr; s.K = 2048; s.N = 2048; s.mode = 0;
    if (r < 2048) { s.W = ka_in(7); s.g = ka_in(2); s.WT = (bf16*)(ws + WS_W_AIN); s.N = 4096; }
    else if ((r -= 2048) < 1024) { s.W = ka_in(13); s.WT = (bf16*)(ws + WS_W_AOUT); }
    else if ((r -= 1024) < 1024) { s.W = ka_in(14); s.g = ka_in(2) + 2048; s.WT = (bf16*)(ws + WS_W_BIN); }
    else if ((r -= 1024) < 2048) { s.W = ka_in(23); s.WT = (bf16*)(ws + WS_W_BOUT); s.N = 4096; s.mode = 1; }
    else if ((r -= 2048) < 2048) { const int i = r >> 10; r &= 1023; s.W = ka_in(25) + (size_t)i * 2048 * 2048; s.g = ka_in(3) + i * 2048; s.WT = (bf16*)(ws + WS_W_Q + i * 8 * MiB); }
    else if ((r -= 2048) < 4096) { const int i = r >> 11; r &= 2047; s.W = ka_in(26) + (size_t)i * 2048 * 4096; s.g = ka_in(4) + i * 2048; s.WT = (bf16*)(ws + WS_W_KV + i * 16 * MiB); s.N = 4096; }
    else if ((r -= 4096) < 2048) { const int i = r >> 10; r &= 1023; s.W = ka_in(27) + (size_t)i * 2048 * 2048; s.WT = (bf16*)(ws + WS_W_O + i * 8 * MiB); }
    else if ((r -= 2048) < 8192) { const int i = r >> 12; r &= 4095; s.W = ka_in(28) + (size_t)i * 2048 * 8192; s.g = ka_in(5) + i * 2048; s.WT = (bf16*)(ws + WS_W_UP + i * 32 * MiB); s.N = 8192; }
    else { r -= 8192; const int i = r >> 12; r &= 4095; s.W = ka_in(29) + (size_t)i * 8192 * 2048; s.WT = (bf16*)(ws + WS_W_DN + i * 32 * MiB); s.K = 8192; }
    s.item = r; return s;
}
__device__ __forceinline__ void conv_load(const ConvSel& s, f32x4 (&v)[16], int lane) {
#if defined(CONV_KMAJOR)
    const int kblk = s.K >> 6, nb = s.item / kblk, kb = s.item - nb * kblk, k0 = 64 * kb, n0 = 64 * nb;
#else
    const int nblk = s.N >> 6, kb = s.item / nblk, nb = s.item - kb * nblk, k0 = 64 * kb, n0 = 64 * nb;
#endif
#pragma unroll
    for (int i = 0; i < 16; ++i) { const int kk = 4 * i + (lane >> 4); v[i] = *(const f32x4*)(s.W + (size_t)(k0 + kk) * s.N + n0 + 4 * (lane & 15)); }
}
__device__ __forceinline__ void conv_finish(const ConvSel& s, const f32x4 (&v)[16], LAS float* scr, int lane) {
#if defined(CONV_KMAJOR)
    const int kblk = s.K >> 6, nb = s.item / kblk, kb = s.item - nb * kblk, k0 = 64 * kb, n0 = 64 * nb;
#else
    const int nblk = s.N >> 6, kb = s.item / nblk, nb = s.item - kb * nblk, k0 = 64 * kb, n0 = 64 * nb;
#endif
#pragma unroll
    for (int i = 0; i < 16; ++i) { const int kk = 4 * i + (lane >> 4); const float sc = s.g ? s.g[k0 + kk] : 1.0f; LAS float* d = scr + kk * 65 + 4 * (lane & 15);
        d[0] = v[i][0] * sc; d[1] = v[i][1] * sc; d[2] = v[i][2] * sc; d[3] = v[i][3] * sc; }
    LDS_WAIT();
    const int c = lane & 7;
#pragma unroll
    for (int j = 0; j < 8; ++j) { const int n = (lane >> 3) + 8 * j; const LAS float* sp = scr + (8 * c) * 65 + n;
        v4u o; o.x = pk2(sp[0 * 65], sp[1 * 65]); o.y = pk2(sp[2 * 65], sp[3 * 65]); o.z = pk2(sp[4 * 65], sp[5 * 65]); o.w = pk2(sp[6 * 65], sp[7 * 65]);
        const int nr = s.mode ? glu_rowmap(n0 + n) : (n0 + n);
        *(v4u*)(s.WT + (size_t)nr * s.K + k0 + 8 * c) = o; }
    LDS_WAIT();
}
template <int PART> __device__ __forceinline__ int conv_index(int j) { return PART == 0 ? 8192 + j : (j < 8192 ? j : j + 4096); }
template <int PART> __device__ __forceinline__ void conv_run(unsigned char* ws, LAS float* scr, int first, int step, int limit, int lane) {
    if (first >= limit) return;
    f32x4 va[16], vb[16];
    ConvSel sa = conv_select(ws, conv_index<PART>(__builtin_amdgcn_readfirstlane(first))), sb = sa;
    conv_load(sa, va, lane);
    for (int j = first; j < limit; j += 2 * step) {
        const bool hb = (j + step) < limit;
        if (hb) { sb = conv_select(ws, conv_index<PART>(__builtin_amdgcn_readfirstlane(j + step))); conv_load(sb, vb, lane); }
        conv_finish(sa, va, scr, lane);
        if (!hb) break;
        const bool ha = (j + 2 * step) < limit;
        if (ha) { sa = conv_select(ws, conv_index<PART>(__builtin_amdgcn_readfirstlane(j + 2 * step))); conv_load(sa, va, lane); }
        conv_finish(sb, vb, scr, lane);
    }
}
__device__ __forceinline__ void row_to_bf16(const float* xrow, bf16* orow, float* ssqrow, int lane) {
    f32x4 v[8]; float s = 0.f;
#pragma unroll
    for (int j = 0; j < 8; ++j) { v[j] = ((const f32x4*)xrow)[lane + 64 * j]; s += (v[j][0] * v[j][0] + v[j][1] * v[j][1]) + (v[j][2] * v[j][2] + v[j][3] * v[j][3]); }
    s = wave_sum(s);
#pragma unroll
    for (int j = 0; j < 8; ++j) { v2u w; w.x = pk2(v[j][0], v[j][1]); w.y = pk2(v[j][2], v[j][3]); ((v2u*)orow)[lane + 64 * j] = w; }
    if (lane < 32) ssqrow[lane] = (lane == 0) ? s : 0.f;
}
__device__ __forceinline__ void p0_prologue(unsigned char* ws, LAS unsigned char* lds, int wave, int lane) {
    LAS float* scr = (LAS float*)(lds + wave * 16640);
    const int gw = blockIdx.x * NWAVES + wave, NGW = gridDim.x * NWAVES;
    conv_run<0>(ws, scr, gw, NGW, 4096, lane);
    for (int m = gw; m < M + MROWS; m += NGW) {
        if (m < M) row_to_bf16(ka_in(0) + (size_t)m * D, (bf16*)(ws + WS_XB) + (size_t)m * D, (float*)(ws + WS_SSQ) + (size_t)m * 64, lane);
        else { const int r = m - M; row_to_bf16(ka_in(1) + (size_t)r * D, (bf16*)(ws + WS_MEMB) + (size_t)r * D, (float*)(ws + WS_SSQM) + (size_t)r * 64, lane); }
    }
}
constexpr int CONV_REST = 26624, CONV_SPLIT = 22272;
__device__ __forceinline__ void p1_convert(unsigned char* ws, LAS unsigned char* lds, int wave, int lane) {
    LAS float* scr = (LAS float*)(lds + wave * 16640);
    const int bx = blockIdx.x, G = gridDim.x;
    if (G <= 64) { conv_run<1>(ws, scr, bx * NWAVES + wave, G * NWAVES, CONV_REST, lane); return; }
    if (bx >= 64) conv_run<1>(ws, scr, (bx - 64) * NWAVES + wave, (G - 64) * NWAVES, CONV_SPLIT, lane);
    else conv_run<1>(ws, scr, CONV_SPLIT + bx * NWAVES + wave, 64 * NWAVES, CONV_REST, lane);
}
__device__ __forceinline__ void final_norm(const bf16* xb, const float* ssq, const float* g, float* out, int wave, int lane) {
    const int gw = blockIdx.x * NWAVES + wave, NGW = gridDim.x * NWAVES;
    for (int m = gw; m < M; m += NGW) {
        float s = (lane < 32) ? ssq[(size_t)m * 64 + lane] : 0.f; s = wave_sum(s);
        const float rs = 1.0f / sqrtf(s * (1.0f / D) + 1e-6f);
        const v4u* xr = (const v4u*)(xb + (size_t)m * D); f32x4* orow = (f32x4*)(out + (size_t)m * D);
#pragma unroll
        for (int j = 0; j < 4; ++j) { const v4u w = xr[lane + 64 * j]; const f32x4 g0 = ((const f32x4*)g)[2 * (lane + 64 * j)], g1 = ((const f32x4*)g)[2 * (lane + 64 * j) + 1];
            orow[2 * (lane + 64 * j)] = (f32x4){bflo(w.x) * rs * g0[0], bfhi(w.x) * rs * g0[1], bflo(w.y) * rs * g0[2], bfhi(w.y) * rs * g0[3]};
            orow[2 * (lane + 64 * j) + 1] = (f32x4){bflo(w.z) * rs * g1[0], bfhi(w.z) * rs * g1[1], bflo(w.w) * rs * g1[2], bfhi(w.w) * rs * g1[3]}; } }
}
__device__ __forceinline__ void gating_simple(LAS unsigned char* lds, const bf16* z, const float* vst, const float* ln_g, const float* ln_b, const float* w_s, const float* b_s, bf16* gbuf, int tid) {
    LAS float* vln = (LAS float*)lds;
    LAS float* Wl = (LAS float*)(lds + 65536);
    LAS float* mu = (LAS float*)(lds + 65536 + 128 * 129 * 4);
    LAS float* rsd = mu + 128;
    for (int unit = blockIdx.x; unit < 1024; unit += gridDim.x) {
        const int h = unit & 15, tok0 = (unit >> 4) * 128;
        if (tid < 128) { const float* p = vst + (size_t)(tok0 + tid) * 64; float s1 = 0.f, s2 = 0.f;
#pragma unroll 8
            for (int i = 0; i < 32; ++i) { s1 += p[2 * i]; s2 += p[2 * i + 1]; }
            const float mean = s1 * (1.0f / 2048.0f), var = s2 * (1.0f / 2048.0f) - mean * mean; mu[tid] = mean; rsd[tid] = 1.0f / sqrtf(var + 1e-6f); }
        __syncthreads();
        { const int s = tid >> 2, db = (tid & 3) * 32; const float mean = mu[s], rs = rsd[s];
            const bf16* vp = z + (size_t)(tok0 + s) * 4096 + 2048 + h * 128 + db;
#pragma unroll
            for (int q = 0; q < 4; ++q) { const v4u w = *(const v4u*)(vp + 8 * q); const float* gp = ln_g + h * 128 + db + 8 * q; const float* bp = ln_b + h * 128 + db + 8 * q; LAS float* o = vln + s * 128 + db + 8 * q;
                o[0] = (bflo(w.x) - mean) * rs * gp[0] + bp[0]; o[1] = (bfhi(w.x) - mean) * rs * gp[1] + bp[1]; o[2] = (bflo(w.y) - mean) * rs * gp[2] + bp[2]; o[3] = (bfhi(w.y) - mean) * rs * gp[3] + bp[3];
                o[4] = (bflo(w.z) - mean) * rs * gp[4] + bp[4]; o[5] = (bfhi(w.z) - mean) * rs * gp[5] + bp[5]; o[6] = (bflo(w.w) - mean) * rs * gp[6] + bp[6]; o[7] = (bfhi(w.w) - mean) * rs * gp[7] + bp[7]; }
            const float* wp = w_s + ((size_t)h * 128 + s) * 128 + db;
#pragma unroll
            for (int q = 0; q < 8; ++q) { const f32x4 w4 = *(const f32x4*)(wp + 4 * q); LAS float* o = Wl + s * 129 + db + 4 * q; o[0] = w4[0]; o[1] = w4[1]; o[2] = w4[2]; o[3] = w4[3]; } }
        __syncthreads();
        { const int t = tid >> 2, d0 = (tid & 3) * 32, tmax = t | 15; float acc[32];
#pragma unroll
            for (int j = 0; j < 32; ++j) acc[j] = 0.f;
            for (int s = 0; s <= tmax; ++s) { const float w = (s <= t) ? Wl[t * 129 + s] : 0.f; const LAS f32x4* vr = (const LAS f32x4*)(vln + s * 128 + d0);
#pragma unroll
                for (int q = 0; q < 8; ++q) { const f32x4 vv = vr[q]; acc[4 * q] += w * vv[0]; acc[4 * q + 1] += w * vv[1]; acc[4 * q + 2] += w * vv[2]; acc[4 * q + 3] += w * vv[3]; } }
            const float bs = b_s[h * 128 + t];
            const bf16* up = z + (size_t)(tok0 + t) * 4096 + h * 128 + d0; bf16* op = gbuf + (size_t)(tok0 + t) * 2048 + h * 128 + d0;
#pragma unroll
            for (int q = 0; q < 4; ++q) { const v4u w = *(const v4u*)(up + 8 * q); v4u o;
                o.x = pk2(bflo(w.x) * (acc[8 * q] + bs), bfhi(w.x) * (acc[8 * q + 1] + bs)); o.y = pk2(bflo(w.y) * (acc[8 * q + 2] + bs), bfhi(w.y) * (acc[8 * q + 3] + bs));
                o.z = pk2(bflo(w.z) * (acc[8 * q + 4] + bs), bfhi(w.z) * (acc[8 * q + 5] + bs)); o.w = pk2(bflo(w.w) * (acc[8 * q + 6] + bs), bfhi(w.w) * (acc[8 * q + 7] + bs));
                *(v4u*)(op + 8 * q) = o; } }
        __syncthreads();
    }
}
__device__ __forceinline__ void gating_mfma(LAS unsigned char* lds, const bf16* z, const float* vst, const float* ln_g, const float* ln_b, const float* w_s, const float* b_s, bf16* gbuf, int wave, int lane) {
    LAS float* MU = (LAS float*)(lds + 69632);
    const int tid = wave * 64 + lane, fr = lane & 15, fq = lane >> 4;
    const int ss = tid >> 2, db = (tid & 3) * 32;
    for (int unit = blockIdx.x; unit < 256; unit += gridDim.x) {
        const int tok0 = (unit >> 2) * 128, hg = unit & 3;
        __syncthreads();
        if (tid < 128) { const float* sp = vst + (size_t)(tok0 + tid) * 64; float s1 = 0.f, s2 = 0.f;
#pragma unroll
            for (int i = 0; i < 16; ++i) { const f32x4 a = *(const f32x4*)(sp + 4 * i); s1 += a[0] + a[2]; s2 += a[1] + a[3]; }
            const float mean = s1 * (1.0f / 2048.0f), var = s2 * (1.0f / 2048.0f) - mean * mean; MU[tid] = mean; MU[128 + tid] = 1.0f / sqrtf(var + 1e-6f); }
        v4u raw[4];
        { const bf16* vp = z + (size_t)(tok0 + ss) * 4096 + 2048 + (hg * 4) * 128 + db;
#pragma unroll
            for (int q4 = 0; q4 < 4; ++q4) raw[q4] = *(const v4u*)(vp + 8 * q4); }
        __syncthreads();
        const float mean = MU[ss], rs = MU[128 + ss];
#pragma unroll 1
        for (int hh = 0; hh < 4; ++hh) { const int h = hg * 4 + hh; LAS unsigned char* VT = lds + (hh & 1) * 34816;
            { const float* gp = ln_g + h * 128 + db; const float* bp = ln_b + h * 128 + db; LAS unsigned char* wp = VT + db * 272 + ss * 2;
#pragma unroll
                for (int q4 = 0; q4 < 4; ++q4) { const f32x4 g0 = *(const f32x4*)(gp + 8 * q4), g1 = *(const f32x4*)(gp + 8 * q4 + 4), b0 = *(const f32x4*)(bp + 8 * q4), b1 = *(const f32x4*)(bp + 8 * q4 + 4); const v4u w = raw[q4];
                    const float v0 = (bflo(w.x) - mean) * rs * g0[0] + b0[0], v1 = (bfhi(w.x) - mean) * rs * g0[1] + b0[1], v2 = (bflo(w.y) - mean) * rs * g0[2] + b0[2], v3 = (bfhi(w.y) - mean) * rs * g0[3] + b0[3];
                    const float v4 = (bflo(w.z) - mean) * rs * g1[0] + b1[0], v5 = (bfhi(w.z) - mean) * rs * g1[1] + b1[1], v6 = (bflo(w.w) - mean) * rs * g1[2] + b1[2], v7 = (bfhi(w.w) - mean) * rs * g1[3] + b1[3];
                    LAS unsigned char* o = wp + (8 * q4) * 272;
                    *(LAS bf16*)(o + 0 * 272) = (bf16)f2bf(v0); *(LAS bf16*)(o + 1 * 272) = (bf16)f2bf(v1); *(LAS bf16*)(o + 2 * 272) = (bf16)f2bf(v2); *(LAS bf16*)(o + 3 * 272) = (bf16)f2bf(v3);
                    *(LAS bf16*)(o + 4 * 272) = (bf16)f2bf(v4); *(LAS bf16*)(o + 5 * 272) = (bf16)f2bf(v5); *(LAS bf16*)(o + 6 * 272) = (bf16)f2bf(v6); *(LAS bf16*)(o + 7 * 272) = (bf16)f2bf(v7); } }
            if (hh < 3) { const bf16* vp = z + (size_t)(tok0 + ss) * 4096 + 2048 + (h + 1) * 128 + db;
#pragma unroll
                for (int q4 = 0; q4 < 4; ++q4) raw[q4] = *(const v4u*)(vp + 8 * q4); }
            __syncthreads();
            const int t = 16 * wave + fr, nks = (wave >> 1) + 1;
            bf16x8 wf[4];
#pragma unroll
            for (int ks = 0; ks < 4; ++ks) { wf[ks] = (bf16x8){0, 0, 0, 0, 0, 0, 0, 0};
                if (ks < nks) { const float* wp = w_s + ((size_t)h * 128 + t) * 128 + 32 * ks + 8 * fq; const f32x4 a = *(const f32x4*)wp, c = *(const f32x4*)(wp + 4); const int s0 = 32 * ks + 8 * fq;
                    float v[8] = {a[0], a[1], a[2], a[3], c[0], c[1], c[2], c[3]};
#pragma unroll
                    for (int j = 0; j < 8; ++j) v[j] = (s0 + j <= t) ? v[j] : 0.f;
                    v4u w; w.x = pk2(v[0], v[1]); w.y = pk2(v[2], v[3]); w.z = pk2(v[4], v[5]); w.w = pk2(v[6], v[7]); wf[ks] = __builtin_bit_cast(bf16x8, w); } }
            const float bs = b_s[h * 128 + t];
            const bf16* up = z + (size_t)(tok0 + t) * 4096 + h * 128 + 4 * fq; bf16* op = gbuf + (size_t)(tok0 + t) * 2048 + h * 128 + 4 * fq;
            const LAS unsigned char* ab = VT + fr * 272 + fq * 16;
#pragma unroll
            for (int df = 0; df < 8; ++df) { f32x4 acc = (f32x4){0.f, 0.f, 0.f, 0.f};
#pragma unroll
                for (int ks = 0; ks < 4; ++ks) if (ks < nks) { const bf16x8 a = *(const LAS bf16x8*)(ab + df * 16 * 272 + ks * 64); acc = __builtin_amdgcn_mfma_f32_16x16x32_bf16(a, wf[ks], acc, 0, 0, 0); }
                const v2u uw = *(const v2u*)(up + 16 * df); v2u ow;
                ow.x = pg8::cvt_pk_bf16(bflo(uw.x) * (acc[0] + bs), bfhi(uw.x) * (acc[1] + bs)); ow.y = pg8::cvt_pk_bf16(bflo(uw.y) * (acc[2] + bs), bfhi(uw.y) * (acc[3] + bs));
                *(v2u*)(op + 16 * df) = ow; }
        }
    }
    __syncthreads();
}
__device__ __forceinline__ void attn_simple(LAS unsigned char* lds, const bf16* q, const bf16* Kb, const bf16* Vb, bf16* obuf, int wave, int lane) {
    LAS float* pl = (LAS float*)(lds + wave * 1024);
    const int gw = blockIdx.x * NWAVES + wave, NGW = gridDim.x * NWAVES;
    for (int task = gw; task < BATCH * 4 * SEQ; task += NGW) {
        const int bh = task >> 12, t = task & 4095, b = bh >> 2, h = bh & 3;
        float qf[8]; { const v4u w = *(const v4u*)(q + ((size_t)(b * SEQ + t)) * 2048 + h * 512 + 8 * lane);
            qf[0] = bflo(w.x); qf[1] = bfhi(w.x); qf[2] = bflo(w.y); qf[3] = bfhi(w.y); qf[4] = bflo(w.z); qf[5] = bfhi(w.z); qf[6] = bflo(w.w); qf[7] = bfhi(w.w); }
        const bf16* kp = Kb + (size_t)bh * 256 * 512 + 8 * lane;
        float sc[4];
#pragma unroll
        for (int kk = 0; kk < 4; ++kk) { float mine = 0.f;
            for (int l2 = 0; l2 < 64; ++l2) { const v4u w = *(const v4u*)(kp + (size_t)(kk * 64 + l2) * 512);
                float dsum = qf[0] * bflo(w.x) + qf[1] * bfhi(w.x) + qf[2] * bflo(w.y) + qf[3] * bfhi(w.y) + qf[4] * bflo(w.z) + qf[5] * bfhi(w.z) + qf[6] * bflo(w.w) + qf[7] * bfhi(w.w);
                dsum = wave_sum(dsum); if (lane == l2) mine = dsum; }
            sc[kk] = mine; }
        const float mx = wave_max(fmaxf(fmaxf(sc[0], sc[1]), fmaxf(sc[2], sc[3])));
        float p[4], ps = 0.f;
#pragma unroll
        for (int kk = 0; kk < 4; ++kk) { p[kk] = exp2f(sc[kk] - mx); ps += p[kk]; pl[kk * 64 + lane] = p[kk]; }
        const float inv = 1.0f / wave_sum(ps);
        LDS_WAIT();
        float o[8];
#pragma unroll
        for (int i = 0; i < 8; ++i) o[i] = 0.f;
        const bf16* vp = Vb + (size_t)bh * 256 * 512 + 8 * lane;
        for (int key = 0; key < 256; ++key) { const float pk = pl[key]; const v4u w = *(const v4u*)(vp + (size_t)key * 512);
            o[0] += pk * bflo(w.x); o[1] += pk * bfhi(w.x); o[2] += pk * bflo(w.y); o[3] += pk * bfhi(w.y); o[4] += pk * bflo(w.z); o[5] += pk * bfhi(w.z); o[6] += pk * bflo(w.w); o[7] += pk * bfhi(w.w); }
        v4u ow; ow.x = pk2(o[0] * inv, o[1] * inv); ow.y = pk2(o[2] * inv, o[3] * inv); ow.z = pk2(o[4] * inv, o[5] * inv); ow.w = pk2(o[6] * inv, o[7] * inv);
        *(v4u*)(obuf + ((size_t)(b * SEQ + t)) * 2048 + h * 512 + 8 * lane) = ow;
        LDS_WAIT();
    }
}
__device__ __forceinline__ void attn_mfma(LAS unsigned char* lds, const bf16* q, const bf16* Kb, const bf16* VTb, bf16* obuf, int wave, int lane) {
    const int tid = wave * 64 + lane, fr = lane & 15, fq = lane >> 4;
    unsigned voffK[2], voffV[2];
#pragma unroll
    for (int i = 0; i < 2; ++i) { int R, C; pg8::stage_rc(tid * 16 + i * 8192, R, C); voffK[i] = (unsigned)(R * 512 + C) * 2u; voffV[i] = (unsigned)(R * 256 + C) * 2u; }
    const unsigned ldsw = (unsigned)wave * 1024u;
    const int aoff0 = pg8::lds_byte(fr, fq * 8);
#define AT_STAGE_K(c, buf) do { _Pragma("unroll") for (int ht = 0; ht < 4; ++ht) { const char* src = Kg + ((size_t)(128 * (ht >> 1)) * 512 + 128 * (c) + 64 * (ht & 1)) * 2; \
        _Pragma("unroll") for (int i = 0; i < 2; ++i) __builtin_amdgcn_global_load_lds((const unsigned*)(src + voffK[i]), (LAS unsigned*)(lds + (buf) * 65536 + ht * 16384 + ldsw + i * 8192), 16, 0, 0); } } while (0)
#define AT_STAGE_V(cc, buf) do { _Pragma("unroll") for (int ht = 0; ht < 4; ++ht) { const char* src = Vg + ((size_t)(128 * ht) * 256 + 64 * (cc)) * 2; \
        _Pragma("unroll") for (int i = 0; i < 2; ++i) __builtin_amdgcn_global_load_lds((const unsigned*)(src + voffV[i]), (LAS unsigned*)(lds + (buf) * 65536 + ht * 16384 + ldsw + i * 8192), 16, 0, 0); } } while (0)
#define AT_WAIT() do { asm volatile("s_waitcnt vmcnt(0)" ::: "memory"); __syncthreads(); } while (0)
    for (int unit = blockIdx.x; unit < 256; unit += gridDim.x) {
        const int bh = unit >> 5, qb = unit & 31, b = bh >> 2, h = bh & 3;
        const char* Kg = (const char*)(Kb + (size_t)bh * 256 * 512);
        const char* Vg = (const char*)(VTb + (size_t)bh * 512 * 256);
        const size_t tok = (size_t)(b * SEQ + qb * 128 + 16 * wave + fr);
        bf16x8 qf[16];
        { const bf16* qp = q + tok * 2048 + h * 512 + 8 * fq;
#pragma unroll
            for (int s = 0; s < 16; ++s) qf[s] = *(const bf16x8*)(qp + 32 * s); }
        f32x4 acc[16];
#pragma unroll
        for (int n = 0; n < 16; ++n) acc[n] = (f32x4){0.f, 0.f, 0.f, 0.f};
        AT_STAGE_K(0, 0);
#pragma unroll
        for (int c = 0; c < 4; ++c) {
            AT_WAIT();
            if (c < 3) AT_STAGE_K(c + 1, (c + 1) & 1); else AT_STAGE_V(0, 0);
            const LAS unsigned char* bb = lds + (c & 1) * 65536 + aoff0; asm volatile("" : "+v"(bb));
#pragma unroll
            for (int kh = 0; kh < 2; ++kh)
#pragma unroll
                for (int k = 0; k < 2; ++k)
#pragma unroll
                    for (int ng = 0; ng < 2; ++ng) { bf16x8 a[8];
#pragma unroll
                        for (int n8 = 0; n8 < 8; ++n8) a[n8] = *(const LAS bf16x8*)(bb + (ng * 2 + kh) * 16384 + n8 * 2048 + k * 1024);
#pragma unroll
                        for (int n8 = 0; n8 < 8; ++n8) acc[ng * 8 + n8] = __builtin_amdgcn_mfma_f32_16x16x32_bf16(a[n8], qf[4 * c + 2 * kh + k], acc[ng * 8 + n8], 0, 0, 0);
                        __builtin_amdgcn_sched_barrier(0); }
        }
        float mx = acc[0][0];
#pragma unroll
        for (int n = 0; n < 16; ++n) mx = fmaxf(fmaxf(mx, fmaxf(acc[n][0], acc[n][1])), fmaxf(acc[n][2], acc[n][3]));
        mx = fmaxf(mx, __shfl_xor(mx, 16)); mx = fmaxf(mx, __shfl_xor(mx, 32));
        float l = 0.f;
#pragma unroll
        for (int n = 0; n < 16; ++n)
#pragma unroll
            for (int r = 0; r < 4; ++r) { const float pv = __builtin_amdgcn_exp2f(acc[n][r] - mx); acc[n][r] = pv; l += pv; }
        l += __shfl_xor(l, 16); l += __shfl_xor(l, 32);
        const float linv = 1.0f / l;
        bf16x8 pf[8];
#pragma unroll
        for (int s = 0; s < 8; ++s) { v4u w; w.x = pg8::cvt_pk_bf16(acc[2 * s][0], acc[2 * s][1]); w.y = pg8::cvt_pk_bf16(acc[2 * s][2], acc[2 * s][3]);
            w.z = pg8::cvt_pk_bf16(acc[2 * s + 1][0], acc[2 * s + 1][1]); w.w = pg8::cvt_pk_bf16(acc[2 * s + 1][2], acc[2 * s + 1][3]); pf[s] = __builtin_bit_cast(bf16x8, w); }
        __builtin_amdgcn_sched_barrier(0);
        f32x4 o[32];
#pragma unroll
        for (int mm = 0; mm < 32; ++mm) o[mm] = (f32x4){0.f, 0.f, 0.f, 0.f};
#pragma unroll
        for (int cc = 0; cc < 4; ++cc) {
            AT_WAIT();
            if (cc < 3) AT_STAGE_V(cc + 1, (cc + 1) & 1);
            const LAS unsigned char* bb = lds + (cc & 1) * 65536 + aoff0; asm volatile("" : "+v"(bb));
#pragma unroll
            for (int k = 0; k < 2; ++k)
#pragma unroll
                for (int mg = 0; mg < 4; ++mg) { bf16x8 a[8];
#pragma unroll
                    for (int m8 = 0; m8 < 8; ++m8) a[m8] = *(const LAS bf16x8*)(bb + mg * 16384 + m8 * 2048 + k * 1024);
#pragma unroll
                    for (int m8 = 0; m8 < 8; ++m8) o[mg * 8 + m8] = __builtin_amdgcn_mfma_f32_16x16x32_bf16(a[m8], pf[2 * cc + k], o[mg * 8 + m8], 0, 0, 0);
                    __builtin_amdgcn_sched_barrier(0); }
        }
        bf16* op = obuf + tok * 2048 + h * 512 + 4 * fq;
#pragma unroll
        for (int mm = 0; mm < 32; ++mm) { v2u w; w.x = pg8::cvt_pk_bf16(o[mm][0] * linv, o[mm][1] * linv); w.y = pg8::cvt_pk_bf16(o[mm][2] * linv, o[mm][3] * linv); *(v2u*)(op + 16 * mm) = w; }
    }
    asm volatile("s_waitcnt vmcnt(0)" ::: "memory"); __syncthreads();
#undef AT_STAGE_K
#undef AT_STAGE_V
#undef AT_WAIT
}
struct S5Lane { float lbr, lbi; float Br[16], Bi[16]; };
__device__ __forceinline__ void s5_lane_params(int g, int p, S5Lane& L) {
    const float lr = fminf(ka_in(15)[g * 64 + p], -1e-4f), li = ka_in(16)[g * 64 + p], dt = expf(ka_in(17)[g]);
    const float ar = lr * dt, th = li * dt; float sn, cs; sincosf(th, &sn, &cs); const float e = expf(ar), sh = sinf(0.5f * th);
    L.lbr = e * cs; L.lbi = e * sn;
    const float nr = expm1f(ar) * cs - 2.0f * sh * sh, ni = e * sn;
    const float den = 1.0f / (lr * lr + li * li), cr = (nr * lr + ni * li) * den, ci = (ni * lr - nr * li) * den;
#pragma unroll
    for (int c = 0; c < 16; ++c) { const float br = ka_in(18)[(size_t)(g * 64 + p) * 16 + c], bi = ka_in(19)[(size_t)(g * 64 + p) * 16 + c]; L.Br[c] = cr * br - ci * bi; L.Bi[c] = cr * bi + ci * br; }
}
__device__ __forceinline__ void s5_step(const S5Lane& L, const bf16* urow, float& xr, float& xi) {
    const v4u w0 = *(const v4u*)urow, w1 = *(const v4u*)(urow + 8);
    float u[16] = {bflo(w0.x), bfhi(w0.x), bflo(w0.y), bfhi(w0.y), bflo(w0.z), bfhi(w0.z), bflo(w0.w), bfhi(w0.w), bflo(w1.x), bfhi(w1.x), bflo(w1.y), bfhi(w1.y), bflo(w1.z), bfhi(w1.z), bflo(w1.w), bfhi(w1.w)};
    float br = 0.f, bi = 0.f;
#pragma unroll
    for (int c = 0; c < 16; ++c) { br += L.Br[c] * u[c]; bi += L.Bi[c] * u[c]; }
    const float nr = L.lbr * xr - L.lbi * xi + br, ni = L.lbr * xi + L.lbi * xr + bi; xr = nr; xi = ni;
}
__device__ __forceinline__ void s5_pass_a(const bf16* ub, f32x2* st, int wave, int lane) {
    const int gw = blockIdx.x * NWAVES + wave, NGW = gridDim.x * NWAVES;
    for (int task = gw; task < BATCH * 128 * 64; task += NGW) {
        const int seg = task & 63, g = (task >> 6) & 127, b = task >> 13;
        S5Lane L; s5_lane_params(g, lane, L);
        float xr = 0.f, xi = 0.f; const bf16* up = ub + (size_t)(b * SEQ + seg * 64) * 2048 + 16 * g;
#pragma unroll 2
        for (int s = 0; s < 64; ++s) s5_step(L, up + (size_t)s * 2048, xr, xi);
        st[(size_t)task * 64 + lane] = (f32x2){xr, xi};
    }
}
__device__ __forceinline__ void s5_pass_c(LAS unsigned char* lds, const bf16* ub, const f32x2* st, bf16* yb, int wave, int lane) {
    LAS f32x2* Cs = (LAS f32x2*)(lds + wave * 16640);
    LAS f32x2* xs = (LAS f32x2*)(lds + wave * 16640 + 8320);
    const int gw = blockIdx.x * NWAVES + wave, NGW = gridDim.x * NWAVES;
    for (int task = gw; task < BATCH * 128 * 64; task += NGW) {
        const int seg = task & 63, g = (task >> 6) & 127, b = task >> 13;
        S5Lane L; s5_lane_params(g, lane, L);
#pragma unroll
        for (int c = 0; c < 16; ++c) Cs[c * 65 + lane] = (f32x2){ka_in(20)[(size_t)(g * 16 + c) * 64 + lane], ka_in(21)[(size_t)(g * 16 + c) * 64 + lane]};
        float Ar = L.lbr, Ai = L.lbi;
#pragma unroll
        for (int i = 0; i < 6; ++i) { const float nr = Ar * Ar - Ai * Ai, ni = 2.0f * Ar * Ai; Ar = nr; Ai = ni; }
        float xr = 0.f, xi = 0.f; const f32x2* sp = st + (size_t)(task - seg) * 64 + lane;
#pragma unroll 2
        for (int n = 0; n < seg; ++n) { const f32x2 s = sp[(size_t)n * 64]; const float nr = Ar * xr - Ai * xi + s.x, ni = Ar * xi + Ai * xr + s.y; xr = nr; xi = ni; }
        const bf16* up = ub + (size_t)(b * SEQ + seg * 64) * 2048 + 16 * g; bf16* yp = yb + (size_t)(b * SEQ + seg * 64) * 2048 + 16 * g;
        const int t = lane & 15, cq = lane >> 4;
        f32x4 dsk = *(const f32x4*)(ka_in(22) + g * 16 + 4 * cq);
#pragma unroll 1
        for (int blk = 0; blk < 4; ++blk) {
#pragma unroll 2
            for (int s = 0; s < 16; ++s) { s5_step(L, up + (size_t)(blk * 16 + s) * 2048, xr, xi); xs[s * 65 + lane] = (f32x2){xr, xi}; }
            LDS_WAIT();
            float acc[4] = {0.f, 0.f, 0.f, 0.f};
#pragma unroll 4
            for (int p = 0; p < 64; ++p) { const f32x2 x = xs[t * 65 + p];
#pragma unroll
                for (int j = 0; j < 4; ++j) { const f32x2 c = Cs[(4 * cq + j) * 65 + p]; acc[j] += c.x * x.x - c.y * x.y; } }
            const v2u uw = *(const v2u*)(up + (size_t)(blk * 16 + t) * 2048 + 4 * cq);
            const float y0 = gelu_exact(acc[0] + dsk[0] * bflo(uw.x)), y1 = gelu_exact(acc[1] + dsk[1] * bfhi(uw.x)), y2 = gelu_exact(acc[2] + dsk[2] * bflo(uw.y)), y3 = gelu_exact(acc[3] + dsk[3] * bfhi(uw.y));
            v2u ow; ow.x = pk2(y0, y1); ow.y = pk2(y2, y3); *(v2u*)(yp + (size_t)(blk * 16 + t) * 2048 + 4 * cq) = ow;
            LDS_WAIT();
        }
    }
}
__device__ __forceinline__ void s5_mfma(LAS unsigned char* lds, const bf16* ub, bf16* yb, int wave, int lane) {
    LAS f32x2* PW = (LAS f32x2*)(lds);
    LAS f32x2* BB = (LAS f32x2*)(lds + 8704);
    LAS f32x2* CC = (LAS f32x2*)(lds + 16896);
    LAS bf16* KST = (LAS bf16*)(lds + 25088);
    LAS unsigned char* UI = lds + 33280;
    LAS float* SL = (LAS float*)(lds + 66048);
    LAS bf16* XP = (LAS bf16*)(lds + 99840);
    const int tid = wave * 64 + lane, fr = lane & 15, fq = lane >> 4;
#ifndef S5_LOOP_REPS
#define S5_LOOP_REPS 1
#endif
    for (int unit = blockIdx.x; unit < 256; unit += gridDim.x) {
        const int b = unit >> 7, g = unit & 127;
        const bf16* usrc = ub + (size_t)(b * SEQ) * 2048 + 16 * g + (size_t)(tid >> 1) * 2048 + 8 * (tid & 1);
        v4u upre[4];
#pragma unroll
        for (int i = 0; i < 4; ++i) upre[i] = *(const v4u*)(usrc + (size_t)(256 * i) * 2048);
        const float ldt = ka_in(17)[g];
        float plr[3], pli[3];
#pragma unroll
        for (int it = 0; it < 3; ++it) { const int idx = tid + NTHREADS * it, p = idx & 63; plr[it] = ka_in(15)[g * 64 + p]; pli[it] = ka_in(16)[g * 64 + p]; }
        float pbr[2], pbi[2], pcr[2], pci[2];
#pragma unroll
        for (int it = 0; it < 2; ++it) { const int idx = tid + NTHREADS * it; pbr[it] = ka_in(18)[(size_t)g * 1024 + idx]; pbi[it] = ka_in(19)[(size_t)g * 1024 + idx]; pcr[it] = ka_in(20)[(size_t)g * 1024 + idx]; pci[it] = ka_in(21)[(size_t)g * 1024 + idx]; }
        float qlr[2], qli[2];
#pragma unroll
        for (int it = 0; it < 2; ++it) { const int p = (tid + NTHREADS * it) >> 4; qlr[it] = ka_in(15)[g * 64 + p]; qli[it] = ka_in(16)[g * 64 + p]; }
        const f32x4 dsk = *(const f32x4*)(ka_in(22) + g * 16 + 4 * fq);
        const float dt = expf(ldt);
        __syncthreads();
#pragma unroll
        for (int it = 0; it < 3; ++it) { const int idx = tid + NTHREADS * it; if (idx < 17 * 64) { const int e = idx >> 6;
            const float lr = fminf(plr[it], -1e-4f), li = pli[it]; float sn, cs; sincosf(li * dt * (float)e, &sn, &cs); const float ex = expf(lr * dt * (float)e);
            PW[idx] = (f32x2){ex * cs, ex * sn}; } }
#pragma unroll
        for (int it = 0; it < 2; ++it) { const int idx = tid + NTHREADS * it;
            const float lr = fminf(qlr[it], -1e-4f), li = qli[it]; const float ar = lr * dt, th = li * dt; float sn, cs; sincosf(th, &sn, &cs); const float e = expf(ar), sh = sinf(0.5f * th);
            const float nr = expm1f(ar) * cs - 2.0f * sh * sh, ni = e * sn, den = 1.0f / (lr * lr + li * li), cr = (nr * lr + ni * li) * den, ci = (ni * lr - nr * li) * den;
            BB[idx] = (f32x2){cr * pbr[it] - ci * pbi[it], cr * pbi[it] + ci * pbr[it]};
            CC[idx] = (f32x2){pcr[it], pci[it]}; }
        __syncthreads();
        bf16x8 A1[8];
        { const int ri = wave >> 2, p = 16 * (wave & 3) + fr; f32x2 bb[8];
#pragma unroll
            for (int j = 0; j < 8; ++j) bb[j] = BB[p * 16 + 8 * (fq & 1) + j];
#pragma unroll
            for (int ks = 0; ks < 8; ++ks) { const int s = 2 * ks + (fq >> 1); const f32x2 pw = PW[(15 - s) * 64 + p]; float v[8];
#pragma unroll
                for (int j = 0; j < 8; ++j) v[j] = ri ? (pw.x * bb[j].y + pw.y * bb[j].x) : (pw.x * bb[j].x - pw.y * bb[j].y);
                v4u w; w.x = pk2(v[0], v[1]); w.y = pk2(v[2], v[3]); w.z = pk2(v[4], v[5]); w.w = pk2(v[6], v[7]); A1[ks] = __builtin_bit_cast(bf16x8, w); }
            __builtin_amdgcn_sched_barrier(0); }
        const int t0 = wave, t1 = 15 - wave;
        bf16x8 CM[2][4];
        { f32x4 kacc[2] = {(f32x4){0.f, 0.f, 0.f, 0.f}, (f32x4){0.f, 0.f, 0.f, 0.f}};
#pragma unroll
            for (int h = 0; h < 2; ++h) { f32x2 cc[8], pa[8], pb[8];
#pragma unroll
                for (int j = 0; j < 8; ++j) { const int p = 32 * h + 8 * fq + j; cc[j] = CC[fr * 64 + p]; pa[j] = PW[(t0 + 1) * 64 + p]; pb[j] = PW[(t1 + 1) * 64 + p]; }
                float vr[8], vi[8];
#pragma unroll
                for (int j = 0; j < 8; ++j) { vr[j] = cc[j].x * pa[j].x - cc[j].y * pa[j].y; vi[j] = -(cc[j].x * pa[j].y + cc[j].y * pa[j].x); }
                { v4u w; w.x = pk2(vr[0], vr[1]); w.y = pk2(vr[2], vr[3]); w.z = pk2(vr[4], vr[5]); w.w = pk2(vr[6], vr[7]); CM[0][h] = __builtin_bit_cast(bf16x8, w);
                  w.x = pk2(vi[0], vi[1]); w.y = pk2(vi[2], vi[3]); w.z = pk2(vi[4], vi[5]); w.w = pk2(vi[6], vi[7]); CM[0][2 + h] = __builtin_bit_cast(bf16x8, w); }
#pragma unroll
                for (int j = 0; j < 8; ++j) { vr[j] = cc[j].x * pb[j].x - cc[j].y * pb[j].y; vi[j] = -(cc[j].x * pb[j].y + cc[j].y * pb[j].x); }
                { v4u w; w.x = pk2(vr[0], vr[1]); w.y = pk2(vr[2], vr[3]); w.z = pk2(vr[4], vr[5]); w.w = pk2(vr[6], vr[7]); CM[1][h] = __builtin_bit_cast(bf16x8, w);
                  w.x = pk2(vi[0], vi[1]); w.y = pk2(vi[2], vi[3]); w.z = pk2(vi[4], vi[5]); w.w = pk2(vi[6], vi[7]); CM[1][2 + h] = __builtin_bit_cast(bf16x8, w); }
                bf16x8 ctr, cti;
                { v4u w; w.x = pk2(cc[0].x, cc[1].x); w.y = pk2(cc[2].x, cc[3].x); w.z = pk2(cc[4].x, cc[5].x); w.w = pk2(cc[6].x, cc[7].x); ctr = __builtin_bit_cast(bf16x8, w);
                  w.x = pk2(-cc[0].y, -cc[1].y); w.y = pk2(-cc[2].y, -cc[3].y); w.z = pk2(-cc[4].y, -cc[5].y); w.w = pk2(-cc[6].y, -cc[7].y); cti = __builtin_bit_cast(bf16x8, w); }
                f32x2 bq[8];
#pragma unroll
                for (int j = 0; j < 8; ++j) bq[j] = BB[(32 * h + 8 * fq + j) * 16 + fr];
#pragma unroll
                for (int si = 0; si < 2; ++si) { const int s = 2 * wave + si;
#pragma unroll
                    for (int j = 0; j < 8; ++j) { const f32x2 pw = PW[(15 - s) * 64 + 32 * h + 8 * fq + j]; vr[j] = pw.x * bq[j].x - pw.y * bq[j].y; vi[j] = pw.x * bq[j].y + pw.y * bq[j].x; }
                    v4u w; w.x = pk2(vr[0], vr[1]); w.y = pk2(vr[2], vr[3]); w.z = pk2(vr[4], vr[5]); w.w = pk2(vr[6], vr[7]);
                    kacc[si] = __builtin_amdgcn_mfma_f32_16x16x32_bf16(__builtin_bit_cast(bf16x8, w), ctr, kacc[si], 0, 0, 0);
                    w.x = pk2(vi[0], vi[1]); w.y = pk2(vi[2], vi[3]); w.z = pk2(vi[4], vi[5]); w.w = pk2(vi[6], vi[7]);
                    kacc[si] = __builtin_amdgcn_mfma_f32_16x16x32_bf16(__builtin_bit_cast(bf16x8, w), cti, kacc[si], 0, 0, 0); }
                __builtin_amdgcn_sched_barrier(0); }
#pragma unroll
            for (int si = 0; si < 2; ++si) { const int s = 2 * wave + si; v2u kw; kw.x = pk2(kacc[si][0], kacc[si][1]); kw.y = pk2(kacc[si][2], kacc[si][3]);
                *(LAS v2u*)(KST + ((15 - s) * 16 + fr) * 16 + 4 * fq) = kw; } }
#pragma unroll 1
        for (int rep = 0; rep < S5_LOOP_REPS; ++rep) {
        float Xr = 0.f, Xi = 0.f;
#pragma unroll 1
        for (int q = 0; q < 4; ++q) {
            __syncthreads();
#pragma unroll
            for (int i = 0; i < 4; ++i) { const int piece = tid + NTHREADS * i, tok = piece >> 1, half = piece & 1;
                *(LAS v4u*)(UI + ((((tok & 15) * 64 + (tok >> 4)) * 2 + half) * 16)) = upre[i]; }
            { const int qn = (q + 1) & 3;
#pragma unroll
                for (int i = 0; i < 4; ++i) upre[i] = *(const v4u*)(usrc + (size_t)(qn * 1024 + 256 * i) * 2048); }
            __syncthreads();
#pragma unroll 1
            for (int nf = 0; nf < 4; ++nf) { f32x4 acc = (f32x4){0.f, 0.f, 0.f, 0.f};
#pragma unroll
                for (int ks = 0; ks < 8; ++ks) { const bf16x8 bfr = *(const LAS bf16x8*)(UI + ((((2 * ks + (fq >> 1)) * 64 + 16 * nf + fr) * 2 + (fq & 1)) * 16));
                    acc = __builtin_amdgcn_mfma_f32_16x16x32_bf16(A1[ks], bfr, acc, 0, 0, 0); }
                *(LAS f32x4*)(SL + (16 * nf + fr) * 132 + 16 * wave + 4 * fq) = acc; }
            __syncthreads();
            if (wave == 0) { const f32x2 a16 = PW[16 * 64 + lane];
#pragma unroll 1
                for (int nb = 0; nb < 64; nb += 16) { float sr[16], si[16];
#pragma unroll
                    for (int n = 0; n < 16; ++n) { sr[n] = SL[(nb + n) * 132 + lane]; si[n] = SL[(nb + n) * 132 + 64 + lane]; }
#pragma unroll
                    for (int n = 0; n < 16; ++n) { XP[(nb + n) * 136 + lane] = (bf16)f2bf(Xr); XP[(nb + n) * 136 + 64 + lane] = (bf16)f2bf(Xi);
                        const float nr = a16.x * Xr - a16.y * Xi + sr[n], ni = a16.x * Xi + a16.y * Xr + si[n]; Xr = nr; Xi = ni; } } }
            __syncthreads();
#pragma unroll 1
            for (int nf = 0; nf < 4; ++nf) { f32x4 acc0 = (f32x4){0.f, 0.f, 0.f, 0.f}, acc1 = acc0;
#pragma unroll
                for (int ks = 0; ks < 8; ++ks) { if (2 * ks <= t1 || 2 * ks <= t0) {
                    const int s = 2 * ks + (fq >> 1);
                    const bf16x8 bfr = *(const LAS bf16x8*)(UI + (((s * 64 + 16 * nf + fr) * 2 + (fq & 1)) * 16));
                    if (2 * ks <= t0) { bf16x8 tf = (bf16x8){0, 0, 0, 0, 0, 0, 0, 0}; if (s <= t0) tf = *(const LAS bf16x8*)(KST + ((t0 - s) * 16 + fr) * 16 + 8 * (fq & 1)); acc0 = __builtin_amdgcn_mfma_f32_16x16x32_bf16(tf, bfr, acc0, 0, 0, 0); }
                    if (2 * ks <= t1) { bf16x8 tf = (bf16x8){0, 0, 0, 0, 0, 0, 0, 0}; if (s <= t1) tf = *(const LAS bf16x8*)(KST + ((t1 - s) * 16 + fr) * 16 + 8 * (fq & 1)); acc1 = __builtin_amdgcn_mfma_f32_16x16x32_bf16(tf, bfr, acc1, 0, 0, 0); } } }
#pragma unroll
                for (int ks = 0; ks < 4; ++ks) { const bf16x8 xf = *(const LAS bf16x8*)(XP + (16 * nf + fr) * 136 + 32 * ks + 8 * fq);
                    acc0 = __builtin_amdgcn_mfma_f32_16x16x32_bf16(CM[0][ks], xf, acc0, 0, 0, 0); acc1 = __builtin_amdgcn_mfma_f32_16x16x32_bf16(CM[1][ks], xf, acc1, 0, 0, 0); }
#pragma unroll
                for (int ti = 0; ti < 2; ++ti) { const int t = ti ? t1 : t0; const f32x4 a = ti ? acc1 : acc0; const int n = 16 * nf + fr;
                    const v2u uw = *(const LAS v2u*)(UI + (((t * 64 + n) * 2 + (fq >> 1)) * 16) + 8 * (fq & 1));
                    const pg8::f32x2 g0 = pg8::gelu_pk((pg8::f32x2){a[0] + dsk[0] * bflo(uw.x), a[1] + dsk[1] * bfhi(uw.x)}), g1 = pg8::gelu_pk((pg8::f32x2){a[2] + dsk[2] * bflo(uw.y), a[3] + dsk[3] * bfhi(uw.y)});
                    v2u ow; ow.x = pg8::cvt_pk_bf16(g0.x, g0.y); ow.y = pg8::cvt_pk_bf16(g1.x, g1.y);
                    *(v2u*)(yb + (size_t)(b * SEQ + q * 1024 + 16 * n + t) * 2048 + 16 * g + 4 * fq) = ow; } }
        }
        }
    }
    __syncthreads();
}
#ifndef EN
#define EN(k) 1
#endif
template <int PH> __device__ __forceinline__ void run_phase(unsigned char* ws, float* X, LAS unsigned char* lds, int wave, int lane) {
    const int G = gridDim.x, bx = blockIdx.x;
    bf16* XB = (bf16*)(ws + WS_XB); float* SSQ = (float*)(ws + WS_SSQ);
    bf16* R0 = (bf16*)(ws + WS_R);
    constexpr int layer = (PH >= 10) ? 1 : 0;
    if constexpr (!EN(PH)) { return; }
    else if constexpr (PH == 0) p0_prologue(ws, lds, wave, lane);
    else if constexpr (PH == 1) {
        if (bx < 64) { const int i = bx >> 5;
            pg8::Gemm g{(const pg8::bf16_t*)(ws + WS_MEMB), (const pg8::bf16_t*)(ws + WS_W_KV + (size_t)i * 16 * MiB), MROWS, 4096, 2048}; pg8::StaticOrder S; S.init(MROWS, 4096, 32, bx & 31);
            pg8::EpiKV E{(pg8::bf16_t*)(ws + WS_KB + (size_t)i * 2 * MiB), (pg8::bf16_t*)(ws + WS_VB + (size_t)i * 2 * MiB), (pg8::bf16_t*)(ws + WS_VTB + (size_t)i * 2 * MiB), (const float*)(ws + WS_SSQM)};
            pg8::gemm_phase<pg8::EpiKV, pg8::StaticOrder, true, PG8_SP2V>(lds, g, S, E, wave, lane); }
        p1_convert(ws, lds, wave, lane);
    } else if constexpr (PH == 2) {
        pg8::Gemm g{XB, (const pg8::bf16_t*)(ws + WS_W_AIN), M, 4096, 2048}; pg8::StaticOrder S; S.init(M, 4096, G, bx);
        pg8::EpiAct<1, true> E{R0, 4096, ka_in(8), SSQ, 32, 1.0f, (float*)(ws + WS_VST), 8};
        pg8::gemm_phase<pg8::EpiAct<1, true>, pg8::StaticOrder, true, PG8_SP2V>(lds, g, S, E, wave, lane);
    } else if constexpr (PH == 3) {
#if defined(GATING_SIMPLE)
        gating_simple(lds, R0, (const float*)(ws + WS_VST), ka_in(9), ka_in(10), ka_in(11), ka_in(12), R0 + (size_t)M * 4096, wave * 64 + lane);
#else
        gating_mfma(lds, R0, (const float*)(ws + WS_VST), ka_in(9), ka_in(10), ka_in(11), ka_in(12), R0 + (size_t)M * 4096, wave, lane);
#endif
    }
    else if constexpr (PH == 4 || PH == 7 || PH == 9 || PH == 16 || PH == 18) {
        const pg8::bf16_t* A; const pg8::bf16_t* W; int K = 2048;
        if constexpr (PH == 4) { A = R0 + (size_t)M * 4096; W = (const pg8::bf16_t*)(ws + WS_W_AOUT); }
        else if constexpr (PH == 7 || PH == 16) { A = R0 + (size_t)M * 2048; W = (const pg8::bf16_t*)(ws + WS_W_O + (size_t)layer * 8 * MiB); }
        else { A = R0; W = (const pg8::bf16_t*)(ws + WS_W_DN + (size_t)layer * 32 * MiB); K = 8192; }
        pg8::Gemm g{A, W, M, 2048, K}; pg8::StaticOrder S; S.init(M, 2048, G, bx);
        pg8::EpiRes E{XB, SSQ};
        pg8::gemm_phase<pg8::EpiRes, pg8::StaticOrder, true, PG8_SP2V>(lds, g, S, E, wave, lane);
    } else if constexpr (PH == 5 || PH == 14 || PH == 10) {
        const pg8::bf16_t* W = (PH == 10) ? (const pg8::bf16_t*)(ws + WS_W_BIN) : (const pg8::bf16_t*)(ws + WS_W_Q + (size_t)layer * 8 * MiB);
        pg8::Gemm g{XB, W, M, 2048, 2048}; pg8::StaticOrder S; S.init(M, 2048, G, bx);
        pg8::EpiAct<0, false> E{R0, 2048, nullptr, SSQ, (PH == 14) ? 64 : 32, (PH == 10) ? 1.0f : 0.044194173824159216f * 1.4426950408889634f, nullptr, 0};
        pg8::gemm_phase<pg8::EpiAct<0, false>, pg8::StaticOrder, true, PG8_SP2V>(lds, g, S, E, wave, lane);
    } else if constexpr (PH == 6 || PH == 15) {
#if defined(ATTN_SIMPLE)
        attn_simple(lds, R0, (const bf16*)(ws + WS_KB + (size_t)layer * 2 * MiB), (const bf16*)(ws + WS_VB + (size_t)layer * 2 * MiB), R0 + (size_t)M * 2048, wave, lane);
#else
        attn_mfma(lds, R0, (const bf16*)(ws + WS_KB + (size_t)layer * 2 * MiB), (const bf16*)(ws + WS_VTB + (size_t)layer * 2 * MiB), R0 + (size_t)M * 2048, wave, lane);
#endif
    }
    else if constexpr (PH == 8 || PH == 17) {
        pg8::Gemm g{XB, (const pg8::bf16_t*)(ws + WS_W_UP + (size_t)layer * 32 * MiB), M, FF, 2048}; pg8::StaticOrder S; S.init(M, FF, G, bx);
        pg8::EpiAct<2, false> E{R0, FF, nullptr, SSQ, 32, 1.0f, nullptr, 0};
        pg8::gemm_phase<pg8::EpiAct<2, false>, pg8::StaticOrder, true, PG8_SP2V>(lds, g, S, E, wave, lane);
    } else if constexpr (PH == 11) {
#if defined(S5_SIMPLE)
        s5_pass_a(R0, (f32x2*)(ws + WS_S5ST), wave, lane);
#endif
    } else if constexpr (PH == 12) {
#if defined(S5_SIMPLE)
        s5_pass_c(lds, R0, (const f32x2*)(ws + WS_S5ST), R0 + (size_t)M * 2048, wave, lane);
#else
        s5_mfma(lds, R0, R0 + (size_t)M * 2048, wave, lane);
#endif
    }
    else if constexpr (PH == 13) {
        pg8::Gemm g{R0 + (size_t)M * 2048, (const pg8::bf16_t*)(ws + WS_W_BOUT), M, 4096, 2048}; pg8::StaticOrder S; S.init(M, 4096, G, bx);
        pg8::EpiGlu E{XB, SSQ, ka_in(24)};
        pg8::gemm_phase<pg8::EpiGlu, pg8::StaticOrder, true, PG8_SP2V>(lds, g, S, E, wave, lane);
    } else if constexpr (PH == 19) final_norm(XB, SSQ, ka_in(6), X, wave, lane);
}
__device__ __forceinline__ int lane_id() { int l; asm volatile("v_mbcnt_lo_u32_b32 %0, -1, 0\n\tv_mbcnt_hi_u32_b32 %0, -1, %0" : "=v"(l)); return l; }

#define XB_TMO      128
#define XB_XCNT(j)  (256  + 64 * (j))
#define XB_XSUB(j)  (1280 + 64 * (j))
#define XB_XGEN(j)  (2304 + 64 * (j))
#define XB_TOP      3328
#define XB_TOPGEN   3392
#define XCD_BAR_WORDS 3456
#define XB_SPIN_CAP (1u << 22)
__device__ __forceinline__ unsigned xb_ld(unsigned* p)              { return __hip_atomic_load(p, __ATOMIC_RELAXED, __HIP_MEMORY_SCOPE_AGENT); }
__device__ __forceinline__ unsigned xb_add(unsigned* p, unsigned v) { return __hip_atomic_fetch_add(p, v, __ATOMIC_RELAXED, __HIP_MEMORY_SCOPE_AGENT); }
__device__ __forceinline__ unsigned xb_xcc_id() { return (unsigned)__builtin_amdgcn_s_getreg((3 << 11) | 20) & 0xFu; }
#define XB_SPIN(cond, bar) do { unsigned _sp = 0; while (cond) { __builtin_amdgcn_s_sleep(1); \
    if ((++_sp & 255u) == 0u) { if (xb_ld(&(bar)[XB_TMO])) break; if (_sp > XB_SPIN_CAP) { atomicAdd(&(bar)[XB_TMO], 1u); break; } } } } while (0)
__device__ __forceinline__ void xcd_barrier_complete(unsigned* bar, unsigned x, unsigned& nloc, unsigned& nx) {
    const unsigned G = gridDim.x * gridDim.y * gridDim.z;
    unsigned sum, cnt, mine, sp = 0u;
    for (;;) {
        sum = 0u; cnt = 0u; mine = 0u;
#pragma unroll
        for (unsigned j = 0; j < 16; ++j) { const unsigned c = xb_ld(&bar[XB_XCNT(j)]); sum += c; cnt += (c > 0u) ? 1u : 0u; mine = (j == x) ? c : mine; }
        if (sum == G) break;
        __builtin_amdgcn_s_sleep(1);
        if ((++sp & 255u) == 0u) { if (xb_ld(&bar[XB_TMO])) break; if (sp > XB_SPIN_CAP) { atomicAdd(&bar[XB_TMO], 1u); break; } }
    }
    nloc = mine > 0u ? mine : 1u; nx = cnt > 0u ? cnt : 1u;
}
__device__ __forceinline__ void xcd_barrier(unsigned* bar, volatile LAS unsigned* st, bool is_t0) {
    asm volatile("s_waitcnt vmcnt(0)" ::: "memory");
    __syncthreads();
    if (is_t0) {
        __builtin_amdgcn_s_waitcnt(0);
        const unsigned x = xb_xcc_id();
        unsigned nloc = st[0], nx = st[1];
        if (nloc == 0u) { xcd_barrier_complete(bar, x, nloc, nx); st[0] = nloc; st[1] = nx; }
        const unsigned old = xb_add(&bar[XB_XSUB(x)], 1u);
        const unsigned gen = old / nloc;
        if (old + 1u == (gen + 1u) * nloc) {
            __builtin_amdgcn_fence(__ATOMIC_RELEASE, "agent");
            asm volatile("s_waitcnt vmcnt(0)" ::: "memory");
            const unsigned og = xb_add(&bar[XB_TOP], 1u);
            const unsigned tg = og / nx;
            if (og + 1u == (tg + 1u) * nx) xb_add(&bar[XB_TOPGEN], 1u);
            else XB_SPIN(xb_ld(&bar[XB_TOPGEN]) == tg, bar);
            __builtin_amdgcn_fence(__ATOMIC_ACQUIRE, "agent");
            xb_add(&bar[XB_XGEN(x)], 1u);
            asm volatile("s_waitcnt vmcnt(0)" ::: "memory");
        } else {
            XB_SPIN(xb_ld(&bar[XB_XGEN(x)]) == gen, bar);
            __builtin_amdgcn_fence(__ATOMIC_ACQUIRE, "agent");
            asm volatile("s_waitcnt vmcnt(0)" ::: "memory");
        }
    }
    __syncthreads();
}

__global__ void __launch_bounds__(NTHREADS, 2) trunk_fwd(Args args) {
    extern __shared__ __attribute__((aligned(16))) unsigned char lds_raw[];
    LAS unsigned char* lds = (LAS unsigned char*)lds_raw;
    const int wave = __builtin_amdgcn_readfirstlane((int)threadIdx.x >> 6);
    const int lo = args.ph_lo, hi = args.ph_hi;
    unsigned* bar = (unsigned*)args.ws + 4096;
    volatile LAS unsigned* st = (volatile LAS unsigned*)(lds + LDS_BYTES - 512);
#if MK_N_LAUNCHES == 1
    { const int l0 = lane_id(); if (wave == 0 && l0 < 2) st[l0] = 0u; __syncthreads(); if (wave == 0 && l0 == 0) (void)xb_add(&bar[XB_XCNT(xb_xcc_id())], 1u); }
#if defined(USE_CG_SYNC)
#define GRID_BAR(k) do { if ((k) == 1) cg::this_grid().sync(); else xcd_barrier(bar, st, wave == 0 && lane_id() == 0); } while (0)
#else
#define GRID_BAR(k) do { xcd_barrier(bar, st, wave == 0 && lane_id() == 0); } while (0)
#endif
#else
#define GRID_BAR(k) do { } while (0)
#endif
#ifndef DUP_PH
#define DUP_PH -1
#endif
#if defined(PROBE_GEMM)
#if PROBE_GEMM == 3
typedef pg8::StaticOrder ProbeOrder;
#else
struct ProbeOrder { int c;
    __device__ __forceinline__ void init(int, int, int, int c_) { c = c_; }
    __device__ __forceinline__ bool next(int i, pg8::Unit& u) const { if (i >= 4) return false;
#if PROBE_GEMM == 1
        u.pm = 0; u.pn = 0;
#else
        u.pm = c >> 3; u.pn = c & 7;
#endif
        return true; }
    __device__ __forceinline__ void a_ready(const pg8::Unit&) const {}
    __device__ __forceinline__ void done(const pg8::Unit&) const {} };
#endif
#endif
#if defined(STAMP_SEL)
#define STAMP(k) do { if (blockIdx.x == 0 && wave == 0 && lane_id() == 0) st[4 + (k)] = (unsigned)__builtin_amdgcn_s_memrealtime(); } while (0)
#else
#define STAMP(k) do { } while (0)
#endif
#define PHASE(k) if (lo <= (k) && (k) < hi) { if ((k) > lo) GRID_BAR(k); STAMP(k); run_phase<k>(args.ws, args.out, lds, wave, lane_id()); if ((k) == DUP_PH) { GRID_BAR(2); run_phase<k>(args.ws, args.out, lds, wave, lane_id()); } }
    PHASE(0) PHASE(1) PHASE(2) PHASE(3) PHASE(4) PHASE(5) PHASE(6) PHASE(7) PHASE(8) PHASE(9)
#if defined(PROBE_GEMM)
    { GRID_BAR(2); const int lane = lane_id(); unsigned char* ws = args.ws; bf16* R0 = (bf16*)(ws + WS_R);
      pg8::Gemm g{(bf16*)(ws + WS_XB), (const pg8::bf16_t*)(ws + WS_W_UP), M, FF, 2048}; ProbeOrder S; S.init(M, FF, gridDim.x, blockIdx.x);
      pg8::EpiAct<2, false> E{R0, FF, nullptr, (float*)(ws + WS_SSQ), 32, 1.0f, nullptr, 0};
      pg8::gemm_phase<pg8::EpiAct<2, false>, ProbeOrder, true, true>(lds, g, S, E, wave, lane); }
#endif
    PHASE(10)
#if defined(S5_SIMPLE)
    PHASE(11)
#endif
    PHASE(12) PHASE(13) PHASE(14) PHASE(15) PHASE(16) PHASE(17) PHASE(18) PHASE(19)
#undef PHASE
#if defined(STAMP_SEL)
    asm volatile("s_waitcnt vmcnt(0)" ::: "memory"); __syncthreads(); STAMP(20);
    if (blockIdx.x == 0 && wave == 0 && lane_id() == 0) { const unsigned d = (st[4 + STAMP_SEL_END] - st[4 + STAMP_SEL]) * STAMP_MUL; const unsigned t0 = (unsigned)__builtin_amdgcn_s_memrealtime();
        while ((unsigned)__builtin_amdgcn_s_memrealtime() - t0 < d) __builtin_amdgcn_s_sleep(8); }
#endif
}

extern "C" void kernel_launch(void* const* d_in, const int* in_sizes, int n_in, void* d_out, int out_size, void* d_ws, size_t ws_size, hipStream_t stream) {
    static int grid = 0;
    if (grid == 0) {
        if (n_in != 30 || out_size != M * D || ws_size < WS_END) { fprintf(stderr, "kernel_launch: unexpected shapes (n_in %d out %d ws %zu)\n", n_in, out_size, ws_size); grid = -1; return; }
        int dev = 0, cus = 0, per_cu = 0;
        if (hipGetDevice(&dev) != hipSuccess || hipDeviceGetAttribute(&cus, hipDeviceAttributeMultiprocessorCount, dev) != hipSuccess) { grid = -1; return; }
        if (hipFuncSetAttribute((const void*)trunk_fwd, hipFuncAttributeMaxDynamicSharedMemorySize, LDS_BYTES) != hipSuccess) { fprintf(stderr, "kernel_launch: hipFuncSetAttribute failed\n"); grid = -1; return; }
        if (hipOccupancyMaxActiveBlocksPerMultiprocessor(&per_cu, (const void*)trunk_fwd, NTHREADS, LDS_BYTES) != hipSuccess || per_cu < 1) { fprintf(stderr, "kernel_launch: occupancy query says %d\n", per_cu); grid = -1; return; }
        grid = cus;
    }
    if (grid < 0) return;
    if (hipMemsetAsync(d_ws, 0, 65536, stream) != hipSuccess) { fprintf(stderr, "kernel_launch: memset failed\n"); return; }
    Args a{};
    for (int i = 0; i < 30; ++i) a.in[i] = (const float*)d_in[i];
    a.out = (float*)d_out; a.ws = (unsigned char*)d_ws;
#if MK_N_LAUNCHES == 1
    a.ph_lo = 0; a.ph_hi = NPH;
    void* kargs[] = {&a};
    hipError_t e = hipLaunchCooperativeKernel((const void*)trunk_fwd, dim3(grid), dim3(NTHREADS), kargs, LDS_BYTES, stream);
    if (e != hipSuccess) fprintf(stderr, "kernel_launch: cooperative launch failed: %s\n", hipGetErrorString(e));
#else
    for (int ph = 0; ph < NPH; ++ph) { a.ph_lo = ph; a.ph_hi = ph + 1; hipLaunchKernelGGL(trunk_fwd, dim3(grid), dim3(NTHREADS), LDS_BYTES, stream, a); }
#endif
}
```

```cpp
#include <hip/hip_runtime.h>
#include <hip/hip_cooperative_groups.h>
#include <cstdio>
#include <cstdint>
namespace cg = cooperative_groups;
#define MK_N_LAUNCHES 1
#define PG8_SP2V true
namespace pg8 {
#define PG8_LAS __attribute__((address_space(3)))
typedef unsigned short bf16_t;
typedef short bf16x8 __attribute__((ext_vector_type(8)));
typedef float f32x4 __attribute__((ext_vector_type(4)));
typedef unsigned u32x4 __attribute__((ext_vector_type(4)));
constexpr int BM = 256, BK = 64, HALF = 128, HTB = HALF * BK * 2  , STAGE_BYTES = 8 * HTB, NXCD = 8, WGM = 8;

__host__ __device__ __forceinline__ int lds_byte(int r, int c) { const int st = (r >> 4) * 2 + (c >> 5), rr = r & 15, cc = c & 31, ob = rr * 64 + cc * 2; return st * 1024 + (ob ^ (((ob >> 9) & 1) << 5)); }
__host__ __device__ __forceinline__ void stage_rc(int b, int& R, int& C) { const int st = b / 1024, sb = b % 1024, swz = sb ^ (((sb >> 9) & 1) << 5); R = (st >> 1) * 16 + swz / 64; C = (st & 1) * 32 + (swz % 64) / 2; }
__host__ __device__ __forceinline__ int perm32(int rho) { const int n = rho >> 4, i = rho & 15; return 8 * (i >> 2) + 4 * n + (i & 3); }

struct Unit { int pm, pn; };
struct Gemm { const bf16_t* A; const bf16_t* Bt; int M, N, K; };

struct StaticOrder {
    int nM, nN, nwg, G, c;
    __host__ __device__ void init(int M, int N, int G_, int c_) { nM = M / BM; nN = N / BM; nwg = nM * nN; G = G_; c = c_; }
    __host__ __device__ bool next(int i, Unit& u) const {
        const long L = (long)i * G + c; if (L >= nwg) return false;
        int wgid = (int)L; { const int q = nwg / NXCD, r = nwg % NXCD, xcd = wgid % NXCD, off = wgid / NXCD; wgid = (xcd < r ? xcd * (q + 1) : r * (q + 1) + (xcd - r) * q) + off; }
        const int nig = WGM * nN, gid = wgid / nig, fm = gid * WGM, gsz = (nM - fm) < WGM ? (nM - fm) : WGM;
        u.pm = fm + ((wgid % nig) % gsz); u.pn = (wgid % nig) / gsz; return true;
    }
    __device__ __forceinline__ void a_ready(const Unit&) const {}
    __device__ __forceinline__ void done(const Unit&) const {}
};

__device__ __forceinline__ unsigned cvt_pk_bf16(float lo, float hi) { unsigned r; asm volatile("v_cvt_pk_bf16_f32 %0, %1, %2" : "=v"(r) : "v"(lo), "v"(hi)); return r; }
typedef float f32x2 __attribute__((ext_vector_type(2)));
__device__ __forceinline__ f32x2 gelu_pk(f32x2 v) {
    const f32x2 av = __builtin_elementwise_abs(v), d = av * 0.2316418882f + 1.0f;
    f32x2 t; t.x = __builtin_amdgcn_rcpf(d.x); t.y = __builtin_amdgcn_rcpf(d.y);
    f32x2 q = t * 0.5307027145f + (-0.7265760135f); q = q * t + 0.7107068705f; q = q * t + (-0.142248368f); q = q * t + 0.127414796f; q = q * t;
    const f32x2 s = (v * v) * (-0.72134752044f);
    f32x2 e; e.x = __builtin_amdgcn_exp2f(s.x); e.y = __builtin_amdgcn_exp2f(s.y);
    const f32x2 m = v * (q * e), r = v - m;
    f32x2 o; o.x = v.x < 0.f ? m.x : r.x; o.y = v.y < 0.f ? m.y : r.y; return o;
}
typedef unsigned u32x2 __attribute__((ext_vector_type(2)));
constexpr int SSQ_STRIDE = 64;
__device__ __forceinline__ float row_rstd(const float* ssq, int np, int row, int fq) {
    const float* p = ssq + (size_t)row * SSQ_STRIDE + fq * (np >> 2);
    f32x4 a = *(const f32x4*)p, b = *(const f32x4*)(p + 4);
    float s = (a[0] + a[1]) + (a[2] + a[3]) + (b[0] + b[1]) + (b[2] + b[3]);
    if (np == 64) { f32x4 c = *(const f32x4*)(p + 8), d = *(const f32x4*)(p + 12); s += (c[0] + c[1]) + (c[2] + c[3]) + (d[0] + d[1]) + (d[2] + d[3]); }
    s += __shfl_xor(s, 16); s += __shfl_xor(s, 32);
    return __builtin_amdgcn_rsqf(s * (1.0f / 2048.0f) + 1e-6f);
}
template <int ACT, bool STATS> struct EpiAct {
    static constexpr bool PERM = true, AFTER_DRAIN = false;
    bf16_t* O; int ldc; const float* bias; const float* ssq; int np; float oscale; float* vst; int stat_pn0;
    __device__ __forceinline__ void operator()(const f32x4 (&acc)[2][2][4][2], const Unit& u, int wr, int wc, int fr, int fq) const {
        const int row0 = u.pm * BM + wr * 64 + fr, col0 = u.pn * BM + wc * 32 + 8 * fq;
        f32x4 bv[2][2];
#pragma unroll
        for (int bj = 0; bj < 2; ++bj)
#pragma unroll
            for (int n = 0; n < 2; ++n) bv[bj][n] = bias ? *(const f32x4*)(bias + col0 + bj * HALF + 4 * n) : (f32x4){0.f, 0.f, 0.f, 0.f};
        float rsv[2][4];
#pragma unroll
        for (int ai = 0; ai < 2; ++ai) {
#pragma unroll
            for (int m = 0; m < 4; ++m) rsv[ai][m] = row_rstd(ssq, np, row0 + ai * HALF + m * 16, fq); }
#pragma unroll
        for (int ai = 0; ai < 2; ++ai)
#pragma unroll
            for (int m = 0; m < 4; ++m) { const int row = row0 + ai * HALF + m * 16; const float rs = rsv[ai][m];
                bf16_t* rowp = O + (size_t)row * ldc + col0; float s1 = 0.f, s2 = 0.f;
#pragma unroll
                for (int bj = 0; bj < 2; ++bj) { f32x4 v0 = acc[ai][bj][m][0] * rs + bv[bj][0], v1 = acc[ai][bj][m][1] * rs + bv[bj][1];
                    if (ACT == 1) { f32x2 a = gelu_pk((f32x2){v0[0], v0[1]}), b = gelu_pk((f32x2){v0[2], v0[3]}), c = gelu_pk((f32x2){v1[0], v1[1]}), d = gelu_pk((f32x2){v1[2], v1[3]});
                        v0 = (f32x4){a.x, a.y, b.x, b.y}; v1 = (f32x4){c.x, c.y, d.x, d.y}; }
                    if (ACT == 2) {
#pragma unroll
                        for (int j = 0; j < 4; ++j) { const float a = fmaxf(v0[j], 0.f), b = fmaxf(v1[j], 0.f); v0[j] = a * a; v1[j] = b * b; } }
                    v0 = v0 * oscale; v1 = v1 * oscale;
                    if (STATS) { s1 += (v0[0] + v0[1]) + (v0[2] + v0[3]) + (v1[0] + v1[1]) + (v1[2] + v1[3]);
                        s2 += (v0[0] * v0[0] + v0[1] * v0[1]) + (v0[2] * v0[2] + v0[3] * v0[3]) + (v1[0] * v1[0] + v1[1] * v1[1]) + (v1[2] * v1[2] + v1[3] * v1[3]); }
                    u32x4 w; w.x = cvt_pk_bf16(v0[0], v0[1]); w.y = cvt_pk_bf16(v0[2], v0[3]); w.z = cvt_pk_bf16(v1[0], v1[1]); w.w = cvt_pk_bf16(v1[2], v1[3]);
                    *(u32x4*)(rowp + bj * HALF) = w; }
                if (STATS) { s1 += __shfl_xor(s1, 16); s1 += __shfl_xor(s1, 32); s2 += __shfl_xor(s2, 16); s2 += __shfl_xor(s2, 32);
                    if (u.pn >= stat_pn0 && fq == 0) *(f32x2*)(vst + (size_t)row * SSQ_STRIDE + ((u.pn - stat_pn0) * 4 + wc) * 2) = (f32x2){s1, s2}; }
            }
    }
};
struct EpiRes {
    static constexpr bool PERM = true, AFTER_DRAIN = false;
    bf16_t* xb; float* ssq;
    __device__ __forceinline__ void operator()(const f32x4 (&acc)[2][2][4][2], const Unit& u, int wr, int wc, int fr, int fq) const {
        const int row0 = u.pm * BM + wr * 64 + fr, col0 = u.pn * BM + wc * 32 + 8 * fq;
#pragma unroll
        for (int ai = 0; ai < 2; ++ai) {
            u32x4 pre[4][2];
#pragma unroll
            for (int m = 0; m < 4; ++m) { const size_t off = (size_t)(row0 + ai * HALF + m * 16) * 2048 + col0;
#pragma unroll
                for (int bj = 0; bj < 2; ++bj) pre[m][bj] = *(const u32x4*)(xb + off + bj * HALF); }
            asm volatile("" ::: "memory");
#pragma unroll
            for (int m = 0; m < 4; ++m) { const int row = row0 + ai * HALF + m * 16; const size_t off = (size_t)row * 2048 + col0; float ss = 0.f;
#pragma unroll
                for (int bj = 0; bj < 2; ++bj) { const u32x4 b = pre[m][bj]; const f32x4 a0 = acc[ai][bj][m][0], a1 = acc[ai][bj][m][1];
                    const float o0 = __builtin_bit_cast(float, b.x << 16) + a0[0], o1 = __builtin_bit_cast(float, b.x & 0xffff0000u) + a0[1], o2 = __builtin_bit_cast(float, b.y << 16) + a0[2], o3 = __builtin_bit_cast(float, b.y & 0xffff0000u) + a0[3];
                    const float o4 = __builtin_bit_cast(float, b.z << 16) + a1[0], o5 = __builtin_bit_cast(float, b.z & 0xffff0000u) + a1[1], o6 = __builtin_bit_cast(float, b.w << 16) + a1[2], o7 = __builtin_bit_cast(float, b.w & 0xffff0000u) + a1[3];
                    ss += (o0 * o0 + o1 * o1) + (o2 * o2 + o3 * o3) + (o4 * o4 + o5 * o5) + (o6 * o6 + o7 * o7);
                    u32x4 w; w.x = cvt_pk_bf16(o0, o1); w.y = cvt_pk_bf16(o2, o3); w.z = cvt_pk_bf16(o4, o5); w.w = cvt_pk_bf16(o6, o7); *(u32x4*)(xb + off + bj * HALF) = w; }
                ss += __shfl_xor(ss, 16); ss += __shfl_xor(ss, 32);
                if (fq == 0) ssq[(size_t)row * SSQ_STRIDE + u.pn * 4 + wc] = ss; }
            asm volatile("" ::: "memory"); }
    }
};
struct EpiGlu {
    static constexpr bool PERM = false, AFTER_DRAIN = false;
    bf16_t* xb; float* ssq; const float* bias;
    __device__ __forceinline__ void operator()(const f32x4 (&acc)[2][2][4][2], const Unit& u, int wr, int wc, int fr, int fq) const {
        const int row0 = u.pm * BM + wr * 64 + fr, col0 = u.pn * 128 + wc * 16 + 4 * fq;
        f32x4 bval[2], bgate[2];
#pragma unroll
        for (int bj = 0; bj < 2; ++bj) { bval[bj] = *(const f32x4*)(bias + col0 + bj * 64); bgate[bj] = *(const f32x4*)(bias + 2048 + col0 + bj * 64); }
#pragma unroll
        for (int ai = 0; ai < 2; ++ai) {
            u32x2 pre[4][2];
#pragma unroll
            for (int m = 0; m < 4; ++m) { const size_t off = (size_t)(row0 + ai * HALF + m * 16) * 2048 + col0;
#pragma unroll
                for (int bj = 0; bj < 2; ++bj) pre[m][bj] = *(const u32x2*)(xb + off + bj * 64); }
            asm volatile("" ::: "memory");
#pragma unroll
            for (int m = 0; m < 4; ++m) { const int row = row0 + ai * HALF + m * 16; const size_t off = (size_t)row * 2048 + col0; float ss = 0.f;
#pragma unroll
                for (int bj = 0; bj < 2; ++bj) { const f32x4 val = acc[ai][bj][m][0] + bval[bj], gate = acc[ai][bj][m][1] + bgate[bj]; const u32x2 pb = pre[m][bj]; f32x4 o = (f32x4){__builtin_bit_cast(float, pb.x << 16), __builtin_bit_cast(float, pb.x & 0xffff0000u), __builtin_bit_cast(float, pb.y << 16), __builtin_bit_cast(float, pb.y & 0xffff0000u)};
#pragma unroll
                    for (int j = 0; j < 4; ++j) { const float sg = __builtin_amdgcn_rcpf(1.0f + __builtin_amdgcn_exp2f(-1.4426950408889634f * gate[j])); o[j] += val[j] * sg; }
                    ss += (o[0] * o[0] + o[1] * o[1]) + (o[2] * o[2] + o[3] * o[3]);
                    u32x2 w; w.x = cvt_pk_bf16(o[0], o[1]); w.y = cvt_pk_bf16(o[2], o[3]); *(u32x2*)(xb + off + bj * 64) = w; }
                ss += __shfl_xor(ss, 16); ss += __shfl_xor(ss, 32);
                if (fq == 0) ssq[(size_t)row * SSQ_STRIDE + u.pn * 4 + wc] = ss; }
            asm volatile("" ::: "memory"); }
    }
};
__host__ __device__ __forceinline__ int vt_pos(int key) { const int s = key >> 5, w = key & 31; return 32 * s + 8 * ((w & 15) >> 2) + (w & 3) + 4 * (w >> 4); }
struct EpiKV {
    static constexpr bool PERM = true, AFTER_DRAIN = false;
    bf16_t* Kb; bf16_t* Vb; bf16_t* VTb; const float* ssq;
    __device__ __forceinline__ void operator()(const f32x4 (&acc)[2][2][4][2], const Unit& u, int wr, int wc, int fr, int fq) const {
        const int row0 = u.pm * BM + wr * 64 + fr, col0 = u.pn * BM + wc * 32 + 8 * fq;
#pragma unroll
        for (int ai = 0; ai < 2; ++ai)
#pragma unroll
            for (int m = 0; m < 4; ++m) { const int row = row0 + ai * HALF + m * 16; const float rs = row_rstd(ssq, 32, row, fq); const int b = row >> 8, key = row & 255;
#pragma unroll
                for (int bj = 0; bj < 2; ++bj) { const f32x4 v0 = acc[ai][bj][m][0] * rs, v1 = acc[ai][bj][m][1] * rs; const int col = col0 + bj * HALF;
                    u32x4 w; w.x = cvt_pk_bf16(v0[0], v0[1]); w.y = cvt_pk_bf16(v0[2], v0[3]); w.z = cvt_pk_bf16(v1[0], v1[1]); w.w = cvt_pk_bf16(v1[2], v1[3]);
                    if (col < 2048) { const int h = col >> 9, d = col & 511; *(u32x4*)(Kb + ((size_t)((b * 4 + h) * 256 + key)) * 512 + d) = w; }
                    else { const int c2 = col - 2048, h = c2 >> 9, d = c2 & 511; *(u32x4*)(Vb + ((size_t)((b * 4 + h) * 256 + key)) * 512 + d) = w;
                        bf16_t* vt = VTb + ((size_t)((b * 4 + h) * 512 + d)) * 256 + vt_pos(key);
                        vt[0 * 256] = (bf16_t)(w.x & 0xffffu); vt[1 * 256] = (bf16_t)(w.x >> 16); vt[2 * 256] = (bf16_t)(w.y & 0xffffu); vt[3 * 256] = (bf16_t)(w.y >> 16);
                        vt[4 * 256] = (bf16_t)(w.z & 0xffffu); vt[5 * 256] = (bf16_t)(w.z >> 16); vt[6 * 256] = (bf16_t)(w.w & 0xffffu); vt[7 * 256] = (bf16_t)(w.w >> 16); } }
            }
    }
};
template <class Epi, class Sched, bool ALIGN_EPI = false, bool SP2 = false>
__device__ __forceinline__ void gemm_phase(PG8_LAS unsigned char* lds, const Gemm g, const Sched& S, const Epi& E, const int wid  , const int lane) {
    const int tid = wid * 64 + lane, wr = wid >> 2, wc = wid & 3, fr = lane & 15, fq = lane >> 4;
    const int K = g.K, nt = K / BK;
    unsigned voffA[2], voffB[2];
#pragma unroll
    for (int i = 0; i < 2; ++i) { int R, C; stage_rc(tid * 16 + i * 8192, R, C); const int Rb = Epi::PERM ? ((R & ~31) + perm32(R & 31)) : R;
        voffA[i] = (unsigned)(R * K + C) * 2u; voffB[i] = (unsigned)(Rb * K + C) * 2u; }
    const size_t kstep = (size_t)(BK * 2);
    const size_t hstep = (size_t)HALF * K * 2;
    const size_t tstep = 2 * hstep;
    const unsigned ldsw = (unsigned)wid * 1024u;
    const int aoff = lds_byte(wr * 64 + fr, fq * 8), boff = lds_byte(wc * 32 + fr, fq * 8);
#define PG8_SA(b, h) (((b) * 2 + (h)) * HTB)
#define PG8_SB(b, h) ((4 + (b) * 2 + (h)) * HTB)
#define PG8_STAGE(bufoff, gbase, voff) do { _Pragma("unroll") for (int _i = 0; _i < 2; ++_i) \
        __builtin_amdgcn_global_load_lds((const unsigned*)((const char*)(gbase) + (voff)[_i]), (PG8_LAS unsigned*)(lds + (bufoff) + ldsw + _i * 8192), 16, 0, 0); } while (0)
#define PG8_LDA(dst, b, h) do { _Pragma("unroll") for (int m = 0; m < 4; ++m) _Pragma("unroll") for (int k = 0; k < 2; ++k) dst[m][k] = *(const PG8_LAS bf16x8*)(lds + PG8_SA(b, h) + aoff + m * 2048 + k * 1024); } while (0)
#define PG8_LDB(dst, b, h) do { _Pragma("unroll") for (int n = 0; n < 2; ++n) _Pragma("unroll") for (int k = 0; k < 2; ++k) dst[n][k] = *(const PG8_LAS bf16x8*)(lds + PG8_SB(b, h) + boff + n * 2048 + k * 1024); } while (0)
#define PG8_MMA(ai, bj, At, Bt) do { __builtin_amdgcn_s_setprio(1); _Pragma("unroll") for (int m = 0; m < 4; ++m) _Pragma("unroll") for (int n = 0; n < 2; ++n) _Pragma("unroll") for (int k = 0; k < 2; ++k) \
        acc[ai][bj][m][n] = __builtin_amdgcn_mfma_f32_16x16x32_bf16(Bt[n][k], At[m][k], acc[ai][bj][m][n], 0, 0, 0); __builtin_amdgcn_s_setprio(0); } while (0)
#define PG8_WAIT_V(n) asm volatile("s_waitcnt vmcnt(" #n ")" ::: "memory")
#define PG8_WAIT_L(n) asm volatile("s_waitcnt lgkmcnt(" #n ")" ::: "memory")
#define PG8_BAR __builtin_amdgcn_s_barrier()
#define PG8_SCHED __builtin_amdgcn_sched_barrier(0)
    Unit cur, nxt; int ui = 0;
    if (!S.next(0, cur)) return;
    f32x4 acc[2][2][4][2];
#pragma unroll
    for (int a = 0; a < 2; ++a)
#pragma unroll
        for (int b = 0; b < 2; ++b)
#pragma unroll
            for (int m = 0; m < 4; ++m)
#pragma unroll
                for (int n = 0; n < 2; ++n) acc[a][b][m][n] = (f32x4){0.f, 0.f, 0.f, 0.f};
    bf16x8 At[4][2], B0[2][2], B1[2][2];
    const char* cA = (const char*)g.A + (size_t)cur.pm * tstep; const char* cB = (const char*)g.Bt + (size_t)cur.pn * tstep;
    S.a_ready(cur);
    if constexpr (SP2) {
        PG8_STAGE(PG8_SB(0, 0), cB, voffB); PG8_STAGE(PG8_SB(0, 1), cB + hstep, voffB); PG8_STAGE(PG8_SA(0, 0), cA, voffA); PG8_STAGE(PG8_SA(0, 1), cA + hstep, voffA);
        if (wr == 1) PG8_BAR;
        PG8_WAIT_V(2); PG8_BAR;
        PG8_STAGE(PG8_SB(1, 0), cB + kstep, voffB); PG8_STAGE(PG8_SA(1, 0), cA + kstep, voffA); PG8_STAGE(PG8_SB(1, 1), cB + hstep + kstep, voffB);
        PG8_WAIT_V(6); PG8_BAR;
    } else {
        PG8_STAGE(PG8_SB(0, 0), cB, voffB); PG8_STAGE(PG8_SA(0, 0), cA, voffA); PG8_STAGE(PG8_SB(0, 1), cB + hstep, voffB); PG8_STAGE(PG8_SA(0, 1), cA + hstep, voffA);
        if (wr == 1) PG8_BAR;
        PG8_WAIT_V(4); PG8_BAR;
        PG8_STAGE(PG8_SB(1, 0), cB + kstep, voffB); PG8_STAGE(PG8_SA(1, 0), cA + kstep, voffA); PG8_STAGE(PG8_SB(1, 1), cB + hstep + kstep, voffB);
        PG8_WAIT_V(6); PG8_BAR;
    }
    for (;;) {
        const bool has_next = S.next(ui + 1, nxt);
        const char* nA = has_next ? (const char*)g.A + (size_t)nxt.pm * tstep : cA; const char* nB = has_next ? (const char*)g.Bt + (size_t)nxt.pn * tstep : cB;
        for (int t = 0; t < nt; t += 2) {
            const bool last = (t == nt - 2);
            const char* a1 = cA + (size_t)(t + 1) * kstep;
            const char* a2 = last ? nA : cA + (size_t)(t + 2) * kstep; const char* b2 = last ? nB : cB + (size_t)(t + 2) * kstep;
            const char* a3 = a2 + kstep; const char* b3 = b2 + kstep;
            if (last && has_next) S.a_ready(nxt);
            if constexpr (SP2) {
            PG8_LDB(B0, 0, 0); PG8_LDB(B1, 0, 1); PG8_SCHED; PG8_LDA(At, 0, 0); PG8_STAGE(PG8_SA(1, 1), a1 + hstep, voffA);
            PG8_WAIT_V(8); PG8_WAIT_L(0); PG8_BAR; PG8_MMA(0, 0, At, B0); PG8_MMA(0, 1, At, B1); PG8_BAR; PG8_SCHED;
            PG8_LDA(At, 0, 1); PG8_STAGE(PG8_SB(0, 0), b2, voffB); PG8_STAGE(PG8_SB(0, 1), b2 + hstep, voffB); PG8_STAGE(PG8_SA(0, 0), a2, voffA);
            PG8_WAIT_V(8); PG8_WAIT_L(0); PG8_BAR; PG8_MMA(1, 0, At, B0); PG8_MMA(1, 1, At, B1); PG8_BAR; PG8_SCHED;
            PG8_LDB(B0, 1, 0); PG8_LDB(B1, 1, 1); PG8_SCHED; PG8_LDA(At, 1, 0); PG8_STAGE(PG8_SA(0, 1), a2 + hstep, voffA);
            PG8_WAIT_V(8); PG8_WAIT_L(0); PG8_BAR; PG8_MMA(0, 0, At, B0); PG8_MMA(0, 1, At, B1); PG8_BAR; PG8_SCHED;
            PG8_LDA(At, 1, 1); PG8_STAGE(PG8_SB(1, 0), b3, voffB); PG8_STAGE(PG8_SB(1, 1), b3 + hstep, voffB); PG8_STAGE(PG8_SA(1, 0), a3, voffA);
            PG8_WAIT_V(8); PG8_WAIT_L(0); PG8_BAR; PG8_MMA(1, 0, At, B0); PG8_MMA(1, 1, At, B1); PG8_BAR; PG8_SCHED;
            } else {
            PG8_LDB(B0, 0, 0); PG8_SCHED; PG8_LDA(At, 0, 0); PG8_STAGE(PG8_SA(1, 1), a1 + hstep, voffA);
            PG8_WAIT_L(8); PG8_BAR; PG8_WAIT_L(0); PG8_MMA(0, 0, At, B0); PG8_BAR; PG8_SCHED;
            PG8_LDB(B1, 0, 1); PG8_STAGE(PG8_SB(0, 0), b2, voffB);
            PG8_BAR; PG8_WAIT_L(0); PG8_MMA(0, 1, At, B1); PG8_BAR;
            PG8_LDA(At, 0, 1); PG8_STAGE(PG8_SA(0, 0), a2, voffA);
            PG8_BAR; PG8_WAIT_L(0); PG8_MMA(1, 0, At, B0); PG8_BAR; PG8_SCHED;
            PG8_STAGE(PG8_SB(0, 1), b2 + hstep, voffB);
            PG8_WAIT_V(6); PG8_BAR; PG8_MMA(1, 1, At, B1); PG8_BAR;
            PG8_LDB(B0, 1, 0); PG8_SCHED; PG8_LDA(At, 1, 0); PG8_STAGE(PG8_SA(0, 1), a2 + hstep, voffA);
            PG8_WAIT_L(8); PG8_BAR; PG8_WAIT_L(0); PG8_MMA(0, 0, At, B0); PG8_BAR; PG8_SCHED;
            PG8_LDB(B1, 1, 1); PG8_STAGE(PG8_SB(1, 0), b3, voffB);
            PG8_BAR; PG8_WAIT_L(0); PG8_MMA(0, 1, At, B1); PG8_BAR;
            PG8_LDA(At, 1, 1); PG8_STAGE(PG8_SA(1, 0), a3, voffA);
            PG8_BAR; PG8_WAIT_L(0); PG8_MMA(1, 0, At, B0); PG8_BAR; PG8_SCHED;
            PG8_STAGE(PG8_SB(1, 1), b3 + hstep, voffB);
            PG8_WAIT_V(6); PG8_BAR; PG8_MMA(1, 1, At, B1); PG8_BAR;
            }
        }
        if constexpr (ALIGN_EPI) { if (wr == 0) PG8_BAR; }
        if constexpr (!Epi::AFTER_DRAIN) { Unit ue = cur; asm volatile("" : "+s"(ue.pm), "+s"(ue.pn));
            int fre = fr, fqe = fq; asm volatile("" : "+v"(fre), "+v"(fqe)); E(acc, ue, wr, wc, fre, fqe); S.done(cur); }
        if (!has_next) break;
#pragma unroll
        for (int a = 0; a < 2; ++a)
#pragma unroll
            for (int b = 0; b < 2; ++b)
#pragma unroll
                for (int m = 0; m < 4; ++m)
#pragma unroll
                    for (int n = 0; n < 2; ++n) acc[a][b][m][n] = (f32x4){0.f, 0.f, 0.f, 0.f};
        cur = nxt; cA = nA; cB = nB; ++ui;
        if constexpr (ALIGN_EPI) { if (wr == 1) PG8_BAR; }
    }
    PG8_WAIT_V(0);
    if constexpr (!ALIGN_EPI) { if (wr == 0) PG8_BAR; }
    PG8_BAR;
    if constexpr (Epi::AFTER_DRAIN) { E.fused(acc, cur, wr, wc, fr, fq, lds, wid, lane); S.done(cur); }
#undef PG8_SA
#undef PG8_SB
#undef PG8_STAGE
#undef PG8_LDA
#undef PG8_LDB
#undef PG8_MMA
#undef PG8_WAIT_V
#undef PG8_WAIT_L
#undef PG8_BAR
#undef PG8_SCHED
}
}
#ifndef MK_N_LAUNCHES
#define MK_N_LAUNCHES 1
#endif
constexpr int BATCH = 2, SEQ = 4096, D = 2048, M = BATCH * SEQ, MEMLEN = 256, MROWS = BATCH * MEMLEN, FF = 8192;
constexpr int NWAVES = 8, NTHREADS = 512, NPH = 20;
constexpr int LDS_BYTES = 147456;
constexpr size_t MiB = 1u << 20;
constexpr size_t WS_W_AIN = 2 * MiB, WS_W_AOUT = 18 * MiB, WS_W_BIN = 26 * MiB, WS_W_BOUT = 34 * MiB, WS_W_Q = 50 * MiB, WS_W_KV = 66 * MiB, WS_W_O = 98 * MiB, WS_W_UP = 114 * MiB, WS_W_DN = 178 * MiB;
constexpr size_t WS_XB = 242 * MiB, WS_MEMB = 274 * MiB, WS_KB = 276 * MiB, WS_VB = 280 * MiB, WS_VTB = 284 * MiB, WS_SSQ = 288 * MiB, WS_VST = 290 * MiB, WS_SSQM = 292 * MiB, WS_S5ST = 294 * MiB;
constexpr size_t WS_R = 304 * MiB, WS_END = 432 * MiB;
#define GAS __attribute__((address_space(1)))
#define LAS __attribute__((address_space(3)))
typedef unsigned short bf16;
typedef unsigned v4u __attribute__((ext_vector_type(4)));
typedef unsigned v2u __attribute__((ext_vector_type(2)));
typedef float f32x4 __attribute__((ext_vector_type(4)));
typedef float f32x2 __attribute__((ext_vector_type(2)));
typedef short bf16x8 __attribute__((ext_vector_type(8)));
#define LDS_WAIT() asm volatile("s_waitcnt lgkmcnt(0)" ::: "memory")
__device__ __forceinline__ unsigned f2bf(float f) { unsigned u = __builtin_bit_cast(unsigned, f); return (u + 0x7fffu + ((u >> 16) & 1u)) >> 16; }
__device__ __forceinline__ unsigned pk2(float lo, float hi) { return f2bf(lo) | (f2bf(hi) << 16); }
__device__ __forceinline__ float bflo(unsigned w) { return __builtin_bit_cast(float, w << 16); }
__device__ __forceinline__ float bfhi(unsigned w) { return __builtin_bit_cast(float, w & 0xffff0000u); }
__device__ __forceinline__ float wave_sum(float v) {
#pragma unroll
    for (int o = 1; o < 64; o <<= 1) v += __shfl_xor(v, o);
    return v;
}
__device__ __forceinline__ float wave_max(float v) {
#pragma unroll
    for (int o = 1; o < 64; o <<= 1) v = fmaxf(v, __shfl_xor(v, o));
    return v;
}
__device__ __forceinline__ float gelu_exact(float v) { return 0.5f * v * (1.0f + erff(v * 0.70710678118654752f)); }

struct Args { const float* in[30]; float* out; unsigned char* ws; int ph_lo, ph_hi; };
__device__ __forceinline__ const float* ka_in(int i) { const __attribute__((address_space(4))) char* ka = (const __attribute__((address_space(4))) char*)__builtin_amdgcn_kernarg_segment_ptr(); asm volatile("" : "+s"(ka)); return *(const float* const __attribute__((address_space(4)))*)(ka + 8 * i); }

#if defined(STAMP_SEL)
#define STAMP2(lds_, id) do { __syncthreads(); if (blockIdx.x == 0 && wave == 0 && lane_id2() == 0) ((volatile LAS unsigned*)((lds_) + LDS_BYTES - 512))[4 + (id)] = (unsigned)__builtin_amdgcn_s_memrealtime(); } while (0)
__device__ __forceinline__ int lane_id2() { int l; asm volatile("v_mbcnt_lo_u32_b32 %0, -1, 0\n\tv_mbcnt_hi_u32_b32 %0, -1, %0" : "=v"(l)); return l; }
#else
#define STAMP2(lds_, id) do { } while (0)
#endif
__device__ __forceinline__ int glu_rowmap(int n) { return n < 2048 ? 32 * (n >> 4) + (n & 15) : 32 * ((n - 2048) >> 4) + 16 + (n & 15); }
struct ConvSel { const float* W; const float* g; bf16* WT; int K, N, mode, item; };
__device__ __forceinline__ ConvSel conv_select(unsigned char* ws, int r) {
    ConvSel s; s.g = nullptr; s.K = 2048; s.N = 2048; s.mode = 0;
    if (r < 2048) { s.W = ka_in(7); s.g = ka_in(2); s.WT = (bf16*)(ws + WS_W_AIN); s.N = 4096; }
    else if ((r -= 2048) < 1024) { s.W = ka_in(13); s.WT = (bf16*)(ws + WS_W_AOUT); }
    else if ((r -= 1024) < 1024) { s.W = ka_in(14); s.g = ka_in(2) + 2048; s.WT = (bf16*)(ws + WS_W_BIN); }
    else if ((r -= 1024) < 2048) { s.W = ka_in(23); s.WT = (bf16*)(ws + WS_W_BOUT); s.N = 4096; s.mode = 1; }
    else if ((r -= 2048) < 2048) { const int i = r >> 10; r &= 1023; s.W = ka_in(25) + (size_t)i * 2048 * 2048; s.g = ka_in(3) + i * 2048; s.WT = (bf16*)(ws + WS_W_Q + i * 8 * MiB); }
    else if ((r -= 2048) < 4096) { const int i = r >> 11; r &= 2047; s.W = ka_in(26) + (size_t)i * 2048 * 4096; s.g = ka_in(4) + i * 2048; s.WT = (bf16*)(ws + WS_W_KV + i * 16 * MiB); s.N = 4096; }
    else if ((r -= 4096) < 2048) { const int i = r >> 10; r &= 1023; s.W = ka_in(27) + (size_t)i * 2048 * 2048; s.WT = (bf16*)(ws + WS_W_O + i * 8 * MiB); }
    else if ((r -= 2048) < 8192) { const int i = r >> 12; r &= 4095; s.W = ka_in(28) + (size_t)i * 2048 * 8192; s.g = ka_in(5) + i * 2048; s.WT = (bf16*)(ws + WS_W_UP + i * 32 * MiB); s.N = 8192; }
    else { r -= 8192; const int i = r >> 12; r &= 4095; s.W = ka_in(29) + (size_t)i * 8192 * 2048; s.WT = (bf16*)(ws + WS_W_DN + i * 32 * MiB); s.K = 8192; }
    s.item = r; return s;
}
__device__ __forceinline__ void conv_load(const ConvSel& s, f32x4 (&v)[16], int lane) {
#if defined(CONV_KMAJOR)
    const int kblk = s.K >> 6, nb = s.item / kblk, kb = s.item - nb * kblk, k0 = 64 * kb, n0 = 64 * nb;
#else
    const int nblk = s.N >> 6, kb = s.item / nblk, nb = s.item - kb * nblk, k0 = 64 * kb, n0 = 64 * nb;
#endif
#pragma unroll
    for (int i = 0; i < 16; ++i) { const int kk = 4 * i + (lane >> 4); v[i] = *(const f32x4*)(s.W + (size_t)(k0 + kk) * s.N + n0 + 4 * (lane & 15)); }
}
__device__ __forceinline__ void conv_finish(const ConvSel& s, const f32x4 (&v)[16], LAS float* scr, int lane) {
#if defined(CONV_KMAJOR)
    const int kblk = s.K >> 6, nb = s.item / kblk, kb = s.item - nb * kblk, k0 = 64 * kb, n0 = 64 * nb;
#else
    const int nblk = s.N >> 6, kb = s.item / nblk, nb = s.item - kb * nblk, k0 = 64 * kb, n0 = 64 * nb;
#endif
#pragma unroll
    for (int i = 0; i < 16; ++i) { const int kk = 4 * i + (lane >> 4); const float sc = s.g ? s.g[k0 + kk] : 1.0f; LAS float* d = scr + kk * 65 + 4 * (lane & 15);
        d[0] = v[i][0] * sc; d[1] = v[i][1] * sc; d[2] = v[i][2] * sc; d[3] = v[i][3] * sc; }
    LDS_WAIT();
    const int c = lane & 7;
#pragma unroll
    for (int j = 0; j < 8; ++j) { const int n = (lane >> 3) + 8 * j; const LAS float* sp = scr + (8 * c) * 65 + n;
        v4u o; o.x = pk2(sp[0 * 65], sp[1 * 65]); o.y = pk2(sp[2 * 65], sp[3 * 65]); o.z = pk2(sp[4 * 65], sp[5 * 65]); o.w = pk2(sp[6 * 65], sp[7 * 65]);
        const int nr = s.mode ? glu_rowmap(n0 + n) : (n0 + n);
        *(v4u*)(s.WT + (size_t)nr * s.K + k0 + 8 * c) = o; }
    LDS_WAIT();
}
template <int PART> __device__ __forceinline__ int conv_index(int j) { return PART == 0 ? 8192 + j : (j < 8192 ? j : j + 4096); }
template <int PART> __device__ __forceinline__ void conv_run(unsigned char* ws, LAS float* scr, int first, int step, int limit, int lane) {
    if (first >= limit) return;
    f32x4 va[16], vb[16];
    ConvSel sa = conv_select(ws, conv_index<PART>(__builtin_amdgcn_readfirstlane(first))), sb = sa;
    conv_load(sa, va, lane);
    for (int j = first; j < limit; j += 2 * step) {
        const bool hb = (j + step) < limit;
        if (hb) { sb = conv_select(ws, conv_index<PART>(__builtin_amdgcn_readfirstlane(j + step))); conv_load(sb, vb, lane); }
        conv_finish(sa, va, scr, lane);
        if (!hb) break;
        const bool ha = (j + 2 * step) < limit;
        if (ha) { sa = conv_select(ws, conv_index<PART>(__builtin_amdgcn_readfirstlane(j + 2 * step))); conv_load(sa, va, lane); }
        conv_finish(sb, vb, scr, lane);
    }
}
__device__ __forceinline__ void row_to_bf16(const float* xrow, bf16* orow, float* ssqrow, int lane) {
    f32x4 v[8]; float s = 0.f;
#pragma unroll
    for (int j = 0; j < 8; ++j) { v[j] = ((const f32x4*)xrow)[lane + 64 * j]; s += (v[j][0] * v[j][0] + v[j][1] * v[j][1]) + (v[j][2] * v[j][2] + v[j][3] * v[j][3]); }
    s = wave_sum(s);
#pragma unroll
    for (int j = 0; j < 8; ++j) { v2u w; w.x = pk2(v[j][0], v[j][1]); w.y = pk2(v[j][2], v[j][3]); ((v2u*)orow)[lane + 64 * j] = w; }
    if (lane < 32) ssqrow[lane] = (lane == 0) ? s : 0.f;
}
__device__ __forceinline__ void p0_prologue(unsigned char* ws, LAS unsigned char* lds, int wave, int lane) {
    LAS float* scr = (LAS float*)(lds + wave * 16640);
    const int gw = blockIdx.x * NWAVES + wave, NGW = gridDim.x * NWAVES;
    conv_run<0>(ws, scr, gw, NGW, 4096, lane);
    for (int m = gw; m < M + MROWS; m += NGW) {
        if (m < M) row_to_bf16(ka_in(0) + (size_t)m * D, (bf16*)(ws + WS_XB) + (size_t)m * D, (float*)(ws + WS_SSQ) + (size_t)m * 64, lane);
        else { const int r = m - M; row_to_bf16(ka_in(1) + (size_t)r * D, (bf16*)(ws + WS_MEMB) + (size_t)r * D, (float*)(ws + WS_SSQM) + (size_t)r * 64, lane); }
    }
}
constexpr int CONV_REST = 26624, CONV_SPLIT = 22272;
__device__ __forceinline__ void p1_convert(unsigned char* ws, LAS unsigned char* lds, int wave, int lane) {
    LAS float* scr = (LAS float*)(lds + wave * 16640);
    const int bx = blockIdx.x, G = gridDim.x;
    if (G <= 64) { conv_run<1>(ws, scr, bx * NWAVES + wave, G * NWAVES, CONV_REST, lane); return; }
    if (bx >= 64) conv_run<1>(ws, scr, (bx - 64) * NWAVES + wave, (G - 64) * NWAVES, CONV_SPLIT, lane);
    else conv_run<1>(ws, scr, CONV_SPLIT + bx * NWAVES + wave, 64 * NWAVES, CONV_REST, lane);
}
__device__ __forceinline__ void final_norm(const bf16* xb, const float* ssq, const float* g, float* out, int wave, int lane) {
    const int gw = blockIdx.x * NWAVES + wave, NGW = gridDim.x * NWAVES;
    for (int m = gw; m < M; m += NGW) {
        float s = (lane < 32) ? ssq[(size_t)m * 64 + lane] : 0.f; s = wave_sum(s);
        const float rs = 1.0f / sqrtf(s * (1.0f / D) + 1e-6f);
        const v4u* xr = (const v4u*)(xb + (size_t)m * D); f32x4* orow = (f32x4*)(out + (size_t)m * D);
#pragma unroll
        for (int j = 0; j < 4; ++j) { const v4u w = xr[lane + 64 * j]; const f32x4 g0 = ((const f32x4*)g)[2 * (lane + 64 * j)], g1 = ((const f32x4*)g)[2 * (lane + 64 * j) + 1];
            orow[2 * (lane + 64 * j)] = (f32x4){bflo(w.x) * rs * g0[0], bfhi(w.x) * rs * g0[1], bflo(w.y) * rs * g0[2], bfhi(w.y) * rs * g0[3]};
            orow[2 * (lane + 64 * j) + 1] = (f32x4){bflo(w.z) * rs * g1[0], bfhi(w.z) * rs * g1[1], bflo(w.w) * rs * g1[2], bfhi(w.w) * rs * g1[3]}; } }
}
__device__ __forceinline__ void gating_simple(LAS unsigned char* lds, const bf16* z, const float* vst, const float* ln_g, const float* ln_b, const float* w_s, const float* b_s, bf16* gbuf, int tid) {
    LAS float* vln = (LAS float*)lds;
    LAS float* Wl = (LAS float*)(lds + 65536);
    LAS float* mu = (LAS float*)(lds + 65536 + 128 * 129 * 4);
    LAS float* rsd = mu + 128;
    for (int unit = blockIdx.x; unit < 1024; unit += gridDim.x) {
        const int h = unit & 15, tok0 = (unit >> 4) * 128;
        if (tid < 128) { const float* p = vst + (size_t)(tok0 + tid) * 64; float s1 = 0.f, s2 = 0.f;
#pragma unroll 8
            for (int i = 0; i < 32; ++i) { s1 += p[2 * i]; s2 += p[2 * i + 1]; }
            const float mean = s1 * (1.0f / 2048.0f), var = s2 * (1.0f / 2048.0f) - mean * mean; mu[tid] = mean; rsd[tid] = 1.0f / sqrtf(var + 1e-6f); }
        __syncthreads();
        { const int s = tid >> 2, db = (tid & 3) * 32; const float mean = mu[s], rs = rsd[s];
            const bf16* vp = z + (size_t)(tok0 + s) * 4096 + 2048 + h * 128 + db;
#pragma unroll
            for (int q = 0; q < 4; ++q) { const v4u w = *(const v4u*)(vp + 8 * q); const float* gp = ln_g + h * 128 + db + 8 * q; const float* bp = ln_b + h * 128 + db + 8 * q; LAS float* o = vln + s * 128 + db + 8 * q;
                o[0] = (bflo(w.x) - mean) * rs * gp[0] + bp[0]; o[1] = (bfhi(w.x) - mean) * rs * gp[1] + bp[1]; o[2] = (bflo(w.y) - mean) * rs * gp[2] + bp[2]; o[3] = (bfhi(w.y) - mean) * rs * gp[3] + bp[3];
                o[4] = (bflo(w.z) - mean) * rs * gp[4] + bp[4]; o[5] = (bfhi(w.z) - mean) * rs * gp[5] + bp[5]; o[6] = (bflo(w.w) - mean) * rs * gp[6] + bp[6]; o[7] = (bfhi(w.w) - mean) * rs * gp[7] + bp[7]; }
            const float* wp = w_s + ((size_t)h * 128 + s) * 128 + db;
#pragma unroll
            for (int q = 0; q < 8; ++q) { const f32x4 w4 = *(const f32x4*)(wp + 4 * q); LAS float* o = Wl + s * 129 + db + 4 * q; o[0] = w4[0]; o[1] = w4[1]; o[2] = w4[2]; o[3] = w4[3]; } }
        __syncthreads();
        { const int t = tid >> 2, d0 = (tid & 3) * 32, tmax = t | 15; float acc[32];
#pragma unroll
            for (int j = 0; j < 32; ++j) acc[j] = 0.f;
            for (int s = 0; s <= tmax; ++s) { const float w = (s <= t) ? Wl[t * 129 + s] : 0.f; const LAS f32x4* vr = (const LAS f32x4*)(vln + s * 128 + d0);
#pragma unroll
                for (int q = 0; q < 8; ++q) { const f32x4 vv = vr[q]; acc[4 * q] += w * vv[0]; acc[4 * q + 1] += w * vv[1]; acc[4 * q + 2] += w * vv[2]; acc[4 * q + 3] += w * vv[3]; } }
            const float bs = b_s[h * 128 + t];
            const bf16* up = z + (size_t)(tok0 + t) * 4096 + h * 128 + d0; bf16* op = gbuf + (size_t)(tok0 + t) * 2048 + h * 128 + d0;
#pragma unroll
            for (int q = 0; q < 4; ++q) { const v4u w = *(const v4u*)(up + 8 * q); v4u o;
                o.x = pk2(bflo(w.x) * (acc[8 * q] + bs), bfhi(w.x) * (acc[8 * q + 1] + bs)); o.y = pk2(bflo(w.y) * (acc[8 * q + 2] + bs), bfhi(w.y) * (acc[8 * q + 3] + bs));
                o.z = pk2(bflo(w.z) * (acc[8 * q + 4] + bs), bfhi(w.z) * (acc[8 * q + 5] + bs)); o.w = pk2(bflo(w.w) * (acc[8 * q + 6] + bs), bfhi(w.w) * (acc[8 * q + 7] + bs));
                *(v4u*)(op + 8 * q) = o; } }
        __syncthreads();
    }
}
__device__ __forceinline__ void gating_mfma(LAS unsigned char* lds, const bf16* z, const float* vst, const float* ln_g, const float* ln_b, const float* w_s, const float* b_s, bf16* gbuf, int wave, int lane) {
    LAS float* MU = (LAS float*)(lds + 69632);
    const int tid = wave * 64 + lane, fr = lane & 15, fq = lane >> 4;
    const int ss = tid >> 2, db = (tid & 3) * 32;
    for (int unit = blockIdx.x; unit < 256; unit += gridDim.x) {
        const int tok0 = (unit >> 2) * 128, hg = unit & 3;
        __syncthreads();
        if (tid < 128) { const float* sp = vst + (size_t)(tok0 + tid) * 64; float s1 = 0.f, s2 = 0.f;
#pragma unroll
            for (int i = 0; i < 16; ++i) { const f32x4 a = *(const f32x4*)(sp + 4 * i); s1 += a[0] + a[2]; s2 += a[1] + a[3]; }
            const float mean = s1 * (1.0f / 2048.0f), var = s2 * (1.0f / 2048.0f) - mean * mean; MU[tid] = mean; MU[128 + tid] = 1.0f / sqrtf(var + 1e-6f); }
        v4u raw[4];
        { const bf16* vp = z + (size_t)(tok0 + ss) * 4096 + 2048 + (hg * 4) * 128 + db;
#pragma unroll
            for (int q4 = 0; q4 < 4; ++q4) raw[q4] = *(const v4u*)(vp + 8 * q4); }
        __syncthreads();
        const float mean = MU[ss], rs = MU[128 + ss];
#pragma unroll 1
        for (int hh = 0; hh < 4; ++hh) { const int h = hg * 4 + hh; LAS unsigned char* VT = lds + (hh & 1) * 34816;
            const int t = 16 * wave + fr, nks = (wave >> 1) + 1;
            f32x4 wa[4][2];
#pragma unroll
            for (int ks = 0; ks < 4; ++ks) if (ks < nks) { const float* wp = w_s + ((size_t)h * 128 + t) * 128 + 32 * ks + 8 * fq; wa[ks][0] = *(const f32x4*)wp; wa[ks][1] = *(const f32x4*)(wp + 4); }
            const float bs = b_s[h * 128 + t];
            const bf16* up = z + (size_t)(tok0 + t) * 4096 + h * 128 + 4 * fq; bf16* op = gbuf + (size_t)(tok0 + t) * 2048 + h * 128 + 4 * fq;
            v2u uwv[8];
#pragma unroll
            for (int df = 0; df < 8; ++df) uwv[df] = *(const v2u*)(up + 16 * df);
            { const float* gp = ln_g + h * 128 + db; const float* bp = ln_b + h * 128 + db; LAS unsigned char* wp = VT + db * 272 + ss * 2;
#pragma unroll
                for (int q4 = 0; q4 < 4; ++q4) { const f32x4 g0 = *(const f32x4*)(gp + 8 * q4), g1 = *(const f32x4*)(gp + 8 * q4 + 4), b0 = *(const f32x4*)(bp + 8 * q4), b1 = *(const f32x4*)(bp + 8 * q4 + 4); const v4u w = raw[q4];
                    const float v0 = (bflo(w.x) - mean) * rs * g0[0] + b0[0], v1 = (bfhi(w.x) - mean) * rs * g0[1] + b0[1], v2 = (bflo(w.y) - mean) * rs * g0[2] + b0[2], v3 = (bfhi(w.y) - mean) * rs * g0[3] + b0[3];
                    const float v4 = (bflo(w.z) - mean) * rs * g1[0] + b1[0], v5 = (bfhi(w.z) - mean) * rs * g1[1] + b1[1], v6 = (bflo(w.w) - mean) * rs * g1[2] + b1[2], v7 = (bfhi(w.w) - mean) * rs * g1[3] + b1[3];
                    LAS unsigned char* o = wp + (8 * q4) * 272;
                    *(LAS bf16*)(o + 0 * 272) = (bf16)f2bf(v0); *(LAS bf16*)(o + 1 * 272) = (bf16)f2bf(v1); *(LAS bf16*)(o + 2 * 272) = (bf16)f2bf(v2); *(LAS bf16*)(o + 3 * 272) = (bf16)f2bf(v3);
                    *(LAS bf16*)(o + 4 * 272) = (bf16)f2bf(v4); *(LAS bf16*)(o + 5 * 272) = (bf16)f2bf(v5); *(LAS bf16*)(o + 6 * 272) = (bf16)f2bf(v6); *(LAS bf16*)(o + 7 * 272) = (bf16)f2bf(v7); } }
            if (hh < 3) { const bf16* vp = z + (size_t)(tok0 + ss) * 4096 + 2048 + (h + 1) * 128 + db;
#pragma unroll
                for (int q4 = 0; q4 < 4; ++q4) raw[q4] = *(const v4u*)(vp + 8 * q4); }
            __syncthreads();
            bf16x8 wf[4];
#pragma unroll
            for (int ks = 0; ks < 4; ++ks) { wf[ks] = (bf16x8){0, 0, 0, 0, 0, 0, 0, 0};
                if (ks < nks) { const f32x4 a = wa[ks][0], c = wa[ks][1]; const int s0 = 32 * ks + 8 * fq;
                    float v[8] = {a[0], a[1], a[2], a[3], c[0], c[1], c[2], c[3]};
#pragma unroll
                    for (int j = 0; j < 8; ++j) v[j] = (s0 + j <= t) ? v[j] : 0.f;
                    v4u w; w.x = pk2(v[0], v[1]); w.y = pk2(v[2], v[3]); w.z = pk2(v[4], v[5]); w.w = pk2(v[6], v[7]); wf[ks] = __builtin_bit_cast(bf16x8, w); } }
            const LAS unsigned char* ab = VT + fr * 272 + fq * 16;
#pragma unroll
            for (int df = 0; df < 8; ++df) { f32x4 acc = (f32x4){0.f, 0.f, 0.f, 0.f};
#pragma unroll
                for (int ks = 0; ks < 4; ++ks) if (ks < nks) { const bf16x8 a = *(const LAS bf16x8*)(ab + df * 16 * 272 + ks * 64); acc = __builtin_amdgcn_mfma_f32_16x16x32_bf16(a, wf[ks], acc, 0, 0, 0); }
                const v2u uw = uwv[df]; v2u ow;
                ow.x = pg8::cvt_pk_bf16(bflo(uw.x) * (acc[0] + bs), bfhi(uw.x) * (acc[1] + bs)); ow.y = pg8::cvt_pk_bf16(bflo(uw.y) * (acc[2] + bs), bfhi(uw.y) * (acc[3] + bs));
                *(v2u*)(op + 16 * df) = ow; }
        }
    }
    __syncthreads();
}
__device__ __forceinline__ void attn_simple(LAS unsigned char* lds, const bf16* q, const bf16* Kb, const bf16* Vb, bf16* obuf, int wave, int lane) {
    LAS float* pl = (LAS float*)(lds + wave * 1024);
    const int gw = blockIdx.x * NWAVES + wave, NGW = gridDim.x * NWAVES;
    for (int task = gw; task < BATCH * 4 * SEQ; task += NGW) {
        const int bh = task >> 12, t = task & 4095, b = bh >> 2, h = bh & 3;
        float qf[8]; { const v4u w = *(const v4u*)(q + ((size_t)(b * SEQ + t)) * 2048 + h * 512 + 8 * lane);
            qf[0] = bflo(w.x); qf[1] = bfhi(w.x); qf[2] = bflo(w.y); qf[3] = bfhi(w.y); qf[4] = bflo(w.z); qf[5] = bfhi(w.z); qf[6] = bflo(w.w); qf[7] = bfhi(w.w); }
        const bf16* kp = Kb + (size_t)bh * 256 * 512 + 8 * lane;
        float sc[4];
#pragma unroll
        for (int kk = 0; kk < 4; ++kk) { float mine = 0.f;
            for (int l2 = 0; l2 < 64; ++l2) { const v4u w = *(const v4u*)(kp + (size_t)(kk * 64 + l2) * 512);
                float dsum = qf[0] * bflo(w.x) + qf[1] * bfhi(w.x) + qf[2] * bflo(w.y) + qf[3] * bfhi(w.y) + qf[4] * bflo(w.z) + qf[5] * bfhi(w.z) + qf[6] * bflo(w.w) + qf[7] * bfhi(w.w);
                dsum = wave_sum(dsum); if (lane == l2) mine = dsum; }
            sc[kk] = mine; }
        const float mx = wave_max(fmaxf(fmaxf(sc[0], sc[1]), fmaxf(sc[2], sc[3])));
        float p[4], ps = 0.f;
#pragma unroll
        for (int kk = 0; kk < 4; ++kk) { p[kk] = exp2f(sc[kk] - mx); ps += p[kk]; pl[kk * 64 + lane] = p[kk]; }
        const float inv = 1.0f / wave_sum(ps);
        LDS_WAIT();
        float o[8];
#pragma unroll
        for (int i = 0; i < 8; ++i) o[i] = 0.f;
        const bf16* vp = Vb + (size_t)bh * 256 * 512 + 8 * lane;
        for (int key = 0; key < 256; ++key) { const float pk = pl[key]; const v4u w = *(const v4u*)(vp + (size_t)key * 512);
            o[0] += pk * bflo(w.x); o[1] += pk * bfhi(w.x); o[2] += pk * bflo(w.y); o[3] += pk * bfhi(w.y); o[4] += pk * bflo(w.z); o[5] += pk * bfhi(w.z); o[6] += pk * bflo(w.w); o[7] += pk * bfhi(w.w); }
        v4u ow; ow.x = pk2(o[0] * inv, o[1] * inv); ow.y = pk2(o[2] * inv, o[3] * inv); ow.z = pk2(o[4] * inv, o[5] * inv); ow.w = pk2(o[6] * inv, o[7] * inv);
        *(v4u*)(obuf + ((size_t)(b * SEQ + t)) * 2048 + h * 512 + 8 * lane) = ow;
        LDS_WAIT();
    }
}
__device__ __forceinline__ void attn_mfma(LAS unsigned char* lds, const bf16* q, const bf16* Kb, const bf16* VTb, bf16* obuf, int wave, int lane) {
    const int tid = wave * 64 + lane, fr = lane & 15, fq = lane >> 4;
    unsigned voffK[2], voffV[2];
#pragma unroll
    for (int i = 0; i < 2; ++i) { int R, C; pg8::stage_rc(tid * 16 + i * 8192, R, C); voffK[i] = (unsigned)(R * 512 + C) * 2u; voffV[i] = (unsigned)(R * 256 + C) * 2u; }
    const unsigned ldsw = (unsigned)wave * 1024u;
    const int aoff0 = pg8::lds_byte(fr, fq * 8);
#define AT_STAGE_K(c, buf) do { _Pragma("unroll") for (int ht = 0; ht < 4; ++ht) { const char* src = Kg + ((size_t)(128 * (ht >> 1)) * 512 + 128 * (c) + 64 * (ht & 1)) * 2; \
        _Pragma("unroll") for (int i = 0; i < 2; ++i) __builtin_amdgcn_global_load_lds((const unsigned*)(src + voffK[i]), (LAS unsigned*)(lds + (buf) * 65536 + ht * 16384 + ldsw + i * 8192), 16, 0, 0); } } while (0)
#define AT_STAGE_V(cc, buf) do { _Pragma("unroll") for (int ht = 0; ht < 4; ++ht) { const char* src = Vg + ((size_t)(128 * ht) * 256 + 64 * (cc)) * 2; \
        _Pragma("unroll") for (int i = 0; i < 2; ++i) __builtin_amdgcn_global_load_lds((const unsigned*)(src + voffV[i]), (LAS unsigned*)(lds + (buf) * 65536 + ht * 16384 + ldsw + i * 8192), 16, 0, 0); } } while (0)
#define AT_WAIT() do { asm volatile("s_waitcnt vmcnt(0)" ::: "memory"); __syncthreads(); } while (0)
    for (int unit = blockIdx.x; unit < 256; unit += gridDim.x) {
        const int bh = unit & 7, qb = unit >> 3, b = bh >> 2, h = bh & 3;
        const char* Kg = (const char*)(Kb + (size_t)bh * 256 * 512);
        const char* Vg = (const char*)(VTb + (size_t)bh * 512 * 256);
        const size_t tok = (size_t)(b * SEQ + qb * 128 + 16 * wave + fr);
        bf16x8 qf[16];
        { const bf16* qp = q + tok * 2048 + h * 512 + 8 * fq;
#pragma unroll
            for (int s = 0; s < 16; ++s) qf[s] = *(const bf16x8*)(qp + 32 * s); }
        f32x4 acc[16];
#pragma unroll
        for (int n = 0; n < 16; ++n) acc[n] = (f32x4){0.f, 0.f, 0.f, 0.f};
        STAMP2(lds, 40);
        AT_STAGE_K(0, 0);
#pragma unroll
        for (int c = 0; c < 4; ++c) {
            AT_WAIT();
            if (c < 3) AT_STAGE_K(c + 1, (c + 1) & 1); else AT_STAGE_V(0, 0);
            const LAS unsigned char* bb = lds + (c & 1) * 65536 + aoff0; asm volatile("" : "+v"(bb));
#define AT_QK_LOAD(dst, gi) do { _Pragma("unroll") for (int n8 = 0; n8 < 8; ++n8) dst[n8] = *(const LAS bf16x8*)(bb + ((((gi) & 1) * 2 + ((gi) >> 2)) * 16384) + n8 * 2048 + (((gi) >> 1) & 1) * 1024); } while (0)
#define AT_QK_MMA(src, gi) do { _Pragma("unroll") for (int n8 = 0; n8 < 8; ++n8) acc[((gi) & 1) * 8 + n8] = __builtin_amdgcn_mfma_f32_16x16x32_bf16(src[n8], qf[4 * c + 2 * ((gi) >> 2) + (((gi) >> 1) & 1)], acc[((gi) & 1) * 8 + n8], 0, 0, 0); } while (0)
            { bf16x8 a0[8], a1[8];
                AT_QK_LOAD(a0, 0);
#pragma unroll
                for (int gi = 0; gi < 8; gi += 2) { AT_QK_LOAD(a1, gi + 1); AT_QK_MMA(a0, gi); __builtin_amdgcn_sched_barrier(0);
                    if (gi + 2 < 8) AT_QK_LOAD(a0, gi + 2);
                    AT_QK_MMA(a1, gi + 1); __builtin_amdgcn_sched_barrier(0); } }
        }
        STAMP2(lds, 41);
        float mx = acc[0][0];
#pragma unroll
        for (int n = 0; n < 16; ++n) mx = fmaxf(fmaxf(mx, fmaxf(acc[n][0], acc[n][1])), fmaxf(acc[n][2], acc[n][3]));
        mx = fmaxf(mx, __shfl_xor(mx, 16)); mx = fmaxf(mx, __shfl_xor(mx, 32));
        float l = 0.f;
#pragma unroll
        for (int n = 0; n < 16; ++n)
#pragma unroll
            for (int r = 0; r < 4; ++r) { const float pv = __builtin_amdgcn_exp2f(acc[n][r] - mx); acc[n][r] = pv; l += pv; }
        l += __shfl_xor(l, 16); l += __shfl_xor(l, 32);
        const float linv = 1.0f / l;
        bf16x8 pf[8];
#pragma unroll
        for (int s = 0; s < 8; ++s) { v4u w; w.x = pg8::cvt_pk_bf16(acc[2 * s][0], acc[2 * s][1]); w.y = pg8::cvt_pk_bf16(acc[2 * s][2], acc[2 * s][3]);
            w.z = pg8::cvt_pk_bf16(acc[2 * s + 1][0], acc[2 * s + 1][1]); w.w = pg8::cvt_pk_bf16(acc[2 * s + 1][2], acc[2 * s + 1][3]); pf[s] = __builtin_bit_cast(bf16x8, w); }
        STAMP2(lds, 42);
        __builtin_amdgcn_sched_barrier(0);
        f32x4 o[32];
#pragma unroll
        for (int mm = 0; mm < 32; ++mm) o[mm] = (f32x4){0.f, 0.f, 0.f, 0.f};
#pragma unroll
        for (int cc = 0; cc < 4; ++cc) {
            AT_WAIT();
            if (cc < 3) AT_STAGE_V(cc + 1, (cc + 1) & 1);
            const LAS unsigned char* bb = lds + (cc & 1) * 65536 + aoff0; asm volatile("" : "+v"(bb));
#define AT_PV_LOAD(dst, gi) do { _Pragma("unroll") for (int m8 = 0; m8 < 8; ++m8) dst[m8] = *(const LAS bf16x8*)(bb + ((gi) & 3) * 16384 + m8 * 2048 + ((gi) >> 2) * 1024); } while (0)
#define AT_PV_MMA(src, gi) do { _Pragma("unroll") for (int m8 = 0; m8 < 8; ++m8) o[((gi) & 3) * 8 + m8] = __builtin_amdgcn_mfma_f32_16x16x32_bf16(src[m8], pf[2 * cc + ((gi) >> 2)], o[((gi) & 3) * 8 + m8], 0, 0, 0); } while (0)
            { bf16x8 a0[8], a1[8];
                AT_PV_LOAD(a0, 0);
#pragma unroll
                for (int gi = 0; gi < 8; gi += 2) { AT_PV_LOAD(a1, gi + 1); AT_PV_MMA(a0, gi); __builtin_amdgcn_sched_barrier(0);
                    if (gi + 2 < 8) AT_PV_LOAD(a0, gi + 2);
                    AT_PV_MMA(a1, gi + 1); __builtin_amdgcn_sched_barrier(0); } }
        }
        STAMP2(lds, 43);
        bf16* op = obuf + tok * 2048 + h * 512 + 4 * fq;
#pragma unroll
        for (int mm = 0; mm < 32; ++mm) { v2u w; w.x = pg8::cvt_pk_bf16(o[mm][0] * linv, o[mm][1] * linv); w.y = pg8::cvt_pk_bf16(o[mm][2] * linv, o[mm][3] * linv); *(v2u*)(op + 16 * mm) = w; }
    }
    asm volatile("s_waitcnt vmcnt(0)" ::: "memory"); __syncthreads(); STAMP2(lds, 44);
#undef AT_STAGE_K
#undef AT_QK_LOAD
#undef AT_QK_MMA
#undef AT_PV_LOAD
#undef AT_PV_MMA
#undef AT_STAGE_V
#undef AT_WAIT
}
struct S5Lane { float lbr, lbi; float Br[16], Bi[16]; };
__device__ __forceinline__ void s5_lane_params(int g, int p, S5Lane& L) {
    const float lr = fminf(ka_in(15)[g * 64 + p], -1e-4f), li = ka_in(16)[g * 64 + p], dt = expf(ka_in(17)[g]);
    const float ar = lr * dt, th = li * dt; float sn, cs; sincosf(th, &sn, &cs); const float e = expf(ar), sh = sinf(0.5f * th);
    L.lbr = e * cs; L.lbi = e * sn;
    const float nr = expm1f(ar) * cs - 2.0f * sh * sh, ni = e * sn;
    const float den = 1.0f / (lr * lr + li * li), cr = (nr * lr + ni * li) * den, ci = (ni * lr - nr * li) * den;
#pragma unroll
    for (int c = 0; c < 16; ++c) { const float br = ka_in(18)[(size_t)(g * 64 + p) * 16 + c], bi = ka_in(19)[(size_t)(g * 64 + p) * 16 + c]; L.Br[c] = cr * br - ci * bi; L.Bi[c] = cr * bi + ci * br; }
}
__device__ __forceinline__ void s5_step(const S5Lane& L, const bf16* urow, float& xr, float& xi) {
    const v4u w0 = *(const v4u*)urow, w1 = *(const v4u*)(urow + 8);
    float u[16] = {bflo(w0.x), bfhi(w0.x), bflo(w0.y), bfhi(w0.y), bflo(w0.z), bfhi(w0.z), bflo(w0.w), bfhi(w0.w), bflo(w1.x), bfhi(w1.x), bflo(w1.y), bfhi(w1.y), bflo(w1.z), bfhi(w1.z), bflo(w1.w), bfhi(w1.w)};
    float br = 0.f, bi = 0.f;
#pragma unroll
    for (int c = 0; c < 16; ++c) { br += L.Br[c] * u[c]; bi += L.Bi[c] * u[c]; }
    const float nr = L.lbr * xr - L.lbi * xi + br, ni = L.lbr * xi + L.lbi * xr + bi; xr = nr; xi = ni;
}
__device__ __forceinline__ void s5_pass_a(const bf16* ub, f32x2* st, int wave, int lane) {
    const int gw = blockIdx.x * NWAVES + wave, NGW = gridDim.x * NWAVES;
    for (int task = gw; task < BATCH * 128 * 64; task += NGW) {
        const int seg = task & 63, g = (task >> 6) & 127, b = task >> 13;
        S5Lane L; s5_lane_params(g, lane, L);
        float xr = 0.f, xi = 0.f; const bf16* up = ub + (size_t)(b * SEQ + seg * 64) * 2048 + 16 * g;
#pragma unroll 2
        for (int s = 0; s < 64; ++s) s5_step(L, up + (size_t)s * 2048, xr, xi);
        st[(size_t)task * 64 + lane] = (f32x2){xr, xi};
    }
}
__device__ __forceinline__ void s5_pass_c(LAS unsigned char* lds, const bf16* ub, const f32x2* st, bf16* yb, int wave, int lane) {
    LAS f32x2* Cs = (LAS f32x2*)(lds + wave * 16640);
    LAS f32x2* xs = (LAS f32x2*)(lds + wave * 16640 + 8320);
    const int gw = blockIdx.x * NWAVES + wave, NGW = gridDim.x * NWAVES;
    for (int task = gw; task < BATCH * 128 * 64; task += NGW) {
        const int seg = task & 63, g = (task >> 6) & 127, b = task >> 13;
        S5Lane L; s5_lane_params(g, lane, L);
#pragma unroll
        for (int c = 0; c < 16; ++c) Cs[c * 65 + lane] = (f32x2){ka_in(20)[(size_t)(g * 16 + c) * 64 + lane], ka_in(21)[(size_t)(g * 16 + c) * 64 + lane]};
        float Ar = L.lbr, Ai = L.lbi;
#pragma unroll
        for (int i = 0; i < 6; ++i) { const float nr = Ar * Ar - Ai * Ai, ni = 2.0f * Ar * Ai; Ar = nr; Ai = ni; }
        float xr = 0.f, xi = 0.f; const f32x2* sp = st + (size_t)(task - seg) * 64 + lane;
#pragma unroll 2
        for (int n = 0; n < seg; ++n) { const f32x2 s = sp[(size_t)n * 64]; const float nr = Ar * xr - Ai * xi + s.x, ni = Ar * xi + Ai * xr + s.y; xr = nr; xi = ni; }
        const bf16* up = ub + (size_t)(b * SEQ + seg * 64) * 2048 + 16 * g; bf16* yp = yb + (size_t)(b * SEQ + seg * 64) * 2048 + 16 * g;
        const int t = lane & 15, cq = lane >> 4;
        f32x4 dsk = *(const f32x4*)(ka_in(22) + g * 16 + 4 * cq);
#pragma unroll 1
        for (int blk = 0; blk < 4; ++blk) {
#pragma unroll 2
            for (int s = 0; s < 16; ++s) { s5_step(L, up + (size_t)(blk * 16 + s) * 2048, xr, xi); xs[s * 65 + lane] = (f32x2){xr, xi}; }
            LDS_WAIT();
            float acc[4] = {0.f, 0.f, 0.f, 0.f};
#pragma unroll 4
            for (int p = 0; p < 64; ++p) { const f32x2 x = xs[t * 65 + p];
#pragma unroll
                for (int j = 0; j < 4; ++j) { const f32x2 c = Cs[(4 * cq + j) * 65 + p]; acc[j] += c.x * x.x - c.y * x.y; } }
            const v2u uw = *(const v2u*)(up + (size_t)(blk * 16 + t) * 2048 + 4 * cq);
            const float y0 = gelu_exact(acc[0] + dsk[0] * bflo(uw.x)), y1 = gelu_exact(acc[1] + dsk[1] * bfhi(uw.x)), y2 = gelu_exact(acc[2] + dsk[2] * bflo(uw.y)), y3 = gelu_exact(acc[3] + dsk[3] * bfhi(uw.y));
            v2u ow; ow.x = pk2(y0, y1); ow.y = pk2(y2, y3); *(v2u*)(yp + (size_t)(blk * 16 + t) * 2048 + 4 * cq) = ow;
            LDS_WAIT();
        }
    }
}
__device__ __forceinline__ void s5_mfma(LAS unsigned char* lds, const bf16* ub, bf16* yb, int wave, int lane) {
    LAS f32x2* PW = (LAS f32x2*)(lds);
    LAS f32x2* BB = (LAS f32x2*)(lds + 8704);
    LAS f32x2* CC = (LAS f32x2*)(lds + 16896);
    LAS bf16* KST = (LAS bf16*)(lds + 25088);
    LAS unsigned char* UI = lds + 33280;
    LAS float* SL = (LAS float*)(lds + 66048);
    LAS bf16* XP = (LAS bf16*)(lds + 99840);
    const int tid = wave * 64 + lane, fr = lane & 15, fq = lane >> 4;
#ifndef S5_LOOP_REPS
#define S5_LOOP_REPS 1
#endif
    for (int unit = blockIdx.x; unit < 256; unit += gridDim.x) {
        const int b = unit >> 7, g = unit & 127;
        const bf16* usrc = ub + (size_t)(b * SEQ) * 2048 + 16 * g + (size_t)(tid >> 1) * 2048 + 8 * (tid & 1);
        v4u upre[4];
#pragma unroll
        for (int i = 0; i < 4; ++i) upre[i] = *(const v4u*)(usrc + (size_t)(256 * i) * 2048);
        const float ldt = ka_in(17)[g];
        float plr[3], pli[3];
#pragma unroll
        for (int it = 0; it < 3; ++it) { const int idx = tid + NTHREADS * it, p = idx & 63; plr[it] = ka_in(15)[g * 64 + p]; pli[it] = ka_in(16)[g * 64 + p]; }
        float pbr[2], pbi[2], pcr[2], pci[2];
#pragma unroll
        for (int it = 0; it < 2; ++it) { const int idx = tid + NTHREADS * it; pbr[it] = ka_in(18)[(size_t)g * 1024 + idx]; pbi[it] = ka_in(19)[(size_t)g * 1024 + idx]; pcr[it] = ka_in(20)[(size_t)g * 1024 + idx]; pci[it] = ka_in(21)[(size_t)g * 1024 + idx]; }
        float qlr[2], qli[2];
#pragma unroll
        for (int it = 0; it < 2; ++it) { const int p = (tid + NTHREADS * it) >> 4; qlr[it] = ka_in(15)[g * 64 + p]; qli[it] = ka_in(16)[g * 64 + p]; }
        const f32x4 dsk = *(const f32x4*)(ka_in(22) + g * 16 + 4 * fq);
        const float dt = expf(ldt);
        __syncthreads();
#pragma unroll
        for (int it = 0; it < 3; ++it) { const int idx = tid + NTHREADS * it; if (idx < 17 * 64) { const int e = idx >> 6;
            const float lr = fminf(plr[it], -1e-4f), li = pli[it]; float sn, cs; sincosf(li * dt * (float)e, &sn, &cs); const float ex = expf(lr * dt * (float)e);
            PW[idx] = (f32x2){ex * cs, ex * sn}; } }
#pragma unroll
        for (int it = 0; it < 2; ++it) { const int idx = tid + NTHREADS * it;
            const float lr = fminf(qlr[it], -1e-4f), li = qli[it]; const float ar = lr * dt, th = li * dt; float sn, cs; sincosf(th, &sn, &cs); const float e = expf(ar), sh = sinf(0.5f * th);
            const float nr = expm1f(ar) * cs - 2.0f * sh * sh, ni = e * sn, den = 1.0f / (lr * lr + li * li), cr = (nr * lr + ni * li) * den, ci = (ni * lr - nr * li) * den;
            BB[idx] = (f32x2){cr * pbr[it] - ci * pbi[it], cr * pbi[it] + ci * pbr[it]};
            CC[idx] = (f32x2){pcr[it], pci[it]}; }
        __syncthreads();
        bf16x8 A1[8];
        { const int ri = wave >> 2, p = 16 * (wave & 3) + fr; f32x2 bb[8];
#pragma unroll
            for (int j = 0; j < 8; ++j) bb[j] = BB[p * 16 + 8 * (fq & 1) + j];
#pragma unroll
            for (int ks = 0; ks < 8; ++ks) { const int s = 2 * ks + (fq >> 1); const f32x2 pw = PW[(15 - s) * 64 + p]; float v[8];
#pragma unroll
                for (int j = 0; j < 8; ++j) v[j] = ri ? (pw.x * bb[j].y + pw.y * bb[j].x) : (pw.x * bb[j].x - pw.y * bb[j].y);
                v4u w; w.x = pk2(v[0], v[1]); w.y = pk2(v[2], v[3]); w.z = pk2(v[4], v[5]); w.w = pk2(v[6], v[7]); A1[ks] = __builtin_bit_cast(bf16x8, w); }
            __builtin_amdgcn_sched_barrier(0); }
        const int t0 = wave, t1 = 15 - wave;
        bf16x8 CM[2][4];
        { f32x4 kacc[2] = {(f32x4){0.f, 0.f, 0.f, 0.f}, (f32x4){0.f, 0.f, 0.f, 0.f}};
#pragma unroll
            for (int h = 0; h < 2; ++h) { f32x2 cc[8], pa[8], pb[8];
#pragma unroll
                for (int j = 0; j < 8; ++j) { const int p = 32 * h + 8 * fq + j; cc[j] = CC[fr * 64 + p]; pa[j] = PW[(t0 + 1) * 64 + p]; pb[j] = PW[(t1 + 1) * 64 + p]; }
                float vr[8], vi[8];
#pragma unroll
                for (int j = 0; j < 8; ++j) { vr[j] = cc[j].x * pa[j].x - cc[j].y * pa[j].y; vi[j] = -(cc[j].x * pa[j].y + cc[j].y * pa[j].x); }
                { v4u w; w.x = pk2(vr[0], vr[1]); w.y = pk2(vr[2], vr[3]); w.z = pk2(vr[4], vr[5]); w.w = pk2(vr[6], vr[7]); CM[0][h] = __builtin_bit_cast(bf16x8, w);
                  w.x = pk2(vi[0], vi[1]); w.y = pk2(vi[2], vi[3]); w.z = pk2(vi[4], vi[5]); w.w = pk2(vi[6], vi[7]); CM[0][2 + h] = __builtin_bit_cast(bf16x8, w); }
#pragma unroll
                for (int j = 0; j < 8; ++j) { vr[j] = cc[j].x * pb[j].x - cc[j].y * pb[j].y; vi[j] = -(cc[j].x * pb[j].y + cc[j].y * pb[j].x); }
                { v4u w; w.x = pk2(vr[0], vr[1]); w.y = pk2(vr[2], vr[3]); w.z = pk2(vr[4], vr[5]); w.w = pk2(vr[6], vr[7]); CM[1][h] = __builtin_bit_cast(bf16x8, w);
                  w.x = pk2(vi[0], vi[1]); w.y = pk2(vi[2], vi[3]); w.z = pk2(vi[4], vi[5]); w.w = pk2(vi[6], vi[7]); CM[1][2 + h] = __builtin_bit_cast(bf16x8, w); }
                bf16x8 ctr, cti;
                { v4u w; w.x = pk2(cc[0].x, cc[1].x); w.y = pk2(cc[2].x, cc[3].x); w.z = pk2(cc[4].x, cc[5].x); w.w = pk2(cc[6].x, cc[7].x); ctr = __builtin_bit_cast(bf16x8, w);
                  w.x = pk2(-cc[0].y, -cc[1].y); w.y = pk2(-cc[2].y, -cc[3].y); w.z = pk2(-cc[4].y, -cc[5].y); w.w = pk2(-cc[6].y, -cc[7].y); cti = __builtin_bit_cast(bf16x8, w); }
                f32x2 bq[8];
#pragma unroll
                for (int j = 0; j < 8; ++j) bq[j] = BB[(32 * h + 8 * fq + j) * 16 + fr];
#pragma unroll
                for (int si = 0; si < 2; ++si) { const int s = 2 * wave + si;
#pragma unroll
                    for (int j = 0; j < 8; ++j) { const f32x2 pw = PW[(15 - s) * 64 + 32 * h + 8 * fq + j]; vr[j] = pw.x * bq[j].x - pw.y * bq[j].y; vi[j] = pw.x * bq[j].y + pw.y * bq[j].x; }
                    v4u w; w.x = pk2(vr[0], vr[1]); w.y = pk2(vr[2], vr[3]); w.z = pk2(vr[4], vr[5]); w.w = pk2(vr[6], vr[7]);
                    kacc[si] = __builtin_amdgcn_mfma_f32_16x16x32_bf16(__builtin_bit_cast(bf16x8, w), ctr, kacc[si], 0, 0, 0);
                    w.x = pk2(vi[0], vi[1]); w.y = pk2(vi[2], vi[3]); w.z = pk2(vi[4], vi[5]); w.w = pk2(vi[6], vi[7]);
                    kacc[si] = __builtin_amdgcn_mfma_f32_16x16x32_bf16(__builtin_bit_cast(bf16x8, w), cti, kacc[si], 0, 0, 0); }
                __builtin_amdgcn_sched_barrier(0); }
#pragma unroll
            for (int si = 0; si < 2; ++si) { const int s = 2 * wave + si; v2u kw; kw.x = pk2(kacc[si][0], kacc[si][1]); kw.y = pk2(kacc[si][2], kacc[si][3]);
                *(LAS v2u*)(KST + ((15 - s) * 16 + fr) * 16 + 4 * fq) = kw; } }
#pragma unroll 1
        for (int rep = 0; rep < S5_LOOP_REPS; ++rep) {
        float Xr = 0.f, Xi = 0.f;
#pragma unroll 1
        for (int q = 0; q < 4; ++q) {
            __syncthreads();
#pragma unroll
            for (int i = 0; i < 4; ++i) { const int piece = tid + NTHREADS * i, tok = piece >> 1, half = piece & 1;
                *(LAS v4u*)(UI + ((((tok & 15) * 64 + (tok >> 4)) * 2 + half) * 16)) = upre[i]; }
            { const int qn = (q + 1) & 3;
#pragma unroll
                for (int i = 0; i < 4; ++i) upre[i] = *(const v4u*)(usrc + (size_t)(qn * 1024 + 256 * i) * 2048); }
            __syncthreads();
#pragma unroll 1
            for (int nf = 0; nf < 4; ++nf) { f32x4 acc = (f32x4){0.f, 0.f, 0.f, 0.f};
#pragma unroll
                for (int ks = 0; ks < 8; ++ks) { const bf16x8 bfr = *(const LAS bf16x8*)(UI + ((((2 * ks + (fq >> 1)) * 64 + 16 * nf + fr) * 2 + (fq & 1)) * 16));
                    acc = __builtin_amdgcn_mfma_f32_16x16x32_bf16(A1[ks], bfr, acc, 0, 0, 0); }
                *(LAS f32x4*)(SL + (16 * nf + fr) * 132 + 16 * wave + 4 * fq) = acc; }
            __syncthreads();
            if (wave == 0) { const f32x2 a16 = PW[16 * 64 + lane];
#pragma unroll 1
                for (int nb = 0; nb < 64; nb += 16) { float sr[16], si[16];
#pragma unroll
                    for (int n = 0; n < 16; ++n) { sr[n] = SL[(nb + n) * 132 + lane]; si[n] = SL[(nb + n) * 132 + 64 + lane]; }
#pragma unroll
                    for (int n = 0; n < 16; ++n) { XP[(nb + n) * 136 + lane] = (bf16)f2bf(Xr); XP[(nb + n) * 136 + 64 + lane] = (bf16)f2bf(Xi);
                        const float nr = a16.x * Xr - a16.y * Xi + sr[n], ni = a16.x * Xi + a16.y * Xr + si[n]; Xr = nr; Xi = ni; } } }
            __syncthreads();
#pragma unroll 1
            for (int nf = 0; nf < 4; ++nf) { f32x4 acc0 = (f32x4){0.f, 0.f, 0.f, 0.f}, acc1 = acc0;
#pragma unroll
                for (int ks = 0; ks < 8; ++ks) { if (2 * ks <= t1 || 2 * ks <= t0) {
                    const int s = 2 * ks + (fq >> 1);
                    const bf16x8 bfr = *(const LAS bf16x8*)(UI + (((s * 64 + 16 * nf + fr) * 2 + (fq & 1)) * 16));
                    if (2 * ks <= t0) { bf16x8 tf = (bf16x8){0, 0, 0, 0, 0, 0, 0, 0}; if (s <= t0) tf = *(const LAS bf16x8*)(KST + ((t0 - s) * 16 + fr) * 16 + 8 * (fq & 1)); acc0 = __builtin_amdgcn_mfma_f32_16x16x32_bf16(tf, bfr, acc0, 0, 0, 0); }
                    if (2 * ks <= t1) { bf16x8 tf = (bf16x8){0, 0, 0, 0, 0, 0, 0, 0}; if (s <= t1) tf = *(const LAS bf16x8*)(KST + ((t1 - s) * 16 + fr) * 16 + 8 * (fq & 1)); acc1 = __builtin_amdgcn_mfma_f32_16x16x32_bf16(tf, bfr, acc1, 0, 0, 0); } } }
#pragma unroll
                for (int ks = 0; ks < 4; ++ks) { const bf16x8 xf = *(const LAS bf16x8*)(XP + (16 * nf + fr) * 136 + 32 * ks + 8 * fq);
                    acc0 = __builtin_amdgcn_mfma_f32_16x16x32_bf16(CM[0][ks], xf, acc0, 0, 0, 0); acc1 = __builtin_amdgcn_mfma_f32_16x16x32_bf16(CM[1][ks], xf, acc1, 0, 0, 0); }
#pragma unroll
                for (int ti = 0; ti < 2; ++ti) { const int t = ti ? t1 : t0; const f32x4 a = ti ? acc1 : acc0; const int n = 16 * nf + fr;
                    const v2u uw = *(const LAS v2u*)(UI + (((t * 64 + n) * 2 + (fq >> 1)) * 16) + 8 * (fq & 1));
                    const pg8::f32x2 g0 = pg8::gelu_pk((pg8::f32x2){a[0] + dsk[0] * bflo(uw.x), a[1] + dsk[1] * bfhi(uw.x)}), g1 = pg8::gelu_pk((pg8::f32x2){a[2] + dsk[2] * bflo(uw.y), a[3] + dsk[3] * bfhi(uw.y)});
                    v2u ow; ow.x = pg8::cvt_pk_bf16(g0.x, g0.y); ow.y = pg8::cvt_pk_bf16(g1.x, g1.y);
                    *(v2u*)(yb + (size_t)(b * SEQ + q * 1024 + 16 * n + t) * 2048 + 16 * g + 4 * fq) = ow; } }
        }
        }
    }
    __syncthreads();
}
#ifndef EN
#define EN(k) 1
#endif
template <int PH> __device__ __forceinline__ void run_phase(unsigned char* ws, float* X, LAS unsigned char* lds, int wave, int lane) {
    const int G = gridDim.x, bx = blockIdx.x;
    bf16* XB = (bf16*)(ws + WS_XB); float* SSQ = (float*)(ws + WS_SSQ);
    bf16* R0 = (bf16*)(ws + WS_R);
    constexpr int layer = (PH >= 10) ? 1 : 0;
    if constexpr (!EN(PH)) { return; }
    else if constexpr (PH == 0) p0_prologue(ws, lds, wave, lane);
    else if constexpr (PH == 1) {
        if (bx < 64) { const int i = bx >> 5;
            pg8::Gemm g{(const pg8::bf16_t*)(ws + WS_MEMB), (const pg8::bf16_t*)(ws + WS_W_KV + (size_t)i * 16 * MiB), MROWS, 4096, 2048}; pg8::StaticOrder S; S.init(MROWS, 4096, 32, bx & 31);
            pg8::EpiKV E{(pg8::bf16_t*)(ws + WS_KB + (size_t)i * 2 * MiB), (pg8::bf16_t*)(ws + WS_VB + (size_t)i * 2 * MiB), (pg8::bf16_t*)(ws + WS_VTB + (size_t)i * 2 * MiB), (const float*)(ws + WS_SSQM)};
            pg8::gemm_phase<pg8::EpiKV, pg8::StaticOrder, true, PG8_SP2V>(lds, g, S, E, wave, lane); }
        p1_convert(ws, lds, wave, lane);
    } else if constexpr (PH == 2) {
        pg8::Gemm g{XB, (const pg8::bf16_t*)(ws + WS_W_AIN), M, 4096, 2048}; pg8::StaticOrder S; S.init(M, 4096, G, bx);
        pg8::EpiAct<1, true> E{R0, 4096, ka_in(8), SSQ, 32, 1.0f, (float*)(ws + WS_VST), 8};
        pg8::gemm_phase<pg8::EpiAct<1, true>, pg8::StaticOrder, true, PG8_SP2V>(lds, g, S, E, wave, lane);
    } else if constexpr (PH == 3) {
#if defined(GATING_SIMPLE)
        gating_simple(lds, R0, (const float*)(ws + WS_VST), ka_in(9), ka_in(10), ka_in(11), ka_in(12), R0 + (size_t)M * 4096, wave * 64 + lane);
#else
        gating_mfma(lds, R0, (const float*)(ws + WS_VST), ka_in(9), ka_in(10), ka_in(11), ka_in(12), R0 + (size_t)M * 4096, wave, lane);
#endif
    }
    else if constexpr (PH == 4 || PH == 7 || PH == 9 || PH == 16 || PH == 18) {
        const pg8::bf16_t* A; const pg8::bf16_t* W; int K = 2048;
        if constexpr (PH == 4) { A = R0 + (size_t)M * 4096; W = (const pg8::bf16_t*)(ws + WS_W_AOUT); }
        else if constexpr (PH == 7 || PH == 16) { A = R0 + (size_t)M * 2048; W = (const pg8::bf16_t*)(ws + WS_W_O + (size_t)layer * 8 * MiB); }
        else { A = R0; W = (const pg8::bf16_t*)(ws + WS_W_DN + (size_t)layer * 32 * MiB); K = 8192; }
        pg8::Gemm g{A, W, M, 2048, K}; pg8::StaticOrder S; S.init(M, 2048, G, bx);
        pg8::EpiRes E{XB, SSQ};
        pg8::gemm_phase<pg8::EpiRes, pg8::StaticOrder, true, PG8_SP2V>(lds, g, S, E, wave, lane);
    } else if constexpr (PH == 5 || PH == 14 || PH == 10) {
        const pg8::bf16_t* W = (PH == 10) ? (const pg8::bf16_t*)(ws + WS_W_BIN) : (const pg8::bf16_t*)(ws + WS_W_Q + (size_t)layer * 8 * MiB);
        pg8::Gemm g{XB, W, M, 2048, 2048}; pg8::StaticOrder S; S.init(M, 2048, G, bx);
        pg8::EpiAct<0, false> E{R0, 2048, nullptr, SSQ, (PH == 14) ? 64 : 32, (PH == 10) ? 1.0f : 0.044194173824159216f * 1.4426950408889634f, nullptr, 0};
        pg8::gemm_phase<pg8::EpiAct<0, false>, pg8::StaticOrder, true, PG8_SP2V>(lds, g, S, E, wave, lane);
    } else if constexpr (PH == 6 || PH == 15) {
#if defined(ATTN_SIMPLE)
        attn_simple(lds, R0, (const bf16*)(ws + WS_KB + (size_t)layer * 2 * MiB), (const bf16*)(ws + WS_VB + (size_t)layer * 2 * MiB), R0 + (size_t)M * 2048, wave, lane);
#else
        attn_mfma(lds, R0, (const bf16*)(ws + WS_KB + (size_t)layer * 2 * MiB), (const bf16*)(ws + WS_VTB + (size_t)layer * 2 * MiB), R0 + (size_t)M * 2048, wave, lane);
#endif
    }
    else if constexpr (PH == 8 || PH == 17) {
        pg8::Gemm g{XB, (const pg8::bf16_t*)(ws + WS_W_UP + (size_t)layer * 32 * MiB), M, FF, 2048}; pg8::StaticOrder S; S.init(M, FF, G, bx);
        pg8::EpiAct<2, false> E{R0, FF, nullptr, SSQ, 32, 1.0f, nullptr, 0};
        pg8::gemm_phase<pg8::EpiAct<2, false>, pg8::StaticOrder, true, PG8_SP2V>(lds, g, S, E, wave, lane);
    } else if constexpr (PH == 11) {
#if defined(S5_SIMPLE)
        s5_pass_a(R0, (f32x2*)(ws + WS_S5ST), wave, lane);
#endif
    } else if constexpr (PH == 12) {
#if defined(S5_SIMPLE)
        s5_pass_c(lds, R0, (const f32x2*)(ws + WS_S5ST), R0 + (size_t)M * 2048, wave, lane);
#else
        s5_mfma(lds, R0, R0 + (size_t)M * 2048, wave, lane);
#endif
    }
    else if constexpr (PH == 13) {
        pg8::Gemm g{R0 + (size_t)M * 2048, (const pg8::bf16_t*)(ws + WS_W_BOUT), M, 4096, 2048}; pg8::StaticOrder S; S.init(M, 4096, G, bx);
        pg8::EpiGlu E{XB, SSQ, ka_in(24)};
        pg8::gemm_phase<pg8::EpiGlu, pg8::StaticOrder, true, PG8_SP2V>(lds, g, S, E, wave, lane);
    } else if constexpr (PH == 19) final_norm(XB, SSQ, ka_in(6), X, wave, lane);
}
__device__ __forceinline__ int lane_id() { int l; asm volatile("v_mbcnt_lo_u32_b32 %0, -1, 0\n\tv_mbcnt_hi_u32_b32 %0, -1, %0" : "=v"(l)); return l; }

#define XB_TMO      128
#define XB_XCNT(j)  (256  + 64 * (j))
#define XB_XSUB(j)  (1280 + 64 * (j))
#define XB_XGEN(j)  (2304 + 64 * (j))
#define XB_TOP      3328
#define XB_TOPGEN   3392
#define XCD_BAR_WORDS 3456
#define XB_SPIN_CAP (1u << 22)
__device__ __forceinline__ unsigned xb_ld(unsigned* p)              { return __hip_atomic_load(p, __ATOMIC_RELAXED, __HIP_MEMORY_SCOPE_AGENT); }
__device__ __forceinline__ unsigned xb_add(unsigned* p, unsigned v) { return __hip_atomic_fetch_add(p, v, __ATOMIC_RELAXED, __HIP_MEMORY_SCOPE_AGENT); }
__device__ __forceinline__ unsigned xb_xcc_id() { return (unsigned)__builtin_amdgcn_s_getreg((3 << 11) | 20) & 0xFu; }
#define XB_SPIN(cond, bar) do { unsigned _sp = 0; while (cond) { __builtin_amdgcn_s_sleep(1); \
    if ((++_sp & 255u) == 0u) { if (xb_ld(&(bar)[XB_TMO])) break; if (_sp > XB_SPIN_CAP) { atomicAdd(&(bar)[XB_TMO], 1u); break; } } } } while (0)
__device__ __forceinline__ void xcd_barrier_complete(unsigned* bar, unsigned x, unsigned& nloc, unsigned& nx) {
    const unsigned G = gridDim.x * gridDim.y * gridDim.z;
    unsigned sum, cnt, mine, sp = 0u;
    for (;;) {
        sum = 0u; cnt = 0u; mine = 0u;
#pragma unroll
        for (unsigned j = 0; j < 16; ++j) { const unsigned c = xb_ld(&bar[XB_XCNT(j)]); sum += c; cnt += (c > 0u) ? 1u : 0u; mine = (j == x) ? c : mine; }
        if (sum == G) break;
        __builtin_amdgcn_s_sleep(1);
        if ((++sp & 255u) == 0u) { if (xb_ld(&bar[XB_TMO])) break; if (sp > XB_SPIN_CAP) { atomicAdd(&bar[XB_TMO], 1u); break; } }
    }
    nloc = mine > 0u ? mine : 1u; nx = cnt > 0u ? cnt : 1u;
}
__device__ __forceinline__ void xcd_barrier(unsigned* bar, volatile LAS unsigned* st, bool is_t0) {
    asm volatile("s_waitcnt vmcnt(0)" ::: "memory");
    __syncthreads();
    if (is_t0) {
        __builtin_amdgcn_s_waitcnt(0);
        const unsigned x = xb_xcc_id();
        unsigned nloc = st[0], nx = st[1];
        if (nloc == 0u) { xcd_barrier_complete(bar, x, nloc, nx); st[0] = nloc; st[1] = nx; }
        const unsigned old = xb_add(&bar[XB_XSUB(x)], 1u);
        const unsigned gen = old / nloc;
        if (old + 1u == (gen + 1u) * nloc) {
            __builtin_amdgcn_fence(__ATOMIC_RELEASE, "agent");
            asm volatile("s_waitcnt vmcnt(0)" ::: "memory");
            const unsigned og = xb_add(&bar[XB_TOP], 1u);
            const unsigned tg = og / nx;
            if (og + 1u == (tg + 1u) * nx) xb_add(&bar[XB_TOPGEN], 1u);
            else XB_SPIN(xb_ld(&bar[XB_TOPGEN]) == tg, bar);
            __builtin_amdgcn_fence(__ATOMIC_ACQUIRE, "agent");
            xb_add(&bar[XB_XGEN(x)], 1u);
            asm volatile("s_waitcnt vmcnt(0)" ::: "memory");
        } else {
            XB_SPIN(xb_ld(&bar[XB_XGEN(x)]) == gen, bar);
            __builtin_amdgcn_fence(__ATOMIC_ACQUIRE, "agent");
            asm volatile("s_waitcnt vmcnt(0)" ::: "memory");
        }
    }
    __syncthreads();
}

__global__ void __launch_bounds__(NTHREADS, 2) trunk_fwd(Args args) {
    extern __shared__ __attribute__((aligned(16))) unsigned char lds_raw[];
    LAS unsigned char* lds = (LAS unsigned char*)lds_raw;
    const int wave = __builtin_amdgcn_readfirstlane((int)threadIdx.x >> 6);
    const int lo = args.ph_lo, hi = args.ph_hi;
    unsigned* bar = (unsigned*)args.ws + 4096;
    volatile LAS unsigned* st = (volatile LAS unsigned*)(lds + LDS_BYTES - 512);
#if MK_N_LAUNCHES == 1
    { const int l0 = lane_id(); if (wave == 0 && l0 < 2) st[l0] = 0u; __syncthreads(); if (wave == 0 && l0 == 0) (void)xb_add(&bar[XB_XCNT(xb_xcc_id())], 1u); }
#if defined(USE_CG_SYNC)
#define GRID_BAR(k) do { if ((k) == 1) cg::this_grid().sync(); else xcd_barrier(bar, st, wave == 0 && lane_id() == 0); } while (0)
#else
#define GRID_BAR(k) do { xcd_barrier(bar, st, wave == 0 && lane_id() == 0); } while (0)
#endif
#else
#define GRID_BAR(k) do { } while (0)
#endif
#ifndef DUP_PH
#define DUP_PH -1
#endif
#if defined(PROBE_GEMM)
#if PROBE_GEMM == 3
typedef pg8::StaticOrder ProbeOrder;
#else
struct ProbeOrder { int c;
    __device__ __forceinline__ void init(int, int, int, int c_) { c = c_; }
    __device__ __forceinline__ bool next(int i, pg8::Unit& u) const { if (i >= 4) return false;
#if PROBE_GEMM == 1
        u.pm = 0; u.pn = 0;
#else
        u.pm = c >> 3; u.pn = c & 7;
#endif
        return true; }
    __device__ __forceinline__ void a_ready(const pg8::Unit&) const {}
    __device__ __forceinline__ void done(const pg8::Unit&) const {} };
#endif
#endif
#if defined(STAMP_SEL)
#define STAMP(k) do { if (blockIdx.x == 0 && wave == 0 && lane_id() == 0) st[4 + (k)] = (unsigned)__builtin_amdgcn_s_memrealtime(); } while (0)
#else
#define STAMP(k) do { } while (0)
#endif
#define PHASE(k) if (lo <= (k) && (k) < hi) { if ((k) > lo) GRID_BAR(k); STAMP(k); run_phase<k>(args.ws, args.out, lds, wave, lane_id()); if ((k) == DUP_PH) { GRID_BAR(2); run_phase<k>(args.ws, args.out, lds, wave, lane_id()); } }
    PHASE(0) PHASE(1) PHASE(2) PHASE(3) PHASE(4) PHASE(5) PHASE(6) PHASE(7) PHASE(8) PHASE(9)
#if defined(PROBE_GEMM)
    { GRID_BAR(2); const int lane = lane_id(); unsigned char* ws = args.ws; bf16* R0 = (bf16*)(ws + WS_R);
      pg8::Gemm g{(bf16*)(ws + WS_XB), (const pg8::bf16_t*)(ws + WS_W_UP), M, FF, 2048}; ProbeOrder S; S.init(M, FF, gridDim.x, blockIdx.x);
      pg8::EpiAct<2, false> E{R0, FF, nullptr, (float*)(ws + WS_SSQ), 32, 1.0f, nullptr, 0};
      pg8::gemm_phase<pg8::EpiAct<2, false>, ProbeOrder, true, true>(lds, g, S, E, wave, lane); }
#endif
    PHASE(10)
#if defined(S5_SIMPLE)
    PHASE(11)
#endif
    PHASE(12) PHASE(13) PHASE(14) PHASE(15) PHASE(16) PHASE(17) PHASE(18) PHASE(19)
#undef PHASE
#if defined(STAMP_SEL)
    asm volatile("s_waitcnt vmcnt(0)" ::: "memory"); __syncthreads(); STAMP(20);
    if (blockIdx.x == 0 && wave == 0 && lane_id() == 0) { unsigned d = (st[4 + STAMP_SEL_END] - st[4 + STAMP_SEL]); d = (d > 100000u ? 0u : d) * STAMP_MUL; const unsigned t0 = (unsigned)__builtin_amdgcn_s_memrealtime();
        while ((unsigned)__builtin_amdgcn_s_memrealtime() - t0 < d) __builtin_amdgcn_s_sleep(8); }
#endif
}

extern "C" void kernel_launch(void* const* d_in, const int* in_sizes, int n_in, void* d_out, int out_size, void* d_ws, size_t ws_size, hipStream_t stream) {
    static int grid = 0;
    if (grid == 0) {
        if (n_in != 30 || out_size != M * D || ws_size < WS_END) { fprintf(stderr, "kernel_launch: unexpected shapes (n_in %d out %d ws %zu)\n", n_in, out_size, ws_size); grid = -1; return; }
        int dev = 0, cus = 0, per_cu = 0;
        if (hipGetDevice(&dev) != hipSuccess || hipDeviceGetAttribute(&cus, hipDeviceAttributeMultiprocessorCount, dev) != hipSuccess) { grid = -1; return; }
        if (hipFuncSetAttribute((const void*)trunk_fwd, hipFuncAttributeMaxDynamicSharedMemorySize, LDS_BYTES) != hipSuccess) { fprintf(stderr, "kernel_launch: hipFuncSetAttribute failed\n"); grid = -1; return; }
        if (hipOccupancyMaxActiveBlocksPerMultiprocessor(&per_cu, (const void*)trunk_fwd, NTHREADS, LDS_BYTES) != hipSuccess || per_cu < 1) { fprintf(stderr, "kernel_launch: occupancy query says %d\n", per_cu); grid = -1; return; }
        grid = cus;
    }
    if (grid < 0) return;
    if (hipMemsetAsync(d_ws, 0, 65536, stream) != hipSuccess) { fprintf(stderr, "kernel_launch: memset failed\n"); return; }
    Args a{};
    for (int i = 0; i < 30; ++i) a.in[i] = (const float*)d_in[i];
    a.out = (float*)d_out; a.ws = (unsigned char*)d_ws;
#if MK_N_LAUNCHES == 1
    a.ph_lo = 0; a.ph_hi = NPH;
    void* kargs[] = {&a};
    hipError_t e = hipLaunchCooperativeKernel((const void*)trunk_fwd, dim3(grid), dim3(NTHREADS), kargs, LDS_BYTES, stream);
    if (e != hipSuccess) fprintf(stderr, "kernel_launch: cooperative launch failed: %s\n", hipGetErrorString(e));
#else
    for (int ph = 0; ph < NPH; ++ph) { a.ph_lo = ph; a.ph_hi = ph + 1; hipLaunchKernelGGL(trunk_fwd, dim3(grid), dim3(NTHREADS), LDS_BYTES, stream, a); }
#endif
}
```

```cpp
#include <hip/hip_runtime.h>
#include <hip/hip_cooperative_groups.h>
#include <cstdio>
#include <cstdint>
namespace cg = cooperative_groups;
#define MK_N_LAUNCHES 1
#define PG8_SP2V true
namespace pg8 {
#define PG8_LAS __attribute__((address_space(3)))
typedef unsigned short bf16_t;
typedef short bf16x8 __attribute__((ext_vector_type(8)));
typedef float f32x4 __attribute__((ext_vector_type(4)));
typedef unsigned u32x4 __attribute__((ext_vector_type(4)));
constexpr int BM = 256, BK = 64, HALF = 128, HTB = HALF * BK * 2  , STAGE_BYTES = 8 * HTB, NXCD = 8, WGM = 8;

__host__ __device__ __forceinline__ int lds_byte(int r, int c) { const int st = (r >> 4) * 2 + (c >> 5), rr = r & 15, cc = c & 31, ob = rr * 64 + cc * 2; return st * 1024 + (ob ^ (((ob >> 9) & 1) << 5)); }
__host__ __device__ __forceinline__ void stage_rc(int b, int& R, int& C) { const int st = b / 1024, sb = b % 1024, swz = sb ^ (((sb >> 9) & 1) << 5); R = (st >> 1) * 16 + swz / 64; C = (st & 1) * 32 + (swz % 64) / 2; }
__host__ __device__ __forceinline__ int perm32(int rho) { const int n = rho >> 4, i = rho & 15; return 8 * (i >> 2) + 4 * n + (i & 3); }

struct Unit { int pm, pn; };
struct Gemm { const bf16_t* A; const bf16_t* Bt; int M, N, K; };

struct StaticOrder {
    int nM, nN, nwg, G, c;
    __host__ __device__ void init(int M, int N, int G_, int c_) { nM = M / BM; nN = N / BM; nwg = nM * nN; G = G_; c = c_; }
    __host__ __device__ bool next(int i, Unit& u) const {
        const long L = (long)i * G + c; if (L >= nwg) return false;
        int wgid = (int)L; { const int q = nwg / NXCD, r = nwg % NXCD, xcd = wgid % NXCD, off = wgid / NXCD; wgid = (xcd < r ? xcd * (q + 1) : r * (q + 1) + (xcd - r) * q) + off; }
        const int nig = WGM * nN, gid = wgid / nig, fm = gid * WGM, gsz = (nM - fm) < WGM ? (nM - fm) : WGM;
        u.pm = fm + ((wgid % nig) % gsz); u.pn = (wgid % nig) / gsz; return true;
    }
    __device__ __forceinline__ void a_ready(const Unit&) const {}
    __device__ __forceinline__ void done(const Unit&) const {}
};

__device__ __forceinline__ unsigned cvt_pk_bf16(float lo, float hi) { unsigned r; asm volatile("v_cvt_pk_bf16_f32 %0, %1, %2" : "=v"(r) : "v"(lo), "v"(hi)); return r; }
typedef float f32x2 __attribute__((ext_vector_type(2)));
__device__ __forceinline__ f32x2 gelu_pk(f32x2 v) {
    const f32x2 av = __builtin_elementwise_abs(v), d = av * 0.2316418882f + 1.0f;
    f32x2 t; t.x = __builtin_amdgcn_rcpf(d.x); t.y = __builtin_amdgcn_rcpf(d.y);
    f32x2 q = t * 0.5307027145f + (-0.7265760135f); q = q * t + 0.7107068705f; q = q * t + (-0.142248368f); q = q * t + 0.127414796f; q = q * t;
    const f32x2 s = (v * v) * (-0.72134752044f);
    f32x2 e; e.x = __builtin_amdgcn_exp2f(s.x); e.y = __builtin_amdgcn_exp2f(s.y);
    const f32x2 m = v * (q * e), r = v - m;
    f32x2 o; o.x = v.x < 0.f ? m.x : r.x; o.y = v.y < 0.f ? m.y : r.y; return o;
}
typedef unsigned u32x2 __attribute__((ext_vector_type(2)));
#if defined(WT_STORES)
__device__ __forceinline__ void st_wt16(void* p, u32x4 v) { asm volatile("global_store_dwordx4 %0, %1, off sc1\n\ts_nop 1" :: "v"(p), "v"(v) : "memory"); }
__device__ __forceinline__ void st_wt8(void* p, u32x2 v) { asm volatile("global_store_dwordx2 %0, %1, off sc1\n\ts_nop 1" :: "v"(p), "v"(v) : "memory"); }
#else
__device__ __forceinline__ void st_wt16(void* p, u32x4 v) { *(u32x4*)p = v; }
__device__ __forceinline__ void st_wt8(void* p, u32x2 v) { *(u32x2*)p = v; }
#endif
constexpr int SSQ_STRIDE = 64;
__device__ __forceinline__ float row_rstd(const float* ssq, int np, int row, int fq) {
    const float* p = ssq + (size_t)row * SSQ_STRIDE + fq * (np >> 2);
    f32x4 a = *(const f32x4*)p, b = *(const f32x4*)(p + 4);
    float s = (a[0] + a[1]) + (a[2] + a[3]) + (b[0] + b[1]) + (b[2] + b[3]);
    if (np == 64) { f32x4 c = *(const f32x4*)(p + 8), d = *(const f32x4*)(p + 12); s += (c[0] + c[1]) + (c[2] + c[3]) + (d[0] + d[1]) + (d[2] + d[3]); }
    s += __shfl_xor(s, 16); s += __shfl_xor(s, 32);
    return __builtin_amdgcn_rsqf(s * (1.0f / 2048.0f) + 1e-6f);
}
template <int ACT, bool STATS> struct EpiAct {
    static constexpr bool PERM = true, AFTER_DRAIN = false;
    bf16_t* O; int ldc; const float* bias; const float* ssq; int np; float oscale; float* vst; int stat_pn0;
    __device__ __forceinline__ void operator()(const f32x4 (&acc)[2][2][4][2], const Unit& u, int wr, int wc, int fr, int fq) const {
        const int row0 = u.pm * BM + wr * 64 + fr, col0 = u.pn * BM + wc * 32 + 8 * fq;
        f32x4 bv[2][2];
#pragma unroll
        for (int bj = 0; bj < 2; ++bj)
#pragma unroll
            for (int n = 0; n < 2; ++n) bv[bj][n] = bias ? *(const f32x4*)(bias + col0 + bj * HALF + 4 * n) : (f32x4){0.f, 0.f, 0.f, 0.f};
        float rsv[2][4];
#pragma unroll
        for (int ai = 0; ai < 2; ++ai) {
#pragma unroll
            for (int m = 0; m < 4; ++m) rsv[ai][m] = row_rstd(ssq, np, row0 + ai * HALF + m * 16, fq); }
#pragma unroll
        for (int ai = 0; ai < 2; ++ai)
#pragma unroll
            for (int m = 0; m < 4; ++m) { const int row = row0 + ai * HALF + m * 16; const float rs = rsv[ai][m];
                bf16_t* rowp = O + (size_t)row * ldc + col0; float s1 = 0.f, s2 = 0.f;
#pragma unroll
                for (int bj = 0; bj < 2; ++bj) { f32x4 v0 = acc[ai][bj][m][0] * rs + bv[bj][0], v1 = acc[ai][bj][m][1] * rs + bv[bj][1];
                    if (ACT == 1) { f32x2 a = gelu_pk((f32x2){v0[0], v0[1]}), b = gelu_pk((f32x2){v0[2], v0[3]}), c = gelu_pk((f32x2){v1[0], v1[1]}), d = gelu_pk((f32x2){v1[2], v1[3]});
                        v0 = (f32x4){a.x, a.y, b.x, b.y}; v1 = (f32x4){c.x, c.y, d.x, d.y}; }
                    if (ACT == 2) {
#pragma unroll
                        for (int j = 0; j < 4; ++j) { const float a = fmaxf(v0[j], 0.f), b = fmaxf(v1[j], 0.f); v0[j] = a * a; v1[j] = b * b; } }
                    v0 = v0 * oscale; v1 = v1 * oscale;
                    if (STATS) { s1 += (v0[0] + v0[1]) + (v0[2] + v0[3]) + (v1[0] + v1[1]) + (v1[2] + v1[3]);
                        s2 += (v0[0] * v0[0] + v0[1] * v0[1]) + (v0[2] * v0[2] + v0[3] * v0[3]) + (v1[0] * v1[0] + v1[1] * v1[1]) + (v1[2] * v1[2] + v1[3] * v1[3]); }
                    u32x4 w; w.x = cvt_pk_bf16(v0[0], v0[1]); w.y = cvt_pk_bf16(v0[2], v0[3]); w.z = cvt_pk_bf16(v1[0], v1[1]); w.w = cvt_pk_bf16(v1[2], v1[3]);
                    st_wt16(rowp + bj * HALF, w); }
                if (STATS) { s1 += __shfl_xor(s1, 16); s1 += __shfl_xor(s1, 32); s2 += __shfl_xor(s2, 16); s2 += __shfl_xor(s2, 32);
                    if (u.pn >= stat_pn0 && fq == 0) *(f32x2*)(vst + (size_t)row * SSQ_STRIDE + ((u.pn - stat_pn0) * 4 + wc) * 2) = (f32x2){s1, s2}; }
            }
    }
};
struct EpiRes {
    static constexpr bool PERM = true, AFTER_DRAIN = false;
    bf16_t* xb; float* ssq;
    __device__ __forceinline__ void operator()(const f32x4 (&acc)[2][2][4][2], const Unit& u, int wr, int wc, int fr, int fq) const {
        const int row0 = u.pm * BM + wr * 64 + fr, col0 = u.pn * BM + wc * 32 + 8 * fq;
#pragma unroll
        for (int ai = 0; ai < 2; ++ai) {
            u32x4 pre[4][2];
#pragma unroll
            for (int m = 0; m < 4; ++m) { const size_t off = (size_t)(row0 + ai * HALF + m * 16) * 2048 + col0;
#pragma unroll
                for (int bj = 0; bj < 2; ++bj) pre[m][bj] = *(const u32x4*)(xb + off + bj * HALF); }
            asm volatile("" ::: "memory");
#pragma unroll
            for (int m = 0; m < 4; ++m) { const int row = row0 + ai * HALF + m * 16; const size_t off = (size_t)row * 2048 + col0; float ss = 0.f;
#pragma unroll
                for (int bj = 0; bj < 2; ++bj) { const u32x4 b = pre[m][bj]; const f32x4 a0 = acc[ai][bj][m][0], a1 = acc[ai][bj][m][1];
                    const float o0 = __builtin_bit_cast(float, b.x << 16) + a0[0], o1 = __builtin_bit_cast(float, b.x & 0xffff0000u) + a0[1], o2 = __builtin_bit_cast(float, b.y << 16) + a0[2], o3 = __builtin_bit_cast(float, b.y & 0xffff0000u) + a0[3];
                    const float o4 = __builtin_bit_cast(float, b.z << 16) + a1[0], o5 = __builtin_bit_cast(float, b.z & 0xffff0000u) + a1[1], o6 = __builtin_bit_cast(float, b.w << 16) + a1[2], o7 = __builtin_bit_cast(float, b.w & 0xffff0000u) + a1[3];
                    ss += (o0 * o0 + o1 * o1) + (o2 * o2 + o3 * o3) + (o4 * o4 + o5 * o5) + (o6 * o6 + o7 * o7);
                    u32x4 w; w.x = cvt_pk_bf16(o0, o1); w.y = cvt_pk_bf16(o2, o3); w.z = cvt_pk_bf16(o4, o5); w.w = cvt_pk_bf16(o6, o7); st_wt16(xb + off + bj * HALF, w); }
                ss += __shfl_xor(ss, 16); ss += __shfl_xor(ss, 32);
                if (fq == 0) ssq[(size_t)row * SSQ_STRIDE + u.pn * 4 + wc] = ss; }
            asm volatile("" ::: "memory"); }
    }
};
struct EpiGlu {
    static constexpr bool PERM = false, AFTER_DRAIN = false;
    bf16_t* xb; float* ssq; const float* bias;
    __device__ __forceinline__ void operator()(const f32x4 (&acc)[2][2][4][2], const Unit& u, int wr, int wc, int fr, int fq) const {
        const int row0 = u.pm * BM + wr * 64 + fr, col0 = u.pn * 128 + wc * 16 + 4 * fq;
        f32x4 bval[2], bgate[2];
#pragma unroll
        for (int bj = 0; bj < 2; ++bj) { bval[bj] = *(const f32x4*)(bias + col0 + bj * 64); bgate[bj] = *(const f32x4*)(bias + 2048 + col0 + bj * 64); }
#pragma unroll
        for (int ai = 0; ai < 2; ++ai) {
            u32x2 pre[4][2];
#pragma unroll
            for (int m = 0; m < 4; ++m) { const size_t off = (size_t)(row0 + ai * HALF + m * 16) * 2048 + col0;
#pragma unroll
                for (int bj = 0; bj < 2; ++bj) pre[m][bj] = *(const u32x2*)(xb + off + bj * 64); }
            asm volatile("" ::: "memory");
#pragma unroll
            for (int m = 0; m < 4; ++m) { const int row = row0 + ai * HALF + m * 16; const size_t off = (size_t)row * 2048 + col0; float ss = 0.f;
#pragma unroll
                for (int bj = 0; bj < 2; ++bj) { const f32x4 val = acc[ai][bj][m][0] + bval[bj], gate = acc[ai][bj][m][1] + bgate[bj]; const u32x2 pb = pre[m][bj]; f32x4 o = (f32x4){__builtin_bit_cast(float, pb.x << 16), __builtin_bit_cast(float, pb.x & 0xffff0000u), __builtin_bit_cast(float, pb.y << 16), __builtin_bit_cast(float, pb.y & 0xffff0000u)};
#pragma unroll
                    for (int j = 0; j < 4; ++j) { const float sg = __builtin_amdgcn_rcpf(1.0f + __builtin_amdgcn_exp2f(-1.4426950408889634f * gate[j])); o[j] += val[j] * sg; }
                    ss += (o[0] * o[0] + o[1] * o[1]) + (o[2] * o[2] + o[3] * o[3]);
                    u32x2 w; w.x = cvt_pk_bf16(o[0], o[1]); w.y = cvt_pk_bf16(o[2], o[3]); st_wt8(xb + off + bj * 64, w); }
                ss += __shfl_xor(ss, 16); ss += __shfl_xor(ss, 32);
                if (fq == 0) ssq[(size_t)row * SSQ_STRIDE + u.pn * 4 + wc] = ss; }
            asm volatile("" ::: "memory"); }
    }
};
__host__ __device__ __forceinline__ int vt_pos(int key) { const int s = key >> 5, w = key & 31; return 32 * s + 8 * ((w & 15) >> 2) + (w & 3) + 4 * (w >> 4); }
struct EpiKV {
    static constexpr bool PERM = true, AFTER_DRAIN = false;
    bf16_t* Kb; bf16_t* Vb; bf16_t* VTb; const float* ssq;
    __device__ __forceinline__ void operator()(const f32x4 (&acc)[2][2][4][2], const Unit& u, int wr, int wc, int fr, int fq) const {
        const int row0 = u.pm * BM + wr * 64 + fr, col0 = u.pn * BM + wc * 32 + 8 * fq;
#pragma unroll
        for (int ai = 0; ai < 2; ++ai)
#pragma unroll
            for (int m = 0; m < 4; ++m) { const int row = row0 + ai * HALF + m * 16; const float rs = row_rstd(ssq, 32, row, fq); const int b = row >> 8, key = row & 255;
#pragma unroll
                for (int bj = 0; bj < 2; ++bj) { const f32x4 v0 = acc[ai][bj][m][0] * rs, v1 = acc[ai][bj][m][1] * rs; const int col = col0 + bj * HALF;
                    u32x4 w; w.x = cvt_pk_bf16(v0[0], v0[1]); w.y = cvt_pk_bf16(v0[2], v0[3]); w.z = cvt_pk_bf16(v1[0], v1[1]); w.w = cvt_pk_bf16(v1[2], v1[3]);
                    if (col < 2048) { const int h = col >> 9, d = col & 511; *(u32x4*)(Kb + ((size_t)((b * 4 + h) * 256 + key)) * 512 + d) = w; }
                    else { const int c2 = col - 2048, h = c2 >> 9, d = c2 & 511; *(u32x4*)(Vb + ((size_t)((b * 4 + h) * 256 + key)) * 512 + d) = w;
                        bf16_t* vt = VTb + ((size_t)((b * 4 + h) * 512 + d)) * 256 + vt_pos(key);
                        vt[0 * 256] = (bf16_t)(w.x & 0xffffu); vt[1 * 256] = (bf16_t)(w.x >> 16); vt[2 * 256] = (bf16_t)(w.y & 0xffffu); vt[3 * 256] = (bf16_t)(w.y >> 16);
                        vt[4 * 256] = (bf16_t)(w.z & 0xffffu); vt[5 * 256] = (bf16_t)(w.z >> 16); vt[6 * 256] = (bf16_t)(w.w & 0xffffu); vt[7 * 256] = (bf16_t)(w.w >> 16); } }
            }
    }
};
template <class Epi, class Sched, bool ALIGN_EPI = false, bool SP2 = false>
__device__ __forceinline__ void gemm_phase(PG8_LAS unsigned char* lds, const Gemm g, const Sched& S, const Epi& E, const int wid  , const int lane) {
    const int tid = wid * 64 + lane, wr = wid >> 2, wc = wid & 3, fr = lane & 15, fq = lane >> 4;
    const int K = g.K, nt = K / BK;
    unsigned voffA[2], voffB[2];
#pragma unroll
    for (int i = 0; i < 2; ++i) { int R, C; stage_rc(tid * 16 + i * 8192, R, C); const int Rb = Epi::PERM ? ((R & ~31) + perm32(R & 31)) : R;
        voffA[i] = (unsigned)(R * K + C) * 2u; voffB[i] = (unsigned)(Rb * K + C) * 2u; }
    const size_t kstep = (size_t)(BK * 2);
    const size_t hstep = (size_t)HALF * K * 2;
    const size_t tstep = 2 * hstep;
    const unsigned ldsw = (unsigned)wid * 1024u;
    const int aoff = lds_byte(wr * 64 + fr, fq * 8), boff = lds_byte(wc * 32 + fr, fq * 8);
#define PG8_SA(b, h) (((b) * 2 + (h)) * HTB)
#define PG8_SB(b, h) ((4 + (b) * 2 + (h)) * HTB)
#define PG8_STAGE(bufoff, gbase, voff) do { _Pragma("unroll") for (int _i = 0; _i < 2; ++_i) \
        __builtin_amdgcn_global_load_lds((const unsigned*)((const char*)(gbase) + (voff)[_i]), (PG8_LAS unsigned*)(lds + (bufoff) + ldsw + _i * 8192), 16, 0, 0); } while (0)
#define PG8_LDA(dst, b, h) do { _Pragma("unroll") for (int m = 0; m < 4; ++m) _Pragma("unroll") for (int k = 0; k < 2; ++k) dst[m][k] = *(const PG8_LAS bf16x8*)(lds + PG8_SA(b, h) + aoff + m * 2048 + k * 1024); } while (0)
#define PG8_LDB(dst, b, h) do { _Pragma("unroll") for (int n = 0; n < 2; ++n) _Pragma("unroll") for (int k = 0; k < 2; ++k) dst[n][k] = *(const PG8_LAS bf16x8*)(lds + PG8_SB(b, h) + boff + n * 2048 + k * 1024); } while (0)
#define PG8_MMA(ai, bj, At, Bt) do { __builtin_amdgcn_s_setprio(1); _Pragma("unroll") for (int m = 0; m < 4; ++m) _Pragma("unroll") for (int n = 0; n < 2; ++n) _Pragma("unroll") for (int k = 0; k < 2; ++k) \
        acc[ai][bj][m][n] = __builtin_amdgcn_mfma_f32_16x16x32_bf16(Bt[n][k], At[m][k], acc[ai][bj][m][n], 0, 0, 0); __builtin_amdgcn_s_setprio(0); } while (0)
#define PG8_WAIT_V(n) asm volatile("s_waitcnt vmcnt(" #n ")" ::: "memory")
#define PG8_WAIT_L(n) asm volatile("s_waitcnt lgkmcnt(" #n ")" ::: "memory")
#define PG8_BAR __builtin_amdgcn_s_barrier()
#define PG8_SCHED __builtin_amdgcn_sched_barrier(0)
    Unit cur, nxt; int ui = 0;
    if (!S.next(0, cur)) return;
    f32x4 acc[2][2][4][2];
#pragma unroll
    for (int a = 0; a < 2; ++a)
#pragma unroll
        for (int b = 0; b < 2; ++b)
#pragma unroll
            for (int m = 0; m < 4; ++m)
#pragma unroll
                for (int n = 0; n < 2; ++n) acc[a][b][m][n] = (f32x4){0.f, 0.f, 0.f, 0.f};
    bf16x8 At[4][2], B0[2][2], B1[2][2];
    const char* cA = (const char*)g.A + (size_t)cur.pm * tstep; const char* cB = (const char*)g.Bt + (size_t)cur.pn * tstep;
    S.a_ready(cur);
    if constexpr (SP2) {
        PG8_STAGE(PG8_SB(0, 0), cB, voffB); PG8_STAGE(PG8_SB(0, 1), cB + hstep, voffB); PG8_STAGE(PG8_SA(0, 0), cA, voffA); PG8_STAGE(PG8_SA(0, 1), cA + hstep, voffA);
        if (wr == 1) PG8_BAR;
        PG8_WAIT_V(2); PG8_BAR;
        PG8_STAGE(PG8_SB(1, 0), cB + kstep, voffB); PG8_STAGE(PG8_SA(1, 0), cA + kstep, voffA); PG8_STAGE(PG8_SB(1, 1), cB + hstep + kstep, voffB);
        PG8_WAIT_V(6); PG8_BAR;
    } else {
        PG8_STAGE(PG8_SB(0, 0), cB, voffB); PG8_STAGE(PG8_SA(0, 0), cA, voffA); PG8_STAGE(PG8_SB(0, 1), cB + hstep, voffB); PG8_STAGE(PG8_SA(0, 1), cA + hstep, voffA);
        if (wr == 1) PG8_BAR;
        PG8_WAIT_V(4); PG8_BAR;
        PG8_STAGE(PG8_SB(1, 0), cB + kstep, voffB); PG8_STAGE(PG8_SA(1, 0), cA + kstep, voffA); PG8_STAGE(PG8_SB(1, 1), cB + hstep + kstep, voffB);
        PG8_WAIT_V(6); PG8_BAR;
    }
    for (;;) {
        const bool has_next = S.next(ui + 1, nxt);
        const char* nA = has_next ? (const char*)g.A + (size_t)nxt.pm * tstep : cA; const char* nB = has_next ? (const char*)g.Bt + (size_t)nxt.pn * tstep : cB;
        for (int t = 0; t < nt; t += 2) {
            const bool last = (t == nt - 2);
            const char* a1 = cA + (size_t)(t + 1) * kstep;
            const char* a2 = last ? nA : cA + (size_t)(t + 2) * kstep; const char* b2 = last ? nB : cB + (size_t)(t + 2) * kstep;
            const char* a3 = a2 + kstep; const char* b3 = b2 + kstep;
            if (last && has_next) S.a_ready(nxt);
            if constexpr (SP2) {
            PG8_LDB(B0, 0, 0); PG8_LDB(B1, 0, 1); PG8_SCHED; PG8_LDA(At, 0, 0); PG8_STAGE(PG8_SA(1, 1), a1 + hstep, voffA);
            PG8_WAIT_V(8); PG8_WAIT_L(0); PG8_BAR; PG8_MMA(0, 0, At, B0); PG8_MMA(0, 1, At, B1); PG8_BAR; PG8_SCHED;
            PG8_LDA(At, 0, 1); PG8_STAGE(PG8_SB(0, 0), b2, voffB); PG8_STAGE(PG8_SB(0, 1), b2 + hstep, voffB); PG8_STAGE(PG8_SA(0, 0), a2, voffA);
            PG8_WAIT_V(8); PG8_WAIT_L(0); PG8_BAR; PG8_MMA(1, 0, At, B0); PG8_MMA(1, 1, At, B1); PG8_BAR; PG8_SCHED;
            PG8_LDB(B0, 1, 0); PG8_LDB(B1, 1, 1); PG8_SCHED; PG8_LDA(At, 1, 0); PG8_STAGE(PG8_SA(0, 1), a2 + hstep, voffA);
            PG8_WAIT_V(8); PG8_WAIT_L(0); PG8_BAR; PG8_MMA(0, 0, At, B0); PG8_MMA(0, 1, At, B1); PG8_BAR; PG8_SCHED;
            PG8_LDA(At, 1, 1); PG8_STAGE(PG8_SB(1, 0), b3, voffB); PG8_STAGE(PG8_SB(1, 1), b3 + hstep, voffB); PG8_STAGE(PG8_SA(1, 0), a3, voffA);
            PG8_WAIT_V(8); PG8_WAIT_L(0); PG8_BAR; PG8_MMA(1, 0, At, B0); PG8_MMA(1, 1, At, B1); PG8_BAR; PG8_SCHED;
            } else {
            PG8_LDB(B0, 0, 0); PG8_SCHED; PG8_LDA(At, 0, 0); PG8_STAGE(PG8_SA(1, 1), a1 + hstep, voffA);
            PG8_WAIT_L(8); PG8_BAR; PG8_WAIT_L(0); PG8_MMA(0, 0, At, B0); PG8_BAR; PG8_SCHED;
            PG8_LDB(B1, 0, 1); PG8_STAGE(PG8_SB(0, 0), b2, voffB);
            PG8_BAR; PG8_WAIT_L(0); PG8_MMA(0, 1, At, B1); PG8_BAR;
            PG8_LDA(At, 0, 1); PG8_STAGE(PG8_SA(0, 0), a2, voffA);
            PG8_BAR; PG8_WAIT_L(0); PG8_MMA(1, 0, At, B0); PG8_BAR; PG8_SCHED;
            PG8_STAGE(PG8_SB(0, 1), b2 + hstep, voffB);
            PG8_WAIT_V(6); PG8_BAR; PG8_MMA(1, 1, At, B1); PG8_BAR;
            PG8_LDB(B0, 1, 0); PG8_SCHED; PG8_LDA(At, 1, 0); PG8_STAGE(PG8_SA(0, 1), a2 + hstep, voffA);
            PG8_WAIT_L(8); PG8_BAR; PG8_WAIT_L(0); PG8_MMA(0, 0, At, B0); PG8_BAR; PG8_SCHED;
            PG8_LDB(B1, 1, 1); PG8_STAGE(PG8_SB(1, 0), b3, voffB);
            PG8_BAR; PG8_WAIT_L(0); PG8_MMA(0, 1, At, B1); PG8_BAR;
            PG8_LDA(At, 1, 1); PG8_STAGE(PG8_SA(1, 0), a3, voffA);
            PG8_BAR; PG8_WAIT_L(0); PG8_MMA(1, 0, At, B0); PG8_BAR; PG8_SCHED;
            PG8_STAGE(PG8_SB(1, 1), b3 + hstep, voffB);
            PG8_WAIT_V(6); PG8_BAR; PG8_MMA(1, 1, At, B1); PG8_BAR;
            }
        }
        if constexpr (ALIGN_EPI) { if (wr == 0) PG8_BAR; }
        if constexpr (!Epi::AFTER_DRAIN) { Unit ue = cur; asm volatile("" : "+s"(ue.pm), "+s"(ue.pn));
            int fre = fr, fqe = fq; asm volatile("" : "+v"(fre), "+v"(fqe)); E(acc, ue, wr, wc, fre, fqe); S.done(cur); }
        if (!has_next) break;
#pragma unroll
        for (int a = 0; a < 2; ++a)
#pragma unroll
            for (int b = 0; b < 2; ++b)
#pragma unroll
                for (int m = 0; m < 4; ++m)
#pragma unroll
                    for (int n = 0; n < 2; ++n) acc[a][b][m][n] = (f32x4){0.f, 0.f, 0.f, 0.f};
        cur = nxt; cA = nA; cB = nB; ++ui;
        if constexpr (ALIGN_EPI) { if (wr == 1) PG8_BAR; }
    }
    PG8_WAIT_V(0);
    if constexpr (!ALIGN_EPI) { if (wr == 0) PG8_BAR; }
    PG8_BAR;
    if constexpr (Epi::AFTER_DRAIN) { E.fused(acc, cur, wr, wc, fr, fq, lds, wid, lane); S.done(cur); }
#undef PG8_SA
#undef PG8_SB
#undef PG8_STAGE
#undef PG8_LDA
#undef PG8_LDB
#undef PG8_MMA
#undef PG8_WAIT_V
#undef PG8_WAIT_L
#undef PG8_BAR
#undef PG8_SCHED
}
}
#ifndef MK_N_LAUNCHES
#define MK_N_LAUNCHES 1
#endif
constexpr int BATCH = 2, SEQ = 4096, D = 2048, M = BATCH * SEQ, MEMLEN = 256, MROWS = BATCH * MEMLEN, FF = 8192;
constexpr int NWAVES = 8, NTHREADS = 512, NPH = 20;
constexpr int LDS_BYTES = 147456;
constexpr size_t MiB = 1u << 20;
constexpr size_t WS_W_AIN = 2 * MiB, WS_W_AOUT = 18 * MiB, WS_W_BIN = 26 * MiB, WS_W_BOUT = 34 * MiB, WS_W_Q = 50 * MiB, WS_W_KV = 66 * MiB, WS_W_O = 98 * MiB, WS_W_UP = 114 * MiB, WS_W_DN = 178 * MiB;
constexpr size_t WS_XB = 242 * MiB, WS_MEMB = 274 * MiB, WS_KB = 276 * MiB, WS_VB = 280 * MiB, WS_VTB = 284 * MiB, WS_SSQ = 288 * MiB, WS_VST = 290 * MiB, WS_SSQM = 292 * MiB, WS_S5ST = 294 * MiB;
constexpr size_t WS_R = 304 * MiB, WS_END = 432 * MiB;
#define GAS __attribute__((address_space(1)))
#define LAS __attribute__((address_space(3)))
typedef unsigned short bf16;
typedef unsigned v4u __attribute__((ext_vector_type(4)));
typedef unsigned v2u __attribute__((ext_vector_type(2)));
typedef float f32x4 __attribute__((ext_vector_type(4)));
typedef float f32x2 __attribute__((ext_vector_type(2)));
typedef short bf16x8 __attribute__((ext_vector_type(8)));
#define LDS_WAIT() asm volatile("s_waitcnt lgkmcnt(0)" ::: "memory")
__device__ __forceinline__ unsigned f2bf(float f) { unsigned u = __builtin_bit_cast(unsigned, f); return (u + 0x7fffu + ((u >> 16) & 1u)) >> 16; }
__device__ __forceinline__ unsigned pk2(float lo, float hi) { return f2bf(lo) | (f2bf(hi) << 16); }
__device__ __forceinline__ float bflo(unsigned w) { return __builtin_bit_cast(float, w << 16); }
__device__ __forceinline__ float bfhi(unsigned w) { return __builtin_bit_cast(float, w & 0xffff0000u); }
__device__ __forceinline__ float wave_sum(float v) {
#pragma unroll
    for (int o = 1; o < 64; o <<= 1) v += __shfl_xor(v, o);
    return v;
}
__device__ __forceinline__ float wave_max(float v) {
#pragma unroll
    for (int o = 1; o < 64; o <<= 1) v = fmaxf(v, __shfl_xor(v, o));
    return v;
}
__device__ __forceinline__ float gelu_exact(float v) { return 0.5f * v * (1.0f + erff(v * 0.70710678118654752f)); }

struct Args { const float* in[30]; float* out; unsigned char* ws; int ph_lo, ph_hi; };
__device__ __forceinline__ const float* ka_in(int i) { const __attribute__((address_space(4))) char* ka = (const __attribute__((address_space(4))) char*)__builtin_amdgcn_kernarg_segment_ptr(); asm volatile("" : "+s"(ka)); return *(const float* const __attribute__((address_space(4)))*)(ka + 8 * i); }

#if defined(STAMP_SEL)
#define STAMP2(lds_, id) do { __syncthreads(); if (blockIdx.x == 0 && wave == 0 && lane_id2() == 0) ((volatile LAS unsigned*)((lds_) + LDS_BYTES - 512))[4 + (id)] = (unsigned)__builtin_amdgcn_s_memrealtime(); } while (0)
__device__ __forceinline__ int lane_id2() { int l; asm volatile("v_mbcnt_lo_u32_b32 %0, -1, 0\n\tv_mbcnt_hi_u32_b32 %0, -1, %0" : "=v"(l)); return l; }
#else
#define STAMP2(lds_, id) do { } while (0)
#endif
__device__ __forceinline__ int glu_rowmap(int n) { return n < 2048 ? 32 * (n >> 4) + (n & 15) : 32 * ((n - 2048) >> 4) + 16 + (n & 15); }
struct ConvSel { const float* W; const float* g; bf16* WT; int K, N, mode, item; };
__device__ __forceinline__ ConvSel conv_select(unsigned char* ws, int r) {
    ConvSel s; s.g = nullptr; s.K = 2048; s.N = 2048; s.mode = 0;
    if (r < 2048) { s.W = ka_in(7); s.g = ka_in(2); s.WT = (bf16*)(ws + WS_W_AIN); s.N = 4096; }
    else if ((r -= 2048) < 1024) { s.W = ka_in(13); s.WT = (bf16*)(ws + WS_W_AOUT); }
    else if ((r -= 1024) < 1024) { s.W = ka_in(14); s.g = ka_in(2) + 2048; s.WT = (bf16*)(ws + WS_W_BIN); }
    else if ((r -= 1024) < 2048) { s.W = ka_in(23); s.WT = (bf16*)(ws + WS_W_BOUT); s.N = 4096; s.mode = 1; }
    else if ((r -= 2048) < 2048) { const int i = r >> 10; r &= 1023; s.W = ka_in(25) + (size_t)i * 2048 * 2048; s.g = ka_in(3) + i * 2048; s.WT = (bf16*)(ws + WS_W_Q + i * 8 * MiB); }
    else if ((r -= 2048) < 4096) { const int i = r >> 11; r &= 2047; s.W = ka_in(26) + (size_t)i * 2048 * 4096; s.g = ka_in(4) + i * 2048; s.WT = (bf16*)(ws + WS_W_KV + i * 16 * MiB); s.N = 4096; }
    else if ((r -= 4096) < 2048) { const int i = r >> 10; r &= 1023; s.W = ka_in(27) + (size_t)i * 2048 * 2048; s.WT = (bf16*)(ws + WS_W_O + i * 8 * MiB); }
    else if ((r -= 2048) < 8192) { const int i = r >> 12; r &= 4095; s.W = ka_in(28) + (size_t)i * 2048 * 8192; s.g = ka_in(5) + i * 2048; s.WT = (bf16*)(ws + WS_W_UP + i * 32 * MiB); s.N = 8192; }
    else { r -= 8192; const int i = r >> 12; r &= 4095; s.W = ka_in(29) + (size_t)i * 8192 * 2048; s.WT = (bf16*)(ws + WS_W_DN + i * 32 * MiB); s.K = 8192; }
    s.item = r; return s;
}
#if defined(CONV_WIDE)
__device__ __forceinline__ void conv_load(const ConvSel& s, f32x4 (&v)[16], int lane) {
    const int nblk = s.N >> 7, kb = s.item / nblk, nb = s.item - kb * nblk, k0 = 32 * kb, n0 = 128 * nb;
#pragma unroll
    for (int i = 0; i < 16; ++i) { const int kk = 2 * i + (lane >> 5); v[i] = *(const f32x4*)(s.W + (size_t)(k0 + kk) * s.N + n0 + 4 * (lane & 31)); }
}
__device__ __forceinline__ void conv_finish(const ConvSel& s, const f32x4 (&v)[16], LAS float* scr, int lane) {
    const int nblk = s.N >> 7, kb = s.item / nblk, nb = s.item - kb * nblk, k0 = 32 * kb, n0 = 128 * nb;
#pragma unroll
    for (int i = 0; i < 16; ++i) { const int kk = 2 * i + (lane >> 5); const float sc = s.g ? s.g[k0 + kk] : 1.0f; LAS float* d = scr + kk * 129 + 4 * (lane & 31);
        d[0] = v[i][0] * sc; d[1] = v[i][1] * sc; d[2] = v[i][2] * sc; d[3] = v[i][3] * sc; }
    LDS_WAIT();
    const int c = lane & 3;
#pragma unroll
    for (int j = 0; j < 8; ++j) { const int n = (lane >> 2) + 16 * j; const LAS float* sp = scr + (8 * c) * 129 + n;
        v4u o; o.x = pk2(sp[0 * 129], sp[1 * 129]); o.y = pk2(sp[2 * 129], sp[3 * 129]); o.z = pk2(sp[4 * 129], sp[5 * 129]); o.w = pk2(sp[6 * 129], sp[7 * 129]);
        const int nr = s.mode ? glu_rowmap(n0 + n) : (n0 + n);
        *(v4u*)(s.WT + (size_t)nr * s.K + k0 + 8 * c) = o; }
    LDS_WAIT();
}
#elif defined(CONV_TALL)
__device__ __forceinline__ void conv_load(const ConvSel& s, f32x4 (&v)[16], int lane) {
    const int nblk = s.N >> 5, kb = s.item / nblk, nb = s.item - kb * nblk, k0 = 128 * kb, n0 = 32 * nb;
#pragma unroll
    for (int i = 0; i < 16; ++i) { const int kk = 8 * i + (lane >> 3); v[i] = *(const f32x4*)(s.W + (size_t)(k0 + kk) * s.N + n0 + 4 * (lane & 7)); }
}
__device__ __forceinline__ void conv_finish(const ConvSel& s, const f32x4 (&v)[16], LAS float* scr, int lane) {
    const int nblk = s.N >> 5, kb = s.item / nblk, nb = s.item - kb * nblk, k0 = 128 * kb, n0 = 32 * nb;
#pragma unroll
    for (int i = 0; i < 16; ++i) { const int kk = 8 * i + (lane >> 3); const float sc = s.g ? s.g[k0 + kk] : 1.0f; LAS float* d = scr + kk * 33 + 4 * (lane & 7);
        d[0] = v[i][0] * sc; d[1] = v[i][1] * sc; d[2] = v[i][2] * sc; d[3] = v[i][3] * sc; }
    LDS_WAIT();
    const int c = lane & 15;
#pragma unroll
    for (int j = 0; j < 8; ++j) { const int n = (lane >> 4) + 4 * j; const LAS float* sp = scr + (8 * c) * 33 + n;
        v4u o; o.x = pk2(sp[0 * 33], sp[1 * 33]); o.y = pk2(sp[2 * 33], sp[3 * 33]); o.z = pk2(sp[4 * 33], sp[5 * 33]); o.w = pk2(sp[6 * 33], sp[7 * 33]);
        const int nr = s.mode ? glu_rowmap(n0 + n) : (n0 + n);
        *(v4u*)(s.WT + (size_t)nr * s.K + k0 + 8 * c) = o; }
    LDS_WAIT();
}
#else
__device__ __forceinline__ void conv_load(const ConvSel& s, f32x4 (&v)[16], int lane) {
#if defined(CONV_KMAJOR)
    const int kblk = s.K >> 6, nb = s.item / kblk, kb = s.item - nb * kblk, k0 = 64 * kb, n0 = 64 * nb;
#else
    const int nblk = s.N >> 6, kb = s.item / nblk, nb = s.item - kb * nblk, k0 = 64 * kb, n0 = 64 * nb;
#endif
#pragma unroll
#if !defined(CONV_NO_NT)
    for (int i = 0; i < 16; ++i) { const int kk = 4 * i + (lane >> 4); v[i] = __builtin_nontemporal_load((const f32x4*)(s.W + (size_t)(k0 + kk) * s.N + n0 + 4 * (lane & 15))); }
#else
    for (int i = 0; i < 16; ++i) { const int kk = 4 * i + (lane >> 4); v[i] = *(const f32x4*)(s.W + (size_t)(k0 + kk) * s.N + n0 + 4 * (lane & 15)); }
#endif
}
__device__ __forceinline__ void conv_finish(const ConvSel& s, const f32x4 (&v)[16], LAS float* scr, int lane) {
#if defined(CONV_KMAJOR)
    const int kblk = s.K >> 6, nb = s.item / kblk, kb = s.item - nb * kblk, k0 = 64 * kb, n0 = 64 * nb;
#else
    const int nblk = s.N >> 6, kb = s.item / nblk, nb = s.item - kb * nblk, k0 = 64 * kb, n0 = 64 * nb;
#endif
#pragma unroll
    for (int i = 0; i < 16; ++i) { const int kk = 4 * i + (lane >> 4); const float sc = s.g ? s.g[k0 + kk] : 1.0f; LAS float* d = scr + kk * 65 + 4 * (lane & 15);
        d[0] = v[i][0] * sc; d[1] = v[i][1] * sc; d[2] = v[i][2] * sc; d[3] = v[i][3] * sc; }
    LDS_WAIT();
    const int c = lane & 7;
#pragma unroll
    for (int j = 0; j < 8; ++j) { const int n = (lane >> 3) + 8 * j; const LAS float* sp = scr + (8 * c) * 65 + n;
        v4u o; o.x = pk2(sp[0 * 65], sp[1 * 65]); o.y = pk2(sp[2 * 65], sp[3 * 65]); o.z = pk2(sp[4 * 65], sp[5 * 65]); o.w = pk2(sp[6 * 65], sp[7 * 65]);
        const int nr = s.mode ? glu_rowmap(n0 + n) : (n0 + n);
#if defined(CONV_NT_ST)
        __builtin_nontemporal_store(o, (v4u*)(s.WT + (size_t)nr * s.K + k0 + 8 * c)); }
#else
        *(v4u*)(s.WT + (size_t)nr * s.K + k0 + 8 * c) = o; }
#endif
    LDS_WAIT();
}
#endif
template <int PART> __device__ __forceinline__ int conv_index(int j) {
#if !defined(BG_CONV)
    if (PART == 0) return 8192 + j;
    if (PART == 1) return j < 8192 ? j : j + 4096;
#endif
    if (PART == 0) return j < 4096 ? 8192 + j : j - 4096;
    if (PART == 1) return j < 1024 ? 2048 + j : (j < 2048 ? 6144 + (j - 1024) : (j < 3072 ? 12288 + (j - 2048) : 14336 + (j - 3072)));
    return j < 4096 ? 22528 + j : (j < 5120 ? 3072 + (j - 4096) : (j < 6144 ? 7168 + (j - 5120) : (j < 8192 ? 4096 + (j - 6144) : (j < 9216 ? 13312 + (j - 8192) : (j < 13312 ? 18432 + (j - 9216) : 26624 + (j - 13312))))));
}
template <int PART> __device__ __forceinline__ void conv_run(unsigned char* ws, LAS float* scr, int first, int step, int limit, int lane) {
    if (first >= limit) return;
    f32x4 va[16], vb[16];
    ConvSel sa = conv_select(ws, conv_index<PART>(__builtin_amdgcn_readfirstlane(first))), sb = sa;
    conv_load(sa, va, lane);
    for (int j = first; j < limit; j += 2 * step) {
        const bool hb = (j + step) < limit;
        if (hb) { sb = conv_select(ws, conv_index<PART>(__builtin_amdgcn_readfirstlane(j + step))); conv_load(sb, vb, lane); }
        conv_finish(sa, va, scr, lane);
        if (!hb) break;
        const bool ha = (j + 2 * step) < limit;
        if (ha) { sa = conv_select(ws, conv_index<PART>(__builtin_amdgcn_readfirstlane(j + 2 * step))); conv_load(sa, va, lane); }
        conv_finish(sb, vb, scr, lane);
    }
}
__device__ __forceinline__ void row_to_bf16(const float* xrow, bf16* orow, float* ssqrow, int lane) {
    f32x4 v[8]; float s = 0.f;
#pragma unroll
    for (int j = 0; j < 8; ++j) { v[j] = __builtin_nontemporal_load(((const f32x4*)xrow) + lane + 64 * j); s += (v[j][0] * v[j][0] + v[j][1] * v[j][1]) + (v[j][2] * v[j][2] + v[j][3] * v[j][3]); }
    s = wave_sum(s);
#pragma unroll
    for (int j = 0; j < 8; ++j) { v2u w; w.x = pk2(v[j][0], v[j][1]); w.y = pk2(v[j][2], v[j][3]); ((v2u*)orow)[lane + 64 * j] = w; }
    if (lane < 32) ssqrow[lane] = (lane == 0) ? s : 0.f;
}
__device__ __forceinline__ void p0_prologue(unsigned char* ws, LAS unsigned char* lds, int wave, int lane) {
    LAS float* scr = (LAS float*)(lds + wave * 16896);
    const int gw = blockIdx.x * NWAVES + wave, NGW = gridDim.x * NWAVES;
#if defined(BG_CONV)
    conv_run<0>(ws, scr, gw, NGW, 6144, lane);
#else
    conv_run<0>(ws, scr, gw, NGW, 4096, lane);
#endif
    for (int m = gw; m < M + MROWS; m += NGW) {
        if (m < M) row_to_bf16(ka_in(0) + (size_t)m * D, (bf16*)(ws + WS_XB) + (size_t)m * D, (float*)(ws + WS_SSQ) + (size_t)m * 64, lane);
        else { const int r = m - M; row_to_bf16(ka_in(1) + (size_t)r * D, (bf16*)(ws + WS_MEMB) + (size_t)r * D, (float*)(ws + WS_SSQM) + (size_t)r * 64, lane); }
    }
}
__device__ __forceinline__ void p1_convert(unsigned char* ws, LAS unsigned char* lds, int wave, int lane) {
    LAS float* scr = (LAS float*)(lds + wave * 16896);
    const int bx = blockIdx.x, G = gridDim.x;
#if defined(BG_CONV)
    if (G <= 64) { conv_run<1>(ws, scr, bx * NWAVES + wave, G * NWAVES, 7168, lane); return; }
    if (bx >= 64) conv_run<1>(ws, scr, (bx - 64) * NWAVES + wave, (G - 64) * NWAVES, 7168, lane);
#else
    constexpr int CONV_REST = 26624, CONV_SPLIT = 22272;
    if (G <= 64) { conv_run<1>(ws, scr, bx * NWAVES + wave, G * NWAVES, CONV_REST, lane); return; }
    if (bx >= 64) conv_run<1>(ws, scr, (bx - 64) * NWAVES + wave, (G - 64) * NWAVES, CONV_SPLIT, lane);
    else conv_run<1>(ws, scr, CONV_SPLIT + bx * NWAVES + wave, 64 * NWAVES, CONV_REST, lane);
#endif
}
template <int PH> __device__ __forceinline__ void bg_convert(unsigned char* ws, LAS unsigned char* lds, int wave, int lane) {
    constexpr int j0 = (PH == 2) ? 0 : (PH == 4) ? 2048 : (PH == 5) ? 4096 : (PH == 7) ? 6144 : (PH == 8) ? 8192 : (PH == 9) ? 12288 : (PH == 10) ? 16384 : -1;
    constexpr int j1 = (PH == 8) ? 12288 : (PH == 9) ? 16384 : (PH == 10) ? 17408 : j0 + 2048;
#if defined(BG_CONV)
    if constexpr (j0 >= 0) { LAS float* scr = (LAS float*)(lds + wave * 16896); const int gw = blockIdx.x * NWAVES + wave, NGW = gridDim.x * NWAVES;
        conv_run<2>(ws, scr, j0 + gw, NGW, j1, lane); }
#endif
}
__device__ __forceinline__ void final_norm(const bf16* xb, const float* ssq, const float* g, float* out, int wave, int lane) {
    const int gw = blockIdx.x * NWAVES + wave, NGW = gridDim.x * NWAVES;
    for (int m = gw; m < M; m += NGW) {
        float s = (lane < 32) ? ssq[(size_t)m * 64 + lane] : 0.f; s = wave_sum(s);
        const float rs = 1.0f / sqrtf(s * (1.0f / D) + 1e-6f);
        const v4u* xr = (const v4u*)(xb + (size_t)m * D); f32x4* orow = (f32x4*)(out + (size_t)m * D);
#pragma unroll
        for (int j = 0; j < 4; ++j) { const v4u w = xr[lane + 64 * j]; const f32x4 g0 = ((const f32x4*)g)[2 * (lane + 64 * j)], g1 = ((const f32x4*)g)[2 * (lane + 64 * j) + 1];
            orow[2 * (lane + 64 * j)] = (f32x4){bflo(w.x) * rs * g0[0], bfhi(w.x) * rs * g0[1], bflo(w.y) * rs * g0[2], bfhi(w.y) * rs * g0[3]};
            orow[2 * (lane + 64 * j) + 1] = (f32x4){bflo(w.z) * rs * g1[0], bfhi(w.z) * rs * g1[1], bflo(w.w) * rs * g1[2], bfhi(w.w) * rs * g1[3]}; } }
}
__device__ __forceinline__ void gating_simple(LAS unsigned char* lds, const bf16* z, const float* vst, const float* ln_g, const float* ln_b, const float* w_s, const float* b_s, bf16* gbuf, int tid) {
    LAS float* vln = (LAS float*)lds;
    LAS float* Wl = (LAS float*)(lds + 65536);
    LAS float* mu = (LAS float*)(lds + 65536 + 128 * 129 * 4);
    LAS float* rsd = mu + 128;
    for (int unit = blockIdx.x; unit < 1024; unit += gridDim.x) {
        const int h = unit & 15, tok0 = (unit >> 4) * 128;
        if (tid < 128) { const float* p = vst + (size_t)(tok0 + tid) * 64; float s1 = 0.f, s2 = 0.f;
#pragma unroll 8
            for (int i = 0; i < 32; ++i) { s1 += p[2 * i]; s2 += p[2 * i + 1]; }
            const float mean = s1 * (1.0f / 2048.0f), var = s2 * (1.0f / 2048.0f) - mean * mean; mu[tid] = mean; rsd[tid] = 1.0f / sqrtf(var + 1e-6f); }
        __syncthreads();
        { const int s = tid >> 2, db = (tid & 3) * 32; const float mean = mu[s], rs = rsd[s];
            const bf16* vp = z + (size_t)(tok0 + s) * 4096 + 2048 + h * 128 + db;
#pragma unroll
            for (int q = 0; q < 4; ++q) { const v4u w = *(const v4u*)(vp + 8 * q); const float* gp = ln_g + h * 128 + db + 8 * q; const float* bp = ln_b + h * 128 + db + 8 * q; LAS float* o = vln + s * 128 + db + 8 * q;
                o[0] = (bflo(w.x) - mean) * rs * gp[0] + bp[0]; o[1] = (bfhi(w.x) - mean) * rs * gp[1] + bp[1]; o[2] = (bflo(w.y) - mean) * rs * gp[2] + bp[2]; o[3] = (bfhi(w.y) - mean) * rs * gp[3] + bp[3];
                o[4] = (bflo(w.z) - mean) * rs * gp[4] + bp[4]; o[5] = (bfhi(w.z) - mean) * rs * gp[5] + bp[5]; o[6] = (bflo(w.w) - mean) * rs * gp[6] + bp[6]; o[7] = (bfhi(w.w) - mean) * rs * gp[7] + bp[7]; }
            const float* wp = w_s + ((size_t)h * 128 + s) * 128 + db;
#pragma unroll
            for (int q = 0; q < 8; ++q) { const f32x4 w4 = *(const f32x4*)(wp + 4 * q); LAS float* o = Wl + s * 129 + db + 4 * q; o[0] = w4[0]; o[1] = w4[1]; o[2] = w4[2]; o[3] = w4[3]; } }
        __syncthreads();
        { const int t = tid >> 2, d0 = (tid & 3) * 32, tmax = t | 15; float acc[32];
#pragma unroll
            for (int j = 0; j < 32; ++j) acc[j] = 0.f;
            for (int s = 0; s <= tmax; ++s) { const float w = (s <= t) ? Wl[t * 129 + s] : 0.f; const LAS f32x4* vr = (const LAS f32x4*)(vln + s * 128 + d0);
#pragma unroll
                for (int q = 0; q < 8; ++q) { const f32x4 vv = vr[q]; acc[4 * q] += w * vv[0]; acc[4 * q + 1] += w * vv[1]; acc[4 * q + 2] += w * vv[2]; acc[4 * q + 3] += w * vv[3]; } }
            const float bs = b_s[h * 128 + t];
            const bf16* up = z + (size_t)(tok0 + t) * 4096 + h * 128 + d0; bf16* op = gbuf + (size_t)(tok0 + t) * 2048 + h * 128 + d0;
#pragma unroll
            for (int q = 0; q < 4; ++q) { const v4u w = *(const v4u*)(up + 8 * q); v4u o;
                o.x = pk2(bflo(w.x) * (acc[8 * q] + bs), bfhi(w.x) * (acc[8 * q + 1] + bs)); o.y = pk2(bflo(w.y) * (acc[8 * q + 2] + bs), bfhi(w.y) * (acc[8 * q + 3] + bs));
                o.z = pk2(bflo(w.z) * (acc[8 * q + 4] + bs), bfhi(w.z) * (acc[8 * q + 5] + bs)); o.w = pk2(bflo(w.w) * (acc[8 * q + 6] + bs), bfhi(w.w) * (acc[8 * q + 7] + bs));
                *(v4u*)(op + 8 * q) = o; } }
        __syncthreads();
    }
}
__device__ __forceinline__ void gating_mfma(LAS unsigned char* lds, const bf16* z, const float* vst, const float* ln_g, const float* ln_b, const float* w_s, const float* b_s, bf16* gbuf, int wave, int lane) {
    LAS float* MU = (LAS float*)(lds + 69632);
    const int tid = wave * 64 + lane, fr = lane & 15, fq = lane >> 4;
    const int ss = tid >> 2, db = (tid & 3) * 32;
    for (int unit = blockIdx.x; unit < 256; unit += gridDim.x) {
        const int tok0 = (unit >> 2) * 128, hg = unit & 3;
        __syncthreads();
        if (tid < 128) { const float* sp = vst + (size_t)(tok0 + tid) * 64; float s1 = 0.f, s2 = 0.f;
#pragma unroll
            for (int i = 0; i < 16; ++i) { const f32x4 a = *(const f32x4*)(sp + 4 * i); s1 += a[0] + a[2]; s2 += a[1] + a[3]; }
            const float mean = s1 * (1.0f / 2048.0f), var = s2 * (1.0f / 2048.0f) - mean * mean; MU[tid] = mean; MU[128 + tid] = 1.0f / sqrtf(var + 1e-6f); }
        v4u raw[4];
        { const bf16* vp = z + (size_t)(tok0 + ss) * 4096 + 2048 + (hg * 4) * 128 + db;
#pragma unroll
            for (int q4 = 0; q4 < 4; ++q4) raw[q4] = *(const v4u*)(vp + 8 * q4); }
        __syncthreads();
        const float mean = MU[ss], rs = MU[128 + ss];
#pragma unroll 1
        for (int hh = 0; hh < 4; ++hh) { const int h = hg * 4 + hh; LAS unsigned char* VT = lds + (hh & 1) * 34816;
            const int t = 16 * wave + fr, nks = (wave >> 1) + 1;
            f32x4 wa[4][2];
#pragma unroll
            for (int ks = 0; ks < 4; ++ks) if (ks < nks) { const float* wp = w_s + ((size_t)h * 128 + t) * 128 + 32 * ks + 8 * fq; wa[ks][0] = *(const f32x4*)wp; wa[ks][1] = *(const f32x4*)(wp + 4); }
            const float bs = b_s[h * 128 + t];
            const bf16* up = z + (size_t)(tok0 + t) * 4096 + h * 128 + 4 * fq; bf16* op = gbuf + (size_t)(tok0 + t) * 2048 + h * 128 + 4 * fq;
            v2u uwv[8];
#pragma unroll
            for (int df = 0; df < 8; ++df) uwv[df] = *(const v2u*)(up + 16 * df);
            { const float* gp = ln_g + h * 128 + db; const float* bp = ln_b + h * 128 + db; LAS unsigned char* wp = VT + db * 272 + ss * 2;
#pragma unroll
                for (int q4 = 0; q4 < 4; ++q4) { const f32x4 g0 = *(const f32x4*)(gp + 8 * q4), g1 = *(const f32x4*)(gp + 8 * q4 + 4), b0 = *(const f32x4*)(bp + 8 * q4), b1 = *(const f32x4*)(bp + 8 * q4 + 4); const v4u w = raw[q4];
                    const float v0 = (bflo(w.x) - mean) * rs * g0[0] + b0[0], v1 = (bfhi(w.x) - mean) * rs * g0[1] + b0[1], v2 = (bflo(w.y) - mean) * rs * g0[2] + b0[2], v3 = (bfhi(w.y) - mean) * rs * g0[3] + b0[3];
                    const float v4 = (bflo(w.z) - mean) * rs * g1[0] + b1[0], v5 = (bfhi(w.z) - mean) * rs * g1[1] + b1[1], v6 = (bflo(w.w) - mean) * rs * g1[2] + b1[2], v7 = (bfhi(w.w) - mean) * rs * g1[3] + b1[3];
                    LAS unsigned char* o = wp + (8 * q4) * 272;
                    *(LAS bf16*)(o + 0 * 272) = (bf16)f2bf(v0); *(LAS bf16*)(o + 1 * 272) = (bf16)f2bf(v1); *(LAS bf16*)(o + 2 * 272) = (bf16)f2bf(v2); *(LAS bf16*)(o + 3 * 272) = (bf16)f2bf(v3);
                    *(LAS bf16*)(o + 4 * 272) = (bf16)f2bf(v4); *(LAS bf16*)(o + 5 * 272) = (bf16)f2bf(v5); *(LAS bf16*)(o + 6 * 272) = (bf16)f2bf(v6); *(LAS bf16*)(o + 7 * 272) = (bf16)f2bf(v7); } }
            if (hh < 3) { const bf16* vp = z + (size_t)(tok0 + ss) * 4096 + 2048 + (h + 1) * 128 + db;
#pragma unroll
                for (int q4 = 0; q4 < 4; ++q4) raw[q4] = *(const v4u*)(vp + 8 * q4); }
            __syncthreads();
            bf16x8 wf[4];
#pragma unroll
            for (int ks = 0; ks < 4; ++ks) { wf[ks] = (bf16x8){0, 0, 0, 0, 0, 0, 0, 0};
                if (ks < nks) { const f32x4 a = wa[ks][0], c = wa[ks][1]; const int s0 = 32 * ks + 8 * fq;
                    float v[8] = {a[0], a[1], a[2], a[3], c[0], c[1], c[2], c[3]};
#pragma unroll
                    for (int j = 0; j < 8; ++j) v[j] = (s0 + j <= t) ? v[j] : 0.f;
                    v4u w; w.x = pk2(v[0], v[1]); w.y = pk2(v[2], v[3]); w.z = pk2(v[4], v[5]); w.w = pk2(v[6], v[7]); wf[ks] = __builtin_bit_cast(bf16x8, w); } }
            const LAS unsigned char* ab = VT + fr * 272 + fq * 16;
#pragma unroll
            for (int df = 0; df < 8; ++df) { f32x4 acc = (f32x4){0.f, 0.f, 0.f, 0.f};
#pragma unroll
                for (int ks = 0; ks < 4; ++ks) if (ks < nks) { const bf16x8 a = *(const LAS bf16x8*)(ab + df * 16 * 272 + ks * 64); acc = __builtin_amdgcn_mfma_f32_16x16x32_bf16(a, wf[ks], acc, 0, 0, 0); }
                const v2u uw = uwv[df]; v2u ow;
                ow.x = pg8::cvt_pk_bf16(bflo(uw.x) * (acc[0] + bs), bfhi(uw.x) * (acc[1] + bs)); ow.y = pg8::cvt_pk_bf16(bflo(uw.y) * (acc[2] + bs), bfhi(uw.y) * (acc[3] + bs));
                pg8::st_wt8(op + 16 * df, ow); }
        }
    }
    __syncthreads();
}
__device__ __forceinline__ void attn_simple(LAS unsigned char* lds, const bf16* q, const bf16* Kb, const bf16* Vb, bf16* obuf, int wave, int lane) {
    LAS float* pl = (LAS float*)(lds + wave * 1024);
    const int gw = blockIdx.x * NWAVES + wave, NGW = gridDim.x * NWAVES;
    for (int task = gw; task < BATCH * 4 * SEQ; task += NGW) {
        const int bh = task >> 12, t = task & 4095, b = bh >> 2, h = bh & 3;
        float qf[8]; { const v4u w = *(const v4u*)(q + ((size_t)(b * SEQ + t)) * 2048 + h * 512 + 8 * lane);
            qf[0] = bflo(w.x); qf[1] = bfhi(w.x); qf[2] = bflo(w.y); qf[3] = bfhi(w.y); qf[4] = bflo(w.z); qf[5] = bfhi(w.z); qf[6] = bflo(w.w); qf[7] = bfhi(w.w); }
        const bf16* kp = Kb + (size_t)bh * 256 * 512 + 8 * lane;
        float sc[4];
#pragma unroll
        for (int kk = 0; kk < 4; ++kk) { float mine = 0.f;
            for (int l2 = 0; l2 < 64; ++l2) { const v4u w = *(const v4u*)(kp + (size_t)(kk * 64 + l2) * 512);
                float dsum = qf[0] * bflo(w.x) + qf[1] * bfhi(w.x) + qf[2] * bflo(w.y) + qf[3] * bfhi(w.y) + qf[4] * bflo(w.z) + qf[5] * bfhi(w.z) + qf[6] * bflo(w.w) + qf[7] * bfhi(w.w);
                dsum = wave_sum(dsum); if (lane == l2) mine = dsum; }
            sc[kk] = mine; }
        const float mx = wave_max(fmaxf(fmaxf(sc[0], sc[1]), fmaxf(sc[2], sc[3])));
        float p[4], ps = 0.f;
#pragma unroll
        for (int kk = 0; kk < 4; ++kk) { p[kk] = exp2f(sc[kk] - mx); ps += p[kk]; pl[kk * 64 + lane] = p[kk]; }
        const float inv = 1.0f / wave_sum(ps);
        LDS_WAIT();
        float o[8];
#pragma unroll
        for (int i = 0; i < 8; ++i) o[i] = 0.f;
        const bf16* vp = Vb + (size_t)bh * 256 * 512 + 8 * lane;
        for (int key = 0; key < 256; ++key) { const float pk = pl[key]; const v4u w = *(const v4u*)(vp + (size_t)key * 512);
            o[0] += pk * bflo(w.x); o[1] += pk * bfhi(w.x); o[2] += pk * bflo(w.y); o[3] += pk * bfhi(w.y); o[4] += pk * bflo(w.z); o[5] += pk * bfhi(w.z); o[6] += pk * bflo(w.w); o[7] += pk * bfhi(w.w); }
        v4u ow; ow.x = pk2(o[0] * inv, o[1] * inv); ow.y = pk2(o[2] * inv, o[3] * inv); ow.z = pk2(o[4] * inv, o[5] * inv); ow.w = pk2(o[6] * inv, o[7] * inv);
        *(v4u*)(obuf + ((size_t)(b * SEQ + t)) * 2048 + h * 512 + 8 * lane) = ow;
        LDS_WAIT();
    }
}
__device__ __forceinline__ void attn_mfma(LAS unsigned char* lds, const bf16* q, const bf16* Kb, const bf16* VTb, bf16* obuf, int wave, int lane) {
    const int tid = wave * 64 + lane, fr = lane & 15, fq = lane >> 4;
    unsigned voffK[2], voffV[2];
#pragma unroll
    for (int i = 0; i < 2; ++i) { int R, C; pg8::stage_rc(tid * 16 + i * 8192, R, C); voffK[i] = (unsigned)(R * 512 + C) * 2u; voffV[i] = (unsigned)(R * 256 + C) * 2u; }
    const unsigned ldsw = (unsigned)wave * 1024u;
    const int aoff0 = pg8::lds_byte(fr, fq * 8);
#define AT_STAGE_K(c, buf) do { _Pragma("unroll") for (int ht = 0; ht < 4; ++ht) { const char* src = Kg + ((size_t)(128 * (ht >> 1)) * 512 + 128 * (c) + 64 * (ht & 1)) * 2; \
        _Pragma("unroll") for (int i = 0; i < 2; ++i) __builtin_amdgcn_global_load_lds((const unsigned*)(src + voffK[i]), (LAS unsigned*)(lds + (buf) * 65536 + ht * 16384 + ldsw + i * 8192), 16, 0, 0); } } while (0)
#define AT_STAGE_V(cc, buf) do { _Pragma("unroll") for (int ht = 0; ht < 4; ++ht) { const char* src = Vg + ((size_t)(128 * ht) * 256 + 64 * (cc)) * 2; \
        _Pragma("unroll") for (int i = 0; i < 2; ++i) __builtin_amdgcn_global_load_lds((const unsigned*)(src + voffV[i]), (LAS unsigned*)(lds + (buf) * 65536 + ht * 16384 + ldsw + i * 8192), 16, 0, 0); } } while (0)
#define AT_WAIT() do { asm volatile("s_waitcnt vmcnt(0)" ::: "memory"); __syncthreads(); } while (0)
    for (int unit = blockIdx.x; unit < 256; unit += gridDim.x) {
        const int bh = unit & 7, qb = unit >> 3, b = bh >> 2, h = bh & 3;
        const char* Kg = (const char*)(Kb + (size_t)bh * 256 * 512);
        const char* Vg = (const char*)(VTb + (size_t)bh * 512 * 256);
        const size_t tok = (size_t)(b * SEQ + qb * 128 + 16 * wave + fr);
        bf16x8 qf[16];
        { const bf16* qp = q + tok * 2048 + h * 512 + 8 * fq;
#pragma unroll
            for (int s = 0; s < 16; ++s) qf[s] = *(const bf16x8*)(qp + 32 * s); }
        f32x4 acc[16];
#pragma unroll
        for (int n = 0; n < 16; ++n) acc[n] = (f32x4){0.f, 0.f, 0.f, 0.f};
        STAMP2(lds, 40);
        AT_STAGE_K(0, 0);
#pragma unroll
        for (int c = 0; c < 4; ++c) {
            AT_WAIT();
            if (c < 3) AT_STAGE_K(c + 1, (c + 1) & 1); else AT_STAGE_V(0, 0);
            const LAS unsigned char* bb = lds + (c & 1) * 65536 + aoff0; asm volatile("" : "+v"(bb));
#define AT_QK_LOAD(dst, gi) do { _Pragma("unroll") for (int n8 = 0; n8 < 8; ++n8) dst[n8] = *(const LAS bf16x8*)(bb + ((((gi) & 1) * 2 + ((gi) >> 2)) * 16384) + n8 * 2048 + (((gi) >> 1) & 1) * 1024); } while (0)
#define AT_QK_MMA(src, gi) do { _Pragma("unroll") for (int n8 = 0; n8 < 8; ++n8) acc[((gi) & 1) * 8 + n8] = __builtin_amdgcn_mfma_f32_16x16x32_bf16(src[n8], qf[4 * c + 2 * ((gi) >> 2) + (((gi) >> 1) & 1)], acc[((gi) & 1) * 8 + n8], 0, 0, 0); } while (0)
            { bf16x8 a0[8], a1[8];
                AT_QK_LOAD(a0, 0);
#pragma unroll
                for (int gi = 0; gi < 8; gi += 2) { AT_QK_LOAD(a1, gi + 1); AT_QK_MMA(a0, gi); __builtin_amdgcn_sched_barrier(0);
                    if (gi + 2 < 8) AT_QK_LOAD(a0, gi + 2);
                    AT_QK_MMA(a1, gi + 1); __builtin_amdgcn_sched_barrier(0); } }
        }
        STAMP2(lds, 41);
        float mx = acc[0][0];
#pragma unroll
        for (int n = 0; n < 16; ++n) mx = fmaxf(fmaxf(mx, fmaxf(acc[n][0], acc[n][1])), fmaxf(acc[n][2], acc[n][3]));
        mx = fmaxf(mx, __shfl_xor(mx, 16)); mx = fmaxf(mx, __shfl_xor(mx, 32));
        float l = 0.f;
#pragma unroll
        for (int n = 0; n < 16; ++n)
#pragma unroll
            for (int r = 0; r < 4; ++r) { const float pv = __builtin_amdgcn_exp2f(acc[n][r] - mx); acc[n][r] = pv; l += pv; }
        l += __shfl_xor(l, 16); l += __shfl_xor(l, 32);
        const float linv = 1.0f / l;
        bf16x8 pf[8];
#pragma unroll
        for (int s = 0; s < 8; ++s) { v4u w; w.x = pg8::cvt_pk_bf16(acc[2 * s][0], acc[2 * s][1]); w.y = pg8::cvt_pk_bf16(acc[2 * s][2], acc[2 * s][3]);
            w.z = pg8::cvt_pk_bf16(acc[2 * s + 1][0], acc[2 * s + 1][1]); w.w = pg8::cvt_pk_bf16(acc[2 * s + 1][2], acc[2 * s + 1][3]); pf[s] = __builtin_bit_cast(bf16x8, w); }
        STAMP2(lds, 42);
        __builtin_amdgcn_sched_barrier(0);
        f32x4 o[32];
#pragma unroll
        for (int mm = 0; mm < 32; ++mm) o[mm] = (f32x4){0.f, 0.f, 0.f, 0.f};
#pragma unroll
        for (int cc = 0; cc < 4; ++cc) {
            AT_WAIT();
            if (cc < 3) AT_STAGE_V(cc + 1, (cc + 1) & 1);
            const LAS unsigned char* bb = lds + (cc & 1) * 65536 + aoff0; asm volatile("" : "+v"(bb));
#define AT_PV_LOAD(dst, gi) do { _Pragma("unroll") for (int m8 = 0; m8 < 8; ++m8) dst[m8] = *(const LAS bf16x8*)(bb + ((gi) & 3) * 16384 + m8 * 2048 + ((gi) >> 2) * 1024); } while (0)
#define AT_PV_MMA(src, gi) do { _Pragma("unroll") for (int m8 = 0; m8 < 8; ++m8) o[((gi) & 3) * 8 + m8] = __builtin_amdgcn_mfma_f32_16x16x32_bf16(src[m8], pf[2 * cc + ((gi) >> 2)], o[((gi) & 3) * 8 + m8], 0, 0, 0); } while (0)
            { bf16x8 a0[8], a1[8];
                AT_PV_LOAD(a0, 0);
#pragma unroll
                for (int gi = 0; gi < 8; gi += 2) { AT_PV_LOAD(a1, gi + 1); AT_PV_MMA(a0, gi); __builtin_amdgcn_sched_barrier(0);
                    if (gi + 2 < 8) AT_PV_LOAD(a0, gi + 2);
                    AT_PV_MMA(a1, gi + 1); __builtin_amdgcn_sched_barrier(0); } }
        }
        STAMP2(lds, 43);
        bf16* op = obuf + tok * 2048 + h * 512 + 4 * fq;
#pragma unroll
        for (int mm = 0; mm < 32; ++mm) { v2u w; w.x = pg8::cvt_pk_bf16(o[mm][0] * linv, o[mm][1] * linv); w.y = pg8::cvt_pk_bf16(o[mm][2] * linv, o[mm][3] * linv); pg8::st_wt8(op + 16 * mm, w); }
    }
    asm volatile("s_waitcnt vmcnt(0)" ::: "memory"); __syncthreads(); STAMP2(lds, 44);
#undef AT_STAGE_K
#undef AT_QK_LOAD
#undef AT_QK_MMA
#undef AT_PV_LOAD
#undef AT_PV_MMA
#undef AT_STAGE_V
#undef AT_WAIT
}
struct S5Lane { float lbr, lbi; float Br[16], Bi[16]; };
__device__ __forceinline__ void s5_lane_params(int g, int p, S5Lane& L) {
    const float lr = fminf(ka_in(15)[g * 64 + p], -1e-4f), li = ka_in(16)[g * 64 + p], dt = expf(ka_in(17)[g]);
    const float ar = lr * dt, th = li * dt; float sn, cs; sincosf(th, &sn, &cs); const float e = expf(ar), sh = sinf(0.5f * th);
    L.lbr = e * cs; L.lbi = e * sn;
    const float nr = expm1f(ar) * cs - 2.0f * sh * sh, ni = e * sn;
    const float den = 1.0f / (lr * lr + li * li), cr = (nr * lr + ni * li) * den, ci = (ni * lr - nr * li) * den;
#pragma unroll
    for (int c = 0; c < 16; ++c) { const float br = ka_in(18)[(size_t)(g * 64 + p) * 16 + c], bi = ka_in(19)[(size_t)(g * 64 + p) * 16 + c]; L.Br[c] = cr * br - ci * bi; L.Bi[c] = cr * bi + ci * br; }
}
__device__ __forceinline__ void s5_step(const S5Lane& L, const bf16* urow, float& xr, float& xi) {
    const v4u w0 = *(const v4u*)urow, w1 = *(const v4u*)(urow + 8);
    float u[16] = {bflo(w0.x), bfhi(w0.x), bflo(w0.y), bfhi(w0.y), bflo(w0.z), bfhi(w0.z), bflo(w0.w), bfhi(w0.w), bflo(w1.x), bfhi(w1.x), bflo(w1.y), bfhi(w1.y), bflo(w1.z), bfhi(w1.z), bflo(w1.w), bfhi(w1.w)};
    float br = 0.f, bi = 0.f;
#pragma unroll
    for (int c = 0; c < 16; ++c) { br += L.Br[c] * u[c]; bi += L.Bi[c] * u[c]; }
    const float nr = L.lbr * xr - L.lbi * xi + br, ni = L.lbr * xi + L.lbi * xr + bi; xr = nr; xi = ni;
}
__device__ __forceinline__ void s5_pass_a(const bf16* ub, f32x2* st, int wave, int lane) {
    const int gw = blockIdx.x * NWAVES + wave, NGW = gridDim.x * NWAVES;
    for (int task = gw; task < BATCH * 128 * 64; task += NGW) {
        const int seg = task & 63, g = (task >> 6) & 127, b = task >> 13;
        S5Lane L; s5_lane_params(g, lane, L);
        float xr = 0.f, xi = 0.f; const bf16* up = ub + (size_t)(b * SEQ + seg * 64) * 2048 + 16 * g;
#pragma unroll 2
        for (int s = 0; s < 64; ++s) s5_step(L, up + (size_t)s * 2048, xr, xi);
        st[(size_t)task * 64 + lane] = (f32x2){xr, xi};
    }
}
__device__ __forceinline__ void s5_pass_c(LAS unsigned char* lds, const bf16* ub, const f32x2* st, bf16* yb, int wave, int lane) {
    LAS f32x2* Cs = (LAS f32x2*)(lds + wave * 16640);
    LAS f32x2* xs = (LAS f32x2*)(lds + wave * 16640 + 8320);
    const int gw = blockIdx.x * NWAVES + wave, NGW = gridDim.x * NWAVES;
    for (int task = gw; task < BATCH * 128 * 64; task += NGW) {
        const int seg = task & 63, g = (task >> 6) & 127, b = task >> 13;
        S5Lane L; s5_lane_params(g, lane, L);
#pragma unroll
        for (int c = 0; c < 16; ++c) Cs[c * 65 + lane] = (f32x2){ka_in(20)[(size_t)(g * 16 + c) * 64 + lane], ka_in(21)[(size_t)(g * 16 + c) * 64 + lane]};
        float Ar = L.lbr, Ai = L.lbi;
#pragma unroll
        for (int i = 0; i < 6; ++i) { const float nr = Ar * Ar - Ai * Ai, ni = 2.0f * Ar * Ai; Ar = nr; Ai = ni; }
        float xr = 0.f, xi = 0.f; const f32x2* sp = st + (size_t)(task - seg) * 64 + lane;
#pragma unroll 2
        for (int n = 0; n < seg; ++n) { const f32x2 s = sp[(size_t)n * 64]; const float nr = Ar * xr - Ai * xi + s.x, ni = Ar * xi + Ai * xr + s.y; xr = nr; xi = ni; }
        const bf16* up = ub + (size_t)(b * SEQ + seg * 64) * 2048 + 16 * g; bf16* yp = yb + (size_t)(b * SEQ + seg * 64) * 2048 + 16 * g;
        const int t = lane & 15, cq = lane >> 4;
        f32x4 dsk = *(const f32x4*)(ka_in(22) + g * 16 + 4 * cq);
#pragma unroll 1
        for (int blk = 0; blk < 4; ++blk) {
#pragma unroll 2
            for (int s = 0; s < 16; ++s) { s5_step(L, up + (size_t)(blk * 16 + s) * 2048, xr, xi); xs[s * 65 + lane] = (f32x2){xr, xi}; }
            LDS_WAIT();
            float acc[4] = {0.f, 0.f, 0.f, 0.f};
#pragma unroll 4
            for (int p = 0; p < 64; ++p) { const f32x2 x = xs[t * 65 + p];
#pragma unroll
                for (int j = 0; j < 4; ++j) { const f32x2 c = Cs[(4 * cq + j) * 65 + p]; acc[j] += c.x * x.x - c.y * x.y; } }
            const v2u uw = *(const v2u*)(up + (size_t)(blk * 16 + t) * 2048 + 4 * cq);
            const float y0 = gelu_exact(acc[0] + dsk[0] * bflo(uw.x)), y1 = gelu_exact(acc[1] + dsk[1] * bfhi(uw.x)), y2 = gelu_exact(acc[2] + dsk[2] * bflo(uw.y)), y3 = gelu_exact(acc[3] + dsk[3] * bfhi(uw.y));
            v2u ow; ow.x = pk2(y0, y1); ow.y = pk2(y2, y3); *(v2u*)(yp + (size_t)(blk * 16 + t) * 2048 + 4 * cq) = ow;
            LDS_WAIT();
        }
    }
}
__device__ __forceinline__ void s5_mfma(LAS unsigned char* lds, const bf16* ub, bf16* yb, int wave, int lane) {
    LAS f32x2* PW = (LAS f32x2*)(lds);
    LAS f32x2* BB = (LAS f32x2*)(lds + 8704);
    LAS f32x2* CC = (LAS f32x2*)(lds + 16896);
    LAS bf16* KST = (LAS bf16*)(lds + 25088);
    LAS unsigned char* UI = lds + 33280;
    LAS float* SL = (LAS float*)(lds + 66048);
    LAS bf16* XP = (LAS bf16*)(lds + 99840);
    const int tid = wave * 64 + lane, fr = lane & 15, fq = lane >> 4;
#ifndef S5_LOOP_REPS
#define S5_LOOP_REPS 1
#endif
    for (int unit = blockIdx.x; unit < 256; unit += gridDim.x) {
        const int b = unit >> 7, g = unit & 127;
        const bf16* usrc = ub + (size_t)(b * SEQ) * 2048 + 16 * g + (size_t)(tid >> 1) * 2048 + 8 * (tid & 1);
        v4u upre[4];
#pragma unroll
        for (int i = 0; i < 4; ++i) upre[i] = *(const v4u*)(usrc + (size_t)(256 * i) * 2048);
        const float ldt = ka_in(17)[g];
        float plr[3], pli[3];
#pragma unroll
        for (int it = 0; it < 3; ++it) { const int idx = tid + NTHREADS * it, p = idx & 63; plr[it] = ka_in(15)[g * 64 + p]; pli[it] = ka_in(16)[g * 64 + p]; }
        float pbr[2], pbi[2], pcr[2], pci[2];
#pragma unroll
        for (int it = 0; it < 2; ++it) { const int idx = tid + NTHREADS * it; pbr[it] = ka_in(18)[(size_t)g * 1024 + idx]; pbi[it] = ka_in(19)[(size_t)g * 1024 + idx]; pcr[it] = ka_in(20)[(size_t)g * 1024 + idx]; pci[it] = ka_in(21)[(size_t)g * 1024 + idx]; }
        float qlr[2], qli[2];
#pragma unroll
        for (int it = 0; it < 2; ++it) { const int p = (tid + NTHREADS * it) >> 4; qlr[it] = ka_in(15)[g * 64 + p]; qli[it] = ka_in(16)[g * 64 + p]; }
        const f32x4 dsk = *(const f32x4*)(ka_in(22) + g * 16 + 4 * fq);
        const float dt = expf(ldt);
        __syncthreads();
#pragma unroll
        for (int it = 0; it < 3; ++it) { const int idx = tid + NTHREADS * it; if (idx < 17 * 64) { const int e = idx >> 6;
            const float lr = fminf(plr[it], -1e-4f), li = pli[it]; float sn, cs; sincosf(li * dt * (float)e, &sn, &cs); const float ex = expf(lr * dt * (float)e);
            PW[idx] = (f32x2){ex * cs, ex * sn}; } }
#pragma unroll
        for (int it = 0; it < 2; ++it) { const int idx = tid + NTHREADS * it;
            const float lr = fminf(qlr[it], -1e-4f), li = qli[it]; const float ar = lr * dt, th = li * dt; float sn, cs; sincosf(th, &sn, &cs); const float e = expf(ar), sh = sinf(0.5f * th);
            const float nr = expm1f(ar) * cs - 2.0f * sh * sh, ni = e * sn, den = 1.0f / (lr * lr + li * li), cr = (nr * lr + ni * li) * den, ci = (ni * lr - nr * li) * den;
            BB[idx] = (f32x2){cr * pbr[it] - ci * pbi[it], cr * pbi[it] + ci * pbr[it]};
            CC[idx] = (f32x2){pcr[it], pci[it]}; }
        __syncthreads();
        bf16x8 A1[8];
        { const int ri = wave >> 2, p = 16 * (wave & 3) + fr; f32x2 bb[8];
#pragma unroll
            for (int j = 0; j < 8; ++j) bb[j] = BB[p * 16 + 8 * (fq & 1) + j];
#pragma unroll
            for (int ks = 0; ks < 8; ++ks) { const int s = 2 * ks + (fq >> 1); const f32x2 pw = PW[(15 - s) * 64 + p]; float v[8];
#pragma unroll
                for (int j = 0; j < 8; ++j) v[j] = ri ? (pw.x * bb[j].y + pw.y * bb[j].x) : (pw.x * bb[j].x - pw.y * bb[j].y);
                v4u w; w.x = pk2(v[0], v[1]); w.y = pk2(v[2], v[3]); w.z = pk2(v[4], v[5]); w.w = pk2(v[6], v[7]); A1[ks] = __builtin_bit_cast(bf16x8, w); }
            __builtin_amdgcn_sched_barrier(0); }
        const int t0 = wave, t1 = 15 - wave;
        bf16x8 CM[2][4];
        { f32x4 kacc[2] = {(f32x4){0.f, 0.f, 0.f, 0.f}, (f32x4){0.f, 0.f, 0.f, 0.f}};
#pragma unroll
            for (int h = 0; h < 2; ++h) { f32x2 cc[8], pa[8], pb[8];
#pragma unroll
                for (int j = 0; j < 8; ++j) { const int p = 32 * h + 8 * fq + j; cc[j] = CC[fr * 64 + p]; pa[j] = PW[(t0 + 1) * 64 + p]; pb[j] = PW[(t1 + 1) * 64 + p]; }
                float vr[8], vi[8];
#pragma unroll
                for (int j = 0; j < 8; ++j) { vr[j] = cc[j].x * pa[j].x - cc[j].y * pa[j].y; vi[j] = -(cc[j].x * pa[j].y + cc[j].y * pa[j].x); }
                { v4u w; w.x = pk2(vr[0], vr[1]); w.y = pk2(vr[2], vr[3]); w.z = pk2(vr[4], vr[5]); w.w = pk2(vr[6], vr[7]); CM[0][h] = __builtin_bit_cast(bf16x8, w);
                  w.x = pk2(vi[0], vi[1]); w.y = pk2(vi[2], vi[3]); w.z = pk2(vi[4], vi[5]); w.w = pk2(vi[6], vi[7]); CM[0][2 + h] = __builtin_bit_cast(bf16x8, w); }
#pragma unroll
                for (int j = 0; j < 8; ++j) { vr[j] = cc[j].x * pb[j].x - cc[j].y * pb[j].y; vi[j] = -(cc[j].x * pb[j].y + cc[j].y * pb[j].x); }
                { v4u w; w.x = pk2(vr[0], vr[1]); w.y = pk2(vr[2], vr[3]); w.z = pk2(vr[4], vr[5]); w.w = pk2(vr[6], vr[7]); CM[1][h] = __builtin_bit_cast(bf16x8, w);
                  w.x = pk2(vi[0], vi[1]); w.y = pk2(vi[2], vi[3]); w.z = pk2(vi[4], vi[5]); w.w = pk2(vi[6], vi[7]); CM[1][2 + h] = __builtin_bit_cast(bf16x8, w); }
                bf16x8 ctr, cti;
                { v4u w; w.x = pk2(cc[0].x, cc[1].x); w.y = pk2(cc[2].x, cc[3].x); w.z = pk2(cc[4].x, cc[5].x); w.w = pk2(cc[6].x, cc[7].x); ctr = __builtin_bit_cast(bf16x8, w);
                  w.x = pk2(-cc[0].y, -cc[1].y); w.y = pk2(-cc[2].y, -cc[3].y); w.z = pk2(-cc[4].y, -cc[5].y); w.w = pk2(-cc[6].y, -cc[7].y); cti = __builtin_bit_cast(bf16x8, w); }
                f32x2 bq[8];
#pragma unroll
                for (int j = 0; j < 8; ++j) bq[j] = BB[(32 * h + 8 * fq + j) * 16 + fr];
#pragma unroll
                for (int si = 0; si < 2; ++si) { const int s = 2 * wave + si;
#pragma unroll
                    for (int j = 0; j < 8; ++j) { const f32x2 pw = PW[(15 - s) * 64 + 32 * h + 8 * fq + j]; vr[j] = pw.x * bq[j].x - pw.y * bq[j].y; vi[j] = pw.x * bq[j].y + pw.y * bq[j].x; }
                    v4u w; w.x = pk2(vr[0], vr[1]); w.y = pk2(vr[2], vr[3]); w.z = pk2(vr[4], vr[5]); w.w = pk2(vr[6], vr[7]);
                    kacc[si] = __builtin_amdgcn_mfma_f32_16x16x32_bf16(__builtin_bit_cast(bf16x8, w), ctr, kacc[si], 0, 0, 0);
                    w.x = pk2(vi[0], vi[1]); w.y = pk2(vi[2], vi[3]); w.z = pk2(vi[4], vi[5]); w.w = pk2(vi[6], vi[7]);
                    kacc[si] = __builtin_amdgcn_mfma_f32_16x16x32_bf16(__builtin_bit_cast(bf16x8, w), cti, kacc[si], 0, 0, 0); }
                __builtin_amdgcn_sched_barrier(0); }
#pragma unroll
            for (int si = 0; si < 2; ++si) { const int s = 2 * wave + si; v2u kw; kw.x = pk2(kacc[si][0], kacc[si][1]); kw.y = pk2(kacc[si][2], kacc[si][3]);
                *(LAS v2u*)(KST + ((15 - s) * 16 + fr) * 16 + 4 * fq) = kw; } }
#pragma unroll 1
        for (int rep = 0; rep < S5_LOOP_REPS; ++rep) {
        float Xr = 0.f, Xi = 0.f;
#pragma unroll 1
        for (int q = 0; q < 4; ++q) {
            __syncthreads();
#pragma unroll
            for (int i = 0; i < 4; ++i) { const int piece = tid + NTHREADS * i, tok = piece >> 1, half = piece & 1;
                *(LAS v4u*)(UI + ((((tok & 15) * 64 + (tok >> 4)) * 2 + half) * 16)) = upre[i]; }
            { const int qn = (q + 1) & 3;
#pragma unroll
                for (int i = 0; i < 4; ++i) upre[i] = *(const v4u*)(usrc + (size_t)(qn * 1024 + 256 * i) * 2048); }
            __syncthreads();
#pragma unroll 1
            for (int nf = 0; nf < 4; ++nf) { f32x4 acc = (f32x4){0.f, 0.f, 0.f, 0.f};
#pragma unroll
                for (int ks = 0; ks < 8; ++ks) { const bf16x8 bfr = *(const LAS bf16x8*)(UI + ((((2 * ks + (fq >> 1)) * 64 + 16 * nf + fr) * 2 + (fq & 1)) * 16));
                    acc = __builtin_amdgcn_mfma_f32_16x16x32_bf16(A1[ks], bfr, acc, 0, 0, 0); }
                *(LAS f32x4*)(SL + (16 * nf + fr) * 132 + 16 * wave + 4 * fq) = acc; }
            __syncthreads();
            if (wave == 0) { const f32x2 a16 = PW[16 * 64 + lane];
#pragma unroll 1
                for (int nb = 0; nb < 64; nb += 16) { float sr[16], si[16];
#pragma unroll
                    for (int n = 0; n < 16; ++n) { sr[n] = SL[(nb + n) * 132 + lane]; si[n] = SL[(nb + n) * 132 + 64 + lane]; }
#pragma unroll
                    for (int n = 0; n < 16; ++n) { XP[(nb + n) * 136 + lane] = (bf16)f2bf(Xr); XP[(nb + n) * 136 + 64 + lane] = (bf16)f2bf(Xi);
                        const float nr = a16.x * Xr - a16.y * Xi + sr[n], ni = a16.x * Xi + a16.y * Xr + si[n]; Xr = nr; Xi = ni; } } }
            __syncthreads();
#pragma unroll 1
            for (int nf = 0; nf < 4; ++nf) { f32x4 acc0 = (f32x4){0.f, 0.f, 0.f, 0.f}, acc1 = acc0;
#pragma unroll
                for (int ks = 0; ks < 8; ++ks) { if (2 * ks <= t1 || 2 * ks <= t0) {
                    const int s = 2 * ks + (fq >> 1);
                    const bf16x8 bfr = *(const LAS bf16x8*)(UI + (((s * 64 + 16 * nf + fr) * 2 + (fq & 1)) * 16));
                    if (2 * ks <= t0) { bf16x8 tf = (bf16x8){0, 0, 0, 0, 0, 0, 0, 0}; if (s <= t0) tf = *(const LAS bf16x8*)(KST + ((t0 - s) * 16 + fr) * 16 + 8 * (fq & 1)); acc0 = __builtin_amdgcn_mfma_f32_16x16x32_bf16(tf, bfr, acc0, 0, 0, 0); }
                    if (2 * ks <= t1) { bf16x8 tf = (bf16x8){0, 0, 0, 0, 0, 0, 0, 0}; if (s <= t1) tf = *(const LAS bf16x8*)(KST + ((t1 - s) * 16 + fr) * 16 + 8 * (fq & 1)); acc1 = __builtin_amdgcn_mfma_f32_16x16x32_bf16(tf, bfr, acc1, 0, 0, 0); } } }
#pragma unroll
                for (int ks = 0; ks < 4; ++ks) { const bf16x8 xf = *(const LAS bf16x8*)(XP + (16 * nf + fr) * 136 + 32 * ks + 8 * fq);
                    acc0 = __builtin_amdgcn_mfma_f32_16x16x32_bf16(CM[0][ks], xf, acc0, 0, 0, 0); acc1 = __builtin_amdgcn_mfma_f32_16x16x32_bf16(CM[1][ks], xf, acc1, 0, 0, 0); }
#pragma unroll
                for (int ti = 0; ti < 2; ++ti) { const int t = ti ? t1 : t0; const f32x4 a = ti ? acc1 : acc0; const int n = 16 * nf + fr;
                    const v2u uw = *(const LAS v2u*)(UI + (((t * 64 + n) * 2 + (fq >> 1)) * 16) + 8 * (fq & 1));
                    const pg8::f32x2 g0 = pg8::gelu_pk((pg8::f32x2){a[0] + dsk[0] * bflo(uw.x), a[1] + dsk[1] * bfhi(uw.x)}), g1 = pg8::gelu_pk((pg8::f32x2){a[2] + dsk[2] * bflo(uw.y), a[3] + dsk[3] * bfhi(uw.y)});
                    v2u ow; ow.x = pg8::cvt_pk_bf16(g0.x, g0.y); ow.y = pg8::cvt_pk_bf16(g1.x, g1.y);
                    pg8::st_wt8(yb + (size_t)(b * SEQ + q * 1024 + 16 * n + t) * 2048 + 16 * g + 4 * fq, ow); } }
        }
        }
    }
    __syncthreads();
}
#ifndef EN
#define EN(k) 1
#endif
template <int PH> __device__ __forceinline__ void run_phase(unsigned char* ws, float* X, LAS unsigned char* lds, int wave, int lane) {
    const int G = gridDim.x, bx = blockIdx.x;
    bf16* XB = (bf16*)(ws + WS_XB); float* SSQ = (float*)(ws + WS_SSQ);
    bf16* R0 = (bf16*)(ws + WS_R);
    constexpr int layer = (PH >= 10) ? 1 : 0;
    if constexpr (!EN(PH)) { return; }
    else if constexpr (PH == 0) p0_prologue(ws, lds, wave, lane);
    else if constexpr (PH == 1) {
        if (bx < 64) { const int i = bx >> 5;
            pg8::Gemm g{(const pg8::bf16_t*)(ws + WS_MEMB), (const pg8::bf16_t*)(ws + WS_W_KV + (size_t)i * 16 * MiB), MROWS, 4096, 2048}; pg8::StaticOrder S; S.init(MROWS, 4096, 32, bx & 31);
            pg8::EpiKV E{(pg8::bf16_t*)(ws + WS_KB + (size_t)i * 2 * MiB), (pg8::bf16_t*)(ws + WS_VB + (size_t)i * 2 * MiB), (pg8::bf16_t*)(ws + WS_VTB + (size_t)i * 2 * MiB), (const float*)(ws + WS_SSQM)};
            pg8::gemm_phase<pg8::EpiKV, pg8::StaticOrder, true, PG8_SP2V>(lds, g, S, E, wave, lane); }
        p1_convert(ws, lds, wave, lane);
    } else if constexpr (PH == 2) {
        pg8::Gemm g{XB, (const pg8::bf16_t*)(ws + WS_W_AIN), M, 4096, 2048}; pg8::StaticOrder S; S.init(M, 4096, G, bx);
        pg8::EpiAct<1, true> E{R0, 4096, ka_in(8), SSQ, 32, 1.0f, (float*)(ws + WS_VST), 8};
        {
#if defined(BG_CONV)
            const bool bgpre = (blockIdx.x & 1) != 0;
            if (bgpre) { bg_convert<PH>(ws, lds, wave, lane); __syncthreads(); }
#else
            const bool bgpre = true;
#endif
            pg8::gemm_phase<pg8::EpiAct<1, true>, pg8::StaticOrder, true, PG8_SP2V>(lds, g, S, E, wave, lane);
            if (!bgpre) bg_convert<PH>(ws, lds, wave, lane); }
    } else if constexpr (PH == 3) {
#if defined(GATING_SIMPLE)
        gating_simple(lds, R0, (const float*)(ws + WS_VST), ka_in(9), ka_in(10), ka_in(11), ka_in(12), R0 + (size_t)M * 4096, wave * 64 + lane);
#else
        gating_mfma(lds, R0, (const float*)(ws + WS_VST), ka_in(9), ka_in(10), ka_in(11), ka_in(12), R0 + (size_t)M * 4096, wave, lane);
#endif
    }
    else if constexpr (PH == 4 || PH == 7 || PH == 9 || PH == 16 || PH == 18) {
        const pg8::bf16_t* A; const pg8::bf16_t* W; int K = 2048;
        if constexpr (PH == 4) { A = R0 + (size_t)M * 4096; W = (const pg8::bf16_t*)(ws + WS_W_AOUT); }
        else if constexpr (PH == 7 || PH == 16) { A = R0 + (size_t)M * 2048; W = (const pg8::bf16_t*)(ws + WS_W_O + (size_t)layer * 8 * MiB); }
        else { A = R0; W = (const pg8::bf16_t*)(ws + WS_W_DN + (size_t)layer * 32 * MiB); K = 8192; }
        pg8::Gemm g{A, W, M, 2048, K}; pg8::StaticOrder S; S.init(M, 2048, G, bx);
        pg8::EpiRes E{XB, SSQ};
        {
#if defined(BG_CONV)
            const bool bgpre = (blockIdx.x & 1) != 0;
            if (bgpre) { bg_convert<PH>(ws, lds, wave, lane); __syncthreads(); }
#else
            const bool bgpre = true;
#endif
            pg8::gemm_phase<pg8::EpiRes, pg8::StaticOrder, true, PG8_SP2V>(lds, g, S, E, wave, lane);
            if (!bgpre) bg_convert<PH>(ws, lds, wave, lane); }
    } else if constexpr (PH == 5 || PH == 14 || PH == 10) {
        const pg8::bf16_t* W = (PH == 10) ? (const pg8::bf16_t*)(ws + WS_W_BIN) : (const pg8::bf16_t*)(ws + WS_W_Q + (size_t)layer * 8 * MiB);
        pg8::Gemm g{XB, W, M, 2048, 2048}; pg8::StaticOrder S; S.init(M, 2048, G, bx);
        pg8::EpiAct<0, false> E{R0, 2048, nullptr, SSQ, (PH == 14) ? 64 : 32, (PH == 10) ? 1.0f : 0.044194173824159216f * 1.4426950408889634f, nullptr, 0};
        {
#if defined(BG_CONV)
            const bool bgpre = (blockIdx.x & 1) != 0;
            if (bgpre) { bg_convert<PH>(ws, lds, wave, lane); __syncthreads(); }
#else
            const bool bgpre = true;
#endif
            pg8::gemm_phase<pg8::EpiAct<0, false>, pg8::StaticOrder, true, PG8_SP2V>(lds, g, S, E, wave, lane);
            if (!bgpre) bg_convert<PH>(ws, lds, wave, lane); }
    } else if constexpr (PH == 6 || PH == 15) {
#if defined(ATTN_SIMPLE)
        attn_simple(lds, R0, (const bf16*)(ws + WS_KB + (size_t)layer * 2 * MiB), (const bf16*)(ws + WS_VB + (size_t)layer * 2 * MiB), R0 + (size_t)M * 2048, wave, lane);
#else
        attn_mfma(lds, R0, (const bf16*)(ws + WS_KB + (size_t)layer * 2 * MiB), (const bf16*)(ws + WS_VTB + (size_t)layer * 2 * MiB), R0 + (size_t)M * 2048, wave, lane);
#endif
    }
    else if constexpr (PH == 8 || PH == 17) {
        pg8::Gemm g{XB, (const pg8::bf16_t*)(ws + WS_W_UP + (size_t)layer * 32 * MiB), M, FF, 2048}; pg8::StaticOrder S; S.init(M, FF, G, bx);
        pg8::EpiAct<2, false> E{R0, FF, nullptr, SSQ, 32, 1.0f, nullptr, 0};
        {
#if defined(BG_CONV)
            const bool bgpre = (blockIdx.x & 1) != 0;
            if (bgpre) { bg_convert<PH>(ws, lds, wave, lane); __syncthreads(); }
#else
            const bool bgpre = true;
#endif
            pg8::gemm_phase<pg8::EpiAct<2, false>, pg8::StaticOrder, true, PG8_SP2V>(lds, g, S, E, wave, lane);
            if (!bgpre) bg_convert<PH>(ws, lds, wave, lane); }
    } else if constexpr (PH == 11) {
#if defined(S5_SIMPLE)
        s5_pass_a(R0, (f32x2*)(ws + WS_S5ST), wave, lane);
#endif
    } else if constexpr (PH == 12) {
#if defined(S5_SIMPLE)
        s5_pass_c(lds, R0, (const f32x2*)(ws + WS_S5ST), R0 + (size_t)M * 2048, wave, lane);
#else
        s5_mfma(lds, R0, R0 + (size_t)M * 2048, wave, lane);
#endif
    }
    else if constexpr (PH == 13) {
        pg8::Gemm g{R0 + (size_t)M * 2048, (const pg8::bf16_t*)(ws + WS_W_BOUT), M, 4096, 2048}; pg8::StaticOrder S; S.init(M, 4096, G, bx);
        pg8::EpiGlu E{XB, SSQ, ka_in(24)};
        pg8::gemm_phase<pg8::EpiGlu, pg8::StaticOrder, true, PG8_SP2V>(lds, g, S, E, wave, lane);
    } else if constexpr (PH == 19) final_norm(XB, SSQ, ka_in(6), X, wave, lane);
}
__device__ __forceinline__ int lane_id() { int l; asm volatile("v_mbcnt_lo_u32_b32 %0, -1, 0\n\tv_mbcnt_hi_u32_b32 %0, -1, %0" : "=v"(l)); return l; }

#define XB_TMO      128
#define XB_XCNT(j)  (256  + 64 * (j))
#define XB_XSUB(j)  (1280 + 64 * (j))
#define XB_XGEN(j)  (2304 + 64 * (j))
#define XB_TOP      3328
#define XB_TOPGEN   3392
#define XCD_BAR_WORDS 3456
#define XB_SPIN_CAP (1u << 22)
__device__ __forceinline__ unsigned xb_ld(unsigned* p)              { return __hip_atomic_load(p, __ATOMIC_RELAXED, __HIP_MEMORY_SCOPE_AGENT); }
__device__ __forceinline__ unsigned xb_add(unsigned* p, unsigned v) { return __hip_atomic_fetch_add(p, v, __ATOMIC_RELAXED, __HIP_MEMORY_SCOPE_AGENT); }
__device__ __forceinline__ unsigned xb_xcc_id() { return (unsigned)__builtin_amdgcn_s_getreg((3 << 11) | 20) & 0xFu; }
#define XB_SPIN(cond, bar) do { unsigned _sp = 0; while (cond) { __builtin_amdgcn_s_sleep(1); \
    if ((++_sp & 255u) == 0u) { if (xb_ld(&(bar)[XB_TMO])) break; if (_sp > XB_SPIN_CAP) { atomicAdd(&(bar)[XB_TMO], 1u); break; } } } } while (0)
__device__ __forceinline__ void xcd_barrier_complete(unsigned* bar, unsigned x, unsigned& nloc, unsigned& nx) {
    const unsigned G = gridDim.x * gridDim.y * gridDim.z;
    unsigned sum, cnt, mine, sp = 0u;
    for (;;) {
        sum = 0u; cnt = 0u; mine = 0u;
#pragma unroll
        for (unsigned j = 0; j < 16; ++j) { const unsigned c = xb_ld(&bar[XB_XCNT(j)]); sum += c; cnt += (c > 0u) ? 1u : 0u; mine = (j == x) ? c : mine; }
        if (sum == G) break;
        __builtin_amdgcn_s_sleep(1);
        if ((++sp & 255u) == 0u) { if (xb_ld(&bar[XB_TMO])) break; if (sp > XB_SPIN_CAP) { atomicAdd(&bar[XB_TMO], 1u); break; } }
    }
    nloc = mine > 0u ? mine : 1u; nx = cnt > 0u ? cnt : 1u;
}
__device__ __forceinline__ void xcd_barrier(unsigned* bar, volatile LAS unsigned* st, bool is_t0) {
    asm volatile("s_waitcnt vmcnt(0)" ::: "memory");
    __syncthreads();
    if (is_t0) {
        __builtin_amdgcn_s_waitcnt(0);
        const unsigned x = xb_xcc_id();
        unsigned nloc = st[0], nx = st[1];
        if (nloc == 0u) { xcd_barrier_complete(bar, x, nloc, nx); st[0] = nloc; st[1] = nx; }
        const unsigned old = xb_add(&bar[XB_XSUB(x)], 1u);
        const unsigned gen = old / nloc;
        if (old + 1u == (gen + 1u) * nloc) {
            __builtin_amdgcn_fence(__ATOMIC_RELEASE, "agent");
            asm volatile("s_waitcnt vmcnt(0)" ::: "memory");
            const unsigned og = xb_add(&bar[XB_TOP], 1u);
            const unsigned tg = og / nx;
            if (og + 1u == (tg + 1u) * nx) xb_add(&bar[XB_TOPGEN], 1u);
            else XB_SPIN(xb_ld(&bar[XB_TOPGEN]) == tg, bar);
            __builtin_amdgcn_fence(__ATOMIC_ACQUIRE, "agent");
            xb_add(&bar[XB_XGEN(x)], 1u);
            asm volatile("s_waitcnt vmcnt(0)" ::: "memory");
        } else {
            XB_SPIN(xb_ld(&bar[XB_XGEN(x)]) == gen, bar);
            __builtin_amdgcn_fence(__ATOMIC_ACQUIRE, "agent");
            asm volatile("s_waitcnt vmcnt(0)" ::: "memory");
        }
    }
    __syncthreads();
}

__global__ void __launch_bounds__(NTHREADS, 2) trunk_fwd(Args args) {
    extern __shared__ __attribute__((aligned(16))) unsigned char lds_raw[];
    LAS unsigned char* lds = (LAS unsigned char*)lds_raw;
    const int wave = __builtin_amdgcn_readfirstlane((int)threadIdx.x >> 6);
    const int lo = args.ph_lo, hi = args.ph_hi;
    unsigned* bar = (unsigned*)args.ws + 4096;
    volatile LAS unsigned* st = (volatile LAS unsigned*)(lds + LDS_BYTES - 512);
#if MK_N_LAUNCHES == 1
    { const int l0 = lane_id(); if (wave == 0 && l0 < 2) st[l0] = 0u; __syncthreads(); if (wave == 0 && l0 == 0) (void)xb_add(&bar[XB_XCNT(xb_xcc_id())], 1u); }
#if defined(USE_CG_SYNC)
#define GRID_BAR(k) do { if ((k) == 1) cg::this_grid().sync(); else xcd_barrier(bar, st, wave == 0 && lane_id() == 0); } while (0)
#else
#define GRID_BAR(k) do { xcd_barrier(bar, st, wave == 0 && lane_id() == 0); } while (0)
#endif
#else
#define GRID_BAR(k) do { } while (0)
#endif
#ifndef DUP_PH
#define DUP_PH -1
#endif
#if defined(PROBE_GEMM)
#if PROBE_GEMM == 3
typedef pg8::StaticOrder ProbeOrder;
#else
struct ProbeOrder { int c;
    __device__ __forceinline__ void init(int, int, int, int c_) { c = c_; }
    __device__ __forceinline__ bool next(int i, pg8::Unit& u) const { if (i >= 4) return false;
#if PROBE_GEMM == 1
        u.pm = 0; u.pn = 0;
#else
        u.pm = c >> 3; u.pn = c & 7;
#endif
        return true; }
    __device__ __forceinline__ void a_ready(const pg8::Unit&) const {}
    __device__ __forceinline__ void done(const pg8::Unit&) const {} };
#endif
#endif
#if defined(STAMP_SEL)
#define STAMP(k) do { if (blockIdx.x == 0 && wave == 0 && lane_id() == 0) st[4 + (k)] = (unsigned)__builtin_amdgcn_s_memrealtime(); } while (0)
#else
#define STAMP(k) do { } while (0)
#endif
#define PHASE(k) if (lo <= (k) && (k) < hi) { if ((k) > lo) GRID_BAR(k); STAMP(k); run_phase<k>(args.ws, args.out, lds, wave, lane_id()); STAMP(50 + (k)); if ((k) == DUP_PH) { GRID_BAR(2); run_phase<k>(args.ws, args.out, lds, wave, lane_id()); } }
    PHASE(0) PHASE(1) PHASE(2) PHASE(3) PHASE(4) PHASE(5) PHASE(6) PHASE(7) PHASE(8) PHASE(9)
#if defined(PROBE_GEMM)
    { GRID_BAR(2); const int lane = lane_id(); unsigned char* ws = args.ws; bf16* R0 = (bf16*)(ws + WS_R);
      pg8::Gemm g{(bf16*)(ws + WS_XB), (const pg8::bf16_t*)(ws + WS_W_UP), M, FF, 2048}; ProbeOrder S; S.init(M, FF, gridDim.x, blockIdx.x);
      pg8::EpiAct<2, false> E{R0, FF, nullptr, (float*)(ws + WS_SSQ), 32, 1.0f, nullptr, 0};
      pg8::gemm_phase<pg8::EpiAct<2, false>, ProbeOrder, true, true>(lds, g, S, E, wave, lane); }
#endif
#if defined(EXTRA_BARS)
    for (int eb = 0; eb < EXTRA_BARS; ++eb) GRID_BAR(2);
#endif
    PHASE(10)
#if defined(S5_SIMPLE)
    PHASE(11)
#endif
    PHASE(12) PHASE(13) PHASE(14) PHASE(15) PHASE(16) PHASE(17) PHASE(18) PHASE(19)
#undef PHASE
#if defined(STAMP_SEL)
    asm volatile("s_waitcnt vmcnt(0)" ::: "memory"); __syncthreads(); STAMP(20);
    if (blockIdx.x == 0 && wave == 0 && lane_id() == 0) { unsigned d = (st[4 + STAMP_SEL_END] - st[4 + STAMP_SEL]); d = (d > 100000u ? 0u : d) * STAMP_MUL; const unsigned t0 = (unsigned)__builtin_amdgcn_s_memrealtime();
        while ((unsigned)__builtin_amdgcn_s_memrealtime() - t0 < d) __builtin_amdgcn_s_sleep(8); }
#endif
}

extern "C" void kernel_launch(void* const* d_in, const int* in_sizes, int n_in, void* d_out, int out_size, void* d_ws, size_t ws_size, hipStream_t stream) {
    static int grid = 0;
    if (grid == 0) {
        if (n_in != 30 || out_size != M * D || ws_size < WS_END) { fprintf(stderr, "kernel_launch: unexpected shapes (n_in %d out %d ws %zu)\n", n_in, out_size, ws_size); grid = -1; return; }
        int dev = 0, cus = 0, per_cu = 0;
        if (hipGetDevice(&dev) != hipSuccess || hipDeviceGetAttribute(&cus, hipDeviceAttributeMultiprocessorCount, dev) != hipSuccess) { grid = -1; return; }
        if (hipFuncSetAttribute((const void*)trunk_fwd, hipFuncAttributeMaxDynamicSharedMemorySize, LDS_BYTES) != hipSuccess) { fprintf(stderr, "kernel_launch: hipFuncSetAttribute failed\n"); grid = -1; return; }
        if (hipOccupancyMaxActiveBlocksPerMultiprocessor(&per_cu, (const void*)trunk_fwd, NTHREADS, LDS_BYTES) != hipSuccess || per_cu < 1) { fprintf(stderr, "kernel_launch: occupancy query says %d\n", per_cu); grid = -1; return; }
        grid = cus;
    }
    if (grid < 0) return;
    if (hipMemsetAsync(d_ws, 0, 65536, stream) != hipSuccess) { fprintf(stderr, "kernel_launch: memset failed\n"); return; }
    Args a{};
    for (int i = 0; i < 30; ++i) a.in[i] = (const float*)d_in[i];
    a.out = (float*)d_out; a.ws = (unsigned char*)d_ws;
#if MK_N_LAUNCHES == 1
    a.ph_lo = 0; a.ph_hi = NPH;
    void* kargs[] = {&a};
    hipError_t e = hipLaunchCooperativeKernel((const void*)trunk_fwd, dim3(grid), dim3(NTHREADS), kargs, LDS_BYTES, stream);
    if (e != hipSuccess) fprintf(stderr, "kernel_launch: cooperative launch failed: %s\n", hipGetErrorString(e));
#else
    for (int ph = 0; ph < NPH; ++ph) { a.ph_lo = ph; a.ph_hi = ph + 1; hipLaunchKernelGGL(trunk_fwd, dim3(grid), dim3(NTHREADS), LDS_BYTES, stream, a); }
#endif
}
```

```cpp
#include <hip/hip_runtime.h>
#include <hip/hip_cooperative_groups.h>
#include <cstdio>
#include <cstdint>
namespace cg = cooperative_groups;
#define MK_N_LAUNCHES 1
#define PG8_SP2V true
namespace pg8 {
#define PG8_LAS __attribute__((address_space(3)))
typedef unsigned short bf16_t;
typedef short bf16x8 __attribute__((ext_vector_type(8)));
typedef float f32x4 __attribute__((ext_vector_type(4)));
typedef unsigned u32x4 __attribute__((ext_vector_type(4)));
constexpr int BM = 256, BK = 64, HALF = 128, HTB = HALF * BK * 2  , STAGE_BYTES = 8 * HTB, NXCD = 8, WGM = 8;

__host__ __device__ __forceinline__ int lds_byte(int r, int c) { const int st = (r >> 4) * 2 + (c >> 5), rr = r & 15, cc = c & 31, ob = rr * 64 + cc * 2; return st * 1024 + (ob ^ (((ob >> 9) & 1) << 5)); }
__host__ __device__ __forceinline__ void stage_rc(int b, int& R, int& C) { const int st = b / 1024, sb = b % 1024, swz = sb ^ (((sb >> 9) & 1) << 5); R = (st >> 1) * 16 + swz / 64; C = (st & 1) * 32 + (swz % 64) / 2; }
__host__ __device__ __forceinline__ int perm32(int rho) { const int n = rho >> 4, i = rho & 15; return 8 * (i >> 2) + 4 * n + (i & 3); }

struct Unit { int pm, pn; };
struct Gemm { const bf16_t* A; const bf16_t* Bt; int M, N, K; };

struct StaticOrder {
    int nM, nN, nwg, G, c;
    __host__ __device__ void init(int M, int N, int G_, int c_) { nM = M / BM; nN = N / BM; nwg = nM * nN; G = G_; c = c_; }
    __host__ __device__ bool next(int i, Unit& u) const {
        const long L = (long)i * G + c; if (L >= nwg) return false;
        int wgid = (int)L; { const int q = nwg / NXCD, r = nwg % NXCD, xcd = wgid % NXCD, off = wgid / NXCD; wgid = (xcd < r ? xcd * (q + 1) : r * (q + 1) + (xcd - r) * q) + off; }
        const int nig = WGM * nN, gid = wgid / nig, fm = gid * WGM, gsz = (nM - fm) < WGM ? (nM - fm) : WGM;
        u.pm = fm + ((wgid % nig) % gsz); u.pn = (wgid % nig) / gsz; return true;
    }
    __device__ __forceinline__ void a_ready(const Unit&) const {}
    __device__ __forceinline__ void done(const Unit&) const {}
};

__device__ __forceinline__ unsigned cvt_pk_bf16(float lo, float hi) { unsigned r; asm volatile("v_cvt_pk_bf16_f32 %0, %1, %2" : "=v"(r) : "v"(lo), "v"(hi)); return r; }
typedef float f32x2 __attribute__((ext_vector_type(2)));
__device__ __forceinline__ f32x2 gelu_pk(f32x2 v) {
    const f32x2 av = __builtin_elementwise_abs(v), d = av * 0.2316418882f + 1.0f;
    f32x2 t; t.x = __builtin_amdgcn_rcpf(d.x); t.y = __builtin_amdgcn_rcpf(d.y);
    f32x2 q = t * 0.5307027145f + (-0.7265760135f); q = q * t + 0.7107068705f; q = q * t + (-0.142248368f); q = q * t + 0.127414796f; q = q * t;
    const f32x2 s = (v * v) * (-0.72134752044f);
    f32x2 e; e.x = __builtin_amdgcn_exp2f(s.x); e.y = __builtin_amdgcn_exp2f(s.y);
    const f32x2 m = v * (q * e), r = v - m;
    f32x2 o; o.x = v.x < 0.f ? m.x : r.x; o.y = v.y < 0.f ? m.y : r.y; return o;
}
typedef unsigned u32x2 __attribute__((ext_vector_type(2)));
#if defined(WT_STORES)
__device__ __forceinline__ void st_wt16(void* p, u32x4 v) { asm volatile("global_store_dwordx4 %0, %1, off sc1\n\ts_nop 1" :: "v"(p), "v"(v) : "memory"); }
__device__ __forceinline__ void st_wt8(void* p, u32x2 v) { asm volatile("global_store_dwordx2 %0, %1, off sc1\n\ts_nop 1" :: "v"(p), "v"(v) : "memory"); }
#else
__device__ __forceinline__ void st_wt16(void* p, u32x4 v) { *(u32x4*)p = v; }
__device__ __forceinline__ void st_wt8(void* p, u32x2 v) { *(u32x2*)p = v; }
#endif
constexpr int SSQ_STRIDE = 64;
__device__ __forceinline__ float row_rstd(const float* ssq, int np, int row, int fq) {
    const float* p = ssq + (size_t)row * SSQ_STRIDE + fq * (np >> 2);
    f32x4 a = *(const f32x4*)p, b = *(const f32x4*)(p + 4);
    float s = (a[0] + a[1]) + (a[2] + a[3]) + (b[0] + b[1]) + (b[2] + b[3]);
    if (np == 64) { f32x4 c = *(const f32x4*)(p + 8), d = *(const f32x4*)(p + 12); s += (c[0] + c[1]) + (c[2] + c[3]) + (d[0] + d[1]) + (d[2] + d[3]); }
    s += __shfl_xor(s, 16); s += __shfl_xor(s, 32);
    return __builtin_amdgcn_rsqf(s * (1.0f / 2048.0f) + 1e-6f);
}
template <int ACT, bool STATS> struct EpiAct {
    static constexpr bool PERM = true, AFTER_DRAIN = false, HAS_PRE = true;
    bf16_t* O; int ldc; const float* bias; const float* ssq; int np; float oscale; float* vst; int stat_pn0; PG8_LAS float* rsl;
    __device__ __forceinline__ void pre_issue(f32x4 (&r)[4], const Unit& u, int tid) const {
        if (tid < 256) { const float* p = ssq + (size_t)(u.pm * BM + tid) * SSQ_STRIDE;
#pragma unroll
            for (int k = 0; k < 4; ++k) r[k] = *(const f32x4*)(p + 4 * k) + *(const f32x4*)(p + 16 + 4 * k);
            if (np == 64) {
#pragma unroll
                for (int k = 0; k < 4; ++k) r[k] += *(const f32x4*)(p + 32 + 4 * k) + *(const f32x4*)(p + 48 + 4 * k); } } }
    __device__ __forceinline__ void pre_commit(const f32x4 (&r)[4], PG8_LAS unsigned char*, int tid) const {
        if (tid < 256) { const f32x4 s4 = (r[0] + r[1]) + (r[2] + r[3]); const float s = (s4[0] + s4[1]) + (s4[2] + s4[3]); rsl[tid] = __builtin_amdgcn_rsqf(s * (1.0f / 2048.0f) + 1e-6f); } }
    __device__ __forceinline__ void operator()(const f32x4 (&acc)[2][2][4][2], const Unit& u, int wr, int wc, int fr, int fq) const {
        const int row0 = u.pm * BM + wr * 64 + fr, col0 = u.pn * BM + wc * 32 + 8 * fq;
        f32x4 bv[2][2];
#pragma unroll
        for (int bj = 0; bj < 2; ++bj)
#pragma unroll
            for (int n = 0; n < 2; ++n) bv[bj][n] = bias ? *(const f32x4*)(bias + col0 + bj * HALF + 4 * n) : (f32x4){0.f, 0.f, 0.f, 0.f};
        float rsv[2][4];
#pragma unroll
        for (int ai = 0; ai < 2; ++ai) {
#pragma unroll
            for (int m = 0; m < 4; ++m) rsv[ai][m] = rsl[ai * HALF + wr * 64 + m * 16 + fr]; }
#pragma unroll
        for (int ai = 0; ai < 2; ++ai)
#pragma unroll
            for (int m = 0; m < 4; ++m) { const int row = row0 + ai * HALF + m * 16; const float rs = rsv[ai][m];
                bf16_t* rowp = O + (size_t)row * ldc + col0; float s1 = 0.f, s2 = 0.f;
#pragma unroll
                for (int bj = 0; bj < 2; ++bj) { f32x4 v0 = acc[ai][bj][m][0] * rs + bv[bj][0], v1 = acc[ai][bj][m][1] * rs + bv[bj][1];
                    if (ACT == 1) { f32x2 a = gelu_pk((f32x2){v0[0], v0[1]}), b = gelu_pk((f32x2){v0[2], v0[3]}), c = gelu_pk((f32x2){v1[0], v1[1]}), d = gelu_pk((f32x2){v1[2], v1[3]});
                        v0 = (f32x4){a.x, a.y, b.x, b.y}; v1 = (f32x4){c.x, c.y, d.x, d.y}; }
                    if (ACT == 2) {
#pragma unroll
                        for (int j = 0; j < 4; ++j) { const float a = fmaxf(v0[j], 0.f), b = fmaxf(v1[j], 0.f); v0[j] = a * a; v1[j] = b * b; } }
                    v0 = v0 * oscale; v1 = v1 * oscale;
                    if (STATS) { s1 += (v0[0] + v0[1]) + (v0[2] + v0[3]) + (v1[0] + v1[1]) + (v1[2] + v1[3]);
                        s2 += (v0[0] * v0[0] + v0[1] * v0[1]) + (v0[2] * v0[2] + v0[3] * v0[3]) + (v1[0] * v1[0] + v1[1] * v1[1]) + (v1[2] * v1[2] + v1[3] * v1[3]); }
                    u32x4 w; w.x = cvt_pk_bf16(v0[0], v0[1]); w.y = cvt_pk_bf16(v0[2], v0[3]); w.z = cvt_pk_bf16(v1[0], v1[1]); w.w = cvt_pk_bf16(v1[2], v1[3]);
                    st_wt16(rowp + bj * HALF, w); }
                if (STATS) { s1 += __shfl_xor(s1, 16); s1 += __shfl_xor(s1, 32); s2 += __shfl_xor(s2, 16); s2 += __shfl_xor(s2, 32);
                    if (u.pn >= stat_pn0 && fq == 0) *(f32x2*)(vst + (size_t)row * SSQ_STRIDE + ((u.pn - stat_pn0) * 4 + wc) * 2) = (f32x2){s1, s2}; }
            }
    }
};
struct EpiRes {
    static constexpr bool PERM = true, AFTER_DRAIN = false, HAS_PRE = false;
    bf16_t* xb; float* ssq;
    __device__ __forceinline__ void operator()(const f32x4 (&acc)[2][2][4][2], const Unit& u, int wr, int wc, int fr, int fq) const {
        const int row0 = u.pm * BM + wr * 64 + fr, col0 = u.pn * BM + wc * 32 + 8 * fq;
#pragma unroll
        for (int ai = 0; ai < 2; ++ai) {
            u32x4 pre[4][2];
#pragma unroll
            for (int m = 0; m < 4; ++m) { const size_t off = (size_t)(row0 + ai * HALF + m * 16) * 2048 + col0;
#pragma unroll
                for (int bj = 0; bj < 2; ++bj) pre[m][bj] = *(const u32x4*)(xb + off + bj * HALF); }
            asm volatile("" ::: "memory");
#pragma unroll
            for (int m = 0; m < 4; ++m) { const int row = row0 + ai * HALF + m * 16; const size_t off = (size_t)row * 2048 + col0; float ss = 0.f;
#pragma unroll
                for (int bj = 0; bj < 2; ++bj) { const u32x4 b = pre[m][bj]; const f32x4 a0 = acc[ai][bj][m][0], a1 = acc[ai][bj][m][1];
                    const float o0 = __builtin_bit_cast(float, b.x << 16) + a0[0], o1 = __builtin_bit_cast(float, b.x & 0xffff0000u) + a0[1], o2 = __builtin_bit_cast(float, b.y << 16) + a0[2], o3 = __builtin_bit_cast(float, b.y & 0xffff0000u) + a0[3];
                    const float o4 = __builtin_bit_cast(float, b.z << 16) + a1[0], o5 = __builtin_bit_cast(float, b.z & 0xffff0000u) + a1[1], o6 = __builtin_bit_cast(float, b.w << 16) + a1[2], o7 = __builtin_bit_cast(float, b.w & 0xffff0000u) + a1[3];
                    ss += (o0 * o0 + o1 * o1) + (o2 * o2 + o3 * o3) + (o4 * o4 + o5 * o5) + (o6 * o6 + o7 * o7);
                    u32x4 w; w.x = cvt_pk_bf16(o0, o1); w.y = cvt_pk_bf16(o2, o3); w.z = cvt_pk_bf16(o4, o5); w.w = cvt_pk_bf16(o6, o7); st_wt16(xb + off + bj * HALF, w); }
                ss += __shfl_xor(ss, 16); ss += __shfl_xor(ss, 32);
                if (fq == 0) ssq[(size_t)row * SSQ_STRIDE + u.pn * 4 + wc] = ss; }
            asm volatile("" ::: "memory"); }
    }
};
struct EpiGlu {
    static constexpr bool PERM = false, AFTER_DRAIN = false, HAS_PRE = false;
    bf16_t* xb; float* ssq; const float* bias;
    __device__ __forceinline__ void operator()(const f32x4 (&acc)[2][2][4][2], const Unit& u, int wr, int wc, int fr, int fq) const {
        const int row0 = u.pm * BM + wr * 64 + fr, col0 = u.pn * 128 + wc * 16 + 4 * fq;
        f32x4 bval[2], bgate[2];
#pragma unroll
        for (int bj = 0; bj < 2; ++bj) { bval[bj] = *(const f32x4*)(bias + col0 + bj * 64); bgate[bj] = *(const f32x4*)(bias + 2048 + col0 + bj * 64); }
#pragma unroll
        for (int ai = 0; ai < 2; ++ai) {
            u32x2 pre[4][2];
#pragma unroll
            for (int m = 0; m < 4; ++m) { const size_t off = (size_t)(row0 + ai * HALF + m * 16) * 2048 + col0;
#pragma unroll
                for (int bj = 0; bj < 2; ++bj) pre[m][bj] = *(const u32x2*)(xb + off + bj * 64); }
            asm volatile("" ::: "memory");
#pragma unroll
            for (int m = 0; m < 4; ++m) { const int row = row0 + ai * HALF + m * 16; const size_t off = (size_t)row * 2048 + col0; float ss = 0.f;
#pragma unroll
                for (int bj = 0; bj < 2; ++bj) { const f32x4 val = acc[ai][bj][m][0] + bval[bj], gate = acc[ai][bj][m][1] + bgate[bj]; const u32x2 pb = pre[m][bj]; f32x4 o = (f32x4){__builtin_bit_cast(float, pb.x << 16), __builtin_bit_cast(float, pb.x & 0xffff0000u), __builtin_bit_cast(float, pb.y << 16), __builtin_bit_cast(float, pb.y & 0xffff0000u)};
#pragma unroll
                    for (int j = 0; j < 4; ++j) { const float sg = __builtin_amdgcn_rcpf(1.0f + __builtin_amdgcn_exp2f(-1.4426950408889634f * gate[j])); o[j] += val[j] * sg; }
                    ss += (o[0] * o[0] + o[1] * o[1]) + (o[2] * o[2] + o[3] * o[3]);
                    u32x2 w; w.x = cvt_pk_bf16(o[0], o[1]); w.y = cvt_pk_bf16(o[2], o[3]); st_wt8(xb + off + bj * 64, w); }
                ss += __shfl_xor(ss, 16); ss += __shfl_xor(ss, 32);
                if (fq == 0) ssq[(size_t)row * SSQ_STRIDE + u.pn * 4 + wc] = ss; }
            asm volatile("" ::: "memory"); }
    }
};
__host__ __device__ __forceinline__ int vt_pos(int key) { const int s = key >> 5, w = key & 31; return 32 * s + 8 * ((w & 15) >> 2) + (w & 3) + 4 * (w >> 4); }
struct EpiKV {
    static constexpr bool PERM = true, AFTER_DRAIN = false, HAS_PRE = false;
    bf16_t* Kb; bf16_t* Vb; bf16_t* VTb; const float* ssq;
    __device__ __forceinline__ void operator()(const f32x4 (&acc)[2][2][4][2], const Unit& u, int wr, int wc, int fr, int fq) const {
        const int row0 = u.pm * BM + wr * 64 + fr, col0 = u.pn * BM + wc * 32 + 8 * fq;
#pragma unroll
        for (int ai = 0; ai < 2; ++ai)
#pragma unroll
            for (int m = 0; m < 4; ++m) { const int row = row0 + ai * HALF + m * 16; const float rs = row_rstd(ssq, 32, row, fq); const int b = row >> 8, key = row & 255;
#pragma unroll
                for (int bj = 0; bj < 2; ++bj) { const f32x4 v0 = acc[ai][bj][m][0] * rs, v1 = acc[ai][bj][m][1] * rs; const int col = col0 + bj * HALF;
                    u32x4 w; w.x = cvt_pk_bf16(v0[0], v0[1]); w.y = cvt_pk_bf16(v0[2], v0[3]); w.z = cvt_pk_bf16(v1[0], v1[1]); w.w = cvt_pk_bf16(v1[2], v1[3]);
                    if (col < 2048) { const int h = col >> 9, d = col & 511; *(u32x4*)(Kb + ((size_t)((b * 4 + h) * 256 + key)) * 512 + d) = w; }
                    else { const int c2 = col - 2048, h = c2 >> 9, d = c2 & 511; *(u32x4*)(Vb + ((size_t)((b * 4 + h) * 256 + key)) * 512 + d) = w;
                        bf16_t* vt = VTb + ((size_t)((b * 4 + h) * 512 + d)) * 256 + vt_pos(key);
                        vt[0 * 256] = (bf16_t)(w.x & 0xffffu); vt[1 * 256] = (bf16_t)(w.x >> 16); vt[2 * 256] = (bf16_t)(w.y & 0xffffu); vt[3 * 256] = (bf16_t)(w.y >> 16);
                        vt[4 * 256] = (bf16_t)(w.z & 0xffffu); vt[5 * 256] = (bf16_t)(w.z >> 16); vt[6 * 256] = (bf16_t)(w.w & 0xffffu); vt[7 * 256] = (bf16_t)(w.w >> 16); } }
            }
    }
};
template <class Epi, class Sched, bool ALIGN_EPI = false, bool SP2 = false>
__device__ __forceinline__ void gemm_phase(PG8_LAS unsigned char* lds, const Gemm g, const Sched& S, const Epi& E, const int wid  , const int lane) {
    const int tid = wid * 64 + lane, wr = wid >> 2, wc = wid & 3, fr = lane & 15, fq = lane >> 4;
    const int K = g.K, nt = K / BK;
    unsigned voffA[2], voffB[2];
#pragma unroll
    for (int i = 0; i < 2; ++i) { int R, C; stage_rc(tid * 16 + i * 8192, R, C); const int Rb = Epi::PERM ? ((R & ~31) + perm32(R & 31)) : R;
        voffA[i] = (unsigned)(R * K + C) * 2u; voffB[i] = (unsigned)(Rb * K + C) * 2u; }
    const size_t kstep = (size_t)(BK * 2);
    const size_t hstep = (size_t)HALF * K * 2;
    const size_t tstep = 2 * hstep;
    const unsigned ldsw = (unsigned)wid * 1024u;
    const int aoff = lds_byte(wr * 64 + fr, fq * 8), boff = lds_byte(wc * 32 + fr, fq * 8);
#define PG8_SA(b, h) (((b) * 2 + (h)) * HTB)
#define PG8_SB(b, h) ((4 + (b) * 2 + (h)) * HTB)
#define PG8_STAGE(bufoff, gbase, voff) do { _Pragma("unroll") for (int _i = 0; _i < 2; ++_i) \
        __builtin_amdgcn_global_load_lds((const unsigned*)((const char*)(gbase) + (voff)[_i]), (PG8_LAS unsigned*)(lds + (bufoff) + ldsw + _i * 8192), 16, 0, 0); } while (0)
#define PG8_LDA(dst, b, h) do { _Pragma("unroll") for (int m = 0; m < 4; ++m) _Pragma("unroll") for (int k = 0; k < 2; ++k) dst[m][k] = *(const PG8_LAS bf16x8*)(lds + PG8_SA(b, h) + aoff + m * 2048 + k * 1024); } while (0)
#define PG8_LDB(dst, b, h) do { _Pragma("unroll") for (int n = 0; n < 2; ++n) _Pragma("unroll") for (int k = 0; k < 2; ++k) dst[n][k] = *(const PG8_LAS bf16x8*)(lds + PG8_SB(b, h) + boff + n * 2048 + k * 1024); } while (0)
#define PG8_MMA(ai, bj, At, Bt) do { __builtin_amdgcn_s_setprio(1); _Pragma("unroll") for (int m = 0; m < 4; ++m) _Pragma("unroll") for (int n = 0; n < 2; ++n) _Pragma("unroll") for (int k = 0; k < 2; ++k) \
        acc[ai][bj][m][n] = __builtin_amdgcn_mfma_f32_16x16x32_bf16(Bt[n][k], At[m][k], acc[ai][bj][m][n], 0, 0, 0); __builtin_amdgcn_s_setprio(0); } while (0)
#define PG8_WAIT_V(n) asm volatile("s_waitcnt vmcnt(" #n ")" ::: "memory")
#define PG8_WAIT_L(n) asm volatile("s_waitcnt lgkmcnt(" #n ")" ::: "memory")
#define PG8_BAR __builtin_amdgcn_s_barrier()
#define PG8_SCHED __builtin_amdgcn_sched_barrier(0)
    Unit cur, nxt; int ui = 0;
    if (!S.next(0, cur)) return;
    f32x4 acc[2][2][4][2];
#pragma unroll
    for (int a = 0; a < 2; ++a)
#pragma unroll
        for (int b = 0; b < 2; ++b)
#pragma unroll
            for (int m = 0; m < 4; ++m)
#pragma unroll
                for (int n = 0; n < 2; ++n) acc[a][b][m][n] = (f32x4){0.f, 0.f, 0.f, 0.f};
    bf16x8 At[4][2], B0[2][2], B1[2][2];
    const char* cA = (const char*)g.A + (size_t)cur.pm * tstep; const char* cB = (const char*)g.Bt + (size_t)cur.pn * tstep;
    S.a_ready(cur);
    f32x4 prereg[4]; if constexpr (Epi::HAS_PRE) E.pre_issue(prereg, cur, tid);
    if constexpr (SP2) {
        PG8_STAGE(PG8_SB(0, 0), cB, voffB); PG8_STAGE(PG8_SB(0, 1), cB + hstep, voffB); PG8_STAGE(PG8_SA(0, 0), cA, voffA); PG8_STAGE(PG8_SA(0, 1), cA + hstep, voffA);
        if (wr == 1) PG8_BAR;
        PG8_WAIT_V(2); PG8_BAR;
        PG8_STAGE(PG8_SB(1, 0), cB + kstep, voffB); PG8_STAGE(PG8_SA(1, 0), cA + kstep, voffA); PG8_STAGE(PG8_SB(1, 1), cB + hstep + kstep, voffB);
        PG8_WAIT_V(6); PG8_BAR;
        if constexpr (Epi::HAS_PRE) E.pre_commit(prereg, lds, tid);
    } else {
        PG8_STAGE(PG8_SB(0, 0), cB, voffB); PG8_STAGE(PG8_SA(0, 0), cA, voffA); PG8_STAGE(PG8_SB(0, 1), cB + hstep, voffB); PG8_STAGE(PG8_SA(0, 1), cA + hstep, voffA);
        if (wr == 1) PG8_BAR;
        PG8_WAIT_V(4); PG8_BAR;
        PG8_STAGE(PG8_SB(1, 0), cB + kstep, voffB); PG8_STAGE(PG8_SA(1, 0), cA + kstep, voffA); PG8_STAGE(PG8_SB(1, 1), cB + hstep + kstep, voffB);
        PG8_WAIT_V(6); PG8_BAR;
    }
    for (;;) {
        const bool has_next = S.next(ui + 1, nxt);
        const char* nA = has_next ? (const char*)g.A + (size_t)nxt.pm * tstep : cA; const char* nB = has_next ? (const char*)g.Bt + (size_t)nxt.pn * tstep : cB;
        for (int t = 0; t < nt; t += 2) {
            const bool last = (t == nt - 2);
            const char* a1 = cA + (size_t)(t + 1) * kstep;
            const char* a2 = last ? nA : cA + (size_t)(t + 2) * kstep; const char* b2 = last ? nB : cB + (size_t)(t + 2) * kstep;
            const char* a3 = a2 + kstep; const char* b3 = b2 + kstep;
            if (last && has_next) S.a_ready(nxt);
            if constexpr (SP2) {
            PG8_LDB(B0, 0, 0); PG8_LDB(B1, 0, 1); PG8_SCHED; PG8_LDA(At, 0, 0); PG8_STAGE(PG8_SA(1, 1), a1 + hstep, voffA);
            PG8_WAIT_V(8); PG8_WAIT_L(0); PG8_BAR; PG8_MMA(0, 0, At, B0); PG8_MMA(0, 1, At, B1); PG8_BAR; PG8_SCHED;
            PG8_LDA(At, 0, 1); PG8_STAGE(PG8_SB(0, 0), b2, voffB); PG8_STAGE(PG8_SB(0, 1), b2 + hstep, voffB); PG8_STAGE(PG8_SA(0, 0), a2, voffA);
            PG8_WAIT_V(8); PG8_WAIT_L(0); PG8_BAR; PG8_MMA(1, 0, At, B0); PG8_MMA(1, 1, At, B1); PG8_BAR; PG8_SCHED;
            PG8_LDB(B0, 1, 0); PG8_LDB(B1, 1, 1); PG8_SCHED; PG8_LDA(At, 1, 0); PG8_STAGE(PG8_SA(0, 1), a2 + hstep, voffA);
            PG8_WAIT_V(8); PG8_WAIT_L(0); PG8_BAR; PG8_MMA(0, 0, At, B0); PG8_MMA(0, 1, At, B1); PG8_BAR; PG8_SCHED;
            PG8_LDA(At, 1, 1); PG8_STAGE(PG8_SB(1, 0), b3, voffB); PG8_STAGE(PG8_SB(1, 1), b3 + hstep, voffB); PG8_STAGE(PG8_SA(1, 0), a3, voffA);
            PG8_WAIT_V(8); PG8_WAIT_L(0); PG8_BAR; PG8_MMA(1, 0, At, B0); PG8_MMA(1, 1, At, B1); PG8_BAR; PG8_SCHED;
            } else {
            PG8_LDB(B0, 0, 0); PG8_SCHED; PG8_LDA(At, 0, 0); PG8_STAGE(PG8_SA(1, 1), a1 + hstep, voffA);
            PG8_WAIT_L(8); PG8_BAR; PG8_WAIT_L(0); PG8_MMA(0, 0, At, B0); PG8_BAR; PG8_SCHED;
            PG8_LDB(B1, 0, 1); PG8_STAGE(PG8_SB(0, 0), b2, voffB);
            PG8_BAR; PG8_WAIT_L(0); PG8_MMA(0, 1, At, B1); PG8_BAR;
            PG8_LDA(At, 0, 1); PG8_STAGE(PG8_SA(0, 0), a2, voffA);
            PG8_BAR; PG8_WAIT_L(0); PG8_MMA(1, 0, At, B0); PG8_BAR; PG8_SCHED;
            PG8_STAGE(PG8_SB(0, 1), b2 + hstep, voffB);
            PG8_WAIT_V(6); PG8_BAR; PG8_MMA(1, 1, At, B1); PG8_BAR;
            PG8_LDB(B0, 1, 0); PG8_SCHED; PG8_LDA(At, 1, 0); PG8_STAGE(PG8_SA(0, 1), a2 + hstep, voffA);
            PG8_WAIT_L(8); PG8_BAR; PG8_WAIT_L(0); PG8_MMA(0, 0, At, B0); PG8_BAR; PG8_SCHED;
            PG8_LDB(B1, 1, 1); PG8_STAGE(PG8_SB(1, 0), b3, voffB);
            PG8_BAR; PG8_WAIT_L(0); PG8_MMA(0, 1, At, B1); PG8_BAR;
            PG8_LDA(At, 1, 1); PG8_STAGE(PG8_SA(1, 0), a3, voffA);
            PG8_BAR; PG8_WAIT_L(0); PG8_MMA(1, 0, At, B0); PG8_BAR; PG8_SCHED;
            PG8_STAGE(PG8_SB(1, 1), b3 + hstep, voffB);
            PG8_WAIT_V(6); PG8_BAR; PG8_MMA(1, 1, At, B1); PG8_BAR;
            }
        }
        if constexpr (ALIGN_EPI) { if (wr == 0) PG8_BAR; }
        if constexpr (!Epi::AFTER_DRAIN) { Unit ue = cur; asm volatile("" : "+s"(ue.pm), "+s"(ue.pn));
            int fre = fr, fqe = fq; asm volatile("" : "+v"(fre), "+v"(fqe)); E(acc, ue, wr, wc, fre, fqe); S.done(cur); }
        if (!has_next) break;
#pragma unroll
        for (int a = 0; a < 2; ++a)
#pragma unroll
            for (int b = 0; b < 2; ++b)
#pragma unroll
                for (int m = 0; m < 4; ++m)
#pragma unroll
                    for (int n = 0; n < 2; ++n) acc[a][b][m][n] = (f32x4){0.f, 0.f, 0.f, 0.f};
        cur = nxt; cA = nA; cB = nB; ++ui;
        if constexpr (ALIGN_EPI) { if (wr == 1) PG8_BAR; }
    }
    PG8_WAIT_V(0);
    if constexpr (!ALIGN_EPI) { if (wr == 0) PG8_BAR; }
    PG8_BAR;
    if constexpr (Epi::AFTER_DRAIN) { E.fused(acc, cur, wr, wc, fr, fq, lds, wid, lane); S.done(cur); }
#undef PG8_SA
#undef PG8_SB
#undef PG8_STAGE
#undef PG8_LDA
#undef PG8_LDB
#undef PG8_MMA
#undef PG8_WAIT_V
#undef PG8_WAIT_L
#undef PG8_BAR
#undef PG8_SCHED
}
}
#ifndef MK_N_LAUNCHES
#define MK_N_LAUNCHES 1
#endif
constexpr int BATCH = 2, SEQ = 4096, D = 2048, M = BATCH * SEQ, MEMLEN = 256, MROWS = BATCH * MEMLEN, FF = 8192;
constexpr int NWAVES = 8, NTHREADS = 512, NPH = 20;
constexpr int LDS_BYTES = 147456;
constexpr size_t MiB = 1u << 20;
constexpr size_t WS_W_AIN = 2 * MiB, WS_W_AOUT = 18 * MiB, WS_W_BIN = 26 * MiB, WS_W_BOUT = 34 * MiB, WS_W_Q = 50 * MiB, WS_W_KV = 66 * MiB, WS_W_O = 98 * MiB, WS_W_UP = 114 * MiB, WS_W_DN = 178 * MiB;
constexpr size_t WS_XB = 242 * MiB, WS_MEMB = 274 * MiB, WS_KB = 276 * MiB, WS_VB = 280 * MiB, WS_VTB = 284 * MiB, WS_SSQ = 288 * MiB, WS_VST = 290 * MiB, WS_SSQM = 292 * MiB, WS_S5ST = 294 * MiB;
constexpr size_t WS_R = 304 * MiB, WS_END = 432 * MiB;
#define GAS __attribute__((address_space(1)))
#define LAS __attribute__((address_space(3)))
typedef unsigned short bf16;
typedef unsigned v4u __attribute__((ext_vector_type(4)));
typedef unsigned v2u __attribute__((ext_vector_type(2)));
typedef float f32x4 __attribute__((ext_vector_type(4)));
typedef float f32x2 __attribute__((ext_vector_type(2)));
typedef short bf16x8 __attribute__((ext_vector_type(8)));
#define LDS_WAIT() asm volatile("s_waitcnt lgkmcnt(0)" ::: "memory")
#if defined(NT_ACT)
#define NTL(p) __builtin_nontemporal_load(p)
#else
#define NTL(p) (*(p))
#endif
#if defined(NT_OUT)
#define NTS(v, p) __builtin_nontemporal_store((v), (p))
#else
#define NTS(v, p) (*(p) = (v))
#endif
__device__ __forceinline__ unsigned f2bf(float f) { unsigned u = __builtin_bit_cast(unsigned, f); return (u + 0x7fffu + ((u >> 16) & 1u)) >> 16; }
__device__ __forceinline__ unsigned pk2(float lo, float hi) { return f2bf(lo) | (f2bf(hi) << 16); }
__device__ __forceinline__ float bflo(unsigned w) { return __builtin_bit_cast(float, w << 16); }
__device__ __forceinline__ float bfhi(unsigned w) { return __builtin_bit_cast(float, w & 0xffff0000u); }
__device__ __forceinline__ float wave_sum(float v) {
#pragma unroll
    for (int o = 1; o < 64; o <<= 1) v += __shfl_xor(v, o);
    return v;
}
__device__ __forceinline__ float wave_max(float v) {
#pragma unroll
    for (int o = 1; o < 64; o <<= 1) v = fmaxf(v, __shfl_xor(v, o));
    return v;
}
__device__ __forceinline__ float gelu_exact(float v) { return 0.5f * v * (1.0f + erff(v * 0.70710678118654752f)); }

struct Args { const float* in[30]; float* out; unsigned char* ws; int ph_lo, ph_hi; };
__device__ __forceinline__ const float* ka_in(int i) { const __attribute__((address_space(4))) char* ka = (const __attribute__((address_space(4))) char*)__builtin_amdgcn_kernarg_segment_ptr(); asm volatile("" : "+s"(ka)); return *(const float* const __attribute__((address_space(4)))*)(ka + 8 * i); }

#if defined(STAMP_SEL)
#define STAMP2(lds_, id) do { __syncthreads(); if (blockIdx.x == 0 && wave == 0 && lane_id2() == 0) ((volatile LAS unsigned*)((lds_) + LDS_BYTES - 512))[4 + (id)] = (unsigned)__builtin_amdgcn_s_memrealtime(); } while (0)
__device__ __forceinline__ int lane_id2() { int l; asm volatile("v_mbcnt_lo_u32_b32 %0, -1, 0\n\tv_mbcnt_hi_u32_b32 %0, -1, %0" : "=v"(l)); return l; }
#else
#define STAMP2(lds_, id) do { } while (0)
#endif
__device__ __forceinline__ int glu_rowmap(int n) { return n < 2048 ? 32 * (n >> 4) + (n & 15) : 32 * ((n - 2048) >> 4) + 16 + (n & 15); }
struct ConvSel { const float* W; const float* g; bf16* WT; int K, N, mode, item; };
__device__ __forceinline__ ConvSel conv_select(unsigned char* ws, int r) {
    ConvSel s; s.g = nullptr; s.K = 2048; s.N = 2048; s.mode = 0;
    if (r < 2048) { s.W = ka_in(7); s.g = ka_in(2); s.WT = (bf16*)(ws + WS_W_AIN); s.N = 4096; }
    else if ((r -= 2048) < 1024) { s.W = ka_in(13); s.WT = (bf16*)(ws + WS_W_AOUT); }
    else if ((r -= 1024) < 1024) { s.W = ka_in(14); s.g = ka_in(2) + 2048; s.WT = (bf16*)(ws + WS_W_BIN); }
    else if ((r -= 1024) < 2048) { s.W = ka_in(23); s.WT = (bf16*)(ws + WS_W_BOUT); s.N = 4096; s.mode = 1; }
    else if ((r -= 2048) < 2048) { const int i = r >> 10; r &= 1023; s.W = ka_in(25) + (size_t)i * 2048 * 2048; s.g = ka_in(3) + i * 2048; s.WT = (bf16*)(ws + WS_W_Q + i * 8 * MiB); }
    else if ((r -= 2048) < 4096) { const int i = r >> 11; r &= 2047; s.W = ka_in(26) + (size_t)i * 2048 * 4096; s.g = ka_in(4) + i * 2048; s.WT = (bf16*)(ws + WS_W_KV + i * 16 * MiB); s.N = 4096; }
    else if ((r -= 4096) < 2048) { const int i = r >> 10; r &= 1023; s.W = ka_in(27) + (size_t)i * 2048 * 2048; s.WT = (bf16*)(ws + WS_W_O + i * 8 * MiB); }
    else if ((r -= 2048) < 8192) { const int i = r >> 12; r &= 4095; s.W = ka_in(28) + (size_t)i * 2048 * 8192; s.g = ka_in(5) + i * 2048; s.WT = (bf16*)(ws + WS_W_UP + i * 32 * MiB); s.N = 8192; }
    else { r -= 8192; const int i = r >> 12; r &= 4095; s.W = ka_in(29) + (size_t)i * 8192 * 2048; s.WT = (bf16*)(ws + WS_W_DN + i * 32 * MiB); s.K = 8192; }
    s.item = r; return s;
}
#if defined(CONV_WIDE)
__device__ __forceinline__ void conv_load(const ConvSel& s, f32x4 (&v)[16], int lane) {
    const int nblk = s.N >> 7, kb = s.item / nblk, nb = s.item - kb * nblk, k0 = 32 * kb, n0 = 128 * nb;
#pragma unroll
    for (int i = 0; i < 16; ++i) { const int kk = 2 * i + (lane >> 5); v[i] = *(const f32x4*)(s.W + (size_t)(k0 + kk) * s.N + n0 + 4 * (lane & 31)); }
}
__device__ __forceinline__ void conv_finish(const ConvSel& s, const f32x4 (&v)[16], LAS float* scr, int lane) {
    const int nblk = s.N >> 7, kb = s.item / nblk, nb = s.item - kb * nblk, k0 = 32 * kb, n0 = 128 * nb;
#pragma unroll
    for (int i = 0; i < 16; ++i) { const int kk = 2 * i + (lane >> 5); const float sc = s.g ? s.g[k0 + kk] : 1.0f; LAS float* d = scr + kk * 129 + 4 * (lane & 31);
        d[0] = v[i][0] * sc; d[1] = v[i][1] * sc; d[2] = v[i][2] * sc; d[3] = v[i][3] * sc; }
    LDS_WAIT();
    const int c = lane & 3;
#pragma unroll
    for (int j = 0; j < 8; ++j) { const int n = (lane >> 2) + 16 * j; const LAS float* sp = scr + (8 * c) * 129 + n;
        v4u o; o.x = pk2(sp[0 * 129], sp[1 * 129]); o.y = pk2(sp[2 * 129], sp[3 * 129]); o.z = pk2(sp[4 * 129], sp[5 * 129]); o.w = pk2(sp[6 * 129], sp[7 * 129]);
        const int nr = s.mode ? glu_rowmap(n0 + n) : (n0 + n);
        *(v4u*)(s.WT + (size_t)nr * s.K + k0 + 8 * c) = o; }
    LDS_WAIT();
}
#elif defined(CONV_TALL)
__device__ __forceinline__ void conv_load(const ConvSel& s, f32x4 (&v)[16], int lane) {
    const int nblk = s.N >> 5, kb = s.item / nblk, nb = s.item - kb * nblk, k0 = 128 * kb, n0 = 32 * nb;
#pragma unroll
    for (int i = 0; i < 16; ++i) { const int kk = 8 * i + (lane >> 3); v[i] = *(const f32x4*)(s.W + (size_t)(k0 + kk) * s.N + n0 + 4 * (lane & 7)); }
}
__device__ __forceinline__ void conv_finish(const ConvSel& s, const f32x4 (&v)[16], LAS float* scr, int lane) {
    const int nblk = s.N >> 5, kb = s.item / nblk, nb = s.item - kb * nblk, k0 = 128 * kb, n0 = 32 * nb;
#pragma unroll
    for (int i = 0; i < 16; ++i) { const int kk = 8 * i + (lane >> 3); const float sc = s.g ? s.g[k0 + kk] : 1.0f; LAS float* d = scr + kk * 33 + 4 * (lane & 7);
        d[0] = v[i][0] * sc; d[1] = v[i][1] * sc; d[2] = v[i][2] * sc; d[3] = v[i][3] * sc; }
    LDS_WAIT();
    const int c = lane & 15;
#pragma unroll
    for (int j = 0; j < 8; ++j) { const int n = (lane >> 4) + 4 * j; const LAS float* sp = scr + (8 * c) * 33 + n;
        v4u o; o.x = pk2(sp[0 * 33], sp[1 * 33]); o.y = pk2(sp[2 * 33], sp[3 * 33]); o.z = pk2(sp[4 * 33], sp[5 * 33]); o.w = pk2(sp[6 * 33], sp[7 * 33]);
        const int nr = s.mode ? glu_rowmap(n0 + n) : (n0 + n);
        *(v4u*)(s.WT + (size_t)nr * s.K + k0 + 8 * c) = o; }
    LDS_WAIT();
}
#else
__device__ __forceinline__ void conv_load(const ConvSel& s, f32x4 (&v)[16], int lane) {
#if defined(CONV_KMAJOR)
    const int kblk = s.K >> 6, nb = s.item / kblk, kb = s.item - nb * kblk, k0 = 64 * kb, n0 = 64 * nb;
#else
    const int nblk = s.N >> 6, kb = s.item / nblk, nb = s.item - kb * nblk, k0 = 64 * kb, n0 = 64 * nb;
#endif
#pragma unroll
#if !defined(CONV_NO_NT)
    for (int i = 0; i < 16; ++i) { const int kk = 4 * i + (lane >> 4); v[i] = __builtin_nontemporal_load((const f32x4*)(s.W + (size_t)(k0 + kk) * s.N + n0 + 4 * (lane & 15))); }
#else
    for (int i = 0; i < 16; ++i) { const int kk = 4 * i + (lane >> 4); v[i] = *(const f32x4*)(s.W + (size_t)(k0 + kk) * s.N + n0 + 4 * (lane & 15)); }
#endif
}
__device__ __forceinline__ void conv_finish(const ConvSel& s, const f32x4 (&v)[16], LAS float* scr, int lane) {
#if defined(CONV_KMAJOR)
    const int kblk = s.K >> 6, nb = s.item / kblk, kb = s.item - nb * kblk, k0 = 64 * kb, n0 = 64 * nb;
#else
    const int nblk = s.N >> 6, kb = s.item / nblk, nb = s.item - kb * nblk, k0 = 64 * kb, n0 = 64 * nb;
#endif
#pragma unroll
    for (int i = 0; i < 16; ++i) { const int kk = 4 * i + (lane >> 4); const float sc = s.g ? s.g[k0 + kk] : 1.0f; LAS float* d = scr + kk * 65 + 4 * (lane & 15);
        d[0] = v[i][0] * sc; d[1] = v[i][1] * sc; d[2] = v[i][2] * sc; d[3] = v[i][3] * sc; }
    LDS_WAIT();
    const int c = lane & 7;
#pragma unroll
    for (int j = 0; j < 8; ++j) { const int n = (lane >> 3) + 8 * j; const LAS float* sp = scr + (8 * c) * 65 + n;
        v4u o; o.x = pk2(sp[0 * 65], sp[1 * 65]); o.y = pk2(sp[2 * 65], sp[3 * 65]); o.z = pk2(sp[4 * 65], sp[5 * 65]); o.w = pk2(sp[6 * 65], sp[7 * 65]);
        const int nr = s.mode ? glu_rowmap(n0 + n) : (n0 + n);
#if defined(CONV_NT_ST)
        __builtin_nontemporal_store(o, (v4u*)(s.WT + (size_t)nr * s.K + k0 + 8 * c)); }
#else
        *(v4u*)(s.WT + (size_t)nr * s.K + k0 + 8 * c) = o; }
#endif
    LDS_WAIT();
}
#endif
template <int PART> __device__ __forceinline__ int conv_index(int j) {
#if !defined(BG_CONV)
    if (PART == 0) return 8192 + j;
    if (PART == 1) return j < 8192 ? j : j + 4096;
#endif
    if (PART == 0) return j < 4096 ? 8192 + j : j - 4096;
    if (PART == 1) return j < 1024 ? 2048 + j : (j < 2048 ? 6144 + (j - 1024) : (j < 3072 ? 12288 + (j - 2048) : 14336 + (j - 3072)));
    return j < 4096 ? 22528 + j : (j < 5120 ? 3072 + (j - 4096) : (j < 6144 ? 7168 + (j - 5120) : (j < 8192 ? 4096 + (j - 6144) : (j < 9216 ? 13312 + (j - 8192) : (j < 13312 ? 18432 + (j - 9216) : 26624 + (j - 13312))))));
}
template <int PART> __device__ __forceinline__ void conv_run(unsigned char* ws, LAS float* scr, int first, int step, int limit, int lane) {
    if (first >= limit) return;
    f32x4 va[16], vb[16];
    ConvSel sa = conv_select(ws, conv_index<PART>(__builtin_amdgcn_readfirstlane(first))), sb = sa;
    conv_load(sa, va, lane);
    for (int j = first; j < limit; j += 2 * step) {
        const bool hb = (j + step) < limit;
        if (hb) { sb = conv_select(ws, conv_index<PART>(__builtin_amdgcn_readfirstlane(j + step))); conv_load(sb, vb, lane); }
        conv_finish(sa, va, scr, lane);
        if (!hb) break;
        const bool ha = (j + 2 * step) < limit;
        if (ha) { sa = conv_select(ws, conv_index<PART>(__builtin_amdgcn_readfirstlane(j + 2 * step))); conv_load(sa, va, lane); }
        conv_finish(sb, vb, scr, lane);
    }
}
__device__ __forceinline__ void row_to_bf16(const float* xrow, bf16* orow, float* ssqrow, int lane) {
    f32x4 v[8]; float s = 0.f;
#pragma unroll
    for (int j = 0; j < 8; ++j) { v[j] = __builtin_nontemporal_load(((const f32x4*)xrow) + lane + 64 * j); s += (v[j][0] * v[j][0] + v[j][1] * v[j][1]) + (v[j][2] * v[j][2] + v[j][3] * v[j][3]); }
    s = wave_sum(s);
#pragma unroll
    for (int j = 0; j < 8; ++j) { v2u w; w.x = pk2(v[j][0], v[j][1]); w.y = pk2(v[j][2], v[j][3]); ((v2u*)orow)[lane + 64 * j] = w; }
    if (lane < 32) ssqrow[lane] = (lane == 0) ? s : 0.f;
}
__device__ __forceinline__ void p0_prologue(unsigned char* ws, LAS unsigned char* lds, int wave, int lane) {
    LAS float* scr = (LAS float*)(lds + wave * 16896);
    const int gw = blockIdx.x * NWAVES + wave, NGW = gridDim.x * NWAVES;
#if defined(BG_CONV)
    conv_run<0>(ws, scr, gw, NGW, 6144, lane);
#else
    conv_run<0>(ws, scr, gw, NGW, 4096, lane);
#endif
    for (int m = gw; m < M + MROWS; m += NGW) {
        if (m < M) row_to_bf16(ka_in(0) + (size_t)m * D, (bf16*)(ws + WS_XB) + (size_t)m * D, (float*)(ws + WS_SSQ) + (size_t)m * 64, lane);
        else { const int r = m - M; row_to_bf16(ka_in(1) + (size_t)r * D, (bf16*)(ws + WS_MEMB) + (size_t)r * D, (float*)(ws + WS_SSQM) + (size_t)r * 64, lane); }
    }
}
__device__ __forceinline__ void p1_convert(unsigned char* ws, LAS unsigned char* lds, int wave, int lane) {
    LAS float* scr = (LAS float*)(lds + wave * 16896);
    const int bx = blockIdx.x, G = gridDim.x;
#if defined(BG_CONV)
    if (G <= 64) { conv_run<1>(ws, scr, bx * NWAVES + wave, G * NWAVES, 7168, lane); return; }
    if (bx >= 64) conv_run<1>(ws, scr, (bx - 64) * NWAVES + wave, (G - 64) * NWAVES, 7168, lane);
#else
    constexpr int CONV_REST = 26624, CONV_SPLIT = 22272;
    if (G <= 64) { conv_run<1>(ws, scr, bx * NWAVES + wave, G * NWAVES, CONV_REST, lane); return; }
    if (bx >= 64) conv_run<1>(ws, scr, (bx - 64) * NWAVES + wave, (G - 64) * NWAVES, CONV_SPLIT, lane);
    else conv_run<1>(ws, scr, CONV_SPLIT + bx * NWAVES + wave, 64 * NWAVES, CONV_REST, lane);
#endif
}
template <int PH> __device__ __forceinline__ void bg_convert(unsigned char* ws, LAS unsigned char* lds, int wave, int lane) {
    constexpr int j0 = (PH == 2) ? 0 : (PH == 4) ? 2048 : (PH == 5) ? 4096 : (PH == 7) ? 6144 : (PH == 8) ? 8192 : (PH == 9) ? 12288 : (PH == 10) ? 16384 : -1;
    constexpr int j1 = (PH == 8) ? 12288 : (PH == 9) ? 16384 : (PH == 10) ? 17408 : j0 + 2048;
#if defined(BG_CONV)
    if constexpr (j0 >= 0) { LAS float* scr = (LAS float*)(lds + wave * 16896); const int gw = blockIdx.x * NWAVES + wave, NGW = gridDim.x * NWAVES;
        conv_run<2>(ws, scr, j0 + gw, NGW, j1, lane); }
#endif
}
__device__ __forceinline__ void final_norm(const bf16* xb, const float* ssq, const float* g, float* out, int wave, int lane) {
    const int gw = blockIdx.x * NWAVES + wave, NGW = gridDim.x * NWAVES;
    for (int m = gw; m < M; m += NGW) {
        float s = (lane < 32) ? ssq[(size_t)m * 64 + lane] : 0.f; s = wave_sum(s);
        const float rs = 1.0f / sqrtf(s * (1.0f / D) + 1e-6f);
        const v4u* xr = (const v4u*)(xb + (size_t)m * D); f32x4* orow = (f32x4*)(out + (size_t)m * D);
#pragma unroll
        for (int j = 0; j < 4; ++j) { const v4u w = NTL(xr + lane + 64 * j); const f32x4 g0 = ((const f32x4*)g)[2 * (lane + 64 * j)], g1 = ((const f32x4*)g)[2 * (lane + 64 * j) + 1];
            NTS(((f32x4){bflo(w.x) * rs * g0[0], bfhi(w.x) * rs * g0[1], bflo(w.y) * rs * g0[2], bfhi(w.y) * rs * g0[3]}), orow + 2 * (lane + 64 * j));
            NTS(((f32x4){bflo(w.z) * rs * g1[0], bfhi(w.z) * rs * g1[1], bflo(w.w) * rs * g1[2], bfhi(w.w) * rs * g1[3]}), orow + 2 * (lane + 64 * j) + 1); } }
}
__device__ __forceinline__ void gating_simple(LAS unsigned char* lds, const bf16* z, const float* vst, const float* ln_g, const float* ln_b, const float* w_s, const float* b_s, bf16* gbuf, int tid) {
    LAS float* vln = (LAS float*)lds;
    LAS float* Wl = (LAS float*)(lds + 65536);
    LAS float* mu = (LAS float*)(lds + 65536 + 128 * 129 * 4);
    LAS float* rsd = mu + 128;
    for (int unit = blockIdx.x; unit < 1024; unit += gridDim.x) {
        const int h = unit & 15, tok0 = (unit >> 4) * 128;
        if (tid < 128) { const float* p = vst + (size_t)(tok0 + tid) * 64; float s1 = 0.f, s2 = 0.f;
#pragma unroll 8
            for (int i = 0; i < 32; ++i) { s1 += p[2 * i]; s2 += p[2 * i + 1]; }
            const float mean = s1 * (1.0f / 2048.0f), var = s2 * (1.0f / 2048.0f) - mean * mean; mu[tid] = mean; rsd[tid] = 1.0f / sqrtf(var + 1e-6f); }
        __syncthreads();
        { const int s = tid >> 2, db = (tid & 3) * 32; const float mean = mu[s], rs = rsd[s];
            const bf16* vp = z + (size_t)(tok0 + s) * 4096 + 2048 + h * 128 + db;
#pragma unroll
            for (int q = 0; q < 4; ++q) { const v4u w = *(const v4u*)(vp + 8 * q); const float* gp = ln_g + h * 128 + db + 8 * q; const float* bp = ln_b + h * 128 + db + 8 * q; LAS float* o = vln + s * 128 + db + 8 * q;
                o[0] = (bflo(w.x) - mean) * rs * gp[0] + bp[0]; o[1] = (bfhi(w.x) - mean) * rs * gp[1] + bp[1]; o[2] = (bflo(w.y) - mean) * rs * gp[2] + bp[2]; o[3] = (bfhi(w.y) - mean) * rs * gp[3] + bp[3];
                o[4] = (bflo(w.z) - mean) * rs * gp[4] + bp[4]; o[5] = (bfhi(w.z) - mean) * rs * gp[5] + bp[5]; o[6] = (bflo(w.w) - mean) * rs * gp[6] + bp[6]; o[7] = (bfhi(w.w) - mean) * rs * gp[7] + bp[7]; }
            const float* wp = w_s + ((size_t)h * 128 + s) * 128 + db;
#pragma unroll
            for (int q = 0; q < 8; ++q) { const f32x4 w4 = *(const f32x4*)(wp + 4 * q); LAS float* o = Wl + s * 129 + db + 4 * q; o[0] = w4[0]; o[1] = w4[1]; o[2] = w4[2]; o[3] = w4[3]; } }
        __syncthreads();
        { const int t = tid >> 2, d0 = (tid & 3) * 32, tmax = t | 15; float acc[32];
#pragma unroll
            for (int j = 0; j < 32; ++j) acc[j] = 0.f;
            for (int s = 0; s <= tmax; ++s) { const float w = (s <= t) ? Wl[t * 129 + s] : 0.f; const LAS f32x4* vr = (const LAS f32x4*)(vln + s * 128 + d0);
#pragma unroll
                for (int q = 0; q < 8; ++q) { const f32x4 vv = vr[q]; acc[4 * q] += w * vv[0]; acc[4 * q + 1] += w * vv[1]; acc[4 * q + 2] += w * vv[2]; acc[4 * q + 3] += w * vv[3]; } }
            const float bs = b_s[h * 128 + t];
            const bf16* up = z + (size_t)(tok0 + t) * 4096 + h * 128 + d0; bf16* op = gbuf + (size_t)(tok0 + t) * 2048 + h * 128 + d0;
#pragma unroll
            for (int q = 0; q < 4; ++q) { const v4u w = *(const v4u*)(up + 8 * q); v4u o;
                o.x = pk2(bflo(w.x) * (acc[8 * q] + bs), bfhi(w.x) * (acc[8 * q + 1] + bs)); o.y = pk2(bflo(w.y) * (acc[8 * q + 2] + bs), bfhi(w.y) * (acc[8 * q + 3] + bs));
                o.z = pk2(bflo(w.z) * (acc[8 * q + 4] + bs), bfhi(w.z) * (acc[8 * q + 5] + bs)); o.w = pk2(bflo(w.w) * (acc[8 * q + 6] + bs), bfhi(w.w) * (acc[8 * q + 7] + bs));
                *(v4u*)(op + 8 * q) = o; } }
        __syncthreads();
    }
}
__device__ __forceinline__ void gating_mfma(LAS unsigned char* lds, const bf16* z, const float* vst, const float* ln_g, const float* ln_b, const float* w_s, const float* b_s, bf16* gbuf, int wave, int lane) {
    LAS float* MU = (LAS float*)(lds + 69632);
    const int tid = wave * 64 + lane, fr = lane & 15, fq = lane >> 4;
    const int ss = tid >> 2, db = (tid & 3) * 32;
    for (int unit = blockIdx.x; unit < 256; unit += gridDim.x) {
        const int tok0 = (unit >> 2) * 128, hg = unit & 3;
        __syncthreads();
        if (tid < 128) { const float* sp = vst + (size_t)(tok0 + tid) * 64; float s1 = 0.f, s2 = 0.f;
#pragma unroll
            for (int i = 0; i < 16; ++i) { const f32x4 a = *(const f32x4*)(sp + 4 * i); s1 += a[0] + a[2]; s2 += a[1] + a[3]; }
            const float mean = s1 * (1.0f / 2048.0f), var = s2 * (1.0f / 2048.0f) - mean * mean; MU[tid] = mean; MU[128 + tid] = 1.0f / sqrtf(var + 1e-6f); }
        v4u raw[4];
        { const bf16* vp = z + (size_t)(tok0 + ss) * 4096 + 2048 + (hg * 4) * 128 + db;
#pragma unroll
            for (int q4 = 0; q4 < 4; ++q4) raw[q4] = NTL((const v4u*)(vp + 8 * q4)); }
        __syncthreads();
        const float mean = MU[ss], rs = MU[128 + ss];
#pragma unroll 1
        for (int hh = 0; hh < 4; ++hh) { const int h = hg * 4 + hh; LAS unsigned char* VT = lds + (hh & 1) * 34816;
            const int t = 16 * wave + fr, nks = (wave >> 1) + 1;
            f32x4 wa[4][2];
#pragma unroll
            for (int ks = 0; ks < 4; ++ks) if (ks < nks) { const float* wp = w_s + ((size_t)h * 128 + t) * 128 + 32 * ks + 8 * fq; wa[ks][0] = *(const f32x4*)wp; wa[ks][1] = *(const f32x4*)(wp + 4); }
            const float bs = b_s[h * 128 + t];
            const bf16* up = z + (size_t)(tok0 + t) * 4096 + h * 128 + 4 * fq; bf16* op = gbuf + (size_t)(tok0 + t) * 2048 + h * 128 + 4 * fq;
            v2u uwv[8];
#pragma unroll
            for (int df = 0; df < 8; ++df) uwv[df] = NTL((const v2u*)(up + 16 * df));
            { const float* gp = ln_g + h * 128 + db; const float* bp = ln_b + h * 128 + db; LAS unsigned char* wp = VT + db * 272 + ss * 2;
#pragma unroll
                for (int q4 = 0; q4 < 4; ++q4) { const f32x4 g0 = *(const f32x4*)(gp + 8 * q4), g1 = *(const f32x4*)(gp + 8 * q4 + 4), b0 = *(const f32x4*)(bp + 8 * q4), b1 = *(const f32x4*)(bp + 8 * q4 + 4); const v4u w = raw[q4];
                    const float v0 = (bflo(w.x) - mean) * rs * g0[0] + b0[0], v1 = (bfhi(w.x) - mean) * rs * g0[1] + b0[1], v2 = (bflo(w.y) - mean) * rs * g0[2] + b0[2], v3 = (bfhi(w.y) - mean) * rs * g0[3] + b0[3];
                    const float v4 = (bflo(w.z) - mean) * rs * g1[0] + b1[0], v5 = (bfhi(w.z) - mean) * rs * g1[1] + b1[1], v6 = (bflo(w.w) - mean) * rs * g1[2] + b1[2], v7 = (bfhi(w.w) - mean) * rs * g1[3] + b1[3];
                    LAS unsigned char* o = wp + (8 * q4) * 272;
                    *(LAS bf16*)(o + 0 * 272) = (bf16)f2bf(v0); *(LAS bf16*)(o + 1 * 272) = (bf16)f2bf(v1); *(LAS bf16*)(o + 2 * 272) = (bf16)f2bf(v2); *(LAS bf16*)(o + 3 * 272) = (bf16)f2bf(v3);
                    *(LAS bf16*)(o + 4 * 272) = (bf16)f2bf(v4); *(LAS bf16*)(o + 5 * 272) = (bf16)f2bf(v5); *(LAS bf16*)(o + 6 * 272) = (bf16)f2bf(v6); *(LAS bf16*)(o + 7 * 272) = (bf16)f2bf(v7); } }
            if (hh < 3) { const bf16* vp = z + (size_t)(tok0 + ss) * 4096 + 2048 + (h + 1) * 128 + db;
#pragma unroll
                for (int q4 = 0; q4 < 4; ++q4) raw[q4] = NTL((const v4u*)(vp + 8 * q4)); }
            __syncthreads();
            bf16x8 wf[4];
#pragma unroll
            for (int ks = 0; ks < 4; ++ks) { wf[ks] = (bf16x8){0, 0, 0, 0, 0, 0, 0, 0};
                if (ks < nks) { const f32x4 a = wa[ks][0], c = wa[ks][1]; const int s0 = 32 * ks + 8 * fq;
                    float v[8] = {a[0], a[1], a[2], a[3], c[0], c[1], c[2], c[3]};
#pragma unroll
                    for (int j = 0; j < 8; ++j) v[j] = (s0 + j <= t) ? v[j] : 0.f;
                    v4u w; w.x = pk2(v[0], v[1]); w.y = pk2(v[2], v[3]); w.z = pk2(v[4], v[5]); w.w = pk2(v[6], v[7]); wf[ks] = __builtin_bit_cast(bf16x8, w); } }
            const LAS unsigned char* ab = VT + fr * 272 + fq * 16;
#pragma unroll
            for (int df = 0; df < 8; ++df) { f32x4 acc = (f32x4){0.f, 0.f, 0.f, 0.f};
#pragma unroll
                for (int ks = 0; ks < 4; ++ks) if (ks < nks) { const bf16x8 a = *(const LAS bf16x8*)(ab + df * 16 * 272 + ks * 64); acc = __builtin_amdgcn_mfma_f32_16x16x32_bf16(a, wf[ks], acc, 0, 0, 0); }
                const v2u uw = uwv[df]; v2u ow;
                ow.x = pg8::cvt_pk_bf16(bflo(uw.x) * (acc[0] + bs), bfhi(uw.x) * (acc[1] + bs)); ow.y = pg8::cvt_pk_bf16(bflo(uw.y) * (acc[2] + bs), bfhi(uw.y) * (acc[3] + bs));
                pg8::st_wt8(op + 16 * df, ow); }
        }
    }
    __syncthreads();
}
__device__ __forceinline__ void attn_simple(LAS unsigned char* lds, const bf16* q, const bf16* Kb, const bf16* Vb, bf16* obuf, int wave, int lane) {
    LAS float* pl = (LAS float*)(lds + wave * 1024);
    const int gw = blockIdx.x * NWAVES + wave, NGW = gridDim.x * NWAVES;
    for (int task = gw; task < BATCH * 4 * SEQ; task += NGW) {
        const int bh = task >> 12, t = task & 4095, b = bh >> 2, h = bh & 3;
        float qf[8]; { const v4u w = *(const v4u*)(q + ((size_t)(b * SEQ + t)) * 2048 + h * 512 + 8 * lane);
            qf[0] = bflo(w.x); qf[1] = bfhi(w.x); qf[2] = bflo(w.y); qf[3] = bfhi(w.y); qf[4] = bflo(w.z); qf[5] = bfhi(w.z); qf[6] = bflo(w.w); qf[7] = bfhi(w.w); }
        const bf16* kp = Kb + (size_t)bh * 256 * 512 + 8 * lane;
        float sc[4];
#pragma unroll
        for (int kk = 0; kk < 4; ++kk) { float mine = 0.f;
            for (int l2 = 0; l2 < 64; ++l2) { const v4u w = *(const v4u*)(kp + (size_t)(kk * 64 + l2) * 512);
                float dsum = qf[0] * bflo(w.x) + qf[1] * bfhi(w.x) + qf[2] * bflo(w.y) + qf[3] * bfhi(w.y) + qf[4] * bflo(w.z) + qf[5] * bfhi(w.z) + qf[6] * bflo(w.w) + qf[7] * bfhi(w.w);
                dsum = wave_sum(dsum); if (lane == l2) mine = dsum; }
            sc[kk] = mine; }
        const float mx = wave_max(fmaxf(fmaxf(sc[0], sc[1]), fmaxf(sc[2], sc[3])));
        float p[4], ps = 0.f;
#pragma unroll
        for (int kk = 0; kk < 4; ++kk) { p[kk] = exp2f(sc[kk] - mx); ps += p[kk]; pl[kk * 64 + lane] = p[kk]; }
        const float inv = 1.0f / wave_sum(ps);
        LDS_WAIT();
        float o[8];
#pragma unroll
        for (int i = 0; i < 8; ++i) o[i] = 0.f;
        const bf16* vp = Vb + (size_t)bh * 256 * 512 + 8 * lane;
        for (int key = 0; key < 256; ++key) { const float pk = pl[key]; const v4u w = *(const v4u*)(vp + (size_t)key * 512);
            o[0] += pk * bflo(w.x); o[1] += pk * bfhi(w.x); o[2] += pk * bflo(w.y); o[3] += pk * bfhi(w.y); o[4] += pk * bflo(w.z); o[5] += pk * bfhi(w.z); o[6] += pk * bflo(w.w); o[7] += pk * bfhi(w.w); }
        v4u ow; ow.x = pk2(o[0] * inv, o[1] * inv); ow.y = pk2(o[2] * inv, o[3] * inv); ow.z = pk2(o[4] * inv, o[5] * inv); ow.w = pk2(o[6] * inv, o[7] * inv);
        *(v4u*)(obuf + ((size_t)(b * SEQ + t)) * 2048 + h * 512 + 8 * lane) = ow;
        LDS_WAIT();
    }
}
__device__ __forceinline__ void attn_mfma(LAS unsigned char* lds, const bf16* q, const bf16* Kb, const bf16* VTb, bf16* obuf, int wave, int lane) {
    const int tid = wave * 64 + lane, fr = lane & 15, fq = lane >> 4;
    unsigned voffK[2], voffV[2];
#pragma unroll
    for (int i = 0; i < 2; ++i) { int R, C; pg8::stage_rc(tid * 16 + i * 8192, R, C); voffK[i] = (unsigned)(R * 512 + C) * 2u; voffV[i] = (unsigned)(R * 256 + C) * 2u; }
    const unsigned ldsw = (unsigned)wave * 1024u;
    const int aoff0 = pg8::lds_byte(fr, fq * 8);
#define AT_STAGE_K(c, buf) do { _Pragma("unroll") for (int ht = 0; ht < 4; ++ht) { const char* src = Kg + ((size_t)(128 * (ht >> 1)) * 512 + 128 * (c) + 64 * (ht & 1)) * 2; \
        _Pragma("unroll") for (int i = 0; i < 2; ++i) __builtin_amdgcn_global_load_lds((const unsigned*)(src + voffK[i]), (LAS unsigned*)(lds + (buf) * 65536 + ht * 16384 + ldsw + i * 8192), 16, 0, 0); } } while (0)
#define AT_STAGE_V(cc, buf) do { _Pragma("unroll") for (int ht = 0; ht < 4; ++ht) { const char* src = Vg + ((size_t)(128 * ht) * 256 + 64 * (cc)) * 2; \
        _Pragma("unroll") for (int i = 0; i < 2; ++i) __builtin_amdgcn_global_load_lds((const unsigned*)(src + voffV[i]), (LAS unsigned*)(lds + (buf) * 65536 + ht * 16384 + ldsw + i * 8192), 16, 0, 0); } } while (0)
#define AT_WAIT() do { asm volatile("s_waitcnt vmcnt(0)" ::: "memory"); __syncthreads(); } while (0)
    for (int unit = blockIdx.x; unit < 256; unit += gridDim.x) {
        const int bh = unit & 7, qb = unit >> 3, b = bh >> 2, h = bh & 3;
        const char* Kg = (const char*)(Kb + (size_t)bh * 256 * 512);
        const char* Vg = (const char*)(VTb + (size_t)bh * 512 * 256);
        const size_t tok = (size_t)(b * SEQ + qb * 128 + 16 * wave + fr);
        bf16x8 qf[16];
        { const bf16* qp = q + tok * 2048 + h * 512 + 8 * fq;
#pragma unroll
            for (int s = 0; s < 16; ++s) qf[s] = NTL((const bf16x8*)(qp + 32 * s)); }
        f32x4 acc[16];
#pragma unroll
        for (int n = 0; n < 16; ++n) acc[n] = (f32x4){0.f, 0.f, 0.f, 0.f};
        STAMP2(lds, 40);
        AT_STAGE_K(0, 0);
#pragma unroll
        for (int c = 0; c < 4; ++c) {
            AT_WAIT();
            if (c < 3) AT_STAGE_K(c + 1, (c + 1) & 1); else AT_STAGE_V(0, 0);
            const LAS unsigned char* bb = lds + (c & 1) * 65536 + aoff0; asm volatile("" : "+v"(bb));
#define AT_QK_LOAD(dst, gi) do { _Pragma("unroll") for (int n8 = 0; n8 < 8; ++n8) dst[n8] = *(const LAS bf16x8*)(bb + ((((gi) & 1) * 2 + ((gi) >> 2)) * 16384) + n8 * 2048 + (((gi) >> 1) & 1) * 1024); } while (0)
#define AT_QK_MMA(src, gi) do { _Pragma("unroll") for (int n8 = 0; n8 < 8; ++n8) acc[((gi) & 1) * 8 + n8] = __builtin_amdgcn_mfma_f32_16x16x32_bf16(src[n8], qf[4 * c + 2 * ((gi) >> 2) + (((gi) >> 1) & 1)], acc[((gi) & 1) * 8 + n8], 0, 0, 0); } while (0)
            { bf16x8 a0[8], a1[8];
                AT_QK_LOAD(a0, 0);
#pragma unroll
                for (int gi = 0; gi < 8; gi += 2) { AT_QK_LOAD(a1, gi + 1); AT_QK_MMA(a0, gi); __builtin_amdgcn_sched_barrier(0);
                    if (gi + 2 < 8) AT_QK_LOAD(a0, gi + 2);
                    AT_QK_MMA(a1, gi + 1); __builtin_amdgcn_sched_barrier(0); } }
        }
        STAMP2(lds, 41);
        float mx = acc[0][0];
#pragma unroll
        for (int n = 0; n < 16; ++n) mx = fmaxf(fmaxf(mx, fmaxf(acc[n][0], acc[n][1])), fmaxf(acc[n][2], acc[n][3]));
        mx = fmaxf(mx, __shfl_xor(mx, 16)); mx = fmaxf(mx, __shfl_xor(mx, 32));
        float l = 0.f;
#pragma unroll
        for (int n = 0; n < 16; ++n)
#pragma unroll
            for (int r = 0; r < 4; ++r) { const float pv = __builtin_amdgcn_exp2f(acc[n][r] - mx); acc[n][r] = pv; l += pv; }
        l += __shfl_xor(l, 16); l += __shfl_xor(l, 32);
        const float linv = 1.0f / l;
        bf16x8 pf[8];
#pragma unroll
        for (int s = 0; s < 8; ++s) { v4u w; w.x = pg8::cvt_pk_bf16(acc[2 * s][0], acc[2 * s][1]); w.y = pg8::cvt_pk_bf16(acc[2 * s][2], acc[2 * s][3]);
            w.z = pg8::cvt_pk_bf16(acc[2 * s + 1][0], acc[2 * s + 1][1]); w.w = pg8::cvt_pk_bf16(acc[2 * s + 1][2], acc[2 * s + 1][3]); pf[s] = __builtin_bit_cast(bf16x8, w); }
        STAMP2(lds, 42);
        __builtin_amdgcn_sched_barrier(0);
        f32x4 o[32];
#pragma unroll
        for (int mm = 0; mm < 32; ++mm) o[mm] = (f32x4){0.f, 0.f, 0.f, 0.f};
#pragma unroll
        for (int cc = 0; cc < 4; ++cc) {
            AT_WAIT();
            if (cc < 3) AT_STAGE_V(cc + 1, (cc + 1) & 1);
            const LAS unsigned char* bb = lds + (cc & 1) * 65536 + aoff0; asm volatile("" : "+v"(bb));
#define AT_PV_LOAD(dst, gi) do { _Pragma("unroll") for (int m8 = 0; m8 < 8; ++m8) dst[m8] = *(const LAS bf16x8*)(bb + ((gi) & 3) * 16384 + m8 * 2048 + ((gi) >> 2) * 1024); } while (0)
#define AT_PV_MMA(src, gi) do { _Pragma("unroll") for (int m8 = 0; m8 < 8; ++m8) o[((gi) & 3) * 8 + m8] = __builtin_amdgcn_mfma_f32_16x16x32_bf16(src[m8], pf[2 * cc + ((gi) >> 2)], o[((gi) & 3) * 8 + m8], 0, 0, 0); } while (0)
            { bf16x8 a0[8], a1[8];
                AT_PV_LOAD(a0, 0);
#pragma unroll
                for (int gi = 0; gi < 8; gi += 2) { AT_PV_LOAD(a1, gi + 1); AT_PV_MMA(a0, gi); __builtin_amdgcn_sched_barrier(0);
                    if (gi + 2 < 8) AT_PV_LOAD(a0, gi + 2);
                    AT_PV_MMA(a1, gi + 1); __builtin_amdgcn_sched_barrier(0); } }
        }
        STAMP2(lds, 43);
        bf16* op = obuf + tok * 2048 + h * 512 + 4 * fq;
#pragma unroll
        for (int mm = 0; mm < 32; ++mm) { v2u w; w.x = pg8::cvt_pk_bf16(o[mm][0] * linv, o[mm][1] * linv); w.y = pg8::cvt_pk_bf16(o[mm][2] * linv, o[mm][3] * linv); pg8::st_wt8(op + 16 * mm, w); }
    }
    asm volatile("s_waitcnt vmcnt(0)" ::: "memory"); __syncthreads(); STAMP2(lds, 44);
#undef AT_STAGE_K
#undef AT_QK_LOAD
#undef AT_QK_MMA
#undef AT_PV_LOAD
#undef AT_PV_MMA
#undef AT_STAGE_V
#undef AT_WAIT
}
struct S5Lane { float lbr, lbi; float Br[16], Bi[16]; };
__device__ __forceinline__ void s5_lane_params(int g, int p, S5Lane& L) {
    const float lr = fminf(ka_in(15)[g * 64 + p], -1e-4f), li = ka_in(16)[g * 64 + p], dt = expf(ka_in(17)[g]);
    const float ar = lr * dt, th = li * dt; float sn, cs; sincosf(th, &sn, &cs); const float e = expf(ar), sh = sinf(0.5f * th);
    L.lbr = e * cs; L.lbi = e * sn;
    const float nr = expm1f(ar) * cs - 2.0f * sh * sh, ni = e * sn;
    const float den = 1.0f / (lr * lr + li * li), cr = (nr * lr + ni * li) * den, ci = (ni * lr - nr * li) * den;
#pragma unroll
    for (int c = 0; c < 16; ++c) { const float br = ka_in(18)[(size_t)(g * 64 + p) * 16 + c], bi = ka_in(19)[(size_t)(g * 64 + p) * 16 + c]; L.Br[c] = cr * br - ci * bi; L.Bi[c] = cr * bi + ci * br; }
}
__device__ __forceinline__ void s5_step(const S5Lane& L, const bf16* urow, float& xr, float& xi) {
    const v4u w0 = *(const v4u*)urow, w1 = *(const v4u*)(urow + 8);
    float u[16] = {bflo(w0.x), bfhi(w0.x), bflo(w0.y), bfhi(w0.y), bflo(w0.z), bfhi(w0.z), bflo(w0.w), bfhi(w0.w), bflo(w1.x), bfhi(w1.x), bflo(w1.y), bfhi(w1.y), bflo(w1.z), bfhi(w1.z), bflo(w1.w), bfhi(w1.w)};
    float br = 0.f, bi = 0.f;
#pragma unroll
    for (int c = 0; c < 16; ++c) { br += L.Br[c] * u[c]; bi += L.Bi[c] * u[c]; }
    const float nr = L.lbr * xr - L.lbi * xi + br, ni = L.lbr * xi + L.lbi * xr + bi; xr = nr; xi = ni;
}
__device__ __forceinline__ void s5_pass_a(const bf16* ub, f32x2* st, int wave, int lane) {
    const int gw = blockIdx.x * NWAVES + wave, NGW = gridDim.x * NWAVES;
    for (int task = gw; task < BATCH * 128 * 64; task += NGW) {
        const int seg = task & 63, g = (task >> 6) & 127, b = task >> 13;
        S5Lane L; s5_lane_params(g, lane, L);
        float xr = 0.f, xi = 0.f; const bf16* up = ub + (size_t)(b * SEQ + seg * 64) * 2048 + 16 * g;
#pragma unroll 2
        for (int s = 0; s < 64; ++s) s5_step(L, up + (size_t)s * 2048, xr, xi);
        st[(size_t)task * 64 + lane] = (f32x2){xr, xi};
    }
}
__device__ __forceinline__ void s5_pass_c(LAS unsigned char* lds, const bf16* ub, const f32x2* st, bf16* yb, int wave, int lane) {
    LAS f32x2* Cs = (LAS f32x2*)(lds + wave * 16640);
    LAS f32x2* xs = (LAS f32x2*)(lds + wave * 16640 + 8320);
    const int gw = blockIdx.x * NWAVES + wave, NGW = gridDim.x * NWAVES;
    for (int task = gw; task < BATCH * 128 * 64; task += NGW) {
        const int seg = task & 63, g = (task >> 6) & 127, b = task >> 13;
        S5Lane L; s5_lane_params(g, lane, L);
#pragma unroll
        for (int c = 0; c < 16; ++c) Cs[c * 65 + lane] = (f32x2){ka_in(20)[(size_t)(g * 16 + c) * 64 + lane], ka_in(21)[(size_t)(g * 16 + c) * 64 + lane]};
        float Ar = L.lbr, Ai = L.lbi;
#pragma unroll
        for (int i = 0; i < 6; ++i) { const float nr = Ar * Ar - Ai * Ai, ni = 2.0f * Ar * Ai; Ar = nr; Ai = ni; }
        float xr = 0.f, xi = 0.f; const f32x2* sp = st + (size_t)(task - seg) * 64 + lane;
#pragma unroll 2
        for (int n = 0; n < seg; ++n) { const f32x2 s = sp[(size_t)n * 64]; const float nr = Ar * xr - Ai * xi + s.x, ni = Ar * xi + Ai * xr + s.y; xr = nr; xi = ni; }
        const bf16* up = ub + (size_t)(b * SEQ + seg * 64) * 2048 + 16 * g; bf16* yp = yb + (size_t)(b * SEQ + seg * 64) * 2048 + 16 * g;
        const int t = lane & 15, cq = lane >> 4;
        f32x4 dsk = *(const f32x4*)(ka_in(22) + g * 16 + 4 * cq);
#pragma unroll 1
        for (int blk = 0; blk < 4; ++blk) {
#pragma unroll 2
            for (int s = 0; s < 16; ++s) { s5_step(L, up + (size_t)(blk * 16 + s) * 2048, xr, xi); xs[s * 65 + lane] = (f32x2){xr, xi}; }
            LDS_WAIT();
            float acc[4] = {0.f, 0.f, 0.f, 0.f};
#pragma unroll 4
            for (int p = 0; p < 64; ++p) { const f32x2 x = xs[t * 65 + p];
#pragma unroll
                for (int j = 0; j < 4; ++j) { const f32x2 c = Cs[(4 * cq + j) * 65 + p]; acc[j] += c.x * x.x - c.y * x.y; } }
            const v2u uw = *(const v2u*)(up + (size_t)(blk * 16 + t) * 2048 + 4 * cq);
            const float y0 = gelu_exact(acc[0] + dsk[0] * bflo(uw.x)), y1 = gelu_exact(acc[1] + dsk[1] * bfhi(uw.x)), y2 = gelu_exact(acc[2] + dsk[2] * bflo(uw.y)), y3 = gelu_exact(acc[3] + dsk[3] * bfhi(uw.y));
            v2u ow; ow.x = pk2(y0, y1); ow.y = pk2(y2, y3); *(v2u*)(yp + (size_t)(blk * 16 + t) * 2048 + 4 * cq) = ow;
            LDS_WAIT();
        }
    }
}
__device__ __forceinline__ void s5_mfma(LAS unsigned char* lds, const bf16* ub, bf16* yb, int wave, int lane) {
    LAS f32x2* PW = (LAS f32x2*)(lds);
    LAS f32x2* BB = (LAS f32x2*)(lds + 8704);
    LAS f32x2* CC = (LAS f32x2*)(lds + 16896);
    LAS bf16* KST = (LAS bf16*)(lds + 25088);
    LAS unsigned char* UI = lds + 33280;
    LAS float* SL = (LAS float*)(lds + 66048);
    LAS bf16* XP = (LAS bf16*)(lds + 99840);
    const int tid = wave * 64 + lane, fr = lane & 15, fq = lane >> 4;
#ifndef S5_LOOP_REPS
#define S5_LOOP_REPS 1
#endif
    for (int unit = blockIdx.x; unit < 256; unit += gridDim.x) {
        const int b = unit >> 7, g = unit & 127;
        const bf16* usrc = ub + (size_t)(b * SEQ) * 2048 + 16 * g + (size_t)(tid >> 1) * 2048 + 8 * (tid & 1);
        v4u upre[4];
#pragma unroll
        for (int i = 0; i < 4; ++i) upre[i] = NTL((const v4u*)(usrc + (size_t)(256 * i) * 2048));
        const float ldt = ka_in(17)[g];
        float plr[3], pli[3];
#pragma unroll
        for (int it = 0; it < 3; ++it) { const int idx = tid + NTHREADS * it, p = idx & 63; plr[it] = ka_in(15)[g * 64 + p]; pli[it] = ka_in(16)[g * 64 + p]; }
        float pbr[2], pbi[2], pcr[2], pci[2];
#pragma unroll
        for (int it = 0; it < 2; ++it) { const int idx = tid + NTHREADS * it; pbr[it] = ka_in(18)[(size_t)g * 1024 + idx]; pbi[it] = ka_in(19)[(size_t)g * 1024 + idx]; pcr[it] = ka_in(20)[(size_t)g * 1024 + idx]; pci[it] = ka_in(21)[(size_t)g * 1024 + idx]; }
        float qlr[2], qli[2];
#pragma unroll
        for (int it = 0; it < 2; ++it) { const int p = (tid + NTHREADS * it) >> 4; qlr[it] = ka_in(15)[g * 64 + p]; qli[it] = ka_in(16)[g * 64 + p]; }
        const f32x4 dsk = *(const f32x4*)(ka_in(22) + g * 16 + 4 * fq);
        const float dt = expf(ldt);
        __syncthreads();
#pragma unroll
        for (int it = 0; it < 3; ++it) { const int idx = tid + NTHREADS * it; if (idx < 17 * 64) { const int e = idx >> 6;
            const float lr = fminf(plr[it], -1e-4f), li = pli[it]; float sn, cs; sincosf(li * dt * (float)e, &sn, &cs); const float ex = expf(lr * dt * (float)e);
            PW[idx] = (f32x2){ex * cs, ex * sn}; } }
#pragma unroll
        for (int it = 0; it < 2; ++it) { const int idx = tid + NTHREADS * it;
            const float lr = fminf(qlr[it], -1e-4f), li = qli[it]; const float ar = lr * dt, th = li * dt; float sn, cs; sincosf(th, &sn, &cs); const float e = expf(ar), sh = sinf(0.5f * th);
            const float nr = expm1f(ar) * cs - 2.0f * sh * sh, ni = e * sn, den = 1.0f / (lr * lr + li * li), cr = (nr * lr + ni * li) * den, ci = (ni * lr - nr * li) * den;
            BB[idx] = (f32x2){cr * pbr[it] - ci * pbi[it], cr * pbi[it] + ci * pbr[it]};
            CC[idx] = (f32x2){pcr[it], pci[it]}; }
        __syncthreads();
        bf16x8 A1[8];
        { const int ri = wave >> 2, p = 16 * (wave & 3) + fr; f32x2 bb[8];
#pragma unroll
            for (int j = 0; j < 8; ++j) bb[j] = BB[p * 16 + 8 * (fq & 1) + j];
#pragma unroll
            for (int ks = 0; ks < 8; ++ks) { const int s = 2 * ks + (fq >> 1); const f32x2 pw = PW[(15 - s) * 64 + p]; float v[8];
#pragma unroll
                for (int j = 0; j < 8; ++j) v[j] = ri ? (pw.x * bb[j].y + pw.y * bb[j].x) : (pw.x * bb[j].x - pw.y * bb[j].y);
                v4u w; w.x = pk2(v[0], v[1]); w.y = pk2(v[2], v[3]); w.z = pk2(v[4], v[5]); w.w = pk2(v[6], v[7]); A1[ks] = __builtin_bit_cast(bf16x8, w); }
            __builtin_amdgcn_sched_barrier(0); }
        const int t0 = wave, t1 = 15 - wave;
        bf16x8 CM[2][4];
        { f32x4 kacc[2] = {(f32x4){0.f, 0.f, 0.f, 0.f}, (f32x4){0.f, 0.f, 0.f, 0.f}};
#pragma unroll
            for (int h = 0; h < 2; ++h) { f32x2 cc[8], pa[8], pb[8];
#pragma unroll
                for (int j = 0; j < 8; ++j) { const int p = 32 * h + 8 * fq + j; cc[j] = CC[fr * 64 + p]; pa[j] = PW[(t0 + 1) * 64 + p]; pb[j] = PW[(t1 + 1) * 64 + p]; }
                float vr[8], vi[8];
#pragma unroll
                for (int j = 0; j < 8; ++j) { vr[j] = cc[j].x * pa[j].x - cc[j].y * pa[j].y; vi[j] = -(cc[j].x * pa[j].y + cc[j].y * pa[j].x); }
                { v4u w; w.x = pk2(vr[0], vr[1]); w.y = pk2(vr[2], vr[3]); w.z = pk2(vr[4], vr[5]); w.w = pk2(vr[6], vr[7]); CM[0][h] = __builtin_bit_cast(bf16x8, w);
                  w.x = pk2(vi[0], vi[1]); w.y = pk2(vi[2], vi[3]); w.z = pk2(vi[4], vi[5]); w.w = pk2(vi[6], vi[7]); CM[0][2 + h] = __builtin_bit_cast(bf16x8, w); }
#pragma unroll
                for (int j = 0; j < 8; ++j) { vr[j] = cc[j].x * pb[j].x - cc[j].y * pb[j].y; vi[j] = -(cc[j].x * pb[j].y + cc[j].y * pb[j].x); }
                { v4u w; w.x = pk2(vr[0], vr[1]); w.y = pk2(vr[2], vr[3]); w.z = pk2(vr[4], vr[5]); w.w = pk2(vr[6], vr[7]); CM[1][h] = __builtin_bit_cast(bf16x8, w);
                  w.x = pk2(vi[0], vi[1]); w.y = pk2(vi[2], vi[3]); w.z = pk2(vi[4], vi[5]); w.w = pk2(vi[6], vi[7]); CM[1][2 + h] = __builtin_bit_cast(bf16x8, w); }
                bf16x8 ctr, cti;
                { v4u w; w.x = pk2(cc[0].x, cc[1].x); w.y = pk2(cc[2].x, cc[3].x); w.z = pk2(cc[4].x, cc[5].x); w.w = pk2(cc[6].x, cc[7].x); ctr = __builtin_bit_cast(bf16x8, w);
                  w.x = pk2(-cc[0].y, -cc[1].y); w.y = pk2(-cc[2].y, -cc[3].y); w.z = pk2(-cc[4].y, -cc[5].y); w.w = pk2(-cc[6].y, -cc[7].y); cti = __builtin_bit_cast(bf16x8, w); }
                f32x2 bq[8];
#pragma unroll
                for (int j = 0; j < 8; ++j) bq[j] = BB[(32 * h + 8 * fq + j) * 16 + fr];
#pragma unroll
                for (int si = 0; si < 2; ++si) { const int s = 2 * wave + si;
#pragma unroll
                    for (int j = 0; j < 8; ++j) { const f32x2 pw = PW[(15 - s) * 64 + 32 * h + 8 * fq + j]; vr[j] = pw.x * bq[j].x - pw.y * bq[j].y; vi[j] = pw.x * bq[j].y + pw.y * bq[j].x; }
                    v4u w; w.x = pk2(vr[0], vr[1]); w.y = pk2(vr[2], vr[3]); w.z = pk2(vr[4], vr[5]); w.w = pk2(vr[6], vr[7]);
                    kacc[si] = __builtin_amdgcn_mfma_f32_16x16x32_bf16(__builtin_bit_cast(bf16x8, w), ctr, kacc[si], 0, 0, 0);
                    w.x = pk2(vi[0], vi[1]); w.y = pk2(vi[2], vi[3]); w.z = pk2(vi[4], vi[5]); w.w = pk2(vi[6], vi[7]);
                    kacc[si] = __builtin_amdgcn_mfma_f32_16x16x32_bf16(__builtin_bit_cast(bf16x8, w), cti, kacc[si], 0, 0, 0); }
                __builtin_amdgcn_sched_barrier(0); }
#pragma unroll
            for (int si = 0; si < 2; ++si) { const int s = 2 * wave + si; v2u kw; kw.x = pk2(kacc[si][0], kacc[si][1]); kw.y = pk2(kacc[si][2], kacc[si][3]);
                *(LAS v2u*)(KST + ((15 - s) * 16 + fr) * 16 + 4 * fq) = kw; } }
#pragma unroll 1
        for (int rep = 0; rep < S5_LOOP_REPS; ++rep) {
        float Xr = 0.f, Xi = 0.f;
#pragma unroll 1
        for (int q = 0; q < 4; ++q) {
            __syncthreads();
#pragma unroll
            for (int i = 0; i < 4; ++i) { const int piece = tid + NTHREADS * i, tok = piece >> 1, half = piece & 1;
                *(LAS v4u*)(UI + ((((tok & 15) * 64 + (tok >> 4)) * 2 + half) * 16)) = upre[i]; }
            { const int qn = (q + 1) & 3;
#pragma unroll
                for (int i = 0; i < 4; ++i) upre[i] = NTL((const v4u*)(usrc + (size_t)(qn * 1024 + 256 * i) * 2048)); }
            __syncthreads();
#pragma unroll 1
            for (int nf = 0; nf < 4; ++nf) { f32x4 acc = (f32x4){0.f, 0.f, 0.f, 0.f};
#pragma unroll
                for (int ks = 0; ks < 8; ++ks) { const bf16x8 bfr = *(const LAS bf16x8*)(UI + ((((2 * ks + (fq >> 1)) * 64 + 16 * nf + fr) * 2 + (fq & 1)) * 16));
                    acc = __builtin_amdgcn_mfma_f32_16x16x32_bf16(A1[ks], bfr, acc, 0, 0, 0); }
                *(LAS f32x4*)(SL + (16 * nf + fr) * 132 + 16 * wave + 4 * fq) = acc; }
            __syncthreads();
            if (wave == 0) { const f32x2 a16 = PW[16 * 64 + lane];
#pragma unroll 1
                for (int nb = 0; nb < 64; nb += 16) { float sr[16], si[16];
#pragma unroll
                    for (int n = 0; n < 16; ++n) { sr[n] = SL[(nb + n) * 132 + lane]; si[n] = SL[(nb + n) * 132 + 64 + lane]; }
#pragma unroll
                    for (int n = 0; n < 16; ++n) { XP[(nb + n) * 136 + lane] = (bf16)f2bf(Xr); XP[(nb + n) * 136 + 64 + lane] = (bf16)f2bf(Xi);
                        const float nr = a16.x * Xr - a16.y * Xi + sr[n], ni = a16.x * Xi + a16.y * Xr + si[n]; Xr = nr; Xi = ni; } } }
            __syncthreads();
#pragma unroll 1
            for (int nf = 0; nf < 4; ++nf) { f32x4 acc0 = (f32x4){0.f, 0.f, 0.f, 0.f}, acc1 = acc0;
#pragma unroll
                for (int ks = 0; ks < 8; ++ks) { if (2 * ks <= t1 || 2 * ks <= t0) {
                    const int s = 2 * ks + (fq >> 1);
                    const bf16x8 bfr = *(const LAS bf16x8*)(UI + (((s * 64 + 16 * nf + fr) * 2 + (fq & 1)) * 16));
                    if (2 * ks <= t0) { bf16x8 tf = (bf16x8){0, 0, 0, 0, 0, 0, 0, 0}; if (s <= t0) tf = *(const LAS bf16x8*)(KST + ((t0 - s) * 16 + fr) * 16 + 8 * (fq & 1)); acc0 = __builtin_amdgcn_mfma_f32_16x16x32_bf16(tf, bfr, acc0, 0, 0, 0); }
                    if (2 * ks <= t1) { bf16x8 tf = (bf16x8){0, 0, 0, 0, 0, 0, 0, 0}; if (s <= t1) tf = *(const LAS bf16x8*)(KST + ((t1 - s) * 16 + fr) * 16 + 8 * (fq & 1)); acc1 = __builtin_amdgcn_mfma_f32_16x16x32_bf16(tf, bfr, acc1, 0, 0, 0); } } }
#pragma unroll
                for (int ks = 0; ks < 4; ++ks) { const bf16x8 xf = *(const LAS bf16x8*)(XP + (16 * nf + fr) * 136 + 32 * ks + 8 * fq);
                    acc0 = __builtin_amdgcn_mfma_f32_16x16x32_bf16(CM[0][ks], xf, acc0, 0, 0, 0); acc1 = __builtin_amdgcn_mfma_f32_16x16x32_bf16(CM[1][ks], xf, acc1, 0, 0, 0); }
#pragma unroll
                for (int ti = 0; ti < 2; ++ti) { const int t = ti ? t1 : t0; const f32x4 a = ti ? acc1 : acc0; const int n = 16 * nf + fr;
                    const v2u uw = *(const LAS v2u*)(UI + (((t * 64 + n) * 2 + (fq >> 1)) * 16) + 8 * (fq & 1));
                    const pg8::f32x2 g0 = pg8::gelu_pk((pg8::f32x2){a[0] + dsk[0] * bflo(uw.x), a[1] + dsk[1] * bfhi(uw.x)}), g1 = pg8::gelu_pk((pg8::f32x2){a[2] + dsk[2] * bflo(uw.y), a[3] + dsk[3] * bfhi(uw.y)});
                    v2u ow; ow.x = pg8::cvt_pk_bf16(g0.x, g0.y); ow.y = pg8::cvt_pk_bf16(g1.x, g1.y);
                    pg8::st_wt8(yb + (size_t)(b * SEQ + q * 1024 + 16 * n + t) * 2048 + 16 * g + 4 * fq, ow); } }
        }
        }
    }
    __syncthreads();
}
#ifndef EN
#define EN(k) 1
#endif
template <int PH> __device__ __forceinline__ void run_phase(unsigned char* ws, float* X, LAS unsigned char* lds, int wave, int lane) {
    const int G = gridDim.x, bx = blockIdx.x;
    bf16* XB = (bf16*)(ws + WS_XB); float* SSQ = (float*)(ws + WS_SSQ);
    bf16* R0 = (bf16*)(ws + WS_R);
    constexpr int layer = (PH >= 10) ? 1 : 0;
    if constexpr (!EN(PH)) { return; }
    else if constexpr (PH == 0) p0_prologue(ws, lds, wave, lane);
    else if constexpr (PH == 1) {
        if (bx < 64) { const int i = bx >> 5;
            pg8::Gemm g{(const pg8::bf16_t*)(ws + WS_MEMB), (const pg8::bf16_t*)(ws + WS_W_KV + (size_t)i * 16 * MiB), MROWS, 4096, 2048}; pg8::StaticOrder S; S.init(MROWS, 4096, 32, bx & 31);
            pg8::EpiKV E{(pg8::bf16_t*)(ws + WS_KB + (size_t)i * 2 * MiB), (pg8::bf16_t*)(ws + WS_VB + (size_t)i * 2 * MiB), (pg8::bf16_t*)(ws + WS_VTB + (size_t)i * 2 * MiB), (const float*)(ws + WS_SSQM)};
            pg8::gemm_phase<pg8::EpiKV, pg8::StaticOrder, true, PG8_SP2V>(lds, g, S, E, wave, lane); }
        p1_convert(ws, lds, wave, lane);
    } else if constexpr (PH == 2) {
        pg8::Gemm g{XB, (const pg8::bf16_t*)(ws + WS_W_AIN), M, 4096, 2048}; pg8::StaticOrder S; S.init(M, 4096, G, bx);
        pg8::EpiAct<1, true> E{R0, 4096, ka_in(8), SSQ, 32, 1.0f, (float*)(ws + WS_VST), 8, (LAS float*)(lds + 131072)};
        {
#if defined(BG_CONV)
            const bool bgpre = (blockIdx.x & 1) != 0;
            if (bgpre) { bg_convert<PH>(ws, lds, wave, lane); __syncthreads(); }
#else
            const bool bgpre = true;
#endif
            pg8::gemm_phase<pg8::EpiAct<1, true>, pg8::StaticOrder, true, PG8_SP2V>(lds, g, S, E, wave, lane);
            if (!bgpre) bg_convert<PH>(ws, lds, wave, lane); }
    } else if constexpr (PH == 3) {
#if defined(GATING_SIMPLE)
        gating_simple(lds, R0, (const float*)(ws + WS_VST), ka_in(9), ka_in(10), ka_in(11), ka_in(12), R0 + (size_t)M * 4096, wave * 64 + lane);
#else
        gating_mfma(lds, R0, (const float*)(ws + WS_VST), ka_in(9), ka_in(10), ka_in(11), ka_in(12), R0 + (size_t)M * 4096, wave, lane);
#endif
    }
    else if constexpr (PH == 4 || PH == 7 || PH == 9 || PH == 16 || PH == 18) {
        const pg8::bf16_t* A; const pg8::bf16_t* W; int K = 2048;
        if constexpr (PH == 4) { A = R0 + (size_t)M * 4096; W = (const pg8::bf16_t*)(ws + WS_W_AOUT); }
        else if constexpr (PH == 7 || PH == 16) { A = R0 + (size_t)M * 2048; W = (const pg8::bf16_t*)(ws + WS_W_O + (size_t)layer * 8 * MiB); }
        else { A = R0; W = (const pg8::bf16_t*)(ws + WS_W_DN + (size_t)layer * 32 * MiB); K = 8192; }
        pg8::Gemm g{A, W, M, 2048, K}; pg8::StaticOrder S; S.init(M, 2048, G, bx);
        pg8::EpiRes E{XB, SSQ};
        {
#if defined(BG_CONV)
            const bool bgpre = (blockIdx.x & 1) != 0;
            if (bgpre) { bg_convert<PH>(ws, lds, wave, lane); __syncthreads(); }
#else
            const bool bgpre = true;
#endif
            pg8::gemm_phase<pg8::EpiRes, pg8::StaticOrder, true, PG8_SP2V>(lds, g, S, E, wave, lane);
            if (!bgpre) bg_convert<PH>(ws, lds, wave, lane); }
    } else if constexpr (PH == 5 || PH == 14 || PH == 10) {
        const pg8::bf16_t* W = (PH == 10) ? (const pg8::bf16_t*)(ws + WS_W_BIN) : (const pg8::bf16_t*)(ws + WS_W_Q + (size_t)layer * 8 * MiB);
        pg8::Gemm g{XB, W, M, 2048, 2048}; pg8::StaticOrder S; S.init(M, 2048, G, bx);
        pg8::EpiAct<0, false> E{R0, 2048, nullptr, SSQ, (PH == 14) ? 64 : 32, (PH == 10) ? 1.0f : 0.044194173824159216f * 1.4426950408889634f, nullptr, 0, (LAS float*)(lds + 131072)};
        {
#if defined(BG_CONV)
            const bool bgpre = (blockIdx.x & 1) != 0;
            if (bgpre) { bg_convert<PH>(ws, lds, wave, lane); __syncthreads(); }
#else
            const bool bgpre = true;
#endif
            pg8::gemm_phase<pg8::EpiAct<0, false>, pg8::StaticOrder, true, PG8_SP2V>(lds, g, S, E, wave, lane);
            if (!bgpre) bg_convert<PH>(ws, lds, wave, lane); }
    } else if constexpr (PH == 6 || PH == 15) {
#if defined(ATTN_SIMPLE)
        attn_simple(lds, R0, (const bf16*)(ws + WS_KB + (size_t)layer * 2 * MiB), (const bf16*)(ws + WS_VB + (size_t)layer * 2 * MiB), R0 + (size_t)M * 2048, wave, lane);
#else
        attn_mfma(lds, R0, (const bf16*)(ws + WS_KB + (size_t)layer * 2 * MiB), (const bf16*)(ws + WS_VTB + (size_t)layer * 2 * MiB), R0 + (size_t)M * 2048, wave, lane);
#endif
    }
    else if constexpr (PH == 8 || PH == 17) {
        pg8::Gemm g{XB, (const pg8::bf16_t*)(ws + WS_W_UP + (size_t)layer * 32 * MiB), M, FF, 2048}; pg8::StaticOrder S; S.init(M, FF, G, bx);
        pg8::EpiAct<2, false> E{R0, FF, nullptr, SSQ, 32, 1.0f, nullptr, 0, (LAS float*)(lds + 131072)};
        {
#if defined(BG_CONV)
            const bool bgpre = (blockIdx.x & 1) != 0;
            if (bgpre) { bg_convert<PH>(ws, lds, wave, lane); __syncthreads(); }
#else
            const bool bgpre = true;
#endif
            pg8::gemm_phase<pg8::EpiAct<2, false>, pg8::StaticOrder, true, PG8_SP2V>(lds, g, S, E, wave, lane);
            if (!bgpre) bg_convert<PH>(ws, lds, wave, lane); }
    } else if constexpr (PH == 11) {
#if defined(S5_SIMPLE)
        s5_pass_a(R0, (f32x2*)(ws + WS_S5ST), wave, lane);
#endif
    } else if constexpr (PH == 12) {
#if defined(S5_SIMPLE)
        s5_pass_c(lds, R0, (const f32x2*)(ws + WS_S5ST), R0 + (size_t)M * 2048, wave, lane);
#else
        s5_mfma(lds, R0, R0 + (size_t)M * 2048, wave, lane);
#endif
    }
    else if constexpr (PH == 13) {
        pg8::Gemm g{R0 + (size_t)M * 2048, (const pg8::bf16_t*)(ws + WS_W_BOUT), M, 4096, 2048}; pg8::StaticOrder S; S.init(M, 4096, G, bx);
        pg8::EpiGlu E{XB, SSQ, ka_in(24)};
        pg8::gemm_phase<pg8::EpiGlu, pg8::StaticOrder, true, PG8_SP2V>(lds, g, S, E, wave, lane);
    } else if constexpr (PH == 19) final_norm(XB, SSQ, ka_in(6), X, wave, lane);
}
__device__ __forceinline__ int lane_id() { int l; asm volatile("v_mbcnt_lo_u32_b32 %0, -1, 0\n\tv_mbcnt_hi_u32_b32 %0, -1, %0" : "=v"(l)); return l; }

#define XB_TMO      128
#define XB_XCNT(j)  (256  + 64 * (j))
#define XB_XSUB(j)  (1280 + 64 * (j))
#define XB_XGEN(j)  (2304 + 64 * (j))
#define XB_TOP      3328
#define XB_TOPGEN   3392
#define XCD_BAR_WORDS 3456
#define XB_SPIN_CAP (1u << 22)
__device__ __forceinline__ unsigned xb_ld(unsigned* p)              { return __hip_atomic_load(p, __ATOMIC_RELAXED, __HIP_MEMORY_SCOPE_AGENT); }
__device__ __forceinline__ unsigned xb_add(unsigned* p, unsigned v) { return __hip_atomic_fetch_add(p, v, __ATOMIC_RELAXED, __HIP_MEMORY_SCOPE_AGENT); }
__device__ __forceinline__ unsigned xb_xcc_id() { return (unsigned)__builtin_amdgcn_s_getreg((3 << 11) | 20) & 0xFu; }
#define XB_SPIN(cond, bar) do { unsigned _sp = 0; while (cond) { __builtin_amdgcn_s_sleep(1); \
    if ((++_sp & 255u) == 0u) { if (xb_ld(&(bar)[XB_TMO])) break; if (_sp > XB_SPIN_CAP) { atomicAdd(&(bar)[XB_TMO], 1u); break; } } } } while (0)
__device__ __forceinline__ void xcd_barrier_complete(unsigned* bar, unsigned x, unsigned& nloc, unsigned& nx) {
    const unsigned G = gridDim.x * gridDim.y * gridDim.z;
    unsigned sum, cnt, mine, sp = 0u;
    for (;;) {
        sum = 0u; cnt = 0u; mine = 0u;
#pragma unroll
        for (unsigned j = 0; j < 16; ++j) { const unsigned c = xb_ld(&bar[XB_XCNT(j)]); sum += c; cnt += (c > 0u) ? 1u : 0u; mine = (j == x) ? c : mine; }
        if (sum == G) break;
        __builtin_amdgcn_s_sleep(1);
        if ((++sp & 255u) == 0u) { if (xb_ld(&bar[XB_TMO])) break; if (sp > XB_SPIN_CAP) { atomicAdd(&bar[XB_TMO], 1u); break; } }
    }
    nloc = mine > 0u ? mine : 1u; nx = cnt > 0u ? cnt : 1u;
}
__device__ __forceinline__ void xcd_barrier(unsigned* bar, volatile LAS unsigned* st, bool is_t0) {
    asm volatile("s_waitcnt vmcnt(0)" ::: "memory");
    __syncthreads();
    if (is_t0) {
        __builtin_amdgcn_s_waitcnt(0);
        const unsigned x = xb_xcc_id();
        unsigned nloc = st[0], nx = st[1];
        if (nloc == 0u) { xcd_barrier_complete(bar, x, nloc, nx); st[0] = nloc; st[1] = nx; }
        const unsigned old = xb_add(&bar[XB_XSUB(x)], 1u);
        const unsigned gen = old / nloc;
        if (old + 1u == (gen + 1u) * nloc) {
            __builtin_amdgcn_fence(__ATOMIC_RELEASE, "agent");
            asm volatile("s_waitcnt vmcnt(0)" ::: "memory");
            const unsigned og = xb_add(&bar[XB_TOP], 1u);
            const unsigned tg = og / nx;
            if (og + 1u == (tg + 1u) * nx) xb_add(&bar[XB_TOPGEN], 1u);
            else XB_SPIN(xb_ld(&bar[XB_TOPGEN]) == tg, bar);
            __builtin_amdgcn_fence(__ATOMIC_ACQUIRE, "agent");
            xb_add(&bar[XB_XGEN(x)], 1u);
            asm volatile("s_waitcnt vmcnt(0)" ::: "memory");
        } else {
            XB_SPIN(xb_ld(&bar[XB_XGEN(x)]) == gen, bar);
            __builtin_amdgcn_fence(__ATOMIC_ACQUIRE, "agent");
            asm volatile("s_waitcnt vmcnt(0)" ::: "memory");
        }
    }
    __syncthreads();
}

__global__ void __launch_bounds__(NTHREADS, 2) trunk_fwd(Args args) {
    extern __shared__ __attribute__((aligned(16))) unsigned char lds_raw[];
    LAS unsigned char* lds = (LAS unsigned char*)lds_raw;
    const int wave = __builtin_amdgcn_readfirstlane((int)threadIdx.x >> 6);
    const int lo = args.ph_lo, hi = args.ph_hi;
    unsigned* bar = (unsigned*)args.ws + 4096;
    volatile LAS unsigned* st = (volatile LAS unsigned*)(lds + LDS_BYTES - 512);
#if MK_N_LAUNCHES == 1
    { const int l0 = lane_id(); if (wave == 0 && l0 < 2) st[l0] = 0u; __syncthreads(); if (wave == 0 && l0 == 0) (void)xb_add(&bar[XB_XCNT(xb_xcc_id())], 1u); }
#if defined(USE_CG_SYNC)
#define GRID_BAR(k) do { if ((k) == 1) cg::this_grid().sync(); else xcd_barrier(bar, st, wave == 0 && lane_id() == 0); } while (0)
#else
#define GRID_BAR(k) do { xcd_barrier(bar, st, wave == 0 && lane_id() == 0); } while (0)
#endif
#else
#define GRID_BAR(k) do { } while (0)
#endif
#ifndef DUP_PH
#define DUP_PH -1
#endif
#if defined(PROBE_GEMM)
#if PROBE_GEMM == 3
typedef pg8::StaticOrder ProbeOrder;
#else
struct ProbeOrder { int c;
    __device__ __forceinline__ void init(int, int, int, int c_) { c = c_; }
    __device__ __forceinline__ bool next(int i, pg8::Unit& u) const { if (i >= 4) return false;
#if PROBE_GEMM == 1
        u.pm = 0; u.pn = 0;
#else
        u.pm = c >> 3; u.pn = c & 7;
#endif
        return true; }
    __device__ __forceinline__ void a_ready(const pg8::Unit&) const {}
    __device__ __forceinline__ void done(const pg8::Unit&) const {} };
#endif
#endif
#if defined(STAMP_SEL)
#define STAMP(k) do { if (blockIdx.x == 0 && wave == 0 && lane_id() == 0) st[4 + (k)] = (unsigned)__builtin_amdgcn_s_memrealtime(); } while (0)
#else
#define STAMP(k) do { } while (0)
#endif
#define PHASE(k) if (lo <= (k) && (k) < hi) { if ((k) > lo) GRID_BAR(k); STAMP(k); run_phase<k>(args.ws, args.out, lds, wave, lane_id()); STAMP(50 + (k)); if ((k) == DUP_PH) { GRID_BAR(2); run_phase<k>(args.ws, args.out, lds, wave, lane_id()); } }
    PHASE(0) PHASE(1) PHASE(2) PHASE(3) PHASE(4) PHASE(5) PHASE(6) PHASE(7) PHASE(8) PHASE(9)
#if defined(PROBE_GEMM)
    { GRID_BAR(2); const int lane = lane_id(); unsigned char* ws = args.ws; bf16* R0 = (bf16*)(ws + WS_R);
      pg8::Gemm g{(bf16*)(ws + WS_XB), (const pg8::bf16_t*)(ws + WS_W_UP), M, FF, 2048}; ProbeOrder S; S.init(M, FF, gridDim.x, blockIdx.x);
      pg8::EpiAct<2, false> E{R0, FF, nullptr, (float*)(ws + WS_SSQ), 32, 1.0f, nullptr, 0};
      pg8::gemm_phase<pg8::EpiAct<2, false>, ProbeOrder, true, true>(lds, g, S, E, wave, lane); }
#endif
#if defined(EXTRA_BARS)
    for (int eb = 0; eb < EXTRA_BARS; ++eb) GRID_BAR(2);
#endif
    PHASE(10)
#if defined(S5_SIMPLE)
    PHASE(11)
#endif
    PHASE(12) PHASE(13) PHASE(14) PHASE(15) PHASE(16) PHASE(17) PHASE(18) PHASE(19)
#undef PHASE
#if defined(STAMP_SEL)
    asm volatile("s_waitcnt vmcnt(0)" ::: "memory"); __syncthreads(); STAMP(20);
    if (blockIdx.x == 0 && wave == 0 && lane_id() == 0) { unsigned d = (st[4 + STAMP_SEL_END] - st[4 + STAMP_SEL]); d = (d > 100000u ? 0u : d) * STAMP_MUL; const unsigned t0 = (unsigned)__builtin_amdgcn_s_memrealtime();
        while ((unsigned)__builtin_amdgcn_s_memrealtime() - t0 < d) __builtin_amdgcn_s_sleep(8); }
#endif
}

extern "C" void kernel_launch(void* const* d_in, const int* in_sizes, int n_in, void* d_out, int out_size, void* d_ws, size_t ws_size, hipStream_t stream) {
    static int grid = 0;
    if (grid == 0) {
        if (n_in != 30 || out_size != M * D || ws_size < WS_END) { fprintf(stderr, "kernel_launch: unexpected shapes (n_in %d out %d ws %zu)\n", n_in, out_size, ws_size); grid = -1; return; }
        int dev = 0, cus = 0, per_cu = 0;
        if (hipGetDevice(&dev) != hipSuccess || hipDeviceGetAttribute(&cus, hipDeviceAttributeMultiprocessorCount, dev) != hipSuccess) { grid = -1; return; }
        if (hipFuncSetAttribute((const void*)trunk_fwd, hipFuncAttributeMaxDynamicSharedMemorySize, LDS_BYTES) != hipSuccess) { fprintf(stderr, "kernel_launch: hipFuncSetAttribute failed\n"); grid = -1; return; }
        if (hipOccupancyMaxActiveBlocksPerMultiprocessor(&per_cu, (const void*)trunk_fwd, NTHREADS, LDS_BYTES) != hipSuccess || per_cu < 1) { fprintf(stderr, "kernel_launch: occupancy query says %d\n", per_cu); grid = -1; return; }
        grid = cus;
    }
    if (grid < 0) return;
    if (hipMemsetAsync(d_ws, 0, 65536, stream) != hipSuccess) { fprintf(stderr, "kernel_launch: memset failed\n"); return; }
    Args a{};
    for (int i = 0; i < 30; ++i) a.in[i] = (const float*)d_in[i];
    a.out = (float*)d_out; a.ws = (unsigned char*)d_ws;
#if MK_N_LAUNCHES == 1
    a.ph_lo = 0; a.ph_hi = NPH;
    void* kargs[] = {&a};
    hipError_t e = hipLaunchCooperativeKernel((const void*)trunk_fwd, dim3(grid), dim3(NTHREADS), kargs, LDS_BYTES, stream);
    if (e != hipSuccess) fprintf(stderr, "kernel_launch: cooperative launch failed: %s\n", hipGetErrorString(e));
#else
    for (int ph = 0; ph < NPH; ++ph) { a.ph_lo = ph; a.ph_hi = ph + 1; hipLaunchKernelGGL(trunk_fwd, dim3(grid), dim3(NTHREADS), LDS_BYTES, stream, a); }
#endif
}
```

```cpp
#include <hip/hip_runtime.h>
#include <hip/hip_cooperative_groups.h>
#include <cstdio>
#include <cstdint>
namespace cg = cooperative_groups;
#define MK_N_LAUNCHES 1
namespace pg8 {
#define PG8_LAS __attribute__((address_space(3)))
typedef unsigned short bf16_t;
typedef short bf16x8 __attribute__((ext_vector_type(8)));
typedef float f32x4 __attribute__((ext_vector_type(4)));
typedef unsigned u32x4 __attribute__((ext_vector_type(4)));
constexpr int BM = 256, BK = 64, HALF = 128, HTB = HALF * BK * 2  , STAGE_BYTES = 8 * HTB, NXCD = 8, WGM = 8;

__host__ __device__ __forceinline__ int lds_byte(int r, int c) { const int st = (r >> 4) * 2 + (c >> 5), rr = r & 15, cc = c & 31, ob = rr * 64 + cc * 2; return st * 1024 + (ob ^ (((ob >> 9) & 1) << 5)); }
__host__ __device__ __forceinline__ void stage_rc(int b, int& R, int& C) { const int st = b / 1024, sb = b % 1024, swz = sb ^ (((sb >> 9) & 1) << 5); R = (st >> 1) * 16 + swz / 64; C = (st & 1) * 32 + (swz % 64) / 2; }
__host__ __device__ __forceinline__ int perm32(int rho) { const int n = rho >> 4, i = rho & 15; return 8 * (i >> 2) + 4 * n + (i & 3); }

struct Unit { int pm, pn; };
struct Gemm { const bf16_t* A; const bf16_t* Bt; int M, N, K; };

struct StaticOrder {
    int nM, nN, nwg, G, c;
    __host__ __device__ void init(int M, int N, int G_, int c_) { nM = M / BM; nN = N / BM; nwg = nM * nN; G = G_; c = c_; }
    __host__ __device__ bool next(int i, Unit& u) const {
        const long L = (long)i * G + c; if (L >= nwg) return false;
        int wgid = (int)L; { const int q = nwg / NXCD, r = nwg % NXCD, xcd = wgid % NXCD, off = wgid / NXCD; wgid = (xcd < r ? xcd * (q + 1) : r * (q + 1) + (xcd - r) * q) + off; }
        const int nig = WGM * nN, gid = wgid / nig, fm = gid * WGM, gsz = (nM - fm) < WGM ? (nM - fm) : WGM;
        u.pm = fm + ((wgid % nig) % gsz); u.pn = (wgid % nig) / gsz; return true;
    }
    __device__ __forceinline__ void a_ready(const Unit&) const {}
    __device__ __forceinline__ void done(const Unit&) const {}
};

__device__ __forceinline__ unsigned cvt_pk_bf16(float lo, float hi) { unsigned r; asm volatile("v_cvt_pk_bf16_f32 %0, %1, %2" : "=v"(r) : "v"(lo), "v"(hi)); return r; }
typedef float f32x2 __attribute__((ext_vector_type(2)));
__device__ __forceinline__ f32x2 gelu_pk(f32x2 v) {
    const f32x2 av = __builtin_elementwise_abs(v), d = av * 0.2316418882f + 1.0f;
    f32x2 t; t.x = __builtin_amdgcn_rcpf(d.x); t.y = __builtin_amdgcn_rcpf(d.y);
    f32x2 q = t * 0.5307027145f + (-0.7265760135f); q = q * t + 0.7107068705f; q = q * t + (-0.142248368f); q = q * t + 0.127414796f; q = q * t;
    const f32x2 s = (v * v) * (-0.72134752044f);
    f32x2 e; e.x = __builtin_amdgcn_exp2f(s.x); e.y = __builtin_amdgcn_exp2f(s.y);
    const f32x2 m = v * (q * e), r = v - m;
    f32x2 o; o.x = v.x < 0.f ? m.x : r.x; o.y = v.y < 0.f ? m.y : r.y; return o;
}
typedef unsigned u32x2 __attribute__((ext_vector_type(2)));
#if defined(WT_STORES)
__device__ __forceinline__ void st_wt16(void* p, u32x4 v) { asm volatile("global_store_dwordx4 %0, %1, off sc1\n\ts_nop 1" :: "v"(p), "v"(v) : "memory"); }
__device__ __forceinline__ void st_wt8(void* p, u32x2 v) { asm volatile("global_store_dwordx2 %0, %1, off sc1\n\ts_nop 1" :: "v"(p), "v"(v) : "memory"); }
#else
__device__ __forceinline__ void st_wt16(void* p, u32x4 v) { *(u32x4*)p = v; }
__device__ __forceinline__ void st_wt8(void* p, u32x2 v) { *(u32x2*)p = v; }
#endif
constexpr int SSQ_STRIDE = 64;
__device__ __forceinline__ float row_rstd(const float* ssq, int np, int row, int fq) {
    const float* p = ssq + (size_t)row * SSQ_STRIDE + fq * (np >> 2);
    f32x4 a = *(const f32x4*)p, b = *(const f32x4*)(p + 4);
    float s = (a[0] + a[1]) + (a[2] + a[3]) + (b[0] + b[1]) + (b[2] + b[3]);
    if (np == 64) { f32x4 c = *(const f32x4*)(p + 8), d = *(const f32x4*)(p + 12); s += (c[0] + c[1]) + (c[2] + c[3]) + (d[0] + d[1]) + (d[2] + d[3]); }
    s += __shfl_xor(s, 16); s += __shfl_xor(s, 32);
    return __builtin_amdgcn_rsqf(s * (1.0f / 2048.0f) + 1e-6f);
}
template <int ACT, bool STATS> struct EpiAct {
    static constexpr bool PERM = true, AFTER_DRAIN = false, HAS_PRE = true;
    bf16_t* O; int ldc; const float* bias; const float* ssq; int np; float oscale; float* vst; int stat_pn0; PG8_LAS float* rsl;
    __device__ __forceinline__ void pre_issue(f32x4 (&r)[4], const Unit& u, int tid) const {
        if (tid < 256) { const float* p = ssq + (size_t)(u.pm * BM + tid) * SSQ_STRIDE;
#pragma unroll
            for (int k = 0; k < 4; ++k) r[k] = *(const f32x4*)(p + 4 * k) + *(const f32x4*)(p + 16 + 4 * k);
            if (np == 64) {
#pragma unroll
                for (int k = 0; k < 4; ++k) r[k] += *(const f32x4*)(p + 32 + 4 * k) + *(const f32x4*)(p + 48 + 4 * k); } } }
    __device__ __forceinline__ void pre_commit(const f32x4 (&r)[4], PG8_LAS unsigned char*, int tid) const {
        if (tid < 256) { const f32x4 s4 = (r[0] + r[1]) + (r[2] + r[3]); const float s = (s4[0] + s4[1]) + (s4[2] + s4[3]); rsl[tid] = __builtin_amdgcn_rsqf(s * (1.0f / 2048.0f) + 1e-6f); } }
    __device__ __forceinline__ void operator()(const f32x4 (&acc)[2][2][4][2], const Unit& u, int wr, int wc, int fr, int fq) const {
        const int row0 = u.pm * BM + wr * 64 + fr, col0 = u.pn * BM + wc * 32 + 8 * fq;
        f32x4 bv[2][2];
#pragma unroll
        for (int bj = 0; bj < 2; ++bj)
#pragma unroll
            for (int n = 0; n < 2; ++n) bv[bj][n] = bias ? *(const f32x4*)(bias + col0 + bj * HALF + 4 * n) : (f32x4){0.f, 0.f, 0.f, 0.f};
        float rsv[2][4];
#pragma unroll
        for (int ai = 0; ai < 2; ++ai) {
#pragma unroll
            for (int m = 0; m < 4; ++m) rsv[ai][m] = rsl[ai * HALF + wr * 64 + m * 16 + fr]; }
#pragma unroll
        for (int ai = 0; ai < 2; ++ai)
#pragma unroll
            for (int m = 0; m < 4; ++m) { const int row = row0 + ai * HALF + m * 16; const float rs = rsv[ai][m];
                bf16_t* rowp = O + (size_t)row * ldc + col0; float s1 = 0.f, s2 = 0.f;
#pragma unroll
                for (int bj = 0; bj < 2; ++bj) { f32x4 v0 = acc[ai][bj][m][0] * rs + bv[bj][0], v1 = acc[ai][bj][m][1] * rs + bv[bj][1];
                    if (ACT == 1) { f32x2 a = gelu_pk((f32x2){v0[0], v0[1]}), b = gelu_pk((f32x2){v0[2], v0[3]}), c = gelu_pk((f32x2){v1[0], v1[1]}), d = gelu_pk((f32x2){v1[2], v1[3]});
                        v0 = (f32x4){a.x, a.y, b.x, b.y}; v1 = (f32x4){c.x, c.y, d.x, d.y}; }
                    if (ACT == 2) {
#pragma unroll
                        for (int j = 0; j < 4; ++j) { const float a = fmaxf(v0[j], 0.f), b = fmaxf(v1[j], 0.f); v0[j] = a * a; v1[j] = b * b; } }
                    v0 = v0 * oscale; v1 = v1 * oscale;
                    if (STATS) { s1 += (v0[0] + v0[1]) + (v0[2] + v0[3]) + (v1[0] + v1[1]) + (v1[2] + v1[3]);
                        s2 += (v0[0] * v0[0] + v0[1] * v0[1]) + (v0[2] * v0[2] + v0[3] * v0[3]) + (v1[0] * v1[0] + v1[1] * v1[1]) + (v1[2] * v1[2] + v1[3] * v1[3]); }
                    u32x4 w; w.x = cvt_pk_bf16(v0[0], v0[1]); w.y = cvt_pk_bf16(v0[2], v0[3]); w.z = cvt_pk_bf16(v1[0], v1[1]); w.w = cvt_pk_bf16(v1[2], v1[3]);
                    st_wt16(rowp + bj * HALF, w); }
                if (STATS) { s1 += __shfl_xor(s1, 16); s1 += __shfl_xor(s1, 32); s2 += __shfl_xor(s2, 16); s2 += __shfl_xor(s2, 32);
                    if (u.pn >= stat_pn0 && fq == 0) *(f32x2*)(vst + (size_t)row * SSQ_STRIDE + ((u.pn - stat_pn0) * 4 + wc) * 2) = (f32x2){s1, s2}; }
            }
    }
};
struct EpiRes {
    static constexpr bool PERM = true, AFTER_DRAIN = false, HAS_PRE = false;
    bf16_t* xb; float* ssq;
    __device__ __forceinline__ void operator()(const f32x4 (&acc)[2][2][4][2], const Unit& u, int wr, int wc, int fr, int fq) const {
        const int row0 = u.pm * BM + wr * 64 + fr, col0 = u.pn * BM + wc * 32 + 8 * fq;
        u32x4 pre[2][4][2];
#pragma unroll
        for (int ai = 0; ai < 2; ++ai)
#pragma unroll
            for (int m = 0; m < 4; ++m) { const size_t off = (size_t)(row0 + ai * HALF + m * 16) * 2048 + col0;
#pragma unroll
                for (int bj = 0; bj < 2; ++bj) pre[ai][m][bj] = *(const u32x4*)(xb + off + bj * HALF); }
        asm volatile("" ::: "memory");
#pragma unroll
        for (int ai = 0; ai < 2; ++ai) {
#pragma unroll
            for (int m = 0; m < 4; ++m) { const int row = row0 + ai * HALF + m * 16; const size_t off = (size_t)row * 2048 + col0; float ss = 0.f;
#pragma unroll
                for (int bj = 0; bj < 2; ++bj) { const u32x4 b = pre[ai][m][bj]; const f32x4 a0 = acc[ai][bj][m][0], a1 = acc[ai][bj][m][1];
                    const float o0 = __builtin_bit_cast(float, b.x << 16) + a0[0], o1 = __builtin_bit_cast(float, b.x & 0xffff0000u) + a0[1], o2 = __builtin_bit_cast(float, b.y << 16) + a0[2], o3 = __builtin_bit_cast(float, b.y & 0xffff0000u) + a0[3];
                    const float o4 = __builtin_bit_cast(float, b.z << 16) + a1[0], o5 = __builtin_bit_cast(float, b.z & 0xffff0000u) + a1[1], o6 = __builtin_bit_cast(float, b.w << 16) + a1[2], o7 = __builtin_bit_cast(float, b.w & 0xffff0000u) + a1[3];
                    ss += (o0 * o0 + o1 * o1) + (o2 * o2 + o3 * o3) + (o4 * o4 + o5 * o5) + (o6 * o6 + o7 * o7);
                    u32x4 w; w.x = cvt_pk_bf16(o0, o1); w.y = cvt_pk_bf16(o2, o3); w.z = cvt_pk_bf16(o4, o5); w.w = cvt_pk_bf16(o6, o7); st_wt16(xb + off + bj * HALF, w); }
                ss += __shfl_xor(ss, 16); ss += __shfl_xor(ss, 32);
                if (fq == 0) ssq[(size_t)row * SSQ_STRIDE + u.pn * 4 + wc] = ss; }
            asm volatile("" ::: "memory"); }
    }
};
struct EpiGlu {
    static constexpr bool PERM = false, AFTER_DRAIN = false, HAS_PRE = false;
    bf16_t* xb; float* ssq; const float* bias;
    __device__ __forceinline__ void operator()(const f32x4 (&acc)[2][2][4][2], const Unit& u, int wr, int wc, int fr, int fq) const {
        const int row0 = u.pm * BM + wr * 64 + fr, col0 = u.pn * 128 + wc * 16 + 4 * fq;
        f32x4 bval[2], bgate[2];
#pragma unroll
        for (int bj = 0; bj < 2; ++bj) { bval[bj] = *(const f32x4*)(bias + col0 + bj * 64); bgate[bj] = *(const f32x4*)(bias + 2048 + col0 + bj * 64); }
#pragma unroll
        for (int ai = 0; ai < 2; ++ai) {
            u32x2 pre[4][2];
#pragma unroll
            for (int m = 0; m < 4; ++m) { const size_t off = (size_t)(row0 + ai * HALF + m * 16) * 2048 + col0;
#pragma unroll
                for (int bj = 0; bj < 2; ++bj) pre[m][bj] = *(const u32x2*)(xb + off + bj * 64); }
            asm volatile("" ::: "memory");
#pragma unroll
            for (int m = 0; m < 4; ++m) { const int row = row0 + ai * HALF + m * 16; const size_t off = (size_t)row * 2048 + col0; float ss = 0.f;
#pragma unroll
                for (int bj = 0; bj < 2; ++bj) { const f32x4 val = acc[ai][bj][m][0] + bval[bj], gate = acc[ai][bj][m][1] + bgate[bj]; const u32x2 pb = pre[m][bj]; f32x4 o = (f32x4){__builtin_bit_cast(float, pb.x << 16), __builtin_bit_cast(float, pb.x & 0xffff0000u), __builtin_bit_cast(float, pb.y << 16), __builtin_bit_cast(float, pb.y & 0xffff0000u)};
#pragma unroll
                    for (int j = 0; j < 4; ++j) { const float sg = __builtin_amdgcn_rcpf(1.0f + __builtin_amdgcn_exp2f(-1.4426950408889634f * gate[j])); o[j] += val[j] * sg; }
                    ss += (o[0] * o[0] + o[1] * o[1]) + (o[2] * o[2] + o[3] * o[3]);
                    u32x2 w; w.x = cvt_pk_bf16(o[0], o[1]); w.y = cvt_pk_bf16(o[2], o[3]); st_wt8(xb + off + bj * 64, w); }
                ss += __shfl_xor(ss, 16); ss += __shfl_xor(ss, 32);
                if (fq == 0) ssq[(size_t)row * SSQ_STRIDE + u.pn * 4 + wc] = ss; }
            asm volatile("" ::: "memory"); }
    }
};
__host__ __device__ __forceinline__ int vt_pos(int key) { const int s = key >> 5, w = key & 31; return 32 * s + 8 * ((w & 15) >> 2) + (w & 3) + 4 * (w >> 4); }
struct EpiKV {
    static constexpr bool PERM = true, AFTER_DRAIN = false, HAS_PRE = false;
    bf16_t* Kb; bf16_t* Vb; bf16_t* VTb; const float* ssq;
    __device__ __forceinline__ void operator()(const f32x4 (&acc)[2][2][4][2], const Unit& u, int wr, int wc, int fr, int fq) const {
        const int row0 = u.pm * BM + wr * 64 + fr, col0 = u.pn * BM + wc * 32 + 8 * fq;
#pragma unroll
        for (int ai = 0; ai < 2; ++ai)
#pragma unroll
            for (int m = 0; m < 4; ++m) { const int row = row0 + ai * HALF + m * 16; const float rs = row_rstd(ssq, 32, row, fq); const int b = row >> 8, key = row & 255;
#pragma unroll
                for (int bj = 0; bj < 2; ++bj) { const f32x4 v0 = acc[ai][bj][m][0] * rs, v1 = acc[ai][bj][m][1] * rs; const int col = col0 + bj * HALF;
                    u32x4 w; w.x = cvt_pk_bf16(v0[0], v0[1]); w.y = cvt_pk_bf16(v0[2], v0[3]); w.z = cvt_pk_bf16(v1[0], v1[1]); w.w = cvt_pk_bf16(v1[2], v1[3]);
                    if (col < 2048) { const int h = col >> 9, d = col & 511; *(u32x4*)(Kb + ((size_t)((b * 4 + h) * 256 + key)) * 512 + d) = w; }
                    else { const int c2 = col - 2048, h = c2 >> 9, d = c2 & 511; *(u32x4*)(Vb + ((size_t)((b * 4 + h) * 256 + key)) * 512 + d) = w;
                        bf16_t* vt = VTb + ((size_t)((b * 4 + h) * 512 + d)) * 256 + vt_pos(key);
                        vt[0 * 256] = (bf16_t)(w.x & 0xffffu); vt[1 * 256] = (bf16_t)(w.x >> 16); vt[2 * 256] = (bf16_t)(w.y & 0xffffu); vt[3 * 256] = (bf16_t)(w.y >> 16);
                        vt[4 * 256] = (bf16_t)(w.z & 0xffffu); vt[5 * 256] = (bf16_t)(w.z >> 16); vt[6 * 256] = (bf16_t)(w.w & 0xffffu); vt[7 * 256] = (bf16_t)(w.w >> 16); } }
            }
    }
};
template <class Epi, class Sched, bool ALIGN_EPI = false, bool SP2 = false>
__device__ __forceinline__ void gemm_phase(PG8_LAS unsigned char* lds, const Gemm g, const Sched& S, const Epi& E, const int wid  , const int lane) {
    const int tid = wid * 64 + lane, wr = wid >> 2, wc = wid & 3, fr = lane & 15, fq = lane >> 4;
    const int K = g.K, nt = K / BK;
    unsigned voffA[2], voffB[2];
#pragma unroll
    for (int i = 0; i < 2; ++i) { int R, C; stage_rc(tid * 16 + i * 8192, R, C); const int Rb = Epi::PERM ? ((R & ~31) + perm32(R & 31)) : R;
        voffA[i] = (unsigned)(R * K + C) * 2u; voffB[i] = (unsigned)(Rb * K + C) * 2u; }
    const size_t kstep = (size_t)(BK * 2);
    const size_t hstep = (size_t)HALF * K * 2;
    const size_t tstep = 2 * hstep;
    const unsigned ldsw = (unsigned)wid * 1024u;
    const int aoff = lds_byte(wr * 64 + fr, fq * 8), boff = lds_byte(wc * 32 + fr, fq * 8);
#define PG8_SA(b, h) (((b) * 2 + (h)) * HTB)
#define PG8_SB(b, h) ((4 + (b) * 2 + (h)) * HTB)
#define PG8_STAGE(bufoff, gbase, voff) do { _Pragma("unroll") for (int _i = 0; _i < 2; ++_i) \
        __builtin_amdgcn_global_load_lds((const unsigned*)((const char*)(gbase) + (voff)[_i]), (PG8_LAS unsigned*)(lds + (bufoff) + ldsw + _i * 8192), 16, 0, 0); } while (0)
#define PG8_LDA(dst, b, h) do { _Pragma("unroll") for (int m = 0; m < 4; ++m) _Pragma("unroll") for (int k = 0; k < 2; ++k) dst[m][k] = *(const PG8_LAS bf16x8*)(lds + PG8_SA(b, h) + aoff + m * 2048 + k * 1024); } while (0)
#define PG8_LDB(dst, b, h) do { _Pragma("unroll") for (int n = 0; n < 2; ++n) _Pragma("unroll") for (int k = 0; k < 2; ++k) dst[n][k] = *(const PG8_LAS bf16x8*)(lds + PG8_SB(b, h) + boff + n * 2048 + k * 1024); } while (0)
#define PG8_MMA(ai, bj, At, Bt) do { __builtin_amdgcn_s_setprio(1); _Pragma("unroll") for (int m = 0; m < 4; ++m) _Pragma("unroll") for (int n = 0; n < 2; ++n) _Pragma("unroll") for (int k = 0; k < 2; ++k) \
        acc[ai][bj][m][n] = __builtin_amdgcn_mfma_f32_16x16x32_bf16(Bt[n][k], At[m][k], acc[ai][bj][m][n], 0, 0, 0); __builtin_amdgcn_s_setprio(0); } while (0)
#define PG8_WAIT_V(n) asm volatile("s_waitcnt vmcnt(" #n ")" ::: "memory")
#define PG8_WAIT_L(n) asm volatile("s_waitcnt lgkmcnt(" #n ")" ::: "memory")
#define PG8_BAR __builtin_amdgcn_s_barrier()
#define PG8_SCHED __builtin_amdgcn_sched_barrier(0)
    Unit cur, nxt; int ui = 0;
    if (!S.next(0, cur)) return;
    f32x4 acc[2][2][4][2];
#pragma unroll
    for (int a = 0; a < 2; ++a)
#pragma unroll
        for (int b = 0; b < 2; ++b)
#pragma unroll
            for (int m = 0; m < 4; ++m)
#pragma unroll
                for (int n = 0; n < 2; ++n) acc[a][b][m][n] = (f32x4){0.f, 0.f, 0.f, 0.f};
    bf16x8 At[4][2], B0[2][2], B1[2][2];
    const char* cA = (const char*)g.A + (size_t)cur.pm * tstep; const char* cB = (const char*)g.Bt + (size_t)cur.pn * tstep;
    S.a_ready(cur);
    f32x4 prereg[4]; if constexpr (Epi::HAS_PRE) E.pre_issue(prereg, cur, tid);
    if constexpr (SP2) {
        PG8_STAGE(PG8_SB(0, 0), cB, voffB); PG8_STAGE(PG8_SB(0, 1), cB + hstep, voffB); PG8_STAGE(PG8_SA(0, 0), cA, voffA); PG8_STAGE(PG8_SA(0, 1), cA + hstep, voffA);
        if (wr == 1) PG8_BAR;
        PG8_WAIT_V(2); PG8_BAR;
        PG8_STAGE(PG8_SB(1, 0), cB + kstep, voffB); PG8_STAGE(PG8_SA(1, 0), cA + kstep, voffA); PG8_STAGE(PG8_SB(1, 1), cB + hstep + kstep, voffB);
        PG8_WAIT_V(6); PG8_BAR;
        if constexpr (Epi::HAS_PRE) E.pre_commit(prereg, lds, tid);
    } else {
        PG8_STAGE(PG8_SB(0, 0), cB, voffB); PG8_STAGE(PG8_SA(0, 0), cA, voffA); PG8_STAGE(PG8_SB(0, 1), cB + hstep, voffB); PG8_STAGE(PG8_SA(0, 1), cA + hstep, voffA);
        if (wr == 1) PG8_BAR;
        PG8_WAIT_V(4); PG8_BAR;
        PG8_STAGE(PG8_SB(1, 0), cB + kstep, voffB); PG8_STAGE(PG8_SA(1, 0), cA + kstep, voffA); PG8_STAGE(PG8_SB(1, 1), cB + hstep + kstep, voffB);
        PG8_WAIT_V(6); PG8_BAR;
    }
    for (;;) {
        const bool has_next = S.next(ui + 1, nxt);
        const char* nA = has_next ? (const char*)g.A + (size_t)nxt.pm * tstep : cA; const char* nB = has_next ? (const char*)g.Bt + (size_t)nxt.pn * tstep : cB;
        for (int t = 0; t < nt; t += 2) {
            const bool last = (t == nt - 2);
            const char* a1 = cA + (size_t)(t + 1) * kstep;
            const char* a2 = last ? nA : cA + (size_t)(t + 2) * kstep; const char* b2 = last ? nB : cB + (size_t)(t + 2) * kstep;
            const char* a3 = a2 + kstep; const char* b3 = b2 + kstep;
            if (last && has_next) S.a_ready(nxt);
            if constexpr (SP2) {
            PG8_LDB(B0, 0, 0); PG8_LDB(B1, 0, 1); PG8_SCHED; PG8_LDA(At, 0, 0); PG8_STAGE(PG8_SA(1, 1), a1 + hstep, voffA);
            PG8_WAIT_V(8); PG8_WAIT_L(0); PG8_BAR; PG8_MMA(0, 0, At, B0); PG8_MMA(0, 1, At, B1); PG8_BAR; PG8_SCHED;
            PG8_LDA(At, 0, 1); PG8_STAGE(PG8_SB(0, 0), b2, voffB); PG8_STAGE(PG8_SB(0, 1), b2 + hstep, voffB); PG8_STAGE(PG8_SA(0, 0), a2, voffA);
            PG8_WAIT_V(8); PG8_WAIT_L(0); PG8_BAR; PG8_MMA(1, 0, At, B0); PG8_MMA(1, 1, At, B1); PG8_BAR; PG8_SCHED;
            PG8_LDB(B0, 1, 0); PG8_LDB(B1, 1, 1); PG8_SCHED; PG8_LDA(At, 1, 0); PG8_STAGE(PG8_SA(0, 1), a2 + hstep, voffA);
            PG8_WAIT_V(8); PG8_WAIT_L(0); PG8_BAR; PG8_MMA(0, 0, At, B0); PG8_MMA(0, 1, At, B1); PG8_BAR; PG8_SCHED;
            PG8_LDA(At, 1, 1); PG8_STAGE(PG8_SB(1, 0), b3, voffB); PG8_STAGE(PG8_SB(1, 1), b3 + hstep, voffB); PG8_STAGE(PG8_SA(1, 0), a3, voffA);
            PG8_WAIT_V(8); PG8_WAIT_L(0); PG8_BAR; PG8_MMA(1, 0, At, B0); PG8_MMA(1, 1, At, B1); PG8_BAR; PG8_SCHED;
            } else {
            PG8_LDB(B0, 0, 0); PG8_SCHED; PG8_LDA(At, 0, 0); PG8_STAGE(PG8_SA(1, 1), a1 + hstep, voffA);
            PG8_WAIT_L(8); PG8_BAR; PG8_WAIT_L(0); PG8_MMA(0, 0, At, B0); PG8_BAR; PG8_SCHED;
            PG8_LDB(B1, 0, 1); PG8_STAGE(PG8_SB(0, 0), b2, voffB);
            PG8_BAR; PG8_WAIT_L(0); PG8_MMA(0, 1, At, B1); PG8_BAR;
            PG8_LDA(At, 0, 1); PG8_STAGE(PG8_SA(0, 0), a2, voffA);
            PG8_BAR; PG8_WAIT_L(0); PG8_MMA(1, 0, At, B0); PG8_BAR; PG8_SCHED;
            PG8_STAGE(PG8_SB(0, 1), b2 + hstep, voffB);
            PG8_WAIT_V(6); PG8_BAR; PG8_MMA(1, 1, At, B1); PG8_BAR;
            PG8_LDB(B0, 1, 0); PG8_SCHED; PG8_LDA(At, 1, 0); PG8_STAGE(PG8_SA(0, 1), a2 + hstep, voffA);
            PG8_WAIT_L(8); PG8_BAR; PG8_WAIT_L(0); PG8_MMA(0, 0, At, B0); PG8_BAR; PG8_SCHED;
            PG8_LDB(B1, 1, 1); PG8_STAGE(PG8_SB(1, 0), b3, voffB);
            PG8_BAR; PG8_WAIT_L(0); PG8_MMA(0, 1, At, B1); PG8_BAR;
            PG8_LDA(At, 1, 1); PG8_STAGE(PG8_SA(1, 0), a3, voffA);
            PG8_BAR; PG8_WAIT_L(0); PG8_MMA(1, 0, At, B0); PG8_BAR; PG8_SCHED;
            PG8_STAGE(PG8_SB(1, 1), b3 + hstep, voffB);
            PG8_WAIT_V(6); PG8_BAR; PG8_MMA(1, 1, At, B1); PG8_BAR;
            }
        }
        if constexpr (ALIGN_EPI) { if (wr == 0) PG8_BAR; }
        if constexpr (!Epi::AFTER_DRAIN) { Unit ue = cur; asm volatile("" : "+s"(ue.pm), "+s"(ue.pn));
            int fre = fr, fqe = fq; asm volatile("" : "+v"(fre), "+v"(fqe)); E(acc, ue, wr, wc, fre, fqe); S.done(cur); }
        if (!has_next) break;
#pragma unroll
        for (int a = 0; a < 2; ++a)
#pragma unroll
            for (int b = 0; b < 2; ++b)
#pragma unroll
                for (int m = 0; m < 4; ++m)
#pragma unroll
                    for (int n = 0; n < 2; ++n) acc[a][b][m][n] = (f32x4){0.f, 0.f, 0.f, 0.f};
        cur = nxt; cA = nA; cB = nB; ++ui;
        if constexpr (ALIGN_EPI) { if (wr == 1) PG8_BAR; }
    }
    PG8_WAIT_V(0);
    if constexpr (!ALIGN_EPI) { if (wr == 0) PG8_BAR; }
    PG8_BAR;
    if constexpr (Epi::AFTER_DRAIN) { E.fused(acc, cur, wr, wc, fr, fq, lds, wid, lane); S.done(cur); }
#undef PG8_SA
#undef PG8_SB
#undef PG8_STAGE
#undef PG8_LDA
#undef PG8_LDB
#undef PG8_MMA
#undef PG8_WAIT_V
#undef PG8_WAIT_L
#undef PG8_BAR
#undef PG8_SCHED
}
}
#ifndef PG8_SP2V
#define PG8_SP2V true
#endif
#ifndef PG8_ALIGNV
#define PG8_ALIGNV true
#endif
#ifndef MK_N_LAUNCHES
#define MK_N_LAUNCHES 1
#endif
constexpr int BATCH = 2, SEQ = 4096, D = 2048, M = BATCH * SEQ, MEMLEN = 256, MROWS = BATCH * MEMLEN, FF = 8192;
constexpr int NWAVES = 8, NTHREADS = 512, NPH = 20;
constexpr int LDS_BYTES = 147456;
constexpr size_t MiB = 1u << 20;
constexpr size_t WS_W_AIN = 2 * MiB, WS_W_AOUT = 18 * MiB, WS_W_BIN = 26 * MiB, WS_W_BOUT = 34 * MiB, WS_W_Q = 50 * MiB, WS_W_KV = 66 * MiB, WS_W_O = 98 * MiB, WS_W_UP = 114 * MiB, WS_W_DN = 178 * MiB;
constexpr size_t WS_XB = 242 * MiB, WS_MEMB = 274 * MiB, WS_KB = 276 * MiB, WS_VB = 280 * MiB, WS_VTB = 284 * MiB, WS_SSQ = 288 * MiB, WS_VST = 290 * MiB, WS_SSQM = 292 * MiB, WS_S5ST = 294 * MiB;
constexpr size_t WS_R = 304 * MiB, WS_END = 432 * MiB;
#define GAS __attribute__((address_space(1)))
#define LAS __attribute__((address_space(3)))
typedef unsigned short bf16;
typedef unsigned v4u __attribute__((ext_vector_type(4)));
typedef unsigned v2u __attribute__((ext_vector_type(2)));
typedef float f32x4 __attribute__((ext_vector_type(4)));
typedef float f32x2 __attribute__((ext_vector_type(2)));
typedef short bf16x8 __attribute__((ext_vector_type(8)));
#define LDS_WAIT() asm volatile("s_waitcnt lgkmcnt(0)" ::: "memory")
#if defined(NT_ACT)
#define NTL(p) __builtin_nontemporal_load(p)
#else
#define NTL(p) (*(p))
#endif
#if defined(NT_OUT)
#define NTS(v, p) __builtin_nontemporal_store((v), (p))
#else
#define NTS(v, p) (*(p) = (v))
#endif
__device__ __forceinline__ unsigned f2bf(float f) { unsigned u = __builtin_bit_cast(unsigned, f); return (u + 0x7fffu + ((u >> 16) & 1u)) >> 16; }
__device__ __forceinline__ unsigned pk2(float lo, float hi) { return f2bf(lo) | (f2bf(hi) << 16); }
__device__ __forceinline__ float bflo(unsigned w) { return __builtin_bit_cast(float, w << 16); }
__device__ __forceinline__ float bfhi(unsigned w) { return __builtin_bit_cast(float, w & 0xffff0000u); }
__device__ __forceinline__ float wave_sum(float v) {
#pragma unroll
    for (int o = 1; o < 64; o <<= 1) v += __shfl_xor(v, o);
    return v;
}
__device__ __forceinline__ float wave_max(float v) {
#pragma unroll
    for (int o = 1; o < 64; o <<= 1) v = fmaxf(v, __shfl_xor(v, o));
    return v;
}
__device__ __forceinline__ float gelu_exact(float v) { return 0.5f * v * (1.0f + erff(v * 0.70710678118654752f)); }

struct Args { const float* in[30]; float* out; unsigned char* ws; int ph_lo, ph_hi; };
__device__ __forceinline__ const float* ka_in(int i) { const __attribute__((address_space(4))) char* ka = (const __attribute__((address_space(4))) char*)__builtin_amdgcn_kernarg_segment_ptr(); asm volatile("" : "+s"(ka)); return *(const float* const __attribute__((address_space(4)))*)(ka + 8 * i); }

#if defined(STAMP_SEL)
#define STAMP2(lds_, id) do { __syncthreads(); if (blockIdx.x == 0 && wave == 0 && lane_id2() == 0) ((volatile LAS unsigned*)((lds_) + LDS_BYTES - 512))[4 + (id)] = (unsigned)__builtin_amdgcn_s_memrealtime(); } while (0)
__device__ __forceinline__ int lane_id2() { int l; asm volatile("v_mbcnt_lo_u32_b32 %0, -1, 0\n\tv_mbcnt_hi_u32_b32 %0, -1, %0" : "=v"(l)); return l; }
#else
#define STAMP2(lds_, id) do { } while (0)
#endif
__device__ __forceinline__ int glu_rowmap(int n) { return n < 2048 ? 32 * (n >> 4) + (n & 15) : 32 * ((n - 2048) >> 4) + 16 + (n & 15); }
struct ConvSel { const float* W; const float* g; bf16* WT; int K, N, mode, item; };
__device__ __forceinline__ ConvSel conv_select(unsigned char* ws, int r) {
    ConvSel s; s.g = nullptr; s.K = 2048; s.N = 2048; s.mode = 0;
    if (r < 2048) { s.W = ka_in(7); s.g = ka_in(2); s.WT = (bf16*)(ws + WS_W_AIN); s.N = 4096; }
    else if ((r -= 2048) < 1024) { s.W = ka_in(13); s.WT = (bf16*)(ws + WS_W_AOUT); }
    else if ((r -= 1024) < 1024) { s.W = ka_in(14); s.g = ka_in(2) + 2048; s.WT = (bf16*)(ws + WS_W_BIN); }
    else if ((r -= 1024) < 2048) { s.W = ka_in(23); s.WT = (bf16*)(ws + WS_W_BOUT); s.N = 4096; s.mode = 1; }
    else if ((r -= 2048) < 2048) { const int i = r >> 10; r &= 1023; s.W = ka_in(25) + (size_t)i * 2048 * 2048; s.g = ka_in(3) + i * 2048; s.WT = (bf16*)(ws + WS_W_Q + i * 8 * MiB); }
    else if ((r -= 2048) < 4096) { const int i = r >> 11; r &= 2047; s.W = ka_in(26) + (size_t)i * 2048 * 4096; s.g = ka_in(4) + i * 2048; s.WT = (bf16*)(ws + WS_W_KV + i * 16 * MiB); s.N = 4096; }
    else if ((r -= 4096) < 2048) { const int i = r >> 10; r &= 1023; s.W = ka_in(27) + (size_t)i * 2048 * 2048; s.WT = (bf16*)(ws + WS_W_O + i * 8 * MiB); }
    else if ((r -= 2048) < 8192) { const int i = r >> 12; r &= 4095; s.W = ka_in(28) + (size_t)i * 2048 * 8192; s.g = ka_in(5) + i * 2048; s.WT = (bf16*)(ws + WS_W_UP + i * 32 * MiB); s.N = 8192; }
    else { r -= 8192; const int i = r >> 12; r &= 4095; s.W = ka_in(29) + (size_t)i * 8192 * 2048; s.WT = (bf16*)(ws + WS_W_DN + i * 32 * MiB); s.K = 8192; }
    s.item = r; return s;
}
#if defined(CONV_WIDE)
__device__ __forceinline__ void conv_load(const ConvSel& s, f32x4 (&v)[16], int lane) {
    const int nblk = s.N >> 7, kb = s.item / nblk, nb = s.item - kb * nblk, k0 = 32 * kb, n0 = 128 * nb;
#pragma unroll
    for (int i = 0; i < 16; ++i) { const int kk = 2 * i + (lane >> 5); v[i] = *(const f32x4*)(s.W + (size_t)(k0 + kk) * s.N + n0 + 4 * (lane & 31)); }
}
__device__ __forceinline__ void conv_finish(const ConvSel& s, const f32x4 (&v)[16], LAS float* scr, int lane) {
    const int nblk = s.N >> 7, kb = s.item / nblk, nb = s.item - kb * nblk, k0 = 32 * kb, n0 = 128 * nb;
#pragma unroll
    for (int i = 0; i < 16; ++i) { const int kk = 2 * i + (lane >> 5); const float sc = s.g ? s.g[k0 + kk] : 1.0f; LAS float* d = scr + kk * 129 + 4 * (lane & 31);
        d[0] = v[i][0] * sc; d[1] = v[i][1] * sc; d[2] = v[i][2] * sc; d[3] = v[i][3] * sc; }
    LDS_WAIT();
    const int c = lane & 3;
#pragma unroll
    for (int j = 0; j < 8; ++j) { const int n = (lane >> 2) + 16 * j; const LAS float* sp = scr + (8 * c) * 129 + n;
        v4u o; o.x = pk2(sp[0 * 129], sp[1 * 129]); o.y = pk2(sp[2 * 129], sp[3 * 129]); o.z = pk2(sp[4 * 129], sp[5 * 129]); o.w = pk2(sp[6 * 129], sp[7 * 129]);
        const int nr = s.mode ? glu_rowmap(n0 + n) : (n0 + n);
        *(v4u*)(s.WT + (size_t)nr * s.K + k0 + 8 * c) = o; }
    LDS_WAIT();
}
#elif defined(CONV_TALL)
__device__ __forceinline__ void conv_load(const ConvSel& s, f32x4 (&v)[16], int lane) {
    const int nblk = s.N >> 5, kb = s.item / nblk, nb = s.item - kb * nblk, k0 = 128 * kb, n0 = 32 * nb;
#pragma unroll
    for (int i = 0; i < 16; ++i) { const int kk = 8 * i + (lane >> 3); v[i] = *(const f32x4*)(s.W + (size_t)(k0 + kk) * s.N + n0 + 4 * (lane & 7)); }
}
__device__ __forceinline__ void conv_finish(const ConvSel& s, const f32x4 (&v)[16], LAS float* scr, int lane) {
    const int nblk = s.N >> 5, kb = s.item / nblk, nb = s.item - kb * nblk, k0 = 128 * kb, n0 = 32 * nb;
#pragma unroll
    for (int i = 0; i < 16; ++i) { const int kk = 8 * i + (lane >> 3); const float sc = s.g ? s.g[k0 + kk] : 1.0f; LAS float* d = scr + kk * 33 + 4 * (lane & 7);
        d[0] = v[i][0] * sc; d[1] = v[i][1] * sc; d[2] = v[i][2] * sc; d[3] = v[i][3] * sc; }
    LDS_WAIT();
    const int c = lane & 15;
#pragma unroll
    for (int j = 0; j < 8; ++j) { const int n = (lane >> 4) + 4 * j; const LAS float* sp = scr + (8 * c) * 33 + n;
        v4u o; o.x = pk2(sp[0 * 33], sp[1 * 33]); o.y = pk2(sp[2 * 33], sp[3 * 33]); o.z = pk2(sp[4 * 33], sp[5 * 33]); o.w = pk2(sp[6 * 33], sp[7 * 33]);
        const int nr = s.mode ? glu_rowmap(n0 + n) : (n0 + n);
        *(v4u*)(s.WT + (size_t)nr * s.K + k0 + 8 * c) = o; }
    LDS_WAIT();
}
#else
__device__ __forceinline__ void conv_load(const ConvSel& s, f32x4 (&v)[16], int lane) {
#if defined(CONV_KMAJOR)
    const int kblk = s.K >> 6, nb = s.item / kblk, kb = s.item - nb * kblk, k0 = 64 * kb, n0 = 64 * nb;
#else
    const int nblk = s.N >> 6, kb = s.item / nblk, nb = s.item - kb * nblk, k0 = 64 * kb, n0 = 64 * nb;
#endif
#pragma unroll
#if !defined(CONV_NO_NT)
    for (int i = 0; i < 16; ++i) { const int kk = 4 * i + (lane >> 4); v[i] = __builtin_nontemporal_load((const f32x4*)(s.W + (size_t)(k0 + kk) * s.N + n0 + 4 * (lane & 15))); }
#else
    for (int i = 0; i < 16; ++i) { const int kk = 4 * i + (lane >> 4); v[i] = *(const f32x4*)(s.W + (size_t)(k0 + kk) * s.N + n0 + 4 * (lane & 15)); }
#endif
}
__device__ __forceinline__ void conv_finish(const ConvSel& s, const f32x4 (&v)[16], LAS float* scr, int lane) {
#if defined(CONV_KMAJOR)
    const int kblk = s.K >> 6, nb = s.item / kblk, kb = s.item - nb * kblk, k0 = 64 * kb, n0 = 64 * nb;
#else
    const int nblk = s.N >> 6, kb = s.item / nblk, nb = s.item - kb * nblk, k0 = 64 * kb, n0 = 64 * nb;
#endif
#pragma unroll
    for (int i = 0; i < 16; ++i) { const int kk = 4 * i + (lane >> 4); const float sc = s.g ? s.g[k0 + kk] : 1.0f; LAS float* d = scr + kk * 65 + 4 * (lane & 15);
        d[0] = v[i][0] * sc; d[1] = v[i][1] * sc; d[2] = v[i][2] * sc; d[3] = v[i][3] * sc; }
    LDS_WAIT();
    const int c = lane & 7;
#pragma unroll
    for (int j = 0; j < 8; ++j) { const int n = (lane >> 3) + 8 * j; const LAS float* sp = scr + (8 * c) * 65 + n;
        v4u o; o.x = pg8::cvt_pk_bf16(sp[0 * 65], sp[1 * 65]); o.y = pg8::cvt_pk_bf16(sp[2 * 65], sp[3 * 65]); o.z = pg8::cvt_pk_bf16(sp[4 * 65], sp[5 * 65]); o.w = pg8::cvt_pk_bf16(sp[6 * 65], sp[7 * 65]);
        const int nr = s.mode ? glu_rowmap(n0 + n) : (n0 + n);
#if defined(CONV_NT_ST)
        __builtin_nontemporal_store(o, (v4u*)(s.WT + (size_t)nr * s.K + k0 + 8 * c)); }
#else
        *(v4u*)(s.WT + (size_t)nr * s.K + k0 + 8 * c) = o; }
#endif
    LDS_WAIT();
}
#endif
template <int PART> __device__ __forceinline__ int conv_index(int j) {
#if !defined(BG_CONV)
    if (PART == 0) return 8192 + j;
    if (PART == 1) return j < 8192 ? j : j + 4096;
#endif
    if (PART == 0) return j < 4096 ? 8192 + j : j - 4096;
    if (PART == 1) return j < 1024 ? 2048 + j : (j < 2048 ? 6144 + (j - 1024) : (j < 3072 ? 12288 + (j - 2048) : 14336 + (j - 3072)));
    return j < 4096 ? 22528 + j : (j < 5120 ? 3072 + (j - 4096) : (j < 6144 ? 7168 + (j - 5120) : (j < 8192 ? 4096 + (j - 6144) : (j < 9216 ? 13312 + (j - 8192) : (j < 13312 ? 18432 + (j - 9216) : 26624 + (j - 13312))))));
}
template <int PART> __device__ __forceinline__ void conv_run(unsigned char* ws, LAS float* scr, int first, int step, int limit, int lane) {
    if (first >= limit) return;
    f32x4 va[16], vb[16];
    ConvSel sa = conv_select(ws, conv_index<PART>(__builtin_amdgcn_readfirstlane(first))), sb = sa;
    conv_load(sa, va, lane);
    for (int j = first; j < limit; j += 2 * step) {
        const bool hb = (j + step) < limit;
        if (hb) { sb = conv_select(ws, conv_index<PART>(__builtin_amdgcn_readfirstlane(j + step))); conv_load(sb, vb, lane); }
        conv_finish(sa, va, scr, lane);
        if (!hb) break;
        const bool ha = (j + 2 * step) < limit;
        if (ha) { sa = conv_select(ws, conv_index<PART>(__builtin_amdgcn_readfirstlane(j + 2 * step))); conv_load(sa, va, lane); }
        conv_finish(sb, vb, scr, lane);
    }
}
__device__ __forceinline__ void rows_to_bf16(unsigned char* ws, int m0, int step, int lane) {
    f32x4 v[3][8];
#pragma unroll
    for (int r = 0; r < 3; ++r) { const int m = m0 + r * step; if (m < M + MROWS) { const float* xrow = (m < M) ? ka_in(0) + (size_t)m * D : ka_in(1) + (size_t)(m - M) * D;
#pragma unroll
            for (int j = 0; j < 8; ++j) v[r][j] = __builtin_nontemporal_load(((const f32x4*)xrow) + lane + 64 * j); } }
#pragma unroll
    for (int r = 0; r < 3; ++r) { const int m = m0 + r * step; if (m < M + MROWS) {
            bf16* orow = (m < M) ? (bf16*)(ws + WS_XB) + (size_t)m * D : (bf16*)(ws + WS_MEMB) + (size_t)(m - M) * D;
            float* ssqrow = (m < M) ? (float*)(ws + WS_SSQ) + (size_t)m * 64 : (float*)(ws + WS_SSQM) + (size_t)(m - M) * 64;
            float s = 0.f;
#pragma unroll
            for (int j = 0; j < 8; ++j) s += (v[r][j][0] * v[r][j][0] + v[r][j][1] * v[r][j][1]) + (v[r][j][2] * v[r][j][2] + v[r][j][3] * v[r][j][3]);
            s = wave_sum(s);
#pragma unroll
            for (int j = 0; j < 8; ++j) { v2u w; w.x = pg8::cvt_pk_bf16(v[r][j][0], v[r][j][1]); w.y = pg8::cvt_pk_bf16(v[r][j][2], v[r][j][3]); ((v2u*)orow)[lane + 64 * j] = w; }
            if (lane < 32) ssqrow[lane] = (lane == 0) ? s : 0.f; } }
}
__device__ __forceinline__ void p0_prologue(unsigned char* ws, LAS unsigned char* lds, int wave, int lane) {
    LAS float* scr = (LAS float*)(lds + wave * 16896);
    const int gw = blockIdx.x * NWAVES + wave, NGW = gridDim.x * NWAVES;
#if defined(BG_CONV)
    conv_run<0>(ws, scr, gw, NGW, 6144, lane);
#else
    conv_run<0>(ws, scr, gw, NGW, 4096, lane);
#endif
    for (int m = gw; m < M + MROWS; m += 3 * NGW) rows_to_bf16(ws, m, NGW, lane);
}
__device__ __forceinline__ void p1_convert(unsigned char* ws, LAS unsigned char* lds, int wave, int lane) {
    LAS float* scr = (LAS float*)(lds + wave * 16896);
    const int bx = blockIdx.x, G = gridDim.x;
#if defined(BG_CONV)
    if (G <= 64) { conv_run<1>(ws, scr, bx * NWAVES + wave, G * NWAVES, 7168, lane); return; }
    if (bx >= 64) conv_run<1>(ws, scr, (bx - 64) * NWAVES + wave, (G - 64) * NWAVES, 7168, lane);
#else
    constexpr int CONV_REST = 26624, CONV_SPLIT = 22272;
    if (G <= 64) { conv_run<1>(ws, scr, bx * NWAVES + wave, G * NWAVES, CONV_REST, lane); return; }
    if (bx >= 64) conv_run<1>(ws, scr, (bx - 64) * NWAVES + wave, (G - 64) * NWAVES, CONV_SPLIT, lane);
    else conv_run<1>(ws, scr, CONV_SPLIT + bx * NWAVES + wave, 64 * NWAVES, CONV_REST, lane);
#endif
}
template <int PH> __device__ __forceinline__ void bg_convert(unsigned char* ws, LAS unsigned char* lds, int wave, int lane) {
    constexpr int j0 = (PH == 2) ? 0 : (PH == 4) ? 2048 : (PH == 5) ? 4096 : (PH == 7) ? 6144 : (PH == 8) ? 8192 : (PH == 9) ? 12288 : (PH == 10) ? 16384 : -1;
    constexpr int j1 = (PH == 8) ? 12288 : (PH == 9) ? 16384 : (PH == 10) ? 17408 : j0 + 2048;
#if defined(BG_CONV)
    if constexpr (j0 >= 0) { LAS float* scr = (LAS float*)(lds + wave * 16896); const int gw = blockIdx.x * NWAVES + wave, NGW = gridDim.x * NWAVES;
        conv_run<2>(ws, scr, j0 + gw, NGW, j1, lane); }
#endif
}
__device__ __forceinline__ void final_norm(const bf16* xb, const float* ssq, const float* g, float* out, int wave, int lane) {
    const int gw = blockIdx.x * NWAVES + wave, NGW = gridDim.x * NWAVES;
    for (int m = gw; m < M; m += NGW) {
        float s = (lane < 32) ? ssq[(size_t)m * 64 + lane] : 0.f; s = wave_sum(s);
        const float rs = 1.0f / sqrtf(s * (1.0f / D) + 1e-6f);
        const v4u* xr = (const v4u*)(xb + (size_t)m * D); f32x4* orow = (f32x4*)(out + (size_t)m * D);
#pragma unroll
        for (int j = 0; j < 4; ++j) { const v4u w = NTL(xr + lane + 64 * j); const f32x4 g0 = ((const f32x4*)g)[2 * (lane + 64 * j)], g1 = ((const f32x4*)g)[2 * (lane + 64 * j) + 1];
            NTS(((f32x4){bflo(w.x) * rs * g0[0], bfhi(w.x) * rs * g0[1], bflo(w.y) * rs * g0[2], bfhi(w.y) * rs * g0[3]}), orow + 2 * (lane + 64 * j));
            NTS(((f32x4){bflo(w.z) * rs * g1[0], bfhi(w.z) * rs * g1[1], bflo(w.w) * rs * g1[2], bfhi(w.w) * rs * g1[3]}), orow + 2 * (lane + 64 * j) + 1); } }
}
__device__ __forceinline__ void gating_simple(LAS unsigned char* lds, const bf16* z, const float* vst, const float* ln_g, const float* ln_b, const float* w_s, const float* b_s, bf16* gbuf, int tid) {
    LAS float* vln = (LAS float*)lds;
    LAS float* Wl = (LAS float*)(lds + 65536);
    LAS float* mu = (LAS float*)(lds + 65536 + 128 * 129 * 4);
    LAS float* rsd = mu + 128;
    for (int unit = blockIdx.x; unit < 1024; unit += gridDim.x) {
        const int h = unit & 15, tok0 = (unit >> 4) * 128;
        if (tid < 128) { const float* p = vst + (size_t)(tok0 + tid) * 64; float s1 = 0.f, s2 = 0.f;
#pragma unroll 8
            for (int i = 0; i < 32; ++i) { s1 += p[2 * i]; s2 += p[2 * i + 1]; }
            const float mean = s1 * (1.0f / 2048.0f), var = s2 * (1.0f / 2048.0f) - mean * mean; mu[tid] = mean; rsd[tid] = 1.0f / sqrtf(var + 1e-6f); }
        __syncthreads();
        { const int s = tid >> 2, db = (tid & 3) * 32; const float mean = mu[s], rs = rsd[s];
            const bf16* vp = z + (size_t)(tok0 + s) * 4096 + 2048 + h * 128 + db;
#pragma unroll
            for (int q = 0; q < 4; ++q) { const v4u w = *(const v4u*)(vp + 8 * q); const float* gp = ln_g + h * 128 + db + 8 * q; const float* bp = ln_b + h * 128 + db + 8 * q; LAS float* o = vln + s * 128 + db + 8 * q;
                o[0] = (bflo(w.x) - mean) * rs * gp[0] + bp[0]; o[1] = (bfhi(w.x) - mean) * rs * gp[1] + bp[1]; o[2] = (bflo(w.y) - mean) * rs * gp[2] + bp[2]; o[3] = (bfhi(w.y) - mean) * rs * gp[3] + bp[3];
                o[4] = (bflo(w.z) - mean) * rs * gp[4] + bp[4]; o[5] = (bfhi(w.z) - mean) * rs * gp[5] + bp[5]; o[6] = (bflo(w.w) - mean) * rs * gp[6] + bp[6]; o[7] = (bfhi(w.w) - mean) * rs * gp[7] + bp[7]; }
            const float* wp = w_s + ((size_t)h * 128 + s) * 128 + db;
#pragma unroll
            for (int q = 0; q < 8; ++q) { const f32x4 w4 = *(const f32x4*)(wp + 4 * q); LAS float* o = Wl + s * 129 + db + 4 * q; o[0] = w4[0]; o[1] = w4[1]; o[2] = w4[2]; o[3] = w4[3]; } }
        __syncthreads();
        { const int t = tid >> 2, d0 = (tid & 3) * 32, tmax = t | 15; float acc[32];
#pragma unroll
            for (int j = 0; j < 32; ++j) acc[j] = 0.f;
            for (int s = 0; s <= tmax; ++s) { const float w = (s <= t) ? Wl[t * 129 + s] : 0.f; const LAS f32x4* vr = (const LAS f32x4*)(vln + s * 128 + d0);
#pragma unroll
                for (int q = 0; q < 8; ++q) { const f32x4 vv = vr[q]; acc[4 * q] += w * vv[0]; acc[4 * q + 1] += w * vv[1]; acc[4 * q + 2] += w * vv[2]; acc[4 * q + 3] += w * vv[3]; } }
            const float bs = b_s[h * 128 + t];
            const bf16* up = z + (size_t)(tok0 + t) * 4096 + h * 128 + d0; bf16* op = gbuf + (size_t)(tok0 + t) * 2048 + h * 128 + d0;
#pragma unroll
            for (int q = 0; q < 4; ++q) { const v4u w = *(const v4u*)(up + 8 * q); v4u o;
                o.x = pk2(bflo(w.x) * (acc[8 * q] + bs), bfhi(w.x) * (acc[8 * q + 1] + bs)); o.y = pk2(bflo(w.y) * (acc[8 * q + 2] + bs), bfhi(w.y) * (acc[8 * q + 3] + bs));
                o.z = pk2(bflo(w.z) * (acc[8 * q + 4] + bs), bfhi(w.z) * (acc[8 * q + 5] + bs)); o.w = pk2(bflo(w.w) * (acc[8 * q + 6] + bs), bfhi(w.w) * (acc[8 * q + 7] + bs));
                *(v4u*)(op + 8 * q) = o; } }
        __syncthreads();
    }
}
__device__ __forceinline__ void gating_mfma(LAS unsigned char* lds, const bf16* z, const float* vst, const float* ln_g, const float* ln_b, const float* w_s, const float* b_s, bf16* gbuf, int wave, int lane) {
    LAS float* MU = (LAS float*)(lds + 69632);
    const int tid = wave * 64 + lane, fr = lane & 15, fq = lane >> 4;
    const int ss = tid >> 2, db = (tid & 3) * 32;
    for (int unit = blockIdx.x; unit < 256; unit += gridDim.x) {
        const int tok0 = (unit >> 2) * 128, hg = unit & 3;
        __syncthreads();
        if (tid < 128) { const float* sp = vst + (size_t)(tok0 + tid) * 64; float s1 = 0.f, s2 = 0.f;
#pragma unroll
            for (int i = 0; i < 16; ++i) { const f32x4 a = *(const f32x4*)(sp + 4 * i); s1 += a[0] + a[2]; s2 += a[1] + a[3]; }
            const float mean = s1 * (1.0f / 2048.0f), var = s2 * (1.0f / 2048.0f) - mean * mean; MU[tid] = mean; MU[128 + tid] = 1.0f / sqrtf(var + 1e-6f); }
        v4u raw[4];
        { const bf16* vp = z + (size_t)(tok0 + ss) * 4096 + 2048 + (hg * 4) * 128 + db;
#pragma unroll
            for (int q4 = 0; q4 < 4; ++q4) raw[q4] = NTL((const v4u*)(vp + 8 * q4)); }
        __syncthreads();
        const float mean = MU[ss], rs = MU[128 + ss];
#pragma unroll 1
        for (int hh = 0; hh < 4; ++hh) { const int h = hg * 4 + hh; LAS unsigned char* VT = lds + (hh & 1) * 34816;
            const int t = 16 * wave + fr, nks = (wave >> 1) + 1;
            f32x4 wa[4][2];
#pragma unroll
            for (int ks = 0; ks < 4; ++ks) if (ks < nks) { const float* wp = w_s + ((size_t)h * 128 + t) * 128 + 32 * ks + 8 * fq; wa[ks][0] = *(const f32x4*)wp; wa[ks][1] = *(const f32x4*)(wp + 4); }
            const float bs = b_s[h * 128 + t];
            const bf16* up = z + (size_t)(tok0 + t) * 4096 + h * 128 + 4 * fq; bf16* op = gbuf + (size_t)(tok0 + t) * 2048 + h * 128 + 4 * fq;
            v2u uwv[8];
#pragma unroll
            for (int df = 0; df < 8; ++df) uwv[df] = NTL((const v2u*)(up + 16 * df));
            { const float* gp = ln_g + h * 128 + db; const float* bp = ln_b + h * 128 + db; LAS unsigned char* wp = VT + db * 272 + (ss ^ (8 * (tid & 3))) * 2;
#pragma unroll
                for (int q4 = 0; q4 < 4; ++q4) { const f32x4 g0 = *(const f32x4*)(gp + 8 * q4), g1 = *(const f32x4*)(gp + 8 * q4 + 4), b0 = *(const f32x4*)(bp + 8 * q4), b1 = *(const f32x4*)(bp + 8 * q4 + 4); const v4u w = raw[q4];
                    const float v0 = (bflo(w.x) - mean) * rs * g0[0] + b0[0], v1 = (bfhi(w.x) - mean) * rs * g0[1] + b0[1], v2 = (bflo(w.y) - mean) * rs * g0[2] + b0[2], v3 = (bfhi(w.y) - mean) * rs * g0[3] + b0[3];
                    const float v4 = (bflo(w.z) - mean) * rs * g1[0] + b1[0], v5 = (bfhi(w.z) - mean) * rs * g1[1] + b1[1], v6 = (bflo(w.w) - mean) * rs * g1[2] + b1[2], v7 = (bfhi(w.w) - mean) * rs * g1[3] + b1[3];
                    LAS unsigned char* o = wp + (8 * q4) * 272;
                    *(LAS bf16*)(o + 0 * 272) = (bf16)f2bf(v0); *(LAS bf16*)(o + 1 * 272) = (bf16)f2bf(v1); *(LAS bf16*)(o + 2 * 272) = (bf16)f2bf(v2); *(LAS bf16*)(o + 3 * 272) = (bf16)f2bf(v3);
                    *(LAS bf16*)(o + 4 * 272) = (bf16)f2bf(v4); *(LAS bf16*)(o + 5 * 272) = (bf16)f2bf(v5); *(LAS bf16*)(o + 6 * 272) = (bf16)f2bf(v6); *(LAS bf16*)(o + 7 * 272) = (bf16)f2bf(v7); } }
            if (hh < 3) { const bf16* vp = z + (size_t)(tok0 + ss) * 4096 + 2048 + (h + 1) * 128 + db;
#pragma unroll
                for (int q4 = 0; q4 < 4; ++q4) raw[q4] = NTL((const v4u*)(vp + 8 * q4)); }
            __syncthreads();
            bf16x8 wf[4];
#pragma unroll
            for (int ks = 0; ks < 4; ++ks) { wf[ks] = (bf16x8){0, 0, 0, 0, 0, 0, 0, 0};
                if (ks < nks) { const f32x4 a = wa[ks][0], c = wa[ks][1]; const int s0 = 32 * ks + 8 * fq;
                    float v[8] = {a[0], a[1], a[2], a[3], c[0], c[1], c[2], c[3]};
#pragma unroll
                    for (int j = 0; j < 8; ++j) v[j] = (s0 + j <= t) ? v[j] : 0.f;
                    v4u w; w.x = pk2(v[0], v[1]); w.y = pk2(v[2], v[3]); w.z = pk2(v[4], v[5]); w.w = pk2(v[6], v[7]); wf[ks] = __builtin_bit_cast(bf16x8, w); } }
#pragma unroll
            for (int df = 0; df < 8; ++df) { f32x4 acc = (f32x4){0.f, 0.f, 0.f, 0.f};
#pragma unroll
                for (int ks = 0; ks < 4; ++ks) if (ks < nks) { const bf16x8 a = *(const LAS bf16x8*)(VT + (df * 16 + fr) * 272 + (((32 * ks + 8 * fq) ^ (8 * ((df >> 1) & 3))) * 2)); acc = __builtin_amdgcn_mfma_f32_16x16x32_bf16(a, wf[ks], acc, 0, 0, 0); }
                const v2u uw = uwv[df]; v2u ow;
                ow.x = pg8::cvt_pk_bf16(bflo(uw.x) * (acc[0] + bs), bfhi(uw.x) * (acc[1] + bs)); ow.y = pg8::cvt_pk_bf16(bflo(uw.y) * (acc[2] + bs), bfhi(uw.y) * (acc[3] + bs));
                pg8::st_wt8(op + 16 * df, ow); }
        }
    }
    __syncthreads();
}
__device__ __forceinline__ void attn_simple(LAS unsigned char* lds, const bf16* q, const bf16* Kb, const bf16* Vb, bf16* obuf, int wave, int lane) {
    LAS float* pl = (LAS float*)(lds + wave * 1024);
    const int gw = blockIdx.x * NWAVES + wave, NGW = gridDim.x * NWAVES;
    for (int task = gw; task < BATCH * 4 * SEQ; task += NGW) {
        const int bh = task >> 12, t = task & 4095, b = bh >> 2, h = bh & 3;
        float qf[8]; { const v4u w = *(const v4u*)(q + ((size_t)(b * SEQ + t)) * 2048 + h * 512 + 8 * lane);
            qf[0] = bflo(w.x); qf[1] = bfhi(w.x); qf[2] = bflo(w.y); qf[3] = bfhi(w.y); qf[4] = bflo(w.z); qf[5] = bfhi(w.z); qf[6] = bflo(w.w); qf[7] = bfhi(w.w); }
        const bf16* kp = Kb + (size_t)bh * 256 * 512 + 8 * lane;
        float sc[4];
#pragma unroll
        for (int kk = 0; kk < 4; ++kk) { float mine = 0.f;
            for (int l2 = 0; l2 < 64; ++l2) { const v4u w = *(const v4u*)(kp + (size_t)(kk * 64 + l2) * 512);
                float dsum = qf[0] * bflo(w.x) + qf[1] * bfhi(w.x) + qf[2] * bflo(w.y) + qf[3] * bfhi(w.y) + qf[4] * bflo(w.z) + qf[5] * bfhi(w.z) + qf[6] * bflo(w.w) + qf[7] * bfhi(w.w);
                dsum = wave_sum(dsum); if (lane == l2) mine = dsum; }
            sc[kk] = mine; }
        const float mx = wave_max(fmaxf(fmaxf(sc[0], sc[1]), fmaxf(sc[2], sc[3])));
        float p[4], ps = 0.f;
#pragma unroll
        for (int kk = 0; kk < 4; ++kk) { p[kk] = exp2f(sc[kk] - mx); ps += p[kk]; pl[kk * 64 + lane] = p[kk]; }
        const float inv = 1.0f / wave_sum(ps);
        LDS_WAIT();
        float o[8];
#pragma unroll
        for (int i = 0; i < 8; ++i) o[i] = 0.f;
        const bf16* vp = Vb + (size_t)bh * 256 * 512 + 8 * lane;
        for (int key = 0; key < 256; ++key) { const float pk = pl[key]; const v4u w = *(const v4u*)(vp + (size_t)key * 512);
            o[0] += pk * bflo(w.x); o[1] += pk * bfhi(w.x); o[2] += pk * bflo(w.y); o[3] += pk * bfhi(w.y); o[4] += pk * bflo(w.z); o[5] += pk * bfhi(w.z); o[6] += pk * bflo(w.w); o[7] += pk * bfhi(w.w); }
        v4u ow; ow.x = pk2(o[0] * inv, o[1] * inv); ow.y = pk2(o[2] * inv, o[3] * inv); ow.z = pk2(o[4] * inv, o[5] * inv); ow.w = pk2(o[6] * inv, o[7] * inv);
        *(v4u*)(obuf + ((size_t)(b * SEQ + t)) * 2048 + h * 512 + 8 * lane) = ow;
        LDS_WAIT();
    }
}
__device__ __forceinline__ void attn_mfma(LAS unsigned char* lds, const bf16* q, const bf16* Kb, const bf16* VTb, bf16* obuf, int wave, int lane) {
    const int tid = wave * 64 + lane, fr = lane & 15, fq = lane >> 4;
    unsigned voffK[2], voffV[2];
#pragma unroll
    for (int i = 0; i < 2; ++i) { int R, C; pg8::stage_rc(tid * 16 + i * 8192, R, C); voffK[i] = (unsigned)(R * 512 + C) * 2u; voffV[i] = (unsigned)(R * 256 + C) * 2u; }
    const unsigned ldsw = (unsigned)wave * 1024u;
    const int aoff0 = pg8::lds_byte(fr, fq * 8);
#define AT_STAGE_K(c, buf) do { _Pragma("unroll") for (int ht = 0; ht < 4; ++ht) { const char* src = Kg + ((size_t)(128 * (ht >> 1)) * 512 + 128 * (c) + 64 * (ht & 1)) * 2; \
        _Pragma("unroll") for (int i = 0; i < 2; ++i) __builtin_amdgcn_global_load_lds((const unsigned*)(src + voffK[i]), (LAS unsigned*)(lds + (buf) * 65536 + ht * 16384 + ldsw + i * 8192), 16, 0, 0); } } while (0)
#define AT_STAGE_V(cc, buf) do { _Pragma("unroll") for (int ht = 0; ht < 4; ++ht) { const char* src = Vg + ((size_t)(128 * ht) * 256 + 64 * (cc)) * 2; \
        _Pragma("unroll") for (int i = 0; i < 2; ++i) __builtin_amdgcn_global_load_lds((const unsigned*)(src + voffV[i]), (LAS unsigned*)(lds + (buf) * 65536 + ht * 16384 + ldsw + i * 8192), 16, 0, 0); } } while (0)
#define AT_WAIT() do { asm volatile("s_waitcnt vmcnt(0)" ::: "memory"); __syncthreads(); } while (0)
    for (int unit = blockIdx.x; unit < 256; unit += gridDim.x) {
        const int bh = unit & 7, qb = unit >> 3, b = bh >> 2, h = bh & 3;
        const char* Kg = (const char*)(Kb + (size_t)bh * 256 * 512);
        const char* Vg = (const char*)(VTb + (size_t)bh * 512 * 256);
        const size_t tok = (size_t)(b * SEQ + qb * 128 + 16 * wave + fr);
        bf16x8 qf[16];
        { const bf16* qp = q + tok * 2048 + h * 512 + 8 * fq;
#pragma unroll
            for (int s = 0; s < 16; ++s) qf[s] = NTL((const bf16x8*)(qp + 32 * s)); }
        f32x4 acc[16];
#pragma unroll
        for (int n = 0; n < 16; ++n) acc[n] = (f32x4){0.f, 0.f, 0.f, 0.f};
        STAMP2(lds, 40);
        AT_STAGE_K(0, 0);
#pragma unroll
        for (int c = 0; c < 4; ++c) {
            AT_WAIT();
            if (c < 3) AT_STAGE_K(c + 1, (c + 1) & 1); else AT_STAGE_V(0, 0);
            const LAS unsigned char* bb = lds + (c & 1) * 65536 + aoff0; asm volatile("" : "+v"(bb));
#define AT_QK_LOAD(dst, gi) do { _Pragma("unroll") for (int n8 = 0; n8 < 8; ++n8) dst[n8] = *(const LAS bf16x8*)(bb + ((((gi) & 1) * 2 + ((gi) >> 2)) * 16384) + n8 * 2048 + (((gi) >> 1) & 1) * 1024); } while (0)
#define AT_QK_MMA(src, gi) do { _Pragma("unroll") for (int n8 = 0; n8 < 8; ++n8) acc[((gi) & 1) * 8 + n8] = __builtin_amdgcn_mfma_f32_16x16x32_bf16(src[n8], qf[4 * c + 2 * ((gi) >> 2) + (((gi) >> 1) & 1)], acc[((gi) & 1) * 8 + n8], 0, 0, 0); } while (0)
            { bf16x8 a0[8], a1[8];
                AT_QK_LOAD(a0, 0);
#pragma unroll
                for (int gi = 0; gi < 8; gi += 2) { AT_QK_LOAD(a1, gi + 1); AT_QK_MMA(a0, gi); __builtin_amdgcn_sched_barrier(0);
                    if (gi + 2 < 8) AT_QK_LOAD(a0, gi + 2);
                    AT_QK_MMA(a1, gi + 1); __builtin_amdgcn_sched_barrier(0); } }
        }
        STAMP2(lds, 41);
        float mx = acc[0][0];
#pragma unroll
        for (int n = 0; n < 16; ++n) mx = fmaxf(fmaxf(mx, fmaxf(acc[n][0], acc[n][1])), fmaxf(acc[n][2], acc[n][3]));
        mx = fmaxf(mx, __shfl_xor(mx, 16)); mx = fmaxf(mx, __shfl_xor(mx, 32));
        float l = 0.f;
#pragma unroll
        for (int n = 0; n < 16; ++n)
#pragma unroll
            for (int r = 0; r < 4; ++r) { const float pv = __builtin_amdgcn_exp2f(acc[n][r] - mx); acc[n][r] = pv; l += pv; }
        l += __shfl_xor(l, 16); l += __shfl_xor(l, 32);
        const float linv = 1.0f / l;
        bf16x8 pf[8];
#pragma unroll
        for (int s = 0; s < 8; ++s) { v4u w; w.x = pg8::cvt_pk_bf16(acc[2 * s][0], acc[2 * s][1]); w.y = pg8::cvt_pk_bf16(acc[2 * s][2], acc[2 * s][3]);
            w.z = pg8::cvt_pk_bf16(acc[2 * s + 1][0], acc[2 * s + 1][1]); w.w = pg8::cvt_pk_bf16(acc[2 * s + 1][2], acc[2 * s + 1][3]); pf[s] = __builtin_bit_cast(bf16x8, w); }
        STAMP2(lds, 42);
        __builtin_amdgcn_sched_barrier(0);
        f32x4 o[32];
#pragma unroll
        for (int mm = 0; mm < 32; ++mm) o[mm] = (f32x4){0.f, 0.f, 0.f, 0.f};
#pragma unroll
        for (int cc = 0; cc < 4; ++cc) {
            AT_WAIT();
            if (cc < 3) AT_STAGE_V(cc + 1, (cc + 1) & 1);
            const LAS unsigned char* bb = lds + (cc & 1) * 65536 + aoff0; asm volatile("" : "+v"(bb));
#define AT_PV_LOAD(dst, gi) do { _Pragma("unroll") for (int m8 = 0; m8 < 8; ++m8) dst[m8] = *(const LAS bf16x8*)(bb + ((gi) & 3) * 16384 + m8 * 2048 + ((gi) >> 2) * 1024); } while (0)
#define AT_PV_MMA(src, gi) do { _Pragma("unroll") for (int m8 = 0; m8 < 8; ++m8) o[((gi) & 3) * 8 + m8] = __builtin_amdgcn_mfma_f32_16x16x32_bf16(src[m8], pf[2 * cc + ((gi) >> 2)], o[((gi) & 3) * 8 + m8], 0, 0, 0); } while (0)
            { bf16x8 a0[8], a1[8];
                AT_PV_LOAD(a0, 0);
#pragma unroll
                for (int gi = 0; gi < 8; gi += 2) { AT_PV_LOAD(a1, gi + 1); AT_PV_MMA(a0, gi); __builtin_amdgcn_sched_barrier(0);
                    if (gi + 2 < 8) AT_PV_LOAD(a0, gi + 2);
                    AT_PV_MMA(a1, gi + 1); __builtin_amdgcn_sched_barrier(0); } }
        }
        STAMP2(lds, 43);
        bf16* op = obuf + tok * 2048 + h * 512 + 4 * fq;
#pragma unroll
        for (int mm = 0; mm < 32; ++mm) { v2u w; w.x = pg8::cvt_pk_bf16(o[mm][0] * linv, o[mm][1] * linv); w.y = pg8::cvt_pk_bf16(o[mm][2] * linv, o[mm][3] * linv); pg8::st_wt8(op + 16 * mm, w); }
    }
    asm volatile("s_waitcnt vmcnt(0)" ::: "memory"); __syncthreads(); STAMP2(lds, 44);
#undef AT_STAGE_K
#undef AT_QK_LOAD
#undef AT_QK_MMA
#undef AT_PV_LOAD
#undef AT_PV_MMA
#undef AT_STAGE_V
#undef AT_WAIT
}
struct S5Lane { float lbr, lbi; float Br[16], Bi[16]; };
__device__ __forceinline__ void s5_lane_params(int g, int p, S5Lane& L) {
    const float lr = fminf(ka_in(15)[g * 64 + p], -1e-4f), li = ka_in(16)[g * 64 + p], dt = expf(ka_in(17)[g]);
    const float ar = lr * dt, th = li * dt; float sn, cs; sincosf(th, &sn, &cs); const float e = expf(ar), sh = sinf(0.5f * th);
    L.lbr = e * cs; L.lbi = e * sn;
    const float nr = expm1f(ar) * cs - 2.0f * sh * sh, ni = e * sn;
    const float den = 1.0f / (lr * lr + li * li), cr = (nr * lr + ni * li) * den, ci = (ni * lr - nr * li) * den;
#pragma unroll
    for (int c = 0; c < 16; ++c) { const float br = ka_in(18)[(size_t)(g * 64 + p) * 16 + c], bi = ka_in(19)[(size_t)(g * 64 + p) * 16 + c]; L.Br[c] = cr * br - ci * bi; L.Bi[c] = cr * bi + ci * br; }
}
__device__ __forceinline__ void s5_step(const S5Lane& L, const bf16* urow, float& xr, float& xi) {
    const v4u w0 = *(const v4u*)urow, w1 = *(const v4u*)(urow + 8);
    float u[16] = {bflo(w0.x), bfhi(w0.x), bflo(w0.y), bfhi(w0.y), bflo(w0.z), bfhi(w0.z), bflo(w0.w), bfhi(w0.w), bflo(w1.x), bfhi(w1.x), bflo(w1.y), bfhi(w1.y), bflo(w1.z), bfhi(w1.z), bflo(w1.w), bfhi(w1.w)};
    float br = 0.f, bi = 0.f;
#pragma unroll
    for (int c = 0; c < 16; ++c) { br += L.Br[c] * u[c]; bi += L.Bi[c] * u[c]; }
    const float nr = L.lbr * xr - L.lbi * xi + br, ni = L.lbr * xi + L.lbi * xr + bi; xr = nr; xi = ni;
}
__device__ __forceinline__ void s5_pass_a(const bf16* ub, f32x2* st, int wave, int lane) {
    const int gw = blockIdx.x * NWAVES + wave, NGW = gridDim.x * NWAVES;
    for (int task = gw; task < BATCH * 128 * 64; task += NGW) {
        const int seg = task & 63, g = (task >> 6) & 127, b = task >> 13;
        S5Lane L; s5_lane_params(g, lane, L);
        float xr = 0.f, xi = 0.f; const bf16* up = ub + (size_t)(b * SEQ + seg * 64) * 2048 + 16 * g;
#pragma unroll 2
        for (int s = 0; s < 64; ++s) s5_step(L, up + (size_t)s * 2048, xr, xi);
        st[(size_t)task * 64 + lane] = (f32x2){xr, xi};
    }
}
__device__ __forceinline__ void s5_pass_c(LAS unsigned char* lds, const bf16* ub, const f32x2* st, bf16* yb, int wave, int lane) {
    LAS f32x2* Cs = (LAS f32x2*)(lds + wave * 16640);
    LAS f32x2* xs = (LAS f32x2*)(lds + wave * 16640 + 8320);
    const int gw = blockIdx.x * NWAVES + wave, NGW = gridDim.x * NWAVES;
    for (int task = gw; task < BATCH * 128 * 64; task += NGW) {
        const int seg = task & 63, g = (task >> 6) & 127, b = task >> 13;
        S5Lane L; s5_lane_params(g, lane, L);
#pragma unroll
        for (int c = 0; c < 16; ++c) Cs[c * 65 + lane] = (f32x2){ka_in(20)[(size_t)(g * 16 + c) * 64 + lane], ka_in(21)[(size_t)(g * 16 + c) * 64 + lane]};
        float Ar = L.lbr, Ai = L.lbi;
#pragma unroll
        for (int i = 0; i < 6; ++i) { const float nr = Ar * Ar - Ai * Ai, ni = 2.0f * Ar * Ai; Ar = nr; Ai = ni; }
        float xr = 0.f, xi = 0.f; const f32x2* sp = st + (size_t)(task - seg) * 64 + lane;
#pragma unroll 2
        for (int n = 0; n < seg; ++n) { const f32x2 s = sp[(size_t)n * 64]; const float nr = Ar * xr - Ai * xi + s.x, ni = Ar * xi + Ai * xr + s.y; xr = nr; xi = ni; }
        const bf16* up = ub + (size_t)(b * SEQ + seg * 64) * 2048 + 16 * g; bf16* yp = yb + (size_t)(b * SEQ + seg * 64) * 2048 + 16 * g;
        const int t = lane & 15, cq = lane >> 4;
        f32x4 dsk = *(const f32x4*)(ka_in(22) + g * 16 + 4 * cq);
#pragma unroll 1
        for (int blk = 0; blk < 4; ++blk) {
#pragma unroll 2
            for (int s = 0; s < 16; ++s) { s5_step(L, up + (size_t)(blk * 16 + s) * 2048, xr, xi); xs[s * 65 + lane] = (f32x2){xr, xi}; }
            LDS_WAIT();
            float acc[4] = {0.f, 0.f, 0.f, 0.f};
#pragma unroll 4
            for (int p = 0; p < 64; ++p) { const f32x2 x = xs[t * 65 + p];
#pragma unroll
                for (int j = 0; j < 4; ++j) { const f32x2 c = Cs[(4 * cq + j) * 65 + p]; acc[j] += c.x * x.x - c.y * x.y; } }
            const v2u uw = *(const v2u*)(up + (size_t)(blk * 16 + t) * 2048 + 4 * cq);
            const float y0 = gelu_exact(acc[0] + dsk[0] * bflo(uw.x)), y1 = gelu_exact(acc[1] + dsk[1] * bfhi(uw.x)), y2 = gelu_exact(acc[2] + dsk[2] * bflo(uw.y)), y3 = gelu_exact(acc[3] + dsk[3] * bfhi(uw.y));
            v2u ow; ow.x = pk2(y0, y1); ow.y = pk2(y2, y3); *(v2u*)(yp + (size_t)(blk * 16 + t) * 2048 + 4 * cq) = ow;
            LDS_WAIT();
        }
    }
}
__device__ __forceinline__ void s5_mfma(LAS unsigned char* lds, const bf16* ub, bf16* yb, int wave, int lane) {
    LAS f32x2* PW = (LAS f32x2*)(lds);
    LAS f32x2* BB = (LAS f32x2*)(lds + 8704);
    LAS f32x2* CC = (LAS f32x2*)(lds + 16896);
    LAS bf16* KST = (LAS bf16*)(lds + 25088);
    LAS unsigned char* UI = lds + 33280;
    LAS float* SL = (LAS float*)(lds + 66048);
    LAS bf16* XP = (LAS bf16*)(lds + 99840);
    const int tid = wave * 64 + lane, fr = lane & 15, fq = lane >> 4;
#ifndef S5_LOOP_REPS
#define S5_LOOP_REPS 1
#endif
    for (int unit = blockIdx.x; unit < 256; unit += gridDim.x) {
        const int b = unit >> 7, g = unit & 127;
        const bf16* usrc = ub + (size_t)(b * SEQ) * 2048 + 16 * g + (size_t)(tid >> 1) * 2048 + 8 * (tid & 1);
        v4u upre[4];
#pragma unroll
        for (int i = 0; i < 4; ++i) upre[i] = NTL((const v4u*)(usrc + (size_t)(256 * i) * 2048));
        const float ldt = ka_in(17)[g];
        float plr[3], pli[3];
#pragma unroll
        for (int it = 0; it < 3; ++it) { const int idx = tid + NTHREADS * it, p = idx & 63; plr[it] = ka_in(15)[g * 64 + p]; pli[it] = ka_in(16)[g * 64 + p]; }
        float pbr[2], pbi[2], pcr[2], pci[2];
#pragma unroll
        for (int it = 0; it < 2; ++it) { const int idx = tid + NTHREADS * it; pbr[it] = ka_in(18)[(size_t)g * 1024 + idx]; pbi[it] = ka_in(19)[(size_t)g * 1024 + idx]; pcr[it] = ka_in(20)[(size_t)g * 1024 + idx]; pci[it] = ka_in(21)[(size_t)g * 1024 + idx]; }
        float qlr[2], qli[2];
#pragma unroll
        for (int it = 0; it < 2; ++it) { const int p = (tid + NTHREADS * it) >> 4; qlr[it] = ka_in(15)[g * 64 + p]; qli[it] = ka_in(16)[g * 64 + p]; }
        const f32x4 dsk = *(const f32x4*)(ka_in(22) + g * 16 + 4 * fq);
        const float dt = expf(ldt);
        __syncthreads();
#pragma unroll
        for (int it = 0; it < 3; ++it) { const int idx = tid + NTHREADS * it; if (idx < 17 * 64) { const int e = idx >> 6;
            const float lr = fminf(plr[it], -1e-4f), li = pli[it]; float sn, cs; sincosf(li * dt * (float)e, &sn, &cs); const float ex = expf(lr * dt * (float)e);
            PW[idx] = (f32x2){ex * cs, ex * sn}; } }
#pragma unroll
        for (int it = 0; it < 2; ++it) { const int idx = tid + NTHREADS * it;
            const float lr = fminf(qlr[it], -1e-4f), li = qli[it]; const float ar = lr * dt, th = li * dt; float sn, cs; sincosf(th, &sn, &cs); const float e = expf(ar), sh = sinf(0.5f * th);
            const float nr = expm1f(ar) * cs - 2.0f * sh * sh, ni = e * sn, den = 1.0f / (lr * lr + li * li), cr = (nr * lr + ni * li) * den, ci = (ni * lr - nr * li) * den;
            BB[idx] = (f32x2){cr * pbr[it] - ci * pbi[it], cr * pbi[it] + ci * pbr[it]};
            CC[idx] = (f32x2){pcr[it], pci[it]}; }
        __syncthreads();
        bf16x8 A1[8];
        { const int ri = wave >> 2, p = 16 * (wave & 3) + fr; f32x2 bb[8];
#pragma unroll
            for (int j = 0; j < 8; ++j) bb[j] = BB[p * 16 + 8 * (fq & 1) + j];
#pragma unroll
            for (int ks = 0; ks < 8; ++ks) { const int s = 2 * ks + (fq >> 1); const f32x2 pw = PW[(15 - s) * 64 + p]; float v[8];
#pragma unroll
                for (int j = 0; j < 8; ++j) v[j] = ri ? (pw.x * bb[j].y + pw.y * bb[j].x) : (pw.x * bb[j].x - pw.y * bb[j].y);
                v4u w; w.x = pk2(v[0], v[1]); w.y = pk2(v[2], v[3]); w.z = pk2(v[4], v[5]); w.w = pk2(v[6], v[7]); A1[ks] = __builtin_bit_cast(bf16x8, w); }
            __builtin_amdgcn_sched_barrier(0); }
        const int t0 = wave, t1 = 15 - wave;
        bf16x8 CM[2][4];
        { f32x4 kacc[2] = {(f32x4){0.f, 0.f, 0.f, 0.f}, (f32x4){0.f, 0.f, 0.f, 0.f}};
#pragma unroll
            for (int h = 0; h < 2; ++h) { f32x2 cc[8], pa[8], pb[8];
#pragma unroll
                for (int j = 0; j < 8; ++j) { const int p = 32 * h + 8 * fq + j; cc[j] = CC[fr * 64 + p]; pa[j] = PW[(t0 + 1) * 64 + p]; pb[j] = PW[(t1 + 1) * 64 + p]; }
                float vr[8], vi[8];
#pragma unroll
                for (int j = 0; j < 8; ++j) { vr[j] = cc[j].x * pa[j].x - cc[j].y * pa[j].y; vi[j] = -(cc[j].x * pa[j].y + cc[j].y * pa[j].x); }
                { v4u w; w.x = pk2(vr[0], vr[1]); w.y = pk2(vr[2], vr[3]); w.z = pk2(vr[4], vr[5]); w.w = pk2(vr[6], vr[7]); CM[0][h] = __builtin_bit_cast(bf16x8, w);
                  w.x = pk2(vi[0], vi[1]); w.y = pk2(vi[2], vi[3]); w.z = pk2(vi[4], vi[5]); w.w = pk2(vi[6], vi[7]); CM[0][2 + h] = __builtin_bit_cast(bf16x8, w); }
#pragma unroll
                for (int j = 0; j < 8; ++j) { vr[j] = cc[j].x * pb[j].x - cc[j].y * pb[j].y; vi[j] = -(cc[j].x * pb[j].y + cc[j].y * pb[j].x); }
                { v4u w; w.x = pk2(vr[0], vr[1]); w.y = pk2(vr[2], vr[3]); w.z = pk2(vr[4], vr[5]); w.w = pk2(vr[6], vr[7]); CM[1][h] = __builtin_bit_cast(bf16x8, w);
                  w.x = pk2(vi[0], vi[1]); w.y = pk2(vi[2], vi[3]); w.z = pk2(vi[4], vi[5]); w.w = pk2(vi[6], vi[7]); CM[1][2 + h] = __builtin_bit_cast(bf16x8, w); }
                bf16x8 ctr, cti;
                { v4u w; w.x = pk2(cc[0].x, cc[1].x); w.y = pk2(cc[2].x, cc[3].x); w.z = pk2(cc[4].x, cc[5].x); w.w = pk2(cc[6].x, cc[7].x); ctr = __builtin_bit_cast(bf16x8, w);
                  w.x = pk2(-cc[0].y, -cc[1].y); w.y = pk2(-cc[2].y, -cc[3].y); w.z = pk2(-cc[4].y, -cc[5].y); w.w = pk2(-cc[6].y, -cc[7].y); cti = __builtin_bit_cast(bf16x8, w); }
                f32x2 bq[8];
#pragma unroll
                for (int j = 0; j < 8; ++j) bq[j] = BB[(32 * h + 8 * fq + j) * 16 + fr];
#pragma unroll
                for (int si = 0; si < 2; ++si) { const int s = 2 * wave + si;
#pragma unroll
                    for (int j = 0; j < 8; ++j) { const f32x2 pw = PW[(15 - s) * 64 + 32 * h + 8 * fq + j]; vr[j] = pw.x * bq[j].x - pw.y * bq[j].y; vi[j] = pw.x * bq[j].y + pw.y * bq[j].x; }
                    v4u w; w.x = pk2(vr[0], vr[1]); w.y = pk2(vr[2], vr[3]); w.z = pk2(vr[4], vr[5]); w.w = pk2(vr[6], vr[7]);
                    kacc[si] = __builtin_amdgcn_mfma_f32_16x16x32_bf16(__builtin_bit_cast(bf16x8, w), ctr, kacc[si], 0, 0, 0);
                    w.x = pk2(vi[0], vi[1]); w.y = pk2(vi[2], vi[3]); w.z = pk2(vi[4], vi[5]); w.w = pk2(vi[6], vi[7]);
                    kacc[si] = __builtin_amdgcn_mfma_f32_16x16x32_bf16(__builtin_bit_cast(bf16x8, w), cti, kacc[si], 0, 0, 0); }
                __builtin_amdgcn_sched_barrier(0); }
#pragma unroll
            for (int si = 0; si < 2; ++si) { const int s = 2 * wave + si; v2u kw; kw.x = pk2(kacc[si][0], kacc[si][1]); kw.y = pk2(kacc[si][2], kacc[si][3]);
                *(LAS v2u*)(KST + ((15 - s) * 16 + fr) * 16 + 4 * fq) = kw; } }
#pragma unroll 1
        for (int rep = 0; rep < S5_LOOP_REPS; ++rep) {
        float Xr = 0.f, Xi = 0.f;
#pragma unroll 1
        for (int q = 0; q < 4; ++q) {
            __syncthreads();
#pragma unroll
            for (int i = 0; i < 4; ++i) { const int piece = tid + NTHREADS * i, tok = piece >> 1, half = piece & 1;
                *(LAS v4u*)(UI + ((((tok & 15) * 64 + (tok >> 4)) * 2 + half) * 16)) = upre[i]; }
            { const int qn = (q + 1) & 3;
#pragma unroll
                for (int i = 0; i < 4; ++i) upre[i] = NTL((const v4u*)(usrc + (size_t)(qn * 1024 + 256 * i) * 2048)); }
            __syncthreads();
#pragma unroll 1
            for (int nf = 0; nf < 4; ++nf) { f32x4 acc = (f32x4){0.f, 0.f, 0.f, 0.f};
#pragma unroll
                for (int ks = 0; ks < 8; ++ks) { const bf16x8 bfr = *(const LAS bf16x8*)(UI + ((((2 * ks + (fq >> 1)) * 64 + 16 * nf + fr) * 2 + (fq & 1)) * 16));
                    acc = __builtin_amdgcn_mfma_f32_16x16x32_bf16(A1[ks], bfr, acc, 0, 0, 0); }
                *(LAS f32x4*)(SL + (16 * nf + fr) * 132 + 16 * wave + 4 * fq) = acc; }
            __syncthreads();
            if (wave == 0) { const f32x2 a16 = PW[16 * 64 + lane];
#pragma unroll 1
                for (int nb = 0; nb < 64; nb += 16) { float sr[16], si[16];
#pragma unroll
                    for (int n = 0; n < 16; ++n) { sr[n] = SL[(nb + n) * 132 + lane]; si[n] = SL[(nb + n) * 132 + 64 + lane]; }
#pragma unroll
                    for (int n = 0; n < 16; ++n) { XP[(nb + n) * 136 + lane] = (bf16)f2bf(Xr); XP[(nb + n) * 136 + 64 + lane] = (bf16)f2bf(Xi);
                        const float nr = a16.x * Xr - a16.y * Xi + sr[n], ni = a16.x * Xi + a16.y * Xr + si[n]; Xr = nr; Xi = ni; } } }
            __syncthreads();
#pragma unroll 1
            for (int nf = 0; nf < 4; ++nf) { f32x4 acc0 = (f32x4){0.f, 0.f, 0.f, 0.f}, acc1 = acc0;
#pragma unroll
                for (int ks = 0; ks < 8; ++ks) { if (2 * ks <= t1 || 2 * ks <= t0) {
                    const int s = 2 * ks + (fq >> 1);
                    const bf16x8 bfr = *(const LAS bf16x8*)(UI + (((s * 64 + 16 * nf + fr) * 2 + (fq & 1)) * 16));
                    if (2 * ks <= t0) { bf16x8 tf = (bf16x8){0, 0, 0, 0, 0, 0, 0, 0}; if (s <= t0) tf = *(const LAS bf16x8*)(KST + ((t0 - s) * 16 + fr) * 16 + 8 * (fq & 1)); acc0 = __builtin_amdgcn_mfma_f32_16x16x32_bf16(tf, bfr, acc0, 0, 0, 0); }
                    if (2 * ks <= t1) { bf16x8 tf = (bf16x8){0, 0, 0, 0, 0, 0, 0, 0}; if (s <= t1) tf = *(const LAS bf16x8*)(KST + ((t1 - s) * 16 + fr) * 16 + 8 * (fq & 1)); acc1 = __builtin_amdgcn_mfma_f32_16x16x32_bf16(tf, bfr, acc1, 0, 0, 0); } } }
#pragma unroll
                for (int ks = 0; ks < 4; ++ks) { const bf16x8 xf = *(const LAS bf16x8*)(XP + (16 * nf + fr) * 136 + 32 * ks + 8 * fq);
                    acc0 = __builtin_amdgcn_mfma_f32_16x16x32_bf16(CM[0][ks], xf, acc0, 0, 0, 0); acc1 = __builtin_amdgcn_mfma_f32_16x16x32_bf16(CM[1][ks], xf, acc1, 0, 0, 0); }
#pragma unroll
                for (int ti = 0; ti < 2; ++ti) { const int t = ti ? t1 : t0; const f32x4 a = ti ? acc1 : acc0; const int n = 16 * nf + fr;
                    const v2u uw = *(const LAS v2u*)(UI + (((t * 64 + n) * 2 + (fq >> 1)) * 16) + 8 * (fq & 1));
                    const pg8::f32x2 g0 = pg8::gelu_pk((pg8::f32x2){a[0] + dsk[0] * bflo(uw.x), a[1] + dsk[1] * bfhi(uw.x)}), g1 = pg8::gelu_pk((pg8::f32x2){a[2] + dsk[2] * bflo(uw.y), a[3] + dsk[3] * bfhi(uw.y)});
                    v2u ow; ow.x = pg8::cvt_pk_bf16(g0.x, g0.y); ow.y = pg8::cvt_pk_bf16(g1.x, g1.y);
                    pg8::st_wt8(yb + (size_t)(b * SEQ + q * 1024 + 16 * n + t) * 2048 + 16 * g + 4 * fq, ow); } }
        }
        }
    }
    __syncthreads();
}
#ifndef EN
#define EN(k) 1
#endif
template <int PH> __device__ __forceinline__ void run_phase(unsigned char* ws, float* X, LAS unsigned char* lds, int wave, int lane) {
    const int G = gridDim.x, bx = blockIdx.x;
    bf16* XB = (bf16*)(ws + WS_XB); float* SSQ = (float*)(ws + WS_SSQ);
    bf16* R0 = (bf16*)(ws + WS_R);
    constexpr int layer = (PH >= 10) ? 1 : 0;
    if constexpr (!EN(PH)) { return; }
    else if constexpr (PH == 0) p0_prologue(ws, lds, wave, lane);
    else if constexpr (PH == 1) {
        if (bx < 64) { const int i = bx >> 5;
            pg8::Gemm g{(const pg8::bf16_t*)(ws + WS_MEMB), (const pg8::bf16_t*)(ws + WS_W_KV + (size_t)i * 16 * MiB), MROWS, 4096, 2048}; pg8::StaticOrder S; S.init(MROWS, 4096, 32, bx & 31);
            pg8::EpiKV E{(pg8::bf16_t*)(ws + WS_KB + (size_t)i * 2 * MiB), (pg8::bf16_t*)(ws + WS_VB + (size_t)i * 2 * MiB), (pg8::bf16_t*)(ws + WS_VTB + (size_t)i * 2 * MiB), (const float*)(ws + WS_SSQM)};
            pg8::gemm_phase<pg8::EpiKV, pg8::StaticOrder, PG8_ALIGNV, PG8_SP2V>(lds, g, S, E, wave, lane); }
        p1_convert(ws, lds, wave, lane);
    } else if constexpr (PH == 2) {
        pg8::Gemm g{XB, (const pg8::bf16_t*)(ws + WS_W_AIN), M, 4096, 2048}; pg8::StaticOrder S; S.init(M, 4096, G, bx);
        pg8::EpiAct<1, true> E{R0, 4096, ka_in(8), SSQ, 32, 1.0f, (float*)(ws + WS_VST), 8, (LAS float*)(lds + 131072)};
        {
#if defined(BG_CONV)
            const bool bgpre = (blockIdx.x & 1) != 0;
            if (bgpre) { bg_convert<PH>(ws, lds, wave, lane); __syncthreads(); }
#else
            const bool bgpre = true;
#endif
            pg8::gemm_phase<pg8::EpiAct<1, true>, pg8::StaticOrder, PG8_ALIGNV, PG8_SP2V>(lds, g, S, E, wave, lane);
            if (!bgpre) bg_convert<PH>(ws, lds, wave, lane); }
    } else if constexpr (PH == 3) {
#if defined(GATING_SIMPLE)
        gating_simple(lds, R0, (const float*)(ws + WS_VST), ka_in(9), ka_in(10), ka_in(11), ka_in(12), R0 + (size_t)M * 4096, wave * 64 + lane);
#else
        gating_mfma(lds, R0, (const float*)(ws + WS_VST), ka_in(9), ka_in(10), ka_in(11), ka_in(12), R0 + (size_t)M * 4096, wave, lane);
#endif
    }
    else if constexpr (PH == 4 || PH == 7 || PH == 9 || PH == 16 || PH == 18) {
        const pg8::bf16_t* A; const pg8::bf16_t* W; int K = 2048;
        if constexpr (PH == 4) { A = R0 + (size_t)M * 4096; W = (const pg8::bf16_t*)(ws + WS_W_AOUT); }
        else if constexpr (PH == 7 || PH == 16) { A = R0 + (size_t)M * 2048; W = (const pg8::bf16_t*)(ws + WS_W_O + (size_t)layer * 8 * MiB); }
        else { A = R0; W = (const pg8::bf16_t*)(ws + WS_W_DN + (size_t)layer * 32 * MiB); K = 8192; }
        pg8::Gemm g{A, W, M, 2048, K}; pg8::StaticOrder S; S.init(M, 2048, G, bx);
        pg8::EpiRes E{XB, SSQ};
        {
#if defined(BG_CONV)
            const bool bgpre = (blockIdx.x & 1) != 0;
            if (bgpre) { bg_convert<PH>(ws, lds, wave, lane); __syncthreads(); }
#else
            const bool bgpre = true;
#endif
            pg8::gemm_phase<pg8::EpiRes, pg8::StaticOrder, PG8_ALIGNV, PG8_SP2V>(lds, g, S, E, wave, lane);
            if (!bgpre) bg_convert<PH>(ws, lds, wave, lane); }
    } else if constexpr (PH == 5 || PH == 14 || PH == 10) {
        const pg8::bf16_t* W = (PH == 10) ? (const pg8::bf16_t*)(ws + WS_W_BIN) : (const pg8::bf16_t*)(ws + WS_W_Q + (size_t)layer * 8 * MiB);
        pg8::Gemm g{XB, W, M, 2048, 2048}; pg8::StaticOrder S; S.init(M, 2048, G, bx);
        pg8::EpiAct<0, false> E{R0, 2048, nullptr, SSQ, (PH == 14) ? 64 : 32, (PH == 10) ? 1.0f : 0.044194173824159216f * 1.4426950408889634f, nullptr, 0, (LAS float*)(lds + 131072)};
        {
#if defined(BG_CONV)
            const bool bgpre = (blockIdx.x & 1) != 0;
            if (bgpre) { bg_convert<PH>(ws, lds, wave, lane); __syncthreads(); }
#else
            const bool bgpre = true;
#endif
            pg8::gemm_phase<pg8::EpiAct<0, false>, pg8::StaticOrder, PG8_ALIGNV, PG8_SP2V>(lds, g, S, E, wave, lane);
            if (!bgpre) bg_convert<PH>(ws, lds, wave, lane); }
    } else if constexpr (PH == 6 || PH == 15) {
#if defined(ATTN_SIMPLE)
        attn_simple(lds, R0, (const bf16*)(ws + WS_KB + (size_t)layer * 2 * MiB), (const bf16*)(ws + WS_VB + (size_t)layer * 2 * MiB), R0 + (size_t)M * 2048, wave, lane);
#else
        attn_mfma(lds, R0, (const bf16*)(ws + WS_KB + (size_t)layer * 2 * MiB), (const bf16*)(ws + WS_VTB + (size_t)layer * 2 * MiB), R0 + (size_t)M * 2048, wave, lane);
#endif
    }
    else if constexpr (PH == 8 || PH == 17) {
        pg8::Gemm g{XB, (const pg8::bf16_t*)(ws + WS_W_UP + (size_t)layer * 32 * MiB), M, FF, 2048}; pg8::StaticOrder S; S.init(M, FF, G, bx);
        pg8::EpiAct<2, false> E{R0, FF, nullptr, SSQ, 32, 1.0f, nullptr, 0, (LAS float*)(lds + 131072)};
        {
#if defined(BG_CONV)
            const bool bgpre = (blockIdx.x & 1) != 0;
            if (bgpre) { bg_convert<PH>(ws, lds, wave, lane); __syncthreads(); }
#else
            const bool bgpre = true;
#endif
            pg8::gemm_phase<pg8::EpiAct<2, false>, pg8::StaticOrder, PG8_ALIGNV, PG8_SP2V>(lds, g, S, E, wave, lane);
            if (!bgpre) bg_convert<PH>(ws, lds, wave, lane); }
    } else if constexpr (PH == 11) {
#if defined(S5_SIMPLE)
        s5_pass_a(R0, (f32x2*)(ws + WS_S5ST), wave, lane);
#endif
    } else if constexpr (PH == 12) {
#if defined(S5_SIMPLE)
        s5_pass_c(lds, R0, (const f32x2*)(ws + WS_S5ST), R0 + (size_t)M * 2048, wave, lane);
#else
        s5_mfma(lds, R0, R0 + (size_t)M * 2048, wave, lane);
#endif
    }
    else if constexpr (PH == 13) {
        pg8::Gemm g{R0 + (size_t)M * 2048, (const pg8::bf16_t*)(ws + WS_W_BOUT), M, 4096, 2048}; pg8::StaticOrder S; S.init(M, 4096, G, bx);
        pg8::EpiGlu E{XB, SSQ, ka_in(24)};
        pg8::gemm_phase<pg8::EpiGlu, pg8::StaticOrder, PG8_ALIGNV, PG8_SP2V>(lds, g, S, E, wave, lane);
    } else if constexpr (PH == 19) final_norm(XB, SSQ, ka_in(6), X, wave, lane);
}
__device__ __forceinline__ int lane_id() { int l; asm volatile("v_mbcnt_lo_u32_b32 %0, -1, 0\n\tv_mbcnt_hi_u32_b32 %0, -1, %0" : "=v"(l)); return l; }

#define XB_TMO      128
#define XB_XCNT(j)  (256  + 64 * (j))
#define XB_XSUB(j)  (1280 + 64 * (j))
#define XB_XGEN(j)  (2304 + 64 * (j))
#define XB_TOP      3328
#define XB_TOPGEN   3392
#define XCD_BAR_WORDS 3456
#define XB_SPIN_CAP (1u << 22)
__device__ __forceinline__ unsigned xb_ld(unsigned* p)              { return __hip_atomic_load(p, __ATOMIC_RELAXED, __HIP_MEMORY_SCOPE_AGENT); }
__device__ __forceinline__ unsigned xb_add(unsigned* p, unsigned v) { return __hip_atomic_fetch_add(p, v, __ATOMIC_RELAXED, __HIP_MEMORY_SCOPE_AGENT); }
__device__ __forceinline__ unsigned xb_xcc_id() { return (unsigned)__builtin_amdgcn_s_getreg((3 << 11) | 20) & 0xFu; }
#define XB_SPIN(cond, bar) do { unsigned _sp = 0; while (cond) { __builtin_amdgcn_s_sleep(1); \
    if ((++_sp & 255u) == 0u) { if (xb_ld(&(bar)[XB_TMO])) break; if (_sp > XB_SPIN_CAP) { atomicAdd(&(bar)[XB_TMO], 1u); break; } } } } while (0)
__device__ __forceinline__ void xcd_barrier_complete(unsigned* bar, unsigned x, unsigned& nloc, unsigned& nx) {
    const unsigned G = gridDim.x * gridDim.y * gridDim.z;
    unsigned sum, cnt, mine, sp = 0u;
    for (;;) {
        sum = 0u; cnt = 0u; mine = 0u;
#pragma unroll
        for (unsigned j = 0; j < 16; ++j) { const unsigned c = xb_ld(&bar[XB_XCNT(j)]); sum += c; cnt += (c > 0u) ? 1u : 0u; mine = (j == x) ? c : mine; }
        if (sum == G) break;
        __builtin_amdgcn_s_sleep(1);
        if ((++sp & 255u) == 0u) { if (xb_ld(&bar[XB_TMO])) break; if (sp > XB_SPIN_CAP) { atomicAdd(&bar[XB_TMO], 1u); break; } }
    }
    nloc = mine > 0u ? mine : 1u; nx = cnt > 0u ? cnt : 1u;
}
__device__ __forceinline__ void xcd_barrier(unsigned* bar, volatile LAS unsigned* st, bool is_t0) {
    asm volatile("s_waitcnt vmcnt(0)" ::: "memory");
    __syncthreads();
    if (is_t0) {
        __builtin_amdgcn_s_waitcnt(0);
        const unsigned x = xb_xcc_id();
        unsigned nloc = st[0], nx = st[1];
        if (nloc == 0u) { xcd_barrier_complete(bar, x, nloc, nx); st[0] = nloc; st[1] = nx; }
        const unsigned old = xb_add(&bar[XB_XSUB(x)], 1u);
        const unsigned gen = old / nloc;
        if (old + 1u == (gen + 1u) * nloc) {
            __builtin_amdgcn_fence(__ATOMIC_RELEASE, "agent");
            asm volatile("s_waitcnt vmcnt(0)" ::: "memory");
            const unsigned og = xb_add(&bar[XB_TOP], 1u);
            const unsigned tg = og / nx;
            if (og + 1u == (tg + 1u) * nx) xb_add(&bar[XB_TOPGEN], 1u);
            else XB_SPIN(xb_ld(&bar[XB_TOPGEN]) == tg, bar);
            __builtin_amdgcn_fence(__ATOMIC_ACQUIRE, "agent");
            xb_add(&bar[XB_XGEN(x)], 1u);
            asm volatile("s_waitcnt vmcnt(0)" ::: "memory");
        } else {
            XB_SPIN(xb_ld(&bar[XB_XGEN(x)]) == gen, bar);
            __builtin_amdgcn_fence(__ATOMIC_ACQUIRE, "agent");
            asm volatile("s_waitcnt vmcnt(0)" ::: "memory");
        }
    }
    __syncthreads();
}

__global__ void __launch_bounds__(NTHREADS, 2) trunk_fwd(Args args) {
    extern __shared__ __attribute__((aligned(16))) unsigned char lds_raw[];
    LAS unsigned char* lds = (LAS unsigned char*)lds_raw;
    const int wave = __builtin_amdgcn_readfirstlane((int)threadIdx.x >> 6);
    const int lo = args.ph_lo, hi = args.ph_hi;
    unsigned* bar = (unsigned*)args.ws + 4096;
    volatile LAS unsigned* st = (volatile LAS unsigned*)(lds + LDS_BYTES - 512);
#if MK_N_LAUNCHES == 1
    { const int l0 = lane_id(); if (wave == 0 && l0 < 2) st[l0] = 0u; __syncthreads(); if (wave == 0 && l0 == 0) (void)xb_add(&bar[XB_XCNT(xb_xcc_id())], 1u); }
#if defined(USE_CG_SYNC)
#define GRID_BAR(k) do { if ((k) == 1) cg::this_grid().sync(); else xcd_barrier(bar, st, wave == 0 && lane_id() == 0); } while (0)
#else
#define GRID_BAR(k) do { xcd_barrier(bar, st, wave == 0 && lane_id() == 0); } while (0)
#endif
#else
#define GRID_BAR(k) do { } while (0)
#endif
#ifndef DUP_PH
#define DUP_PH -1
#endif
#if defined(PROBE_GEMM)
#if PROBE_GEMM == 3
typedef pg8::StaticOrder ProbeOrder;
#else
struct ProbeOrder { int c;
    __device__ __forceinline__ void init(int, int, int, int c_) { c = c_; }
    __device__ __forceinline__ bool next(int i, pg8::Unit& u) const { if (i >= 4) return false;
#if PROBE_GEMM == 1
        u.pm = 0; u.pn = 0;
#else
        u.pm = c >> 3; u.pn = c & 7;
#endif
        return true; }
    __device__ __forceinline__ void a_ready(const pg8::Unit&) const {}
    __device__ __forceinline__ void done(const pg8::Unit&) const {} };
#endif
#endif
#if defined(STAMP_SEL)
#define STAMP(k) do { if (blockIdx.x == 0 && wave == 0 && lane_id() == 0) st[4 + (k)] = (unsigned)__builtin_amdgcn_s_memrealtime(); } while (0)
#else
#define STAMP(k) do { } while (0)
#endif
#define PHASE(k) if (lo <= (k) && (k) < hi) { if ((k) > lo) GRID_BAR(k); STAMP(k); run_phase<k>(args.ws, args.out, lds, wave, lane_id()); STAMP(50 + (k)); if ((k) == DUP_PH) { GRID_BAR(2); run_phase<k>(args.ws, args.out, lds, wave, lane_id()); } }
#if defined(PROBE_WRITE)
    { const int lane = lane_id(); const int gw = blockIdx.x * NWAVES + wave, NGW = gridDim.x * NWAVES;
      for (int it = gw; it < 30720; it += NGW) { ConvSel s = conv_select(args.ws, __builtin_amdgcn_readfirstlane(it));
#if PROBE_WRITE == 1
          const int nblk = s.N >> 6, kb = s.item / nblk, nb = s.item - kb * nblk, k0 = 64 * kb, n0 = 64 * nb; const int c = lane & 7;
#pragma unroll
          for (int j = 0; j < 8; ++j) { const int n = (lane >> 3) + 8 * j; const int nr = s.mode ? glu_rowmap(n0 + n) : (n0 + n); *(v4u*)(s.WT + (size_t)nr * s.K + k0 + 8 * c) = (v4u){0u, 0u, 0u, 0u}; }
#else
          bf16* dst = s.WT + (size_t)s.item * 4096;
#pragma unroll
          for (int j = 0; j < 8; ++j) *(v4u*)(dst + (j * 64 + lane) * 8) = (v4u){0u, 0u, 0u, 0u};
#endif
      }
      GRID_BAR(2); }
#endif
    PHASE(0) PHASE(1) PHASE(2) PHASE(3) PHASE(4) PHASE(5) PHASE(6) PHASE(7) PHASE(8) PHASE(9)
#if defined(PROBE_GEMM)
    { GRID_BAR(2); const int lane = lane_id(); unsigned char* ws = args.ws; bf16* R0 = (bf16*)(ws + WS_R);
      pg8::Gemm g{(bf16*)(ws + WS_XB), (const pg8::bf16_t*)(ws + WS_W_UP), M, FF, 2048}; ProbeOrder S; S.init(M, FF, gridDim.x, blockIdx.x);
      pg8::EpiAct<2, false> E{R0, FF, nullptr, (float*)(ws + WS_SSQ), 32, 1.0f, nullptr, 0};
      pg8::gemm_phase<pg8::EpiAct<2, false>, ProbeOrder, true, true>(lds, g, S, E, wave, lane); }
#endif
#if defined(PROBE_READ)
    { GRID_BAR(2); const int lane = lane_id(); const int gw = blockIdx.x * NWAVES + wave, NGW = gridDim.x * NWAVES; f32x4 accv = (f32x4){0.f, 0.f, 0.f, 0.f};
      for (int it = gw; it < 30720; it += NGW) { f32x4 v[16]; ConvSel s = conv_select(args.ws, __builtin_amdgcn_readfirstlane(it)); conv_load(s, v, lane);
#pragma unroll
          for (int i = 0; i < 16; ++i) accv += v[i]; }
      if (accv[0] + accv[1] + accv[2] + accv[3] == 12345.678f) ((float*)(args.ws + WS_S5ST))[gw * 64 + lane] = accv[0]; }
#endif
#if defined(EXTRA_BARS)
    for (int eb = 0; eb < EXTRA_BARS; ++eb) GRID_BAR(2);
#endif
    PHASE(10)
#if defined(S5_SIMPLE)
    PHASE(11)
#endif
    PHASE(12) PHASE(13) PHASE(14) PHASE(15) PHASE(16) PHASE(17) PHASE(18) PHASE(19)
#undef PHASE
#if defined(STAMP_SEL)
    asm volatile("s_waitcnt vmcnt(0)" ::: "memory"); __syncthreads(); STAMP(20);
    if (blockIdx.x == 0 && wave == 0 && lane_id() == 0) { unsigned d = (st[4 + STAMP_SEL_END] - st[4 + STAMP_SEL]); d = (d > 100000u ? 0u : d) * STAMP_MUL; const unsigned t0 = (unsigned)__builtin_amdgcn_s_memrealtime();
        while ((unsigned)__builtin_amdgcn_s_memrealtime() - t0 < d) __builtin_amdgcn_s_sleep(8); }
#endif
}

extern "C" void kernel_launch(void* const* d_in, const int* in_sizes, int n_in, void* d_out, int out_size, void* d_ws, size_t ws_size, hipStream_t stream) {
    static int grid = 0;
    if (grid == 0) {
        if (n_in != 30 || out_size != M * D || ws_size < WS_END) { fprintf(stderr, "kernel_launch: unexpected shapes (n_in %d out %d ws %zu)\n", n_in, out_size, ws_size); grid = -1; return; }
        int dev = 0, cus = 0, per_cu = 0;
        if (hipGetDevice(&dev) != hipSuccess || hipDeviceGetAttribute(&cus, hipDeviceAttributeMultiprocessorCount, dev) != hipSuccess) { grid = -1; return; }
        if (hipFuncSetAttribute((const void*)trunk_fwd, hipFuncAttributeMaxDynamicSharedMemorySize, LDS_BYTES) != hipSuccess) { fprintf(stderr, "kernel_launch: hipFuncSetAttribute failed\n"); grid = -1; return; }
        if (hipOccupancyMaxActiveBlocksPerMultiprocessor(&per_cu, (const void*)trunk_fwd, NTHREADS, LDS_BYTES) != hipSuccess || per_cu < 1) { fprintf(stderr, "kernel_launch: occupancy query says %d\n", per_cu); grid = -1; return; }
        grid = cus;
    }
    if (grid < 0) return;
    if (hipMemsetAsync(d_ws, 0, 65536, stream) != hipSuccess) { fprintf(stderr, "kernel_launch: memset failed\n"); return; }
    Args a{};
    for (int i = 0; i < 30; ++i) a.in[i] = (const float*)d_in[i];
    a.out = (float*)d_out; a.ws = (unsigned char*)d_ws;
#if MK_N_LAUNCHES == 1
    a.ph_lo = 0; a.ph_hi = NPH;
    void* kargs[] = {&a};
    hipError_t e = hipLaunchCooperativeKernel((const void*)trunk_fwd, dim3(grid), dim3(NTHREADS), kargs, LDS_BYTES, stream);
    if (e != hipSuccess) fprintf(stderr, "kernel_launch: cooperative launch failed: %s\n", hipGetErrorString(e));
#else
    for (int ph = 0; ph < NPH; ++ph) { a.ph_lo = ph; a.ph_hi = ph + 1; hipLaunchKernelGGL(trunk_fwd, dim3(grid), dim3(NTHREADS), LDS_BYTES, stream, a); }
#endif
}
```

```cpp
#include <hip/hip_runtime.h>
#include <hip/hip_cooperative_groups.h>
#include <cstdio>
#include <cstdint>
namespace cg = cooperative_groups;
#define MK_N_LAUNCHES 1
namespace pg8 {
#define PG8_LAS __attribute__((address_space(3)))
typedef unsigned short bf16_t;
typedef short bf16x8 __attribute__((ext_vector_type(8)));
typedef float f32x4 __attribute__((ext_vector_type(4)));
typedef unsigned u32x4 __attribute__((ext_vector_type(4)));
constexpr int BM = 256, BK = 64, HALF = 128, HTB = HALF * BK * 2  , STAGE_BYTES = 8 * HTB, NXCD = 8, WGM = 8;

__host__ __device__ __forceinline__ int lds_byte(int r, int c) { const int st = (r >> 4) * 2 + (c >> 5), rr = r & 15, cc = c & 31, ob = rr * 64 + cc * 2; return st * 1024 + (ob ^ (((ob >> 9) & 1) << 5)); }
__host__ __device__ __forceinline__ void stage_rc(int b, int& R, int& C) { const int st = b / 1024, sb = b % 1024, swz = sb ^ (((sb >> 9) & 1) << 5); R = (st >> 1) * 16 + swz / 64; C = (st & 1) * 32 + (swz % 64) / 2; }
__host__ __device__ __forceinline__ int perm32(int rho) { const int n = rho >> 4, i = rho & 15; return 8 * (i >> 2) + 4 * n + (i & 3); }

struct Unit { int pm, pn; };
struct Gemm { const bf16_t* A; const bf16_t* Bt; int M, N, K; };

struct StaticOrder {
    int nM, nN, nwg, G, c;
    __host__ __device__ void init(int M, int N, int G_, int c_) { nM = M / BM; nN = N / BM; nwg = nM * nN; G = G_; c = c_; }
    __host__ __device__ bool next(int i, Unit& u) const {
        const long L = (long)i * G + c; if (L >= nwg) return false;
        int wgid = (int)L; { const int q = nwg / NXCD, r = nwg % NXCD, xcd = wgid % NXCD, off = wgid / NXCD; wgid = (xcd < r ? xcd * (q + 1) : r * (q + 1) + (xcd - r) * q) + off; }
        const int nig = WGM * nN, gid = wgid / nig, fm = gid * WGM, gsz = (nM - fm) < WGM ? (nM - fm) : WGM;
        u.pm = fm + ((wgid % nig) % gsz); u.pn = (wgid % nig) / gsz; return true;
    }
    __device__ __forceinline__ void a_ready(const Unit&) const {}
    __device__ __forceinline__ void done(const Unit&) const {}
};

__device__ __forceinline__ unsigned cvt_pk_bf16(float lo, float hi) { unsigned r; asm volatile("v_cvt_pk_bf16_f32 %0, %1, %2" : "=v"(r) : "v"(lo), "v"(hi)); return r; }
typedef float f32x2 __attribute__((ext_vector_type(2)));
__device__ __forceinline__ f32x2 gelu_pk(f32x2 v) {
    const f32x2 av = __builtin_elementwise_abs(v), d = av * 0.2316418882f + 1.0f;
    f32x2 t; t.x = __builtin_amdgcn_rcpf(d.x); t.y = __builtin_amdgcn_rcpf(d.y);
    f32x2 q = t * 0.5307027145f + (-0.7265760135f); q = q * t + 0.7107068705f; q = q * t + (-0.142248368f); q = q * t + 0.127414796f; q = q * t;
    const f32x2 s = (v * v) * (-0.72134752044f);
    f32x2 e; e.x = __builtin_amdgcn_exp2f(s.x); e.y = __builtin_amdgcn_exp2f(s.y);
    const f32x2 m = v * (q * e), r = v - m;
    f32x2 o; o.x = v.x < 0.f ? m.x : r.x; o.y = v.y < 0.f ? m.y : r.y; return o;
}
typedef unsigned u32x2 __attribute__((ext_vector_type(2)));
#if defined(WT_STORES)
__device__ __forceinline__ void st_wt16(void* p, u32x4 v) { asm volatile("global_store_dwordx4 %0, %1, off sc1\n\ts_nop 1" :: "v"(p), "v"(v) : "memory"); }
__device__ __forceinline__ void st_wt8(void* p, u32x2 v) { asm volatile("global_store_dwordx2 %0, %1, off sc1\n\ts_nop 1" :: "v"(p), "v"(v) : "memory"); }
#else
__device__ __forceinline__ void st_wt16(void* p, u32x4 v) { *(u32x4*)p = v; }
__device__ __forceinline__ void st_wt8(void* p, u32x2 v) { *(u32x2*)p = v; }
#endif
constexpr int SSQ_STRIDE = 64;
__device__ __forceinline__ float row_rstd(const float* ssq, int np, int row, int fq) {
    const float* p = ssq + (size_t)row * SSQ_STRIDE + fq * (np >> 2);
    f32x4 a = *(const f32x4*)p, b = *(const f32x4*)(p + 4);
    float s = (a[0] + a[1]) + (a[2] + a[3]) + (b[0] + b[1]) + (b[2] + b[3]);
    if (np == 64) { f32x4 c = *(const f32x4*)(p + 8), d = *(const f32x4*)(p + 12); s += (c[0] + c[1]) + (c[2] + c[3]) + (d[0] + d[1]) + (d[2] + d[3]); }
    s += __shfl_xor(s, 16); s += __shfl_xor(s, 32);
    return __builtin_amdgcn_rsqf(s * (1.0f / 2048.0f) + 1e-6f);
}
template <int ACT, bool STATS> struct EpiAct {
    static constexpr bool PERM = true, AFTER_DRAIN = false, HAS_PRE = true;
    bf16_t* O; int ldc; const float* bias; const float* ssq; int np; float oscale; float* vst; int stat_pn0; PG8_LAS float* rsl;
    __device__ __forceinline__ void pre_issue(f32x4 (&r)[4], const Unit& u, int tid) const {
        if (tid < 256) { const float* p = ssq + (size_t)(u.pm * BM + tid) * SSQ_STRIDE;
#pragma unroll
            for (int k = 0; k < 4; ++k) r[k] = *(const f32x4*)(p + 4 * k) + *(const f32x4*)(p + 16 + 4 * k);
            if (np == 64) {
#pragma unroll
                for (int k = 0; k < 4; ++k) r[k] += *(const f32x4*)(p + 32 + 4 * k) + *(const f32x4*)(p + 48 + 4 * k); } } }
    __device__ __forceinline__ void pre_commit(const f32x4 (&r)[4], PG8_LAS unsigned char*, int tid) const {
        if (tid < 256) { const f32x4 s4 = (r[0] + r[1]) + (r[2] + r[3]); const float s = (s4[0] + s4[1]) + (s4[2] + s4[3]); rsl[tid] = __builtin_amdgcn_rsqf(s * (1.0f / 2048.0f) + 1e-6f); } }
    __device__ __forceinline__ void operator()(const f32x4 (&acc)[2][2][4][2], const Unit& u, int wr, int wc, int fr, int fq) const {
        const int row0 = u.pm * BM + wr * 64 + fr, col0 = u.pn * BM + wc * 32 + 8 * fq;
        f32x4 bv[2][2];
#pragma unroll
        for (int bj = 0; bj < 2; ++bj)
#pragma unroll
            for (int n = 0; n < 2; ++n) bv[bj][n] = bias ? *(const f32x4*)(bias + col0 + bj * HALF + 4 * n) : (f32x4){0.f, 0.f, 0.f, 0.f};
        float rsv[2][4];
#pragma unroll
        for (int ai = 0; ai < 2; ++ai) {
#pragma unroll
            for (int m = 0; m < 4; ++m) rsv[ai][m] = rsl[ai * HALF + wr * 64 + m * 16 + fr]; }
#pragma unroll
        for (int ai = 0; ai < 2; ++ai)
#pragma unroll
            for (int m = 0; m < 4; ++m) { const int row = row0 + ai * HALF + m * 16; const float rs = rsv[ai][m];
                bf16_t* rowp = O + (size_t)row * ldc + col0; float s1 = 0.f, s2 = 0.f;
#pragma unroll
                for (int bj = 0; bj < 2; ++bj) { f32x4 v0 = acc[ai][bj][m][0] * rs + bv[bj][0], v1 = acc[ai][bj][m][1] * rs + bv[bj][1];
                    if (ACT == 1) { f32x2 a = gelu_pk((f32x2){v0[0], v0[1]}), b = gelu_pk((f32x2){v0[2], v0[3]}), c = gelu_pk((f32x2){v1[0], v1[1]}), d = gelu_pk((f32x2){v1[2], v1[3]});
                        v0 = (f32x4){a.x, a.y, b.x, b.y}; v1 = (f32x4){c.x, c.y, d.x, d.y}; }
                    if (ACT == 2) {
#pragma unroll
                        for (int j = 0; j < 4; ++j) { const float a = fmaxf(v0[j], 0.f), b = fmaxf(v1[j], 0.f); v0[j] = a * a; v1[j] = b * b; } }
                    v0 = v0 * oscale; v1 = v1 * oscale;
                    if (STATS) { s1 += (v0[0] + v0[1]) + (v0[2] + v0[3]) + (v1[0] + v1[1]) + (v1[2] + v1[3]);
                        s2 += (v0[0] * v0[0] + v0[1] * v0[1]) + (v0[2] * v0[2] + v0[3] * v0[3]) + (v1[0] * v1[0] + v1[1] * v1[1]) + (v1[2] * v1[2] + v1[3] * v1[3]); }
                    u32x4 w; w.x = cvt_pk_bf16(v0[0], v0[1]); w.y = cvt_pk_bf16(v0[2], v0[3]); w.z = cvt_pk_bf16(v1[0], v1[1]); w.w = cvt_pk_bf16(v1[2], v1[3]);
                    st_wt16(rowp + bj * HALF, w); }
                if (STATS) { s1 += __shfl_xor(s1, 16); s1 += __shfl_xor(s1, 32); s2 += __shfl_xor(s2, 16); s2 += __shfl_xor(s2, 32);
                    if (u.pn >= stat_pn0 && fq == 0) *(f32x2*)(vst + (size_t)row * SSQ_STRIDE + ((u.pn - stat_pn0) * 4 + wc) * 2) = (f32x2){s1, s2}; }
            }
    }
};
struct EpiRes {
    static constexpr bool PERM = true, AFTER_DRAIN = false, HAS_PRE = false;
    bf16_t* xb; float* ssq;
    __device__ __forceinline__ void operator()(const f32x4 (&acc)[2][2][4][2], const Unit& u, int wr, int wc, int fr, int fq) const {
        const int row0 = u.pm * BM + wr * 64 + fr, col0 = u.pn * BM + wc * 32 + 8 * fq;
        u32x4 pre[2][4][2];
#pragma unroll
        for (int ai = 0; ai < 2; ++ai)
#pragma unroll
            for (int m = 0; m < 4; ++m) { const size_t off = (size_t)(row0 + ai * HALF + m * 16) * 2048 + col0;
#pragma unroll
                for (int bj = 0; bj < 2; ++bj) pre[ai][m][bj] = *(const u32x4*)(xb + off + bj * HALF); }
        asm volatile("" ::: "memory");
#pragma unroll
        for (int ai = 0; ai < 2; ++ai) {
#pragma unroll
            for (int m = 0; m < 4; ++m) { const int row = row0 + ai * HALF + m * 16; const size_t off = (size_t)row * 2048 + col0; float ss = 0.f;
#pragma unroll
                for (int bj = 0; bj < 2; ++bj) { const u32x4 b = pre[ai][m][bj]; const f32x4 a0 = acc[ai][bj][m][0], a1 = acc[ai][bj][m][1];
                    const float o0 = __builtin_bit_cast(float, b.x << 16) + a0[0], o1 = __builtin_bit_cast(float, b.x & 0xffff0000u) + a0[1], o2 = __builtin_bit_cast(float, b.y << 16) + a0[2], o3 = __builtin_bit_cast(float, b.y & 0xffff0000u) + a0[3];
                    const float o4 = __builtin_bit_cast(float, b.z << 16) + a1[0], o5 = __builtin_bit_cast(float, b.z & 0xffff0000u) + a1[1], o6 = __builtin_bit_cast(float, b.w << 16) + a1[2], o7 = __builtin_bit_cast(float, b.w & 0xffff0000u) + a1[3];
                    ss += (o0 * o0 + o1 * o1) + (o2 * o2 + o3 * o3) + (o4 * o4 + o5 * o5) + (o6 * o6 + o7 * o7);
                    u32x4 w; w.x = cvt_pk_bf16(o0, o1); w.y = cvt_pk_bf16(o2, o3); w.z = cvt_pk_bf16(o4, o5); w.w = cvt_pk_bf16(o6, o7); st_wt16(xb + off + bj * HALF, w); }
                ss += __shfl_xor(ss, 16); ss += __shfl_xor(ss, 32);
                if (fq == 0) ssq[(size_t)row * SSQ_STRIDE + u.pn * 4 + wc] = ss; }
            asm volatile("" ::: "memory"); }
    }
};
struct EpiGlu {
    static constexpr bool PERM = false, AFTER_DRAIN = false, HAS_PRE = false;
    bf16_t* xb; float* ssq; const float* bias;
    __device__ __forceinline__ void operator()(const f32x4 (&acc)[2][2][4][2], const Unit& u, int wr, int wc, int fr, int fq) const {
        const int row0 = u.pm * BM + wr * 64 + fr, col0 = u.pn * 128 + wc * 16 + 4 * fq;
        f32x4 bval[2], bgate[2];
#pragma unroll
        for (int bj = 0; bj < 2; ++bj) { bval[bj] = *(const f32x4*)(bias + col0 + bj * 64); bgate[bj] = *(const f32x4*)(bias + 2048 + col0 + bj * 64); }
#pragma unroll
        for (int ai = 0; ai < 2; ++ai) {
            u32x2 pre[4][2];
#pragma unroll
            for (int m = 0; m < 4; ++m) { const size_t off = (size_t)(row0 + ai * HALF + m * 16) * 2048 + col0;
#pragma unroll
                for (int bj = 0; bj < 2; ++bj) pre[m][bj] = *(const u32x2*)(xb + off + bj * 64); }
            asm volatile("" ::: "memory");
#pragma unroll
            for (int m = 0; m < 4; ++m) { const int row = row0 + ai * HALF + m * 16; const size_t off = (size_t)row * 2048 + col0; float ss = 0.f;
#pragma unroll
                for (int bj = 0; bj < 2; ++bj) { const f32x4 val = acc[ai][bj][m][0] + bval[bj], gate = acc[ai][bj][m][1] + bgate[bj]; const u32x2 pb = pre[m][bj]; f32x4 o = (f32x4){__builtin_bit_cast(float, pb.x << 16), __builtin_bit_cast(float, pb.x & 0xffff0000u), __builtin_bit_cast(float, pb.y << 16), __builtin_bit_cast(float, pb.y & 0xffff0000u)};
#pragma unroll
                    for (int j = 0; j < 4; ++j) { const float sg = __builtin_amdgcn_rcpf(1.0f + __builtin_amdgcn_exp2f(-1.4426950408889634f * gate[j])); o[j] += val[j] * sg; }
                    ss += (o[0] * o[0] + o[1] * o[1]) + (o[2] * o[2] + o[3] * o[3]);
                    u32x2 w; w.x = cvt_pk_bf16(o[0], o[1]); w.y = cvt_pk_bf16(o[2], o[3]); st_wt8(xb + off + bj * 64, w); }
                ss += __shfl_xor(ss, 16); ss += __shfl_xor(ss, 32);
                if (fq == 0) ssq[(size_t)row * SSQ_STRIDE + u.pn * 4 + wc] = ss; }
            asm volatile("" ::: "memory"); }
    }
};
__host__ __device__ __forceinline__ int vt_pos(int key) { const int s = key >> 5, w = key & 31; return 32 * s + 8 * ((w & 15) >> 2) + (w & 3) + 4 * (w >> 4); }
struct EpiKV {
    static constexpr bool PERM = true, AFTER_DRAIN = false, HAS_PRE = false;
    bf16_t* Kb; bf16_t* Vb; bf16_t* VTb; const float* ssq;
    __device__ __forceinline__ void operator()(const f32x4 (&acc)[2][2][4][2], const Unit& u, int wr, int wc, int fr, int fq) const {
        const int row0 = u.pm * BM + wr * 64 + fr, col0 = u.pn * BM + wc * 32 + 8 * fq;
#pragma unroll
        for (int ai = 0; ai < 2; ++ai)
#pragma unroll
            for (int m = 0; m < 4; ++m) { const int row = row0 + ai * HALF + m * 16; const float rs = row_rstd(ssq, 32, row, fq); const int b = row >> 8, key = row & 255;
#pragma unroll
                for (int bj = 0; bj < 2; ++bj) { const f32x4 v0 = acc[ai][bj][m][0] * rs, v1 = acc[ai][bj][m][1] * rs; const int col = col0 + bj * HALF;
                    u32x4 w; w.x = cvt_pk_bf16(v0[0], v0[1]); w.y = cvt_pk_bf16(v0[2], v0[3]); w.z = cvt_pk_bf16(v1[0], v1[1]); w.w = cvt_pk_bf16(v1[2], v1[3]);
                    if (col < 2048) { const int h = col >> 9, d = col & 511; *(u32x4*)(Kb + ((size_t)((b * 4 + h) * 256 + key)) * 512 + d) = w; }
                    else { const int c2 = col - 2048, h = c2 >> 9, d = c2 & 511; *(u32x4*)(Vb + ((size_t)((b * 4 + h) * 256 + key)) * 512 + d) = w;
                        bf16_t* vt = VTb + ((size_t)((b * 4 + h) * 512 + d)) * 256 + vt_pos(key);
                        vt[0 * 256] = (bf16_t)(w.x & 0xffffu); vt[1 * 256] = (bf16_t)(w.x >> 16); vt[2 * 256] = (bf16_t)(w.y & 0xffffu); vt[3 * 256] = (bf16_t)(w.y >> 16);
                        vt[4 * 256] = (bf16_t)(w.z & 0xffffu); vt[5 * 256] = (bf16_t)(w.z >> 16); vt[6 * 256] = (bf16_t)(w.w & 0xffffu); vt[7 * 256] = (bf16_t)(w.w >> 16); } }
            }
    }
};
template <class Epi, class Sched, bool ALIGN_EPI = false, bool SP2 = false>
__device__ __forceinline__ void gemm_phase(PG8_LAS unsigned char* lds, const Gemm g, const Sched& S, const Epi& E, const int wid  , const int lane) {
    const int tid = wid * 64 + lane, wr = wid >> 2, wc = wid & 3, fr = lane & 15, fq = lane >> 4;
    const int K = g.K, nt = K / BK;
    unsigned voffA[2], voffB[2];
#pragma unroll
    for (int i = 0; i < 2; ++i) { int R, C; stage_rc(tid * 16 + i * 8192, R, C); const int Rb = Epi::PERM ? ((R & ~31) + perm32(R & 31)) : R;
        voffA[i] = (unsigned)(R * K + C) * 2u; voffB[i] = (unsigned)(Rb * K + C) * 2u; }
    const size_t kstep = (size_t)(BK * 2);
    const size_t hstep = (size_t)HALF * K * 2;
    const size_t tstep = 2 * hstep;
    const unsigned ldsw = (unsigned)wid * 1024u;
    const int aoff = lds_byte(wr * 64 + fr, fq * 8), boff = lds_byte(wc * 32 + fr, fq * 8);
#define PG8_SA(b, h) (((b) * 2 + (h)) * HTB)
#define PG8_SB(b, h) ((4 + (b) * 2 + (h)) * HTB)
#define PG8_STAGE(bufoff, gbase, voff) do { _Pragma("unroll") for (int _i = 0; _i < 2; ++_i) \
        __builtin_amdgcn_global_load_lds((const unsigned*)((const char*)(gbase) + (voff)[_i]), (PG8_LAS unsigned*)(lds + (bufoff) + ldsw + _i * 8192), 16, 0, 0); } while (0)
#define PG8_LDA(dst, b, h) do { _Pragma("unroll") for (int m = 0; m < 4; ++m) _Pragma("unroll") for (int k = 0; k < 2; ++k) dst[m][k] = *(const PG8_LAS bf16x8*)(lds + PG8_SA(b, h) + aoff + m * 2048 + k * 1024); } while (0)
#define PG8_LDB(dst, b, h) do { _Pragma("unroll") for (int n = 0; n < 2; ++n) _Pragma("unroll") for (int k = 0; k < 2; ++k) dst[n][k] = *(const PG8_LAS bf16x8*)(lds + PG8_SB(b, h) + boff + n * 2048 + k * 1024); } while (0)
#define PG8_MMA(ai, bj, At, Bt) do { __builtin_amdgcn_s_setprio(1); _Pragma("unroll") for (int m = 0; m < 4; ++m) _Pragma("unroll") for (int n = 0; n < 2; ++n) _Pragma("unroll") for (int k = 0; k < 2; ++k) \
        acc[ai][bj][m][n] = __builtin_amdgcn_mfma_f32_16x16x32_bf16(Bt[n][k], At[m][k], acc[ai][bj][m][n], 0, 0, 0); __builtin_amdgcn_s_setprio(0); } while (0)
#define PG8_WAIT_V(n) asm volatile("s_waitcnt vmcnt(" #n ")" ::: "memory")
#define PG8_WAIT_L(n) asm volatile("s_waitcnt lgkmcnt(" #n ")" ::: "memory")
#define PG8_BAR __builtin_amdgcn_s_barrier()
#define PG8_SCHED __builtin_amdgcn_sched_barrier(0)
    Unit cur, nxt; int ui = 0;
    if (!S.next(0, cur)) return;
    f32x4 acc[2][2][4][2];
#pragma unroll
    for (int a = 0; a < 2; ++a)
#pragma unroll
        for (int b = 0; b < 2; ++b)
#pragma unroll
            for (int m = 0; m < 4; ++m)
#pragma unroll
                for (int n = 0; n < 2; ++n) acc[a][b][m][n] = (f32x4){0.f, 0.f, 0.f, 0.f};
    bf16x8 At[4][2], B0[2][2], B1[2][2];
    const char* cA = (const char*)g.A + (size_t)cur.pm * tstep; const char* cB = (const char*)g.Bt + (size_t)cur.pn * tstep;
    S.a_ready(cur);
    f32x4 prereg[4]; if constexpr (Epi::HAS_PRE) E.pre_issue(prereg, cur, tid);
    if constexpr (SP2) {
        PG8_STAGE(PG8_SB(0, 0), cB, voffB); PG8_STAGE(PG8_SB(0, 1), cB + hstep, voffB); PG8_STAGE(PG8_SA(0, 0), cA, voffA); PG8_STAGE(PG8_SA(0, 1), cA + hstep, voffA);
        if (wr == 1) PG8_BAR;
        PG8_WAIT_V(2); PG8_BAR;
        PG8_STAGE(PG8_SB(1, 0), cB + kstep, voffB); PG8_STAGE(PG8_SA(1, 0), cA + kstep, voffA); PG8_STAGE(PG8_SB(1, 1), cB + hstep + kstep, voffB);
        PG8_WAIT_V(6); PG8_BAR;
        if constexpr (Epi::HAS_PRE) E.pre_commit(prereg, lds, tid);
    } else {
        PG8_STAGE(PG8_SB(0, 0), cB, voffB); PG8_STAGE(PG8_SA(0, 0), cA, voffA); PG8_STAGE(PG8_SB(0, 1), cB + hstep, voffB); PG8_STAGE(PG8_SA(0, 1), cA + hstep, voffA);
        if (wr == 1) PG8_BAR;
        PG8_WAIT_V(4); PG8_BAR;
        PG8_STAGE(PG8_SB(1, 0), cB + kstep, voffB); PG8_STAGE(PG8_SA(1, 0), cA + kstep, voffA); PG8_STAGE(PG8_SB(1, 1), cB + hstep + kstep, voffB);
        PG8_WAIT_V(6); PG8_BAR;
    }
    for (;;) {
        const bool has_next = S.next(ui + 1, nxt);
        const char* nA = has_next ? (const char*)g.A + (size_t)nxt.pm * tstep : cA; const char* nB = has_next ? (const char*)g.Bt + (size_t)nxt.pn * tstep : cB;
        for (int t = 0; t < nt; t += 2) {
            const bool last = (t == nt - 2);
            const char* a1 = cA + (size_t)(t + 1) * kstep;
            const char* a2 = last ? nA : cA + (size_t)(t + 2) * kstep; const char* b2 = last ? nB : cB + (size_t)(t + 2) * kstep;
            const char* a3 = a2 + kstep; const char* b3 = b2 + kstep;
            if (last && has_next) S.a_ready(nxt);
            if constexpr (SP2) {
            PG8_LDB(B0, 0, 0); PG8_LDB(B1, 0, 1); PG8_SCHED; PG8_LDA(At, 0, 0); PG8_STAGE(PG8_SA(1, 1), a1 + hstep, voffA);
            PG8_WAIT_V(8); PG8_WAIT_L(0); PG8_BAR; PG8_MMA(0, 0, At, B0); PG8_MMA(0, 1, At, B1); PG8_BAR; PG8_SCHED;
            PG8_LDA(At, 0, 1); PG8_STAGE(PG8_SB(0, 0), b2, voffB); PG8_STAGE(PG8_SB(0, 1), b2 + hstep, voffB); PG8_STAGE(PG8_SA(0, 0), a2, voffA);
            PG8_WAIT_V(8); PG8_WAIT_L(0); PG8_BAR; PG8_MMA(1, 0, At, B0); PG8_MMA(1, 1, At, B1); PG8_BAR; PG8_SCHED;
            PG8_LDB(B0, 1, 0); PG8_LDB(B1, 1, 1); PG8_SCHED; PG8_LDA(At, 1, 0); PG8_STAGE(PG8_SA(0, 1), a2 + hstep, voffA);
            PG8_WAIT_V(8); PG8_WAIT_L(0); PG8_BAR; PG8_MMA(0, 0, At, B0); PG8_MMA(0, 1, At, B1); PG8_BAR; PG8_SCHED;
            PG8_LDA(At, 1, 1); PG8_STAGE(PG8_SB(1, 0), b3, voffB); PG8_STAGE(PG8_SB(1, 1), b3 + hstep, voffB); PG8_STAGE(PG8_SA(1, 0), a3, voffA);
            PG8_WAIT_V(8); PG8_WAIT_L(0); PG8_BAR; PG8_MMA(1, 0, At, B0); PG8_MMA(1, 1, At, B1); PG8_BAR; PG8_SCHED;
            } else {
            PG8_LDB(B0, 0, 0); PG8_SCHED; PG8_LDA(At, 0, 0); PG8_STAGE(PG8_SA(1, 1), a1 + hstep, voffA);
            PG8_WAIT_L(8); PG8_BAR; PG8_WAIT_L(0); PG8_MMA(0, 0, At, B0); PG8_BAR; PG8_SCHED;
            PG8_LDB(B1, 0, 1); PG8_STAGE(PG8_SB(0, 0), b2, voffB);
            PG8_BAR; PG8_WAIT_L(0); PG8_MMA(0, 1, At, B1); PG8_BAR;
            PG8_LDA(At, 0, 1); PG8_STAGE(PG8_SA(0, 0), a2, voffA);
            PG8_BAR; PG8_WAIT_L(0); PG8_MMA(1, 0, At, B0); PG8_BAR; PG8_SCHED;
            PG8_STAGE(PG8_SB(0, 1), b2 + hstep, voffB);
            PG8_WAIT_V(6); PG8_BAR; PG8_MMA(1, 1, At, B1); PG8_BAR;
            PG8_LDB(B0, 1, 0); PG8_SCHED; PG8_LDA(At, 1, 0); PG8_STAGE(PG8_SA(0, 1), a2 + hstep, voffA);
            PG8_WAIT_L(8); PG8_BAR; PG8_WAIT_L(0); PG8_MMA(0, 0, At, B0); PG8_BAR; PG8_SCHED;
            PG8_LDB(B1, 1, 1); PG8_STAGE(PG8_SB(1, 0), b3, voffB);
            PG8_BAR; PG8_WAIT_L(0); PG8_MMA(0, 1, At, B1); PG8_BAR;
            PG8_LDA(At, 1, 1); PG8_STAGE(PG8_SA(1, 0), a3, voffA);
            PG8_BAR; PG8_WAIT_L(0); PG8_MMA(1, 0, At, B0); PG8_BAR; PG8_SCHED;
            PG8_STAGE(PG8_SB(1, 1), b3 + hstep, voffB);
            PG8_WAIT_V(6); PG8_BAR; PG8_MMA(1, 1, At, B1); PG8_BAR;
            }
        }
        if constexpr (ALIGN_EPI) { if (wr == 0) PG8_BAR; }
        if constexpr (!Epi::AFTER_DRAIN) { Unit ue = cur; asm volatile("" : "+s"(ue.pm), "+s"(ue.pn));
            int fre = fr, fqe = fq; asm volatile("" : "+v"(fre), "+v"(fqe)); E(acc, ue, wr, wc, fre, fqe); S.done(cur); }
        if (!has_next) break;
#pragma unroll
        for (int a = 0; a < 2; ++a)
#pragma unroll
            for (int b = 0; b < 2; ++b)
#pragma unroll
                for (int m = 0; m < 4; ++m)
#pragma unroll
                    for (int n = 0; n < 2; ++n) acc[a][b][m][n] = (f32x4){0.f, 0.f, 0.f, 0.f};
        cur = nxt; cA = nA; cB = nB; ++ui;
        if constexpr (ALIGN_EPI) { if (wr == 1) PG8_BAR; }
    }
    PG8_WAIT_V(0);
    if constexpr (!ALIGN_EPI) { if (wr == 0) PG8_BAR; }
    PG8_BAR;
    if constexpr (Epi::AFTER_DRAIN) { E.fused(acc, cur, wr, wc, fr, fq, lds, wid, lane); S.done(cur); }
#undef PG8_SA
#undef PG8_SB
#undef PG8_STAGE
#undef PG8_LDA
#undef PG8_LDB
#undef PG8_MMA
#undef PG8_WAIT_V
#undef PG8_WAIT_L
#undef PG8_BAR
#undef PG8_SCHED
}
}
#if !defined(NO_MERGE12) && !defined(MERGE12)
#define MERGE12 1
#endif
#ifndef PG8_SP2V
#define PG8_SP2V true
#endif
#ifndef PG8_ALIGNV
#define PG8_ALIGNV true
#endif
#ifndef MK_N_LAUNCHES
#define MK_N_LAUNCHES 1
#endif
constexpr int BATCH = 2, SEQ = 4096, D = 2048, M = BATCH * SEQ, MEMLEN = 256, MROWS = BATCH * MEMLEN, FF = 8192;
constexpr int NWAVES = 8, NTHREADS = 512, NPH = 20;
constexpr int LDS_BYTES = 147456;
constexpr size_t MiB = 1u << 20;
constexpr size_t WS_W_AIN = 2 * MiB, WS_W_AOUT = 18 * MiB, WS_W_BIN = 26 * MiB, WS_W_BOUT = 34 * MiB, WS_W_Q = 50 * MiB, WS_W_KV = 66 * MiB, WS_W_O = 98 * MiB, WS_W_UP = 114 * MiB, WS_W_DN = 178 * MiB;
constexpr size_t WS_XB = 242 * MiB, WS_MEMB = 274 * MiB, WS_KB = 276 * MiB, WS_VB = 280 * MiB, WS_VTB = 284 * MiB, WS_SSQ = 288 * MiB, WS_VST = 290 * MiB, WS_SSQM = 292 * MiB, WS_S5ST = 294 * MiB;
constexpr size_t WS_R = 304 * MiB, WS_END = 432 * MiB;
#define GAS __attribute__((address_space(1)))
#define LAS __attribute__((address_space(3)))
typedef unsigned short bf16;
typedef unsigned v4u __attribute__((ext_vector_type(4)));
typedef unsigned v2u __attribute__((ext_vector_type(2)));
typedef float f32x4 __attribute__((ext_vector_type(4)));
typedef float f32x2 __attribute__((ext_vector_type(2)));
typedef short bf16x8 __attribute__((ext_vector_type(8)));
#define LDS_WAIT() asm volatile("s_waitcnt lgkmcnt(0)" ::: "memory")
#if defined(NT_ACT)
#define NTL(p) __builtin_nontemporal_load(p)
#else
#define NTL(p) (*(p))
#endif
#if defined(NT_OUT)
#define NTS(v, p) __builtin_nontemporal_store((v), (p))
#else
#define NTS(v, p) (*(p) = (v))
#endif
__device__ __forceinline__ unsigned f2bf(float f) { unsigned u = __builtin_bit_cast(unsigned, f); return (u + 0x7fffu + ((u >> 16) & 1u)) >> 16; }
__device__ __forceinline__ unsigned pk2(float lo, float hi) { return f2bf(lo) | (f2bf(hi) << 16); }
__device__ __forceinline__ float bflo(unsigned w) { return __builtin_bit_cast(float, w << 16); }
__device__ __forceinline__ float bfhi(unsigned w) { return __builtin_bit_cast(float, w & 0xffff0000u); }
__device__ __forceinline__ float wave_sum(float v) {
#pragma unroll
    for (int o = 1; o < 64; o <<= 1) v += __shfl_xor(v, o);
    return v;
}
__device__ __forceinline__ float wave_max(float v) {
#pragma unroll
    for (int o = 1; o < 64; o <<= 1) v = fmaxf(v, __shfl_xor(v, o));
    return v;
}
__device__ __forceinline__ float gelu_exact(float v) { return 0.5f * v * (1.0f + erff(v * 0.70710678118654752f)); }

struct Args { const float* in[30]; float* out; unsigned char* ws; int ph_lo, ph_hi; };
__device__ __forceinline__ const float* ka_in(int i) { const __attribute__((address_space(4))) char* ka = (const __attribute__((address_space(4))) char*)__builtin_amdgcn_kernarg_segment_ptr(); asm volatile("" : "+s"(ka)); return *(const float* const __attribute__((address_space(4)))*)(ka + 8 * i); }

#if defined(STAMP_SEL)
#define STAMP2(lds_, id) do { __syncthreads(); if (blockIdx.x == 0 && wave == 0 && lane_id2() == 0) ((volatile LAS unsigned*)((lds_) + LDS_BYTES - 512))[4 + (id)] = (unsigned)__builtin_amdgcn_s_memrealtime(); } while (0)
__device__ __forceinline__ int lane_id2() { int l; asm volatile("v_mbcnt_lo_u32_b32 %0, -1, 0\n\tv_mbcnt_hi_u32_b32 %0, -1, %0" : "=v"(l)); return l; }
#else
#define STAMP2(lds_, id) do { } while (0)
#endif
__device__ __forceinline__ int glu_rowmap(int n) { return n < 2048 ? 32 * (n >> 4) + (n & 15) : 32 * ((n - 2048) >> 4) + 16 + (n & 15); }
struct ConvSel { const float* W; const float* g; bf16* WT; int K, N, mode, item, hasg; };
__device__ const int CONV_TBL[14][9] = {
    {0,     7,  0, 2, 0,   2, 2048, 4096, 0},
    {2048, 13,  0, -1, 0, 18, 2048, 2048, 0},
    {3072, 14,  0, 2, 1,  26, 2048, 2048, 0},
    {4096, 23,  0, -1, 0, 34, 2048, 4096, 1},
    {6144, 25,  0, 3, 0,  50, 2048, 2048, 0},
    {7168, 25,  4, 3, 1,  58, 2048, 2048, 0},
    {8192, 26,  0, 4, 0,  66, 2048, 4096, 0},
    {10240, 26, 8, 4, 1,  82, 2048, 4096, 0},
    {12288, 27, 0, -1, 0, 98, 2048, 2048, 0},
    {13312, 27, 4, -1, 0, 106, 2048, 2048, 0},
    {14336, 28, 0, 5, 0,  114, 2048, 8192, 0},
    {18432, 28, 16, 5, 1, 146, 2048, 8192, 0},
    {22528, 29, 0, -1, 0, 178, 8192, 2048, 0},
    {26624, 29, 16, -1, 0, 210, 8192, 2048, 0},
};
__device__ __forceinline__ ConvSel conv_select(unsigned char* ws, int r) {
    int m = 0;
#pragma unroll
    for (int k = 1; k < 14; ++k) m += (r >= CONV_TBL[k][0]) ? 1 : 0;
    const int* t = CONV_TBL[m];
    ConvSel s; s.W = ka_in(t[1]) + ((size_t)t[2] << 20); s.g = ka_in(t[3] < 0 ? 2 : t[3]) + t[4] * 2048; s.hasg = t[3] >= 0;
    s.WT = (bf16*)(ws + ((size_t)t[5] << 20)); s.K = t[6]; s.N = t[7]; s.mode = t[8]; s.item = r - t[0]; return s;
}
#if defined(CONV_WIDE)
__device__ __forceinline__ void conv_load(const ConvSel& s, f32x4 (&v)[16], int lane) {
    const int nblk = s.N >> 7, kb = s.item / nblk, nb = s.item - kb * nblk, k0 = 32 * kb, n0 = 128 * nb;
#pragma unroll
    for (int i = 0; i < 16; ++i) { const int kk = 2 * i + (lane >> 5); v[i] = *(const f32x4*)(s.W + (size_t)(k0 + kk) * s.N + n0 + 4 * (lane & 31)); }
}
__device__ __forceinline__ void conv_finish(const ConvSel& s, const f32x4 (&v)[16], LAS float* scr, int lane) {
    const int nblk = s.N >> 7, kb = s.item / nblk, nb = s.item - kb * nblk, k0 = 32 * kb, n0 = 128 * nb;
#pragma unroll
    for (int i = 0; i < 16; ++i) { const int kk = 2 * i + (lane >> 5); const float sc = s.g ? s.g[k0 + kk] : 1.0f; LAS float* d = scr + kk * 129 + 4 * (lane & 31);
        d[0] = v[i][0] * sc; d[1] = v[i][1] * sc; d[2] = v[i][2] * sc; d[3] = v[i][3] * sc; }
    LDS_WAIT();
    const int c = lane & 3;
#pragma unroll
    for (int j = 0; j < 8; ++j) { const int n = (lane >> 2) + 16 * j; const LAS float* sp = scr + (8 * c) * 129 + n;
        v4u o; o.x = pk2(sp[0 * 129], sp[1 * 129]); o.y = pk2(sp[2 * 129], sp[3 * 129]); o.z = pk2(sp[4 * 129], sp[5 * 129]); o.w = pk2(sp[6 * 129], sp[7 * 129]);
        const int nr = s.mode ? glu_rowmap(n0 + n) : (n0 + n);
        *(v4u*)(s.WT + (size_t)nr * s.K + k0 + 8 * c) = o; }
    LDS_WAIT();
}
#elif defined(CONV_TALL)
__device__ __forceinline__ void conv_load(const ConvSel& s, f32x4 (&v)[16], int lane) {
    const int nblk = s.N >> 5, kb = s.item / nblk, nb = s.item - kb * nblk, k0 = 128 * kb, n0 = 32 * nb;
#pragma unroll
    for (int i = 0; i < 16; ++i) { const int kk = 8 * i + (lane >> 3); v[i] = *(const f32x4*)(s.W + (size_t)(k0 + kk) * s.N + n0 + 4 * (lane & 7)); }
}
__device__ __forceinline__ void conv_finish(const ConvSel& s, const f32x4 (&v)[16], LAS float* scr, int lane) {
    const int nblk = s.N >> 5, kb = s.item / nblk, nb = s.item - kb * nblk, k0 = 128 * kb, n0 = 32 * nb;
#pragma unroll
    for (int i = 0; i < 16; ++i) { const int kk = 8 * i + (lane >> 3); const float sc = s.g ? s.g[k0 + kk] : 1.0f; LAS float* d = scr + kk * 33 + 4 * (lane & 7);
        d[0] = v[i][0] * sc; d[1] = v[i][1] * sc; d[2] = v[i][2] * sc; d[3] = v[i][3] * sc; }
    LDS_WAIT();
    const int c = lane & 15;
#pragma unroll
    for (int j = 0; j < 8; ++j) { const int n = (lane >> 4) + 4 * j; const LAS float* sp = scr + (8 * c) * 33 + n;
        v4u o; o.x = pk2(sp[0 * 33], sp[1 * 33]); o.y = pk2(sp[2 * 33], sp[3 * 33]); o.z = pk2(sp[4 * 33], sp[5 * 33]); o.w = pk2(sp[6 * 33], sp[7 * 33]);
        const int nr = s.mode ? glu_rowmap(n0 + n) : (n0 + n);
        *(v4u*)(s.WT + (size_t)nr * s.K + k0 + 8 * c) = o; }
    LDS_WAIT();
}
#else
__device__ __forceinline__ void conv_load(const ConvSel& s, f32x4 (&v)[16], f32x4 (&gq)[2], int lane) {
    const int nblk = s.N >> 6, kb = s.item / nblk, nb = s.item - kb * nblk, k0 = 64 * kb, n0 = 64 * nb;
#pragma unroll
    for (int i = 0; i < 16; ++i) { const int kk = 4 * i + (lane >> 4); v[i] = __builtin_nontemporal_load((const f32x4*)(s.W + (size_t)(k0 + kk) * s.N + n0 + 4 * (lane & 15))); }
    gq[0] = *(const f32x4*)(s.g + k0 + 8 * (lane & 7)); gq[1] = *(const f32x4*)(s.g + k0 + 8 * (lane & 7) + 4);
}
__device__ __forceinline__ void conv_finish(const ConvSel& s, const f32x4 (&v)[16], const f32x4 (&gq)[2], LAS float* scr, int lane) {
    const int nblk = s.N >> 6, kb = s.item / nblk, nb = s.item - kb * nblk, k0 = 64 * kb, n0 = 64 * nb;
#pragma unroll
    for (int i = 0; i < 16; ++i) { const int kk = 4 * i + (lane >> 4); LAS float* d = scr + kk * 65 + 4 * (lane & 15);
        d[0] = v[i][0]; d[1] = v[i][1]; d[2] = v[i][2]; d[3] = v[i][3]; }
    LDS_WAIT();
    const f32x4 one = (f32x4){1.f, 1.f, 1.f, 1.f}; const f32x4 g0 = s.hasg ? gq[0] : one, g1 = s.hasg ? gq[1] : one;
    const int c = lane & 7;
#pragma unroll
    for (int j = 0; j < 8; ++j) { const int n = (lane >> 3) + 8 * j; const LAS float* sp = scr + (8 * c) * 65 + n;
        v4u o; o.x = pg8::cvt_pk_bf16(sp[0 * 65] * g0[0], sp[1 * 65] * g0[1]); o.y = pg8::cvt_pk_bf16(sp[2 * 65] * g0[2], sp[3 * 65] * g0[3]);
        o.z = pg8::cvt_pk_bf16(sp[4 * 65] * g1[0], sp[5 * 65] * g1[1]); o.w = pg8::cvt_pk_bf16(sp[6 * 65] * g1[2], sp[7 * 65] * g1[3]);
        const int nr = s.mode ? glu_rowmap(n0 + n) : (n0 + n);
        *(v4u*)(s.WT + (size_t)nr * s.K + k0 + 8 * c) = o; }
    LDS_WAIT();
}
#endif
template <int PART> __device__ __forceinline__ int conv_index(int j) {
#if defined(MERGE12)
    if (PART == 0) return j < 4096 ? 8192 + j : j - 4096;
    if (PART == 1) return j < 6144 ? 2048 + j : 12288 + (j - 6144);
#elif !defined(BG_CONV)
    if (PART == 0) return 8192 + j;
    if (PART == 1) return j < 8192 ? j : j + 4096;
#endif
    if (PART == 0) return j < 4096 ? 8192 + j : j - 4096;
    if (PART == 1) return j < 1024 ? 2048 + j : (j < 2048 ? 6144 + (j - 1024) : (j < 3072 ? 12288 + (j - 2048) : 14336 + (j - 3072)));
    return j < 4096 ? 22528 + j : (j < 5120 ? 3072 + (j - 4096) : (j < 6144 ? 7168 + (j - 5120) : (j < 8192 ? 4096 + (j - 6144) : (j < 9216 ? 13312 + (j - 8192) : (j < 13312 ? 18432 + (j - 9216) : 26624 + (j - 13312))))));
}
template <int PART> __device__ __forceinline__ void conv_run(unsigned char* ws, LAS float* scr, int first, int step, int limit, int lane) {
    if (first >= limit) return;
    const int cnt = (limit - first + step - 1) / step, jlast = first + (cnt - 1) * step;
    f32x4 va[16], vb[16], ga[2], gb[2];
    ConvSel sa = conv_select(ws, conv_index<PART>(__builtin_amdgcn_readfirstlane(first))), sb;
    conv_load(sa, va, ga, lane);
    for (int i = 0; i < cnt; i += 2) {
        const int j1 = min(first + (i + 1) * step, jlast), j2 = min(first + (i + 2) * step, jlast);
        sb = conv_select(ws, conv_index<PART>(__builtin_amdgcn_readfirstlane(j1))); conv_load(sb, vb, gb, lane);
        conv_finish(sa, va, ga, scr, lane);
        sa = conv_select(ws, conv_index<PART>(__builtin_amdgcn_readfirstlane(j2))); conv_load(sa, va, ga, lane);
        conv_finish(sb, vb, gb, scr, lane);
    }
}
__device__ __forceinline__ void rows_to_bf16(unsigned char* ws, int m0, int step, int lane) {
    f32x4 v[3][8];
#pragma unroll
    for (int r = 0; r < 3; ++r) { const int m = m0 + r * step; if (m < M + MROWS) { const float* xrow = (m < M) ? ka_in(0) + (size_t)m * D : ka_in(1) + (size_t)(m - M) * D;
#pragma unroll
            for (int j = 0; j < 8; ++j) v[r][j] = __builtin_nontemporal_load(((const f32x4*)xrow) + lane + 64 * j); } }
#pragma unroll
    for (int r = 0; r < 3; ++r) { const int m = m0 + r * step; if (m < M + MROWS) {
            bf16* orow = (m < M) ? (bf16*)(ws + WS_XB) + (size_t)m * D : (bf16*)(ws + WS_MEMB) + (size_t)(m - M) * D;
            float* ssqrow = (m < M) ? (float*)(ws + WS_SSQ) + (size_t)m * 64 : (float*)(ws + WS_SSQM) + (size_t)(m - M) * 64;
            float s = 0.f;
#pragma unroll
            for (int j = 0; j < 8; ++j) s += (v[r][j][0] * v[r][j][0] + v[r][j][1] * v[r][j][1]) + (v[r][j][2] * v[r][j][2] + v[r][j][3] * v[r][j][3]);
            s = wave_sum(s);
#pragma unroll
            for (int j = 0; j < 8; ++j) { v2u w; w.x = pg8::cvt_pk_bf16(v[r][j][0], v[r][j][1]); w.y = pg8::cvt_pk_bf16(v[r][j][2], v[r][j][3]); ((v2u*)orow)[lane + 64 * j] = w; }
            if (lane < 32) ssqrow[lane] = (lane == 0) ? s : 0.f; } }
}
__device__ __forceinline__ void p0_prologue(unsigned char* ws, LAS unsigned char* lds, int wave, int lane) {
    LAS float* scr = (LAS float*)(lds + wave * 16896);
    const int gw = blockIdx.x * NWAVES + wave, NGW = gridDim.x * NWAVES;
#if defined(BG_CONV) || defined(MERGE12)
    conv_run<0>(ws, scr, gw, NGW, 6144, lane);
#else
    conv_run<0>(ws, scr, gw, NGW, 4096, lane);
#endif
    for (int m = gw; m < M + MROWS; m += 3 * NGW) rows_to_bf16(ws, m, NGW, lane);
}
__device__ __forceinline__ void p1_convert(unsigned char* ws, LAS unsigned char* lds, int wave, int lane) {
    LAS float* scr = (LAS float*)(lds + wave * 16896);
    const int bx = blockIdx.x, G = gridDim.x;
#if defined(BG_CONV)
    if (G <= 64) { conv_run<1>(ws, scr, bx * NWAVES + wave, G * NWAVES, 7168, lane); return; }
    if (bx >= 64) conv_run<1>(ws, scr, (bx - 64) * NWAVES + wave, (G - 64) * NWAVES, 7168, lane);
#else
    constexpr int CONV_REST = 26624, CONV_SPLIT = 22272;
    if (G <= 64) { conv_run<1>(ws, scr, bx * NWAVES + wave, G * NWAVES, CONV_REST, lane); return; }
    if (bx >= 64) conv_run<1>(ws, scr, (bx - 64) * NWAVES + wave, (G - 64) * NWAVES, CONV_SPLIT, lane);
    else conv_run<1>(ws, scr, CONV_SPLIT + bx * NWAVES + wave, 64 * NWAVES, CONV_REST, lane);
#endif
}
template <int PH> __device__ __forceinline__ void bg_convert(unsigned char* ws, LAS unsigned char* lds, int wave, int lane) {
    constexpr int j0 = (PH == 2) ? 0 : (PH == 4) ? 2048 : (PH == 5) ? 4096 : (PH == 7) ? 6144 : (PH == 8) ? 8192 : (PH == 9) ? 12288 : (PH == 10) ? 16384 : -1;
    constexpr int j1 = (PH == 8) ? 12288 : (PH == 9) ? 16384 : (PH == 10) ? 17408 : j0 + 2048;
#if defined(BG_CONV)
    if constexpr (j0 >= 0) { LAS float* scr = (LAS float*)(lds + wave * 16896); const int gw = blockIdx.x * NWAVES + wave, NGW = gridDim.x * NWAVES;
        conv_run<2>(ws, scr, j0 + gw, NGW, j1, lane); }
#endif
}
__device__ __forceinline__ void final_norm(const bf16* xb, const float* ssq, const float* g, float* out, int wave, int lane) {
    const int gw = blockIdx.x * NWAVES + wave, NGW = gridDim.x * NWAVES;
    for (int m = gw; m < M; m += NGW) {
        float s = (lane < 32) ? ssq[(size_t)m * 64 + lane] : 0.f; s = wave_sum(s);
        const float rs = 1.0f / sqrtf(s * (1.0f / D) + 1e-6f);
        const v4u* xr = (const v4u*)(xb + (size_t)m * D); f32x4* orow = (f32x4*)(out + (size_t)m * D);
#pragma unroll
        for (int j = 0; j < 4; ++j) { const v4u w = NTL(xr + lane + 64 * j); const f32x4 g0 = ((const f32x4*)g)[2 * (lane + 64 * j)], g1 = ((const f32x4*)g)[2 * (lane + 64 * j) + 1];
            NTS(((f32x4){bflo(w.x) * rs * g0[0], bfhi(w.x) * rs * g0[1], bflo(w.y) * rs * g0[2], bfhi(w.y) * rs * g0[3]}), orow + 2 * (lane + 64 * j));
            NTS(((f32x4){bflo(w.z) * rs * g1[0], bfhi(w.z) * rs * g1[1], bflo(w.w) * rs * g1[2], bfhi(w.w) * rs * g1[3]}), orow + 2 * (lane + 64 * j) + 1); } }
}
__device__ __forceinline__ void gating_simple(LAS unsigned char* lds, const bf16* z, const float* vst, const float* ln_g, const float* ln_b, const float* w_s, const float* b_s, bf16* gbuf, int tid) {
    LAS float* vln = (LAS float*)lds;
    LAS float* Wl = (LAS float*)(lds + 65536);
    LAS float* mu = (LAS float*)(lds + 65536 + 128 * 129 * 4);
    LAS float* rsd = mu + 128;
    for (int unit = blockIdx.x; unit < 1024; unit += gridDim.x) {
        const int h = unit & 15, tok0 = (unit >> 4) * 128;
        if (tid < 128) { const float* p = vst + (size_t)(tok0 + tid) * 64; float s1 = 0.f, s2 = 0.f;
#pragma unroll 8
            for (int i = 0; i < 32; ++i) { s1 += p[2 * i]; s2 += p[2 * i + 1]; }
            const float mean = s1 * (1.0f / 2048.0f), var = s2 * (1.0f / 2048.0f) - mean * mean; mu[tid] = mean; rsd[tid] = 1.0f / sqrtf(var + 1e-6f); }
        __syncthreads();
        { const int s = tid >> 2, db = (tid & 3) * 32; const float mean = mu[s], rs = rsd[s];
            const bf16* vp = z + (size_t)(tok0 + s) * 4096 + 2048 + h * 128 + db;
#pragma unroll
            for (int q = 0; q < 4; ++q) { const v4u w = *(const v4u*)(vp + 8 * q); const float* gp = ln_g + h * 128 + db + 8 * q; const float* bp = ln_b + h * 128 + db + 8 * q; LAS float* o = vln + s * 128 + db + 8 * q;
                o[0] = (bflo(w.x) - mean) * rs * gp[0] + bp[0]; o[1] = (bfhi(w.x) - mean) * rs * gp[1] + bp[1]; o[2] = (bflo(w.y) - mean) * rs * gp[2] + bp[2]; o[3] = (bfhi(w.y) - mean) * rs * gp[3] + bp[3];
                o[4] = (bflo(w.z) - mean) * rs * gp[4] + bp[4]; o[5] = (bfhi(w.z) - mean) * rs * gp[5] + bp[5]; o[6] = (bflo(w.w) - mean) * rs * gp[6] + bp[6]; o[7] = (bfhi(w.w) - mean) * rs * gp[7] + bp[7]; }
            const float* wp = w_s + ((size_t)h * 128 + s) * 128 + db;
#pragma unroll
            for (int q = 0; q < 8; ++q) { const f32x4 w4 = *(const f32x4*)(wp + 4 * q); LAS float* o = Wl + s * 129 + db + 4 * q; o[0] = w4[0]; o[1] = w4[1]; o[2] = w4[2]; o[3] = w4[3]; } }
        __syncthreads();
        { const int t = tid >> 2, d0 = (tid & 3) * 32, tmax = t | 15; float acc[32];
#pragma unroll
            for (int j = 0; j < 32; ++j) acc[j] = 0.f;
            for (int s = 0; s <= tmax; ++s) { const float w = (s <= t) ? Wl[t * 129 + s] : 0.f; const LAS f32x4* vr = (const LAS f32x4*)(vln + s * 128 + d0);
#pragma unroll
                for (int q = 0; q < 8; ++q) { const f32x4 vv = vr[q]; acc[4 * q] += w * vv[0]; acc[4 * q + 1] += w * vv[1]; acc[4 * q + 2] += w * vv[2]; acc[4 * q + 3] += w * vv[3]; } }
            const float bs = b_s[h * 128 + t];
            const bf16* up = z + (size_t)(tok0 + t) * 4096 + h * 128 + d0; bf16* op = gbuf + (size_t)(tok0 + t) * 2048 + h * 128 + d0;
#pragma unroll
            for (int q = 0; q < 4; ++q) { const v4u w = *(const v4u*)(up + 8 * q); v4u o;
                o.x = pk2(bflo(w.x) * (acc[8 * q] + bs), bfhi(w.x) * (acc[8 * q + 1] + bs)); o.y = pk2(bflo(w.y) * (acc[8 * q + 2] + bs), bfhi(w.y) * (acc[8 * q + 3] + bs));
                o.z = pk2(bflo(w.z) * (acc[8 * q + 4] + bs), bfhi(w.z) * (acc[8 * q + 5] + bs)); o.w = pk2(bflo(w.w) * (acc[8 * q + 6] + bs), bfhi(w.w) * (acc[8 * q + 7] + bs));
                *(v4u*)(op + 8 * q) = o; } }
        __syncthreads();
    }
}
__device__ __forceinline__ void gating_mfma(LAS unsigned char* lds, const bf16* z, const float* vst, const float* ln_g, const float* ln_b, const float* w_s, const float* b_s, bf16* gbuf, int wave, int lane) {
    LAS float* MU = (LAS float*)(lds + 69632);
    const int tid = wave * 64 + lane, fr = lane & 15, fq = lane >> 4;
    const int ss = tid >> 2, db = (tid & 3) * 32;
    for (int unit = blockIdx.x; unit < 256; unit += gridDim.x) {
        const int tok0 = (unit >> 2) * 128, hg = unit & 3;
        __syncthreads();
        if (tid < 128) { const float* sp = vst + (size_t)(tok0 + tid) * 64; float s1 = 0.f, s2 = 0.f;
#pragma unroll
            for (int i = 0; i < 16; ++i) { const f32x4 a = *(const f32x4*)(sp + 4 * i); s1 += a[0] + a[2]; s2 += a[1] + a[3]; }
            const float mean = s1 * (1.0f / 2048.0f), var = s2 * (1.0f / 2048.0f) - mean * mean; MU[tid] = mean; MU[128 + tid] = 1.0f / sqrtf(var + 1e-6f); }
        v4u raw[4];
        { const bf16* vp = z + (size_t)(tok0 + ss) * 4096 + 2048 + (hg * 4) * 128 + db;
#pragma unroll
            for (int q4 = 0; q4 < 4; ++q4) raw[q4] = NTL((const v4u*)(vp + 8 * q4)); }
        __syncthreads();
        const float mean = MU[ss], rs = MU[128 + ss];
#pragma unroll 1
        for (int hh = 0; hh < 4; ++hh) { const int h = hg * 4 + hh; LAS unsigned char* VT = lds + (hh & 1) * 34816;
            const int t = 16 * wave + fr, nks = (wave >> 1) + 1;
            f32x4 wa[4][2];
#pragma unroll
            for (int ks = 0; ks < 4; ++ks) if (ks < nks) { const float* wp = w_s + ((size_t)h * 128 + t) * 128 + 32 * ks + 8 * fq; wa[ks][0] = *(const f32x4*)wp; wa[ks][1] = *(const f32x4*)(wp + 4); }
            const float bs = b_s[h * 128 + t];
            const bf16* up = z + (size_t)(tok0 + t) * 4096 + h * 128 + 4 * fq; bf16* op = gbuf + (size_t)(tok0 + t) * 2048 + h * 128 + 4 * fq;
            v2u uwv[8];
#pragma unroll
            for (int df = 0; df < 8; ++df) uwv[df] = NTL((const v2u*)(up + 16 * df));
            { const float* gp = ln_g + h * 128 + db; const float* bp = ln_b + h * 128 + db; LAS unsigned char* wp = VT + db * 272 + (ss ^ (8 * (tid & 3))) * 2;
#pragma unroll
                for (int q4 = 0; q4 < 4; ++q4) { const f32x4 g0 = *(const f32x4*)(gp + 8 * q4), g1 = *(const f32x4*)(gp + 8 * q4 + 4), b0 = *(const f32x4*)(bp + 8 * q4), b1 = *(const f32x4*)(bp + 8 * q4 + 4); const v4u w = raw[q4];
                    const float v0 = (bflo(w.x) - mean) * rs * g0[0] + b0[0], v1 = (bfhi(w.x) - mean) * rs * g0[1] + b0[1], v2 = (bflo(w.y) - mean) * rs * g0[2] + b0[2], v3 = (bfhi(w.y) - mean) * rs * g0[3] + b0[3];
                    const float v4 = (bflo(w.z) - mean) * rs * g1[0] + b1[0], v5 = (bfhi(w.z) - mean) * rs * g1[1] + b1[1], v6 = (bflo(w.w) - mean) * rs * g1[2] + b1[2], v7 = (bfhi(w.w) - mean) * rs * g1[3] + b1[3];
                    LAS unsigned char* o = wp + (8 * q4) * 272;
                    *(LAS bf16*)(o + 0 * 272) = (bf16)f2bf(v0); *(LAS bf16*)(o + 1 * 272) = (bf16)f2bf(v1); *(LAS bf16*)(o + 2 * 272) = (bf16)f2bf(v2); *(LAS bf16*)(o + 3 * 272) = (bf16)f2bf(v3);
                    *(LAS bf16*)(o + 4 * 272) = (bf16)f2bf(v4); *(LAS bf16*)(o + 5 * 272) = (bf16)f2bf(v5); *(LAS bf16*)(o + 6 * 272) = (bf16)f2bf(v6); *(LAS bf16*)(o + 7 * 272) = (bf16)f2bf(v7); } }
            if (hh < 3) { const bf16* vp = z + (size_t)(tok0 + ss) * 4096 + 2048 + (h + 1) * 128 + db;
#pragma unroll
                for (int q4 = 0; q4 < 4; ++q4) raw[q4] = NTL((const v4u*)(vp + 8 * q4)); }
            __syncthreads();
            bf16x8 wf[4];
#pragma unroll
            for (int ks = 0; ks < 4; ++ks) { wf[ks] = (bf16x8){0, 0, 0, 0, 0, 0, 0, 0};
                if (ks < nks) { const f32x4 a = wa[ks][0], c = wa[ks][1]; const int s0 = 32 * ks + 8 * fq;
                    float v[8] = {a[0], a[1], a[2], a[3], c[0], c[1], c[2], c[3]};
#pragma unroll
                    for (int j = 0; j < 8; ++j) v[j] = (s0 + j <= t) ? v[j] : 0.f;
                    v4u w; w.x = pk2(v[0], v[1]); w.y = pk2(v[2], v[3]); w.z = pk2(v[4], v[5]); w.w = pk2(v[6], v[7]); wf[ks] = __builtin_bit_cast(bf16x8, w); } }
#pragma unroll
            for (int df = 0; df < 8; ++df) { f32x4 acc = (f32x4){0.f, 0.f, 0.f, 0.f};
#pragma unroll
                for (int ks = 0; ks < 4; ++ks) if (ks < nks) { const bf16x8 a = *(const LAS bf16x8*)(VT + (df * 16 + fr) * 272 + (((32 * ks + 8 * fq) ^ (8 * ((df >> 1) & 3))) * 2)); acc = __builtin_amdgcn_mfma_f32_16x16x32_bf16(a, wf[ks], acc, 0, 0, 0); }
                const v2u uw = uwv[df]; v2u ow;
                ow.x = pg8::cvt_pk_bf16(bflo(uw.x) * (acc[0] + bs), bfhi(uw.x) * (acc[1] + bs)); ow.y = pg8::cvt_pk_bf16(bflo(uw.y) * (acc[2] + bs), bfhi(uw.y) * (acc[3] + bs));
                pg8::st_wt8(op + 16 * df, ow); }
        }
    }
    __syncthreads();
}
__device__ __forceinline__ void attn_simple(LAS unsigned char* lds, const bf16* q, const bf16* Kb, const bf16* Vb, bf16* obuf, int wave, int lane) {
    LAS float* pl = (LAS float*)(lds + wave * 1024);
    const int gw = blockIdx.x * NWAVES + wave, NGW = gridDim.x * NWAVES;
    for (int task = gw; task < BATCH * 4 * SEQ; task += NGW) {
        const int bh = task >> 12, t = task & 4095, b = bh >> 2, h = bh & 3;
        float qf[8]; { const v4u w = *(const v4u*)(q + ((size_t)(b * SEQ + t)) * 2048 + h * 512 + 8 * lane);
            qf[0] = bflo(w.x); qf[1] = bfhi(w.x); qf[2] = bflo(w.y); qf[3] = bfhi(w.y); qf[4] = bflo(w.z); qf[5] = bfhi(w.z); qf[6] = bflo(w.w); qf[7] = bfhi(w.w); }
        const bf16* kp = Kb + (size_t)bh * 256 * 512 + 8 * lane;
        float sc[4];
#pragma unroll
        for (int kk = 0; kk < 4; ++kk) { float mine = 0.f;
            for (int l2 = 0; l2 < 64; ++l2) { const v4u w = *(const v4u*)(kp + (size_t)(kk * 64 + l2) * 512);
                float dsum = qf[0] * bflo(w.x) + qf[1] * bfhi(w.x) + qf[2] * bflo(w.y) + qf[3] * bfhi(w.y) + qf[4] * bflo(w.z) + qf[5] * bfhi(w.z) + qf[6] * bflo(w.w) + qf[7] * bfhi(w.w);
                dsum = wave_sum(dsum); if (lane == l2) mine = dsum; }
            sc[kk] = mine; }
        const float mx = wave_max(fmaxf(fmaxf(sc[0], sc[1]), fmaxf(sc[2], sc[3])));
        float p[4], ps = 0.f;
#pragma unroll
        for (int kk = 0; kk < 4; ++kk) { p[kk] = exp2f(sc[kk] - mx); ps += p[kk]; pl[kk * 64 + lane] = p[kk]; }
        const float inv = 1.0f / wave_sum(ps);
        LDS_WAIT();
        float o[8];
#pragma unroll
        for (int i = 0; i < 8; ++i) o[i] = 0.f;
        const bf16* vp = Vb + (size_t)bh * 256 * 512 + 8 * lane;
        for (int key = 0; key < 256; ++key) { const float pk = pl[key]; const v4u w = *(const v4u*)(vp + (size_t)key * 512);
            o[0] += pk * bflo(w.x); o[1] += pk * bfhi(w.x); o[2] += pk * bflo(w.y); o[3] += pk * bfhi(w.y); o[4] += pk * bflo(w.z); o[5] += pk * bfhi(w.z); o[6] += pk * bflo(w.w); o[7] += pk * bfhi(w.w); }
        v4u ow; ow.x = pk2(o[0] * inv, o[1] * inv); ow.y = pk2(o[2] * inv, o[3] * inv); ow.z = pk2(o[4] * inv, o[5] * inv); ow.w = pk2(o[6] * inv, o[7] * inv);
        *(v4u*)(obuf + ((size_t)(b * SEQ + t)) * 2048 + h * 512 + 8 * lane) = ow;
        LDS_WAIT();
    }
}
__device__ __forceinline__ void attn_mfma(LAS unsigned char* lds, const bf16* q, const bf16* Kb, const bf16* VTb, bf16* obuf, int wave, int lane) {
    const int tid = wave * 64 + lane, fr = lane & 15, fq = lane >> 4;
    unsigned voffK[2], voffV[2];
#pragma unroll
    for (int i = 0; i < 2; ++i) { int R, C; pg8::stage_rc(tid * 16 + i * 8192, R, C); voffK[i] = (unsigned)(R * 512 + C) * 2u; voffV[i] = (unsigned)(R * 256 + C) * 2u; }
    const unsigned ldsw = (unsigned)wave * 1024u;
    const int aoff0 = pg8::lds_byte(fr, fq * 8);
#define AT_STAGE_K(c, buf) do { _Pragma("unroll") for (int ht = 0; ht < 4; ++ht) { const char* src = Kg + ((size_t)(128 * (ht >> 1)) * 512 + 128 * (c) + 64 * (ht & 1)) * 2; \
        _Pragma("unroll") for (int i = 0; i < 2; ++i) __builtin_amdgcn_global_load_lds((const unsigned*)(src + voffK[i]), (LAS unsigned*)(lds + (buf) * 65536 + ht * 16384 + ldsw + i * 8192), 16, 0, 0); } } while (0)
#define AT_STAGE_V(cc, buf) do { _Pragma("unroll") for (int ht = 0; ht < 4; ++ht) { const char* src = Vg + ((size_t)(128 * ht) * 256 + 64 * (cc)) * 2; \
        _Pragma("unroll") for (int i = 0; i < 2; ++i) __builtin_amdgcn_global_load_lds((const unsigned*)(src + voffV[i]), (LAS unsigned*)(lds + (buf) * 65536 + ht * 16384 + ldsw + i * 8192), 16, 0, 0); } } while (0)
#define AT_WAIT() do { asm volatile("s_waitcnt vmcnt(0)" ::: "memory"); __syncthreads(); } while (0)
    for (int unit = blockIdx.x; unit < 256; unit += gridDim.x) {
        const int bh = unit & 7, qb = unit >> 3, b = bh >> 2, h = bh & 3;
        const char* Kg = (const char*)(Kb + (size_t)bh * 256 * 512);
        const char* Vg = (const char*)(VTb + (size_t)bh * 512 * 256);
        const size_t tok = (size_t)(b * SEQ + qb * 128 + 16 * wave + fr);
        bf16x8 qf[16];
        { const bf16* qp = q + tok * 2048 + h * 512 + 8 * fq;
#pragma unroll
            for (int s = 0; s < 16; ++s) qf[s] = NTL((const bf16x8*)(qp + 32 * s)); }
        f32x4 acc[16];
#pragma unroll
        for (int n = 0; n < 16; ++n) acc[n] = (f32x4){0.f, 0.f, 0.f, 0.f};
        STAMP2(lds, 40);
        AT_STAGE_K(0, 0);
#pragma unroll
        for (int c = 0; c < 4; ++c) {
            AT_WAIT();
            if (c < 3) AT_STAGE_K(c + 1, (c + 1) & 1); else AT_STAGE_V(0, 0);
            const LAS unsigned char* bb = lds + (c & 1) * 65536 + aoff0; asm volatile("" : "+v"(bb));
#define AT_QK_LOAD(dst, gi) do { _Pragma("unroll") for (int n8 = 0; n8 < 8; ++n8) dst[n8] = *(const LAS bf16x8*)(bb + ((((gi) & 1) * 2 + ((gi) >> 2)) * 16384) + n8 * 2048 + (((gi) >> 1) & 1) * 1024); } while (0)
#define AT_QK_MMA(src, gi) do { _Pragma("unroll") for (int n8 = 0; n8 < 8; ++n8) acc[((gi) & 1) * 8 + n8] = __builtin_amdgcn_mfma_f32_16x16x32_bf16(src[n8], qf[4 * c + 2 * ((gi) >> 2) + (((gi) >> 1) & 1)], acc[((gi) & 1) * 8 + n8], 0, 0, 0); } while (0)
            { bf16x8 a0[8], a1[8];
                AT_QK_LOAD(a0, 0);
#pragma unroll
                for (int gi = 0; gi < 8; gi += 2) { AT_QK_LOAD(a1, gi + 1); AT_QK_MMA(a0, gi); __builtin_amdgcn_sched_barrier(0);
                    if (gi + 2 < 8) AT_QK_LOAD(a0, gi + 2);
                    AT_QK_MMA(a1, gi + 1); __builtin_amdgcn_sched_barrier(0); } }
        }
        STAMP2(lds, 41);
        float mx = acc[0][0];
#pragma unroll
        for (int n = 0; n < 16; ++n) mx = fmaxf(fmaxf(mx, fmaxf(acc[n][0], acc[n][1])), fmaxf(acc[n][2], acc[n][3]));
        mx = fmaxf(mx, __shfl_xor(mx, 16)); mx = fmaxf(mx, __shfl_xor(mx, 32));
        float l = 0.f;
#pragma unroll
        for (int n = 0; n < 16; ++n)
#pragma unroll
            for (int r = 0; r < 4; ++r) { const float pv = __builtin_amdgcn_exp2f(acc[n][r] - mx); acc[n][r] = pv; l += pv; }
        l += __shfl_xor(l, 16); l += __shfl_xor(l, 32);
        const float linv = 1.0f / l;
        bf16x8 pf[8];
#pragma unroll
        for (int s = 0; s < 8; ++s) { v4u w; w.x = pg8::cvt_pk_bf16(acc[2 * s][0], acc[2 * s][1]); w.y = pg8::cvt_pk_bf16(acc[2 * s][2], acc[2 * s][3]);
            w.z = pg8::cvt_pk_bf16(acc[2 * s + 1][0], acc[2 * s + 1][1]); w.w = pg8::cvt_pk_bf16(acc[2 * s + 1][2], acc[2 * s + 1][3]); pf[s] = __builtin_bit_cast(bf16x8, w); }
        STAMP2(lds, 42);
        __builtin_amdgcn_sched_barrier(0);
        f32x4 o[32];
#pragma unroll
        for (int mm = 0; mm < 32; ++mm) o[mm] = (f32x4){0.f, 0.f, 0.f, 0.f};
#pragma unroll
        for (int cc = 0; cc < 4; ++cc) {
            AT_WAIT();
            if (cc < 3) AT_STAGE_V(cc + 1, (cc + 1) & 1);
            const LAS unsigned char* bb = lds + (cc & 1) * 65536 + aoff0; asm volatile("" : "+v"(bb));
#define AT_PV_LOAD(dst, gi) do { _Pragma("unroll") for (int m8 = 0; m8 < 8; ++m8) dst[m8] = *(const LAS bf16x8*)(bb + ((gi) & 3) * 16384 + m8 * 2048 + ((gi) >> 2) * 1024); } while (0)
#define AT_PV_MMA(src, gi) do { _Pragma("unroll") for (int m8 = 0; m8 < 8; ++m8) o[((gi) & 3) * 8 + m8] = __builtin_amdgcn_mfma_f32_16x16x32_bf16(src[m8], pf[2 * cc + ((gi) >> 2)], o[((gi) & 3) * 8 + m8], 0, 0, 0); } while (0)
            { bf16x8 a0[8], a1[8];
                AT_PV_LOAD(a0, 0);
#pragma unroll
                for (int gi = 0; gi < 8; gi += 2) { AT_PV_LOAD(a1, gi + 1); AT_PV_MMA(a0, gi); __builtin_amdgcn_sched_barrier(0);
                    if (gi + 2 < 8) AT_PV_LOAD(a0, gi + 2);
                    AT_PV_MMA(a1, gi + 1); __builtin_amdgcn_sched_barrier(0); } }
        }
        STAMP2(lds, 43);
        bf16* op = obuf + tok * 2048 + h * 512 + 4 * fq;
#pragma unroll
        for (int mm = 0; mm < 32; ++mm) { v2u w; w.x = pg8::cvt_pk_bf16(o[mm][0] * linv, o[mm][1] * linv); w.y = pg8::cvt_pk_bf16(o[mm][2] * linv, o[mm][3] * linv); pg8::st_wt8(op + 16 * mm, w); }
    }
    asm volatile("s_waitcnt vmcnt(0)" ::: "memory"); __syncthreads(); STAMP2(lds, 44);
#undef AT_STAGE_K
#undef AT_QK_LOAD
#undef AT_QK_MMA
#undef AT_PV_LOAD
#undef AT_PV_MMA
#undef AT_STAGE_V
#undef AT_WAIT
}
struct S5Lane { float lbr, lbi; float Br[16], Bi[16]; };
__device__ __forceinline__ void s5_lane_params(int g, int p, S5Lane& L) {
    const float lr = fminf(ka_in(15)[g * 64 + p], -1e-4f), li = ka_in(16)[g * 64 + p], dt = expf(ka_in(17)[g]);
    const float ar = lr * dt, th = li * dt; float sn, cs; sincosf(th, &sn, &cs); const float e = expf(ar), sh = sinf(0.5f * th);
    L.lbr = e * cs; L.lbi = e * sn;
    const float nr = expm1f(ar) * cs - 2.0f * sh * sh, ni = e * sn;
    const float den = 1.0f / (lr * lr + li * li), cr = (nr * lr + ni * li) * den, ci = (ni * lr - nr * li) * den;
#pragma unroll
    for (int c = 0; c < 16; ++c) { const float br = ka_in(18)[(size_t)(g * 64 + p) * 16 + c], bi = ka_in(19)[(size_t)(g * 64 + p) * 16 + c]; L.Br[c] = cr * br - ci * bi; L.Bi[c] = cr * bi + ci * br; }
}
__device__ __forceinline__ void s5_step(const S5Lane& L, const bf16* urow, float& xr, float& xi) {
    const v4u w0 = *(const v4u*)urow, w1 = *(const v4u*)(urow + 8);
    float u[16] = {bflo(w0.x), bfhi(w0.x), bflo(w0.y), bfhi(w0.y), bflo(w0.z), bfhi(w0.z), bflo(w0.w), bfhi(w0.w), bflo(w1.x), bfhi(w1.x), bflo(w1.y), bfhi(w1.y), bflo(w1.z), bfhi(w1.z), bflo(w1.w), bfhi(w1.w)};
    float br = 0.f, bi = 0.f;
#pragma unroll
    for (int c = 0; c < 16; ++c) { br += L.Br[c] * u[c]; bi += L.Bi[c] * u[c]; }
    const float nr = L.lbr * xr - L.lbi * xi + br, ni = L.lbr * xi + L.lbi * xr + bi; xr = nr; xi = ni;
}
__device__ __forceinline__ void s5_pass_a(const bf16* ub, f32x2* st, int wave, int lane) {
    const int gw = blockIdx.x * NWAVES + wave, NGW = gridDim.x * NWAVES;
    for (int task = gw; task < BATCH * 128 * 64; task += NGW) {
        const int seg = task & 63, g = (task >> 6) & 127, b = task >> 13;
        S5Lane L; s5_lane_params(g, lane, L);
        float xr = 0.f, xi = 0.f; const bf16* up = ub + (size_t)(b * SEQ + seg * 64) * 2048 + 16 * g;
#pragma unroll 2
        for (int s = 0; s < 64; ++s) s5_step(L, up + (size_t)s * 2048, xr, xi);
        st[(size_t)task * 64 + lane] = (f32x2){xr, xi};
    }
}
__device__ __forceinline__ void s5_pass_c(LAS unsigned char* lds, const bf16* ub, const f32x2* st, bf16* yb, int wave, int lane) {
    LAS f32x2* Cs = (LAS f32x2*)(lds + wave * 16640);
    LAS f32x2* xs = (LAS f32x2*)(lds + wave * 16640 + 8320);
    const int gw = blockIdx.x * NWAVES + wave, NGW = gridDim.x * NWAVES;
    for (int task = gw; task < BATCH * 128 * 64; task += NGW) {
        const int seg = task & 63, g = (task >> 6) & 127, b = task >> 13;
        S5Lane L; s5_lane_params(g, lane, L);
#pragma unroll
        for (int c = 0; c < 16; ++c) Cs[c * 65 + lane] = (f32x2){ka_in(20)[(size_t)(g * 16 + c) * 64 + lane], ka_in(21)[(size_t)(g * 16 + c) * 64 + lane]};
        float Ar = L.lbr, Ai = L.lbi;
#pragma unroll
        for (int i = 0; i < 6; ++i) { const float nr = Ar * Ar - Ai * Ai, ni = 2.0f * Ar * Ai; Ar = nr; Ai = ni; }
        float xr = 0.f, xi = 0.f; const f32x2* sp = st + (size_t)(task - seg) * 64 + lane;
#pragma unroll 2
        for (int n = 0; n < seg; ++n) { const f32x2 s = sp[(size_t)n * 64]; const float nr = Ar * xr - Ai * xi + s.x, ni = Ar * xi + Ai * xr + s.y; xr = nr; xi = ni; }
        const bf16* up = ub + (size_t)(b * SEQ + seg * 64) * 2048 + 16 * g; bf16* yp = yb + (size_t)(b * SEQ + seg * 64) * 2048 + 16 * g;
        const int t = lane & 15, cq = lane >> 4;
        f32x4 dsk = *(const f32x4*)(ka_in(22) + g * 16 + 4 * cq);
#pragma unroll 1
        for (int blk = 0; blk < 4; ++blk) {
#pragma unroll 2
            for (int s = 0; s < 16; ++s) { s5_step(L, up + (size_t)(blk * 16 + s) * 2048, xr, xi); xs[s * 65 + lane] = (f32x2){xr, xi}; }
            LDS_WAIT();
            float acc[4] = {0.f, 0.f, 0.f, 0.f};
#pragma unroll 4
            for (int p = 0; p < 64; ++p) { const f32x2 x = xs[t * 65 + p];
#pragma unroll
                for (int j = 0; j < 4; ++j) { const f32x2 c = Cs[(4 * cq + j) * 65 + p]; acc[j] += c.x * x.x - c.y * x.y; } }
            const v2u uw = *(const v2u*)(up + (size_t)(blk * 16 + t) * 2048 + 4 * cq);
            const float y0 = gelu_exact(acc[0] + dsk[0] * bflo(uw.x)), y1 = gelu_exact(acc[1] + dsk[1] * bfhi(uw.x)), y2 = gelu_exact(acc[2] + dsk[2] * bflo(uw.y)), y3 = gelu_exact(acc[3] + dsk[3] * bfhi(uw.y));
            v2u ow; ow.x = pk2(y0, y1); ow.y = pk2(y2, y3); *(v2u*)(yp + (size_t)(blk * 16 + t) * 2048 + 4 * cq) = ow;
            LDS_WAIT();
        }
    }
}
__device__ __forceinline__ void s5_mfma(LAS unsigned char* lds, const bf16* ub, bf16* yb, int wave, int lane) {
    LAS f32x2* PW = (LAS f32x2*)(lds);
    LAS f32x2* BB = (LAS f32x2*)(lds + 8704);
    LAS f32x2* CC = (LAS f32x2*)(lds + 16896);
    LAS bf16* KST = (LAS bf16*)(lds + 25088);
    LAS unsigned char* UI = lds + 33280;
    LAS float* SL = (LAS float*)(lds + 66048);
    LAS bf16* XP = (LAS bf16*)(lds + 99840);
    const int tid = wave * 64 + lane, fr = lane & 15, fq = lane >> 4;
#ifndef S5_LOOP_REPS
#define S5_LOOP_REPS 1
#endif
    for (int unit = blockIdx.x; unit < 256; unit += gridDim.x) {
        const int b = unit >> 7, g = unit & 127;
        const bf16* usrc = ub + (size_t)(b * SEQ) * 2048 + 16 * g + (size_t)(tid >> 1) * 2048 + 8 * (tid & 1);
        v4u upre[4];
#pragma unroll
        for (int i = 0; i < 4; ++i) upre[i] = NTL((const v4u*)(usrc + (size_t)(256 * i) * 2048));
        const float ldt = ka_in(17)[g];
        float plr[3], pli[3];
#pragma unroll
        for (int it = 0; it < 3; ++it) { const int idx = tid + NTHREADS * it, p = idx & 63; plr[it] = ka_in(15)[g * 64 + p]; pli[it] = ka_in(16)[g * 64 + p]; }
        float pbr[2], pbi[2], pcr[2], pci[2];
#pragma unroll
        for (int it = 0; it < 2; ++it) { const int idx = tid + NTHREADS * it; pbr[it] = ka_in(18)[(size_t)g * 1024 + idx]; pbi[it] = ka_in(19)[(size_t)g * 1024 + idx]; pcr[it] = ka_in(20)[(size_t)g * 1024 + idx]; pci[it] = ka_in(21)[(size_t)g * 1024 + idx]; }
        float qlr[2], qli[2];
#pragma unroll
        for (int it = 0; it < 2; ++it) { const int p = (tid + NTHREADS * it) >> 4; qlr[it] = ka_in(15)[g * 64 + p]; qli[it] = ka_in(16)[g * 64 + p]; }
        const f32x4 dsk = *(const f32x4*)(ka_in(22) + g * 16 + 4 * fq);
        const float dt = expf(ldt);
        __syncthreads();
#pragma unroll
        for (int it = 0; it < 3; ++it) { const int idx = tid + NTHREADS * it; if (idx < 17 * 64) { const int e = idx >> 6;
            const float lr = fminf(plr[it], -1e-4f), li = pli[it]; float sn, cs; sincosf(li * dt * (float)e, &sn, &cs); const float ex = expf(lr * dt * (float)e);
            PW[idx] = (f32x2){ex * cs, ex * sn}; } }
#pragma unroll
        for (int it = 0; it < 2; ++it) { const int idx = tid + NTHREADS * it;
            const float lr = fminf(qlr[it], -1e-4f), li = qli[it]; const float ar = lr * dt, th = li * dt; float sn, cs; sincosf(th, &sn, &cs); const float e = expf(ar), sh = sinf(0.5f * th);
            const float nr = expm1f(ar) * cs - 2.0f * sh * sh, ni = e * sn, den = 1.0f / (lr * lr + li * li), cr = (nr * lr + ni * li) * den, ci = (ni * lr - nr * li) * den;
            BB[idx] = (f32x2){cr * pbr[it] - ci * pbi[it], cr * pbi[it] + ci * pbr[it]};
            CC[idx] = (f32x2){pcr[it], pci[it]}; }
        __syncthreads();
        bf16x8 A1[8];
        { const int ri = wave >> 2, p = 16 * (wave & 3) + fr; f32x2 bb[8];
#pragma unroll
            for (int j = 0; j < 8; ++j) bb[j] = BB[p * 16 + 8 * (fq & 1) + j];
#pragma unroll
            for (int ks = 0; ks < 8; ++ks) { const int s = 2 * ks + (fq >> 1); const f32x2 pw = PW[(15 - s) * 64 + p]; float v[8];
#pragma unroll
                for (int j = 0; j < 8; ++j) v[j] = ri ? (pw.x * bb[j].y + pw.y * bb[j].x) : (pw.x * bb[j].x - pw.y * bb[j].y);
                v4u w; w.x = pk2(v[0], v[1]); w.y = pk2(v[2], v[3]); w.z = pk2(v[4], v[5]); w.w = pk2(v[6], v[7]); A1[ks] = __builtin_bit_cast(bf16x8, w); }
            __builtin_amdgcn_sched_barrier(0); }
        const int t0 = wave, t1 = 15 - wave;
        bf16x8 CM[2][4];
        { f32x4 kacc[2] = {(f32x4){0.f, 0.f, 0.f, 0.f}, (f32x4){0.f, 0.f, 0.f, 0.f}};
#pragma unroll
            for (int h = 0; h < 2; ++h) { f32x2 cc[8], pa[8], pb[8];
#pragma unroll
                for (int j = 0; j < 8; ++j) { const int p = 32 * h + 8 * fq + j; cc[j] = CC[fr * 64 + p]; pa[j] = PW[(t0 + 1) * 64 + p]; pb[j] = PW[(t1 + 1) * 64 + p]; }
                float vr[8], vi[8];
#pragma unroll
                for (int j = 0; j < 8; ++j) { vr[j] = cc[j].x * pa[j].x - cc[j].y * pa[j].y; vi[j] = -(cc[j].x * pa[j].y + cc[j].y * pa[j].x); }
                { v4u w; w.x = pk2(vr[0], vr[1]); w.y = pk2(vr[2], vr[3]); w.z = pk2(vr[4], vr[5]); w.w = pk2(vr[6], vr[7]); CM[0][h] = __builtin_bit_cast(bf16x8, w);
                  w.x = pk2(vi[0], vi[1]); w.y = pk2(vi[2], vi[3]); w.z = pk2(vi[4], vi[5]); w.w = pk2(vi[6], vi[7]); CM[0][2 + h] = __builtin_bit_cast(bf16x8, w); }
#pragma unroll
                for (int j = 0; j < 8; ++j) { vr[j] = cc[j].x * pb[j].x - cc[j].y * pb[j].y; vi[j] = -(cc[j].x * pb[j].y + cc[j].y * pb[j].x); }
                { v4u w; w.x = pk2(vr[0], vr[1]); w.y = pk2(vr[2], vr[3]); w.z = pk2(vr[4], vr[5]); w.w = pk2(vr[6], vr[7]); CM[1][h] = __builtin_bit_cast(bf16x8, w);
                  w.x = pk2(vi[0], vi[1]); w.y = pk2(vi[2], vi[3]); w.z = pk2(vi[4], vi[5]); w.w = pk2(vi[6], vi[7]); CM[1][2 + h] = __builtin_bit_cast(bf16x8, w); }
                bf16x8 ctr, cti;
                { v4u w; w.x = pk2(cc[0].x, cc[1].x); w.y = pk2(cc[2].x, cc[3].x); w.z = pk2(cc[4].x, cc[5].x); w.w = pk2(cc[6].x, cc[7].x); ctr = __builtin_bit_cast(bf16x8, w);
                  w.x = pk2(-cc[0].y, -cc[1].y); w.y = pk2(-cc[2].y, -cc[3].y); w.z = pk2(-cc[4].y, -cc[5].y); w.w = pk2(-cc[6].y, -cc[7].y); cti = __builtin_bit_cast(bf16x8, w); }
                f32x2 bq[8];
#pragma unroll
                for (int j = 0; j < 8; ++j) bq[j] = BB[(32 * h + 8 * fq + j) * 16 + fr];
#pragma unroll
                for (int si = 0; si < 2; ++si) { const int s = 2 * wave + si;
#pragma unroll
                    for (int j = 0; j < 8; ++j) { const f32x2 pw = PW[(15 - s) * 64 + 32 * h + 8 * fq + j]; vr[j] = pw.x * bq[j].x - pw.y * bq[j].y; vi[j] = pw.x * bq[j].y + pw.y * bq[j].x; }
                    v4u w; w.x = pk2(vr[0], vr[1]); w.y = pk2(vr[2], vr[3]); w.z = pk2(vr[4], vr[5]); w.w = pk2(vr[6], vr[7]);
                    kacc[si] = __builtin_amdgcn_mfma_f32_16x16x32_bf16(__builtin_bit_cast(bf16x8, w), ctr, kacc[si], 0, 0, 0);
                    w.x = pk2(vi[0], vi[1]); w.y = pk2(vi[2], vi[3]); w.z = pk2(vi[4], vi[5]); w.w = pk2(vi[6], vi[7]);
                    kacc[si] = __builtin_amdgcn_mfma_f32_16x16x32_bf16(__builtin_bit_cast(bf16x8, w), cti, kacc[si], 0, 0, 0); }
                __builtin_amdgcn_sched_barrier(0); }
#pragma unroll
            for (int si = 0; si < 2; ++si) { const int s = 2 * wave + si; v2u kw; kw.x = pk2(kacc[si][0], kacc[si][1]); kw.y = pk2(kacc[si][2], kacc[si][3]);
                *(LAS v2u*)(KST + ((15 - s) * 16 + fr) * 16 + 4 * fq) = kw; } }
#pragma unroll 1
        for (int rep = 0; rep < S5_LOOP_REPS; ++rep) {
        float Xr = 0.f, Xi = 0.f;
#pragma unroll 1
        for (int q = 0; q < 4; ++q) {
            __syncthreads();
#pragma unroll
            for (int i = 0; i < 4; ++i) { const int piece = tid + NTHREADS * i, tok = piece >> 1, half = piece & 1;
                *(LAS v4u*)(UI + ((((tok & 15) * 64 + (tok >> 4)) * 2 + half) * 16)) = upre[i]; }
            { const int qn = (q + 1) & 3;
#pragma unroll
                for (int i = 0; i < 4; ++i) upre[i] = NTL((const v4u*)(usrc + (size_t)(qn * 1024 + 256 * i) * 2048)); }
            __syncthreads();
#pragma unroll 1
            for (int nf = 0; nf < 4; ++nf) { f32x4 acc = (f32x4){0.f, 0.f, 0.f, 0.f};
#pragma unroll
                for (int ks = 0; ks < 8; ++ks) { const bf16x8 bfr = *(const LAS bf16x8*)(UI + ((((2 * ks + (fq >> 1)) * 64 + 16 * nf + fr) * 2 + (fq & 1)) * 16));
                    acc = __builtin_amdgcn_mfma_f32_16x16x32_bf16(A1[ks], bfr, acc, 0, 0, 0); }
                *(LAS f32x4*)(SL + (16 * nf + fr) * 132 + 16 * wave + 4 * fq) = acc; }
            __syncthreads();
            if (wave == 0) { const f32x2 a16 = PW[16 * 64 + lane];
#pragma unroll 1
                for (int nb = 0; nb < 64; nb += 16) { float sr[16], si[16];
#pragma unroll
                    for (int n = 0; n < 16; ++n) { sr[n] = SL[(nb + n) * 132 + lane]; si[n] = SL[(nb + n) * 132 + 64 + lane]; }
#pragma unroll
                    for (int n = 0; n < 16; ++n) { XP[(nb + n) * 136 + lane] = (bf16)f2bf(Xr); XP[(nb + n) * 136 + 64 + lane] = (bf16)f2bf(Xi);
                        const float nr = a16.x * Xr - a16.y * Xi + sr[n], ni = a16.x * Xi + a16.y * Xr + si[n]; Xr = nr; Xi = ni; } } }
            __syncthreads();
#pragma unroll 1
            for (int nf = 0; nf < 4; ++nf) { f32x4 acc0 = (f32x4){0.f, 0.f, 0.f, 0.f}, acc1 = acc0;
#pragma unroll
                for (int ks = 0; ks < 8; ++ks) { if (2 * ks <= t1 || 2 * ks <= t0) {
                    const int s = 2 * ks + (fq >> 1);
                    const bf16x8 bfr = *(const LAS bf16x8*)(UI + (((s * 64 + 16 * nf + fr) * 2 + (fq & 1)) * 16));
                    if (2 * ks <= t0) { bf16x8 tf = (bf16x8){0, 0, 0, 0, 0, 0, 0, 0}; if (s <= t0) tf = *(const LAS bf16x8*)(KST + ((t0 - s) * 16 + fr) * 16 + 8 * (fq & 1)); acc0 = __builtin_amdgcn_mfma_f32_16x16x32_bf16(tf, bfr, acc0, 0, 0, 0); }
                    if (2 * ks <= t1) { bf16x8 tf = (bf16x8){0, 0, 0, 0, 0, 0, 0, 0}; if (s <= t1) tf = *(const LAS bf16x8*)(KST + ((t1 - s) * 16 + fr) * 16 + 8 * (fq & 1)); acc1 = __builtin_amdgcn_mfma_f32_16x16x32_bf16(tf, bfr, acc1, 0, 0, 0); } } }
#pragma unroll
                for (int ks = 0; ks < 4; ++ks) { const bf16x8 xf = *(const LAS bf16x8*)(XP + (16 * nf + fr) * 136 + 32 * ks + 8 * fq);
                    acc0 = __builtin_amdgcn_mfma_f32_16x16x32_bf16(CM[0][ks], xf, acc0, 0, 0, 0); acc1 = __builtin_amdgcn_mfma_f32_16x16x32_bf16(CM[1][ks], xf, acc1, 0, 0, 0); }
#pragma unroll
                for (int ti = 0; ti < 2; ++ti) { const int t = ti ? t1 : t0; const f32x4 a = ti ? acc1 : acc0; const int n = 16 * nf + fr;
                    const v2u uw = *(const LAS v2u*)(UI + (((t * 64 + n) * 2 + (fq >> 1)) * 16) + 8 * (fq & 1));
                    const pg8::f32x2 g0 = pg8::gelu_pk((pg8::f32x2){a[0] + dsk[0] * bflo(uw.x), a[1] + dsk[1] * bfhi(uw.x)}), g1 = pg8::gelu_pk((pg8::f32x2){a[2] + dsk[2] * bflo(uw.y), a[3] + dsk[3] * bfhi(uw.y)});
                    v2u ow; ow.x = pg8::cvt_pk_bf16(g0.x, g0.y); ow.y = pg8::cvt_pk_bf16(g1.x, g1.y);
                    pg8::st_wt8(yb + (size_t)(b * SEQ + q * 1024 + 16 * n + t) * 2048 + 16 * g + 4 * fq, ow); } }
        }
        }
    }
    __syncthreads();
}
#ifndef EN
#define EN(k) 1
#endif
template <int PH> __device__ __forceinline__ void run_phase(unsigned char* ws, float* X, LAS unsigned char* lds, int wave, int lane) {
    const int G = gridDim.x, bx = blockIdx.x;
    bf16* XB = (bf16*)(ws + WS_XB); float* SSQ = (float*)(ws + WS_SSQ);
    bf16* R0 = (bf16*)(ws + WS_R);
    constexpr int layer = (PH >= 10) ? 1 : 0;
    if constexpr (!EN(PH)) { return; }
    else if constexpr (PH == 0) p0_prologue(ws, lds, wave, lane);
#if defined(MERGE12)
    else if constexpr (PH == 1) {
        struct OneRound { pg8::StaticOrder so; int r;
            __device__ __forceinline__ bool next(int i, pg8::Unit& u) const { return i == 0 ? so.next(r, u) : false; }
            __device__ __forceinline__ void a_ready(const pg8::Unit&) const {}
            __device__ __forceinline__ void done(const pg8::Unit&) const {} };
        LAS float* scr = (LAS float*)(lds + wave * 16896);
        if (bx < 64) { const int i = bx >> 5;
            pg8::Gemm g{(const pg8::bf16_t*)(ws + WS_MEMB), (const pg8::bf16_t*)(ws + WS_W_KV + (size_t)i * 16 * MiB), MROWS, 4096, 2048}; pg8::StaticOrder S; S.init(MROWS, 4096, 32, bx & 31);
            pg8::EpiKV E{(pg8::bf16_t*)(ws + WS_KB + (size_t)i * 2 * MiB), (pg8::bf16_t*)(ws + WS_VB + (size_t)i * 2 * MiB), (pg8::bf16_t*)(ws + WS_VTB + (size_t)i * 2 * MiB), (const float*)(ws + WS_SSQM)};
            pg8::gemm_phase<pg8::EpiKV, pg8::StaticOrder, PG8_ALIGNV, PG8_SP2V>(lds, g, S, E, wave, lane); }
        else if ((bx & 1) == 0) { conv_run<1>(ws, scr, (bx - 64) * NWAVES + wave, (G - 64) * NWAVES, 24576, lane); asm volatile("s_waitcnt vmcnt(0)" ::: "memory"); __syncthreads(); }
        pg8::Gemm g{XB, (const pg8::bf16_t*)(ws + WS_W_AIN), M, 4096, 2048};
        pg8::EpiAct<1, true> E{R0, 4096, ka_in(8), SSQ, 32, 1.0f, (float*)(ws + WS_VST), 8, (LAS float*)(lds + 131072)};
#pragma unroll
        for (int r = 0; r < 2; ++r) { OneRound S; S.so.init(M, 4096, G, bx); S.r = r;
            pg8::gemm_phase<pg8::EpiAct<1, true>, OneRound, PG8_ALIGNV, PG8_SP2V>(lds, g, S, E, wave, lane);
            if (r == 0 && bx >= 64 && (bx & 1) == 1) { conv_run<1>(ws, scr, (bx - 64) * NWAVES + wave, (G - 64) * NWAVES, 24576, lane); asm volatile("s_waitcnt vmcnt(0)" ::: "memory"); __syncthreads(); } }
    }
#else
    else if constexpr (PH == 1) {
        if (bx < 64) { const int i = bx >> 5;
            pg8::Gemm g{(const pg8::bf16_t*)(ws + WS_MEMB), (const pg8::bf16_t*)(ws + WS_W_KV + (size_t)i * 16 * MiB), MROWS, 4096, 2048}; pg8::StaticOrder S; S.init(MROWS, 4096, 32, bx & 31);
            pg8::EpiKV E{(pg8::bf16_t*)(ws + WS_KB + (size_t)i * 2 * MiB), (pg8::bf16_t*)(ws + WS_VB + (size_t)i * 2 * MiB), (pg8::bf16_t*)(ws + WS_VTB + (size_t)i * 2 * MiB), (const float*)(ws + WS_SSQM)};
            pg8::gemm_phase<pg8::EpiKV, pg8::StaticOrder, PG8_ALIGNV, PG8_SP2V>(lds, g, S, E, wave, lane); }
        p1_convert(ws, lds, wave, lane);
    }
#endif
#if defined(MERGE12)
    else if constexpr (PH == 2) { }
#else
    else if constexpr (PH == 2) {
        pg8::Gemm g{XB, (const pg8::bf16_t*)(ws + WS_W_AIN), M, 4096, 2048}; pg8::StaticOrder S; S.init(M, 4096, G, bx);
        pg8::EpiAct<1, true> E{R0, 4096, ka_in(8), SSQ, 32, 1.0f, (float*)(ws + WS_VST), 8, (LAS float*)(lds + 131072)};
        {
#if defined(BG_CONV)
            const bool bgpre = (blockIdx.x & 1) != 0;
            if (bgpre) { bg_convert<PH>(ws, lds, wave, lane); __syncthreads(); }
#else
            const bool bgpre = true;
#endif
            pg8::gemm_phase<pg8::EpiAct<1, true>, pg8::StaticOrder, PG8_ALIGNV, PG8_SP2V>(lds, g, S, E, wave, lane);
            if (!bgpre) bg_convert<PH>(ws, lds, wave, lane); }
    }
#endif
    else if constexpr (PH == 3) {
#if defined(GATING_SIMPLE)
        gating_simple(lds, R0, (const float*)(ws + WS_VST), ka_in(9), ka_in(10), ka_in(11), ka_in(12), R0 + (size_t)M * 4096, wave * 64 + lane);
#else
        gating_mfma(lds, R0, (const float*)(ws + WS_VST), ka_in(9), ka_in(10), ka_in(11), ka_in(12), R0 + (size_t)M * 4096, wave, lane);
#endif
    }
    else if constexpr (PH == 4 || PH == 7 || PH == 9 || PH == 16 || PH == 18) {
        const pg8::bf16_t* A; const pg8::bf16_t* W; int K = 2048;
        if constexpr (PH == 4) { A = R0 + (size_t)M * 4096; W = (const pg8::bf16_t*)(ws + WS_W_AOUT); }
        else if constexpr (PH == 7 || PH == 16) { A = R0 + (size_t)M * 2048; W = (const pg8::bf16_t*)(ws + WS_W_O + (size_t)layer * 8 * MiB); }
        else { A = R0; W = (const pg8::bf16_t*)(ws + WS_W_DN + (size_t)layer * 32 * MiB); K = 8192; }
        pg8::Gemm g{A, W, M, 2048, K}; pg8::StaticOrder S; S.init(M, 2048, G, bx);
        pg8::EpiRes E{XB, SSQ};
        {
#if defined(BG_CONV)
            const bool bgpre = (blockIdx.x & 1) != 0;
            if (bgpre) { bg_convert<PH>(ws, lds, wave, lane); __syncthreads(); }
#else
            const bool bgpre = true;
#endif
            pg8::gemm_phase<pg8::EpiRes, pg8::StaticOrder, PG8_ALIGNV, PG8_SP2V>(lds, g, S, E, wave, lane);
            if (!bgpre) bg_convert<PH>(ws, lds, wave, lane); }
    } else if constexpr (PH == 5 || PH == 14 || PH == 10) {
        const pg8::bf16_t* W = (PH == 10) ? (const pg8::bf16_t*)(ws + WS_W_BIN) : (const pg8::bf16_t*)(ws + WS_W_Q + (size_t)layer * 8 * MiB);
        pg8::Gemm g{XB, W, M, 2048, 2048}; pg8::StaticOrder S; S.init(M, 2048, G, bx);
        pg8::EpiAct<0, false> E{R0, 2048, nullptr, SSQ, (PH == 14) ? 64 : 32, (PH == 10) ? 1.0f : 0.044194173824159216f * 1.4426950408889634f, nullptr, 0, (LAS float*)(lds + 131072)};
        {
#if defined(BG_CONV)
            const bool bgpre = (blockIdx.x & 1) != 0;
            if (bgpre) { bg_convert<PH>(ws, lds, wave, lane); __syncthreads(); }
#else
            const bool bgpre = true;
#endif
            pg8::gemm_phase<pg8::EpiAct<0, false>, pg8::StaticOrder, PG8_ALIGNV, PG8_SP2V>(lds, g, S, E, wave, lane);
            if (!bgpre) bg_convert<PH>(ws, lds, wave, lane); }
    } else if constexpr (PH == 6 || PH == 15) {
#if defined(ATTN_SIMPLE)
        attn_simple(lds, R0, (const bf16*)(ws + WS_KB + (size_t)layer * 2 * MiB), (const bf16*)(ws + WS_VB + (size_t)layer * 2 * MiB), R0 + (size_t)M * 2048, wave, lane);
#else
        attn_mfma(lds, R0, (const bf16*)(ws + WS_KB + (size_t)layer * 2 * MiB), (const bf16*)(ws + WS_VTB + (size_t)layer * 2 * MiB), R0 + (size_t)M * 2048, wave, lane);
#endif
    }
    else if constexpr (PH == 8 || PH == 17) {
        pg8::Gemm g{XB, (const pg8::bf16_t*)(ws + WS_W_UP + (size_t)layer * 32 * MiB), M, FF, 2048}; pg8::StaticOrder S; S.init(M, FF, G, bx);
        pg8::EpiAct<2, false> E{R0, FF, nullptr, SSQ, 32, 1.0f, nullptr, 0, (LAS float*)(lds + 131072)};
        {
#if defined(BG_CONV)
            const bool bgpre = (blockIdx.x & 1) != 0;
            if (bgpre) { bg_convert<PH>(ws, lds, wave, lane); __syncthreads(); }
#else
            const bool bgpre = true;
#endif
            pg8::gemm_phase<pg8::EpiAct<2, false>, pg8::StaticOrder, PG8_ALIGNV, PG8_SP2V>(lds, g, S, E, wave, lane);
            if (!bgpre) bg_convert<PH>(ws, lds, wave, lane); }
    } else if constexpr (PH == 11) {
#if defined(S5_SIMPLE)
        s5_pass_a(R0, (f32x2*)(ws + WS_S5ST), wave, lane);
#endif
    } else if constexpr (PH == 12) {
#if defined(S5_SIMPLE)
        s5_pass_c(lds, R0, (const f32x2*)(ws + WS_S5ST), R0 + (size_t)M * 2048, wave, lane);
#else
        s5_mfma(lds, R0, R0 + (size_t)M * 2048, wave, lane);
#endif
    }
    else if constexpr (PH == 13) {
        pg8::Gemm g{R0 + (size_t)M * 2048, (const pg8::bf16_t*)(ws + WS_W_BOUT), M, 4096, 2048}; pg8::StaticOrder S; S.init(M, 4096, G, bx);
        pg8::EpiGlu E{XB, SSQ, ka_in(24)};
        pg8::gemm_phase<pg8::EpiGlu, pg8::StaticOrder, PG8_ALIGNV, PG8_SP2V>(lds, g, S, E, wave, lane);
    } else if constexpr (PH == 19) final_norm(XB, SSQ, ka_in(6), X, wave, lane);
}
__device__ __forceinline__ int lane_id() { int l; asm volatile("v_mbcnt_lo_u32_b32 %0, -1, 0\n\tv_mbcnt_hi_u32_b32 %0, -1, %0" : "=v"(l)); return l; }

#define XB_TMO      128
#define XB_XCNT(j)  (256  + 64 * (j))
#define XB_XSUB(j)  (1280 + 64 * (j))
#define XB_XGEN(j)  (2304 + 64 * (j))
#define XB_TOP      3328
#define XB_TOPGEN   3392
#define XCD_BAR_WORDS 3456
#define XB_SPIN_CAP (1u << 22)
__device__ __forceinline__ unsigned xb_ld(unsigned* p)              { return __hip_atomic_load(p, __ATOMIC_RELAXED, __HIP_MEMORY_SCOPE_AGENT); }
__device__ __forceinline__ unsigned xb_add(unsigned* p, unsigned v) { return __hip_atomic_fetch_add(p, v, __ATOMIC_RELAXED, __HIP_MEMORY_SCOPE_AGENT); }
__device__ __forceinline__ unsigned xb_xcc_id() { return (unsigned)__builtin_amdgcn_s_getreg((3 << 11) | 20) & 0xFu; }
#define XB_SPIN(cond, bar) do { unsigned _sp = 0; while (cond) { __builtin_amdgcn_s_sleep(1); \
    if ((++_sp & 255u) == 0u) { if (xb_ld(&(bar)[XB_TMO])) break; if (_sp > XB_SPIN_CAP) { atomicAdd(&(bar)[XB_TMO], 1u); break; } } } } while (0)
__device__ __forceinline__ void xcd_barrier_complete(unsigned* bar, unsigned x, unsigned& nloc, unsigned& nx) {
    const unsigned G = gridDim.x * gridDim.y * gridDim.z;
    unsigned sum, cnt, mine, sp = 0u;
    for (;;) {
        sum = 0u; cnt = 0u; mine = 0u;
#pragma unroll
        for (unsigned j = 0; j < 16; ++j) { const unsigned c = xb_ld(&bar[XB_XCNT(j)]); sum += c; cnt += (c > 0u) ? 1u : 0u; mine = (j == x) ? c : mine; }
        if (sum == G) break;
        __builtin_amdgcn_s_sleep(1);
        if ((++sp & 255u) == 0u) { if (xb_ld(&bar[XB_TMO])) break; if (sp > XB_SPIN_CAP) { atomicAdd(&bar[XB_TMO], 1u); break; } }
    }
    nloc = mine > 0u ? mine : 1u; nx = cnt > 0u ? cnt : 1u;
}
__device__ __forceinline__ void xcd_barrier(unsigned* bar, volatile LAS unsigned* st, bool is_t0) {
    asm volatile("s_waitcnt vmcnt(0)" ::: "memory");
    __syncthreads();
    if (is_t0) {
        __builtin_amdgcn_s_waitcnt(0);
        const unsigned x = xb_xcc_id();
        unsigned nloc = st[0], nx = st[1];
        if (nloc == 0u) { xcd_barrier_complete(bar, x, nloc, nx); st[0] = nloc; st[1] = nx; }
        const unsigned old = xb_add(&bar[XB_XSUB(x)], 1u);
        const unsigned gen = old / nloc;
        if (old + 1u == (gen + 1u) * nloc) {
            __builtin_amdgcn_fence(__ATOMIC_RELEASE, "agent");
            asm volatile("s_waitcnt vmcnt(0)" ::: "memory");
            const unsigned og = xb_add(&bar[XB_TOP], 1u);
            const unsigned tg = og / nx;
            if (og + 1u == (tg + 1u) * nx) xb_add(&bar[XB_TOPGEN], 1u);
            else XB_SPIN(xb_ld(&bar[XB_TOPGEN]) == tg, bar);
            __builtin_amdgcn_fence(__ATOMIC_ACQUIRE, "agent");
            xb_add(&bar[XB_XGEN(x)], 1u);
            asm volatile("s_waitcnt vmcnt(0)" ::: "memory");
        } else {
            XB_SPIN(xb_ld(&bar[XB_XGEN(x)]) == gen, bar);
            __builtin_amdgcn_fence(__ATOMIC_ACQUIRE, "agent");
            asm volatile("s_waitcnt vmcnt(0)" ::: "memory");
        }
    }
    __syncthreads();
}

__global__ void __launch_bounds__(NTHREADS, 2) trunk_fwd(Args args) {
    extern __shared__ __attribute__((aligned(16))) unsigned char lds_raw[];
    LAS unsigned char* lds = (LAS unsigned char*)lds_raw;
    const int wave = __builtin_amdgcn_readfirstlane((int)threadIdx.x >> 6);
    const int lo = args.ph_lo, hi = args.ph_hi;
    unsigned* bar = (unsigned*)args.ws + 4096;
    volatile LAS unsigned* st = (volatile LAS unsigned*)(lds + LDS_BYTES - 512);
#if MK_N_LAUNCHES == 1
    { const int l0 = lane_id(); if (wave == 0 && l0 < 2) st[l0] = 0u; __syncthreads(); if (wave == 0 && l0 == 0) (void)xb_add(&bar[XB_XCNT(xb_xcc_id())], 1u); }
#if defined(USE_CG_SYNC)
#define GRID_BAR(k) do { if ((k) == 1) cg::this_grid().sync(); else xcd_barrier(bar, st, wave == 0 && lane_id() == 0); } while (0)
#else
#define GRID_BAR(k) do { xcd_barrier(bar, st, wave == 0 && lane_id() == 0); } while (0)
#endif
#else
#define GRID_BAR(k) do { } while (0)
#endif
#ifndef DUP_PH
#define DUP_PH -1
#endif
#if defined(PROBE_GEMM)
#if PROBE_GEMM == 3
typedef pg8::StaticOrder ProbeOrder;
#else
struct ProbeOrder { int c;
    __device__ __forceinline__ void init(int, int, int, int c_) { c = c_; }
    __device__ __forceinline__ bool next(int i, pg8::Unit& u) const { if (i >= 4) return false;
#if PROBE_GEMM == 1
        u.pm = 0; u.pn = 0;
#else
        u.pm = c >> 3; u.pn = c & 7;
#endif
        return true; }
    __device__ __forceinline__ void a_ready(const pg8::Unit&) const {}
    __device__ __forceinline__ void done(const pg8::Unit&) const {} };
#endif
#endif
#if defined(STAMP_SEL)
#define STAMP(k) do { if (blockIdx.x == 0 && wave == 0 && lane_id() == 0) st[4 + (k)] = (unsigned)__builtin_amdgcn_s_memrealtime(); } while (0)
#else
#define STAMP(k) do { } while (0)
#endif
#define PHASE(k) if (lo <= (k) && (k) < hi) { if ((k) > lo) GRID_BAR(k); STAMP(k); run_phase<k>(args.ws, args.out, lds, wave, lane_id()); STAMP(50 + (k)); if ((k) == DUP_PH) { GRID_BAR(2); run_phase<k>(args.ws, args.out, lds, wave, lane_id()); } }
#if defined(PROBE_WRITE)
    { const int lane = lane_id(); const int gw = blockIdx.x * NWAVES + wave, NGW = gridDim.x * NWAVES;
      for (int it = gw; it < 30720; it += NGW) { ConvSel s = conv_select(args.ws, __builtin_amdgcn_readfirstlane(it));
#if PROBE_WRITE == 1
          const int nblk = s.N >> 6, kb = s.item / nblk, nb = s.item - kb * nblk, k0 = 64 * kb, n0 = 64 * nb; const int c = lane & 7;
#pragma unroll
          for (int j = 0; j < 8; ++j) { const int n = (lane >> 3) + 8 * j; const int nr = s.mode ? glu_rowmap(n0 + n) : (n0 + n); *(v4u*)(s.WT + (size_t)nr * s.K + k0 + 8 * c) = (v4u){0u, 0u, 0u, 0u}; }
#else
          bf16* dst = s.WT + (size_t)s.item * 4096;
#pragma unroll
          for (int j = 0; j < 8; ++j) *(v4u*)(dst + (j * 64 + lane) * 8) = (v4u){0u, 0u, 0u, 0u};
#endif
      }
      GRID_BAR(2); }
#endif
    PHASE(0) PHASE(1)
#if !defined(MERGE12)
    PHASE(2)
#endif
    PHASE(3) PHASE(4) PHASE(5) PHASE(6) PHASE(7) PHASE(8) PHASE(9)
#if defined(PROBE_GEMM)
    { GRID_BAR(2); const int lane = lane_id(); unsigned char* ws = args.ws; bf16* R0 = (bf16*)(ws + WS_R);
      pg8::Gemm g{(bf16*)(ws + WS_XB), (const pg8::bf16_t*)(ws + WS_W_UP), M, FF, 2048}; ProbeOrder S; S.init(M, FF, gridDim.x, blockIdx.x);
      pg8::EpiAct<2, false> E{R0, FF, nullptr, (float*)(ws + WS_SSQ), 32, 1.0f, nullptr, 0};
      pg8::gemm_phase<pg8::EpiAct<2, false>, ProbeOrder, true, true>(lds, g, S, E, wave, lane); }
#endif
#if defined(PROBE_READ)
    { GRID_BAR(2); const int lane = lane_id(); const int gw = blockIdx.x * NWAVES + wave, NGW = gridDim.x * NWAVES; f32x4 accv = (f32x4){0.f, 0.f, 0.f, 0.f};
      for (int it = gw; it < 30720; it += NGW) { f32x4 v[16]; ConvSel s = conv_select(args.ws, __builtin_amdgcn_readfirstlane(it)); f32x4 gq_[2]; conv_load(s, v, gq_, lane);
#pragma unroll
          for (int i = 0; i < 16; ++i) accv += v[i]; }
      if (accv[0] + accv[1] + accv[2] + accv[3] == 12345.678f) ((float*)(args.ws + WS_S5ST))[gw * 64 + lane] = accv[0]; }
#endif
#if defined(EXTRA_BARS)
    for (int eb = 0; eb < EXTRA_BARS; ++eb) GRID_BAR(2);
#endif
    PHASE(10)
#if defined(S5_SIMPLE)
    PHASE(11)
#endif
    PHASE(12) PHASE(13) PHASE(14) PHASE(15) PHASE(16) PHASE(17) PHASE(18) PHASE(19)
#undef PHASE
#if defined(STAMP_SEL)
    asm volatile("s_waitcnt vmcnt(0)" ::: "memory"); __syncthreads(); STAMP(20);
    if (blockIdx.x == 0 && wave == 0 && lane_id() == 0) { unsigned d = (st[4 + STAMP_SEL_END] - st[4 + STAMP_SEL]); d = (d > 100000u ? 0u : d) * STAMP_MUL; const unsigned t0 = (unsigned)__builtin_amdgcn_s_memrealtime();
        while ((unsigned)__builtin_amdgcn_s_memrealtime() - t0 < d) __builtin_amdgcn_s_sleep(8); }
#endif
}

extern "C" void kernel_launch(void* const* d_in, const int* in_sizes, int n_in, void* d_out, int out_size, void* d_ws, size_t ws_size, hipStream_t stream) {
    static int grid = 0;
    if (grid == 0) {
        if (n_in != 30 || out_size != M * D || ws_size < WS_END) { fprintf(stderr, "kernel_launch: unexpected shapes (n_in %d out %d ws %zu)\n", n_in, out_size, ws_size); grid = -1; return; }
        int dev = 0, cus = 0, per_cu = 0;
        if (hipGetDevice(&dev) != hipSuccess || hipDeviceGetAttribute(&cus, hipDeviceAttributeMultiprocessorCount, dev) != hipSuccess) { grid = -1; return; }
        if (hipFuncSetAttribute((const void*)trunk_fwd, hipFuncAttributeMaxDynamicSharedMemorySize, LDS_BYTES) != hipSuccess) { fprintf(stderr, "kernel_launch: hipFuncSetAttribute failed\n"); grid = -1; return; }
        if (hipOccupancyMaxActiveBlocksPerMultiprocessor(&per_cu, (const void*)trunk_fwd, NTHREADS, LDS_BYTES) != hipSuccess || per_cu < 1) { fprintf(stderr, "kernel_launch: occupancy query says %d\n", per_cu); grid = -1; return; }
        grid = cus;
    }
    if (grid < 0) return;
    if (hipMemsetAsync(d_ws, 0, 65536, stream) != hipSuccess) { fprintf(stderr, "kernel_launch: memset failed\n"); return; }
    Args a{};
    for (int i = 0; i < 30; ++i) a.in[i] = (const float*)d_in[i];
    a.out = (float*)d_out; a.ws = (unsigned char*)d_ws;
#if MK_N_LAUNCHES == 1
    a.ph_lo = 0; a.ph_hi = NPH;
    void* kargs[] = {&a};
    hipError_t e = hipLaunchCooperativeKernel((const void*)trunk_fwd, dim3(grid), dim3(NTHREADS), kargs, LDS_BYTES, stream);
    if (e != hipSuccess) fprintf(stderr, "kernel_launch: cooperative launch failed: %s\n", hipGetErrorString(e));
#else
    for (int ph = 0; ph < NPH; ++ph) { a.ph_lo = ph; a.ph_hi = ph + 1; hipLaunchKernelGGL(trunk_fwd, dim3(grid), dim3(NTHREADS), LDS_BYTES, stream, a); }
#endif
}
```

```cpp
#include <hip/hip_runtime.h>
#include <hip/hip_cooperative_groups.h>
#include <cstdio>
#include <cstdint>
namespace cg = cooperative_groups;
#define MK_N_LAUNCHES 1
namespace pg8 {
#define PG8_LAS __attribute__((address_space(3)))
typedef unsigned short bf16_t;
typedef short bf16x8 __attribute__((ext_vector_type(8)));
typedef float f32x4 __attribute__((ext_vector_type(4)));
typedef unsigned u32x4 __attribute__((ext_vector_type(4)));
constexpr int BM = 256, BK = 64, HALF = 128, HTB = HALF * BK * 2  , STAGE_BYTES = 8 * HTB, NXCD = 8, WGM = 8;

__host__ __device__ __forceinline__ int lds_byte(int r, int c) { const int st = (r >> 4) * 2 + (c >> 5), rr = r & 15, cc = c & 31, ob = rr * 64 + cc * 2; return st * 1024 + (ob ^ (((ob >> 9) & 1) << 5)); }
__host__ __device__ __forceinline__ void stage_rc(int b, int& R, int& C) { const int st = b / 1024, sb = b % 1024, swz = sb ^ (((sb >> 9) & 1) << 5); R = (st >> 1) * 16 + swz / 64; C = (st & 1) * 32 + (swz % 64) / 2; }
__host__ __device__ __forceinline__ int perm32(int rho) { const int n = rho >> 4, i = rho & 15; return 8 * (i >> 2) + 4 * n + (i & 3); }

struct Unit { int pm, pn; };
struct Gemm { const bf16_t* A; const bf16_t* Bt; int M, N, K; };

struct StaticOrder {
    int nM, nN, nwg, G, c;
    __host__ __device__ void init(int M, int N, int G_, int c_) { nM = M / BM; nN = N / BM; nwg = nM * nN; G = G_; c = c_; }
    __host__ __device__ bool next(int i, Unit& u) const {
        const long L = (long)i * G + c; if (L >= nwg) return false;
        int wgid = (int)L; { const int q = nwg / NXCD, r = nwg % NXCD, xcd = wgid % NXCD, off = wgid / NXCD; wgid = (xcd < r ? xcd * (q + 1) : r * (q + 1) + (xcd - r) * q) + off; }
        const int nig = WGM * nN, gid = wgid / nig, fm = gid * WGM, gsz = (nM - fm) < WGM ? (nM - fm) : WGM;
        u.pm = fm + ((wgid % nig) % gsz); u.pn = (wgid % nig) / gsz; return true;
    }
    __device__ __forceinline__ void a_ready(const Unit&) const {}
    __device__ __forceinline__ void done(const Unit&) const {}
};

__device__ __forceinline__ unsigned cvt_pk_bf16(float lo, float hi) { unsigned r; asm volatile("v_cvt_pk_bf16_f32 %0, %1, %2" : "=v"(r) : "v"(lo), "v"(hi)); return r; }
typedef float f32x2 __attribute__((ext_vector_type(2)));
__device__ __forceinline__ f32x2 gelu_pk(f32x2 v) {
    const f32x2 av = __builtin_elementwise_abs(v), d = av * 0.2316418882f + 1.0f;
    f32x2 t; t.x = __builtin_amdgcn_rcpf(d.x); t.y = __builtin_amdgcn_rcpf(d.y);
    f32x2 q = t * 0.5307027145f + (-0.7265760135f); q = q * t + 0.7107068705f; q = q * t + (-0.142248368f); q = q * t + 0.127414796f; q = q * t;
    const f32x2 s = (v * v) * (-0.72134752044f);
    f32x2 e; e.x = __builtin_amdgcn_exp2f(s.x); e.y = __builtin_amdgcn_exp2f(s.y);
    const f32x2 m = v * (q * e), r = v - m;
    f32x2 o; o.x = v.x < 0.f ? m.x : r.x; o.y = v.y < 0.f ? m.y : r.y; return o;
}
typedef unsigned u32x2 __attribute__((ext_vector_type(2)));
#if defined(WT_STORES)
__device__ __forceinline__ void st_wt16(void* p, u32x4 v) { asm volatile("global_store_dwordx4 %0, %1, off sc1\n\ts_nop 1" :: "v"(p), "v"(v) : "memory"); }
__device__ __forceinline__ void st_wt8(void* p, u32x2 v) { asm volatile("global_store_dwordx2 %0, %1, off sc1\n\ts_nop 1" :: "v"(p), "v"(v) : "memory"); }
#else
__device__ __forceinline__ void st_wt16(void* p, u32x4 v) { *(u32x4*)p = v; }
__device__ __forceinline__ void st_wt8(void* p, u32x2 v) { *(u32x2*)p = v; }
#endif
constexpr int SSQ_STRIDE = 64;
__device__ __forceinline__ float row_rstd(const float* ssq, int np, int row, int fq) {
    const float* p = ssq + (size_t)row * SSQ_STRIDE + fq * (np >> 2);
    f32x4 a = *(const f32x4*)p, b = *(const f32x4*)(p + 4);
    float s = (a[0] + a[1]) + (a[2] + a[3]) + (b[0] + b[1]) + (b[2] + b[3]);
    if (np == 64) { f32x4 c = *(const f32x4*)(p + 8), d = *(const f32x4*)(p + 12); s += (c[0] + c[1]) + (c[2] + c[3]) + (d[0] + d[1]) + (d[2] + d[3]); }
    s += __shfl_xor(s, 16); s += __shfl_xor(s, 32);
    return __builtin_amdgcn_rsqf(s * (1.0f / 2048.0f) + 1e-6f);
}
template <int ACT, bool STATS> struct EpiAct {
    static constexpr bool PERM = true, AFTER_DRAIN = false, HAS_PRE = true;
    bf16_t* O; int ldc; const float* bias; const float* ssq; int np; float oscale; float* vst; int stat_pn0; PG8_LAS float* rsl;
    __device__ __forceinline__ void pre_issue(f32x4 (&r)[4], const Unit& u, int tid) const {
        if (tid < 256) { const float* p = ssq + (size_t)(u.pm * BM + tid) * SSQ_STRIDE;
#pragma unroll
            for (int k = 0; k < 4; ++k) r[k] = *(const f32x4*)(p + 4 * k) + *(const f32x4*)(p + 16 + 4 * k);
            if (np == 64) {
#pragma unroll
                for (int k = 0; k < 4; ++k) r[k] += *(const f32x4*)(p + 32 + 4 * k) + *(const f32x4*)(p + 48 + 4 * k); } } }
    __device__ __forceinline__ void pre_commit(const f32x4 (&r)[4], PG8_LAS unsigned char*, int tid) const {
        if (tid < 256) { const f32x4 s4 = (r[0] + r[1]) + (r[2] + r[3]); const float s = (s4[0] + s4[1]) + (s4[2] + s4[3]); rsl[tid] = __builtin_amdgcn_rsqf(s * (1.0f / 2048.0f) + 1e-6f); } }
    __device__ __forceinline__ void operator()(const f32x4 (&acc)[2][2][4][2], const Unit& u, int wr, int wc, int fr, int fq) const {
        const int row0 = u.pm * BM + wr * 64 + fr, col0 = u.pn * BM + wc * 32 + 8 * fq;
        f32x4 bv[2][2];
#pragma unroll
        for (int bj = 0; bj < 2; ++bj)
#pragma unroll
            for (int n = 0; n < 2; ++n) bv[bj][n] = bias ? *(const f32x4*)(bias + col0 + bj * HALF + 4 * n) : (f32x4){0.f, 0.f, 0.f, 0.f};
        float rsv[2][4];
#pragma unroll
        for (int ai = 0; ai < 2; ++ai) {
#pragma unroll
            for (int m = 0; m < 4; ++m) rsv[ai][m] = rsl[ai * HALF + wr * 64 + m * 16 + fr]; }
#pragma unroll
        for (int ai = 0; ai < 2; ++ai)
#pragma unroll
            for (int m = 0; m < 4; ++m) { const int row = row0 + ai * HALF + m * 16; const float rs = rsv[ai][m];
                bf16_t* rowp = O + (size_t)row * ldc + col0; float s1 = 0.f, s2 = 0.f;
#pragma unroll
                for (int bj = 0; bj < 2; ++bj) { f32x4 v0 = acc[ai][bj][m][0] * rs + bv[bj][0], v1 = acc[ai][bj][m][1] * rs + bv[bj][1];
                    if (ACT == 1) { f32x2 a = gelu_pk((f32x2){v0[0], v0[1]}), b = gelu_pk((f32x2){v0[2], v0[3]}), c = gelu_pk((f32x2){v1[0], v1[1]}), d = gelu_pk((f32x2){v1[2], v1[3]});
                        v0 = (f32x4){a.x, a.y, b.x, b.y}; v1 = (f32x4){c.x, c.y, d.x, d.y}; }
                    if (ACT == 2) {
#pragma unroll
                        for (int j = 0; j < 4; ++j) { const float a = fmaxf(v0[j], 0.f), b = fmaxf(v1[j], 0.f); v0[j] = a * a; v1[j] = b * b; } }
                    v0 = v0 * oscale; v1 = v1 * oscale;
                    if (STATS) { s1 += (v0[0] + v0[1]) + (v0[2] + v0[3]) + (v1[0] + v1[1]) + (v1[2] + v1[3]);
                        s2 += (v0[0] * v0[0] + v0[1] * v0[1]) + (v0[2] * v0[2] + v0[3] * v0[3]) + (v1[0] * v1[0] + v1[1] * v1[1]) + (v1[2] * v1[2] + v1[3] * v1[3]); }
                    u32x4 w; w.x = cvt_pk_bf16(v0[0], v0[1]); w.y = cvt_pk_bf16(v0[2], v0[3]); w.z = cvt_pk_bf16(v1[0], v1[1]); w.w = cvt_pk_bf16(v1[2], v1[3]);
                    st_wt16(rowp + bj * HALF, w); }
                if (STATS) { s1 += __shfl_xor(s1, 16); s1 += __shfl_xor(s1, 32); s2 += __shfl_xor(s2, 16); s2 += __shfl_xor(s2, 32);
                    if (u.pn >= stat_pn0 && fq == 0) *(f32x2*)(vst + (size_t)row * SSQ_STRIDE + ((u.pn - stat_pn0) * 4 + wc) * 2) = (f32x2){s1, s2}; }
            }
    }
};
struct EpiRes {
    static constexpr bool PERM = true, AFTER_DRAIN = false, HAS_PRE = false;
    bf16_t* xb; float* ssq;
    __device__ __forceinline__ void operator()(const f32x4 (&acc)[2][2][4][2], const Unit& u, int wr, int wc, int fr, int fq) const {
        const int row0 = u.pm * BM + wr * 64 + fr, col0 = u.pn * BM + wc * 32 + 8 * fq;
        u32x4 pre[2][4][2];
#pragma unroll
        for (int ai = 0; ai < 2; ++ai)
#pragma unroll
            for (int m = 0; m < 4; ++m) { const size_t off = (size_t)(row0 + ai * HALF + m * 16) * 2048 + col0;
#pragma unroll
                for (int bj = 0; bj < 2; ++bj) pre[ai][m][bj] = *(const u32x4*)(xb + off + bj * HALF); }
        asm volatile("" ::: "memory");
#pragma unroll
        for (int ai = 0; ai < 2; ++ai) {
#pragma unroll
            for (int m = 0; m < 4; ++m) { const int row = row0 + ai * HALF + m * 16; const size_t off = (size_t)row * 2048 + col0; float ss = 0.f;
#pragma unroll
                for (int bj = 0; bj < 2; ++bj) { const u32x4 b = pre[ai][m][bj]; const f32x4 a0 = acc[ai][bj][m][0], a1 = acc[ai][bj][m][1];
                    const float o0 = __builtin_bit_cast(float, b.x << 16) + a0[0], o1 = __builtin_bit_cast(float, b.x & 0xffff0000u) + a0[1], o2 = __builtin_bit_cast(float, b.y << 16) + a0[2], o3 = __builtin_bit_cast(float, b.y & 0xffff0000u) + a0[3];
                    const float o4 = __builtin_bit_cast(float, b.z << 16) + a1[0], o5 = __builtin_bit_cast(float, b.z & 0xffff0000u) + a1[1], o6 = __builtin_bit_cast(float, b.w << 16) + a1[2], o7 = __builtin_bit_cast(float, b.w & 0xffff0000u) + a1[3];
                    ss += (o0 * o0 + o1 * o1) + (o2 * o2 + o3 * o3) + (o4 * o4 + o5 * o5) + (o6 * o6 + o7 * o7);
                    u32x4 w; w.x = cvt_pk_bf16(o0, o1); w.y = cvt_pk_bf16(o2, o3); w.z = cvt_pk_bf16(o4, o5); w.w = cvt_pk_bf16(o6, o7); st_wt16(xb + off + bj * HALF, w); }
                ss += __shfl_xor(ss, 16); ss += __shfl_xor(ss, 32);
                if (fq == 0) ssq[(size_t)row * SSQ_STRIDE + u.pn * 4 + wc] = ss; }
            asm volatile("" ::: "memory"); }
    }
};
struct EpiGlu {
    static constexpr bool PERM = false, AFTER_DRAIN = false, HAS_PRE = false;
    bf16_t* xb; float* ssq; const float* bias;
    __device__ __forceinline__ void operator()(const f32x4 (&acc)[2][2][4][2], const Unit& u, int wr, int wc, int fr, int fq) const {
        const int row0 = u.pm * BM + wr * 64 + fr, col0 = u.pn * 128 + wc * 16 + 4 * fq;
        f32x4 bval[2], bgate[2];
#pragma unroll
        for (int bj = 0; bj < 2; ++bj) { bval[bj] = *(const f32x4*)(bias + col0 + bj * 64); bgate[bj] = *(const f32x4*)(bias + 2048 + col0 + bj * 64); }
#pragma unroll
        for (int ai = 0; ai < 2; ++ai) {
            u32x2 pre[4][2];
#pragma unroll
            for (int m = 0; m < 4; ++m) { const size_t off = (size_t)(row0 + ai * HALF + m * 16) * 2048 + col0;
#pragma unroll
                for (int bj = 0; bj < 2; ++bj) pre[m][bj] = *(const u32x2*)(xb + off + bj * 64); }
            asm volatile("" ::: "memory");
#pragma unroll
            for (int m = 0; m < 4; ++m) { const int row = row0 + ai * HALF + m * 16; const size_t off = (size_t)row * 2048 + col0; float ss = 0.f;
#pragma unroll
                for (int bj = 0; bj < 2; ++bj) { const f32x4 val = acc[ai][bj][m][0] + bval[bj], gate = acc[ai][bj][m][1] + bgate[bj]; const u32x2 pb = pre[m][bj]; f32x4 o = (f32x4){__builtin_bit_cast(float, pb.x << 16), __builtin_bit_cast(float, pb.x & 0xffff0000u), __builtin_bit_cast(float, pb.y << 16), __builtin_bit_cast(float, pb.y & 0xffff0000u)};
#pragma unroll
                    for (int j = 0; j < 4; ++j) { const float sg = __builtin_amdgcn_rcpf(1.0f + __builtin_amdgcn_exp2f(-1.4426950408889634f * gate[j])); o[j] += val[j] * sg; }
                    ss += (o[0] * o[0] + o[1] * o[1]) + (o[2] * o[2] + o[3] * o[3]);
                    u32x2 w; w.x = cvt_pk_bf16(o[0], o[1]); w.y = cvt_pk_bf16(o[2], o[3]); st_wt8(xb + off + bj * 64, w); }
                ss += __shfl_xor(ss, 16); ss += __shfl_xor(ss, 32);
                if (fq == 0) ssq[(size_t)row * SSQ_STRIDE + u.pn * 4 + wc] = ss; }
            asm volatile("" ::: "memory"); }
    }
};
__host__ __device__ __forceinline__ int vt_pos(int key) { const int s = key >> 5, w = key & 31; return 32 * s + 8 * ((w & 15) >> 2) + (w & 3) + 4 * (w >> 4); }
struct EpiKV {
    static constexpr bool PERM = true, AFTER_DRAIN = false, HAS_PRE = false;
    bf16_t* Kb; bf16_t* Vb; bf16_t* VTb; const float* ssq;
    __device__ __forceinline__ void operator()(const f32x4 (&acc)[2][2][4][2], const Unit& u, int wr, int wc, int fr, int fq) const {
        const int row0 = u.pm * BM + wr * 64 + fr, col0 = u.pn * BM + wc * 32 + 8 * fq;
#pragma unroll
        for (int ai = 0; ai < 2; ++ai)
#pragma unroll
            for (int m = 0; m < 4; ++m) { const int row = row0 + ai * HALF + m * 16; const float rs = row_rstd(ssq, 32, row, fq); const int b = row >> 8, key = row & 255;
#pragma unroll
                for (int bj = 0; bj < 2; ++bj) { const f32x4 v0 = acc[ai][bj][m][0] * rs, v1 = acc[ai][bj][m][1] * rs; const int col = col0 + bj * HALF;
                    u32x4 w; w.x = cvt_pk_bf16(v0[0], v0[1]); w.y = cvt_pk_bf16(v0[2], v0[3]); w.z = cvt_pk_bf16(v1[0], v1[1]); w.w = cvt_pk_bf16(v1[2], v1[3]);
                    if (col < 2048) { const int h = col >> 9, d = col & 511; *(u32x4*)(Kb + ((size_t)((b * 4 + h) * 256 + key)) * 512 + d) = w; }
                    else { const int c2 = col - 2048, h = c2 >> 9, d = c2 & 511; *(u32x4*)(Vb + ((size_t)((b * 4 + h) * 256 + key)) * 512 + d) = w;
                        bf16_t* vt = VTb + ((size_t)((b * 4 + h) * 512 + d)) * 256 + vt_pos(key);
                        vt[0 * 256] = (bf16_t)(w.x & 0xffffu); vt[1 * 256] = (bf16_t)(w.x >> 16); vt[2 * 256] = (bf16_t)(w.y & 0xffffu); vt[3 * 256] = (bf16_t)(w.y >> 16);
                        vt[4 * 256] = (bf16_t)(w.z & 0xffffu); vt[5 * 256] = (bf16_t)(w.z >> 16); vt[6 * 256] = (bf16_t)(w.w & 0xffffu); vt[7 * 256] = (bf16_t)(w.w >> 16); } }
            }
    }
};
template <class Epi, class Sched, bool ALIGN_EPI = false, bool SP2 = false>
__device__ __forceinline__ void gemm_phase(PG8_LAS unsigned char* lds, const Gemm g, const Sched& S, const Epi& E, const int wid  , const int lane) {
    const int tid = wid * 64 + lane, wr = wid >> 2, wc = wid & 3, fr = lane & 15, fq = lane >> 4;
    const int K = g.K, nt = K / BK;
    unsigned voffA[2], voffB[2];
#pragma unroll
    for (int i = 0; i < 2; ++i) { int R, C; stage_rc(tid * 16 + i * 8192, R, C); const int Rb = Epi::PERM ? ((R & ~31) + perm32(R & 31)) : R;
        voffA[i] = (unsigned)(R * K + C) * 2u; voffB[i] = (unsigned)(Rb * K + C) * 2u; }
    const size_t kstep = (size_t)(BK * 2);
    const size_t hstep = (size_t)HALF * K * 2;
    const size_t tstep = 2 * hstep;
    const unsigned ldsw = (unsigned)wid * 1024u;
    const int aoff = lds_byte(wr * 64 + fr, fq * 8), boff = lds_byte(wc * 32 + fr, fq * 8);
#define PG8_SA(b, h) (((b) * 2 + (h)) * HTB)
#define PG8_SB(b, h) ((4 + (b) * 2 + (h)) * HTB)
#define PG8_STAGE(bufoff, gbase, voff) do { _Pragma("unroll") for (int _i = 0; _i < 2; ++_i) \
        __builtin_amdgcn_global_load_lds((const unsigned*)((const char*)(gbase) + (voff)[_i]), (PG8_LAS unsigned*)(lds + (bufoff) + ldsw + _i * 8192), 16, 0, 0); } while (0)
#define PG8_LDA(dst, b, h) do { _Pragma("unroll") for (int m = 0; m < 4; ++m) _Pragma("unroll") for (int k = 0; k < 2; ++k) dst[m][k] = *(const PG8_LAS bf16x8*)(lds + PG8_SA(b, h) + aoff + m * 2048 + k * 1024); } while (0)
#define PG8_LDB(dst, b, h) do { _Pragma("unroll") for (int n = 0; n < 2; ++n) _Pragma("unroll") for (int k = 0; k < 2; ++k) dst[n][k] = *(const PG8_LAS bf16x8*)(lds + PG8_SB(b, h) + boff + n * 2048 + k * 1024); } while (0)
#define PG8_MMA(ai, bj, At, Bt) do { __builtin_amdgcn_s_setprio(1); _Pragma("unroll") for (int m = 0; m < 4; ++m) _Pragma("unroll") for (int n = 0; n < 2; ++n) _Pragma("unroll") for (int k = 0; k < 2; ++k) \
        acc[ai][bj][m][n] = __builtin_amdgcn_mfma_f32_16x16x32_bf16(Bt[n][k], At[m][k], acc[ai][bj][m][n], 0, 0, 0); __builtin_amdgcn_s_setprio(0); } while (0)
#define PG8_WAIT_V(n) asm volatile("s_waitcnt vmcnt(" #n ")" ::: "memory")
#define PG8_WAIT_L(n) asm volatile("s_waitcnt lgkmcnt(" #n ")" ::: "memory")
#define PG8_BAR __builtin_amdgcn_s_barrier()
#define PG8_SCHED __builtin_amdgcn_sched_barrier(0)
    Unit cur, nxt; int ui = 0;
    if (!S.next(0, cur)) return;
    f32x4 acc[2][2][4][2];
#pragma unroll
    for (int a = 0; a < 2; ++a)
#pragma unroll
        for (int b = 0; b < 2; ++b)
#pragma unroll
            for (int m = 0; m < 4; ++m)
#pragma unroll
                for (int n = 0; n < 2; ++n) acc[a][b][m][n] = (f32x4){0.f, 0.f, 0.f, 0.f};
    bf16x8 At[4][2], B0[2][2], B1[2][2];
    const char* cA = (const char*)g.A + (size_t)cur.pm * tstep; const char* cB = (const char*)g.Bt + (size_t)cur.pn * tstep;
    S.a_ready(cur);
    f32x4 prereg[4]; if constexpr (Epi::HAS_PRE) E.pre_issue(prereg, cur, tid);
    if constexpr (SP2) {
        PG8_STAGE(PG8_SB(0, 0), cB, voffB); PG8_STAGE(PG8_SB(0, 1), cB + hstep, voffB); PG8_STAGE(PG8_SA(0, 0), cA, voffA); PG8_STAGE(PG8_SA(0, 1), cA + hstep, voffA);
        if (wr == 1) PG8_BAR;
        PG8_WAIT_V(2); PG8_BAR;
        PG8_STAGE(PG8_SB(1, 0), cB + kstep, voffB); PG8_STAGE(PG8_SA(1, 0), cA + kstep, voffA); PG8_STAGE(PG8_SB(1, 1), cB + hstep + kstep, voffB);
        PG8_WAIT_V(6); PG8_BAR;
        if constexpr (Epi::HAS_PRE) E.pre_commit(prereg, lds, tid);
    } else {
        PG8_STAGE(PG8_SB(0, 0), cB, voffB); PG8_STAGE(PG8_SA(0, 0), cA, voffA); PG8_STAGE(PG8_SB(0, 1), cB + hstep, voffB); PG8_STAGE(PG8_SA(0, 1), cA + hstep, voffA);
        if (wr == 1) PG8_BAR;
        PG8_WAIT_V(4); PG8_BAR;
        PG8_STAGE(PG8_SB(1, 0), cB + kstep, voffB); PG8_STAGE(PG8_SA(1, 0), cA + kstep, voffA); PG8_STAGE(PG8_SB(1, 1), cB + hstep + kstep, voffB);
        PG8_WAIT_V(6); PG8_BAR;
    }
    for (;;) {
        const bool has_next = S.next(ui + 1, nxt);
        const char* nA = has_next ? (const char*)g.A + (size_t)nxt.pm * tstep : cA; const char* nB = has_next ? (const char*)g.Bt + (size_t)nxt.pn * tstep : cB;
        for (int t = 0; t < nt; t += 2) {
            const bool last = (t == nt - 2);
            const char* a1 = cA + (size_t)(t + 1) * kstep;
            const char* a2 = last ? nA : cA + (size_t)(t + 2) * kstep; const char* b2 = last ? nB : cB + (size_t)(t + 2) * kstep;
            const char* a3 = a2 + kstep; const char* b3 = b2 + kstep;
            if (last && has_next) S.a_ready(nxt);
            if constexpr (SP2) {
            PG8_LDB(B0, 0, 0); PG8_LDB(B1, 0, 1); PG8_SCHED; PG8_LDA(At, 0, 0); PG8_STAGE(PG8_SA(1, 1), a1 + hstep, voffA);
            PG8_WAIT_V(8); PG8_WAIT_L(0); PG8_BAR; PG8_MMA(0, 0, At, B0); PG8_MMA(0, 1, At, B1); PG8_BAR; PG8_SCHED;
            PG8_LDA(At, 0, 1); PG8_STAGE(PG8_SB(0, 0), b2, voffB); PG8_STAGE(PG8_SB(0, 1), b2 + hstep, voffB); PG8_STAGE(PG8_SA(0, 0), a2, voffA);
            PG8_WAIT_V(8); PG8_WAIT_L(0); PG8_BAR; PG8_MMA(1, 0, At, B0); PG8_MMA(1, 1, At, B1); PG8_BAR; PG8_SCHED;
            PG8_LDB(B0, 1, 0); PG8_LDB(B1, 1, 1); PG8_SCHED; PG8_LDA(At, 1, 0); PG8_STAGE(PG8_SA(0, 1), a2 + hstep, voffA);
            PG8_WAIT_V(8); PG8_WAIT_L(0); PG8_BAR; PG8_MMA(0, 0, At, B0); PG8_MMA(0, 1, At, B1); PG8_BAR; PG8_SCHED;
            PG8_LDA(At, 1, 1); PG8_STAGE(PG8_SB(1, 0), b3, voffB); PG8_STAGE(PG8_SB(1, 1), b3 + hstep, voffB); PG8_STAGE(PG8_SA(1, 0), a3, voffA);
            PG8_WAIT_V(8); PG8_WAIT_L(0); PG8_BAR; PG8_MMA(1, 0, At, B0); PG8_MMA(1, 1, At, B1); PG8_BAR; PG8_SCHED;
            } else {
            PG8_LDB(B0, 0, 0); PG8_SCHED; PG8_LDA(At, 0, 0); PG8_STAGE(PG8_SA(1, 1), a1 + hstep, voffA);
            PG8_WAIT_L(8); PG8_BAR; PG8_WAIT_L(0); PG8_MMA(0, 0, At, B0); PG8_BAR; PG8_SCHED;
            PG8_LDB(B1, 0, 1); PG8_STAGE(PG8_SB(0, 0), b2, voffB);
            PG8_BAR; PG8_WAIT_L(0); PG8_MMA(0, 1, At, B1); PG8_BAR;
            PG8_LDA(At, 0, 1); PG8_STAGE(PG8_SA(0, 0), a2, voffA);
            PG8_BAR; PG8_WAIT_L(0); PG8_MMA(1, 0, At, B0); PG8_BAR; PG8_SCHED;
            PG8_STAGE(PG8_SB(0, 1), b2 + hstep, voffB);
            PG8_WAIT_V(6); PG8_BAR; PG8_MMA(1, 1, At, B1); PG8_BAR;
            PG8_LDB(B0, 1, 0); PG8_SCHED; PG8_LDA(At, 1, 0); PG8_STAGE(PG8_SA(0, 1), a2 + hstep, voffA);
            PG8_WAIT_L(8); PG8_BAR; PG8_WAIT_L(0); PG8_MMA(0, 0, At, B0); PG8_BAR; PG8_SCHED;
            PG8_LDB(B1, 1, 1); PG8_STAGE(PG8_SB(1, 0), b3, voffB);
            PG8_BAR; PG8_WAIT_L(0); PG8_MMA(0, 1, At, B1); PG8_BAR;
            PG8_LDA(At, 1, 1); PG8_STAGE(PG8_SA(1, 0), a3, voffA);
            PG8_BAR; PG8_WAIT_L(0); PG8_MMA(1, 0, At, B0); PG8_BAR; PG8_SCHED;
            PG8_STAGE(PG8_SB(1, 1), b3 + hstep, voffB);
            PG8_WAIT_V(6); PG8_BAR; PG8_MMA(1, 1, At, B1); PG8_BAR;
            }
        }
        if constexpr (ALIGN_EPI) { if (wr == 0) PG8_BAR; }
        if constexpr (!Epi::AFTER_DRAIN) { Unit ue = cur; asm volatile("" : "+s"(ue.pm), "+s"(ue.pn));
            int fre = fr, fqe = fq; asm volatile("" : "+v"(fre), "+v"(fqe)); E(acc, ue, wr, wc, fre, fqe); S.done(cur); }
        if (!has_next) break;
#pragma unroll
        for (int a = 0; a < 2; ++a)
#pragma unroll
            for (int b = 0; b < 2; ++b)
#pragma unroll
                for (int m = 0; m < 4; ++m)
#pragma unroll
                    for (int n = 0; n < 2; ++n) acc[a][b][m][n] = (f32x4){0.f, 0.f, 0.f, 0.f};
        cur = nxt; cA = nA; cB = nB; ++ui;
        if constexpr (ALIGN_EPI) { if (wr == 1) PG8_BAR; }
    }
    PG8_WAIT_V(0);
    if constexpr (!ALIGN_EPI) { if (wr == 0) PG8_BAR; }
    PG8_BAR;
    if constexpr (Epi::AFTER_DRAIN) { E.fused(acc, cur, wr, wc, fr, fq, lds, wid, lane); S.done(cur); }
#undef PG8_SA
#undef PG8_SB
#undef PG8_STAGE
#undef PG8_LDA
#undef PG8_LDB
#undef PG8_MMA
#undef PG8_WAIT_V
#undef PG8_WAIT_L
#undef PG8_BAR
#undef PG8_SCHED
}
}
#if !defined(NO_MERGE12) && !defined(MERGE12)
#define MERGE12 1
#endif
#ifndef PG8_SP2V
#define PG8_SP2V true
#endif
#ifndef PG8_ALIGNV
#define PG8_ALIGNV true
#endif
#ifndef MK_N_LAUNCHES
#define MK_N_LAUNCHES 1
#endif
constexpr int BATCH = 2, SEQ = 4096, D = 2048, M = BATCH * SEQ, MEMLEN = 256, MROWS = BATCH * MEMLEN, FF = 8192;
constexpr int NWAVES = 8, NTHREADS = 512, NPH = 20;
constexpr int LDS_BYTES = 147456;
constexpr size_t MiB = 1u << 20;
constexpr size_t WS_W_AIN = 2 * MiB, WS_W_AOUT = 18 * MiB, WS_W_BIN = 26 * MiB, WS_W_BOUT = 34 * MiB, WS_W_Q = 50 * MiB, WS_W_KV = 66 * MiB, WS_W_O = 98 * MiB, WS_W_UP = 114 * MiB, WS_W_DN = 178 * MiB;
constexpr size_t WS_XB = 242 * MiB, WS_MEMB = 274 * MiB, WS_KB = 276 * MiB, WS_VB = 280 * MiB, WS_VTB = 284 * MiB, WS_SSQ = 288 * MiB, WS_VST = 290 * MiB, WS_SSQM = 292 * MiB, WS_S5ST = 294 * MiB;
constexpr size_t WS_R = 304 * MiB, WS_S5TAB = 432 * MiB, WS_END = 452 * MiB;
#if defined(MERGE12) && !defined(NO_S5_PRETAB)
#define S5_PRETAB 1
#endif
#define GAS __attribute__((address_space(1)))
#define LAS __attribute__((address_space(3)))
typedef unsigned short bf16;
typedef unsigned v4u __attribute__((ext_vector_type(4)));
typedef unsigned v2u __attribute__((ext_vector_type(2)));
typedef float f32x4 __attribute__((ext_vector_type(4)));
typedef float f32x2 __attribute__((ext_vector_type(2)));
typedef short bf16x8 __attribute__((ext_vector_type(8)));
#define LDS_WAIT() asm volatile("s_waitcnt lgkmcnt(0)" ::: "memory")
#if defined(NT_ACT)
#define NTL(p) __builtin_nontemporal_load(p)
#else
#define NTL(p) (*(p))
#endif
#if defined(NT_OUT)
#define NTS(v, p) __builtin_nontemporal_store((v), (p))
#else
#define NTS(v, p) (*(p) = (v))
#endif
__device__ __forceinline__ unsigned f2bf(float f) { unsigned u = __builtin_bit_cast(unsigned, f); return (u + 0x7fffu + ((u >> 16) & 1u)) >> 16; }
__device__ __forceinline__ unsigned pk2(float lo, float hi) { return f2bf(lo) | (f2bf(hi) << 16); }
__device__ __forceinline__ float bflo(unsigned w) { return __builtin_bit_cast(float, w << 16); }
__device__ __forceinline__ float bfhi(unsigned w) { return __builtin_bit_cast(float, w & 0xffff0000u); }
__device__ __forceinline__ float wave_sum(float v) {
#pragma unroll
    for (int o = 1; o < 64; o <<= 1) v += __shfl_xor(v, o);
    return v;
}
__device__ __forceinline__ float wave_max(float v) {
#pragma unroll
    for (int o = 1; o < 64; o <<= 1) v = fmaxf(v, __shfl_xor(v, o));
    return v;
}
__device__ __forceinline__ float gelu_exact(float v) { return 0.5f * v * (1.0f + erff(v * 0.70710678118654752f)); }

struct Args { const float* in[30]; float* out; unsigned char* ws; int ph_lo, ph_hi; };
__device__ __forceinline__ const float* ka_in(int i) { const __attribute__((address_space(4))) char* ka = (const __attribute__((address_space(4))) char*)__builtin_amdgcn_kernarg_segment_ptr(); asm volatile("" : "+s"(ka)); return *(const float* const __attribute__((address_space(4)))*)(ka + 8 * i); }

#if defined(STAMP_SEL)
#define STAMP2(lds_, id) do { __syncthreads(); if (blockIdx.x == 0 && wave == 0 && lane_id2() == 0) ((volatile LAS unsigned*)((lds_) + LDS_BYTES - 512))[4 + (id)] = (unsigned)__builtin_amdgcn_s_memrealtime(); } while (0)
__device__ __forceinline__ int lane_id2() { int l; asm volatile("v_mbcnt_lo_u32_b32 %0, -1, 0\n\tv_mbcnt_hi_u32_b32 %0, -1, %0" : "=v"(l)); return l; }
#else
#define STAMP2(lds_, id) do { } while (0)
#endif
__device__ __forceinline__ int glu_rowmap(int n) { return n < 2048 ? 32 * (n >> 4) + (n & 15) : 32 * ((n - 2048) >> 4) + 16 + (n & 15); }
struct ConvSel { const float* W; const float* g; bf16* WT; int K, N, mode, item, hasg; };
__device__ const int CONV_TBL[14][9] = {
    {0,     7,  0, 2, 0,   2, 2048, 4096, 0},
    {2048, 13,  0, -1, 0, 18, 2048, 2048, 0},
    {3072, 14,  0, 2, 1,  26, 2048, 2048, 0},
    {4096, 23,  0, -1, 0, 34, 2048, 4096, 1},
    {6144, 25,  0, 3, 0,  50, 2048, 2048, 0},
    {7168, 25,  4, 3, 1,  58, 2048, 2048, 0},
    {8192, 26,  0, 4, 0,  66, 2048, 4096, 0},
    {10240, 26, 8, 4, 1,  82, 2048, 4096, 0},
    {12288, 27, 0, -1, 0, 98, 2048, 2048, 0},
    {13312, 27, 4, -1, 0, 106, 2048, 2048, 0},
    {14336, 28, 0, 5, 0,  114, 2048, 8192, 0},
    {18432, 28, 16, 5, 1, 146, 2048, 8192, 0},
    {22528, 29, 0, -1, 0, 178, 8192, 2048, 0},
    {26624, 29, 16, -1, 0, 210, 8192, 2048, 0},
};
__device__ __forceinline__ ConvSel conv_select(unsigned char* ws, int r) {
    int m = 0;
#pragma unroll
    for (int k = 1; k < 14; ++k) m += (r >= CONV_TBL[k][0]) ? 1 : 0;
    const int* t = CONV_TBL[m];
    ConvSel s; s.W = ka_in(t[1]) + ((size_t)t[2] << 20); s.g = ka_in(t[3] < 0 ? 2 : t[3]) + t[4] * 2048; s.hasg = t[3] >= 0;
    s.WT = (bf16*)(ws + ((size_t)t[5] << 20)); s.K = t[6]; s.N = t[7]; s.mode = t[8]; s.item = r - t[0]; return s;
}
#if defined(CONV_WIDE)
__device__ __forceinline__ void conv_load(const ConvSel& s, f32x4 (&v)[16], int lane) {
    const int nblk = s.N >> 7, kb = s.item / nblk, nb = s.item - kb * nblk, k0 = 32 * kb, n0 = 128 * nb;
#pragma unroll
    for (int i = 0; i < 16; ++i) { const int kk = 2 * i + (lane >> 5); v[i] = *(const f32x4*)(s.W + (size_t)(k0 + kk) * s.N + n0 + 4 * (lane & 31)); }
}
__device__ __forceinline__ void conv_finish(const ConvSel& s, const f32x4 (&v)[16], LAS float* scr, int lane) {
    const int nblk = s.N >> 7, kb = s.item / nblk, nb = s.item - kb * nblk, k0 = 32 * kb, n0 = 128 * nb;
#pragma unroll
    for (int i = 0; i < 16; ++i) { const int kk = 2 * i + (lane >> 5); const float sc = s.g ? s.g[k0 + kk] : 1.0f; LAS float* d = scr + kk * 129 + 4 * (lane & 31);
        d[0] = v[i][0] * sc; d[1] = v[i][1] * sc; d[2] = v[i][2] * sc; d[3] = v[i][3] * sc; }
    LDS_WAIT();
    const int c = lane & 3;
#pragma unroll
    for (int j = 0; j < 8; ++j) { const int n = (lane >> 2) + 16 * j; const LAS float* sp = scr + (8 * c) * 129 + n;
        v4u o; o.x = pk2(sp[0 * 129], sp[1 * 129]); o.y = pk2(sp[2 * 129], sp[3 * 129]); o.z = pk2(sp[4 * 129], sp[5 * 129]); o.w = pk2(sp[6 * 129], sp[7 * 129]);
        const int nr = s.mode ? glu_rowmap(n0 + n) : (n0 + n);
        *(v4u*)(s.WT + (size_t)nr * s.K + k0 + 8 * c) = o; }
    LDS_WAIT();
}
#elif defined(CONV_TALL)
__device__ __forceinline__ void conv_load(const ConvSel& s, f32x4 (&v)[16], int lane) {
    const int nblk = s.N >> 5, kb = s.item / nblk, nb = s.item - kb * nblk, k0 = 128 * kb, n0 = 32 * nb;
#pragma unroll
    for (int i = 0; i < 16; ++i) { const int kk = 8 * i + (lane >> 3); v[i] = *(const f32x4*)(s.W + (size_t)(k0 + kk) * s.N + n0 + 4 * (lane & 7)); }
}
__device__ __forceinline__ void conv_finish(const ConvSel& s, const f32x4 (&v)[16], LAS float* scr, int lane) {
    const int nblk = s.N >> 5, kb = s.item / nblk, nb = s.item - kb * nblk, k0 = 128 * kb, n0 = 32 * nb;
#pragma unroll
    for (int i = 0; i < 16; ++i) { const int kk = 8 * i + (lane >> 3); const float sc = s.g ? s.g[k0 + kk] : 1.0f; LAS float* d = scr + kk * 33 + 4 * (lane & 7);
        d[0] = v[i][0] * sc; d[1] = v[i][1] * sc; d[2] = v[i][2] * sc; d[3] = v[i][3] * sc; }
    LDS_WAIT();
    const int c = lane & 15;
#pragma unroll
    for (int j = 0; j < 8; ++j) { const int n = (lane >> 4) + 4 * j; const LAS float* sp = scr + (8 * c) * 33 + n;
        v4u o; o.x = pk2(sp[0 * 33], sp[1 * 33]); o.y = pk2(sp[2 * 33], sp[3 * 33]); o.z = pk2(sp[4 * 33], sp[5 * 33]); o.w = pk2(sp[6 * 33], sp[7 * 33]);
        const int nr = s.mode ? glu_rowmap(n0 + n) : (n0 + n);
        *(v4u*)(s.WT + (size_t)nr * s.K + k0 + 8 * c) = o; }
    LDS_WAIT();
}
#else
__device__ __forceinline__ void conv_load(const ConvSel& s, f32x4 (&v)[16], f32x4 (&gq)[2], int lane) {
    const int nblk = s.N >> 6, kb = s.item / nblk, nb = s.item - kb * nblk, k0 = 64 * kb, n0 = 64 * nb;
#pragma unroll
    for (int i = 0; i < 16; ++i) { const int kk = 4 * i + (lane >> 4); v[i] = __builtin_nontemporal_load((const f32x4*)(s.W + (size_t)(k0 + kk) * s.N + n0 + 4 * (lane & 15))); }
    gq[0] = *(const f32x4*)(s.g + k0 + 8 * (lane & 7)); gq[1] = *(const f32x4*)(s.g + k0 + 8 * (lane & 7) + 4);
}
__device__ __forceinline__ void conv_finish(const ConvSel& s, const f32x4 (&v)[16], const f32x4 (&gq)[2], LAS float* scr, int lane) {
    const int nblk = s.N >> 6, kb = s.item / nblk, nb = s.item - kb * nblk, k0 = 64 * kb, n0 = 64 * nb;
#pragma unroll
    for (int i = 0; i < 16; ++i) { const int kk = 4 * i + (lane >> 4); LAS float* d = scr + kk * 65 + 4 * (lane & 15);
        d[0] = v[i][0]; d[1] = v[i][1]; d[2] = v[i][2]; d[3] = v[i][3]; }
    LDS_WAIT();
    const f32x4 one = (f32x4){1.f, 1.f, 1.f, 1.f}; const f32x4 g0 = s.hasg ? gq[0] : one, g1 = s.hasg ? gq[1] : one;
    const int c = lane & 7;
#pragma unroll
    for (int j = 0; j < 8; ++j) { const int n = (lane >> 3) + 8 * j; const LAS float* sp = scr + (8 * c) * 65 + n;
        v4u o; o.x = pg8::cvt_pk_bf16(sp[0 * 65] * g0[0], sp[1 * 65] * g0[1]); o.y = pg8::cvt_pk_bf16(sp[2 * 65] * g0[2], sp[3 * 65] * g0[3]);
        o.z = pg8::cvt_pk_bf16(sp[4 * 65] * g1[0], sp[5 * 65] * g1[1]); o.w = pg8::cvt_pk_bf16(sp[6 * 65] * g1[2], sp[7 * 65] * g1[3]);
        const int nr = s.mode ? glu_rowmap(n0 + n) : (n0 + n);
        *(v4u*)(s.WT + (size_t)nr * s.K + k0 + 8 * c) = o; }
    LDS_WAIT();
}
#endif
template <int PART> __device__ __forceinline__ int conv_index(int j) {
#if defined(MERGE12)
    if (PART == 0) return j < 4096 ? 8192 + j : j - 4096;
    if (PART == 1) return j < 6144 ? 2048 + j : 12288 + (j - 6144);
#elif !defined(BG_CONV)
    if (PART == 0) return 8192 + j;
    if (PART == 1) return j < 8192 ? j : j + 4096;
#endif
    if (PART == 0) return j < 4096 ? 8192 + j : j - 4096;
    if (PART == 1) return j < 1024 ? 2048 + j : (j < 2048 ? 6144 + (j - 1024) : (j < 3072 ? 12288 + (j - 2048) : 14336 + (j - 3072)));
    return j < 4096 ? 22528 + j : (j < 5120 ? 3072 + (j - 4096) : (j < 6144 ? 7168 + (j - 5120) : (j < 8192 ? 4096 + (j - 6144) : (j < 9216 ? 13312 + (j - 8192) : (j < 13312 ? 18432 + (j - 9216) : 26624 + (j - 13312))))));
}
template <int PART> __device__ __forceinline__ void conv_run(unsigned char* ws, LAS float* scr, int first, int step, int limit, int lane) {
    if (first >= limit) return;
    const int cnt = (limit - first + step - 1) / step, jlast = first + (cnt - 1) * step;
    f32x4 va[16], vb[16], ga[2], gb[2];
    ConvSel sa = conv_select(ws, conv_index<PART>(__builtin_amdgcn_readfirstlane(first))), sb;
    conv_load(sa, va, ga, lane);
    for (int i = 0; i < cnt; i += 2) {
        const int j1 = min(first + (i + 1) * step, jlast), j2 = min(first + (i + 2) * step, jlast);
        sb = conv_select(ws, conv_index<PART>(__builtin_amdgcn_readfirstlane(j1))); conv_load(sb, vb, gb, lane);
        conv_finish(sa, va, ga, scr, lane);
        sa = conv_select(ws, conv_index<PART>(__builtin_amdgcn_readfirstlane(j2))); conv_load(sa, va, ga, lane);
        conv_finish(sb, vb, gb, scr, lane);
    }
}
__device__ __forceinline__ void rows_to_bf16(unsigned char* ws, int m0, int step, int lane) {
    f32x4 v[3][8];
#pragma unroll
    for (int r = 0; r < 3; ++r) { const int m = m0 + r * step; if (m < M + MROWS) { const float* xrow = (m < M) ? ka_in(0) + (size_t)m * D : ka_in(1) + (size_t)(m - M) * D;
#pragma unroll
            for (int j = 0; j < 8; ++j) v[r][j] = __builtin_nontemporal_load(((const f32x4*)xrow) + lane + 64 * j); } }
#pragma unroll
    for (int r = 0; r < 3; ++r) { const int m = m0 + r * step; if (m < M + MROWS) {
            bf16* orow = (m < M) ? (bf16*)(ws + WS_XB) + (size_t)m * D : (bf16*)(ws + WS_MEMB) + (size_t)(m - M) * D;
            float* ssqrow = (m < M) ? (float*)(ws + WS_SSQ) + (size_t)m * 64 : (float*)(ws + WS_SSQM) + (size_t)(m - M) * 64;
            float s = 0.f;
#pragma unroll
            for (int j = 0; j < 8; ++j) s += (v[r][j][0] * v[r][j][0] + v[r][j][1] * v[r][j][1]) + (v[r][j][2] * v[r][j][2] + v[r][j][3] * v[r][j][3]);
            s = wave_sum(s);
#pragma unroll
            for (int j = 0; j < 8; ++j) { v2u w; w.x = pg8::cvt_pk_bf16(v[r][j][0], v[r][j][1]); w.y = pg8::cvt_pk_bf16(v[r][j][2], v[r][j][3]); ((v2u*)orow)[lane + 64 * j] = w; }
            if (lane < 32) ssqrow[lane] = (lane == 0) ? s : 0.f; } }
}
__device__ __forceinline__ void p0_prologue(unsigned char* ws, LAS unsigned char* lds, int wave, int lane) {
    LAS float* scr = (LAS float*)(lds + wave * 16896);
    const int gw = blockIdx.x * NWAVES + wave, NGW = gridDim.x * NWAVES;
#if defined(BG_CONV) || defined(MERGE12)
    conv_run<0>(ws, scr, gw, NGW, 6144, lane);
#else
    conv_run<0>(ws, scr, gw, NGW, 4096, lane);
#endif
    for (int m = gw; m < M + MROWS; m += 3 * NGW) rows_to_bf16(ws, m, NGW, lane);
}
__device__ __forceinline__ void p1_convert(unsigned char* ws, LAS unsigned char* lds, int wave, int lane) {
    LAS float* scr = (LAS float*)(lds + wave * 16896);
    const int bx = blockIdx.x, G = gridDim.x;
#if defined(BG_CONV)
    if (G <= 64) { conv_run<1>(ws, scr, bx * NWAVES + wave, G * NWAVES, 7168, lane); return; }
    if (bx >= 64) conv_run<1>(ws, scr, (bx - 64) * NWAVES + wave, (G - 64) * NWAVES, 7168, lane);
#else
    constexpr int CONV_REST = 26624, CONV_SPLIT = 22272;
    if (G <= 64) { conv_run<1>(ws, scr, bx * NWAVES + wave, G * NWAVES, CONV_REST, lane); return; }
    if (bx >= 64) conv_run<1>(ws, scr, (bx - 64) * NWAVES + wave, (G - 64) * NWAVES, CONV_SPLIT, lane);
    else conv_run<1>(ws, scr, CONV_SPLIT + bx * NWAVES + wave, 64 * NWAVES, CONV_REST, lane);
#endif
}
template <int PH> __device__ __forceinline__ void bg_convert(unsigned char* ws, LAS unsigned char* lds, int wave, int lane) {
    constexpr int j0 = (PH == 2) ? 0 : (PH == 4) ? 2048 : (PH == 5) ? 4096 : (PH == 7) ? 6144 : (PH == 8) ? 8192 : (PH == 9) ? 12288 : (PH == 10) ? 16384 : -1;
    constexpr int j1 = (PH == 8) ? 12288 : (PH == 9) ? 16384 : (PH == 10) ? 17408 : j0 + 2048;
#if defined(BG_CONV)
    if constexpr (j0 >= 0) { LAS float* scr = (LAS float*)(lds + wave * 16896); const int gw = blockIdx.x * NWAVES + wave, NGW = gridDim.x * NWAVES;
        conv_run<2>(ws, scr, j0 + gw, NGW, j1, lane); }
#endif
}
__device__ __forceinline__ void final_norm(const bf16* xb, const float* ssq, const float* g, float* out, int wave, int lane) {
    const int gw = blockIdx.x * NWAVES + wave, NGW = gridDim.x * NWAVES;
    for (int m = gw; m < M; m += NGW) {
        float s = (lane < 32) ? ssq[(size_t)m * 64 + lane] : 0.f; s = wave_sum(s);
        const float rs = 1.0f / sqrtf(s * (1.0f / D) + 1e-6f);
        const v4u* xr = (const v4u*)(xb + (size_t)m * D); f32x4* orow = (f32x4*)(out + (size_t)m * D);
#pragma unroll
        for (int j = 0; j < 4; ++j) { const v4u w = NTL(xr + lane + 64 * j); const f32x4 g0 = ((const f32x4*)g)[2 * (lane + 64 * j)], g1 = ((const f32x4*)g)[2 * (lane + 64 * j) + 1];
            NTS(((f32x4){bflo(w.x) * rs * g0[0], bfhi(w.x) * rs * g0[1], bflo(w.y) * rs * g0[2], bfhi(w.y) * rs * g0[3]}), orow + 2 * (lane + 64 * j));
            NTS(((f32x4){bflo(w.z) * rs * g1[0], bfhi(w.z) * rs * g1[1], bflo(w.w) * rs * g1[2], bfhi(w.w) * rs * g1[3]}), orow + 2 * (lane + 64 * j) + 1); } }
}
__device__ __forceinline__ void gating_simple(LAS unsigned char* lds, const bf16* z, const float* vst, const float* ln_g, const float* ln_b, const float* w_s, const float* b_s, bf16* gbuf, int tid) {
    LAS float* vln = (LAS float*)lds;
    LAS float* Wl = (LAS float*)(lds + 65536);
    LAS float* mu = (LAS float*)(lds + 65536 + 128 * 129 * 4);
    LAS float* rsd = mu + 128;
    for (int unit = blockIdx.x; unit < 1024; unit += gridDim.x) {
        const int h = unit & 15, tok0 = (unit >> 4) * 128;
        if (tid < 128) { const float* p = vst + (size_t)(tok0 + tid) * 64; float s1 = 0.f, s2 = 0.f;
#pragma unroll 8
            for (int i = 0; i < 32; ++i) { s1 += p[2 * i]; s2 += p[2 * i + 1]; }
            const float mean = s1 * (1.0f / 2048.0f), var = s2 * (1.0f / 2048.0f) - mean * mean; mu[tid] = mean; rsd[tid] = 1.0f / sqrtf(var + 1e-6f); }
        __syncthreads();
        { const int s = tid >> 2, db = (tid & 3) * 32; const float mean = mu[s], rs = rsd[s];
            const bf16* vp = z + (size_t)(tok0 + s) * 4096 + 2048 + h * 128 + db;
#pragma unroll
            for (int q = 0; q < 4; ++q) { const v4u w = *(const v4u*)(vp + 8 * q); const float* gp = ln_g + h * 128 + db + 8 * q; const float* bp = ln_b + h * 128 + db + 8 * q; LAS float* o = vln + s * 128 + db + 8 * q;
                o[0] = (bflo(w.x) - mean) * rs * gp[0] + bp[0]; o[1] = (bfhi(w.x) - mean) * rs * gp[1] + bp[1]; o[2] = (bflo(w.y) - mean) * rs * gp[2] + bp[2]; o[3] = (bfhi(w.y) - mean) * rs * gp[3] + bp[3];
                o[4] = (bflo(w.z) - mean) * rs * gp[4] + bp[4]; o[5] = (bfhi(w.z) - mean) * rs * gp[5] + bp[5]; o[6] = (bflo(w.w) - mean) * rs * gp[6] + bp[6]; o[7] = (bfhi(w.w) - mean) * rs * gp[7] + bp[7]; }
            const float* wp = w_s + ((size_t)h * 128 + s) * 128 + db;
#pragma unroll
            for (int q = 0; q < 8; ++q) { const f32x4 w4 = *(const f32x4*)(wp + 4 * q); LAS float* o = Wl + s * 129 + db + 4 * q; o[0] = w4[0]; o[1] = w4[1]; o[2] = w4[2]; o[3] = w4[3]; } }
        __syncthreads();
        { const int t = tid >> 2, d0 = (tid & 3) * 32, tmax = t | 15; float acc[32];
#pragma unroll
            for (int j = 0; j < 32; ++j) acc[j] = 0.f;
            for (int s = 0; s <= tmax; ++s) { const float w = (s <= t) ? Wl[t * 129 + s] : 0.f; const LAS f32x4* vr = (const LAS f32x4*)(vln + s * 128 + d0);
#pragma unroll
                for (int q = 0; q < 8; ++q) { const f32x4 vv = vr[q]; acc[4 * q] += w * vv[0]; acc[4 * q + 1] += w * vv[1]; acc[4 * q + 2] += w * vv[2]; acc[4 * q + 3] += w * vv[3]; } }
            const float bs = b_s[h * 128 + t];
            const bf16* up = z + (size_t)(tok0 + t) * 4096 + h * 128 + d0; bf16* op = gbuf + (size_t)(tok0 + t) * 2048 + h * 128 + d0;
#pragma unroll
            for (int q = 0; q < 4; ++q) { const v4u w = *(const v4u*)(up + 8 * q); v4u o;
                o.x = pk2(bflo(w.x) * (acc[8 * q] + bs), bfhi(w.x) * (acc[8 * q + 1] + bs)); o.y = pk2(bflo(w.y) * (acc[8 * q + 2] + bs), bfhi(w.y) * (acc[8 * q + 3] + bs));
                o.z = pk2(bflo(w.z) * (acc[8 * q + 4] + bs), bfhi(w.z) * (acc[8 * q + 5] + bs)); o.w = pk2(bflo(w.w) * (acc[8 * q + 6] + bs), bfhi(w.w) * (acc[8 * q + 7] + bs));
                *(v4u*)(op + 8 * q) = o; } }
        __syncthreads();
    }
}
__device__ __forceinline__ void gating_mfma(LAS unsigned char* lds, const bf16* z, const float* vst, const float* ln_g, const float* ln_b, const float* w_s, const float* b_s, bf16* gbuf, int wave, int lane) {
    LAS float* MU = (LAS float*)(lds + 69632);
    const int tid = wave * 64 + lane, fr = lane & 15, fq = lane >> 4;
    const int ss = tid >> 2, db = (tid & 3) * 32;
    for (int unit = blockIdx.x; unit < 256; unit += gridDim.x) {
        const int tok0 = (unit >> 2) * 128, hg = unit & 3;
        __syncthreads();
        if (tid < 128) { const float* sp = vst + (size_t)(tok0 + tid) * 64; float s1 = 0.f, s2 = 0.f;
#pragma unroll
            for (int i = 0; i < 16; ++i) { const f32x4 a = *(const f32x4*)(sp + 4 * i); s1 += a[0] + a[2]; s2 += a[1] + a[3]; }
            const float mean = s1 * (1.0f / 2048.0f), var = s2 * (1.0f / 2048.0f) - mean * mean; MU[tid] = mean; MU[128 + tid] = 1.0f / sqrtf(var + 1e-6f); }
        v4u raw[4];
        { const bf16* vp = z + (size_t)(tok0 + ss) * 4096 + 2048 + (hg * 4) * 128 + db;
#pragma unroll
            for (int q4 = 0; q4 < 4; ++q4) raw[q4] = NTL((const v4u*)(vp + 8 * q4)); }
        __syncthreads();
        const float mean = MU[ss], rs = MU[128 + ss];
#pragma unroll 1
        for (int hh = 0; hh < 4; ++hh) { const int h = hg * 4 + hh; LAS unsigned char* VT = lds + (hh & 1) * 34816;
            const int t = 16 * wave + fr, nks = (wave >> 1) + 1;
            f32x4 wa[4][2];
#pragma unroll
            for (int ks = 0; ks < 4; ++ks) if (ks < nks) { const float* wp = w_s + ((size_t)h * 128 + t) * 128 + 32 * ks + 8 * fq; wa[ks][0] = *(const f32x4*)wp; wa[ks][1] = *(const f32x4*)(wp + 4); }
            const float bs = b_s[h * 128 + t];
            const bf16* up = z + (size_t)(tok0 + t) * 4096 + h * 128 + 4 * fq; bf16* op = gbuf + (size_t)(tok0 + t) * 2048 + h * 128 + 4 * fq;
            v2u uwv[8];
#pragma unroll
            for (int df = 0; df < 8; ++df) uwv[df] = NTL((const v2u*)(up + 16 * df));
            { const float* gp = ln_g + h * 128 + db; const float* bp = ln_b + h * 128 + db; LAS unsigned char* wp = VT + db * 272 + (ss ^ (8 * (tid & 3))) * 2;
#pragma unroll
                for (int q4 = 0; q4 < 4; ++q4) { const f32x4 g0 = *(const f32x4*)(gp + 8 * q4), g1 = *(const f32x4*)(gp + 8 * q4 + 4), b0 = *(const f32x4*)(bp + 8 * q4), b1 = *(const f32x4*)(bp + 8 * q4 + 4); const v4u w = raw[q4];
                    const float v0 = (bflo(w.x) - mean) * rs * g0[0] + b0[0], v1 = (bfhi(w.x) - mean) * rs * g0[1] + b0[1], v2 = (bflo(w.y) - mean) * rs * g0[2] + b0[2], v3 = (bfhi(w.y) - mean) * rs * g0[3] + b0[3];
                    const float v4 = (bflo(w.z) - mean) * rs * g1[0] + b1[0], v5 = (bfhi(w.z) - mean) * rs * g1[1] + b1[1], v6 = (bflo(w.w) - mean) * rs * g1[2] + b1[2], v7 = (bfhi(w.w) - mean) * rs * g1[3] + b1[3];
                    LAS unsigned char* o = wp + (8 * q4) * 272;
                    *(LAS bf16*)(o + 0 * 272) = (bf16)f2bf(v0); *(LAS bf16*)(o + 1 * 272) = (bf16)f2bf(v1); *(LAS bf16*)(o + 2 * 272) = (bf16)f2bf(v2); *(LAS bf16*)(o + 3 * 272) = (bf16)f2bf(v3);
                    *(LAS bf16*)(o + 4 * 272) = (bf16)f2bf(v4); *(LAS bf16*)(o + 5 * 272) = (bf16)f2bf(v5); *(LAS bf16*)(o + 6 * 272) = (bf16)f2bf(v6); *(LAS bf16*)(o + 7 * 272) = (bf16)f2bf(v7); } }
            if (hh < 3) { const bf16* vp = z + (size_t)(tok0 + ss) * 4096 + 2048 + (h + 1) * 128 + db;
#pragma unroll
                for (int q4 = 0; q4 < 4; ++q4) raw[q4] = NTL((const v4u*)(vp + 8 * q4)); }
            __syncthreads();
            bf16x8 wf[4];
#pragma unroll
            for (int ks = 0; ks < 4; ++ks) { wf[ks] = (bf16x8){0, 0, 0, 0, 0, 0, 0, 0};
                if (ks < nks) { const f32x4 a = wa[ks][0], c = wa[ks][1]; const int s0 = 32 * ks + 8 * fq;
                    float v[8] = {a[0], a[1], a[2], a[3], c[0], c[1], c[2], c[3]};
#pragma unroll
                    for (int j = 0; j < 8; ++j) v[j] = (s0 + j <= t) ? v[j] : 0.f;
                    v4u w; w.x = pk2(v[0], v[1]); w.y = pk2(v[2], v[3]); w.z = pk2(v[4], v[5]); w.w = pk2(v[6], v[7]); wf[ks] = __builtin_bit_cast(bf16x8, w); } }
#pragma unroll
            for (int df = 0; df < 8; ++df) { f32x4 acc = (f32x4){0.f, 0.f, 0.f, 0.f};
#pragma unroll
                for (int ks = 0; ks < 4; ++ks) if (ks < nks) { const bf16x8 a = *(const LAS bf16x8*)(VT + (df * 16 + fr) * 272 + (((32 * ks + 8 * fq) ^ (8 * ((df >> 1) & 3))) * 2)); acc = __builtin_amdgcn_mfma_f32_16x16x32_bf16(a, wf[ks], acc, 0, 0, 0); }
                const v2u uw = uwv[df]; v2u ow;
                ow.x = pg8::cvt_pk_bf16(bflo(uw.x) * (acc[0] + bs), bfhi(uw.x) * (acc[1] + bs)); ow.y = pg8::cvt_pk_bf16(bflo(uw.y) * (acc[2] + bs), bfhi(uw.y) * (acc[3] + bs));
                pg8::st_wt8(op + 16 * df, ow); }
        }
    }
    __syncthreads();
}
__device__ __forceinline__ void attn_simple(LAS unsigned char* lds, const bf16* q, const bf16* Kb, const bf16* Vb, bf16* obuf, int wave, int lane) {
    LAS float* pl = (LAS float*)(lds + wave * 1024);
    const int gw = blockIdx.x * NWAVES + wave, NGW = gridDim.x * NWAVES;
    for (int task = gw; task < BATCH * 4 * SEQ; task += NGW) {
        const int bh = task >> 12, t = task & 4095, b = bh >> 2, h = bh & 3;
        float qf[8]; { const v4u w = *(const v4u*)(q + ((size_t)(b * SEQ + t)) * 2048 + h * 512 + 8 * lane);
            qf[0] = bflo(w.x); qf[1] = bfhi(w.x); qf[2] = bflo(w.y); qf[3] = bfhi(w.y); qf[4] = bflo(w.z); qf[5] = bfhi(w.z); qf[6] = bflo(w.w); qf[7] = bfhi(w.w); }
        const bf16* kp = Kb + (size_t)bh * 256 * 512 + 8 * lane;
        float sc[4];
#pragma unroll
        for (int kk = 0; kk < 4; ++kk) { float mine = 0.f;
            for (int l2 = 0; l2 < 64; ++l2) { const v4u w = *(const v4u*)(kp + (size_t)(kk * 64 + l2) * 512);
                float dsum = qf[0] * bflo(w.x) + qf[1] * bfhi(w.x) + qf[2] * bflo(w.y) + qf[3] * bfhi(w.y) + qf[4] * bflo(w.z) + qf[5] * bfhi(w.z) + qf[6] * bflo(w.w) + qf[7] * bfhi(w.w);
                dsum = wave_sum(dsum); if (lane == l2) mine = dsum; }
            sc[kk] = mine; }
        const float mx = wave_max(fmaxf(fmaxf(sc[0], sc[1]), fmaxf(sc[2], sc[3])));
        float p[4], ps = 0.f;
#pragma unroll
        for (int kk = 0; kk < 4; ++kk) { p[kk] = exp2f(sc[kk] - mx); ps += p[kk]; pl[kk * 64 + lane] = p[kk]; }
        const float inv = 1.0f / wave_sum(ps);
        LDS_WAIT();
        float o[8];
#pragma unroll
        for (int i = 0; i < 8; ++i) o[i] = 0.f;
        const bf16* vp = Vb + (size_t)bh * 256 * 512 + 8 * lane;
        for (int key = 0; key < 256; ++key) { const float pk = pl[key]; const v4u w = *(const v4u*)(vp + (size_t)key * 512);
            o[0] += pk * bflo(w.x); o[1] += pk * bfhi(w.x); o[2] += pk * bflo(w.y); o[3] += pk * bfhi(w.y); o[4] += pk * bflo(w.z); o[5] += pk * bfhi(w.z); o[6] += pk * bflo(w.w); o[7] += pk * bfhi(w.w); }
        v4u ow; ow.x = pk2(o[0] * inv, o[1] * inv); ow.y = pk2(o[2] * inv, o[3] * inv); ow.z = pk2(o[4] * inv, o[5] * inv); ow.w = pk2(o[6] * inv, o[7] * inv);
        *(v4u*)(obuf + ((size_t)(b * SEQ + t)) * 2048 + h * 512 + 8 * lane) = ow;
        LDS_WAIT();
    }
}
__device__ __forceinline__ void attn_mfma(LAS unsigned char* lds, const bf16* q, const bf16* Kb, const bf16* VTb, bf16* obuf, int wave, int lane) {
    const int tid = wave * 64 + lane, fr = lane & 15, fq = lane >> 4;
    unsigned voffK[2], voffV[2];
#pragma unroll
    for (int i = 0; i < 2; ++i) { int R, C; pg8::stage_rc(tid * 16 + i * 8192, R, C); voffK[i] = (unsigned)(R * 512 + C) * 2u; voffV[i] = (unsigned)(R * 256 + C) * 2u; }
    const unsigned ldsw = (unsigned)wave * 1024u;
    const int aoff0 = pg8::lds_byte(fr, fq * 8);
#define AT_STAGE_K(c, buf) do { _Pragma("unroll") for (int ht = 0; ht < 4; ++ht) { const char* src = Kg + ((size_t)(128 * (ht >> 1)) * 512 + 128 * (c) + 64 * (ht & 1)) * 2; \
        _Pragma("unroll") for (int i = 0; i < 2; ++i) __builtin_amdgcn_global_load_lds((const unsigned*)(src + voffK[i]), (LAS unsigned*)(lds + (buf) * 65536 + ht * 16384 + ldsw + i * 8192), 16, 0, 0); } } while (0)
#define AT_STAGE_V(cc, buf) do { _Pragma("unroll") for (int ht = 0; ht < 4; ++ht) { const char* src = Vg + ((size_t)(128 * ht) * 256 + 64 * (cc)) * 2; \
        _Pragma("unroll") for (int i = 0; i < 2; ++i) __builtin_amdgcn_global_load_lds((const unsigned*)(src + voffV[i]), (LAS unsigned*)(lds + (buf) * 65536 + ht * 16384 + ldsw + i * 8192), 16, 0, 0); } } while (0)
#define AT_WAIT() do { asm volatile("s_waitcnt vmcnt(0)" ::: "memory"); __syncthreads(); } while (0)
    for (int unit = blockIdx.x; unit < 256; unit += gridDim.x) {
        const int bh = unit & 7, qb = unit >> 3, b = bh >> 2, h = bh & 3;
        const char* Kg = (const char*)(Kb + (size_t)bh * 256 * 512);
        const char* Vg = (const char*)(VTb + (size_t)bh * 512 * 256);
        const size_t tok = (size_t)(b * SEQ + qb * 128 + 16 * wave + fr);
        bf16x8 qf[16];
        { const bf16* qp = q + tok * 2048 + h * 512 + 8 * fq;
#pragma unroll
            for (int s = 0; s < 16; ++s) qf[s] = NTL((const bf16x8*)(qp + 32 * s)); }
        f32x4 acc[16];
#pragma unroll
        for (int n = 0; n < 16; ++n) acc[n] = (f32x4){0.f, 0.f, 0.f, 0.f};
        STAMP2(lds, 40);
        AT_STAGE_K(0, 0);
#pragma unroll
        for (int c = 0; c < 4; ++c) {
            AT_WAIT();
            if (c < 3) AT_STAGE_K(c + 1, (c + 1) & 1); else AT_STAGE_V(0, 0);
            const LAS unsigned char* bb = lds + (c & 1) * 65536 + aoff0; asm volatile("" : "+v"(bb));
#define AT_QK_LOAD(dst, gi) do { _Pragma("unroll") for (int n8 = 0; n8 < 8; ++n8) dst[n8] = *(const LAS bf16x8*)(bb + ((((gi) & 1) * 2 + ((gi) >> 2)) * 16384) + n8 * 2048 + (((gi) >> 1) & 1) * 1024); } while (0)
#define AT_QK_MMA(src, gi) do { _Pragma("unroll") for (int n8 = 0; n8 < 8; ++n8) acc[((gi) & 1) * 8 + n8] = __builtin_amdgcn_mfma_f32_16x16x32_bf16(src[n8], qf[4 * c + 2 * ((gi) >> 2) + (((gi) >> 1) & 1)], acc[((gi) & 1) * 8 + n8], 0, 0, 0); } while (0)
            { bf16x8 a0[8], a1[8];
                AT_QK_LOAD(a0, 0);
#pragma unroll
                for (int gi = 0; gi < 8; gi += 2) { AT_QK_LOAD(a1, gi + 1); AT_QK_MMA(a0, gi); __builtin_amdgcn_sched_barrier(0);
                    if (gi + 2 < 8) AT_QK_LOAD(a0, gi + 2);
                    AT_QK_MMA(a1, gi + 1); __builtin_amdgcn_sched_barrier(0); } }
        }
        STAMP2(lds, 41);
        float mx = acc[0][0];
#pragma unroll
        for (int n = 0; n < 16; ++n) mx = fmaxf(fmaxf(mx, fmaxf(acc[n][0], acc[n][1])), fmaxf(acc[n][2], acc[n][3]));
        mx = fmaxf(mx, __shfl_xor(mx, 16)); mx = fmaxf(mx, __shfl_xor(mx, 32));
        float l = 0.f;
#pragma unroll
        for (int n = 0; n < 16; ++n)
#pragma unroll
            for (int r = 0; r < 4; ++r) { const float pv = __builtin_amdgcn_exp2f(acc[n][r] - mx); acc[n][r] = pv; l += pv; }
        l += __shfl_xor(l, 16); l += __shfl_xor(l, 32);
        const float linv = 1.0f / l;
        bf16x8 pf[8];
#pragma unroll
        for (int s = 0; s < 8; ++s) { v4u w; w.x = pg8::cvt_pk_bf16(acc[2 * s][0], acc[2 * s][1]); w.y = pg8::cvt_pk_bf16(acc[2 * s][2], acc[2 * s][3]);
            w.z = pg8::cvt_pk_bf16(acc[2 * s + 1][0], acc[2 * s + 1][1]); w.w = pg8::cvt_pk_bf16(acc[2 * s + 1][2], acc[2 * s + 1][3]); pf[s] = __builtin_bit_cast(bf16x8, w); }
        STAMP2(lds, 42);
        __builtin_amdgcn_sched_barrier(0);
        f32x4 o[32];
#pragma unroll
        for (int mm = 0; mm < 32; ++mm) o[mm] = (f32x4){0.f, 0.f, 0.f, 0.f};
#pragma unroll
        for (int cc = 0; cc < 4; ++cc) {
            AT_WAIT();
            if (cc < 3) AT_STAGE_V(cc + 1, (cc + 1) & 1);
            const LAS unsigned char* bb = lds + (cc & 1) * 65536 + aoff0; asm volatile("" : "+v"(bb));
#define AT_PV_LOAD(dst, gi) do { _Pragma("unroll") for (int m8 = 0; m8 < 8; ++m8) dst[m8] = *(const LAS bf16x8*)(bb + ((gi) & 3) * 16384 + m8 * 2048 + ((gi) >> 2) * 1024); } while (0)
#define AT_PV_MMA(src, gi) do { _Pragma("unroll") for (int m8 = 0; m8 < 8; ++m8) o[((gi) & 3) * 8 + m8] = __builtin_amdgcn_mfma_f32_16x16x32_bf16(src[m8], pf[2 * cc + ((gi) >> 2)], o[((gi) & 3) * 8 + m8], 0, 0, 0); } while (0)
            { bf16x8 a0[8], a1[8];
                AT_PV_LOAD(a0, 0);
#pragma unroll
                for (int gi = 0; gi < 8; gi += 2) { AT_PV_LOAD(a1, gi + 1); AT_PV_MMA(a0, gi); __builtin_amdgcn_sched_barrier(0);
                    if (gi + 2 < 8) AT_PV_LOAD(a0, gi + 2);
                    AT_PV_MMA(a1, gi + 1); __builtin_amdgcn_sched_barrier(0); } }
        }
        STAMP2(lds, 43);
        bf16* op = obuf + tok * 2048 + h * 512 + 4 * fq;
#pragma unroll
        for (int mm = 0; mm < 32; ++mm) { v2u w; w.x = pg8::cvt_pk_bf16(o[mm][0] * linv, o[mm][1] * linv); w.y = pg8::cvt_pk_bf16(o[mm][2] * linv, o[mm][3] * linv); pg8::st_wt8(op + 16 * mm, w); }
    }
    asm volatile("s_waitcnt vmcnt(0)" ::: "memory"); __syncthreads(); STAMP2(lds, 44);
#undef AT_STAGE_K
#undef AT_QK_LOAD
#undef AT_QK_MMA
#undef AT_PV_LOAD
#undef AT_PV_MMA
#undef AT_STAGE_V
#undef AT_WAIT
}
struct S5Lane { float lbr, lbi; float Br[16], Bi[16]; };
__device__ __forceinline__ void s5_lane_params(int g, int p, S5Lane& L) {
    const float lr = fminf(ka_in(15)[g * 64 + p], -1e-4f), li = ka_in(16)[g * 64 + p], dt = expf(ka_in(17)[g]);
    const float ar = lr * dt, th = li * dt; float sn, cs; sincosf(th, &sn, &cs); const float e = expf(ar), sh = sinf(0.5f * th);
    L.lbr = e * cs; L.lbi = e * sn;
    const float nr = expm1f(ar) * cs - 2.0f * sh * sh, ni = e * sn;
    const float den = 1.0f / (lr * lr + li * li), cr = (nr * lr + ni * li) * den, ci = (ni * lr - nr * li) * den;
#pragma unroll
    for (int c = 0; c < 16; ++c) { const float br = ka_in(18)[(size_t)(g * 64 + p) * 16 + c], bi = ka_in(19)[(size_t)(g * 64 + p) * 16 + c]; L.Br[c] = cr * br - ci * bi; L.Bi[c] = cr * bi + ci * br; }
}
__device__ __forceinline__ void s5_step(const S5Lane& L, const bf16* urow, float& xr, float& xi) {
    const v4u w0 = *(const v4u*)urow, w1 = *(const v4u*)(urow + 8);
    float u[16] = {bflo(w0.x), bfhi(w0.x), bflo(w0.y), bfhi(w0.y), bflo(w0.z), bfhi(w0.z), bflo(w0.w), bfhi(w0.w), bflo(w1.x), bfhi(w1.x), bflo(w1.y), bfhi(w1.y), bflo(w1.z), bfhi(w1.z), bflo(w1.w), bfhi(w1.w)};
    float br = 0.f, bi = 0.f;
#pragma unroll
    for (int c = 0; c < 16; ++c) { br += L.Br[c] * u[c]; bi += L.Bi[c] * u[c]; }
    const float nr = L.lbr * xr - L.lbi * xi + br, ni = L.lbr * xi + L.lbi * xr + bi; xr = nr; xi = ni;
}
__device__ __forceinline__ void s5_pass_a(const bf16* ub, f32x2* st, int wave, int lane) {
    const int gw = blockIdx.x * NWAVES + wave, NGW = gridDim.x * NWAVES;
    for (int task = gw; task < BATCH * 128 * 64; task += NGW) {
        const int seg = task & 63, g = (task >> 6) & 127, b = task >> 13;
        S5Lane L; s5_lane_params(g, lane, L);
        float xr = 0.f, xi = 0.f; const bf16* up = ub + (size_t)(b * SEQ + seg * 64) * 2048 + 16 * g;
#pragma unroll 2
        for (int s = 0; s < 64; ++s) s5_step(L, up + (size_t)s * 2048, xr, xi);
        st[(size_t)task * 64 + lane] = (f32x2){xr, xi};
    }
}
__device__ __forceinline__ void s5_pass_c(LAS unsigned char* lds, const bf16* ub, const f32x2* st, bf16* yb, int wave, int lane) {
    LAS f32x2* Cs = (LAS f32x2*)(lds + wave * 16640);
    LAS f32x2* xs = (LAS f32x2*)(lds + wave * 16640 + 8320);
    const int gw = blockIdx.x * NWAVES + wave, NGW = gridDim.x * NWAVES;
    for (int task = gw; task < BATCH * 128 * 64; task += NGW) {
        const int seg = task & 63, g = (task >> 6) & 127, b = task >> 13;
        S5Lane L; s5_lane_params(g, lane, L);
#pragma unroll
        for (int c = 0; c < 16; ++c) Cs[c * 65 + lane] = (f32x2){ka_in(20)[(size_t)(g * 16 + c) * 64 + lane], ka_in(21)[(size_t)(g * 16 + c) * 64 + lane]};
        float Ar = L.lbr, Ai = L.lbi;
#pragma unroll
        for (int i = 0; i < 6; ++i) { const float nr = Ar * Ar - Ai * Ai, ni = 2.0f * Ar * Ai; Ar = nr; Ai = ni; }
        float xr = 0.f, xi = 0.f; const f32x2* sp = st + (size_t)(task - seg) * 64 + lane;
#pragma unroll 2
        for (int n = 0; n < seg; ++n) { const f32x2 s = sp[(size_t)n * 64]; const float nr = Ar * xr - Ai * xi + s.x, ni = Ar * xi + Ai * xr + s.y; xr = nr; xi = ni; }
        const bf16* up = ub + (size_t)(b * SEQ + seg * 64) * 2048 + 16 * g; bf16* yp = yb + (size_t)(b * SEQ + seg * 64) * 2048 + 16 * g;
        const int t = lane & 15, cq = lane >> 4;
        f32x4 dsk = *(const f32x4*)(ka_in(22) + g * 16 + 4 * cq);
#pragma unroll 1
        for (int blk = 0; blk < 4; ++blk) {
#pragma unroll 2
            for (int s = 0; s < 16; ++s) { s5_step(L, up + (size_t)(blk * 16 + s) * 2048, xr, xi); xs[s * 65 + lane] = (f32x2){xr, xi}; }
            LDS_WAIT();
            float acc[4] = {0.f, 0.f, 0.f, 0.f};
#pragma unroll 4
            for (int p = 0; p < 64; ++p) { const f32x2 x = xs[t * 65 + p];
#pragma unroll
                for (int j = 0; j < 4; ++j) { const f32x2 c = Cs[(4 * cq + j) * 65 + p]; acc[j] += c.x * x.x - c.y * x.y; } }
            const v2u uw = *(const v2u*)(up + (size_t)(blk * 16 + t) * 2048 + 4 * cq);
            const float y0 = gelu_exact(acc[0] + dsk[0] * bflo(uw.x)), y1 = gelu_exact(acc[1] + dsk[1] * bfhi(uw.x)), y2 = gelu_exact(acc[2] + dsk[2] * bflo(uw.y)), y3 = gelu_exact(acc[3] + dsk[3] * bfhi(uw.y));
            v2u ow; ow.x = pk2(y0, y1); ow.y = pk2(y2, y3); *(v2u*)(yp + (size_t)(blk * 16 + t) * 2048 + 4 * cq) = ow;
            LDS_WAIT();
        }
    }
}
__device__ __forceinline__ void s5_setup(LAS unsigned char* lds, int g, int wave, int lane, bf16x8 (&A1)[8], bf16x8 (&CM)[2][4]) {
    LAS f32x2* PW = (LAS f32x2*)(lds); LAS f32x2* BB = (LAS f32x2*)(lds + 8704); LAS f32x2* CC = (LAS f32x2*)(lds + 16896); LAS bf16* KST = (LAS bf16*)(lds + 25088);
    const int tid = wave * 64 + lane, fr = lane & 15, fq = lane >> 4;
        const float ldt = ka_in(17)[g];
        float plr[3], pli[3];
#pragma unroll
        for (int it = 0; it < 3; ++it) { const int idx = tid + NTHREADS * it, p = idx & 63; plr[it] = ka_in(15)[g * 64 + p]; pli[it] = ka_in(16)[g * 64 + p]; }
        float pbr[2], pbi[2], pcr[2], pci[2];
#pragma unroll
        for (int it = 0; it < 2; ++it) { const int idx = tid + NTHREADS * it; pbr[it] = ka_in(18)[(size_t)g * 1024 + idx]; pbi[it] = ka_in(19)[(size_t)g * 1024 + idx]; pcr[it] = ka_in(20)[(size_t)g * 1024 + idx]; pci[it] = ka_in(21)[(size_t)g * 1024 + idx]; }
        float qlr[2], qli[2];
#pragma unroll
        for (int it = 0; it < 2; ++it) { const int p = (tid + NTHREADS * it) >> 4; qlr[it] = ka_in(15)[g * 64 + p]; qli[it] = ka_in(16)[g * 64 + p]; }
        const float dt = expf(ldt);
        __syncthreads();
#pragma unroll
        for (int it = 0; it < 3; ++it) { const int idx = tid + NTHREADS * it; if (idx < 17 * 64) { const int e = idx >> 6;
            const float lr = fminf(plr[it], -1e-4f), li = pli[it]; float sn, cs; sincosf(li * dt * (float)e, &sn, &cs); const float ex = expf(lr * dt * (float)e);
            PW[idx] = (f32x2){ex * cs, ex * sn}; } }
#pragma unroll
        for (int it = 0; it < 2; ++it) { const int idx = tid + NTHREADS * it;
            const float lr = fminf(qlr[it], -1e-4f), li = qli[it]; const float ar = lr * dt, th = li * dt; float sn, cs; sincosf(th, &sn, &cs); const float e = expf(ar), sh = sinf(0.5f * th);
            const float nr = expm1f(ar) * cs - 2.0f * sh * sh, ni = e * sn, den = 1.0f / (lr * lr + li * li), cr = (nr * lr + ni * li) * den, ci = (ni * lr - nr * li) * den;
            BB[idx] = (f32x2){cr * pbr[it] - ci * pbi[it], cr * pbi[it] + ci * pbr[it]};
            CC[idx] = (f32x2){pcr[it], pci[it]}; }
        __syncthreads();
        { const int ri = wave >> 2, p = 16 * (wave & 3) + fr; f32x2 bb[8];
#pragma unroll
            for (int j = 0; j < 8; ++j) bb[j] = BB[p * 16 + 8 * (fq & 1) + j];
#pragma unroll
            for (int ks = 0; ks < 8; ++ks) { const int s = 2 * ks + (fq >> 1); const f32x2 pw = PW[(15 - s) * 64 + p]; float v[8];
#pragma unroll
                for (int j = 0; j < 8; ++j) v[j] = ri ? (pw.x * bb[j].y + pw.y * bb[j].x) : (pw.x * bb[j].x - pw.y * bb[j].y);
                v4u w; w.x = pk2(v[0], v[1]); w.y = pk2(v[2], v[3]); w.z = pk2(v[4], v[5]); w.w = pk2(v[6], v[7]); A1[ks] = __builtin_bit_cast(bf16x8, w); }
            __builtin_amdgcn_sched_barrier(0); }
        const int t0 = wave, t1 = 15 - wave;
        { f32x4 kacc[2] = {(f32x4){0.f, 0.f, 0.f, 0.f}, (f32x4){0.f, 0.f, 0.f, 0.f}};
#pragma unroll
            for (int h = 0; h < 2; ++h) { f32x2 cc[8], pa[8], pb[8];
#pragma unroll
                for (int j = 0; j < 8; ++j) { const int p = 32 * h + 8 * fq + j; cc[j] = CC[fr * 64 + p]; pa[j] = PW[(t0 + 1) * 64 + p]; pb[j] = PW[(t1 + 1) * 64 + p]; }
                float vr[8], vi[8];
#pragma unroll
                for (int j = 0; j < 8; ++j) { vr[j] = cc[j].x * pa[j].x - cc[j].y * pa[j].y; vi[j] = -(cc[j].x * pa[j].y + cc[j].y * pa[j].x); }
                { v4u w; w.x = pk2(vr[0], vr[1]); w.y = pk2(vr[2], vr[3]); w.z = pk2(vr[4], vr[5]); w.w = pk2(vr[6], vr[7]); CM[0][h] = __builtin_bit_cast(bf16x8, w);
                  w.x = pk2(vi[0], vi[1]); w.y = pk2(vi[2], vi[3]); w.z = pk2(vi[4], vi[5]); w.w = pk2(vi[6], vi[7]); CM[0][2 + h] = __builtin_bit_cast(bf16x8, w); }
#pragma unroll
                for (int j = 0; j < 8; ++j) { vr[j] = cc[j].x * pb[j].x - cc[j].y * pb[j].y; vi[j] = -(cc[j].x * pb[j].y + cc[j].y * pb[j].x); }
                { v4u w; w.x = pk2(vr[0], vr[1]); w.y = pk2(vr[2], vr[3]); w.z = pk2(vr[4], vr[5]); w.w = pk2(vr[6], vr[7]); CM[1][h] = __builtin_bit_cast(bf16x8, w);
                  w.x = pk2(vi[0], vi[1]); w.y = pk2(vi[2], vi[3]); w.z = pk2(vi[4], vi[5]); w.w = pk2(vi[6], vi[7]); CM[1][2 + h] = __builtin_bit_cast(bf16x8, w); }
                bf16x8 ctr, cti;
                { v4u w; w.x = pk2(cc[0].x, cc[1].x); w.y = pk2(cc[2].x, cc[3].x); w.z = pk2(cc[4].x, cc[5].x); w.w = pk2(cc[6].x, cc[7].x); ctr = __builtin_bit_cast(bf16x8, w);
                  w.x = pk2(-cc[0].y, -cc[1].y); w.y = pk2(-cc[2].y, -cc[3].y); w.z = pk2(-cc[4].y, -cc[5].y); w.w = pk2(-cc[6].y, -cc[7].y); cti = __builtin_bit_cast(bf16x8, w); }
                f32x2 bq[8];
#pragma unroll
                for (int j = 0; j < 8; ++j) bq[j] = BB[(32 * h + 8 * fq + j) * 16 + fr];
#pragma unroll
                for (int si = 0; si < 2; ++si) { const int s = 2 * wave + si;
#pragma unroll
                    for (int j = 0; j < 8; ++j) { const f32x2 pw = PW[(15 - s) * 64 + 32 * h + 8 * fq + j]; vr[j] = pw.x * bq[j].x - pw.y * bq[j].y; vi[j] = pw.x * bq[j].y + pw.y * bq[j].x; }
                    v4u w; w.x = pk2(vr[0], vr[1]); w.y = pk2(vr[2], vr[3]); w.z = pk2(vr[4], vr[5]); w.w = pk2(vr[6], vr[7]);
                    kacc[si] = __builtin_amdgcn_mfma_f32_16x16x32_bf16(__builtin_bit_cast(bf16x8, w), ctr, kacc[si], 0, 0, 0);
                    w.x = pk2(vi[0], vi[1]); w.y = pk2(vi[2], vi[3]); w.z = pk2(vi[4], vi[5]); w.w = pk2(vi[6], vi[7]);
                    kacc[si] = __builtin_amdgcn_mfma_f32_16x16x32_bf16(__builtin_bit_cast(bf16x8, w), cti, kacc[si], 0, 0, 0); }
                __builtin_amdgcn_sched_barrier(0); }
#pragma unroll
            for (int si = 0; si < 2; ++si) { const int s = 2 * wave + si; v2u kw; kw.x = pk2(kacc[si][0], kacc[si][1]); kw.y = pk2(kacc[si][2], kacc[si][3]);
                *(LAS v2u*)(KST + ((15 - s) * 16 + fr) * 16 + 4 * fq) = kw; } }
}
constexpr size_t S5TAB_BYTES = 147456;
__device__ __forceinline__ void s5_tables_to_global(LAS unsigned char* lds, int g, unsigned char* gtab, int wave, int lane) {
    bf16x8 A1[8], CM[2][4];
    __syncthreads();
    s5_setup(lds, g, wave, lane, A1, CM);
    unsigned char* t = gtab + (size_t)g * S5TAB_BYTES; v4u* fw = (v4u*)t + (size_t)wave * 16 * 64 + lane;
#pragma unroll
    for (int k = 0; k < 8; ++k) fw[k * 64] = __builtin_bit_cast(v4u, A1[k]);
#pragma unroll
    for (int k = 0; k < 8; ++k) fw[(8 + k) * 64] = __builtin_bit_cast(v4u, CM[k >> 2][k & 3]);
    __syncthreads();
    const int tid = wave * 64 + lane;
    ((v4u*)(t + 131072))[tid] = ((const LAS v4u*)(lds + 25088))[tid];
    if (tid < 64) ((f32x2*)(t + 139264))[tid] = ((const LAS f32x2*)lds)[16 * 64 + tid];
}
__device__ __forceinline__ void s5_mfma(LAS unsigned char* lds, const bf16* ub, bf16* yb, const unsigned char* gtab, int wave, int lane) {
    LAS f32x2* PW = (LAS f32x2*)(lds);
    LAS f32x2* BB = (LAS f32x2*)(lds + 8704);
    LAS f32x2* CC = (LAS f32x2*)(lds + 16896);
    LAS bf16* KST = (LAS bf16*)(lds + 25088);
    LAS unsigned char* UI = lds + 33280;
    LAS float* SL = (LAS float*)(lds + 66048);
    LAS bf16* XP = (LAS bf16*)(lds + 99840);
    const int tid = wave * 64 + lane, fr = lane & 15, fq = lane >> 4;
#ifndef S5_LOOP_REPS
#define S5_LOOP_REPS 1
#endif
    for (int unit = blockIdx.x; unit < 256; unit += gridDim.x) {
        const int b = unit >> 7, g = unit & 127;
        const bf16* usrc = ub + (size_t)(b * SEQ) * 2048 + 16 * g + (size_t)(tid >> 1) * 2048 + 8 * (tid & 1);
        v4u upre[4];
#pragma unroll
        for (int i = 0; i < 4; ++i) upre[i] = NTL((const v4u*)(usrc + (size_t)(256 * i) * 2048));
#if defined(S5_PRETAB)
        const f32x4 dsk = *(const f32x4*)(ka_in(22) + g * 16 + 4 * fq);
        bf16x8 A1[8], CM[2][4];
        { const unsigned char* t = gtab + (size_t)g * S5TAB_BYTES; const v4u* fw = (const v4u*)t + (size_t)wave * 16 * 64 + lane;
#pragma unroll
            for (int k = 0; k < 8; ++k) A1[k] = __builtin_bit_cast(bf16x8, fw[k * 64]);
#pragma unroll
            for (int k = 0; k < 8; ++k) CM[k >> 2][k & 3] = __builtin_bit_cast(bf16x8, fw[(8 + k) * 64]);
            const v4u kw = ((const v4u*)(t + 131072))[tid]; const f32x2 a16v = ((const f32x2*)(t + 139264))[lane];
            __syncthreads();
            ((LAS v4u*)(lds + 25088))[tid] = kw; if (wave == 0) PW[16 * 64 + lane] = a16v; }
        const int t0 = wave, t1 = 15 - wave;
#else
        const f32x4 dsk = *(const f32x4*)(ka_in(22) + g * 16 + 4 * fq);
        bf16x8 A1[8], CM[2][4];
        s5_setup(lds, g, wave, lane, A1, CM);
        const int t0 = wave, t1 = 15 - wave;
#endif
#pragma unroll 1
        for (int rep = 0; rep < S5_LOOP_REPS; ++rep) {
        float Xr = 0.f, Xi = 0.f;
#pragma unroll 1
        for (int q = 0; q < 4; ++q) {
            __syncthreads();
#pragma unroll
            for (int i = 0; i < 4; ++i) { const int piece = tid + NTHREADS * i, tok = piece >> 1, half = piece & 1;
                *(LAS v4u*)(UI + ((((tok & 15) * 64 + (tok >> 4)) * 2 + half) * 16)) = upre[i]; }
            { const int qn = (q + 1) & 3;
#pragma unroll
                for (int i = 0; i < 4; ++i) upre[i] = NTL((const v4u*)(usrc + (size_t)(qn * 1024 + 256 * i) * 2048)); }
            __syncthreads();
#pragma unroll 1
            for (int nf = 0; nf < 4; ++nf) { f32x4 acc = (f32x4){0.f, 0.f, 0.f, 0.f};
#pragma unroll
                for (int ks = 0; ks < 8; ++ks) { const bf16x8 bfr = *(const LAS bf16x8*)(UI + ((((2 * ks + (fq >> 1)) * 64 + 16 * nf + fr) * 2 + (fq & 1)) * 16));
                    acc = __builtin_amdgcn_mfma_f32_16x16x32_bf16(A1[ks], bfr, acc, 0, 0, 0); }
                *(LAS f32x4*)(SL + (16 * nf + fr) * 132 + 16 * wave + 4 * fq) = acc; }
            __syncthreads();
            if (wave == 0) { const f32x2 a16 = PW[16 * 64 + lane];
#pragma unroll 1
                for (int nb = 0; nb < 64; nb += 16) { float sr[16], si[16];
#pragma unroll
                    for (int n = 0; n < 16; ++n) { sr[n] = SL[(nb + n) * 132 + lane]; si[n] = SL[(nb + n) * 132 + 64 + lane]; }
#pragma unroll
                    for (int n = 0; n < 16; ++n) { XP[(nb + n) * 136 + lane] = (bf16)f2bf(Xr); XP[(nb + n) * 136 + 64 + lane] = (bf16)f2bf(Xi);
                        const float nr = a16.x * Xr - a16.y * Xi + sr[n], ni = a16.x * Xi + a16.y * Xr + si[n]; Xr = nr; Xi = ni; } } }
            __syncthreads();
#pragma unroll 1
            for (int nf = 0; nf < 4; ++nf) { f32x4 acc0 = (f32x4){0.f, 0.f, 0.f, 0.f}, acc1 = acc0;
#pragma unroll
                for (int ks = 0; ks < 8; ++ks) { if (2 * ks <= t1 || 2 * ks <= t0) {
                    const int s = 2 * ks + (fq >> 1);
                    const bf16x8 bfr = *(const LAS bf16x8*)(UI + (((s * 64 + 16 * nf + fr) * 2 + (fq & 1)) * 16));
                    if (2 * ks <= t0) { bf16x8 tf = (bf16x8){0, 0, 0, 0, 0, 0, 0, 0}; if (s <= t0) tf = *(const LAS bf16x8*)(KST + ((t0 - s) * 16 + fr) * 16 + 8 * (fq & 1)); acc0 = __builtin_amdgcn_mfma_f32_16x16x32_bf16(tf, bfr, acc0, 0, 0, 0); }
                    if (2 * ks <= t1) { bf16x8 tf = (bf16x8){0, 0, 0, 0, 0, 0, 0, 0}; if (s <= t1) tf = *(const LAS bf16x8*)(KST + ((t1 - s) * 16 + fr) * 16 + 8 * (fq & 1)); acc1 = __builtin_amdgcn_mfma_f32_16x16x32_bf16(tf, bfr, acc1, 0, 0, 0); } } }
#pragma unroll
                for (int ks = 0; ks < 4; ++ks) { const bf16x8 xf = *(const LAS bf16x8*)(XP + (16 * nf + fr) * 136 + 32 * ks + 8 * fq);
                    acc0 = __builtin_amdgcn_mfma_f32_16x16x32_bf16(CM[0][ks], xf, acc0, 0, 0, 0); acc1 = __builtin_amdgcn_mfma_f32_16x16x32_bf16(CM[1][ks], xf, acc1, 0, 0, 0); }
#pragma unroll
                for (int ti = 0; ti < 2; ++ti) { const int t = ti ? t1 : t0; const f32x4 a = ti ? acc1 : acc0; const int n = 16 * nf + fr;
                    const v2u uw = *(const LAS v2u*)(UI + (((t * 64 + n) * 2 + (fq >> 1)) * 16) + 8 * (fq & 1));
                    const pg8::f32x2 g0 = pg8::gelu_pk((pg8::f32x2){a[0] + dsk[0] * bflo(uw.x), a[1] + dsk[1] * bfhi(uw.x)}), g1 = pg8::gelu_pk((pg8::f32x2){a[2] + dsk[2] * bflo(uw.y), a[3] + dsk[3] * bfhi(uw.y)});
                    v2u ow; ow.x = pg8::cvt_pk_bf16(g0.x, g0.y); ow.y = pg8::cvt_pk_bf16(g1.x, g1.y);
                    pg8::st_wt8(yb + (size_t)(b * SEQ + q * 1024 + 16 * n + t) * 2048 + 16 * g + 4 * fq, ow); } }
        }
        }
    }
    __syncthreads();
}
#ifndef EN
#define EN(k) 1
#endif
template <int PH> __device__ __forceinline__ void run_phase(unsigned char* ws, float* X, LAS unsigned char* lds, int wave, int lane) {
    const int G = gridDim.x, bx = blockIdx.x;
    bf16* XB = (bf16*)(ws + WS_XB); float* SSQ = (float*)(ws + WS_SSQ);
    bf16* R0 = (bf16*)(ws + WS_R);
    constexpr int layer = (PH >= 10) ? 1 : 0;
    if constexpr (!EN(PH)) { return; }
    else if constexpr (PH == 0) p0_prologue(ws, lds, wave, lane);
#if defined(MERGE12)
    else if constexpr (PH == 1) {
        struct OneRound { pg8::StaticOrder so; int r;
            __device__ __forceinline__ bool next(int i, pg8::Unit& u) const { return i == 0 ? so.next(r, u) : false; }
            __device__ __forceinline__ void a_ready(const pg8::Unit&) const {}
            __device__ __forceinline__ void done(const pg8::Unit&) const {} };
        LAS float* scr = (LAS float*)(lds + wave * 16896);
        if (bx < 64) { const int i = bx >> 5;
            pg8::Gemm g{(const pg8::bf16_t*)(ws + WS_MEMB), (const pg8::bf16_t*)(ws + WS_W_KV + (size_t)i * 16 * MiB), MROWS, 4096, 2048}; pg8::StaticOrder S; S.init(MROWS, 4096, 32, bx & 31);
            pg8::EpiKV E{(pg8::bf16_t*)(ws + WS_KB + (size_t)i * 2 * MiB), (pg8::bf16_t*)(ws + WS_VB + (size_t)i * 2 * MiB), (pg8::bf16_t*)(ws + WS_VTB + (size_t)i * 2 * MiB), (const float*)(ws + WS_SSQM)};
            pg8::gemm_phase<pg8::EpiKV, pg8::StaticOrder, PG8_ALIGNV, PG8_SP2V>(lds, g, S, E, wave, lane); }
        else if ((bx & 1) == 0) { conv_run<1>(ws, scr, (bx - 64) * NWAVES + wave, (G - 64) * NWAVES, 24576, lane); asm volatile("s_waitcnt vmcnt(0)" ::: "memory"); __syncthreads(); }
        pg8::Gemm g{XB, (const pg8::bf16_t*)(ws + WS_W_AIN), M, 4096, 2048};
        pg8::EpiAct<1, true> E{R0, 4096, ka_in(8), SSQ, 32, 1.0f, (float*)(ws + WS_VST), 8, (LAS float*)(lds + 131072)};
#pragma unroll
        for (int r = 0; r < 2; ++r) { OneRound S; S.so.init(M, 4096, G, bx); S.r = r;
            pg8::gemm_phase<pg8::EpiAct<1, true>, OneRound, PG8_ALIGNV, PG8_SP2V>(lds, g, S, E, wave, lane);
            if (r == 0 && bx >= 64 && (bx & 1) == 1) { conv_run<1>(ws, scr, (bx - 64) * NWAVES + wave, (G - 64) * NWAVES, 24576, lane); asm volatile("s_waitcnt vmcnt(0)" ::: "memory"); __syncthreads(); } }
#if defined(S5_PRETAB)
        if (bx < 64) { s5_tables_to_global(lds, 2 * bx, ws + WS_S5TAB, wave, lane); s5_tables_to_global(lds, 2 * bx + 1, ws + WS_S5TAB, wave, lane); }
#endif
    }
#else
    else if constexpr (PH == 1) {
        if (bx < 64) { const int i = bx >> 5;
            pg8::Gemm g{(const pg8::bf16_t*)(ws + WS_MEMB), (const pg8::bf16_t*)(ws + WS_W_KV + (size_t)i * 16 * MiB), MROWS, 4096, 2048}; pg8::StaticOrder S; S.init(MROWS, 4096, 32, bx & 31);
            pg8::EpiKV E{(pg8::bf16_t*)(ws + WS_KB + (size_t)i * 2 * MiB), (pg8::bf16_t*)(ws + WS_VB + (size_t)i * 2 * MiB), (pg8::bf16_t*)(ws + WS_VTB + (size_t)i * 2 * MiB), (const float*)(ws + WS_SSQM)};
            pg8::gemm_phase<pg8::EpiKV, pg8::StaticOrder, PG8_ALIGNV, PG8_SP2V>(lds, g, S, E, wave, lane); }
        p1_convert(ws, lds, wave, lane);
    }
#endif
#if defined(MERGE12)
    else if constexpr (PH == 2) { }
#else
    else if constexpr (PH == 2) {
        pg8::Gemm g{XB, (const pg8::bf16_t*)(ws + WS_W_AIN), M, 4096, 2048}; pg8::StaticOrder S; S.init(M, 4096, G, bx);
        pg8::EpiAct<1, true> E{R0, 4096, ka_in(8), SSQ, 32, 1.0f, (float*)(ws + WS_VST), 8, (LAS float*)(lds + 131072)};
        {
#if defined(BG_CONV)
            const bool bgpre = (blockIdx.x & 1) != 0;
            if (bgpre) { bg_convert<PH>(ws, lds, wave, lane); __syncthreads(); }
#else
            const bool bgpre = true;
#endif
            pg8::gemm_phase<pg8::EpiAct<1, true>, pg8::StaticOrder, PG8_ALIGNV, PG8_SP2V>(lds, g, S, E, wave, lane);
            if (!bgpre) bg_convert<PH>(ws, lds, wave, lane); }
    }
#endif
    else if constexpr (PH == 3) {
#if defined(GATING_SIMPLE)
        gating_simple(lds, R0, (const float*)(ws + WS_VST), ka_in(9), ka_in(10), ka_in(11), ka_in(12), R0 + (size_t)M * 4096, wave * 64 + lane);
#else
        gating_mfma(lds, R0, (const float*)(ws + WS_VST), ka_in(9), ka_in(10), ka_in(11), ka_in(12), R0 + (size_t)M * 4096, wave, lane);
#endif
    }
    else if constexpr (PH == 4 || PH == 7 || PH == 9 || PH == 16 || PH == 18) {
        const pg8::bf16_t* A; const pg8::bf16_t* W; int K = 2048;
        if constexpr (PH == 4) { A = R0 + (size_t)M * 4096; W = (const pg8::bf16_t*)(ws + WS_W_AOUT); }
        else if constexpr (PH == 7 || PH == 16) { A = R0 + (size_t)M * 2048; W = (const pg8::bf16_t*)(ws + WS_W_O + (size_t)layer * 8 * MiB); }
        else { A = R0; W = (const pg8::bf16_t*)(ws + WS_W_DN + (size_t)layer * 32 * MiB); K = 8192; }
        pg8::Gemm g{A, W, M, 2048, K}; pg8::StaticOrder S; S.init(M, 2048, G, bx);
        pg8::EpiRes E{XB, SSQ};
        {
#if defined(BG_CONV)
            const bool bgpre = (blockIdx.x & 1) != 0;
            if (bgpre) { bg_convert<PH>(ws, lds, wave, lane); __syncthreads(); }
#else
            const bool bgpre = true;
#endif
            pg8::gemm_phase<pg8::EpiRes, pg8::StaticOrder, PG8_ALIGNV, PG8_SP2V>(lds, g, S, E, wave, lane);
            if (!bgpre) bg_convert<PH>(ws, lds, wave, lane); }
    } else if constexpr (PH == 5 || PH == 14 || PH == 10) {
        const pg8::bf16_t* W = (PH == 10) ? (const pg8::bf16_t*)(ws + WS_W_BIN) : (const pg8::bf16_t*)(ws + WS_W_Q + (size_t)layer * 8 * MiB);
        pg8::Gemm g{XB, W, M, 2048, 2048}; pg8::StaticOrder S; S.init(M, 2048, G, bx);
        pg8::EpiAct<0, false> E{R0, 2048, nullptr, SSQ, (PH == 14) ? 64 : 32, (PH == 10) ? 1.0f : 0.044194173824159216f * 1.4426950408889634f, nullptr, 0, (LAS float*)(lds + 131072)};
        {
#if defined(BG_CONV)
            const bool bgpre = (blockIdx.x & 1) != 0;
            if (bgpre) { bg_convert<PH>(ws, lds, wave, lane); __syncthreads(); }
#else
            const bool bgpre = true;
#endif
            pg8::gemm_phase<pg8::EpiAct<0, false>, pg8::StaticOrder, PG8_ALIGNV, PG8_SP2V>(lds, g, S, E, wave, lane);
            if (!bgpre) bg_convert<PH>(ws, lds, wave, lane); }
    } else if constexpr (PH == 6 || PH == 15) {
#if defined(ATTN_SIMPLE)
        attn_simple(lds, R0, (const bf16*)(ws + WS_KB + (size_t)layer * 2 * MiB), (const bf16*)(ws + WS_VB + (size_t)layer * 2 * MiB), R0 + (size_t)M * 2048, wave, lane);
#else
        attn_mfma(lds, R0, (const bf16*)(ws + WS_KB + (size_t)layer * 2 * MiB), (const bf16*)(ws + WS_VTB + (size_t)layer * 2 * MiB), R0 + (size_t)M * 2048, wave, lane);
#endif
    }
    else if constexpr (PH == 8 || PH == 17) {
        pg8::Gemm g{XB, (const pg8::bf16_t*)(ws + WS_W_UP + (size_t)layer * 32 * MiB), M, FF, 2048}; pg8::StaticOrder S; S.init(M, FF, G, bx);
        pg8::EpiAct<2, false> E{R0, FF, nullptr, SSQ, 32, 1.0f, nullptr, 0, (LAS float*)(lds + 131072)};
        {
#if defined(BG_CONV)
            const bool bgpre = (blockIdx.x & 1) != 0;
            if (bgpre) { bg_convert<PH>(ws, lds, wave, lane); __syncthreads(); }
#else
            const bool bgpre = true;
#endif
            pg8::gemm_phase<pg8::EpiAct<2, false>, pg8::StaticOrder, PG8_ALIGNV, PG8_SP2V>(lds, g, S, E, wave, lane);
            if (!bgpre) bg_convert<PH>(ws, lds, wave, lane); }
    } else if constexpr (PH == 11) {
#if defined(S5_SIMPLE)
        s5_pass_a(R0, (f32x2*)(ws + WS_S5ST), wave, lane);
#endif
    } else if constexpr (PH == 12) {
#if defined(S5_SIMPLE)
        s5_pass_c(lds, R0, (const f32x2*)(ws + WS_S5ST), R0 + (size_t)M * 2048, wave, lane);
#else
        s5_mfma(lds, R0, R0 + (size_t)M * 2048, ws + WS_S5TAB, wave, lane);
#endif
    }
    else if constexpr (PH == 13) {
        pg8::Gemm g{R0 + (size_t)M * 2048, (const pg8::bf16_t*)(ws + WS_W_BOUT), M, 4096, 2048}; pg8::StaticOrder S; S.init(M, 4096, G, bx);
        pg8::EpiGlu E{XB, SSQ, ka_in(24)};
        pg8::gemm_phase<pg8::EpiGlu, pg8::StaticOrder, PG8_ALIGNV, PG8_SP2V>(lds, g, S, E, wave, lane);
    } else if constexpr (PH == 19) final_norm(XB, SSQ, ka_in(6), X, wave, lane);
}
__device__ __forceinline__ int lane_id() { int l; asm volatile("v_mbcnt_lo_u32_b32 %0, -1, 0\n\tv_mbcnt_hi_u32_b32 %0, -1, %0" : "=v"(l)); return l; }

#define XB_TMO      128
#define XB_XCNT(j)  (256  + 64 * (j))
#define XB_XSUB(j)  (1280 + 64 * (j))
#define XB_XGEN(j)  (2304 + 64 * (j))
#define XB_TOP      3328
#define XB_TOPGEN   3392
#define XCD_BAR_WORDS 3456
#define XB_SPIN_CAP (1u << 22)
__device__ __forceinline__ unsigned xb_ld(unsigned* p)              { return __hip_atomic_load(p, __ATOMIC_RELAXED, __HIP_MEMORY_SCOPE_AGENT); }
__device__ __forceinline__ unsigned xb_add(unsigned* p, unsigned v) { return __hip_atomic_fetch_add(p, v, __ATOMIC_RELAXED, __HIP_MEMORY_SCOPE_AGENT); }
__device__ __forceinline__ unsigned xb_xcc_id() { return (unsigned)__builtin_amdgcn_s_getreg((3 << 11) | 20) & 0xFu; }
#define XB_SPIN(cond, bar) do { unsigned _sp = 0; while (cond) { __builtin_amdgcn_s_sleep(1); \
    if ((++_sp & 255u) == 0u) { if (xb_ld(&(bar)[XB_TMO])) break; if (_sp > XB_SPIN_CAP) { atomicAdd(&(bar)[XB_TMO], 1u); break; } } } } while (0)
__device__ __forceinline__ void xcd_barrier_complete(unsigned* bar, unsigned x, unsigned& nloc, unsigned& nx) {
    const unsigned G = gridDim.x * gridDim.y * gridDim.z;
    unsigned sum, cnt, mine, sp = 0u;
    for (;;) {
        sum = 0u; cnt = 0u; mine = 0u;
#pragma unroll
        for (unsigned j = 0; j < 16; ++j) { const unsigned c = xb_ld(&bar[XB_XCNT(j)]); sum += c; cnt += (c > 0u) ? 1u : 0u; mine = (j == x) ? c : mine; }
        if (sum == G) break;
        __builtin_amdgcn_s_sleep(1);
        if ((++sp & 255u) == 0u) { if (xb_ld(&bar[XB_TMO])) break; if (sp > XB_SPIN_CAP) { atomicAdd(&bar[XB_TMO], 1u); break; } }
    }
    nloc = mine > 0u ? mine : 1u; nx = cnt > 0u ? cnt : 1u;
}
__device__ __forceinline__ void xcd_barrier(unsigned* bar, volatile LAS unsigned* st, bool is_t0) {
    asm volatile("s_waitcnt vmcnt(0)" ::: "memory");
    __syncthreads();
    if (is_t0) {
        __builtin_amdgcn_s_waitcnt(0);
        const unsigned x = xb_xcc_id();
        unsigned nloc = st[0], nx = st[1];
        if (nloc == 0u) { xcd_barrier_complete(bar, x, nloc, nx); st[0] = nloc; st[1] = nx; }
        const unsigned old = xb_add(&bar[XB_XSUB(x)], 1u);
        const unsigned gen = old / nloc;
        if (old + 1u == (gen + 1u) * nloc) {
            __builtin_amdgcn_fence(__ATOMIC_RELEASE, "agent");
            asm volatile("s_waitcnt vmcnt(0)" ::: "memory");
            const unsigned og = xb_add(&bar[XB_TOP], 1u);
            const unsigned tg = og / nx;
            if (og + 1u == (tg + 1u) * nx) xb_add(&bar[XB_TOPGEN], 1u);
            else XB_SPIN(xb_ld(&bar[XB_TOPGEN]) == tg, bar);
            __builtin_amdgcn_fence(__ATOMIC_ACQUIRE, "agent");
            xb_add(&bar[XB_XGEN(x)], 1u);
            asm volatile("s_waitcnt vmcnt(0)" ::: "memory");
        } else {
            XB_SPIN(xb_ld(&bar[XB_XGEN(x)]) == gen, bar);
            __builtin_amdgcn_fence(__ATOMIC_ACQUIRE, "agent");
            asm volatile("s_waitcnt vmcnt(0)" ::: "memory");
        }
    }
    __syncthreads();
}

__global__ void __launch_bounds__(NTHREADS, 2) trunk_fwd(Args args) {
    extern __shared__ __attribute__((aligned(16))) unsigned char lds_raw[];
    LAS unsigned char* lds = (LAS unsigned char*)lds_raw;
    const int wave = __builtin_amdgcn_readfirstlane((int)threadIdx.x >> 6);
    const int lo = args.ph_lo, hi = args.ph_hi;
    unsigned* bar = (unsigned*)args.ws + 4096;
    volatile LAS unsigned* st = (volatile LAS unsigned*)(lds + LDS_BYTES - 512);
#if MK_N_LAUNCHES == 1
    { const int l0 = lane_id(); if (wave == 0 && l0 < 2) st[l0] = 0u; __syncthreads(); if (wave == 0 && l0 == 0) (void)xb_add(&bar[XB_XCNT(xb_xcc_id())], 1u); }
#if defined(USE_CG_SYNC)
#define GRID_BAR(k) do { if ((k) == 1) cg::this_grid().sync(); else xcd_barrier(bar, st, wave == 0 && lane_id() == 0); } while (0)
#else
#define GRID_BAR(k) do { xcd_barrier(bar, st, wave == 0 && lane_id() == 0); } while (0)
#endif
#else
#define GRID_BAR(k) do { } while (0)
#endif
#ifndef DUP_PH
#define DUP_PH -1
#endif
#if defined(PROBE_GEMM)
#if PROBE_GEMM == 3
typedef pg8::StaticOrder ProbeOrder;
#else
struct ProbeOrder { int c;
    __device__ __forceinline__ void init(int, int, int, int c_) { c = c_; }
    __device__ __forceinline__ bool next(int i, pg8::Unit& u) const { if (i >= 4) return false;
#if PROBE_GEMM == 1
        u.pm = 0; u.pn = 0;
#else
        u.pm = c >> 3; u.pn = c & 7;
#endif
        return true; }
    __device__ __forceinline__ void a_ready(const pg8::Unit&) const {}
    __device__ __forceinline__ void done(const pg8::Unit&) const {} };
#endif
#endif
#if defined(STAMP_SEL)
#define STAMP(k) do { if (blockIdx.x == 0 && wave == 0 && lane_id() == 0) st[4 + (k)] = (unsigned)__builtin_amdgcn_s_memrealtime(); } while (0)
#else
#define STAMP(k) do { } while (0)
#endif
#define PHASE(k) if (lo <= (k) && (k) < hi) { if ((k) > lo) GRID_BAR(k); STAMP(k); run_phase<k>(args.ws, args.out, lds, wave, lane_id()); STAMP(50 + (k)); if ((k) == DUP_PH) { GRID_BAR(2); run_phase<k>(args.ws, args.out, lds, wave, lane_id()); } }
#if defined(PROBE_XCC)
    { unsigned* tab = (unsigned*)(args.ws + WS_S5ST); const int l0 = lane_id();
      if (wave == 0 && l0 == 0) __hip_atomic_store(tab + blockIdx.x, xb_xcc_id(), __ATOMIC_RELAXED, __HIP_MEMORY_SCOPE_AGENT);
      GRID_BAR(2);
      if (blockIdx.x == 0 && wave == 0 && l0 == 0) { int bad = 0;
          for (int b = 0; b < (int)gridDim.x; ++b) { const unsigned x = __hip_atomic_load(tab + b, __ATOMIC_RELAXED, __HIP_MEMORY_SCOPE_AGENT), x0 = __hip_atomic_load(tab + (b & 7), __ATOMIC_RELAXED, __HIP_MEMORY_SCOPE_AGENT); if (x != x0) ++bad; }
          for (int a = 0; a < 8; ++a) for (int c = a + 1; c < 8; ++c) if (__hip_atomic_load(tab + a, __ATOMIC_RELAXED, __HIP_MEMORY_SCOPE_AGENT) == __hip_atomic_load(tab + c, __ATOMIC_RELAXED, __HIP_MEMORY_SCOPE_AGENT)) ++bad;
          const unsigned d = bad ? 50000u : 0u; const unsigned t0 = (unsigned)__builtin_amdgcn_s_memrealtime(); while ((unsigned)__builtin_amdgcn_s_memrealtime() - t0 < d) __builtin_amdgcn_s_sleep(8); }
      GRID_BAR(2); }
#endif
#if defined(PROBE_WRITE)
    { const int lane = lane_id(); const int gw = blockIdx.x * NWAVES + wave, NGW = gridDim.x * NWAVES;
      for (int it = gw; it < 30720; it += NGW) { ConvSel s = conv_select(args.ws, __builtin_amdgcn_readfirstlane(it));
#if PROBE_WRITE == 1
          const int nblk = s.N >> 6, kb = s.item / nblk, nb = s.item - kb * nblk, k0 = 64 * kb, n0 = 64 * nb; const int c = lane & 7;
#pragma unroll
          for (int j = 0; j < 8; ++j) { const int n = (lane >> 3) + 8 * j; const int nr = s.mode ? glu_rowmap(n0 + n) : (n0 + n); *(v4u*)(s.WT + (size_t)nr * s.K + k0 + 8 * c) = (v4u){0u, 0u, 0u, 0u}; }
#else
          bf16* dst = s.WT + (size_t)s.item * 4096;
#pragma unroll
          for (int j = 0; j < 8; ++j) *(v4u*)(dst + (j * 64 + lane) * 8) = (v4u){0u, 0u, 0u, 0u};
#endif
      }
      GRID_BAR(2); }
#endif
    PHASE(0) PHASE(1)
#if !defined(MERGE12)
    PHASE(2)
#endif
    PHASE(3) PHASE(4) PHASE(5) PHASE(6) PHASE(7) PHASE(8) PHASE(9)
#if defined(PROBE_GEMM)
    { GRID_BAR(2); const int lane = lane_id(); unsigned char* ws = args.ws; bf16* R0 = (bf16*)(ws + WS_R);
      pg8::Gemm g{(bf16*)(ws + WS_XB), (const pg8::bf16_t*)(ws + WS_W_UP), M, FF, 2048}; ProbeOrder S; S.init(M, FF, gridDim.x, blockIdx.x);
      pg8::EpiAct<2, false> E{R0, FF, nullptr, (float*)(ws + WS_SSQ), 32, 1.0f, nullptr, 0};
      pg8::gemm_phase<pg8::EpiAct<2, false>, ProbeOrder, true, true>(lds, g, S, E, wave, lane); }
#endif
#if defined(PROBE_READ)
    { GRID_BAR(2); const int lane = lane_id(); const int gw = blockIdx.x * NWAVES + wave, NGW = gridDim.x * NWAVES; f32x4 accv = (f32x4){0.f, 0.f, 0.f, 0.f};
      for (int it = gw; it < 30720; it += NGW) { f32x4 v[16]; ConvSel s = conv_select(args.ws, __builtin_amdgcn_readfirstlane(it)); f32x4 gq_[2]; conv_load(s, v, gq_, lane);
#pragma unroll
          for (int i = 0; i < 16; ++i) accv += v[i]; }
      if (accv[0] + accv[1] + accv[2] + accv[3] == 12345.678f) ((float*)(args.ws + WS_S5ST))[gw * 64 + lane] = accv[0]; }
#endif
#if defined(EXTRA_BARS)
    for (int eb = 0; eb < EXTRA_BARS; ++eb) GRID_BAR(2);
#endif
    PHASE(10)
#if defined(S5_SIMPLE)
    PHASE(11)
#endif
    PHASE(12) PHASE(13) PHASE(14) PHASE(15) PHASE(16) PHASE(17) PHASE(18) PHASE(19)
#undef PHASE
#if defined(STAMP_SEL)
    asm volatile("s_waitcnt vmcnt(0)" ::: "memory"); __syncthreads(); STAMP(20);
    if (blockIdx.x == 0 && wave == 0 && lane_id() == 0) { unsigned d = (st[4 + STAMP_SEL_END] - st[4 + STAMP_SEL]); d = (d > 100000u ? 0u : d) * STAMP_MUL; const unsigned t0 = (unsigned)__builtin_amdgcn_s_memrealtime();
        while ((unsigned)__builtin_amdgcn_s_memrealtime() - t0 < d) __builtin_amdgcn_s_sleep(8); }
#endif
}

extern "C" void kernel_launch(void* const* d_in, const int* in_sizes, int n_in, void* d_out, int out_size, void* d_ws, size_t ws_size, hipStream_t stream) {
    static int grid = 0;
    if (grid == 0) {
        if (n_in != 30 || out_size != M * D || ws_size < WS_END) { fprintf(stderr, "kernel_launch: unexpected shapes (n_in %d out %d ws %zu)\n", n_in, out_size, ws_size); grid = -1; return; }
        int dev = 0, cus = 0, per_cu = 0;
        if (hipGetDevice(&dev) != hipSuccess || hipDeviceGetAttribute(&cus, hipDeviceAttributeMultiprocessorCount, dev) != hipSuccess) { grid = -1; return; }
        if (hipFuncSetAttribute((const void*)trunk_fwd, hipFuncAttributeMaxDynamicSharedMemorySize, LDS_BYTES) != hipSuccess) { fprintf(stderr, "kernel_launch: hipFuncSetAttribute failed\n"); grid = -1; return; }
        if (hipOccupancyMaxActiveBlocksPerMultiprocessor(&per_cu, (const void*)trunk_fwd, NTHREADS, LDS_BYTES) != hipSuccess || per_cu < 1) { fprintf(stderr, "kernel_launch: occupancy query says %d\n", per_cu); grid = -1; return; }
        grid = cus;
    }
    if (grid < 0) return;
    if (hipMemsetAsync(d_ws, 0, 65536, stream) != hipSuccess) { fprintf(stderr, "kernel_launch: memset failed\n"); return; }
    Args a{};
    for (int i = 0; i < 30; ++i) a.in[i] = (const float*)d_in[i];
    a.out = (float*)d_out; a.ws = (unsigned char*)d_ws;
#if MK_N_LAUNCHES == 1
    a.ph_lo = 0; a.ph_hi = NPH;
    void* kargs[] = {&a};
    hipError_t e = hipLaunchCooperativeKernel((const void*)trunk_fwd, dim3(grid), dim3(NTHREADS), kargs, LDS_BYTES, stream);
    if (e != hipSuccess) fprintf(stderr, "kernel_launch: cooperative launch failed: %s\n", hipGetErrorString(e));
#else
    for (int ph = 0; ph < NPH; ++ph) { a.ph_lo = ph; a.ph_hi = ph + 1; hipLaunchKernelGGL(trunk_fwd, dim3(grid), dim3(NTHREADS), LDS_BYTES, stream, a); }
#endif
}
```
